# Optimizing an MI355X kernel written in HIP

```python
import jax, jax.numpy as jnp
from jax import lax
import numpy as np

D_MODEL = 2048
BATCH = 2
SEQ = 4096
DEPTH = 1

N_HEADS = 16
QK_NOPE_DIM = 128
QK_ROPE_DIM = 64
QK_HEAD_DIM = QK_NOPE_DIM + QK_ROPE_DIM
V_HEAD_DIM = 128
Q_LORA_RANK = 512
KV_LORA_RANK = 512
ROPE_THETA = 10000.0
Q_BLOCK = 128
POOL_WINDOWS = (2, 4, 8, 16)
POOL_GROUPS = 4
POOL_GROUP_DIM = D_MODEL // 8
POOL_WIDTH = POOL_GROUPS * POOL_GROUP_DIM
N_BRANCHES = 2
D_FF = (8 * D_MODEL + 3 * 256 - 1) // (3 * 256) * 256
EPS = 1e-6

IN_SPLITS = (Q_LORA_RANK, KV_LORA_RANK, QK_ROPE_DIM, POOL_WIDTH, N_BRANCHES * D_MODEL)
D_IN = sum(IN_SPLITS)

kernel_name = "hybrid_pool_mla_gated_block"


def rmsnorm(x, g):
    x32 = x.astype(jnp.float32)
    inv = lax.rsqrt(jnp.mean(x32 * x32, axis=-1, keepdims=True) + EPS)
    return (x32 * inv).astype(x.dtype) * g


def apply_rope(t, positions):
    half = QK_ROPE_DIM // 2
    inv_freq = ROPE_THETA ** (-jnp.arange(half, dtype=jnp.float32) / half)
    ang = positions.astype(jnp.float32)[..., None] * inv_freq
    cos = jnp.cos(ang)[:, :, None, :]
    sin = jnp.sin(ang)[:, :, None, :]
    t32 = t.astype(jnp.float32)
    t1, t2 = t32[..., :half], t32[..., half:]
    out = jnp.concatenate([t1 * cos - t2 * sin, t2 * cos + t1 * sin], axis=-1)
    return out.astype(t.dtype)


def causal_multiscale_pool(u):
    B, S, _ = u.shape
    ug = u.reshape(B, S, POOL_GROUPS, POOL_GROUP_DIM)
    cs = jnp.cumsum(ug.astype(jnp.float32), axis=1)
    cs = jnp.pad(cs, ((0, 0), (1, 0), (0, 0), (0, 0)))
    t = jnp.arange(S)
    outs = []
    for g, w in enumerate(POOL_WINDOWS):
        cs_g = cs[:, :, g]
        lo = jnp.maximum(t + 1 - w, 0)
        window_sum = cs_g[:, t + 1] - cs_g[:, lo]
        count = (t + 1 - lo).astype(jnp.float32)
        outs.append(window_sum / count[None, :, None] - ug[:, :, g].astype(jnp.float32))
    return jnp.stack(outs, axis=2).astype(u.dtype)


def causal_block_attention(q, k, v):
    B, S, H, Dq = q.shape
    nb = S // Q_BLOCK
    qb = q.reshape(B, nb, Q_BLOCK, H, Dq).transpose(1, 0, 2, 3, 4)
    kpos = jnp.arange(S)
    scale = QK_HEAD_DIM ** -0.5

    def one_block(args):
        i, qi = args
        s = jnp.einsum('bqhd,bkhd->bhqk', qi, k, preferred_element_type=jnp.float32) * scale
        qpos = i * Q_BLOCK + jnp.arange(Q_BLOCK)
        mask = kpos[None, :] <= qpos[:, None]
        s = jnp.where(mask[None, None], s, -jnp.inf)
        p = jax.nn.softmax(s, axis=-1).astype(v.dtype)
        return jnp.einsum('bhqk,bkhd->bqhd', p, v)

    out = lax.map(one_block, (jnp.arange(nb), qb))
    return out.transpose(1, 0, 2, 3, 4).reshape(B, S, H, v.shape[-1])


def setup_inputs(seed: int = 0) -> dict:
    key = jax.random.key(seed)
    ks = jax.random.split(key, 24)

    def w(k, shape, fan_in):
        return jax.random.normal(k, shape, jnp.float32) * fan_in ** -0.5

    def gain(k, shape):
        return 1.0 + 0.02 * jax.random.normal(k, shape, jnp.float32)

    L = DEPTH
    return {
        "x": jax.random.normal(ks[0], (BATCH, SEQ, D_MODEL), jnp.float32),
        "positions": jnp.broadcast_to(jnp.arange(SEQ, dtype=jnp.int32), (BATCH, SEQ)),
        "attn_norm_g": gain(ks[1], (L, D_MODEL)),
        "w_in": w(ks[2], (L, D_MODEL, D_IN), D_MODEL),
        "b_gate": 0.02 * jax.random.normal(ks[3], (L, N_BRANCHES * D_MODEL), jnp.float32),
        "q_a_norm_g": gain(ks[4], (L, Q_LORA_RANK)),
        "w_q_b": w(ks[5], (L, Q_LORA_RANK, N_HEADS * QK_HEAD_DIM), Q_LORA_RANK),
        "kv_a_norm_g": gain(ks[6], (L, KV_LORA_RANK)),
        "w_kv_b": w(ks[7], (L, KV_LORA_RANK, N_HEADS * (QK_NOPE_DIM + V_HEAD_DIM)), KV_LORA_RANK),
        "q_norm_g": gain(ks[8], (L, QK_HEAD_DIM)),
        "k_norm_g": gain(ks[9], (L, QK_HEAD_DIM)),
        "w_attn_o": w(ks[10], (L, N_HEADS * V_HEAD_DIM, D_MODEL), N_HEADS * V_HEAD_DIM),
        "w_pool_grp": w(ks[11], (L, POOL_GROUPS, POOL_GROUP_DIM, POOL_GROUP_DIM), POOL_GROUP_DIM),
        "pool_scale": gain(ks[12], (L, POOL_GROUPS, POOL_GROUP_DIM)),
        "w_pool_o": w(ks[13], (L, POOL_WIDTH, D_MODEL), POOL_WIDTH),
        "w_out": w(ks[14], (L, D_MODEL, D_MODEL), D_MODEL),
        "ffn_norm_g": gain(ks[15], (L, D_MODEL)),
        "w_ffn_gate": w(ks[16], (L, D_MODEL, D_FF), D_MODEL),
        "w_ffn_up": w(ks[17], (L, D_MODEL, D_FF), D_MODEL),
        "w_ffn_down": w(ks[18], (L, D_FF, D_MODEL), D_FF),
    }


def reference(x, positions, attn_norm_g, w_in, b_gate, q_a_norm_g, w_q_b, kv_a_norm_g, w_kv_b,
              q_norm_g, k_norm_g, w_attn_o, w_pool_grp, pool_scale, w_pool_o, w_out,
              ffn_norm_g, w_ffn_gate, w_ffn_up, w_ffn_down):
    B, S, _ = x.shape
    offsets = list(np.cumsum(IN_SPLITS)[:-1])
    for l in range(DEPTH):
        h = rmsnorm(x, attn_norm_g[l])
        proj = h @ w_in[l]
        c_q, c_kv, k_rope, u_pool, gate_logits = jnp.split(proj, offsets, axis=-1)
        gates = jax.nn.sigmoid(gate_logits + b_gate[l])
        g_pool, g_attn = gates[..., :D_MODEL], gates[..., D_MODEL:]

        pooled = causal_multiscale_pool(u_pool)
        pooled = jnp.einsum('bsgc,gcd->bsgd', pooled, w_pool_grp[l]) * pool_scale[l]
        y_pool = pooled.reshape(B, S, POOL_WIDTH) @ w_pool_o[l]

        q = (rmsnorm(c_q, q_a_norm_g[l]) @ w_q_b[l]).reshape(B, S, N_HEADS, QK_HEAD_DIM)
        kv = (rmsnorm(c_kv, kv_a_norm_g[l]) @ w_kv_b[l]).reshape(B, S, N_HEADS, QK_NOPE_DIM + V_HEAD_DIM)
        k_nope, v = kv[..., :QK_NOPE_DIM], kv[..., QK_NOPE_DIM:]
        k_rope_h = jnp.broadcast_to(k_rope[:, :, None, :], (B, S, N_HEADS, QK_ROPE_DIM))
        k = jnp.concatenate([k_nope, k_rope_h], axis=-1)
        q = rmsnorm(q, q_norm_g[l])
        k = rmsnorm(k, k_norm_g[l])
        q = jnp.concatenate([q[..., :QK_NOPE_DIM], apply_rope(q[..., QK_NOPE_DIM:], positions)], axis=-1)
        k = jnp.concatenate([k[..., :QK_NOPE_DIM], apply_rope(k[..., QK_NOPE_DIM:], positions)], axis=-1)
        attn = causal_block_attention(q, k, v)
        y_attn = attn.reshape(B, S, N_HEADS * V_HEAD_DIM) @ w_attn_o[l]

        mixed = g_pool * y_pool + g_attn * y_attn
        x = x + mixed @ w_out[l]

        h2 = rmsnorm(x, ffn_norm_g[l])
        x = x + (jax.nn.silu(h2 @ w_ffn_gate[l]) * (h2 @ w_ffn_up[l])) @ w_ffn_down[l]
    return x
```

```cpp
#include <hip/hip_runtime.h>
#include <hip/hip_cooperative_groups.h>
#include <cstdio>
#include <cstdint>
namespace cg = cooperative_groups;

#ifndef MK_N_LAUNCHES
#define MK_N_LAUNCHES 1
#endif

namespace pg8 {
#define PG8_LAS __attribute__((address_space(3)))
typedef unsigned short bf16_t;
typedef short bf16x8 __attribute__((ext_vector_type(8)));
typedef float f32x4 __attribute__((ext_vector_type(4)));
typedef unsigned u32x4 __attribute__((ext_vector_type(4)));
constexpr int BM = 256, BK = 64, HALF = 128, HTB = HALF * BK * 2, STAGE_BYTES = 8 * HTB, NXCD = 8, WGM = 8;

__host__ __device__ __forceinline__ int lds_byte(int r, int c) { const int st = (r >> 4) * 2 + (c >> 5), rr = r & 15, cc = c & 31, ob = rr * 64 + cc * 2; return st * 1024 + (ob ^ (((ob >> 9) & 1) << 5)); }
__host__ __device__ __forceinline__ void stage_rc(int b, int& R, int& C) { const int st = b / 1024, sb = b % 1024, swz = sb ^ (((sb >> 9) & 1) << 5); R = (st >> 1) * 16 + swz / 64; C = (st & 1) * 32 + (swz % 64) / 2; }
__host__ __device__ __forceinline__ int perm32(int rho) { const int n = rho >> 4, i = rho & 15; return 8 * (i >> 2) + 4 * n + (i & 3); }

struct Unit { int pm, pn; };
struct Gemm { const bf16_t* A; const bf16_t* Bt; int M, N, K, lda, ldb, a_pn_step; };

struct StaticOrder {
    int nM, nN, nwg, G, c;
    __host__ __device__ void init(int M, int N, int G_, int c_) { nM = M / BM; nN = N / BM; nwg = nM * nN; G = G_; c = c_; }
    __host__ __device__ bool next(int i, Unit& u) const {
        const long L = (long)i * G + c; if (L >= nwg) return false;
        int wgid = (int)L; { const int q = nwg / NXCD, r = nwg % NXCD, xcd = wgid % NXCD, off = wgid / NXCD; wgid = (xcd < r ? xcd * (q + 1) : r * (q + 1) + (xcd - r) * q) + off; }
        const int nig = WGM * nN, gid = wgid / nig, fm = gid * WGM, gsz = (nM - fm) < WGM ? (nM - fm) : WGM;
        u.pm = fm + ((wgid % nig) % gsz); u.pn = (wgid % nig) / gsz; return true;
    }
};

typedef float f32x2_t_ __attribute__((ext_vector_type(2))); typedef __bf16 bf16x2_t_ __attribute__((ext_vector_type(2)));
__device__ __forceinline__ unsigned cvt_pk_bf16(float lo, float hi) { f32x2_t_ v = {lo, hi}; bf16x2_t_ b = __builtin_convertvector(v, bf16x2_t_); return __builtin_bit_cast(unsigned, b); }
__device__ __forceinline__ u32x4 pack8(f32x4 a, f32x4 b) { u32x4 w; w.x = cvt_pk_bf16(a[0], a[1]); w.y = cvt_pk_bf16(a[2], a[3]); w.z = cvt_pk_bf16(b[0], b[1]); w.w = cvt_pk_bf16(b[2], b[3]); return w; }
__device__ __forceinline__ void unpack8(u32x4 w, f32x4& a, f32x4& b) {
    a[0] = __uint_as_float(w.x << 16); a[1] = __uint_as_float(w.x & 0xffff0000u); a[2] = __uint_as_float(w.y << 16); a[3] = __uint_as_float(w.y & 0xffff0000u);
    b[0] = __uint_as_float(w.z << 16); b[1] = __uint_as_float(w.z & 0xffff0000u); b[2] = __uint_as_float(w.w << 16); b[3] = __uint_as_float(w.w & 0xffff0000u); }
__device__ __forceinline__ float sigmoidf_(float v) { return __builtin_amdgcn_rcpf(1.0f + __builtin_amdgcn_exp2f(-1.4426950408889634f * v)); }
__device__ __forceinline__ f32x4 sigmoid4(f32x4 v) { f32x4 o; o[0] = sigmoidf_(v[0]); o[1] = sigmoidf_(v[1]); o[2] = sigmoidf_(v[2]); o[3] = sigmoidf_(v[3]); return o; }

typedef f32x4 AccT[2][2][4][2];
#define EPI_LOOP_AM _Pragma("unroll") for (int ai = 0; ai < 2; ++ai) _Pragma("unroll") for (int m = 0; m < 4; ++m)
#define EPI_LOOP_B _Pragma("unroll") for (int bj = 0; bj < 2; ++bj)

struct EpiIn {
    static constexpr bool PERM = true;
    float* C1; bf16_t* U; bf16_t* G; float* KR; const float* bgate;
    __device__ __forceinline__ void operator()(const AccT& acc, const Unit& u, int wr, int wc, int fr, int fq) const {
        const int row0 = u.pm * BM + wr * 64 + fr, pn = u.pn, cw = wc * 32 + 8 * fq;
        if (pn < 4) {
            EPI_LOOP_AM { float* rp = C1 + (size_t)(row0 + ai * HALF + m * 16) * 1024 + pn * 256 + cw;
                EPI_LOOP_B { *(f32x4*)(rp + bj * HALF) = acc[ai][bj][m][0]; *(f32x4*)(rp + bj * HALF + 4) = acc[ai][bj][m][1]; } }
        } else if (pn < 8) {
            EPI_LOOP_AM { bf16_t* rp = U + (size_t)(row0 + ai * HALF + m * 16) * 1024 + (pn - 4) * 256 + cw;
                EPI_LOOP_B { *(u32x4*)(rp + bj * HALF) = pack8(acc[ai][bj][m][0], acc[ai][bj][m][1]); } }
        } else if (pn < 24) {
            const int gc = (pn - 8) * 256 + cw; f32x4 bv[2][2];
            EPI_LOOP_B { bv[bj][0] = *(const f32x4*)(bgate + gc + bj * HALF); bv[bj][1] = *(const f32x4*)(bgate + gc + bj * HALF + 4); }
            EPI_LOOP_AM { bf16_t* rp = G + (size_t)(row0 + ai * HALF + m * 16) * 4096 + gc;
                EPI_LOOP_B { *(u32x4*)(rp + bj * HALF) = pack8(sigmoid4(acc[ai][bj][m][0] + bv[bj][0]), sigmoid4(acc[ai][bj][m][1] + bv[bj][1])); } }
        } else {
            if (wc < 2) { EPI_LOOP_AM { float* rp = KR + (size_t)(row0 + ai * HALF + m * 16) * 64 + cw; *(f32x4*)rp = acc[ai][0][m][0]; *(f32x4*)(rp + 4) = acc[ai][0][m][1]; } }
        }
    }
};
struct EpiBf16 {
    static constexpr bool PERM = true;
    bf16_t* O; int ldc;
    __device__ __forceinline__ void operator()(const AccT& acc, const Unit& u, int wr, int wc, int fr, int fq) const {
        const int row0 = u.pm * BM + wr * 64 + fr, col0 = u.pn * BM + wc * 32 + 8 * fq;
        EPI_LOOP_AM { bf16_t* rp = O + (size_t)(row0 + ai * HALF + m * 16) * ldc + col0;
            EPI_LOOP_B { *(u32x4*)(rp + bj * HALF) = pack8(acc[ai][bj][m][0], acc[ai][bj][m][1]); } }
    }
};
struct EpiKV {
    static constexpr bool PERM = true;
    bf16_t* K; bf16_t* V;
    __device__ __forceinline__ void operator()(const AccT& acc, const Unit& u, int wr, int wc, int fr, int fq) const {
        const int row0 = u.pm * BM + wr * 64 + fr, cw = wc * 32 + 8 * fq, h = u.pn;
        EPI_LOOP_AM { const size_t row = (size_t)(row0 + ai * HALF + m * 16);
            *(u32x4*)(K + row * 3072 + h * 192 + cw) = pack8(acc[ai][0][m][0], acc[ai][0][m][1]);
            *(u32x4*)(V + row * 2048 + h * 128 + cw) = pack8(acc[ai][1][m][0], acc[ai][1][m][1]); }
    }
};
struct EpiScale {
    static constexpr bool PERM = true;
    bf16_t* O; int ldc; const float* scale;
    __device__ __forceinline__ void operator()(const AccT& acc, const Unit& u, int wr, int wc, int fr, int fq) const {
        const int row0 = u.pm * BM + wr * 64 + fr, col0 = u.pn * BM + wc * 32 + 8 * fq; f32x4 sv[2][2];
        EPI_LOOP_B { sv[bj][0] = *(const f32x4*)(scale + col0 + bj * HALF); sv[bj][1] = *(const f32x4*)(scale + col0 + bj * HALF + 4); }
        EPI_LOOP_AM { bf16_t* rp = O + (size_t)(row0 + ai * HALF + m * 16) * ldc + col0;
            EPI_LOOP_B { *(u32x4*)(rp + bj * HALF) = pack8(acc[ai][bj][m][0] * sv[bj][0], acc[ai][bj][m][1] * sv[bj][1]); } }
    }
};
template <bool HAS_ADD> struct EpiGate {
    static constexpr bool PERM = true;
    bf16_t* O; const bf16_t* gate; const bf16_t* add; int gcol0;
    __device__ __forceinline__ void operator()(const AccT& acc, const Unit& u, int wr, int wc, int fr, int fq) const {
        const int row0 = u.pm * BM + wr * 64 + fr, col0 = u.pn * BM + wc * 32 + 8 * fq;
        EPI_LOOP_AM { const size_t row = (size_t)(row0 + ai * HALF + m * 16);
            EPI_LOOP_B { f32x4 g0, g1; unpack8(*(const u32x4*)(gate + row * 4096 + gcol0 + col0 + bj * HALF), g0, g1);
                f32x4 v0 = g0 * acc[ai][bj][m][0], v1 = g1 * acc[ai][bj][m][1];
                if (HAS_ADD) { f32x4 a0, a1; unpack8(*(const u32x4*)(add + row * 2048 + col0 + bj * HALF), a0, a1); v0 += a0; v1 += a1; }
                *(u32x4*)(O + row * 2048 + col0 + bj * HALF) = pack8(v0, v1); } }
    }
};
struct EpiRes {
    static constexpr bool PERM = false;
    const float* base; float* out; int ldc;
    __device__ __forceinline__ void operator()(const AccT& acc, const Unit& u, int wr, int wc, int fr, int fq) const {
        const int row0 = u.pm * BM + wr * 64 + fr, col0 = u.pn * BM + wc * 32 + 4 * fq;
        EPI_LOOP_AM { const size_t off = (size_t)(row0 + ai * HALF + m * 16) * ldc + col0;
            EPI_LOOP_B {
#pragma unroll
                for (int n = 0; n < 2; ++n) { const f32x4 b = *(const f32x4*)(base + off + bj * HALF + n * 16); *(f32x4*)(out + off + bj * HALF + n * 16) = b + acc[ai][bj][m][n]; } } }
    }
};
struct EpiSwiGLU {
    static constexpr bool PERM = true;
    bf16_t* O; int ldc;
    __device__ __forceinline__ void operator()(const AccT& acc, const Unit& u, int wr, int wc, int fr, int fq) const {
        const int row0 = u.pm * BM + wr * 64 + fr, col0 = u.pn * HALF + wc * 32 + 8 * fq;
        EPI_LOOP_AM { bf16_t* rp = O + (size_t)(row0 + ai * HALF + m * 16) * ldc + col0;
            const f32x4 g0 = acc[ai][0][m][0], g1 = acc[ai][0][m][1];
            *(u32x4*)rp = pack8(g0 * sigmoid4(g0) * acc[ai][1][m][0], g1 * sigmoid4(g1) * acc[ai][1][m][1]); }
    }
};

template <class Epi, class Sched, bool ALIGN_EPI = true>
__device__ __forceinline__ void gemm_phase(PG8_LAS unsigned char* lds, const Gemm g, const Sched& S, const Epi& E) {
    const int tid = threadIdx.x, wid = __builtin_amdgcn_readfirstlane(tid >> 6), lane = tid & 63, wr = wid >> 2, wc = wid & 3, fr = lane & 15, fq = lane >> 4;
    const int K = g.K, nt = K / BK;
    unsigned voffA[2], voffB[2];
#pragma unroll
    for (int i = 0; i < 2; ++i) { int R, C; stage_rc(tid * 16 + i * 8192, R, C); const int Rb = Epi::PERM ? ((R & ~31) + perm32(R & 31)) : R;
        voffA[i] = (unsigned)(R * g.lda + C) * 2u; voffB[i] = (unsigned)(Rb * g.ldb + C) * 2u; }
    const size_t kstep = (size_t)(BK * 2);
    const size_t hstepA = (size_t)HALF * g.lda * 2, hstepB = (size_t)HALF * g.ldb * 2;
    const size_t tstepA = 2 * hstepA, tstepB = 2 * hstepB, pstepA = (size_t)g.a_pn_step * 2;
    const unsigned ldsw = (unsigned)wid * 1024u;
    const int aoff = lds_byte(wr * 64 + fr, fq * 8), boff = lds_byte(wc * 32 + fr, fq * 8);
#define PG8_SA(b, h) (((b) * 2 + (h)) * HTB)
#define PG8_SB(b, h) ((4 + (b) * 2 + (h)) * HTB)
#define PG8_STAGE(bufoff, gbase, voff) do { _Pragma("unroll") for (int _i = 0; _i < 2; ++_i) \
        __builtin_amdgcn_global_load_lds((const unsigned*)((const char*)(gbase) + (voff)[_i]), (PG8_LAS unsigned*)(lds + (bufoff) + ldsw + _i * 8192), 16, 0, 0); } while (0)
#define PG8_LDA(dst, b, h) do { _Pragma("unroll") for (int m = 0; m < 4; ++m) _Pragma("unroll") for (int k = 0; k < 2; ++k) dst[m][k] = *(const PG8_LAS bf16x8*)(lds + PG8_SA(b, h) + aoff + m * 2048 + k * 1024); } while (0)
#define PG8_LDB(dst, b, h) do { _Pragma("unroll") for (int n = 0; n < 2; ++n) _Pragma("unroll") for (int k = 0; k < 2; ++k) dst[n][k] = *(const PG8_LAS bf16x8*)(lds + PG8_SB(b, h) + boff + n * 2048 + k * 1024); } while (0)
#define PG8_MMA(ai, bj, At, Bt) do { __builtin_amdgcn_s_setprio(1); _Pragma("unroll") for (int m = 0; m < 4; ++m) _Pragma("unroll") for (int n = 0; n < 2; ++n) _Pragma("unroll") for (int k = 0; k < 2; ++k) \
        acc[ai][bj][m][n] = __builtin_amdgcn_mfma_f32_16x16x32_bf16(Bt[n][k], At[m][k], acc[ai][bj][m][n], 0, 0, 0); __builtin_amdgcn_s_setprio(0); } while (0)
#define PG8_WAIT_V(n) asm volatile("s_waitcnt vmcnt(" #n ")" ::: "memory")
#define PG8_WAIT_L(n) asm volatile("s_waitcnt lgkmcnt(" #n ")" ::: "memory")
#define PG8_BAR __builtin_amdgcn_s_barrier()
#define PG8_SCHED __builtin_amdgcn_sched_barrier(0)
    Unit cur, nxt; int ui = 0;
    if (!S.next(0, cur)) return;
    f32x4 acc[2][2][4][2];
#pragma unroll
    for (int a = 0; a < 2; ++a)
#pragma unroll
        for (int b = 0; b < 2; ++b)
#pragma unroll
            for (int m = 0; m < 4; ++m)
#pragma unroll
                for (int n = 0; n < 2; ++n) acc[a][b][m][n] = (f32x4){0.f, 0.f, 0.f, 0.f};
    bf16x8 At[4][2], B0[2][2], B1[2][2];
    const char* cA = (const char*)g.A + (size_t)cur.pm * tstepA + (size_t)cur.pn * pstepA; const char* cB = (const char*)g.Bt + (size_t)cur.pn * tstepB;
    PG8_STAGE(PG8_SB(0, 0), cB, voffB); PG8_STAGE(PG8_SB(0, 1), cB + hstepB, voffB); PG8_STAGE(PG8_SA(0, 0), cA, voffA); PG8_STAGE(PG8_SA(0, 1), cA + hstepA, voffA);
    if (wr == 1) PG8_BAR;
    PG8_WAIT_V(2); PG8_BAR;
    PG8_STAGE(PG8_SB(1, 0), cB + kstep, voffB); PG8_STAGE(PG8_SA(1, 0), cA + kstep, voffA); PG8_STAGE(PG8_SB(1, 1), cB + hstepB + kstep, voffB);
    PG8_WAIT_V(6); PG8_BAR;
    for (;;) {
        const bool has_next = S.next(ui + 1, nxt);
        const char* nA = has_next ? (const char*)g.A + (size_t)nxt.pm * tstepA + (size_t)nxt.pn * pstepA : cA; const char* nB = has_next ? (const char*)g.Bt + (size_t)nxt.pn * tstepB : cB;
        for (int t = 0; t < nt; t += 2) {
            const bool last = (t == nt - 2);
            const char* a1 = cA + (size_t)(t + 1) * kstep;
            const char* a2 = last ? nA : cA + (size_t)(t + 2) * kstep; const char* b2 = last ? nB : cB + (size_t)(t + 2) * kstep;
            const char* a3 = a2 + kstep; const char* b3 = b2 + kstep;
            PG8_LDB(B0, 0, 0); PG8_LDB(B1, 0, 1); PG8_SCHED; PG8_LDA(At, 0, 0); PG8_STAGE(PG8_SA(1, 1), a1 + hstepA, voffA);
            PG8_WAIT_V(8); PG8_WAIT_L(0); PG8_BAR; PG8_MMA(0, 0, At, B0); PG8_MMA(0, 1, At, B1); PG8_BAR; PG8_SCHED;
            PG8_LDA(At, 0, 1); PG8_STAGE(PG8_SB(0, 0), b2, voffB); PG8_STAGE(PG8_SB(0, 1), b2 + hstepB, voffB); PG8_STAGE(PG8_SA(0, 0), a2, voffA);
            PG8_WAIT_V(8); PG8_WAIT_L(0); PG8_BAR; PG8_MMA(1, 0, At, B0); PG8_MMA(1, 1, At, B1); PG8_BAR; PG8_SCHED;
            PG8_LDB(B0, 1, 0); PG8_LDB(B1, 1, 1); PG8_SCHED; PG8_LDA(At, 1, 0); PG8_STAGE(PG8_SA(0, 1), a2 + hstepA, voffA);
            PG8_WAIT_V(8); PG8_WAIT_L(0); PG8_BAR; PG8_MMA(0, 0, At, B0); PG8_MMA(0, 1, At, B1); PG8_BAR; PG8_SCHED;
            PG8_LDA(At, 1, 1); PG8_STAGE(PG8_SB(1, 0), b3, voffB); PG8_STAGE(PG8_SB(1, 1), b3 + hstepB, voffB); PG8_STAGE(PG8_SA(1, 0), a3, voffA);
            PG8_WAIT_V(8); PG8_WAIT_L(0); PG8_BAR; PG8_MMA(1, 0, At, B0); PG8_MMA(1, 1, At, B1); PG8_BAR; PG8_SCHED;
        }
        if constexpr (ALIGN_EPI) { if (wr == 0) PG8_BAR; }
        E(acc, cur, wr, wc, fr, fq);
        if (!has_next) break;
#pragma unroll
        for (int a = 0; a < 2; ++a)
#pragma unroll
            for (int b = 0; b < 2; ++b)
#pragma unroll
                for (int m = 0; m < 4; ++m)
#pragma unroll
                    for (int n = 0; n < 2; ++n) acc[a][b][m][n] = (f32x4){0.f, 0.f, 0.f, 0.f};
        cur = nxt; cA = nA; cB = nB; ++ui;
        if constexpr (ALIGN_EPI) { if (wr == 1) PG8_BAR; }
    }
    PG8_WAIT_V(0);
    if constexpr (!ALIGN_EPI) { if (wr == 0) PG8_BAR; }
    PG8_BAR;
#undef PG8_SA
#undef PG8_SB
#undef PG8_STAGE
#undef PG8_LDA
#undef PG8_LDB
#undef PG8_MMA
#undef PG8_WAIT_V
#undef PG8_WAIT_L
#undef PG8_BAR
#undef PG8_SCHED
}
}

constexpr int BATCH = 2, SEQ = 4096, DM = 2048, M = BATCH * SEQ;
constexpr int NH = 16, DQK = 192, DNOPE = 128, DROPE = 64, DV = 128, QLORA = 512, KVLORA = 512;
constexpr int POOLW = 1024, DIN = 6208, DIN_PAD = 6400, DFF = 5632;
constexpr float EPS = 1e-6f;
constexpr int NWAVES = 8;

typedef unsigned short bf16;
typedef unsigned v4u __attribute__((ext_vector_type(4)));
typedef unsigned v2u __attribute__((ext_vector_type(2)));
typedef float f32x4 __attribute__((ext_vector_type(4)));
typedef short bf16x8 __attribute__((ext_vector_type(8)));
typedef short s16x4 __attribute__((ext_vector_type(4)));
typedef float f32x16 __attribute__((ext_vector_type(16)));
#define LAS __attribute__((address_space(3)))
#define LDS_WAIT() asm volatile("s_waitcnt lgkmcnt(0)" ::: "memory")

constexpr size_t MiB = 1u << 20;
constexpr size_t WS_WAO = 1 * MiB, WS_WOUT = 9 * MiB, WS_WPO = 17 * MiB, WS_WQB = 21 * MiB, WS_WKVB = 24 * MiB, WS_WPG = 28 * MiB, WS_KR = 29 * MiB;
constexpr size_t WS_G = 31 * MiB;
constexpr size_t WS_WIN = 95 * MiB, WS_XN = 120 * MiB, WS_C1 = 152 * MiB, WS_U = 184 * MiB;
constexpr size_t WS_Q = 95 * MiB, WS_K = 143 * MiB, WS_V = 191 * MiB, WS_CN = 223 * MiB, WS_POOLED = 239 * MiB, WS_PG = 255 * MiB;
constexpr size_t WS_MP = 223 * MiB, WS_O = 255 * MiB, WS_MIXED = 95 * MiB, WS_X1 = 127 * MiB, WS_H2 = 95 * MiB;
constexpr size_t WS_WGU = 191 * MiB, WS_WDN = 235 * MiB, WS_ACT = 1 * MiB;
constexpr size_t WS_END = 296 * MiB, WS_BAR = 512 * 1024;
constexpr int SV_BGATE = 0, SV_QAG = 4096, SV_KVAG = 4608, SV_QNG = 5120, SV_KNG = 5376, SV_PSC = 5632, SV_FNG = 6656, SV_POS = 8704, SV_END = 8704 + 8192;

constexpr int LDS_BYTES = 147456;

__device__ __forceinline__ unsigned cvtpk(float lo, float hi) { return pg8::cvt_pk_bf16(lo, hi); }
__device__ __forceinline__ float bflo(unsigned w) { return __uint_as_float(w << 16); }
__device__ __forceinline__ float bfhi(unsigned w) { return __uint_as_float(w & 0xffff0000u); }
__device__ __forceinline__ float wave_sum(float v) {
#pragma unroll
    for (int o = 1; o < 64; o <<= 1) v += __shfl_xor(v, o);
    return v;
}

__device__ __forceinline__ int dst_row(int mode, int n0) {
    if (mode == 1) { if (n0 < 1024) return n0; if (n0 < 1088) return 6144 + (n0 - 1024); if (n0 < 2112) return 1024 + (n0 - 1088); return 2048 + (n0 - 2112); }
    if (mode == 2) return (n0 >> 7) * 256 + (n0 & 127);
    if (mode == 3) return (n0 >> 7) * 256 + 128 + (n0 & 127);
    return n0;
}
__device__ __forceinline__ void transpose_item(const float* W, int K, int N, bf16* WT, int mode, int row_off, LAS float* scr, int item, int lane) {
    const int nblk = N / 32, kb = item / nblk, nb = item % nblk, k0 = 64 * kb, n0 = 32 * nb;
#pragma unroll 8
    for (int i = 0; i < 32; ++i) { const int kk = 2 * i + (lane >> 5); scr[kk * 33 + (lane & 31)] = W[(size_t)(k0 + kk) * N + n0 + (lane & 31)]; }
    LDS_WAIT(); asm volatile("" ::: "memory");
    const int c = lane & 7, dr = row_off + dst_row(mode, n0);
#pragma unroll
    for (int j = 0; j < 4; ++j) { const int n = (lane >> 3) + 8 * j; const LAS float* s = scr + (8 * c) * 33 + n;
        v4u o; o.x = cvtpk(s[0 * 33], s[1 * 33]); o.y = cvtpk(s[2 * 33], s[3 * 33]); o.z = cvtpk(s[4 * 33], s[5 * 33]); o.w = cvtpk(s[6 * 33], s[7 * 33]);
        *(v4u*)(WT + (size_t)(dr + n) * K + k0 + 8 * c) = o; }
    LDS_WAIT(); asm volatile("" ::: "memory");
}

__device__ __forceinline__ void rms_row_2048(const float* xrow, const float* g, bf16* orow, int lane) {
    const f32x4* xr = (const f32x4*)xrow + lane; const f32x4* gr = (const f32x4*)g + lane;
    f32x4 v[8]; float s = 0.f;
#pragma unroll
    for (int j = 0; j < 8; ++j) { v[j] = xr[64 * j]; s += (v[j].x * v[j].x + v[j].y * v[j].y) + (v[j].z * v[j].z + v[j].w * v[j].w); }
    const float inv = 1.0f / sqrtf(wave_sum(s) * (1.f / 2048.f) + EPS);
    v2u* o8 = (v2u*)orow + lane;
#pragma unroll
    for (int j = 0; j < 8; ++j) { const f32x4 gv = gr[64 * j]; v2u o; o.x = cvtpk(v[j].x * inv * gv.x, v[j].y * inv * gv.y); o.y = cvtpk(v[j].z * inv * gv.z, v[j].w * inv * gv.w); o8[64 * j] = o; }
}

namespace att {
constexpr int QBLK = 32, KVBLK = 64, QB = 256;
constexpr int SHM_V = KVBLK * DV * 2, SHM_K = KVBLK * DQK * 2;
constexpr int OFF_V = 0, OFF_K = 2 * SHM_V, OFF_WS = OFF_K + 2 * SHM_K;
constexpr float SCALE = 0.07216878364870322f;
constexpr float THR = 8.f;
#define KSWZ(row, colB) ((row) * 384 + ((colB) ^ (((row) & 7) << 4)))
#define SBAR() __builtin_amdgcn_sched_barrier(0)
__device__ __forceinline__ int v_st(int k, int c) { const int kk = (k & ~0xC) | ((k & 4) << 1) | ((k & 8) >> 1); return ((kk >> 3) * 4 + (c >> 5)) * 512 + ((kk & 7) * 32 + (c & 31)) * 2; }
__device__ __forceinline__ int v_rd_base(int lane) { return ((lane & 3) << 3) | (((lane >> 2) & 3) << 6) | (((lane >> 4) & 1) << 5) | (((lane >> 5) & 1) << 8); }
__device__ __forceinline__ int crow(int r, int hi) { return (r & 3) + 8 * (r >> 2) + 4 * hi; }
__device__ __forceinline__ void mask_tile(f32x16& p0, f32x16& p1, int dq) {
    const float NEG = -__builtin_inff();
#pragma unroll
    for (int r = 0; r < 16; ++r) {
        const int c = (r & 3) + 8 * (r >> 2);
        if (dq - c < 0) p0[r] = NEG;
        if (dq - c - 32 < 0) p1[r] = NEG;
    }
}
__device__ __forceinline__ void partialSM(f32x16& p0, f32x16& p1, float& m_reg, float& mn, float& alpha) {
    float pmax = p0[0];
#pragma unroll
    for (int r = 1; r < 16; ++r) pmax = fmaxf(pmax, p0[r]);
#pragma unroll
    for (int r = 0; r < 16; ++r) pmax = fmaxf(pmax, p1[r]);
    { auto rr = __builtin_amdgcn_permlane32_swap(__float_as_uint(pmax), __float_as_uint(pmax), false, false);
      pmax = fmaxf(__uint_as_float(rr[0]), __uint_as_float(rr[1])); }
    constexpr float C2 = 1.4426950408889634f * SCALE;
    if (__builtin_expect(__all((pmax - m_reg) * SCALE <= THR), 1)) { mn = m_reg; alpha = 1.f; }
    else { mn = fmaxf(m_reg, pmax); alpha = __builtin_amdgcn_exp2f((m_reg - mn) * C2); m_reg = mn; }
    const float mnL = -mn * C2;
#pragma unroll
    for (int r = 0; r < 16; ++r) p0[r] = fmaf(p0[r], C2, mnL);
#pragma unroll
    for (int r = 0; r < 16; ++r) p1[r] = fmaf(p1[r], C2, mnL);
#pragma unroll
    for (int r = 0; r < 16; ++r) p0[r] = __builtin_amdgcn_exp2f(p0[r]);
}
__device__ __forceinline__ void finishSM(f32x16& p0, f32x16& p1, float alpha, float& l_reg, bf16x8& pa0, bf16x8& pa1, bf16x8& pa2, bf16x8& pa3) {
#pragma unroll
    for (int r = 0; r < 16; ++r) p1[r] = __builtin_amdgcn_exp2f(p1[r]);
    float ps = 0;
#pragma unroll
    for (int r = 0; r < 16; ++r) ps += p0[r];
#pragma unroll
    for (int r = 0; r < 16; ++r) ps += p1[r];
    { auto rr = __builtin_amdgcn_permlane32_swap(__float_as_uint(ps), __float_as_uint(ps), false, false);
      ps = __uint_as_float(rr[0]) + __uint_as_float(rr[1]); }
    l_reg = l_reg * alpha + ps;
#define PK4(P, B_, OUT) do { unsigned a0 = cvtpk(P[B_+0], P[B_+1]), a1 = cvtpk(P[B_+2], P[B_+3]);                          \
        unsigned b0 = cvtpk(P[B_+4], P[B_+5]), b1 = cvtpk(P[B_+6], P[B_+7]);                                             \
        auto r0 = __builtin_amdgcn_permlane32_swap(a0, b0, false, false); auto r1 = __builtin_amdgcn_permlane32_swap(a1, b1, false, false); \
        v4u w = {r0[0], r1[0], r0[1], r1[1]}; OUT = *reinterpret_cast<bf16x8*>(&w); } while (0)
    PK4(p0, 0, pa0); PK4(p0, 8, pa1); PK4(p1, 0, pa2); PK4(p1, 8, pa3);
#undef PK4
}
__device__ __forceinline__ void qkt(f32x16& p0, f32x16& p1, const char* Kb, int r32, int hi, const bf16x8* qr) {
    p0 = f32x16{}; p1 = f32x16{};
    const char* kb[4];
#pragma unroll
    for (int dd = 0; dd < 4; ++dd) kb[dd] = Kb + KSWZ(r32, (dd * 16 + hi * 8) * 2);
#pragma unroll
    for (int d0 = 0; d0 < 12; ++d0) { const char* a = kb[d0 & 3] + (d0 >> 2) * 128;
        bf16x8 b0 = *reinterpret_cast<const bf16x8*>(a);
        bf16x8 b1 = *reinterpret_cast<const bf16x8*>(a + 32 * 384);
        p0 = __builtin_amdgcn_mfma_f32_32x32x16_bf16(b0, qr[d0], p0, 0, 0, 0);
        p1 = __builtin_amdgcn_mfma_f32_32x32x16_bf16(b1, qr[d0], p1, 0, 0, 0); }
}
__device__ __forceinline__ void pv_tile(f32x16* o, int vb0, bf16x8 pa0, bf16x8 pa1, bf16x8 pa2, bf16x8 pa3) {
#define TRRD(dst, off) asm volatile("ds_read_b64_tr_b16 %0, %1 offset:%2" : "=&v"(dst) : "v"(vb0), "i"(off) : "memory")
#define PV_D0(d0) do { s16x4 l0, l1, l2, l3, h0, h1, h2, h3; constexpr int b_ = (d0) * 512; \
        TRRD(l0, b_); TRRD(h0, b_ + 2048); TRRD(l1, b_ + 4096); TRRD(h1, b_ + 6144); TRRD(l2, b_ + 8192); TRRD(h2, b_ + 10240); TRRD(l3, b_ + 12288); TRRD(h3, b_ + 14336); \
        asm volatile("s_waitcnt lgkmcnt(0)" ::: "memory"); SBAR(); \
        o[d0] = __builtin_amdgcn_mfma_f32_32x32x16_bf16(pa0, (bf16x8){l0[0], l0[1], l0[2], l0[3], h0[0], h0[1], h0[2], h0[3]}, o[d0], 0, 0, 0);   \
        o[d0] = __builtin_amdgcn_mfma_f32_32x32x16_bf16(pa1, (bf16x8){l1[0], l1[1], l1[2], l1[3], h1[0], h1[1], h1[2], h1[3]}, o[d0], 0, 0, 0);   \
        o[d0] = __builtin_amdgcn_mfma_f32_32x32x16_bf16(pa2, (bf16x8){l2[0], l2[1], l2[2], l2[3], h2[0], h2[1], h2[2], h2[3]}, o[d0], 0, 0, 0);   \
        o[d0] = __builtin_amdgcn_mfma_f32_32x32x16_bf16(pa3, (bf16x8){l3[0], l3[1], l3[2], l3[3], h3[0], h3[1], h3[2], h3[3]}, o[d0], 0, 0, 0); } while (0)
    PV_D0(0); PV_D0(1); PV_D0(2); PV_D0(3);
#undef PV_D0
#undef TRRD
}
__device__ __forceinline__ void attn_unit(int b, int h, int qb, const bf16* Q, const bf16* K, const bf16* V, bf16* O, char* lds) {
    const int tid = threadIdx.x, wid = __builtin_amdgcn_readfirstlane(tid >> 6), lane = tid & 63, r32 = lane & 31, hi = lane >> 5;
    const size_t rowb = (size_t)b * SEQ;
    const int q0 = qb * QB, qlo = q0 + wid * QBLK;
    const int NT = (q0 + QB) / KVBLK;
    char* V_lds = lds + OFF_V; char* K_lds = lds + OFF_K;
    float* ws = (float*)(lds + OFF_WS) + wid * 64; float* li_l = ws; float* al_l = ws + 32;
    int koff[3], kws[3];
#pragma unroll
    for (int i = 0; i < 3; ++i) { const int c = tid + 512 * i, kr_ = c / 24, kc_ = c % 24; koff[i] = kr_ * 3072 + kc_ * 8; kws[i] = KSWZ(kr_, kc_ * 16); }
    const int sr = tid >> 4, sc = (tid & 15) * 8, vst0 = v_st(sr, sc), vst1 = v_st(32 + sr, sc);
    const bf16* Kh = K + rowb * 3072 + h * DQK; const bf16* Vh = V + rowb * 2048 + h * DV + (size_t)sr * 2048 + sc;
    bf16x8 sk[3];
#define KLOAD(k0) do { _Pragma("unroll") for (int i = 0; i < 3; ++i) sk[i] = *(const bf16x8*)(Kh + (size_t)(k0) * 3072 + koff[i]); } while (0)
#define KWRITE(bf) do { _Pragma("unroll") for (int i = 0; i < 3; ++i) *(bf16x8*)(K_lds + (bf) * SHM_K + kws[i]) = sk[i]; } while (0)
#define VLOAD(k0) do { sk[0] = *(const bf16x8*)(Vh + (size_t)(k0) * 2048); sk[1] = *(const bf16x8*)(Vh + (size_t)((k0) + 32) * 2048); } while (0)
#define VWRITE(bf) do { *(bf16x8*)(V_lds + (bf) * SHM_V + vst0) = sk[0]; *(bf16x8*)(V_lds + (bf) * SHM_V + vst1) = sk[1]; } while (0)
    KLOAD(0);
    bf16x8 qr[12];
    { const bf16* Qp = Q + (rowb + qlo + r32) * 3072 + h * DQK + hi * 8;
#pragma unroll
      for (int d0 = 0; d0 < 12; ++d0) qr[d0] = *(const bf16x8*)(Qp + d0 * 16); }
    asm volatile("s_waitcnt vmcnt(0)" ::: "memory");
    KWRITE(0); SBAR(); VLOAD(0);
    asm volatile("s_waitcnt vmcnt(0)" ::: "memory");
    VWRITE(0);
    __syncthreads();
    float m_reg = -1e30f, l_reg = 0.f; f32x16 o[4] = {};
    const int vbase = (int)(uintptr_t)V_lds + v_rd_base(lane);
    const int qm = qlo + r32 - 4 * hi;
    for (int t = 0; t < NT; ++t) {
        const int cur = t & 1, kb_ = t * KVBLK;
        if (t + 1 < NT) KLOAD((t + 1) * KVBLK);
        SBAR();
        f32x16 p0, p1; float mn, alpha; bf16x8 pa0, pa1, pa2, pa3;
        qkt(p0, p1, K_lds + cur * SHM_K, r32, hi, qr);
        if (kb_ + KVBLK - 1 > qlo) mask_tile(p0, p1, qm - kb_);
        partialSM(p0, p1, m_reg, mn, alpha);
        finishSM(p0, p1, alpha, l_reg, pa0, pa1, pa2, pa3);
        if (__any(alpha < 1.f)) { if (hi == 0) al_l[r32] = alpha; asm volatile("s_waitcnt lgkmcnt(0)" ::: "memory");
#pragma unroll
            for (int d_ = 0; d_ < 4; ++d_)
#pragma unroll
                for (int r = 0; r < 16; ++r) o[d_][r] *= al_l[crow(r, hi)]; }
        SBAR();
        if (t + 1 < NT) { asm volatile("s_waitcnt vmcnt(0)" ::: "memory"); KWRITE(cur ^ 1); SBAR(); VLOAD((t + 1) * KVBLK); }
        SBAR();
        pv_tile(o, vbase + cur * SHM_V, pa0, pa1, pa2, pa3);
        if (t + 1 < NT) { asm volatile("s_waitcnt vmcnt(0)" ::: "memory"); VWRITE(cur ^ 1); }
        __syncthreads();
    }
    if (hi == 0) li_l[r32] = l_reg; asm volatile("s_waitcnt lgkmcnt(0)" ::: "memory");
    float rli[16];
#pragma unroll
    for (int r = 0; r < 16; ++r) rli[r] = __builtin_amdgcn_rcpf(li_l[crow(r, hi)]);
    bf16* Ow = O + (rowb + qlo) * 2048 + h * DV;
#pragma unroll
    for (int r = 0; r < 16; ++r) { const int orow = crow(r, hi);
#pragma unroll
        for (int d0 = 0; d0 < 4; ++d0) { const float v = o[d0][r] * rli[r];
            const float vn = __shfl_xor(v, 1);
            if ((r32 & 1) == 0) *(unsigned*)(Ow + (size_t)orow * 2048 + d0 * 32 + r32) = cvtpk(v, vn); } }
    __syncthreads();
#undef KLOAD
#undef KWRITE
#undef VLOAD
#undef VWRITE
}
#undef SBAR
}

struct Args { const float* in[20]; float* out; unsigned char* ws; int ph_lo, ph_hi, coop, pad; };
__device__ __forceinline__ void grid_bar(unsigned* ctr, unsigned target) {
    asm volatile("s_waitcnt vmcnt(0)" ::: "memory");
    __syncthreads();
    if (threadIdx.x == 0) {
        __builtin_amdgcn_fence(__ATOMIC_RELEASE, "agent");
        asm volatile("s_waitcnt vmcnt(0)" ::: "memory");
        __hip_atomic_fetch_add(ctr, 1u, __ATOMIC_RELAXED, __HIP_MEMORY_SCOPE_AGENT);
        while (__hip_atomic_load(ctr, __ATOMIC_RELAXED, __HIP_MEMORY_SCOPE_AGENT) < target) __builtin_amdgcn_s_sleep(2);
        __builtin_amdgcn_fence(__ATOMIC_ACQUIRE, "agent");
        asm volatile("s_waitcnt vmcnt(0)" ::: "memory");
    }
    __syncthreads();
}
constexpr int NPH = 11;

__global__ void __launch_bounds__(NWAVES * 64, 2) mega_fwd(Args args) {
    extern __shared__ __attribute__((aligned(16))) unsigned char lds[];
    LAS unsigned char* ldsl = (LAS unsigned char*)lds;
    const int tid = threadIdx.x, lane = tid & 63, wave = __builtin_amdgcn_readfirstlane(tid >> 6);
    const int G = gridDim.x, bx = blockIdx.x;
    const int vcu = (G % 8 == 0) ? (bx % 8) * (G / 8) + bx / 8 : bx;
    const int gw = vcu * NWAVES + wave, NGW = G * NWAVES;
    unsigned char* ws = args.ws;
    const float* const* kin = (const float* const*)__builtin_amdgcn_kernarg_segment_ptr();
    const float* svec = (const float*)ws;
    const float* b_gate = svec + SV_BGATE; const float* q_a_norm_g = svec + SV_QAG; const float* kv_a_norm_g = svec + SV_KVAG; const float* q_norm_g = svec + SV_QNG;
    const float* k_norm_g = svec + SV_KNG; const float* pool_scale = svec + SV_PSC; const float* ffn_norm_g = svec + SV_FNG; const int* positions = (const int*)(svec + SV_POS);
    bf16* WIN_T = (bf16*)(ws + WS_WIN); bf16* WQB_T = (bf16*)(ws + WS_WQB); bf16* WKVB_T = (bf16*)(ws + WS_WKVB); bf16* WPG_T = (bf16*)(ws + WS_WPG);
    bf16* WPO_T = (bf16*)(ws + WS_WPO); bf16* WAO_T = (bf16*)(ws + WS_WAO); bf16* WOUT_T = (bf16*)(ws + WS_WOUT); bf16* WGU_T = (bf16*)(ws + WS_WGU); bf16* WDN_T = (bf16*)(ws + WS_WDN);
    bf16* XN = (bf16*)(ws + WS_XN); float* C1 = (float*)(ws + WS_C1); float* KR = (float*)(ws + WS_KR); bf16* U = (bf16*)(ws + WS_U); bf16* Gt = (bf16*)(ws + WS_G);
    bf16* CN = (bf16*)(ws + WS_CN); bf16* POOLED = (bf16*)(ws + WS_POOLED); bf16* Qb = (bf16*)(ws + WS_Q); bf16* Kb = (bf16*)(ws + WS_K); bf16* Vb = (bf16*)(ws + WS_V);
    bf16* PG = (bf16*)(ws + WS_PG); bf16* MP = (bf16*)(ws + WS_MP); bf16* Ob = (bf16*)(ws + WS_O); bf16* MIXED = (bf16*)(ws + WS_MIXED);
    float* X1 = (float*)(ws + WS_X1); bf16* H2 = (bf16*)(ws + WS_H2); bf16* ACT = (bf16*)(ws + WS_ACT);

    const int lo = args.ph_lo, hi_ph = args.ph_hi;
#ifndef PHMASK
#define PHMASK 0x7ff
#endif
#define IN(k) (((PHMASK >> (k)) & 1) && lo <= (k) && (k) < hi_ph)
#define SEAM(k) do { if (IN(k) && IN((k) + 1)) { unsigned char* w2_ = args.ws; asm volatile("" : "+s"(w2_)); grid_bar((unsigned*)(w2_ + WS_BAR), (unsigned)G * ++bar_n); } } while (0)
    unsigned bar_n = 0;
    if (args.coop) cg::this_grid().sync();
    LAS float* scr = (LAS float*)(ldsl + wave * 16384);

    if (IN(0)) {
        { float* sv = (float*)ws; const int gt = bx * (NWAVES * 64) + tid, GT = G * NWAVES * 64;
          for (int i = gt; i < SV_END; i += GT) { int idx, off, lim = 1 << 30;
              if (i < SV_QAG) { idx = 4; off = SV_BGATE; } else if (i < SV_KVAG) { idx = 5; off = SV_QAG; } else if (i < SV_QNG) { idx = 7; off = SV_KVAG; }
              else if (i < SV_KNG) { idx = 9; off = SV_QNG; lim = 192; } else if (i < SV_PSC) { idx = 10; off = SV_KNG; lim = 192; }
              else if (i < SV_FNG) { idx = 13; off = SV_PSC; } else if (i < SV_POS) { idx = 16; off = SV_FNG; } else { idx = 1; off = SV_POS; }
              const float* src = kin[idx]; sv[i] = (i - off < lim) ? src[i - off] : 0.f; } }
        constexpr int I_IN = (DM / 64) * (DIN / 32), I_QB = (QLORA / 64) * (NH * DQK / 32), I_KVB = (KVLORA / 64) * (NH * 256 / 32), I_PG = (256 / 64) * (256 / 32),
                      I_PO = (POOLW / 64) * (DM / 32), I_AO = (DM / 64) * (DM / 32), I_OUT = I_AO;
        constexpr int NITEMS = I_IN + I_QB + I_KVB + 4 * I_PG + I_PO + I_AO + I_OUT;
        for (int it = gw; it < NITEMS; it += NGW) {
            int r = it, idx, Kd, Nd, mode = 0, roff = 0; size_t dsto, srco = 0;
            if (r < I_IN) { idx = 3; Kd = DM; Nd = DIN; mode = 1; dsto = WS_WIN; }
            else if ((r -= I_IN) < I_QB) { idx = 6; Kd = QLORA; Nd = NH * DQK; dsto = WS_WQB; }
            else if ((r -= I_QB) < I_KVB) { idx = 8; Kd = KVLORA; Nd = NH * 256; dsto = WS_WKVB; }
            else if ((r -= I_KVB) < 4 * I_PG) { const int g = r / I_PG; r = r % I_PG; idx = 12; Kd = 256; Nd = 256; dsto = WS_WPG; roff = g * 256; srco = (size_t)g * 65536; }
            else if ((r -= 4 * I_PG) < I_PO) { idx = 14; Kd = POOLW; Nd = DM; dsto = WS_WPO; }
            else if ((r -= I_PO) < I_AO) { idx = 11; Kd = DM; Nd = DM; dsto = WS_WAO; }
            else { r -= I_AO; idx = 15; Kd = DM; Nd = DM; dsto = WS_WOUT; }
            transpose_item(kin[idx] + srco, Kd, Nd, (bf16*)(ws + dsto), mode, roff, scr, r, lane);
        }
        { v4u* z = (v4u*)(WIN_T + (size_t)DIN * DM); const int nz = (DIN_PAD - DIN) * DM / 8;
          for (int i = gw * 64 + lane; i < nz; i += NGW * 64) z[i] = (v4u){0u, 0u, 0u, 0u}; }
        { const float* x = kin[0]; const float* attn_norm_g = kin[2];
          for (int m = gw; m < M; m += NGW) rms_row_2048(x + (size_t)m * DM, attn_norm_g, XN + (size_t)m * DM, lane); }
    }
    SEAM(0);
    if (IN(1)) {
        pg8::Gemm g{XN, WIN_T, M, DIN_PAD, DM, DM, DM, 0}; pg8::StaticOrder S; S.init(M, DIN_PAD, G, bx);
        pg8::EpiIn E{C1, U, Gt, KR, b_gate};
        pg8::gemm_phase<pg8::EpiIn, pg8::StaticOrder, false>(ldsl, g, S, E);
    }
    SEAM(1);
    if (IN(2)) {
        for (int m = gw; m < M; m += NGW) {
            const f32x4* c = (const f32x4*)(C1 + (size_t)m * 1024) + lane; f32x4 v[4]; float sq = 0.f, skv = 0.f;
#pragma unroll
            for (int j = 0; j < 4; ++j) { v[j] = c[64 * j]; const float s = (v[j].x * v[j].x + v[j].y * v[j].y) + (v[j].z * v[j].z + v[j].w * v[j].w); if (j < 2) sq += s; else skv += s; }
            const float iq = 1.0f / sqrtf(wave_sum(sq) * (1.f / 512.f) + EPS), ikv = 1.0f / sqrtf(wave_sum(skv) * (1.f / 512.f) + EPS);
            v2u* o8 = (v2u*)(CN + (size_t)m * 1024) + lane;
#pragma unroll
            for (int j = 0; j < 4; ++j) { const f32x4 gv = (j < 2) ? ((const f32x4*)q_a_norm_g)[lane + 64 * j] : ((const f32x4*)kv_a_norm_g)[lane + 64 * (j - 2)]; const float iv = (j < 2) ? iq : ikv;
                v2u o; o.x = cvtpk(v[j].x * iv * gv.x, v[j].y * iv * gv.y); o.y = cvtpk(v[j].z * iv * gv.z, v[j].w * iv * gv.w); o8[64 * j] = o; }
        }
        for (int m = gw; m < M; m += NGW) {
            const int s = m & (SEQ - 1);
#pragma unroll
            for (int jj = 0; jj < 2; ++jj) {
                const int col = 8 * lane + 512 * jj, grp = col >> 8, w = 2 << grp; const int cnt = (s + 1 < w) ? s + 1 : w;
                float a[8]; float u0[8];
#pragma unroll
                for (int e = 0; e < 8; ++e) a[e] = 0.f;
                for (int d = 0; d < 16; ++d) {
                    if (d < cnt) { const v4u q = *(const v4u*)(U + (size_t)(m - d) * 1024 + col);
                        const float f[8] = {bflo(q.x), bfhi(q.x), bflo(q.y), bfhi(q.y), bflo(q.z), bfhi(q.z), bflo(q.w), bfhi(q.w)};
#pragma unroll
                        for (int e = 0; e < 8; ++e) { a[e] += f[e]; if (d == 0) u0[e] = f[e]; } }
                }
                const float rc = 1.0f / (float)cnt;
                v4u o; o.x = cvtpk(a[0] * rc - u0[0], a[1] * rc - u0[1]); o.y = cvtpk(a[2] * rc - u0[2], a[3] * rc - u0[3]);
                o.z = cvtpk(a[4] * rc - u0[4], a[5] * rc - u0[5]); o.w = cvtpk(a[6] * rc - u0[6], a[7] * rc - u0[7]);
                *(v4u*)(POOLED + (size_t)m * 1024 + col) = o;
            }
        }
    }
    SEAM(2);
    if (IN(3)) {
        { pg8::Gemm g{CN, WQB_T, M, NH * DQK, QLORA, 1024, QLORA, 0}; pg8::StaticOrder S; S.init(M, NH * DQK, G, bx);
          pg8::EpiBf16 E{Qb, 3072}; pg8::gemm_phase<pg8::EpiBf16, pg8::StaticOrder>(ldsl, g, S, E); }
        { pg8::Gemm g{CN + 512, WKVB_T, M, NH * 256, KVLORA, 1024, KVLORA, 0}; pg8::StaticOrder S; S.init(M, NH * 256, G, bx);
          pg8::EpiKV E{Kb, Vb}; pg8::gemm_phase<pg8::EpiKV, pg8::StaticOrder>(ldsl, g, S, E); }
        { pg8::Gemm g{POOLED, WPG_T, M, POOLW, 256, 1024, 256, 256}; pg8::StaticOrder S; S.init(M, POOLW, G, (bx + 128) % G);
          pg8::EpiScale E{PG, 1024, pool_scale}; pg8::gemm_phase<pg8::EpiScale, pg8::StaticOrder, false>(ldsl, g, S, E); }
    }
    SEAM(3);
    if (IN(4)) {
        for (int m = gw; m < M; m += NGW) {
            const float pos = (float)positions[m];
            const int sub = lane & 3, h = lane >> 2;
            float cs[8], sn[8];
#pragma unroll
            for (int j = 0; j < 8; ++j) { const int i = 8 * sub + j; const float invf = __builtin_amdgcn_exp2f(-(float)i * (13.287712379549449f / 32.f));
                const float ang = pos * invf; const float k = rintf(ang * 0.15915494309189535f);
                float r = fmaf(-k, 6.2831854820251465f, ang); r = fmaf(-k, -1.7484555e-7f, r);
                sn[j] = __sinf(r); cs[j] = __cosf(r); }
#pragma unroll
            for (int which = 0; which < 2; ++which) {
                bf16* base = (which == 0 ? Qb : Kb) + (size_t)m * 3072 + h * DQK;
                const float* gn = (which == 0) ? q_norm_g : k_norm_g;
                float nv[32], rl[8], rh[8]; float ss = 0.f;
#pragma unroll
                for (int jj = 0; jj < 4; ++jj) { const v4u q = *(const v4u*)(base + 32 * sub + 8 * jj);
                    nv[8 * jj + 0] = bflo(q.x); nv[8 * jj + 1] = bfhi(q.x); nv[8 * jj + 2] = bflo(q.y); nv[8 * jj + 3] = bfhi(q.y);
                    nv[8 * jj + 4] = bflo(q.z); nv[8 * jj + 5] = bfhi(q.z); nv[8 * jj + 6] = bflo(q.w); nv[8 * jj + 7] = bfhi(q.w); }
                if (which == 0) {
                    const v4u a = *(const v4u*)(base + 128 + 8 * sub), b = *(const v4u*)(base + 160 + 8 * sub);
                    rl[0] = bflo(a.x); rl[1] = bfhi(a.x); rl[2] = bflo(a.y); rl[3] = bfhi(a.y); rl[4] = bflo(a.z); rl[5] = bfhi(a.z); rl[6] = bflo(a.w); rl[7] = bfhi(a.w);
                    rh[0] = bflo(b.x); rh[1] = bfhi(b.x); rh[2] = bflo(b.y); rh[3] = bfhi(b.y); rh[4] = bflo(b.z); rh[5] = bfhi(b.z); rh[6] = bflo(b.w); rh[7] = bfhi(b.w);
                } else {
                    const f32x4 a0 = *(const f32x4*)(KR + (size_t)m * 64 + 8 * sub), a1 = *(const f32x4*)(KR + (size_t)m * 64 + 8 * sub + 4);
                    const f32x4 b0 = *(const f32x4*)(KR + (size_t)m * 64 + 32 + 8 * sub), b1 = *(const f32x4*)(KR + (size_t)m * 64 + 32 + 8 * sub + 4);
                    rl[0] = a0.x; rl[1] = a0.y; rl[2] = a0.z; rl[3] = a0.w; rl[4] = a1.x; rl[5] = a1.y; rl[6] = a1.z; rl[7] = a1.w;
                    rh[0] = b0.x; rh[1] = b0.y; rh[2] = b0.z; rh[3] = b0.w; rh[4] = b1.x; rh[5] = b1.y; rh[6] = b1.z; rh[7] = b1.w;
                }
#pragma unroll
                for (int e = 0; e < 32; ++e) ss += nv[e] * nv[e];
#pragma unroll
                for (int e = 0; e < 8; ++e) ss += rl[e] * rl[e] + rh[e] * rh[e];
                ss += __shfl_xor(ss, 1); ss += __shfl_xor(ss, 2);
                const float inv = 1.0f / sqrtf(ss * (1.f / 192.f) + EPS);
#pragma unroll
                for (int jj = 0; jj < 4; ++jj) { const f32x4 g0 = *(const f32x4*)(gn + 32 * sub + 8 * jj), g1 = *(const f32x4*)(gn + 32 * sub + 8 * jj + 4);
                    v4u o; o.x = cvtpk(nv[8 * jj + 0] * inv * g0.x, nv[8 * jj + 1] * inv * g0.y); o.y = cvtpk(nv[8 * jj + 2] * inv * g0.z, nv[8 * jj + 3] * inv * g0.w);
                    o.z = cvtpk(nv[8 * jj + 4] * inv * g1.x, nv[8 * jj + 5] * inv * g1.y); o.w = cvtpk(nv[8 * jj + 6] * inv * g1.z, nv[8 * jj + 7] * inv * g1.w);
                    *(v4u*)(base + 32 * sub + 8 * jj) = o; }
                float ol[8], oh[8];
#pragma unroll
                for (int e = 0; e < 8; ++e) { const float a = rl[e] * inv * gn[128 + 8 * sub + e], b = rh[e] * inv * gn[160 + 8 * sub + e];
                    ol[e] = a * cs[e] - b * sn[e]; oh[e] = b * cs[e] + a * sn[e]; }
                v4u o1, o2; o1.x = cvtpk(ol[0], ol[1]); o1.y = cvtpk(ol[2], ol[3]); o1.z = cvtpk(ol[4], ol[5]); o1.w = cvtpk(ol[6], ol[7]);
                o2.x = cvtpk(oh[0], oh[1]); o2.y = cvtpk(oh[2], oh[3]); o2.z = cvtpk(oh[4], oh[5]); o2.w = cvtpk(oh[6], oh[7]);
                *(v4u*)(base + 128 + 8 * sub) = o1; *(v4u*)(base + 160 + 8 * sub) = o2;
            }
        }
        { pg8::Gemm g{PG, WPO_T, M, DM, POOLW, POOLW, POOLW, 0}; pg8::StaticOrder S; S.init(M, DM, G, bx);
          pg8::EpiGate<false> E{MP, Gt, nullptr, 0}; pg8::gemm_phase<pg8::EpiGate<false>, pg8::StaticOrder, false>(ldsl, g, S, E); }
    }
    SEAM(4);
    if (IN(5)) {
        const int npair = BATCH * NH * 8;
        for (int p = vcu; p < npair; p += G) {
            const int bh = p >> 3, s = p & 7;
            att::attn_unit(bh / NH, bh % NH, 15 - s, Qb, Kb, Vb, Ob, (char*)lds);
            att::attn_unit(bh / NH, bh % NH, s, Qb, Kb, Vb, Ob, (char*)lds);
        }
    }
    SEAM(5);
    if (IN(6)) {
        pg8::Gemm g{Ob, WAO_T, M, DM, DM, DM, DM, 0}; pg8::StaticOrder S; S.init(M, DM, G, bx);
        pg8::EpiGate<true> E{MIXED, Gt, MP, 2048}; pg8::gemm_phase<pg8::EpiGate<true>, pg8::StaticOrder, false>(ldsl, g, S, E);
    }
    SEAM(6);
    if (IN(7)) {
        pg8::Gemm g{MIXED, WOUT_T, M, DM, DM, DM, DM, 0}; pg8::StaticOrder S; S.init(M, DM, G, bx);
        pg8::EpiRes E{kin[0], X1, DM}; pg8::gemm_phase<pg8::EpiRes, pg8::StaticOrder, false>(ldsl, g, S, E);
    }
    SEAM(7);
    if (IN(8)) {
        for (int m = gw; m < M; m += NGW) rms_row_2048(X1 + (size_t)m * DM, ffn_norm_g, H2 + (size_t)m * DM, lane);
        constexpr int I_G = (DM / 64) * (DFF / 32), I_D = (DFF / 64) * (DM / 32);
        for (int it = gw; it < 2 * I_G + I_D; it += NGW) {
            int r = it, idx, Kd = DM, Nd = DFF, mode; size_t dsto = WS_WGU;
            if (r < I_G) { idx = 17; mode = 2; } else if ((r -= I_G) < I_G) { idx = 18; mode = 3; } else { r -= I_G; idx = 19; mode = 0; Kd = DFF; Nd = DM; dsto = WS_WDN; }
            transpose_item(kin[idx], Kd, Nd, (bf16*)(ws + dsto), mode, 0, scr, r, lane);
        }
    }
    SEAM(8);
    if (IN(9)) {
        pg8::Gemm g{H2, WGU_T, M, 2 * DFF, DM, DM, DM, 0}; pg8::StaticOrder S; S.init(M, 2 * DFF, G, bx);
        pg8::EpiSwiGLU E{ACT, DFF}; pg8::gemm_phase<pg8::EpiSwiGLU, pg8::StaticOrder>(ldsl, g, S, E);
    }
    SEAM(9);
    if (IN(10)) {
        pg8::Gemm g{ACT, WDN_T, M, DM, DFF, DFF, DFF, 0}; pg8::StaticOrder S; S.init(M, DM, G, bx);
        pg8::EpiRes E{X1, args.out, DM}; pg8::gemm_phase<pg8::EpiRes, pg8::StaticOrder, false>(ldsl, g, S, E);
    }
#undef IN
#undef SEAM
}

extern "C" void kernel_launch(void* const* d_in, const int* in_sizes, int n_in, void* d_out, int out_size, void* d_ws, size_t ws_size, hipStream_t stream) {
    static int grid = 0;
    if (grid == 0) {
        if (n_in != 20 || out_size != M * DM || ws_size < WS_END) { fprintf(stderr, "kernel_launch: unexpected shapes (n_in %d, out %d, ws %zu)\n", n_in, out_size, ws_size); grid = -1; return; }
        int dev = 0, cus = 0, per_cu = 0;
        (void)hipGetDevice(&dev); (void)hipDeviceGetAttribute(&cus, hipDeviceAttributeMultiprocessorCount, dev);
        if (hipFuncSetAttribute((const void*)mega_fwd, hipFuncAttributeMaxDynamicSharedMemorySize, LDS_BYTES) != hipSuccess) { fprintf(stderr, "kernel_launch: hipFuncSetAttribute failed\n"); grid = -1; return; }
        if (hipOccupancyMaxActiveBlocksPerMultiprocessor(&per_cu, (const void*)mega_fwd, NWAVES * 64, LDS_BYTES) != hipSuccess || per_cu < 1) { fprintf(stderr, "kernel_launch: occupancy query says %d\n", per_cu); per_cu = 1; }
        (void)hipGetLastError();
        grid = cus > 0 ? cus : 256;
    }
    if (grid < 0) return;
    Args a{};
    for (int i = 0; i < 20; ++i) a.in[i] = (const float*)d_in[i];
    a.out = (float*)d_out; a.ws = (unsigned char*)d_ws;
    if (MK_N_LAUNCHES == 1) {
        a.ph_lo = 0; a.ph_hi = NPH; a.coop = 1;
        (void)hipMemsetAsync((char*)d_ws + WS_BAR, 0, 256, stream);
        void* kargs[] = {&a};
        hipError_t e = hipLaunchCooperativeKernel((const void*)mega_fwd, dim3(grid), dim3(NWAVES * 64), kargs, LDS_BYTES, stream);
        if (e != hipSuccess) fprintf(stderr, "kernel_launch: cooperative launch failed: %s (grid %d)\n", hipGetErrorString(e), grid);
    } else {
        for (int p = 0; p < NPH; ++p) {
            a.ph_lo = p; a.ph_hi = p + 1;
            hipLaunchKernelGGL(mega_fwd, dim3(grid), dim3(NWAVES * 64), LDS_BYTES, stream, a);
        }
    }
}
```

```cpp
#include <hip/hip_runtime.h>
#include <hip/hip_cooperative_groups.h>
#include <cstdio>
#include <cstdint>
namespace cg = cooperative_groups;

#ifndef MK_N_LAUNCHES
#define MK_N_LAUNCHES 1
#endif

namespace pg8 {
#define PG8_LAS __attribute__((address_space(3)))
typedef unsigned short bf16_t;
typedef short bf16x8 __attribute__((ext_vector_type(8)));
typedef float f32x4 __attribute__((ext_vector_type(4)));
typedef unsigned u32x4 __attribute__((ext_vector_type(4)));
constexpr int BM = 256, BK = 64, HALF = 128, HTB = HALF * BK * 2, STAGE_BYTES = 8 * HTB, NXCD = 8, WGM = 8;

__host__ __device__ __forceinline__ int lds_byte(int r, int c) { const int st = (r >> 4) * 2 + (c >> 5), rr = r & 15, cc = c & 31, ob = rr * 64 + cc * 2; return st * 1024 + (ob ^ (((ob >> 9) & 1) << 5)); }
__host__ __device__ __forceinline__ void stage_rc(int b, int& R, int& C) { const int st = b / 1024, sb = b % 1024, swz = sb ^ (((sb >> 9) & 1) << 5); R = (st >> 1) * 16 + swz / 64; C = (st & 1) * 32 + (swz % 64) / 2; }
__host__ __device__ __forceinline__ int perm32(int rho) { const int n = rho >> 4, i = rho & 15; return 8 * (i >> 2) + 4 * n + (i & 3); }

struct Unit { int pm, pn; };
struct Gemm { const bf16_t* A; const bf16_t* Bt; int M, N, K, lda, ldb, a_pn_step; };

struct StaticOrder {
    int nM, nN, nwg, G, c;
    __host__ __device__ void init(int M, int N, int G_, int c_) { nM = M / BM; nN = N / BM; nwg = nM * nN; G = G_; c = c_; }
    __host__ __device__ bool next(int i, Unit& u) const {
        const long L = (long)i * G + c; if (L >= nwg) return false;
        int wgid = (int)L; { const int q = nwg / NXCD, r = nwg % NXCD, xcd = wgid % NXCD, off = wgid / NXCD; wgid = (xcd < r ? xcd * (q + 1) : r * (q + 1) + (xcd - r) * q) + off; }
        const int nig = WGM * nN, gid = wgid / nig, fm = gid * WGM, gsz = (nM - fm) < WGM ? (nM - fm) : WGM;
        u.pm = fm + ((wgid % nig) % gsz); u.pn = (wgid % nig) / gsz; return true;
    }
};

typedef float f32x2_t_ __attribute__((ext_vector_type(2))); typedef __bf16 bf16x2_t_ __attribute__((ext_vector_type(2)));
__device__ __forceinline__ unsigned cvt_pk_bf16(float lo, float hi) { f32x2_t_ v = {lo, hi}; bf16x2_t_ b = __builtin_convertvector(v, bf16x2_t_); return __builtin_bit_cast(unsigned, b); }
__device__ __forceinline__ u32x4 pack8(f32x4 a, f32x4 b) { u32x4 w; w.x = cvt_pk_bf16(a[0], a[1]); w.y = cvt_pk_bf16(a[2], a[3]); w.z = cvt_pk_bf16(b[0], b[1]); w.w = cvt_pk_bf16(b[2], b[3]); return w; }
__device__ __forceinline__ void unpack8(u32x4 w, f32x4& a, f32x4& b) {
    a[0] = __uint_as_float(w.x << 16); a[1] = __uint_as_float(w.x & 0xffff0000u); a[2] = __uint_as_float(w.y << 16); a[3] = __uint_as_float(w.y & 0xffff0000u);
    b[0] = __uint_as_float(w.z << 16); b[1] = __uint_as_float(w.z & 0xffff0000u); b[2] = __uint_as_float(w.w << 16); b[3] = __uint_as_float(w.w & 0xffff0000u); }
__device__ __forceinline__ float sigmoidf_(float v) { return __builtin_amdgcn_rcpf(1.0f + __builtin_amdgcn_exp2f(-1.4426950408889634f * v)); }
__device__ __forceinline__ f32x4 sigmoid4(f32x4 v) { f32x4 o; o[0] = sigmoidf_(v[0]); o[1] = sigmoidf_(v[1]); o[2] = sigmoidf_(v[2]); o[3] = sigmoidf_(v[3]); return o; }

typedef f32x4 AccT[2][2][4][2];
#define EPI_LOOP_AM _Pragma("unroll") for (int ai = 0; ai < 2; ++ai) _Pragma("unroll") for (int m = 0; m < 4; ++m)
#define EPI_LOOP_B _Pragma("unroll") for (int bj = 0; bj < 2; ++bj)

struct EpiIn {
    static constexpr bool PERM = true;
    float* C1; bf16_t* U; bf16_t* G; float* KR; const float* bgate;
    __device__ __forceinline__ void operator()(const AccT& acc, const Unit& u, int wr, int wc, int fr, int fq) const {
        const int row0 = u.pm * BM + wr * 64 + fr, pn = u.pn, cw = wc * 32 + 8 * fq;
        if (pn < 4) {
            EPI_LOOP_AM { float* rp = C1 + (size_t)(row0 + ai * HALF + m * 16) * 1024 + pn * 256 + cw;
                EPI_LOOP_B { *(f32x4*)(rp + bj * HALF) = acc[ai][bj][m][0]; *(f32x4*)(rp + bj * HALF + 4) = acc[ai][bj][m][1]; } }
        } else if (pn < 8) {
            EPI_LOOP_AM { bf16_t* rp = U + (size_t)(row0 + ai * HALF + m * 16) * 1024 + (pn - 4) * 256 + cw;
                EPI_LOOP_B { *(u32x4*)(rp + bj * HALF) = pack8(acc[ai][bj][m][0], acc[ai][bj][m][1]); } }
        } else if (pn < 24) {
            const int gc = (pn - 8) * 256 + cw; f32x4 bv[2][2];
            EPI_LOOP_B { bv[bj][0] = *(const f32x4*)(bgate + gc + bj * HALF); bv[bj][1] = *(const f32x4*)(bgate + gc + bj * HALF + 4); }
            EPI_LOOP_AM { bf16_t* rp = G + (size_t)(row0 + ai * HALF + m * 16) * 4096 + gc;
                EPI_LOOP_B { *(u32x4*)(rp + bj * HALF) = pack8(sigmoid4(acc[ai][bj][m][0] + bv[bj][0]), sigmoid4(acc[ai][bj][m][1] + bv[bj][1])); } }
        } else {
            if (wc < 2) { EPI_LOOP_AM { float* rp = KR + (size_t)(row0 + ai * HALF + m * 16) * 64 + cw; *(f32x4*)rp = acc[ai][0][m][0]; *(f32x4*)(rp + 4) = acc[ai][0][m][1]; } }
        }
    }
};
struct EpiBf16 {
    static constexpr bool PERM = true;
    bf16_t* O; int ldc;
    __device__ __forceinline__ void operator()(const AccT& acc, const Unit& u, int wr, int wc, int fr, int fq) const {
        const int row0 = u.pm * BM + wr * 64 + fr, col0 = u.pn * BM + wc * 32 + 8 * fq;
        EPI_LOOP_AM { bf16_t* rp = O + (size_t)(row0 + ai * HALF + m * 16) * ldc + col0;
            EPI_LOOP_B { *(u32x4*)(rp + bj * HALF) = pack8(acc[ai][bj][m][0], acc[ai][bj][m][1]); } }
    }
};
struct EpiKV {
    static constexpr bool PERM = true;
    bf16_t* K; bf16_t* V;
    __device__ __forceinline__ void operator()(const AccT& acc, const Unit& u, int wr, int wc, int fr, int fq) const {
        const int row0 = u.pm * BM + wr * 64 + fr, cw = wc * 32 + 8 * fq, h = u.pn;
        EPI_LOOP_AM { const size_t row = (size_t)(row0 + ai * HALF + m * 16);
            *(u32x4*)(K + row * 3072 + h * 192 + cw) = pack8(acc[ai][0][m][0], acc[ai][0][m][1]);
            *(u32x4*)(V + row * 2048 + h * 128 + cw) = pack8(acc[ai][1][m][0], acc[ai][1][m][1]); }
    }
};
struct EpiScale {
    static constexpr bool PERM = true;
    bf16_t* O; int ldc; const float* scale;
    __device__ __forceinline__ void operator()(const AccT& acc, const Unit& u, int wr, int wc, int fr, int fq) const {
        const int row0 = u.pm * BM + wr * 64 + fr, col0 = u.pn * BM + wc * 32 + 8 * fq; f32x4 sv[2][2];
        EPI_LOOP_B { sv[bj][0] = *(const f32x4*)(scale + col0 + bj * HALF); sv[bj][1] = *(const f32x4*)(scale + col0 + bj * HALF + 4); }
        EPI_LOOP_AM { bf16_t* rp = O + (size_t)(row0 + ai * HALF + m * 16) * ldc + col0;
            EPI_LOOP_B { *(u32x4*)(rp + bj * HALF) = pack8(acc[ai][bj][m][0] * sv[bj][0], acc[ai][bj][m][1] * sv[bj][1]); } }
    }
};
template <bool HAS_ADD> struct EpiGate {
    static constexpr bool PERM = true;
    bf16_t* O; const bf16_t* gate; const bf16_t* add; int gcol0;
    __device__ __forceinline__ void operator()(const AccT& acc, const Unit& u, int wr, int wc, int fr, int fq) const {
        const int row0 = u.pm * BM + wr * 64 + fr, col0 = u.pn * BM + wc * 32 + 8 * fq;
        EPI_LOOP_AM { const size_t row = (size_t)(row0 + ai * HALF + m * 16);
            EPI_LOOP_B { f32x4 g0, g1; unpack8(*(const u32x4*)(gate + row * 4096 + gcol0 + col0 + bj * HALF), g0, g1);
                f32x4 v0 = g0 * acc[ai][bj][m][0], v1 = g1 * acc[ai][bj][m][1];
                if (HAS_ADD) { f32x4 a0, a1; unpack8(*(const u32x4*)(add + row * 2048 + col0 + bj * HALF), a0, a1); v0 += a0; v1 += a1; }
                *(u32x4*)(O + row * 2048 + col0 + bj * HALF) = pack8(v0, v1); } }
    }
};
struct EpiRes {
    static constexpr bool PERM = false;
    const float* base; float* out; int ldc;
    __device__ __forceinline__ void operator()(const AccT& acc, const Unit& u, int wr, int wc, int fr, int fq) const {
        const int row0 = u.pm * BM + wr * 64 + fr, col0 = u.pn * BM + wc * 32 + 4 * fq;
        EPI_LOOP_AM { const size_t off = (size_t)(row0 + ai * HALF + m * 16) * ldc + col0;
            EPI_LOOP_B {
#pragma unroll
                for (int n = 0; n < 2; ++n) { const f32x4 b = *(const f32x4*)(base + off + bj * HALF + n * 16); *(f32x4*)(out + off + bj * HALF + n * 16) = b + acc[ai][bj][m][n]; } } }
    }
};
struct EpiSwiGLU {
    static constexpr bool PERM = true;
    bf16_t* O; int ldc;
    __device__ __forceinline__ void operator()(const AccT& acc, const Unit& u, int wr, int wc, int fr, int fq) const {
        const int row0 = u.pm * BM + wr * 64 + fr, col0 = u.pn * HALF + wc * 32 + 8 * fq;
        EPI_LOOP_AM { bf16_t* rp = O + (size_t)(row0 + ai * HALF + m * 16) * ldc + col0;
            const f32x4 g0 = acc[ai][0][m][0], g1 = acc[ai][0][m][1];
            *(u32x4*)rp = pack8(g0 * sigmoid4(g0) * acc[ai][1][m][0], g1 * sigmoid4(g1) * acc[ai][1][m][1]); }
    }
};

template <class Epi, class Sched, bool ALIGN_EPI = true>
__device__ __forceinline__ void gemm_phase(PG8_LAS unsigned char* lds, const Gemm g, const Sched& S, const Epi& E) {
    const int tid = threadIdx.x, wid = __builtin_amdgcn_readfirstlane(tid >> 6), lane = tid & 63, wr = wid >> 2, wc = wid & 3, fr = lane & 15, fq = lane >> 4;
    const int K = g.K, nt = K / BK;
    unsigned voffA[2], voffB[2];
#pragma unroll
    for (int i = 0; i < 2; ++i) { int R, C; stage_rc(tid * 16 + i * 8192, R, C); const int Rb = Epi::PERM ? ((R & ~31) + perm32(R & 31)) : R;
        voffA[i] = (unsigned)(R * g.lda + C) * 2u; voffB[i] = (unsigned)(Rb * g.ldb + C) * 2u; }
    const size_t kstep = (size_t)(BK * 2);
    const size_t hstepA = (size_t)HALF * g.lda * 2, hstepB = (size_t)HALF * g.ldb * 2;
    const size_t tstepA = 2 * hstepA, tstepB = 2 * hstepB, pstepA = (size_t)g.a_pn_step * 2;
    const unsigned ldsw = (unsigned)wid * 1024u;
    const int aoff = lds_byte(wr * 64 + fr, fq * 8), boff = lds_byte(wc * 32 + fr, fq * 8);
#define PG8_SA(b, h) (((b) * 2 + (h)) * HTB)
#define PG8_SB(b, h) ((4 + (b) * 2 + (h)) * HTB)
#define PG8_STAGE(bufoff, gbase, voff) do { _Pragma("unroll") for (int _i = 0; _i < 2; ++_i) \
        __builtin_amdgcn_global_load_lds((const unsigned*)((const char*)(gbase) + (voff)[_i]), (PG8_LAS unsigned*)(lds + (bufoff) + ldsw + _i * 8192), 16, 0, 0); } while (0)
#define PG8_LDA(dst, b, h) do { _Pragma("unroll") for (int m = 0; m < 4; ++m) _Pragma("unroll") for (int k = 0; k < 2; ++k) dst[m][k] = *(const PG8_LAS bf16x8*)(lds + PG8_SA(b, h) + aoff + m * 2048 + k * 1024); } while (0)
#define PG8_LDB(dst, b, h) do { _Pragma("unroll") for (int n = 0; n < 2; ++n) _Pragma("unroll") for (int k = 0; k < 2; ++k) dst[n][k] = *(const PG8_LAS bf16x8*)(lds + PG8_SB(b, h) + boff + n * 2048 + k * 1024); } while (0)
#define PG8_MMA(ai, bj, At, Bt) do { __builtin_amdgcn_s_setprio(1); _Pragma("unroll") for (int m = 0; m < 4; ++m) _Pragma("unroll") for (int n = 0; n < 2; ++n) _Pragma("unroll") for (int k = 0; k < 2; ++k) \
        acc[ai][bj][m][n] = __builtin_amdgcn_mfma_f32_16x16x32_bf16(Bt[n][k], At[m][k], acc[ai][bj][m][n], 0, 0, 0); __builtin_amdgcn_s_setprio(0); } while (0)
#define PG8_WAIT_V(n) asm volatile("s_waitcnt vmcnt(" #n ")" ::: "memory")
#define PG8_WAIT_L(n) asm volatile("s_waitcnt lgkmcnt(" #n ")" ::: "memory")
#define PG8_BAR __builtin_amdgcn_s_barrier()
#define PG8_SCHED __builtin_amdgcn_sched_barrier(0)
    Unit cur, nxt; int ui = 0;
    if (!S.next(0, cur)) return;
    f32x4 acc[2][2][4][2];
#pragma unroll
    for (int a = 0; a < 2; ++a)
#pragma unroll
        for (int b = 0; b < 2; ++b)
#pragma unroll
            for (int m = 0; m < 4; ++m)
#pragma unroll
                for (int n = 0; n < 2; ++n) acc[a][b][m][n] = (f32x4){0.f, 0.f, 0.f, 0.f};
    bf16x8 At[4][2], B0[2][2], B1[2][2];
    const char* cA = (const char*)g.A + (size_t)cur.pm * tstepA + (size_t)cur.pn * pstepA; const char* cB = (const char*)g.Bt + (size_t)cur.pn * tstepB;
    PG8_STAGE(PG8_SB(0, 0), cB, voffB); PG8_STAGE(PG8_SB(0, 1), cB + hstepB, voffB); PG8_STAGE(PG8_SA(0, 0), cA, voffA); PG8_STAGE(PG8_SA(0, 1), cA + hstepA, voffA);
    if (wr == 1) PG8_BAR;
    PG8_WAIT_V(2); PG8_BAR;
    PG8_STAGE(PG8_SB(1, 0), cB + kstep, voffB); PG8_STAGE(PG8_SA(1, 0), cA + kstep, voffA); PG8_STAGE(PG8_SB(1, 1), cB + hstepB + kstep, voffB);
    PG8_WAIT_V(6); PG8_BAR;
    for (;;) {
        const bool has_next = S.next(ui + 1, nxt);
        const char* nA = has_next ? (const char*)g.A + (size_t)nxt.pm * tstepA + (size_t)nxt.pn * pstepA : cA; const char* nB = has_next ? (const char*)g.Bt + (size_t)nxt.pn * tstepB : cB;
        for (int t = 0; t < nt; t += 2) {
            const bool last = (t == nt - 2);
            const char* a1 = cA + (size_t)(t + 1) * kstep;
            const char* a2 = last ? nA : cA + (size_t)(t + 2) * kstep; const char* b2 = last ? nB : cB + (size_t)(t + 2) * kstep;
            const char* a3 = a2 + kstep; const char* b3 = b2 + kstep;
            PG8_LDB(B0, 0, 0); PG8_LDB(B1, 0, 1); PG8_SCHED; PG8_LDA(At, 0, 0); PG8_STAGE(PG8_SA(1, 1), a1 + hstepA, voffA);
            PG8_WAIT_V(8); PG8_WAIT_L(0); PG8_BAR; PG8_MMA(0, 0, At, B0); PG8_MMA(0, 1, At, B1); PG8_BAR; PG8_SCHED;
            PG8_LDA(At, 0, 1); PG8_STAGE(PG8_SB(0, 0), b2, voffB); PG8_STAGE(PG8_SB(0, 1), b2 + hstepB, voffB); PG8_STAGE(PG8_SA(0, 0), a2, voffA);
            PG8_WAIT_V(8); PG8_WAIT_L(0); PG8_BAR; PG8_MMA(1, 0, At, B0); PG8_MMA(1, 1, At, B1); PG8_BAR; PG8_SCHED;
            PG8_LDB(B0, 1, 0); PG8_LDB(B1, 1, 1); PG8_SCHED; PG8_LDA(At, 1, 0); PG8_STAGE(PG8_SA(0, 1), a2 + hstepA, voffA);
            PG8_WAIT_V(8); PG8_WAIT_L(0); PG8_BAR; PG8_MMA(0, 0, At, B0); PG8_MMA(0, 1, At, B1); PG8_BAR; PG8_SCHED;
            PG8_LDA(At, 1, 1); PG8_STAGE(PG8_SB(1, 0), b3, voffB); PG8_STAGE(PG8_SB(1, 1), b3 + hstepB, voffB); PG8_STAGE(PG8_SA(1, 0), a3, voffA);
            PG8_WAIT_V(8); PG8_WAIT_L(0); PG8_BAR; PG8_MMA(1, 0, At, B0); PG8_MMA(1, 1, At, B1); PG8_BAR; PG8_SCHED;
        }
        if constexpr (ALIGN_EPI) { if (wr == 0) PG8_BAR; }
        E(acc, cur, wr, wc, fr, fq);
        if (!has_next) break;
#pragma unroll
        for (int a = 0; a < 2; ++a)
#pragma unroll
            for (int b = 0; b < 2; ++b)
#pragma unroll
                for (int m = 0; m < 4; ++m)
#pragma unroll
                    for (int n = 0; n < 2; ++n) acc[a][b][m][n] = (f32x4){0.f, 0.f, 0.f, 0.f};
        cur = nxt; cA = nA; cB = nB; ++ui;
        if constexpr (ALIGN_EPI) { if (wr == 1) PG8_BAR; }
    }
    PG8_WAIT_V(0);
    if constexpr (!ALIGN_EPI) { if (wr == 0) PG8_BAR; }
    PG8_BAR;
#undef PG8_SA
#undef PG8_SB
#undef PG8_STAGE
#undef PG8_LDA
#undef PG8_LDB
#undef PG8_MMA
#undef PG8_WAIT_V
#undef PG8_WAIT_L
#undef PG8_BAR
#undef PG8_SCHED
}
}

constexpr int BATCH = 2, SEQ = 4096, DM = 2048, M = BATCH * SEQ;
constexpr int NH = 16, DQK = 192, DNOPE = 128, DROPE = 64, DV = 128, QLORA = 512, KVLORA = 512;
constexpr int POOLW = 1024, DIN = 6208, DIN_PAD = 6400, DFF = 5632;
constexpr float EPS = 1e-6f;
constexpr int NWAVES = 8;

typedef unsigned short bf16;
typedef unsigned v4u __attribute__((ext_vector_type(4)));
typedef unsigned v2u __attribute__((ext_vector_type(2)));
typedef float f32x4 __attribute__((ext_vector_type(4)));
typedef short bf16x8 __attribute__((ext_vector_type(8)));
typedef short s16x4 __attribute__((ext_vector_type(4)));
typedef float f32x16 __attribute__((ext_vector_type(16)));
#define LAS __attribute__((address_space(3)))
#define LDS_WAIT() asm volatile("s_waitcnt lgkmcnt(0)" ::: "memory")

constexpr size_t MiB = 1u << 20;
constexpr size_t WS_WAO = 1 * MiB, WS_WOUT = 9 * MiB, WS_WPO = 17 * MiB, WS_WQB = 21 * MiB, WS_WKVB = 24 * MiB, WS_WPG = 28 * MiB, WS_KR = 29 * MiB;
constexpr size_t WS_G = 31 * MiB;
constexpr size_t WS_WIN = 95 * MiB, WS_XN = 120 * MiB, WS_C1 = 152 * MiB, WS_U = 184 * MiB;
constexpr size_t WS_Q = 95 * MiB, WS_K = 143 * MiB, WS_V = 191 * MiB, WS_CN = 223 * MiB, WS_POOLED = 239 * MiB, WS_PG = 255 * MiB;
constexpr size_t WS_MP = 223 * MiB, WS_O = 255 * MiB, WS_MIXED = 95 * MiB, WS_X1 = 127 * MiB, WS_H2 = 95 * MiB;
constexpr size_t WS_WGU = 191 * MiB, WS_WDN = 235 * MiB, WS_ACT = 1 * MiB;
constexpr size_t WS_END = 296 * MiB, WS_BAR = 512 * 1024;
constexpr int SV_BGATE = 0, SV_QAG = 4096, SV_KVAG = 4608, SV_QNG = 5120, SV_KNG = 5376, SV_PSC = 5632, SV_FNG = 6656, SV_POS = 8704, SV_END = 8704 + 8192;

constexpr int LDS_BYTES = 147456;

__device__ __forceinline__ unsigned cvtpk(float lo, float hi) { return pg8::cvt_pk_bf16(lo, hi); }
__device__ __forceinline__ float bflo(unsigned w) { return __uint_as_float(w << 16); }
__device__ __forceinline__ float bfhi(unsigned w) { return __uint_as_float(w & 0xffff0000u); }
__device__ __forceinline__ float wave_sum(float v) {
#pragma unroll
    for (int o = 1; o < 64; o <<= 1) v += __shfl_xor(v, o);
    return v;
}

__device__ __forceinline__ int dst_row(int mode, int n0) {
    if (mode == 1) { if (n0 < 1024) return n0; if (n0 < 1088) return 6144 + (n0 - 1024); if (n0 < 2112) return 1024 + (n0 - 1088); return 2048 + (n0 - 2112); }
    if (mode == 2) return (n0 >> 7) * 256 + (n0 & 127);
    if (mode == 3) return (n0 >> 7) * 256 + 128 + (n0 & 127);
    return n0;
}
__device__ __forceinline__ void transpose_item(const float* W, int K, int N, bf16* WT, int mode, int row_off, LAS float* scr, int item, int lane) {
    const int nblk = N / 32, kb = item / nblk, nb = item % nblk, k0 = 64 * kb, n0 = 32 * nb;
    { float tv[32]; const float* wp = W + (size_t)(k0 + (lane >> 5)) * N + n0 + (lane & 31);
#pragma unroll
      for (int i = 0; i < 32; ++i) tv[i] = wp[(size_t)(2 * i) * N];
#pragma unroll
      for (int i = 0; i < 32; ++i) scr[(2 * i + (lane >> 5)) * 33 + (lane & 31)] = tv[i]; }
    LDS_WAIT(); asm volatile("" ::: "memory");
    const int c = lane & 7, dr = row_off + dst_row(mode, n0);
#pragma unroll
    for (int j = 0; j < 4; ++j) { const int n = (lane >> 3) + 8 * j; const LAS float* s = scr + (8 * c) * 33 + n;
        v4u o; o.x = cvtpk(s[0 * 33], s[1 * 33]); o.y = cvtpk(s[2 * 33], s[3 * 33]); o.z = cvtpk(s[4 * 33], s[5 * 33]); o.w = cvtpk(s[6 * 33], s[7 * 33]);
        *(v4u*)(WT + (size_t)(dr + n) * K + k0 + 8 * c) = o; }
    LDS_WAIT(); asm volatile("" ::: "memory");
}

__device__ __forceinline__ void rms_row_2048(const float* xrow, const float* g, bf16* orow, int lane) {
    const f32x4* xr = (const f32x4*)xrow + lane; const f32x4* gr = (const f32x4*)g + lane;
    f32x4 v[8]; float s = 0.f;
#pragma unroll
    for (int j = 0; j < 8; ++j) { v[j] = xr[64 * j]; s += (v[j].x * v[j].x + v[j].y * v[j].y) + (v[j].z * v[j].z + v[j].w * v[j].w); }
    const float inv = 1.0f / sqrtf(wave_sum(s) * (1.f / 2048.f) + EPS);
    v2u* o8 = (v2u*)orow + lane;
#pragma unroll
    for (int j = 0; j < 8; ++j) { const f32x4 gv = gr[64 * j]; v2u o; o.x = cvtpk(v[j].x * inv * gv.x, v[j].y * inv * gv.y); o.y = cvtpk(v[j].z * inv * gv.z, v[j].w * inv * gv.w); o8[64 * j] = o; }
}

namespace att {
constexpr int QBLK = 32, KVBLK = 64, QB = 256;
constexpr int SHM_V = KVBLK * DV * 2, SHM_K = KVBLK * DQK * 2;
constexpr int OFF_V = 0, OFF_K = 2 * SHM_V, OFF_WS = OFF_K + 2 * SHM_K;
constexpr float SCALE = 0.07216878364870322f;
constexpr float THR = 8.f;
#define KSWZ(row, colB) ((row) * 384 + ((colB) ^ (((row) & 7) << 4)))
#define SBAR() __builtin_amdgcn_sched_barrier(0)
__device__ __forceinline__ int v_st(int k, int c) { const int kk = (k & ~0xC) | ((k & 4) << 1) | ((k & 8) >> 1); return ((kk >> 3) * 4 + (c >> 5)) * 512 + ((kk & 7) * 32 + (c & 31)) * 2; }
__device__ __forceinline__ int v_rd_base(int lane) { return ((lane & 3) << 3) | (((lane >> 2) & 3) << 6) | (((lane >> 4) & 1) << 5) | (((lane >> 5) & 1) << 8); }
__device__ __forceinline__ int crow(int r, int hi) { return (r & 3) + 8 * (r >> 2) + 4 * hi; }
__device__ __forceinline__ void mask_tile(f32x16& p0, f32x16& p1, int dq) {
    const float NEG = -__builtin_inff();
#pragma unroll
    for (int r = 0; r < 16; ++r) {
        const int c = (r & 3) + 8 * (r >> 2);
        if (dq - c < 0) p0[r] = NEG;
        if (dq - c - 32 < 0) p1[r] = NEG;
    }
}
__device__ __forceinline__ void partialSM(f32x16& p0, f32x16& p1, float& m_reg, float& mn, float& alpha) {
    float pmax = p0[0];
#pragma unroll
    for (int r = 1; r < 16; ++r) pmax = fmaxf(pmax, p0[r]);
#pragma unroll
    for (int r = 0; r < 16; ++r) pmax = fmaxf(pmax, p1[r]);
    { auto rr = __builtin_amdgcn_permlane32_swap(__float_as_uint(pmax), __float_as_uint(pmax), false, false);
      pmax = fmaxf(__uint_as_float(rr[0]), __uint_as_float(rr[1])); }
    constexpr float C2 = 1.4426950408889634f * SCALE;
    if (__builtin_expect(__all((pmax - m_reg) * SCALE <= THR), 1)) { mn = m_reg; alpha = 1.f; }
    else { mn = fmaxf(m_reg, pmax); alpha = __builtin_amdgcn_exp2f((m_reg - mn) * C2); m_reg = mn; }
    const float mnL = -mn * C2;
#pragma unroll
    for (int r = 0; r < 16; ++r) p0[r] = fmaf(p0[r], C2, mnL);
#pragma unroll
    for (int r = 0; r < 16; ++r) p1[r] = fmaf(p1[r], C2, mnL);
#pragma unroll
    for (int r = 0; r < 16; ++r) p0[r] = __builtin_amdgcn_exp2f(p0[r]);
}
__device__ __forceinline__ void finishSM(f32x16& p0, f32x16& p1, float alpha, float& l_reg, bf16x8& pa0, bf16x8& pa1, bf16x8& pa2, bf16x8& pa3) {
#pragma unroll
    for (int r = 0; r < 16; ++r) p1[r] = __builtin_amdgcn_exp2f(p1[r]);
    float ps = 0;
#pragma unroll
    for (int r = 0; r < 16; ++r) ps += p0[r];
#pragma unroll
    for (int r = 0; r < 16; ++r) ps += p1[r];
    { auto rr = __builtin_amdgcn_permlane32_swap(__float_as_uint(ps), __float_as_uint(ps), false, false);
      ps = __uint_as_float(rr[0]) + __uint_as_float(rr[1]); }
    l_reg = l_reg * alpha + ps;
#define PK4(P, B_, OUT) do { unsigned a0 = cvtpk(P[B_+0], P[B_+1]), a1 = cvtpk(P[B_+2], P[B_+3]);                          \
        unsigned b0 = cvtpk(P[B_+4], P[B_+5]), b1 = cvtpk(P[B_+6], P[B_+7]);                                             \
        auto r0 = __builtin_amdgcn_permlane32_swap(a0, b0, false, false); auto r1 = __builtin_amdgcn_permlane32_swap(a1, b1, false, false); \
        v4u w = {r0[0], r1[0], r0[1], r1[1]}; OUT = *reinterpret_cast<bf16x8*>(&w); } while (0)
    PK4(p0, 0, pa0); PK4(p0, 8, pa1); PK4(p1, 0, pa2); PK4(p1, 8, pa3);
#undef PK4
}
__device__ __forceinline__ void qkt(f32x16& p0, f32x16& p1, const char* Kb, int r32, int hi, const bf16x8* qr) {
    p0 = f32x16{}; p1 = f32x16{};
    const char* kb[4];
#pragma unroll
    for (int dd = 0; dd < 4; ++dd) kb[dd] = Kb + KSWZ(r32, (dd * 16 + hi * 8) * 2);
#pragma unroll
    for (int d0 = 0; d0 < 12; ++d0) { const char* a = kb[d0 & 3] + (d0 >> 2) * 128;
        bf16x8 b0 = *reinterpret_cast<const bf16x8*>(a);
        bf16x8 b1 = *reinterpret_cast<const bf16x8*>(a + 32 * 384);
        p0 = __builtin_amdgcn_mfma_f32_32x32x16_bf16(b0, qr[d0], p0, 0, 0, 0);
        p1 = __builtin_amdgcn_mfma_f32_32x32x16_bf16(b1, qr[d0], p1, 0, 0, 0); }
}
__device__ __forceinline__ void pv_tile(f32x16* o, int vb0, bf16x8 pa0, bf16x8 pa1, bf16x8 pa2, bf16x8 pa3) {
#define TRRD(dst, off) asm volatile("ds_read_b64_tr_b16 %0, %1 offset:%2" : "=&v"(dst) : "v"(vb0), "i"(off) : "memory")
#define PV_D0(d0) do { s16x4 l0, l1, l2, l3, h0, h1, h2, h3; constexpr int b_ = (d0) * 512; \
        TRRD(l0, b_); TRRD(h0, b_ + 2048); TRRD(l1, b_ + 4096); TRRD(h1, b_ + 6144); TRRD(l2, b_ + 8192); TRRD(h2, b_ + 10240); TRRD(l3, b_ + 12288); TRRD(h3, b_ + 14336); \
        asm volatile("s_waitcnt lgkmcnt(0)" ::: "memory"); SBAR(); \
        o[d0] = __builtin_amdgcn_mfma_f32_32x32x16_bf16(pa0, (bf16x8){l0[0], l0[1], l0[2], l0[3], h0[0], h0[1], h0[2], h0[3]}, o[d0], 0, 0, 0);   \
        o[d0] = __builtin_amdgcn_mfma_f32_32x32x16_bf16(pa1, (bf16x8){l1[0], l1[1], l1[2], l1[3], h1[0], h1[1], h1[2], h1[3]}, o[d0], 0, 0, 0);   \
        o[d0] = __builtin_amdgcn_mfma_f32_32x32x16_bf16(pa2, (bf16x8){l2[0], l2[1], l2[2], l2[3], h2[0], h2[1], h2[2], h2[3]}, o[d0], 0, 0, 0);   \
        o[d0] = __builtin_amdgcn_mfma_f32_32x32x16_bf16(pa3, (bf16x8){l3[0], l3[1], l3[2], l3[3], h3[0], h3[1], h3[2], h3[3]}, o[d0], 0, 0, 0); } while (0)
    PV_D0(0); PV_D0(1); PV_D0(2); PV_D0(3);
#undef PV_D0
#undef TRRD
}
__device__ __forceinline__ void attn_unit(int b, int h, int qb, const bf16* Q, const bf16* K, const bf16* V, bf16* O, char* lds) {
    const int tid = threadIdx.x, wid = __builtin_amdgcn_readfirstlane(tid >> 6), lane = tid & 63, r32 = lane & 31, hi = lane >> 5;
    const size_t rowb = (size_t)b * SEQ;
    const int q0 = qb * QB, qlo = q0 + wid * QBLK;
    const int NT = (q0 + QB) / KVBLK;
    char* V_lds = lds + OFF_V; char* K_lds = lds + OFF_K;
    float* ws = (float*)(lds + OFF_WS) + wid * 64; float* li_l = ws; float* al_l = ws + 32;
    int koff[3], kws[3];
#pragma unroll
    for (int i = 0; i < 3; ++i) { const int c = tid + 512 * i, kr_ = c / 24, kc_ = c % 24; koff[i] = kr_ * 3072 + kc_ * 8; kws[i] = KSWZ(kr_, kc_ * 16); }
    const int sr = tid >> 4, sc = (tid & 15) * 8, vst0 = v_st(sr, sc), vst1 = v_st(32 + sr, sc);
    const bf16* Kh = K + rowb * 3072 + h * DQK; const bf16* Vh = V + rowb * 2048 + h * DV + (size_t)sr * 2048 + sc;
    bf16x8 sk[3];
#define KLOAD(k0) do { _Pragma("unroll") for (int i = 0; i < 3; ++i) sk[i] = *(const bf16x8*)(Kh + (size_t)(k0) * 3072 + koff[i]); } while (0)
#define KWRITE(bf) do { _Pragma("unroll") for (int i = 0; i < 3; ++i) *(bf16x8*)(K_lds + (bf) * SHM_K + kws[i]) = sk[i]; } while (0)
#define VLOAD(k0) do { sk[0] = *(const bf16x8*)(Vh + (size_t)(k0) * 2048); sk[1] = *(const bf16x8*)(Vh + (size_t)((k0) + 32) * 2048); } while (0)
#define VWRITE(bf) do { *(bf16x8*)(V_lds + (bf) * SHM_V + vst0) = sk[0]; *(bf16x8*)(V_lds + (bf) * SHM_V + vst1) = sk[1]; } while (0)
    KLOAD(0);
    bf16x8 qr[12];
    { const bf16* Qp = Q + (rowb + qlo + r32) * 3072 + h * DQK + hi * 8;
#pragma unroll
      for (int d0 = 0; d0 < 12; ++d0) qr[d0] = *(const bf16x8*)(Qp + d0 * 16); }
    asm volatile("s_waitcnt vmcnt(0)" ::: "memory");
    KWRITE(0); SBAR(); VLOAD(0);
    asm volatile("s_waitcnt vmcnt(0)" ::: "memory");
    VWRITE(0);
    __syncthreads();
    float m_reg = -1e30f, l_reg = 0.f; f32x16 o[4] = {};
    const int vbase = (int)(uintptr_t)V_lds + v_rd_base(lane);
    const int qm = qlo + r32 - 4 * hi;
    for (int t = 0; t < NT; ++t) {
        const int cur = t & 1, kb_ = t * KVBLK;
        if (t + 1 < NT) KLOAD((t + 1) * KVBLK);
        SBAR();
        f32x16 p0, p1; float mn, alpha; bf16x8 pa0, pa1, pa2, pa3;
        qkt(p0, p1, K_lds + cur * SHM_K, r32, hi, qr);
        if (kb_ + KVBLK - 1 > qlo) mask_tile(p0, p1, qm - kb_);
        partialSM(p0, p1, m_reg, mn, alpha);
        finishSM(p0, p1, alpha, l_reg, pa0, pa1, pa2, pa3);
        if (__any(alpha < 1.f)) { if (hi == 0) al_l[r32] = alpha; asm volatile("s_waitcnt lgkmcnt(0)" ::: "memory");
#pragma unroll
            for (int d_ = 0; d_ < 4; ++d_)
#pragma unroll
                for (int r = 0; r < 16; ++r) o[d_][r] *= al_l[crow(r, hi)]; }
        SBAR();
        if (t + 1 < NT) { asm volatile("s_waitcnt vmcnt(0)" ::: "memory"); KWRITE(cur ^ 1); SBAR(); VLOAD((t + 1) * KVBLK); }
        SBAR();
        pv_tile(o, vbase + cur * SHM_V, pa0, pa1, pa2, pa3);
        if (t + 1 < NT) { asm volatile("s_waitcnt vmcnt(0)" ::: "memory"); VWRITE(cur ^ 1); }
        __syncthreads();
    }
    if (hi == 0) li_l[r32] = l_reg; asm volatile("s_waitcnt lgkmcnt(0)" ::: "memory");
    float rli[16];
#pragma unroll
    for (int r = 0; r < 16; ++r) rli[r] = __builtin_amdgcn_rcpf(li_l[crow(r, hi)]);
    bf16* Ow = O + (rowb + qlo) * 2048 + h * DV;
#pragma unroll
    for (int r = 0; r < 16; ++r) { const int orow = crow(r, hi);
#pragma unroll
        for (int d0 = 0; d0 < 4; ++d0) { const float v = o[d0][r] * rli[r];
            const float vn = __shfl_xor(v, 1);
            if ((r32 & 1) == 0) *(unsigned*)(Ow + (size_t)orow * 2048 + d0 * 32 + r32) = cvtpk(v, vn); } }
    __syncthreads();
#undef KLOAD
#undef KWRITE
#undef VLOAD
#undef VWRITE
}
#undef SBAR
}

struct Args { const float* in[20]; float* out; unsigned char* ws; int ph_lo, ph_hi, coop, pad; };
#define XB_TMO      128
#define XB_XCNT(j)  (256  + 64 * (j))
#define XB_XSUB(j)  (1280 + 64 * (j))
#define XB_XGEN(j)  (2304 + 64 * (j))
#define XB_TOP      3328
#define XB_TOPGEN   3392
#define XCD_BAR_WORDS 3456
#define XB_SPIN_CAP (1u << 20)
__device__ __forceinline__ unsigned xb_ld(unsigned* p)              { return __hip_atomic_load(p, __ATOMIC_RELAXED, __HIP_MEMORY_SCOPE_AGENT); }
__device__ __forceinline__ unsigned xb_add(unsigned* p, unsigned v) { return __hip_atomic_fetch_add(p, v, __ATOMIC_RELAXED, __HIP_MEMORY_SCOPE_AGENT); }
__device__ __forceinline__ unsigned xb_xcc_id() { return (unsigned)__builtin_amdgcn_s_getreg((3 << 11) | 20) & 0xFu; }
#define XB_SPIN(cond, bar) do { unsigned _sp = 0; while (cond) { __builtin_amdgcn_s_sleep(1); \
    if ((++_sp & 255u) == 0u) { if (xb_ld(&(bar)[XB_TMO])) break; if (_sp > XB_SPIN_CAP) { atomicAdd(&(bar)[XB_TMO], 1u); break; } } } } while (0)
__device__ __forceinline__ void xcd_barrier_complete(unsigned* bar, unsigned x, unsigned& nloc, unsigned& nx) {
    const unsigned G = gridDim.x;
    unsigned sum, cnt, mine, sp = 0u;
    for (;;) {
        sum = 0u; cnt = 0u; mine = 0u;
#pragma unroll
        for (unsigned j = 0; j < 16; ++j) { const unsigned c = xb_ld(&bar[XB_XCNT(j)]); sum += c; cnt += (c > 0u) ? 1u : 0u; mine = (j == x) ? c : mine; }
        if (sum == G) break;
        __builtin_amdgcn_s_sleep(1);
        if ((++sp & 255u) == 0u) { if (xb_ld(&bar[XB_TMO])) break; if (sp > XB_SPIN_CAP) { atomicAdd(&bar[XB_TMO], 1u); break; } }
    }
    nloc = mine > 0u ? mine : 1u; nx = cnt > 0u ? cnt : 1u;
}
__device__ __forceinline__ void grid_bar(unsigned* bar, volatile LAS unsigned* st) {
    asm volatile("s_waitcnt vmcnt(0)" ::: "memory");
    __syncthreads();
    if (threadIdx.x == 0) {
        const unsigned x = xb_xcc_id();
        __builtin_amdgcn_s_waitcnt(0);
        unsigned nloc = st[0], nx = st[1];
        if (nloc == 0u) { xcd_barrier_complete(bar, x, nloc, nx); st[0] = nloc; st[1] = nx; }
        const unsigned old = xb_add(&bar[XB_XSUB(x)], 1u);
        const unsigned gen = old / nloc;
        if (old + 1u == (gen + 1u) * nloc) {
            __builtin_amdgcn_fence(__ATOMIC_RELEASE, "agent");
            asm volatile("s_waitcnt vmcnt(0)" ::: "memory");
            const unsigned og = xb_add(&bar[XB_TOP], 1u);
            const unsigned tg = og / nx;
            if (og + 1u == (tg + 1u) * nx) xb_add(&bar[XB_TOPGEN], 1u);
            else XB_SPIN(xb_ld(&bar[XB_TOPGEN]) == tg, bar);
            __builtin_amdgcn_fence(__ATOMIC_ACQUIRE, "agent");
            xb_add(&bar[XB_XGEN(x)], 1u);
            asm volatile("s_waitcnt vmcnt(0)" ::: "memory");
        } else {
            XB_SPIN(xb_ld(&bar[XB_XGEN(x)]) == gen, bar);
            __builtin_amdgcn_fence(__ATOMIC_ACQUIRE, "agent");
            asm volatile("s_waitcnt vmcnt(0)" ::: "memory");
        }
    }
    __syncthreads();
}
constexpr int NPH = 11;

__global__ void __launch_bounds__(NWAVES * 64, 2) mega_fwd(Args args) {
    extern __shared__ __attribute__((aligned(16))) unsigned char lds[];
    LAS unsigned char* ldsl = (LAS unsigned char*)lds;
    const int tid = threadIdx.x, lane = tid & 63, wave = __builtin_amdgcn_readfirstlane(tid >> 6);
    const int G = gridDim.x, bx = blockIdx.x;
    const int vcu = (G % 8 == 0) ? (bx % 8) * (G / 8) + bx / 8 : bx;
    const int gw = vcu * NWAVES + wave, NGW = G * NWAVES;
    unsigned char* ws = args.ws;
    const float* const* kin = (const float* const*)__builtin_amdgcn_kernarg_segment_ptr();
    const float* svec = (const float*)ws;
    const float* b_gate = svec + SV_BGATE; const float* q_a_norm_g = svec + SV_QAG; const float* kv_a_norm_g = svec + SV_KVAG; const float* q_norm_g = svec + SV_QNG;
    const float* k_norm_g = svec + SV_KNG; const float* pool_scale = svec + SV_PSC; const float* ffn_norm_g = svec + SV_FNG; const int* positions = (const int*)(svec + SV_POS);
    bf16* WIN_T = (bf16*)(ws + WS_WIN); bf16* WQB_T = (bf16*)(ws + WS_WQB); bf16* WKVB_T = (bf16*)(ws + WS_WKVB); bf16* WPG_T = (bf16*)(ws + WS_WPG);
    bf16* WPO_T = (bf16*)(ws + WS_WPO); bf16* WAO_T = (bf16*)(ws + WS_WAO); bf16* WOUT_T = (bf16*)(ws + WS_WOUT); bf16* WGU_T = (bf16*)(ws + WS_WGU); bf16* WDN_T = (bf16*)(ws + WS_WDN);
    bf16* XN = (bf16*)(ws + WS_XN); float* C1 = (float*)(ws + WS_C1); float* KR = (float*)(ws + WS_KR); bf16* U = (bf16*)(ws + WS_U); bf16* Gt = (bf16*)(ws + WS_G);
    bf16* CN = (bf16*)(ws + WS_CN); bf16* POOLED = (bf16*)(ws + WS_POOLED); bf16* Qb = (bf16*)(ws + WS_Q); bf16* Kb = (bf16*)(ws + WS_K); bf16* Vb = (bf16*)(ws + WS_V);
    bf16* PG = (bf16*)(ws + WS_PG); bf16* MP = (bf16*)(ws + WS_MP); bf16* Ob = (bf16*)(ws + WS_O); bf16* MIXED = (bf16*)(ws + WS_MIXED);
    float* X1 = (float*)(ws + WS_X1); bf16* H2 = (bf16*)(ws + WS_H2); bf16* ACT = (bf16*)(ws + WS_ACT);

    const int lo = args.ph_lo, hi_ph = args.ph_hi;
#ifndef PHMASK
#define PHMASK 0x7ff
#endif
#define IN(k) (((PHMASK >> (k)) & 1) && lo <= (k) && (k) < hi_ph)
#define SEAM(k) do { if (IN(k) && IN((k) + 1)) { unsigned char* w2_ = args.ws; asm volatile("" : "+s"(w2_)); grid_bar((unsigned*)(w2_ + WS_BAR), (volatile LAS unsigned*)(ldsl + 140032)); } } while (0)
    if (args.coop > 1) cg::this_grid().sync();
    if (threadIdx.x < 2) ((volatile LAS unsigned*)(ldsl + 140032))[threadIdx.x] = 0u;
    __syncthreads();
    if (args.coop && threadIdx.x == 0) { unsigned char* w2_ = args.ws; asm volatile("" : "+s"(w2_)); (void)xb_add(&((unsigned*)(w2_ + WS_BAR))[XB_XCNT(xb_xcc_id())], 1u); }
    LAS float* scr = (LAS float*)(ldsl + wave * 16384);

    if (IN(0)) {
        { float* sv = (float*)ws; const int gt = bx * (NWAVES * 64) + tid, GT = G * NWAVES * 64;
          for (int i = gt; i < SV_END; i += GT) { int idx, off, lim = 1 << 30;
              if (i < SV_QAG) { idx = 4; off = SV_BGATE; } else if (i < SV_KVAG) { idx = 5; off = SV_QAG; } else if (i < SV_QNG) { idx = 7; off = SV_KVAG; }
              else if (i < SV_KNG) { idx = 9; off = SV_QNG; lim = 192; } else if (i < SV_PSC) { idx = 10; off = SV_KNG; lim = 192; }
              else if (i < SV_FNG) { idx = 13; off = SV_PSC; } else if (i < SV_POS) { idx = 16; off = SV_FNG; } else { idx = 1; off = SV_POS; }
              const float* src = kin[idx]; sv[i] = (i - off < lim) ? src[i - off] : 0.f; } }
        constexpr int I_IN = (DM / 64) * (DIN / 32), I_QB = (QLORA / 64) * (NH * DQK / 32), I_KVB = (KVLORA / 64) * (NH * 256 / 32), I_PG = (256 / 64) * (256 / 32),
                      I_PO = (POOLW / 64) * (DM / 32), I_AO = (DM / 64) * (DM / 32), I_OUT = I_AO;
        constexpr int NITEMS = I_IN + I_QB + I_KVB + 4 * I_PG + I_PO + I_AO + I_OUT;
        for (int it = gw; it < NITEMS; it += NGW) {
            int r = it, idx, Kd, Nd, mode = 0, roff = 0; size_t dsto, srco = 0;
            if (r < I_IN) { idx = 3; Kd = DM; Nd = DIN; mode = 1; dsto = WS_WIN; }
            else if ((r -= I_IN) < I_QB) { idx = 6; Kd = QLORA; Nd = NH * DQK; dsto = WS_WQB; }
            else if ((r -= I_QB) < I_KVB) { idx = 8; Kd = KVLORA; Nd = NH * 256; dsto = WS_WKVB; }
            else if ((r -= I_KVB) < 4 * I_PG) { const int g = r / I_PG; r = r % I_PG; idx = 12; Kd = 256; Nd = 256; dsto = WS_WPG; roff = g * 256; srco = (size_t)g * 65536; }
            else if ((r -= 4 * I_PG) < I_PO) { idx = 14; Kd = POOLW; Nd = DM; dsto = WS_WPO; }
            else if ((r -= I_PO) < I_AO) { idx = 11; Kd = DM; Nd = DM; dsto = WS_WAO; }
            else { r -= I_AO; idx = 15; Kd = DM; Nd = DM; dsto = WS_WOUT; }
            transpose_item(kin[idx] + srco, Kd, Nd, (bf16*)(ws + dsto), mode, roff, scr, r, lane);
        }
        { v4u* z = (v4u*)(WIN_T + (size_t)DIN * DM); const int nz = (DIN_PAD - DIN) * DM / 8;
          for (int i = gw * 64 + lane; i < nz; i += NGW * 64) z[i] = (v4u){0u, 0u, 0u, 0u}; }
        { const float* x = kin[0]; const float* attn_norm_g = kin[2];
          for (int m = gw; m < M; m += NGW) rms_row_2048(x + (size_t)m * DM, attn_norm_g, XN + (size_t)m * DM, lane); }
    }
    SEAM(0);
    if (IN(1)) {
        pg8::Gemm g{XN, WIN_T, M, DIN_PAD, DM, DM, DM, 0}; pg8::StaticOrder S; S.init(M, DIN_PAD, G, bx);
        pg8::EpiIn E{C1, U, Gt, KR, b_gate};
        pg8::gemm_phase<pg8::EpiIn, pg8::StaticOrder>(ldsl, g, S, E);
    }
    SEAM(1);
    if (IN(2)) {
        for (int m = gw; m < M; m += NGW) {
            const f32x4* c = (const f32x4*)(C1 + (size_t)m * 1024) + lane; f32x4 v[4]; float sq = 0.f, skv = 0.f;
#pragma unroll
            for (int j = 0; j < 4; ++j) { v[j] = c[64 * j]; const float s = (v[j].x * v[j].x + v[j].y * v[j].y) + (v[j].z * v[j].z + v[j].w * v[j].w); if (j < 2) sq += s; else skv += s; }
            const float iq = 1.0f / sqrtf(wave_sum(sq) * (1.f / 512.f) + EPS), ikv = 1.0f / sqrtf(wave_sum(skv) * (1.f / 512.f) + EPS);
            v2u* o8 = (v2u*)(CN + (size_t)m * 1024) + lane;
#pragma unroll
            for (int j = 0; j < 4; ++j) { const f32x4 gv = (j < 2) ? ((const f32x4*)q_a_norm_g)[lane + 64 * j] : ((const f32x4*)kv_a_norm_g)[lane + 64 * (j - 2)]; const float iv = (j < 2) ? iq : ikv;
                v2u o; o.x = cvtpk(v[j].x * iv * gv.x, v[j].y * iv * gv.y); o.y = cvtpk(v[j].z * iv * gv.z, v[j].w * iv * gv.w); o8[64 * j] = o; }
        }
        for (int m = gw; m < M; m += NGW) {
            const int s = m & (SEQ - 1);
#pragma unroll
            for (int jj = 0; jj < 2; ++jj) {
                const int col = 8 * lane + 512 * jj, grp = col >> 8, w = 2 << grp; const int cnt = (s + 1 < w) ? s + 1 : w;
                float a[8]; float u0[8];
#pragma unroll
                for (int e = 0; e < 8; ++e) a[e] = 0.f;
#pragma unroll
                for (int d = 0; d < 16; ++d) {
                    if (d < cnt) { const v4u q = *(const v4u*)(U + (size_t)(m - d) * 1024 + col);
                        const float f[8] = {bflo(q.x), bfhi(q.x), bflo(q.y), bfhi(q.y), bflo(q.z), bfhi(q.z), bflo(q.w), bfhi(q.w)};
#pragma unroll
                        for (int e = 0; e < 8; ++e) { a[e] += f[e]; if (d == 0) u0[e] = f[e]; } }
                }
                const float rc = 1.0f / (float)cnt;
                v4u o; o.x = cvtpk(a[0] * rc - u0[0], a[1] * rc - u0[1]); o.y = cvtpk(a[2] * rc - u0[2], a[3] * rc - u0[3]);
                o.z = cvtpk(a[4] * rc - u0[4], a[5] * rc - u0[5]); o.w = cvtpk(a[6] * rc - u0[6], a[7] * rc - u0[7]);
                *(v4u*)(POOLED + (size_t)m * 1024 + col) = o;
            }
        }
    }
    SEAM(2);
    if (IN(3)) {
        { pg8::Gemm g{CN, WQB_T, M, NH * DQK, QLORA, 1024, QLORA, 0}; pg8::StaticOrder S; S.init(M, NH * DQK, G, bx);
          pg8::EpiBf16 E{Qb, 3072}; pg8::gemm_phase<pg8::EpiBf16, pg8::StaticOrder>(ldsl, g, S, E); }
        { pg8::Gemm g{CN + 512, WKVB_T, M, NH * 256, KVLORA, 1024, KVLORA, 0}; pg8::StaticOrder S; S.init(M, NH * 256, G, bx);
          pg8::EpiKV E{Kb, Vb}; pg8::gemm_phase<pg8::EpiKV, pg8::StaticOrder>(ldsl, g, S, E); }
        { pg8::Gemm g{POOLED, WPG_T, M, POOLW, 256, 1024, 256, 256}; pg8::StaticOrder S; S.init(M, POOLW, G, (bx + 128) % G);
          pg8::EpiScale E{PG, 1024, pool_scale}; pg8::gemm_phase<pg8::EpiScale, pg8::StaticOrder>(ldsl, g, S, E); }
    }
    SEAM(3);
    if (IN(4)) {
        for (int m = gw; m < M; m += NGW) {
            const float pos = (float)positions[m];
            const int sub = lane & 3, h = lane >> 2;
            float cs[8], sn[8];
#pragma unroll
            for (int j = 0; j < 8; ++j) { const int i = 8 * sub + j; const float invf = __builtin_amdgcn_exp2f(-(float)i * (13.287712379549449f / 32.f));
                const float ang = pos * invf; const float k = rintf(ang * 0.15915494309189535f);
                float r = fmaf(-k, 6.2831854820251465f, ang); r = fmaf(-k, -1.7484555e-7f, r);
                sn[j] = __sinf(r); cs[j] = __cosf(r); }
#pragma unroll
            for (int which = 0; which < 2; ++which) {
                bf16* base = (which == 0 ? Qb : Kb) + (size_t)m * 3072 + h * DQK;
                const float* gn = (which == 0) ? q_norm_g : k_norm_g;
                float nv[32], rl[8], rh[8]; float ss = 0.f;
#pragma unroll
                for (int jj = 0; jj < 4; ++jj) { const v4u q = *(const v4u*)(base + 32 * sub + 8 * jj);
                    nv[8 * jj + 0] = bflo(q.x); nv[8 * jj + 1] = bfhi(q.x); nv[8 * jj + 2] = bflo(q.y); nv[8 * jj + 3] = bfhi(q.y);
                    nv[8 * jj + 4] = bflo(q.z); nv[8 * jj + 5] = bfhi(q.z); nv[8 * jj + 6] = bflo(q.w); nv[8 * jj + 7] = bfhi(q.w); }
                if (which == 0) {
                    const v4u a = *(const v4u*)(base + 128 + 8 * sub), b = *(const v4u*)(base + 160 + 8 * sub);
                    rl[0] = bflo(a.x); rl[1] = bfhi(a.x); rl[2] = bflo(a.y); rl[3] = bfhi(a.y); rl[4] = bflo(a.z); rl[5] = bfhi(a.z); rl[6] = bflo(a.w); rl[7] = bfhi(a.w);
                    rh[0] = bflo(b.x); rh[1] = bfhi(b.x); rh[2] = bflo(b.y); rh[3] = bfhi(b.y); rh[4] = bflo(b.z); rh[5] = bfhi(b.z); rh[6] = bflo(b.w); rh[7] = bfhi(b.w);
                } else {
                    const f32x4 a0 = *(const f32x4*)(KR + (size_t)m * 64 + 8 * sub), a1 = *(const f32x4*)(KR + (size_t)m * 64 + 8 * sub + 4);
                    const f32x4 b0 = *(const f32x4*)(KR + (size_t)m * 64 + 32 + 8 * sub), b1 = *(const f32x4*)(KR + (size_t)m * 64 + 32 + 8 * sub + 4);
                    rl[0] = a0.x; rl[1] = a0.y; rl[2] = a0.z; rl[3] = a0.w; rl[4] = a1.x; rl[5] = a1.y; rl[6] = a1.z; rl[7] = a1.w;
                    rh[0] = b0.x; rh[1] = b0.y; rh[2] = b0.z; rh[3] = b0.w; rh[4] = b1.x; rh[5] = b1.y; rh[6] = b1.z; rh[7] = b1.w;
                }
#pragma unroll
                for (int e = 0; e < 32; ++e) ss += nv[e] * nv[e];
#pragma unroll
                for (int e = 0; e < 8; ++e) ss += rl[e] * rl[e] + rh[e] * rh[e];
                ss += __shfl_xor(ss, 1); ss += __shfl_xor(ss, 2);
                const float inv = 1.0f / sqrtf(ss * (1.f / 192.f) + EPS);
#pragma unroll
                for (int jj = 0; jj < 4; ++jj) { const f32x4 g0 = *(const f32x4*)(gn + 32 * sub + 8 * jj), g1 = *(const f32x4*)(gn + 32 * sub + 8 * jj + 4);
                    v4u o; o.x = cvtpk(nv[8 * jj + 0] * inv * g0.x, nv[8 * jj + 1] * inv * g0.y); o.y = cvtpk(nv[8 * jj + 2] * inv * g0.z, nv[8 * jj + 3] * inv * g0.w);
                    o.z = cvtpk(nv[8 * jj + 4] * inv * g1.x, nv[8 * jj + 5] * inv * g1.y); o.w = cvtpk(nv[8 * jj + 6] * inv * g1.z, nv[8 * jj + 7] * inv * g1.w);
                    *(v4u*)(base + 32 * sub + 8 * jj) = o; }
                float ol[8], oh[8];
#pragma unroll
                for (int e = 0; e < 8; ++e) { const float a = rl[e] * inv * gn[128 + 8 * sub + e], b = rh[e] * inv * gn[160 + 8 * sub + e];
                    ol[e] = a * cs[e] - b * sn[e]; oh[e] = b * cs[e] + a * sn[e]; }
                v4u o1, o2; o1.x = cvtpk(ol[0], ol[1]); o1.y = cvtpk(ol[2], ol[3]); o1.z = cvtpk(ol[4], ol[5]); o1.w = cvtpk(ol[6], ol[7]);
                o2.x = cvtpk(oh[0], oh[1]); o2.y = cvtpk(oh[2], oh[3]); o2.z = cvtpk(oh[4], oh[5]); o2.w = cvtpk(oh[6], oh[7]);
                *(v4u*)(base + 128 + 8 * sub) = o1; *(v4u*)(base + 160 + 8 * sub) = o2;
            }
        }
        { pg8::Gemm g{PG, WPO_T, M, DM, POOLW, POOLW, POOLW, 0}; pg8::StaticOrder S; S.init(M, DM, G, bx);
          pg8::EpiGate<false> E{MP, Gt, nullptr, 0}; pg8::gemm_phase<pg8::EpiGate<false>, pg8::StaticOrder>(ldsl, g, S, E); }
    }
    SEAM(4);
    if (IN(5)) {
        const int npair = BATCH * NH * 8;
        for (int p = vcu; p < npair; p += G) {
            const int bh = p >> 3, s = p & 7;
            att::attn_unit(bh / NH, bh % NH, 15 - s, Qb, Kb, Vb, Ob, (char*)lds);
            att::attn_unit(bh / NH, bh % NH, s, Qb, Kb, Vb, Ob, (char*)lds);
        }
    }
    SEAM(5);
    if (IN(6)) {
        pg8::Gemm g{Ob, WAO_T, M, DM, DM, DM, DM, 0}; pg8::StaticOrder S; S.init(M, DM, G, bx);
        pg8::EpiGate<true> E{MIXED, Gt, MP, 2048}; pg8::gemm_phase<pg8::EpiGate<true>, pg8::StaticOrder>(ldsl, g, S, E);
    }
    SEAM(6);
    if (IN(7)) {
        pg8::Gemm g{MIXED, WOUT_T, M, DM, DM, DM, DM, 0}; pg8::StaticOrder S; S.init(M, DM, G, bx);
        pg8::EpiRes E{kin[0], X1, DM}; pg8::gemm_phase<pg8::EpiRes, pg8::StaticOrder>(ldsl, g, S, E);
    }
    SEAM(7);
    if (IN(8)) {
        for (int m = gw; m < M; m += NGW) rms_row_2048(X1 + (size_t)m * DM, ffn_norm_g, H2 + (size_t)m * DM, lane);
        constexpr int I_G = (DM / 64) * (DFF / 32), I_D = (DFF / 64) * (DM / 32);
        for (int it = gw; it < 2 * I_G + I_D; it += NGW) {
            int r = it, idx, Kd = DM, Nd = DFF, mode; size_t dsto = WS_WGU;
            if (r < I_G) { idx = 17; mode = 2; } else if ((r -= I_G) < I_G) { idx = 18; mode = 3; } else { r -= I_G; idx = 19; mode = 0; Kd = DFF; Nd = DM; dsto = WS_WDN; }
            transpose_item(kin[idx], Kd, Nd, (bf16*)(ws + dsto), mode, 0, scr, r, lane);
        }
    }
    SEAM(8);
    if (IN(9)) {
        pg8::Gemm g{H2, WGU_T, M, 2 * DFF, DM, DM, DM, 0}; pg8::StaticOrder S; S.init(M, 2 * DFF, G, bx);
        pg8::EpiSwiGLU E{ACT, DFF}; pg8::gemm_phase<pg8::EpiSwiGLU, pg8::StaticOrder>(ldsl, g, S, E);
    }
    SEAM(9);
    if (IN(10)) {
        pg8::Gemm g{ACT, WDN_T, M, DM, DFF, DFF, DFF, 0}; pg8::StaticOrder S; S.init(M, DM, G, bx);
        pg8::EpiRes E{X1, args.out, DM}; pg8::gemm_phase<pg8::EpiRes, pg8::StaticOrder>(ldsl, g, S, E);
    }
#undef IN
#undef SEAM
}

extern "C" void kernel_launch(void* const* d_in, const int* in_sizes, int n_in, void* d_out, int out_size, void* d_ws, size_t ws_size, hipStream_t stream) {
    static int grid = 0;
    if (grid == 0) {
        if (n_in != 20 || out_size != M * DM || ws_size < WS_END) { fprintf(stderr, "kernel_launch: unexpected shapes (n_in %d, out %d, ws %zu)\n", n_in, out_size, ws_size); grid = -1; return; }
        int dev = 0, cus = 0, per_cu = 0;
        (void)hipGetDevice(&dev); (void)hipDeviceGetAttribute(&cus, hipDeviceAttributeMultiprocessorCount, dev);
        if (hipFuncSetAttribute((const void*)mega_fwd, hipFuncAttributeMaxDynamicSharedMemorySize, LDS_BYTES) != hipSuccess) { fprintf(stderr, "kernel_launch: hipFuncSetAttribute failed\n"); grid = -1; return; }
        if (hipOccupancyMaxActiveBlocksPerMultiprocessor(&per_cu, (const void*)mega_fwd, NWAVES * 64, LDS_BYTES) != hipSuccess || per_cu < 1) { fprintf(stderr, "kernel_launch: occupancy query says %d\n", per_cu); per_cu = 1; }
        (void)hipGetLastError();
        grid = cus > 0 ? cus : 256;
    }
    if (grid < 0) return;
    Args a{};
    for (int i = 0; i < 20; ++i) a.in[i] = (const float*)d_in[i];
    a.out = (float*)d_out; a.ws = (unsigned char*)d_ws;
    if (MK_N_LAUNCHES == 1) {
        a.ph_lo = 0; a.ph_hi = NPH; a.coop = 1;
        (void)hipMemsetAsync((char*)d_ws + WS_BAR, 0, 16384, stream);
        void* kargs[] = {&a};
        hipError_t e = hipLaunchCooperativeKernel((const void*)mega_fwd, dim3(grid), dim3(NWAVES * 64), kargs, LDS_BYTES, stream);
        if (e != hipSuccess) fprintf(stderr, "kernel_launch: cooperative launch failed: %s (grid %d)\n", hipGetErrorString(e), grid);
    } else {
        for (int p = 0; p < NPH; ++p) {
            a.ph_lo = p; a.ph_hi = p + 1;
            hipLaunchKernelGGL(mega_fwd, dim3(grid), dim3(NWAVES * 64), LDS_BYTES, stream, a);
        }
    }
}
```

```cpp
#include <hip/hip_runtime.h>
#include <hip/hip_cooperative_groups.h>
#include <cstdio>
#include <cstdint>
namespace cg = cooperative_groups;

#ifndef MK_N_LAUNCHES
#define MK_N_LAUNCHES 1
#endif

namespace pg8 {
#define PG8_LAS __attribute__((address_space(3)))
typedef unsigned short bf16_t;
typedef short bf16x8 __attribute__((ext_vector_type(8)));
typedef float f32x4 __attribute__((ext_vector_type(4)));
typedef unsigned u32x4 __attribute__((ext_vector_type(4)));
constexpr int BM = 256, BK = 64, HALF = 128, HTB = HALF * BK * 2, STAGE_BYTES = 8 * HTB, NXCD = 8, WGM = 8;

__host__ __device__ __forceinline__ int lds_byte(int r, int c) { const int st = (r >> 4) * 2 + (c >> 5), rr = r & 15, cc = c & 31, ob = rr * 64 + cc * 2; return st * 1024 + (ob ^ (((ob >> 9) & 1) << 5)); }
__host__ __device__ __forceinline__ void stage_rc(int b, int& R, int& C) { const int st = b / 1024, sb = b % 1024, swz = sb ^ (((sb >> 9) & 1) << 5); R = (st >> 1) * 16 + swz / 64; C = (st & 1) * 32 + (swz % 64) / 2; }
__host__ __device__ __forceinline__ int perm32(int rho) { const int n = rho >> 4, i = rho & 15; return 8 * (i >> 2) + 4 * n + (i & 3); }

struct Unit { int pm, pn; };
struct Gemm { const bf16_t* A; const bf16_t* Bt; int M, N, K, lda, ldb, a_pn_step, b_pn_step; };

struct StaticOrder {
    int nM, nN, nwg, G, c;
    __host__ __device__ void init(int M, int N, int G_, int c_) { nM = M / BM; nN = N / BM; nwg = nM * nN; G = G_; c = c_; }
    __host__ __device__ bool next(int i, Unit& u) const {
        const long L = (long)i * G + c; if (L >= nwg) return false;
        int wgid = (int)L; { const int q = nwg / NXCD, r = nwg % NXCD, xcd = wgid % NXCD, off = wgid / NXCD; wgid = (xcd < r ? xcd * (q + 1) : r * (q + 1) + (xcd - r) * q) + off; }
        const int nig = WGM * nN, gid = wgid / nig, fm = gid * WGM, gsz = (nM - fm) < WGM ? (nM - fm) : WGM;
        u.pm = fm + ((wgid % nig) % gsz); u.pn = (wgid % nig) / gsz; return true;
    }
};

typedef float f32x2_t_ __attribute__((ext_vector_type(2))); typedef __bf16 bf16x2_t_ __attribute__((ext_vector_type(2)));
__device__ __forceinline__ unsigned cvt_pk_bf16(float lo, float hi) { f32x2_t_ v = {lo, hi}; bf16x2_t_ b = __builtin_convertvector(v, bf16x2_t_); return __builtin_bit_cast(unsigned, b); }
__device__ __forceinline__ u32x4 pack8(f32x4 a, f32x4 b) { u32x4 w; w.x = cvt_pk_bf16(a[0], a[1]); w.y = cvt_pk_bf16(a[2], a[3]); w.z = cvt_pk_bf16(b[0], b[1]); w.w = cvt_pk_bf16(b[2], b[3]); return w; }
__device__ __forceinline__ void unpack8(u32x4 w, f32x4& a, f32x4& b) {
    a[0] = __uint_as_float(w.x << 16); a[1] = __uint_as_float(w.x & 0xffff0000u); a[2] = __uint_as_float(w.y << 16); a[3] = __uint_as_float(w.y & 0xffff0000u);
    b[0] = __uint_as_float(w.z << 16); b[1] = __uint_as_float(w.z & 0xffff0000u); b[2] = __uint_as_float(w.w << 16); b[3] = __uint_as_float(w.w & 0xffff0000u); }
__device__ __forceinline__ float sigmoidf_(float v) { return __builtin_amdgcn_rcpf(1.0f + __builtin_amdgcn_exp2f(-1.4426950408889634f * v)); }
__device__ __forceinline__ f32x4 sigmoid4(f32x4 v) { f32x4 o; o[0] = sigmoidf_(v[0]); o[1] = sigmoidf_(v[1]); o[2] = sigmoidf_(v[2]); o[3] = sigmoidf_(v[3]); return o; }

typedef f32x4 AccT[2][2][4][2];
#define EPI_LOOP_AM _Pragma("unroll") for (int ai = 0; ai < 2; ++ai) _Pragma("unroll") for (int m = 0; m < 4; ++m)
#define EPI_LOOP_B _Pragma("unroll") for (int bj = 0; bj < 2; ++bj)

struct EpiIn {
    static constexpr bool PERM = true;
    float* C1; bf16_t* U; bf16_t* G; const float* bgate;
    __device__ __forceinline__ void operator()(const AccT& acc, const Unit& u, int wr, int wc, int fr, int fq) const {
        const int row0 = u.pm * BM + wr * 64 + fr, pn = u.pn, cw = wc * 32 + 8 * fq;
        if (pn < 4) {
            EPI_LOOP_AM { float* rp = C1 + (size_t)(row0 + ai * HALF + m * 16) * 1024 + pn * 256 + cw;
                EPI_LOOP_B { *(f32x4*)(rp + bj * HALF) = acc[ai][bj][m][0]; *(f32x4*)(rp + bj * HALF + 4) = acc[ai][bj][m][1]; } }
        } else if (pn < 8) {
            EPI_LOOP_AM { bf16_t* rp = U + (size_t)(row0 + ai * HALF + m * 16) * 1024 + (pn - 4) * 256 + cw;
                EPI_LOOP_B { *(u32x4*)(rp + bj * HALF) = pack8(acc[ai][bj][m][0], acc[ai][bj][m][1]); } }
        } else {
            const int gc = (pn - 8) * 256 + cw; f32x4 bv[2][2];
            EPI_LOOP_B { bv[bj][0] = *(const f32x4*)(bgate + gc + bj * HALF); bv[bj][1] = *(const f32x4*)(bgate + gc + bj * HALF + 4); }
            EPI_LOOP_AM { bf16_t* rp = G + (size_t)(row0 + ai * HALF + m * 16) * 4096 + gc;
                EPI_LOOP_B { *(u32x4*)(rp + bj * HALF) = pack8(sigmoid4(acc[ai][bj][m][0] + bv[bj][0]), sigmoid4(acc[ai][bj][m][1] + bv[bj][1])); } }
        }
    }
};
struct EpiKRP {
    static constexpr bool PERM = true;
    float* KRP;
    __device__ __forceinline__ void operator()(const AccT& acc, const Unit& u, int wr, int wc, int fr, int fq) const {
        const int row0 = u.pm * BM + wr * 64 + fr, cw = wc * 32 + 8 * fq;
        if (wc < 2) { EPI_LOOP_AM { float* rp = KRP + ((size_t)u.pn * 8192 + (row0 + ai * HALF + m * 16)) * 64 + cw; *(f32x4*)rp = acc[ai][0][m][0]; *(f32x4*)(rp + 4) = acc[ai][0][m][1]; } }
    }
};
struct EpiBf16 {
    static constexpr bool PERM = true;
    bf16_t* O; int ldc;
    __device__ __forceinline__ void operator()(const AccT& acc, const Unit& u, int wr, int wc, int fr, int fq) const {
        const int row0 = u.pm * BM + wr * 64 + fr, col0 = u.pn * BM + wc * 32 + 8 * fq;
        EPI_LOOP_AM { bf16_t* rp = O + (size_t)(row0 + ai * HALF + m * 16) * ldc + col0;
            EPI_LOOP_B { *(u32x4*)(rp + bj * HALF) = pack8(acc[ai][bj][m][0], acc[ai][bj][m][1]); } }
    }
};
struct EpiKV {
    static constexpr bool PERM = true;
    bf16_t* K; bf16_t* V;
    __device__ __forceinline__ void operator()(const AccT& acc, const Unit& u, int wr, int wc, int fr, int fq) const {
        const int row0 = u.pm * BM + wr * 64 + fr, cw = wc * 32 + 8 * fq, h = u.pn;
        EPI_LOOP_AM { const size_t row = (size_t)(row0 + ai * HALF + m * 16);
            *(u32x4*)(K + row * 3072 + h * 192 + cw) = pack8(acc[ai][0][m][0], acc[ai][0][m][1]);
            *(u32x4*)(V + row * 2048 + h * 128 + cw) = pack8(acc[ai][1][m][0], acc[ai][1][m][1]); }
    }
};
struct EpiScale {
    static constexpr bool PERM = true;
    bf16_t* O; int ldc; const float* scale;
    __device__ __forceinline__ void operator()(const AccT& acc, const Unit& u, int wr, int wc, int fr, int fq) const {
        const int row0 = u.pm * BM + wr * 64 + fr, col0 = u.pn * BM + wc * 32 + 8 * fq; f32x4 sv[2][2];
        EPI_LOOP_B { sv[bj][0] = *(const f32x4*)(scale + col0 + bj * HALF); sv[bj][1] = *(const f32x4*)(scale + col0 + bj * HALF + 4); }
        EPI_LOOP_AM { bf16_t* rp = O + (size_t)(row0 + ai * HALF + m * 16) * ldc + col0;
            EPI_LOOP_B { *(u32x4*)(rp + bj * HALF) = pack8(acc[ai][bj][m][0] * sv[bj][0], acc[ai][bj][m][1] * sv[bj][1]); } }
    }
};
template <bool HAS_ADD> struct EpiGate {
    static constexpr bool PERM = true;
    bf16_t* O; const bf16_t* gate; const bf16_t* add; int gcol0;
    __device__ __forceinline__ void operator()(const AccT& acc, const Unit& u, int wr, int wc, int fr, int fq) const {
        const int row0 = u.pm * BM + wr * 64 + fr, col0 = u.pn * BM + wc * 32 + 8 * fq;
        EPI_LOOP_AM { const size_t row = (size_t)(row0 + ai * HALF + m * 16);
            EPI_LOOP_B { f32x4 g0, g1; unpack8(*(const u32x4*)(gate + row * 4096 + gcol0 + col0 + bj * HALF), g0, g1);
                f32x4 v0 = g0 * acc[ai][bj][m][0], v1 = g1 * acc[ai][bj][m][1];
                if (HAS_ADD) { f32x4 a0, a1; unpack8(*(const u32x4*)(add + row * 2048 + col0 + bj * HALF), a0, a1); v0 += a0; v1 += a1; }
                *(u32x4*)(O + row * 2048 + col0 + bj * HALF) = pack8(v0, v1); } }
    }
};
struct EpiRes {
    static constexpr bool PERM = false;
    const float* base; float* out; int ldc;
    __device__ __forceinline__ void operator()(const AccT& acc, const Unit& u, int wr, int wc, int fr, int fq) const {
        const int row0 = u.pm * BM + wr * 64 + fr, col0 = u.pn * BM + wc * 32 + 4 * fq;
        EPI_LOOP_AM { const size_t off = (size_t)(row0 + ai * HALF + m * 16) * ldc + col0;
            EPI_LOOP_B {
#pragma unroll
                for (int n = 0; n < 2; ++n) { const f32x4 b = *(const f32x4*)(base + off + bj * HALF + n * 16); *(f32x4*)(out + off + bj * HALF + n * 16) = b + acc[ai][bj][m][n]; } } }
    }
};
struct EpiResNorm {
    static constexpr bool PERM = false;
    const float* base; float* out; bf16_t* outb; float* ss; int ldc;
    __device__ __forceinline__ void operator()(const AccT& acc, const Unit& u, int wr, int wc, int fr, int fq) const {
        const int row0 = u.pm * BM + wr * 64 + fr, col0 = u.pn * BM + wc * 32 + 4 * fq;
        EPI_LOOP_AM { const int row = row0 + ai * HALF + m * 16; const size_t off = (size_t)row * ldc + col0; float s = 0.f;
            EPI_LOOP_B {
#pragma unroll
                for (int n = 0; n < 2; ++n) { const f32x4 v = *(const f32x4*)(base + off + bj * HALF + n * 16) + acc[ai][bj][m][n]; *(f32x4*)(out + off + bj * HALF + n * 16) = v;
                    typedef unsigned u32x2_ __attribute__((ext_vector_type(2))); u32x2_ w; w.x = cvt_pk_bf16(v[0], v[1]); w.y = cvt_pk_bf16(v[2], v[3]); *(u32x2_*)(outb + off + bj * HALF + n * 16) = w;
                    s += (v[0] * v[0] + v[1] * v[1]) + (v[2] * v[2] + v[3] * v[3]); } }
            s += __shfl_xor(s, 16); s += __shfl_xor(s, 32);
            if (fq == 0) atomicAdd(ss + row, s); }
    }
};
struct EpiSwiGLU {
    static constexpr bool PERM = true;
    bf16_t* O; int ldc; const float* ss;
    __device__ __forceinline__ void operator()(const AccT& acc, const Unit& u, int wr, int wc, int fr, int fq) const {
        const int row0 = u.pm * BM + wr * 64 + fr, col0 = u.pn * HALF + wc * 32 + 8 * fq;
        EPI_LOOP_AM { const int row = row0 + ai * HALF + m * 16; bf16_t* rp = O + (size_t)row * ldc + col0;
            const float inv = 1.0f / sqrtf(ss[row] * (1.f / 2048.f) + 1e-6f);
            const f32x4 g0 = acc[ai][0][m][0] * inv, g1 = acc[ai][0][m][1] * inv;
            *(u32x4*)rp = pack8(g0 * sigmoid4(g0) * (acc[ai][1][m][0] * inv), g1 * sigmoid4(g1) * (acc[ai][1][m][1] * inv)); }
    }
};

template <class Epi, class Sched, bool ALIGN_EPI = true>
__device__ __forceinline__ void gemm_phase(PG8_LAS unsigned char* lds, const Gemm g, const Sched& S, const Epi& E) {
    const int tid = threadIdx.x, wid = __builtin_amdgcn_readfirstlane(tid >> 6), lane = tid & 63, wr = wid >> 2, wc = wid & 3, fr = lane & 15, fq = lane >> 4;
    const int K = g.K, nt = K / BK;
    unsigned voffA[2], voffB[2];
#pragma unroll
    for (int i = 0; i < 2; ++i) { int R, C; stage_rc(tid * 16 + i * 8192, R, C); const int Rb = Epi::PERM ? ((R & ~31) + perm32(R & 31)) : R;
        voffA[i] = (unsigned)(R * g.lda + C) * 2u; voffB[i] = (unsigned)(Rb * g.ldb + C) * 2u; }
    const size_t kstep = (size_t)(BK * 2);
    const size_t hstepA = (size_t)HALF * g.lda * 2, hstepB = (size_t)HALF * g.ldb * 2;
    const size_t tstepA = 2 * hstepA, tstepB = g.b_pn_step ? (size_t)g.b_pn_step * 2 : 2 * hstepB, pstepA = (size_t)g.a_pn_step * 2;
    const unsigned ldsw = (unsigned)wid * 1024u;
    const int aoff = lds_byte(wr * 64 + fr, fq * 8), boff = lds_byte(wc * 32 + fr, fq * 8);
#define PG8_SA(b, h) (((b) * 2 + (h)) * HTB)
#define PG8_SB(b, h) ((4 + (b) * 2 + (h)) * HTB)
#define PG8_STAGE(bufoff, gbase, voff) do { _Pragma("unroll") for (int _i = 0; _i < 2; ++_i) \
        __builtin_amdgcn_global_load_lds((const unsigned*)((const char*)(gbase) + (voff)[_i]), (PG8_LAS unsigned*)(lds + (bufoff) + ldsw + _i * 8192), 16, 0, 0); } while (0)
#define PG8_LDA(dst, b, h) do { _Pragma("unroll") for (int m = 0; m < 4; ++m) _Pragma("unroll") for (int k = 0; k < 2; ++k) dst[m][k] = *(const PG8_LAS bf16x8*)(lds + PG8_SA(b, h) + aoff + m * 2048 + k * 1024); } while (0)
#define PG8_LDB(dst, b, h) do { _Pragma("unroll") for (int n = 0; n < 2; ++n) _Pragma("unroll") for (int k = 0; k < 2; ++k) dst[n][k] = *(const PG8_LAS bf16x8*)(lds + PG8_SB(b, h) + boff + n * 2048 + k * 1024); } while (0)
#define PG8_MMA(ai, bj, At, Bt) do { __builtin_amdgcn_s_setprio(1); _Pragma("unroll") for (int m = 0; m < 4; ++m) _Pragma("unroll") for (int n = 0; n < 2; ++n) _Pragma("unroll") for (int k = 0; k < 2; ++k) \
        acc[ai][bj][m][n] = __builtin_amdgcn_mfma_f32_16x16x32_bf16(Bt[n][k], At[m][k], acc[ai][bj][m][n], 0, 0, 0); __builtin_amdgcn_s_setprio(0); } while (0)
#define PG8_WAIT_V(n) asm volatile("s_waitcnt vmcnt(" #n ")" ::: "memory")
#define PG8_WAIT_L(n) asm volatile("s_waitcnt lgkmcnt(" #n ")" ::: "memory")
#define PG8_BAR __builtin_amdgcn_s_barrier()
#define PG8_SCHED __builtin_amdgcn_sched_barrier(0)
    Unit cur, nxt; int ui = 0;
    if (!S.next(0, cur)) return;
    f32x4 acc[2][2][4][2];
#pragma unroll
    for (int a = 0; a < 2; ++a)
#pragma unroll
        for (int b = 0; b < 2; ++b)
#pragma unroll
            for (int m = 0; m < 4; ++m)
#pragma unroll
                for (int n = 0; n < 2; ++n) acc[a][b][m][n] = (f32x4){0.f, 0.f, 0.f, 0.f};
    bf16x8 At[4][2], B0[2][2], B1[2][2];
    const char* cA = (const char*)g.A + (size_t)cur.pm * tstepA + (size_t)cur.pn * pstepA; const char* cB = (const char*)g.Bt + (size_t)cur.pn * tstepB;
    PG8_STAGE(PG8_SB(0, 0), cB, voffB); PG8_STAGE(PG8_SB(0, 1), cB + hstepB, voffB); PG8_STAGE(PG8_SA(0, 0), cA, voffA); PG8_STAGE(PG8_SA(0, 1), cA + hstepA, voffA);
    if (wr == 1) PG8_BAR;
    PG8_WAIT_V(2); PG8_BAR;
    PG8_STAGE(PG8_SB(1, 0), cB + kstep, voffB); PG8_STAGE(PG8_SA(1, 0), cA + kstep, voffA); PG8_STAGE(PG8_SB(1, 1), cB + hstepB + kstep, voffB);
    PG8_WAIT_V(6); PG8_BAR;
    for (;;) {
        const bool has_next = S.next(ui + 1, nxt);
        const char* nA = has_next ? (const char*)g.A + (size_t)nxt.pm * tstepA + (size_t)nxt.pn * pstepA : cA; const char* nB = has_next ? (const char*)g.Bt + (size_t)nxt.pn * tstepB : cB;
        for (int t = 0; t < nt; t += 2) {
            const bool last = (t == nt - 2);
            const char* a1 = cA + (size_t)(t + 1) * kstep;
            const char* a2 = last ? nA : cA + (size_t)(t + 2) * kstep; const char* b2 = last ? nB : cB + (size_t)(t + 2) * kstep;
            const char* a3 = a2 + kstep; const char* b3 = b2 + kstep;
            PG8_LDB(B0, 0, 0); PG8_LDB(B1, 0, 1); PG8_SCHED; PG8_LDA(At, 0, 0); PG8_STAGE(PG8_SA(1, 1), a1 + hstepA, voffA);
            PG8_WAIT_V(8); PG8_WAIT_L(0); PG8_BAR; PG8_MMA(0, 0, At, B0); PG8_MMA(0, 1, At, B1); PG8_BAR; PG8_SCHED;
            PG8_LDA(At, 0, 1); PG8_STAGE(PG8_SB(0, 0), b2, voffB); PG8_STAGE(PG8_SB(0, 1), b2 + hstepB, voffB); PG8_STAGE(PG8_SA(0, 0), a2, voffA);
            PG8_WAIT_V(8); PG8_WAIT_L(0); PG8_BAR; PG8_MMA(1, 0, At, B0); PG8_MMA(1, 1, At, B1); PG8_BAR; PG8_SCHED;
            PG8_LDB(B0, 1, 0); PG8_LDB(B1, 1, 1); PG8_SCHED; PG8_LDA(At, 1, 0); PG8_STAGE(PG8_SA(0, 1), a2 + hstepA, voffA);
            PG8_WAIT_V(8); PG8_WAIT_L(0); PG8_BAR; PG8_MMA(0, 0, At, B0); PG8_MMA(0, 1, At, B1); PG8_BAR; PG8_SCHED;
            PG8_LDA(At, 1, 1); PG8_STAGE(PG8_SB(1, 0), b3, voffB); PG8_STAGE(PG8_SB(1, 1), b3 + hstepB, voffB); PG8_STAGE(PG8_SA(1, 0), a3, voffA);
            PG8_WAIT_V(8); PG8_WAIT_L(0); PG8_BAR; PG8_MMA(1, 0, At, B0); PG8_MMA(1, 1, At, B1); PG8_BAR; PG8_SCHED;
        }
        if constexpr (ALIGN_EPI) { if (wr == 0) PG8_BAR; }
        E(acc, cur, wr, wc, fr, fq);
        if (!has_next) break;
#pragma unroll
        for (int a = 0; a < 2; ++a)
#pragma unroll
            for (int b = 0; b < 2; ++b)
#pragma unroll
                for (int m = 0; m < 4; ++m)
#pragma unroll
                    for (int n = 0; n < 2; ++n) acc[a][b][m][n] = (f32x4){0.f, 0.f, 0.f, 0.f};
        cur = nxt; cA = nA; cB = nB; ++ui;
        if constexpr (ALIGN_EPI) { if (wr == 1) PG8_BAR; }
    }
    PG8_WAIT_V(0);
    if constexpr (!ALIGN_EPI) { if (wr == 0) PG8_BAR; }
    PG8_BAR;
#undef PG8_SA
#undef PG8_SB
#undef PG8_STAGE
#undef PG8_LDA
#undef PG8_LDB
#undef PG8_MMA
#undef PG8_WAIT_V
#undef PG8_WAIT_L
#undef PG8_BAR
#undef PG8_SCHED
}
}

constexpr int BATCH = 2, SEQ = 4096, DM = 2048, M = BATCH * SEQ;
constexpr int NH = 16, DQK = 192, DNOPE = 128, DROPE = 64, DV = 128, QLORA = 512, KVLORA = 512;
constexpr int POOLW = 1024, DIN = 6208, DIN_PAD = 6400, DFF = 5632;
constexpr float EPS = 1e-6f;
constexpr int NWAVES = 8;

typedef unsigned short bf16;
typedef unsigned v4u __attribute__((ext_vector_type(4)));
typedef unsigned v2u __attribute__((ext_vector_type(2)));
typedef float f32x4 __attribute__((ext_vector_type(4)));
typedef short bf16x8 __attribute__((ext_vector_type(8)));
typedef short s16x4 __attribute__((ext_vector_type(4)));
typedef float f32x16 __attribute__((ext_vector_type(16)));
#define LAS __attribute__((address_space(3)))
#define LDS_WAIT() asm volatile("s_waitcnt lgkmcnt(0)" ::: "memory")

constexpr size_t MiB = 1u << 20;
constexpr size_t WS_WAO = 1 * MiB, WS_WOUT = 9 * MiB, WS_WPO = 17 * MiB, WS_WQB = 21 * MiB, WS_WKVB = 24 * MiB, WS_WPG = 28 * MiB, WS_KR = 29 * MiB;
constexpr size_t WS_G = 31 * MiB;
constexpr size_t WS_WIN = 95 * MiB, WS_XN = 120 * MiB, WS_C1 = 152 * MiB, WS_U = 184 * MiB;
constexpr size_t WS_Q = 95 * MiB, WS_K = 143 * MiB, WS_V = 191 * MiB, WS_CN = 223 * MiB, WS_POOLED = 239 * MiB, WS_PG = 255 * MiB;
constexpr size_t WS_MP = 223 * MiB, WS_O = 255 * MiB, WS_MIXED = 95 * MiB, WS_X1 = 127 * MiB, WS_H2 = 95 * MiB;
constexpr size_t WS_WGU = 191 * MiB, WS_WDN = 235 * MiB, WS_ACT = 1 * MiB;
constexpr size_t WS_END = 296 * MiB, WS_BAR = 512 * 1024, WS_KRP = 272 * MiB, WS_X1B = 257 * MiB;
constexpr int SV_BGATE = 0, SV_QAG = 4096, SV_KVAG = 4608, SV_QNG = 5120, SV_KNG = 5376, SV_PSC = 5632, SV_FNG = 6656, SV_POS = 8704, SV_END = 8704 + 8192, SV_SS = 32768;

constexpr int LDS_BYTES = 147456;

__device__ __forceinline__ unsigned cvtpk(float lo, float hi) { return pg8::cvt_pk_bf16(lo, hi); }
__device__ __forceinline__ float bflo(unsigned w) { return __uint_as_float(w << 16); }
__device__ __forceinline__ float bfhi(unsigned w) { return __uint_as_float(w & 0xffff0000u); }
__device__ __forceinline__ float wave_sum(float v) {
#pragma unroll
    for (int o = 1; o < 64; o <<= 1) v += __shfl_xor(v, o);
    return v;
}

__device__ __forceinline__ int dst_row(int mode, int n0) {
    if (mode == 1) { if (n0 < 1024) return n0; if (n0 < 1088) return 6144 + (n0 - 1024); if (n0 < 2112) return 1024 + (n0 - 1088); return 2048 + (n0 - 2112); }
    if (mode == 2) return (n0 >> 7) * 256 + (n0 & 127);
    if (mode == 3) return (n0 >> 7) * 256 + 128 + (n0 & 127);
    return n0;
}
__device__ __forceinline__ void transpose_item(const float* W, int K, int N, bf16* WT, int mode, int row_off, LAS float* scr, int item, int lane, const float* gk = nullptr) {
    const int nblk = N / 32, kb = item / nblk, nb = item % nblk, k0 = 64 * kb, n0 = 32 * nb;
    { float tv[32]; const float* wp = W + (size_t)(k0 + (lane >> 5)) * N + n0 + (lane & 31);
#pragma unroll
      for (int i = 0; i < 32; ++i) tv[i] = wp[(size_t)(2 * i) * N];
      if (gk) {
#pragma unroll
          for (int i = 0; i < 32; ++i) tv[i] *= gk[k0 + 2 * i + (lane >> 5)]; }
#pragma unroll
      for (int i = 0; i < 32; ++i) scr[(2 * i + (lane >> 5)) * 33 + (lane & 31)] = tv[i]; }
    LDS_WAIT(); asm volatile("" ::: "memory");
    const int c = lane & 7, dr = row_off + dst_row(mode, n0);
#pragma unroll
    for (int j = 0; j < 4; ++j) { const int n = (lane >> 3) + 8 * j; const LAS float* s = scr + (8 * c) * 33 + n;
        v4u o; o.x = cvtpk(s[0 * 33], s[1 * 33]); o.y = cvtpk(s[2 * 33], s[3 * 33]); o.z = cvtpk(s[4 * 33], s[5 * 33]); o.w = cvtpk(s[6 * 33], s[7 * 33]);
        *(v4u*)(WT + (size_t)(dr + n) * K + k0 + 8 * c) = o; }
    LDS_WAIT(); asm volatile("" ::: "memory");
}

__device__ __forceinline__ void rms_row_2048(const float* xrow, const float* g, bf16* orow, int lane) {
    const f32x4* xr = (const f32x4*)xrow + lane; const f32x4* gr = (const f32x4*)g + lane;
    f32x4 v[8]; float s = 0.f;
#pragma unroll
    for (int j = 0; j < 8; ++j) { v[j] = xr[64 * j]; s += (v[j].x * v[j].x + v[j].y * v[j].y) + (v[j].z * v[j].z + v[j].w * v[j].w); }
    const float inv = 1.0f / sqrtf(wave_sum(s) * (1.f / 2048.f) + EPS);
    v2u* o8 = (v2u*)orow + lane;
#pragma unroll
    for (int j = 0; j < 8; ++j) { const f32x4 gv = gr[64 * j]; v2u o; o.x = cvtpk(v[j].x * inv * gv.x, v[j].y * inv * gv.y); o.y = cvtpk(v[j].z * inv * gv.z, v[j].w * inv * gv.w); o8[64 * j] = o; }
}

namespace att {
constexpr int QBLK = 32, KVBLK = 64, QB = 256;
constexpr int SHM_V = KVBLK * DV * 2, SHM_K = KVBLK * DQK * 2;
constexpr int OFF_V = 0, OFF_K = 2 * SHM_V, OFF_WS = OFF_K + 2 * SHM_K;
constexpr float SCALE = 0.07216878364870322f;
constexpr float THR = 8.f;
#define KSWZ(row, colB) ((row) * 384 + ((colB) ^ (((row) & 7) << 4)))
#define SBAR() __builtin_amdgcn_sched_barrier(0)
__device__ __forceinline__ int v_st(int k, int c) { const int kk = (k & ~0xC) | ((k & 4) << 1) | ((k & 8) >> 1); return ((kk >> 3) * 4 + (c >> 5)) * 512 + ((kk & 7) * 32 + (c & 31)) * 2; }
__device__ __forceinline__ int v_rd_base(int lane) { return ((lane & 3) << 3) | (((lane >> 2) & 3) << 6) | (((lane >> 4) & 1) << 5) | (((lane >> 5) & 1) << 8); }
__device__ __forceinline__ int crow(int r, int hi) { return (r & 3) + 8 * (r >> 2) + 4 * hi; }
__device__ __forceinline__ void mask_tile(f32x16& p0, f32x16& p1, int dq) {
    const float NEG = -__builtin_inff();
#pragma unroll
    for (int r = 0; r < 16; ++r) {
        const int c = (r & 3) + 8 * (r >> 2);
        if (dq - c < 0) p0[r] = NEG;
        if (dq - c - 32 < 0) p1[r] = NEG;
    }
}
__device__ __forceinline__ void partialSM(f32x16& p0, f32x16& p1, float& m_reg, float& mn, float& alpha) {
    float pmax = p0[0];
#pragma unroll
    for (int r = 1; r < 16; ++r) pmax = fmaxf(pmax, p0[r]);
#pragma unroll
    for (int r = 0; r < 16; ++r) pmax = fmaxf(pmax, p1[r]);
    { auto rr = __builtin_amdgcn_permlane32_swap(__float_as_uint(pmax), __float_as_uint(pmax), false, false);
      pmax = fmaxf(__uint_as_float(rr[0]), __uint_as_float(rr[1])); }
    constexpr float C2 = 1.4426950408889634f * SCALE;
    if (__builtin_expect(__all((pmax - m_reg) * SCALE <= THR), 1)) { mn = m_reg; alpha = 1.f; }
    else { mn = fmaxf(m_reg, pmax); alpha = __builtin_amdgcn_exp2f((m_reg - mn) * C2); m_reg = mn; }
    const float mnL = -mn * C2;
#pragma unroll
    for (int r = 0; r < 16; ++r) p0[r] = fmaf(p0[r], C2, mnL);
#pragma unroll
    for (int r = 0; r < 16; ++r) p1[r] = fmaf(p1[r], C2, mnL);
#pragma unroll
    for (int r = 0; r < 16; ++r) p0[r] = __builtin_amdgcn_exp2f(p0[r]);
}
__device__ __forceinline__ void finishSM(f32x16& p0, f32x16& p1, float alpha, float& l_reg, bf16x8& pa0, bf16x8& pa1, bf16x8& pa2, bf16x8& pa3) {
#pragma unroll
    for (int r = 0; r < 16; ++r) p1[r] = __builtin_amdgcn_exp2f(p1[r]);
    float ps = 0;
#pragma unroll
    for (int r = 0; r < 16; ++r) ps += p0[r];
#pragma unroll
    for (int r = 0; r < 16; ++r) ps += p1[r];
    { auto rr = __builtin_amdgcn_permlane32_swap(__float_as_uint(ps), __float_as_uint(ps), false, false);
      ps = __uint_as_float(rr[0]) + __uint_as_float(rr[1]); }
    l_reg = l_reg * alpha + ps;
#define PK4(P, B_, OUT) do { unsigned a0 = cvtpk(P[B_+0], P[B_+1]), a1 = cvtpk(P[B_+2], P[B_+3]);                          \
        unsigned b0 = cvtpk(P[B_+4], P[B_+5]), b1 = cvtpk(P[B_+6], P[B_+7]);                                             \
        auto r0 = __builtin_amdgcn_permlane32_swap(a0, b0, false, false); auto r1 = __builtin_amdgcn_permlane32_swap(a1, b1, false, false); \
        v4u w = {r0[0], r1[0], r0[1], r1[1]}; OUT = *reinterpret_cast<bf16x8*>(&w); } while (0)
    PK4(p0, 0, pa0); PK4(p0, 8, pa1); PK4(p1, 0, pa2); PK4(p1, 8, pa3);
#undef PK4
}
__device__ __forceinline__ void qkt(f32x16& p0, f32x16& p1, const char* Kb, int r32, int hi, const bf16x8* qr) {
    p0 = f32x16{}; p1 = f32x16{};
    const char* kb[4];
#pragma unroll
    for (int dd = 0; dd < 4; ++dd) kb[dd] = Kb + KSWZ(r32, (dd * 16 + hi * 8) * 2);
#pragma unroll
    for (int d0 = 0; d0 < 12; ++d0) { const char* a = kb[d0 & 3] + (d0 >> 2) * 128;
        bf16x8 b0 = *reinterpret_cast<const bf16x8*>(a);
        bf16x8 b1 = *reinterpret_cast<const bf16x8*>(a + 32 * 384);
        p0 = __builtin_amdgcn_mfma_f32_32x32x16_bf16(b0, qr[d0], p0, 0, 0, 0);
        p1 = __builtin_amdgcn_mfma_f32_32x32x16_bf16(b1, qr[d0], p1, 0, 0, 0); }
}
__device__ __forceinline__ void pv_tile(f32x16* o, int vb0, bf16x8 pa0, bf16x8 pa1, bf16x8 pa2, bf16x8 pa3) {
#define TRRD(dst, off) asm volatile("ds_read_b64_tr_b16 %0, %1 offset:%2" : "=&v"(dst) : "v"(vb0), "i"(off) : "memory")
#define PV_D0(d0) do { s16x4 l0, l1, l2, l3, h0, h1, h2, h3; constexpr int b_ = (d0) * 512; \
        TRRD(l0, b_); TRRD(h0, b_ + 2048); TRRD(l1, b_ + 4096); TRRD(h1, b_ + 6144); TRRD(l2, b_ + 8192); TRRD(h2, b_ + 10240); TRRD(l3, b_ + 12288); TRRD(h3, b_ + 14336); \
        asm volatile("s_waitcnt lgkmcnt(0)" ::: "memory"); SBAR(); \
        o[d0] = __builtin_amdgcn_mfma_f32_32x32x16_bf16(pa0, (bf16x8){l0[0], l0[1], l0[2], l0[3], h0[0], h0[1], h0[2], h0[3]}, o[d0], 0, 0, 0);   \
        o[d0] = __builtin_amdgcn_mfma_f32_32x32x16_bf16(pa1, (bf16x8){l1[0], l1[1], l1[2], l1[3], h1[0], h1[1], h1[2], h1[3]}, o[d0], 0, 0, 0);   \
        o[d0] = __builtin_amdgcn_mfma_f32_32x32x16_bf16(pa2, (bf16x8){l2[0], l2[1], l2[2], l2[3], h2[0], h2[1], h2[2], h2[3]}, o[d0], 0, 0, 0);   \
        o[d0] = __builtin_amdgcn_mfma_f32_32x32x16_bf16(pa3, (bf16x8){l3[0], l3[1], l3[2], l3[3], h3[0], h3[1], h3[2], h3[3]}, o[d0], 0, 0, 0); } while (0)
    PV_D0(0); PV_D0(1); PV_D0(2); PV_D0(3);
#undef PV_D0
#undef TRRD
}
__device__ __forceinline__ void attn_unit(int b, int h, int qb, const bf16* Q, const bf16* K, const bf16* V, bf16* O, char* lds) {
    const int tid = threadIdx.x, wid = __builtin_amdgcn_readfirstlane(tid >> 6), lane = tid & 63, r32 = lane & 31, hi = lane >> 5;
    const size_t rowb = (size_t)b * SEQ;
    const int q0 = qb * QB, qlo = q0 + wid * QBLK;
    const int NT = (q0 + QB) / KVBLK;
    char* V_lds = lds + OFF_V; char* K_lds = lds + OFF_K;
    float* ws = (float*)(lds + OFF_WS) + wid * 64; float* li_l = ws; float* al_l = ws + 32;
    int koff[3], kws[3];
#pragma unroll
    for (int i = 0; i < 3; ++i) { const int c = tid + 512 * i, kr_ = c / 24, kc_ = c % 24; koff[i] = kr_ * 3072 + kc_ * 8; kws[i] = KSWZ(kr_, kc_ * 16); }
    const int sr = tid >> 4, sc = (tid & 15) * 8, vst0 = v_st(sr, sc), vst1 = v_st(32 + sr, sc);
    const bf16* Kh = K + rowb * 3072 + h * DQK; const bf16* Vh = V + rowb * 2048 + h * DV + (size_t)sr * 2048 + sc;
    bf16x8 sk[3];
#define KLOAD(k0) do { _Pragma("unroll") for (int i = 0; i < 3; ++i) sk[i] = *(const bf16x8*)(Kh + (size_t)(k0) * 3072 + koff[i]); } while (0)
#define KWRITE(bf) do { _Pragma("unroll") for (int i = 0; i < 3; ++i) *(bf16x8*)(K_lds + (bf) * SHM_K + kws[i]) = sk[i]; } while (0)
#define VLOAD(k0) do { sk[0] = *(const bf16x8*)(Vh + (size_t)(k0) * 2048); sk[1] = *(const bf16x8*)(Vh + (size_t)((k0) + 32) * 2048); } while (0)
#define VWRITE(bf) do { *(bf16x8*)(V_lds + (bf) * SHM_V + vst0) = sk[0]; *(bf16x8*)(V_lds + (bf) * SHM_V + vst1) = sk[1]; } while (0)
    KLOAD(0);
    bf16x8 qr[12];
    { const bf16* Qp = Q + (rowb + qlo + r32) * 3072 + h * DQK + hi * 8;
#pragma unroll
      for (int d0 = 0; d0 < 12; ++d0) qr[d0] = *(const bf16x8*)(Qp + d0 * 16); }
    asm volatile("s_waitcnt vmcnt(0)" ::: "memory");
    KWRITE(0); SBAR(); VLOAD(0);
    asm volatile("s_waitcnt vmcnt(0)" ::: "memory");
    VWRITE(0);
    __syncthreads();
    float m_reg = -1e30f, l_reg = 0.f; f32x16 o[4] = {};
    const int vbase = (int)(uintptr_t)V_lds + v_rd_base(lane);
    const int qm = qlo + r32 - 4 * hi;
    for (int t = 0; t < NT; ++t) {
        const int cur = t & 1, kb_ = t * KVBLK;
        if (t + 1 < NT) KLOAD((t + 1) * KVBLK);
        SBAR();
        f32x16 p0, p1; float mn, alpha; bf16x8 pa0, pa1, pa2, pa3;
        qkt(p0, p1, K_lds + cur * SHM_K, r32, hi, qr);
        if (kb_ + KVBLK - 1 > qlo) mask_tile(p0, p1, qm - kb_);
        partialSM(p0, p1, m_reg, mn, alpha);
        finishSM(p0, p1, alpha, l_reg, pa0, pa1, pa2, pa3);
        if (__any(alpha < 1.f)) { if (hi == 0) al_l[r32] = alpha; asm volatile("s_waitcnt lgkmcnt(0)" ::: "memory");
#pragma unroll
            for (int d_ = 0; d_ < 4; ++d_)
#pragma unroll
                for (int r = 0; r < 16; ++r) o[d_][r] *= al_l[crow(r, hi)]; }
        SBAR();
        if (t + 1 < NT) { asm volatile("s_waitcnt vmcnt(0)" ::: "memory"); KWRITE(cur ^ 1); SBAR(); VLOAD((t + 1) * KVBLK); }
        SBAR();
        pv_tile(o, vbase + cur * SHM_V, pa0, pa1, pa2, pa3);
        if (t + 1 < NT) { asm volatile("s_waitcnt vmcnt(0)" ::: "memory"); VWRITE(cur ^ 1); }
        __syncthreads();
    }
    if (hi == 0) li_l[r32] = l_reg; asm volatile("s_waitcnt lgkmcnt(0)" ::: "memory");
    float rli[16];
#pragma unroll
    for (int r = 0; r < 16; ++r) rli[r] = __builtin_amdgcn_rcpf(li_l[crow(r, hi)]);
    bf16* Ow = O + (rowb + qlo) * 2048 + h * DV;
#pragma unroll
    for (int r = 0; r < 16; ++r) { const int orow = crow(r, hi);
#pragma unroll
        for (int d0 = 0; d0 < 4; ++d0) { const float v = o[d0][r] * rli[r];
            const float vn = __shfl_xor(v, 1);
            if ((r32 & 1) == 0) *(unsigned*)(Ow + (size_t)orow * 2048 + d0 * 32 + r32) = cvtpk(v, vn); } }
    __syncthreads();
#undef KLOAD
#undef KWRITE
#undef VLOAD
#undef VWRITE
}
#undef SBAR
}

struct Args { const float* in[20]; float* out; unsigned char* ws; int ph_lo, ph_hi, coop, pad; };
#define XB_TMO      128
#define XB_XCNT(j)  (256  + 64 * (j))
#define XB_XSUB(j)  (1280 + 64 * (j))
#define XB_XGEN(j)  (2304 + 64 * (j))
#define XB_TOP      3328
#define XB_TOPGEN   3392
#define XCD_BAR_WORDS 3456
#define XB_SPIN_CAP (1u << 20)
__device__ __forceinline__ unsigned xb_ld(unsigned* p)              { return __hip_atomic_load(p, __ATOMIC_RELAXED, __HIP_MEMORY_SCOPE_AGENT); }
__device__ __forceinline__ unsigned xb_add(unsigned* p, unsigned v) { return __hip_atomic_fetch_add(p, v, __ATOMIC_RELAXED, __HIP_MEMORY_SCOPE_AGENT); }
__device__ __forceinline__ unsigned xb_xcc_id() { return (unsigned)__builtin_amdgcn_s_getreg((3 << 11) | 20) & 0xFu; }
#define XB_SPIN(cond, bar) do { unsigned _sp = 0; while (cond) { __builtin_amdgcn_s_sleep(1); \
    if ((++_sp & 255u) == 0u) { if (xb_ld(&(bar)[XB_TMO])) break; if (_sp > XB_SPIN_CAP) { atomicAdd(&(bar)[XB_TMO], 1u); break; } } } } while (0)
__device__ __forceinline__ void xcd_barrier_complete(unsigned* bar, unsigned x, unsigned& nloc, unsigned& nx) {
    const unsigned G = gridDim.x;
    unsigned sum, cnt, mine, sp = 0u;
    for (;;) {
        sum = 0u; cnt = 0u; mine = 0u;
#pragma unroll
        for (unsigned j = 0; j < 16; ++j) { const unsigned c = xb_ld(&bar[XB_XCNT(j)]); sum += c; cnt += (c > 0u) ? 1u : 0u; mine = (j == x) ? c : mine; }
        if (sum == G) break;
        __builtin_amdgcn_s_sleep(1);
        if ((++sp & 255u) == 0u) { if (xb_ld(&bar[XB_TMO])) break; if (sp > XB_SPIN_CAP) { atomicAdd(&bar[XB_TMO], 1u); break; } }
    }
    nloc = mine > 0u ? mine : 1u; nx = cnt > 0u ? cnt : 1u;
}
__device__ __forceinline__ void grid_bar(unsigned* bar, volatile LAS unsigned* st) {
    asm volatile("s_waitcnt vmcnt(0)" ::: "memory");
    __syncthreads();
    if (threadIdx.x == 0) {
        const unsigned x = xb_xcc_id();
        __builtin_amdgcn_s_waitcnt(0);
        unsigned nloc = st[0], nx = st[1];
        if (nloc == 0u) { xcd_barrier_complete(bar, x, nloc, nx); st[0] = nloc; st[1] = nx; }
        const unsigned old = xb_add(&bar[XB_XSUB(x)], 1u);
        const unsigned gen = old / nloc;
        if (old + 1u == (gen + 1u) * nloc) {
            __builtin_amdgcn_fence(__ATOMIC_RELEASE, "agent");
            asm volatile("s_waitcnt vmcnt(0)" ::: "memory");
            const unsigned og = xb_add(&bar[XB_TOP], 1u);
            const unsigned tg = og / nx;
            if (og + 1u == (tg + 1u) * nx) xb_add(&bar[XB_TOPGEN], 1u);
            else XB_SPIN(xb_ld(&bar[XB_TOPGEN]) == tg, bar);
            __builtin_amdgcn_fence(__ATOMIC_ACQUIRE, "agent");
            xb_add(&bar[XB_XGEN(x)], 1u);
            asm volatile("s_waitcnt vmcnt(0)" ::: "memory");
        } else {
            XB_SPIN(xb_ld(&bar[XB_XGEN(x)]) == gen, bar);
            __builtin_amdgcn_fence(__ATOMIC_ACQUIRE, "agent");
            asm volatile("s_waitcnt vmcnt(0)" ::: "memory");
        }
    }
    __syncthreads();
}
constexpr int NPH = 11;

__global__ void __launch_bounds__(NWAVES * 64, 2) mega_fwd(Args args) {
    extern __shared__ __attribute__((aligned(16))) unsigned char lds[];
    LAS unsigned char* ldsl = (LAS unsigned char*)lds;
    const int tid = threadIdx.x, lane = tid & 63, wave = __builtin_amdgcn_readfirstlane(tid >> 6);
    const int G = gridDim.x, bx = blockIdx.x;
    const int vcu = (G % 8 == 0) ? (bx % 8) * (G / 8) + bx / 8 : bx;
    const int gw = vcu * NWAVES + wave, NGW = G * NWAVES;
    unsigned char* ws = args.ws;
    const float* const* kin = (const float* const*)__builtin_amdgcn_kernarg_segment_ptr();
    const float* svec = (const float*)ws;
    const float* b_gate = svec + SV_BGATE; const float* q_a_norm_g = svec + SV_QAG; const float* kv_a_norm_g = svec + SV_KVAG; const float* q_norm_g = svec + SV_QNG;
    const float* k_norm_g = svec + SV_KNG; const float* pool_scale = svec + SV_PSC; const float* ffn_norm_g = svec + SV_FNG; const int* positions = (const int*)(svec + SV_POS);
    bf16* WIN_T = (bf16*)(ws + WS_WIN); bf16* WQB_T = (bf16*)(ws + WS_WQB); bf16* WKVB_T = (bf16*)(ws + WS_WKVB); bf16* WPG_T = (bf16*)(ws + WS_WPG);
    bf16* WPO_T = (bf16*)(ws + WS_WPO); bf16* WAO_T = (bf16*)(ws + WS_WAO); bf16* WOUT_T = (bf16*)(ws + WS_WOUT); bf16* WGU_T = (bf16*)(ws + WS_WGU); bf16* WDN_T = (bf16*)(ws + WS_WDN);
    bf16* XN = (bf16*)(ws + WS_XN); float* C1 = (float*)(ws + WS_C1); float* KRP = (float*)(ws + WS_KRP); bf16* U = (bf16*)(ws + WS_U); bf16* Gt = (bf16*)(ws + WS_G);
    bf16* CN = (bf16*)(ws + WS_CN); bf16* POOLED = (bf16*)(ws + WS_POOLED); bf16* Qb = (bf16*)(ws + WS_Q); bf16* Kb = (bf16*)(ws + WS_K); bf16* Vb = (bf16*)(ws + WS_V);
    bf16* PG = (bf16*)(ws + WS_PG); bf16* MP = (bf16*)(ws + WS_MP); bf16* Ob = (bf16*)(ws + WS_O); bf16* MIXED = (bf16*)(ws + WS_MIXED);
    float* X1 = (float*)(ws + WS_X1); bf16* H2 = (bf16*)(ws + WS_H2); bf16* ACT = (bf16*)(ws + WS_ACT);

    const int lo = args.ph_lo, hi_ph = args.ph_hi;
#ifndef PHMASK
#define PHMASK 0x7ff
#endif
#define IN(k) (((PHMASK >> (k)) & 1) && lo <= (k) && (k) < hi_ph)
#define SEAM(k) do { if (IN(k) && IN((k) + 1)) { unsigned char* w2_ = args.ws; asm volatile("" : "+s"(w2_)); grid_bar((unsigned*)(w2_ + WS_BAR), (volatile LAS unsigned*)(ldsl + 140032)); } } while (0)
    if (args.coop > 1) cg::this_grid().sync();
    if (threadIdx.x < 2) ((volatile LAS unsigned*)(ldsl + 140032))[threadIdx.x] = 0u;
    __syncthreads();
    if (args.coop && threadIdx.x == 0) { unsigned char* w2_ = args.ws; asm volatile("" : "+s"(w2_)); (void)xb_add(&((unsigned*)(w2_ + WS_BAR))[XB_XCNT(xb_xcc_id())], 1u); }
    LAS float* scr = (LAS float*)(ldsl + wave * 16384);
#ifdef TPROBE
#define TP_BEGIN(k) do { if ((TPROBE >> (k)) & 1) { if (blockIdx.x == 0 && threadIdx.x == 0) { *(volatile LAS unsigned*)(ldsl + 140000) = (unsigned)__builtin_amdgcn_s_memrealtime(); } } } while (0)
#define TP_END(k) do { if ((TPROBE >> (k)) & 1) { if (blockIdx.x == 0 && threadIdx.x == 0) { volatile LAS unsigned* tp_ = (volatile LAS unsigned*)(ldsl + 140000); tp_[1] += (unsigned)__builtin_amdgcn_s_memrealtime() - tp_[0]; } } } while (0)
    if (blockIdx.x == 0 && threadIdx.x == 0) { ((volatile LAS unsigned*)(ldsl + 140000))[1] = 0u; }
#else
#define TP_BEGIN(k) do {} while (0)
#define TP_END(k) do {} while (0)
#endif

    if (IN(0)) { TP_BEGIN(0);
        { float* sv = (float*)ws; const int gt = bx * (NWAVES * 64) + tid, GT = G * NWAVES * 64;
          for (int i = gt; i < M; i += GT) sv[SV_SS + i] = 0.f;
          for (int i = gt; i < SV_END; i += GT) { int idx, off, lim = 1 << 30;
              if (i < SV_QAG) { idx = 4; off = SV_BGATE; } else if (i < SV_KVAG) { idx = 5; off = SV_QAG; } else if (i < SV_QNG) { idx = 7; off = SV_KVAG; }
              else if (i < SV_KNG) { idx = 9; off = SV_QNG; lim = 192; } else if (i < SV_PSC) { idx = 10; off = SV_KNG; lim = 192; }
              else if (i < SV_FNG) { idx = 13; off = SV_PSC; } else if (i < SV_POS) { idx = 16; off = SV_FNG; } else { idx = 1; off = SV_POS; }
              const float* src = kin[idx]; sv[i] = (i - off < lim) ? src[i - off] : 0.f; } }
        constexpr int I_IN = (DM / 64) * (DIN / 32), I_QB = (QLORA / 64) * (NH * DQK / 32), I_KVB = (KVLORA / 64) * (NH * 256 / 32), I_PG = (256 / 64) * (256 / 32),
                      I_PO = (POOLW / 64) * (DM / 32), I_AO = (DM / 64) * (DM / 32), I_OUT = I_AO;
        constexpr int NITEMS = I_IN + I_QB + I_KVB + 4 * I_PG + I_PO + I_AO + I_OUT;
        for (int it = gw; it < NITEMS; it += NGW) {
            int r = it, idx, Kd, Nd, mode = 0, roff = 0; size_t dsto, srco = 0;
            if (r < I_IN) { idx = 3; Kd = DM; Nd = DIN; mode = 1; dsto = WS_WIN; }
            else if ((r -= I_IN) < I_QB) { idx = 6; Kd = QLORA; Nd = NH * DQK; dsto = WS_WQB; }
            else if ((r -= I_QB) < I_KVB) { idx = 8; Kd = KVLORA; Nd = NH * 256; dsto = WS_WKVB; }
            else if ((r -= I_KVB) < 4 * I_PG) { const int g = r / I_PG; r = r % I_PG; idx = 12; Kd = 256; Nd = 256; dsto = WS_WPG; roff = g * 256; srco = (size_t)g * 65536; }
            else if ((r -= 4 * I_PG) < I_PO) { idx = 14; Kd = POOLW; Nd = DM; dsto = WS_WPO; }
            else if ((r -= I_PO) < I_AO) { idx = 11; Kd = DM; Nd = DM; dsto = WS_WAO; }
            else { r -= I_AO; idx = 15; Kd = DM; Nd = DM; dsto = WS_WOUT; }
            transpose_item(kin[idx] + srco, Kd, Nd, (bf16*)(ws + dsto), mode, roff, scr, r, lane);
        }
        { v4u* z = (v4u*)(WIN_T + (size_t)DIN * DM); const int nz = (DIN_PAD - DIN) * DM / 8;
          for (int i = gw * 64 + lane; i < nz; i += NGW * 64) z[i] = (v4u){0u, 0u, 0u, 0u}; }
        { const float* x = kin[0]; const float* attn_norm_g = kin[2];
          for (int m = gw; m < M; m += NGW) rms_row_2048(x + (size_t)m * DM, attn_norm_g, XN + (size_t)m * DM, lane); }
    TP_END(0); }
    SEAM(0);
    if (IN(1)) { TP_BEGIN(1);
        { pg8::Gemm g{XN, WIN_T, M, 6144, DM, DM, DM, 0, 0}; pg8::StaticOrder S; S.init(M, 6144, G, bx);
          pg8::EpiIn E{C1, U, Gt, b_gate};
          pg8::gemm_phase<pg8::EpiIn, pg8::StaticOrder>(ldsl, g, S, E); }
        { pg8::Gemm g{XN, WIN_T + (size_t)6144 * DM, M, 2048, 256, DM, DM, 256, 256}; pg8::StaticOrder S; S.init(M, 2048, G, bx);
          pg8::EpiKRP E{KRP};
          pg8::gemm_phase<pg8::EpiKRP, pg8::StaticOrder>(ldsl, g, S, E); }
    TP_END(1); }
    SEAM(1);
    if (IN(2)) { TP_BEGIN(2);
        for (int m = gw; m < M; m += NGW) {
            const f32x4* c = (const f32x4*)(C1 + (size_t)m * 1024) + lane; f32x4 v[4]; float sq = 0.f, skv = 0.f;
#pragma unroll
            for (int j = 0; j < 4; ++j) { v[j] = c[64 * j]; const float s = (v[j].x * v[j].x + v[j].y * v[j].y) + (v[j].z * v[j].z + v[j].w * v[j].w); if (j < 2) sq += s; else skv += s; }
            const float iq = 1.0f / sqrtf(wave_sum(sq) * (1.f / 512.f) + EPS), ikv = 1.0f / sqrtf(wave_sum(skv) * (1.f / 512.f) + EPS);
            v2u* o8 = (v2u*)(CN + (size_t)m * 1024) + lane;
#pragma unroll
            for (int j = 0; j < 4; ++j) { const f32x4 gv = (j < 2) ? ((const f32x4*)q_a_norm_g)[lane + 64 * j] : ((const f32x4*)kv_a_norm_g)[lane + 64 * (j - 2)]; const float iv = (j < 2) ? iq : ikv;
                v2u o; o.x = cvtpk(v[j].x * iv * gv.x, v[j].y * iv * gv.y); o.y = cvtpk(v[j].z * iv * gv.z, v[j].w * iv * gv.w); o8[64 * j] = o; }
        }
        for (int m = gw; m < M; m += NGW) {
            const int s = m & (SEQ - 1);
#pragma unroll
            for (int jj = 0; jj < 2; ++jj) {
                const int col = 8 * lane + 512 * jj, grp = col >> 8, w = 2 << grp; const int cnt = (s + 1 < w) ? s + 1 : w;
                float a[8]; float u0[8];
#pragma unroll
                for (int e = 0; e < 8; ++e) a[e] = 0.f;
#pragma unroll
                for (int d = 0; d < 16; ++d) {
                    if (d < cnt) { const v4u q = *(const v4u*)(U + (size_t)(m - d) * 1024 + col);
                        const float f[8] = {bflo(q.x), bfhi(q.x), bflo(q.y), bfhi(q.y), bflo(q.z), bfhi(q.z), bflo(q.w), bfhi(q.w)};
#pragma unroll
                        for (int e = 0; e < 8; ++e) { a[e] += f[e]; if (d == 0) u0[e] = f[e]; } }
                }
                const float rc = 1.0f / (float)cnt;
                v4u o; o.x = cvtpk(a[0] * rc - u0[0], a[1] * rc - u0[1]); o.y = cvtpk(a[2] * rc - u0[2], a[3] * rc - u0[3]);
                o.z = cvtpk(a[4] * rc - u0[4], a[5] * rc - u0[5]); o.w = cvtpk(a[6] * rc - u0[6], a[7] * rc - u0[7]);
                *(v4u*)(POOLED + (size_t)m * 1024 + col) = o;
            }
        }
    TP_END(2); }
    SEAM(2);
    if (IN(3)) { TP_BEGIN(3);
        { pg8::Gemm g{CN, WQB_T, M, NH * DQK, QLORA, 1024, QLORA, 0, 0}; pg8::StaticOrder S; S.init(M, NH * DQK, G, bx);
          pg8::EpiBf16 E{Qb, 3072}; pg8::gemm_phase<pg8::EpiBf16, pg8::StaticOrder>(ldsl, g, S, E); }
        { pg8::Gemm g{CN + 512, WKVB_T, M, NH * 256, KVLORA, 1024, KVLORA, 0, 0}; pg8::StaticOrder S; S.init(M, NH * 256, G, bx);
          pg8::EpiKV E{Kb, Vb}; pg8::gemm_phase<pg8::EpiKV, pg8::StaticOrder>(ldsl, g, S, E); }
        { pg8::Gemm g{POOLED, WPG_T, M, POOLW, 256, 1024, 256, 256, 0}; pg8::StaticOrder S; S.init(M, POOLW, G, (bx + 128) % G);
          pg8::EpiScale E{PG, 1024, pool_scale}; pg8::gemm_phase<pg8::EpiScale, pg8::StaticOrder>(ldsl, g, S, E); }
    TP_END(3); }
    SEAM(3);
    if (IN(4)) { TP_BEGIN(4);
        for (int m = gw; m < M; m += NGW) {
            const float pos = (float)positions[m];
            const int sub = lane & 3, h = lane >> 2;
            float cs[8], sn[8];
#pragma unroll
            for (int j = 0; j < 8; ++j) { const int i = 8 * sub + j; const float invf = __builtin_amdgcn_exp2f(-(float)i * (13.287712379549449f / 32.f));
                const float ang = pos * invf; const float k = rintf(ang * 0.15915494309189535f);
                float r = fmaf(-k, 6.2831854820251465f, ang); r = fmaf(-k, -1.7484555e-7f, r);
                sn[j] = __sinf(r); cs[j] = __cosf(r); }
#pragma unroll
            for (int which = 0; which < 2; ++which) {
                bf16* base = (which == 0 ? Qb : Kb) + (size_t)m * 3072 + h * DQK;
                const float* gn = (which == 0) ? q_norm_g : k_norm_g;
                float nv[32], rl[8], rh[8]; float ss = 0.f;
#pragma unroll
                for (int jj = 0; jj < 4; ++jj) { const v4u q = *(const v4u*)(base + 32 * sub + 8 * jj);
                    nv[8 * jj + 0] = bflo(q.x); nv[8 * jj + 1] = bfhi(q.x); nv[8 * jj + 2] = bflo(q.y); nv[8 * jj + 3] = bfhi(q.y);
                    nv[8 * jj + 4] = bflo(q.z); nv[8 * jj + 5] = bfhi(q.z); nv[8 * jj + 6] = bflo(q.w); nv[8 * jj + 7] = bfhi(q.w); }
                if (which == 0) {
                    const v4u a = *(const v4u*)(base + 128 + 8 * sub), b = *(const v4u*)(base + 160 + 8 * sub);
                    rl[0] = bflo(a.x); rl[1] = bfhi(a.x); rl[2] = bflo(a.y); rl[3] = bfhi(a.y); rl[4] = bflo(a.z); rl[5] = bfhi(a.z); rl[6] = bflo(a.w); rl[7] = bfhi(a.w);
                    rh[0] = bflo(b.x); rh[1] = bfhi(b.x); rh[2] = bflo(b.y); rh[3] = bfhi(b.y); rh[4] = bflo(b.z); rh[5] = bfhi(b.z); rh[6] = bflo(b.w); rh[7] = bfhi(b.w);
                } else {
                    f32x4 a0 = {0.f, 0.f, 0.f, 0.f}, a1 = a0, b0 = a0, b1 = a0;
#pragma unroll
                    for (int ks = 0; ks < 8; ++ks) { const float* kp = KRP + ((size_t)ks * 8192 + m) * 64 + 8 * sub;
                        a0 += *(const f32x4*)kp; a1 += *(const f32x4*)(kp + 4); b0 += *(const f32x4*)(kp + 32); b1 += *(const f32x4*)(kp + 36); }
                    rl[0] = a0.x; rl[1] = a0.y; rl[2] = a0.z; rl[3] = a0.w; rl[4] = a1.x; rl[5] = a1.y; rl[6] = a1.z; rl[7] = a1.w;
                    rh[0] = b0.x; rh[1] = b0.y; rh[2] = b0.z; rh[3] = b0.w; rh[4] = b1.x; rh[5] = b1.y; rh[6] = b1.z; rh[7] = b1.w;
                }
#pragma unroll
                for (int e = 0; e < 32; ++e) ss += nv[e] * nv[e];
#pragma unroll
                for (int e = 0; e < 8; ++e) ss += rl[e] * rl[e] + rh[e] * rh[e];
                ss += __shfl_xor(ss, 1); ss += __shfl_xor(ss, 2);
                const float inv = 1.0f / sqrtf(ss * (1.f / 192.f) + EPS);
#pragma unroll
                for (int jj = 0; jj < 4; ++jj) { const f32x4 g0 = *(const f32x4*)(gn + 32 * sub + 8 * jj), g1 = *(const f32x4*)(gn + 32 * sub + 8 * jj + 4);
                    v4u o; o.x = cvtpk(nv[8 * jj + 0] * inv * g0.x, nv[8 * jj + 1] * inv * g0.y); o.y = cvtpk(nv[8 * jj + 2] * inv * g0.z, nv[8 * jj + 3] * inv * g0.w);
                    o.z = cvtpk(nv[8 * jj + 4] * inv * g1.x, nv[8 * jj + 5] * inv * g1.y); o.w = cvtpk(nv[8 * jj + 6] * inv * g1.z, nv[8 * jj + 7] * inv * g1.w);
                    *(v4u*)(base + 32 * sub + 8 * jj) = o; }
                float ol[8], oh[8];
#pragma unroll
                for (int e = 0; e < 8; ++e) { const float a = rl[e] * inv * gn[128 + 8 * sub + e], b = rh[e] * inv * gn[160 + 8 * sub + e];
                    ol[e] = a * cs[e] - b * sn[e]; oh[e] = b * cs[e] + a * sn[e]; }
                v4u o1, o2; o1.x = cvtpk(ol[0], ol[1]); o1.y = cvtpk(ol[2], ol[3]); o1.z = cvtpk(ol[4], ol[5]); o1.w = cvtpk(ol[6], ol[7]);
                o2.x = cvtpk(oh[0], oh[1]); o2.y = cvtpk(oh[2], oh[3]); o2.z = cvtpk(oh[4], oh[5]); o2.w = cvtpk(oh[6], oh[7]);
                *(v4u*)(base + 128 + 8 * sub) = o1; *(v4u*)(base + 160 + 8 * sub) = o2;
            }
        }
        { pg8::Gemm g{PG, WPO_T, M, DM, POOLW, POOLW, POOLW, 0, 0}; pg8::StaticOrder S; S.init(M, DM, G, bx);
          pg8::EpiGate<false> E{MP, Gt, nullptr, 0}; pg8::gemm_phase<pg8::EpiGate<false>, pg8::StaticOrder>(ldsl, g, S, E); }
    TP_END(4); }
    SEAM(4);
    if (IN(5)) { TP_BEGIN(5);
        const int npair = BATCH * NH * 8;
        for (int p = vcu; p < npair; p += G) {
            const int bh = p >> 3, s = p & 7;
            att::attn_unit(bh / NH, bh % NH, 15 - s, Qb, Kb, Vb, Ob, (char*)lds);
            att::attn_unit(bh / NH, bh % NH, s, Qb, Kb, Vb, Ob, (char*)lds);
        }
    TP_END(5); }
    SEAM(5);
    if (IN(6)) { TP_BEGIN(6);
        pg8::Gemm g{Ob, WAO_T, M, DM, DM, DM, DM, 0, 0}; pg8::StaticOrder S; S.init(M, DM, G, bx);
        pg8::EpiGate<true> E{MIXED, Gt, MP, 2048}; pg8::gemm_phase<pg8::EpiGate<true>, pg8::StaticOrder>(ldsl, g, S, E);
    TP_END(6); }
    SEAM(6);
    if (IN(7)) { TP_BEGIN(7);
        { constexpr int I_G = (DM / 64) * (DFF / 32);
          for (int it = gw; it < 2 * I_G; it += NGW) { int r = it, idx, mode; if (r < I_G) { idx = 17; mode = 2; } else { r -= I_G; idx = 18; mode = 3; }
              transpose_item(kin[idx], DM, DFF, (bf16*)(ws + WS_WGU), mode, 0, scr, r, lane, ffn_norm_g); }
          __syncthreads(); }
        pg8::Gemm g{MIXED, WOUT_T, M, DM, DM, DM, DM, 0, 0}; pg8::StaticOrder S; S.init(M, DM, G, bx);
        pg8::EpiResNorm E{kin[0], X1, (bf16*)(ws + WS_X1B), (float*)ws + SV_SS, DM}; pg8::gemm_phase<pg8::EpiResNorm, pg8::StaticOrder>(ldsl, g, S, E);
    TP_END(7); }
    SEAM(7);
    if (IN(9)) { TP_BEGIN(9);
        pg8::Gemm g{(bf16*)(ws + WS_X1B), WGU_T, M, 2 * DFF, DM, DM, DM, 0, 0}; pg8::StaticOrder S; S.init(M, 2 * DFF, G, bx);
        pg8::EpiSwiGLU E{ACT, DFF, (const float*)ws + SV_SS}; pg8::gemm_phase<pg8::EpiSwiGLU, pg8::StaticOrder>(ldsl, g, S, E);
        if (G == 256 ? (bx >= 128) : true) {
            constexpr int I_D2 = (DFF / 64) * (DM / 32);
            const int nw = (G == 256) ? 128 * NWAVES : NGW, w0 = (G == 256) ? (bx - 128) * NWAVES + wave : gw;
            for (int it = w0; it < I_D2; it += nw) transpose_item(kin[19], DFF, DM, (bf16*)(ws + WS_WDN), 0, 0, scr, it, lane);
        }
    TP_END(9); }
    SEAM(9);
    if (IN(10)) { TP_BEGIN(10);
        pg8::Gemm g{ACT, WDN_T, M, DM, DFF, DFF, DFF, 0, 0}; pg8::StaticOrder S; S.init(M, DM, G, bx);
        pg8::EpiRes E{X1, args.out, DM}; pg8::gemm_phase<pg8::EpiRes, pg8::StaticOrder>(ldsl, g, S, E);
    TP_END(10); }
#ifdef TPROBE
    if (blockIdx.x == 0 && threadIdx.x == 0) { const unsigned w_ = 4u * ((volatile LAS unsigned*)(ldsl + 140000))[1]; const unsigned long long t0_ = __builtin_amdgcn_s_memrealtime(); while ((unsigned)(__builtin_amdgcn_s_memrealtime() - t0_) < w_) __builtin_amdgcn_s_sleep(8); }
#endif
#undef IN
#undef SEAM
}

extern "C" void kernel_launch(void* const* d_in, const int* in_sizes, int n_in, void* d_out, int out_size, void* d_ws, size_t ws_size, hipStream_t stream) {
    static int grid = 0;
    if (grid == 0) {
        if (n_in != 20 || out_size != M * DM || ws_size < WS_END) { fprintf(stderr, "kernel_launch: unexpected shapes (n_in %d, out %d, ws %zu)\n", n_in, out_size, ws_size); grid = -1; return; }
        int dev = 0, cus = 0, per_cu = 0;
        (void)hipGetDevice(&dev); (void)hipDeviceGetAttribute(&cus, hipDeviceAttributeMultiprocessorCount, dev);
        if (hipFuncSetAttribute((const void*)mega_fwd, hipFuncAttributeMaxDynamicSharedMemorySize, LDS_BYTES) != hipSuccess) { fprintf(stderr, "kernel_launch: hipFuncSetAttribute failed\n"); grid = -1; return; }
        if (hipOccupancyMaxActiveBlocksPerMultiprocessor(&per_cu, (const void*)mega_fwd, NWAVES * 64, LDS_BYTES) != hipSuccess || per_cu < 1) { fprintf(stderr, "kernel_launch: occupancy query says %d\n", per_cu); per_cu = 1; }
        (void)hipGetLastError();
        grid = cus > 0 ? cus : 256;
    }
    if (grid < 0) return;
    Args a{};
    for (int i = 0; i < 20; ++i) a.in[i] = (const float*)d_in[i];
    a.out = (float*)d_out; a.ws = (unsigned char*)d_ws;
    if (MK_N_LAUNCHES == 1) {
        a.ph_lo = 0; a.ph_hi = NPH; a.coop = 1;
        (void)hipMemsetAsync((char*)d_ws + WS_BAR, 0, 16384, stream);
        void* kargs[] = {&a};
        hipError_t e = hipLaunchCooperativeKernel((const void*)mega_fwd, dim3(grid), dim3(NWAVES * 64), kargs, LDS_BYTES, stream);
        if (e != hipSuccess) fprintf(stderr, "kernel_launch: cooperative launch failed: %s (grid %d)\n", hipGetErrorString(e), grid);
    } else {
        for (int p = 0; p < NPH; ++p) {
            a.ph_lo = p; a.ph_hi = p + 1;
            hipLaunchKernelGGL(mega_fwd, dim3(grid), dim3(NWAVES * 64), LDS_BYTES, stream, a);
        }
    }
}
```

```cpp
#include <hip/hip_runtime.h>
#include <hip/hip_cooperative_groups.h>
#include <cstdio>
#include <cstdint>
namespace cg = cooperative_groups;

#ifndef MK_N_LAUNCHES
#define MK_N_LAUNCHES 1
#endif

namespace pg8 {
#define PG8_LAS __attribute__((address_space(3)))
typedef unsigned short bf16_t;
typedef short bf16x8 __attribute__((ext_vector_type(8)));
typedef float f32x4 __attribute__((ext_vector_type(4)));
typedef unsigned u32x4 __attribute__((ext_vector_type(4)));
constexpr int BM = 256, BK = 64, HALF = 128, HTB = HALF * BK * 2, STAGE_BYTES = 8 * HTB, NXCD = 8, WGM = 8;

__host__ __device__ __forceinline__ int lds_byte(int r, int c) { const int st = (r >> 4) * 2 + (c >> 5), rr = r & 15, cc = c & 31, ob = rr * 64 + cc * 2; return st * 1024 + (ob ^ (((ob >> 9) & 1) << 5)); }
__host__ __device__ __forceinline__ void stage_rc(int b, int& R, int& C) { const int st = b / 1024, sb = b % 1024, swz = sb ^ (((sb >> 9) & 1) << 5); R = (st >> 1) * 16 + swz / 64; C = (st & 1) * 32 + (swz % 64) / 2; }
__host__ __device__ __forceinline__ int perm32(int rho) { const int n = rho >> 4, i = rho & 15; return 8 * (i >> 2) + 4 * n + (i & 3); }

struct Unit { int pm, pn; };
struct Gemm { const bf16_t* A; const bf16_t* Bt; int M, N, K, lda, ldb, a_pn_step, b_pn_step; };

struct StaticOrder {
    int nM, nN, nwg, G, c;
    __host__ __device__ void init(int M, int N, int G_, int c_) { nM = M / BM; nN = N / BM; nwg = nM * nN; G = G_; c = c_; }
    __host__ __device__ bool next(int i, Unit& u) const {
        const long L = (long)i * G + c; if (L >= nwg) return false;
        int wgid = (int)L; { const int q = nwg / NXCD, r = nwg % NXCD, xcd = wgid % NXCD, off = wgid / NXCD; wgid = (xcd < r ? xcd * (q + 1) : r * (q + 1) + (xcd - r) * q) + off; }
        const int nig = WGM * nN, gid = wgid / nig, fm = gid * WGM, gsz = (nM - fm) < WGM ? (nM - fm) : WGM;
        u.pm = fm + ((wgid % nig) % gsz); u.pn = (wgid % nig) / gsz; return true;
    }
};

typedef float f32x2_t_ __attribute__((ext_vector_type(2))); typedef __bf16 bf16x2_t_ __attribute__((ext_vector_type(2)));
__device__ __forceinline__ unsigned cvt_pk_bf16(float lo, float hi) { f32x2_t_ v = {lo, hi}; bf16x2_t_ b = __builtin_convertvector(v, bf16x2_t_); return __builtin_bit_cast(unsigned, b); }
__device__ __forceinline__ u32x4 pack8(f32x4 a, f32x4 b) { u32x4 w; w.x = cvt_pk_bf16(a[0], a[1]); w.y = cvt_pk_bf16(a[2], a[3]); w.z = cvt_pk_bf16(b[0], b[1]); w.w = cvt_pk_bf16(b[2], b[3]); return w; }
__device__ __forceinline__ void unpack8(u32x4 w, f32x4& a, f32x4& b) {
    a[0] = __uint_as_float(w.x << 16); a[1] = __uint_as_float(w.x & 0xffff0000u); a[2] = __uint_as_float(w.y << 16); a[3] = __uint_as_float(w.y & 0xffff0000u);
    b[0] = __uint_as_float(w.z << 16); b[1] = __uint_as_float(w.z & 0xffff0000u); b[2] = __uint_as_float(w.w << 16); b[3] = __uint_as_float(w.w & 0xffff0000u); }
__device__ __forceinline__ float sigmoidf_(float v) { return __builtin_amdgcn_rcpf(1.0f + __builtin_amdgcn_exp2f(-1.4426950408889634f * v)); }
__device__ __forceinline__ f32x4 sigmoid4(f32x4 v) { f32x4 o; o[0] = sigmoidf_(v[0]); o[1] = sigmoidf_(v[1]); o[2] = sigmoidf_(v[2]); o[3] = sigmoidf_(v[3]); return o; }

typedef f32x4 AccT[2][2][4][2];
#define EPI_LOOP_AM _Pragma("unroll") for (int ai = 0; ai < 2; ++ai) _Pragma("unroll") for (int m = 0; m < 4; ++m)
#define EPI_LOOP_B _Pragma("unroll") for (int bj = 0; bj < 2; ++bj)

struct EpiIn {
    static constexpr bool PERM = true;
    float* C1; bf16_t* U; bf16_t* G; const float* bgate;
    __device__ __forceinline__ void operator()(const AccT& acc, const Unit& u, int wr, int wc, int fr, int fq) const {
        const int row0 = u.pm * BM + wr * 64 + fr, pn = u.pn, cw = wc * 32 + 8 * fq;
        if (pn < 4) {
            EPI_LOOP_AM { float* rp = C1 + (size_t)(row0 + ai * HALF + m * 16) * 1024 + pn * 256 + cw;
                EPI_LOOP_B { *(f32x4*)(rp + bj * HALF) = acc[ai][bj][m][0]; *(f32x4*)(rp + bj * HALF + 4) = acc[ai][bj][m][1]; } }
        } else if (pn < 8) {
            EPI_LOOP_AM { bf16_t* rp = U + (size_t)(row0 + ai * HALF + m * 16) * 1024 + (pn - 4) * 256 + cw;
                EPI_LOOP_B { *(u32x4*)(rp + bj * HALF) = pack8(acc[ai][bj][m][0], acc[ai][bj][m][1]); } }
        } else {
            const int gc = (pn - 8) * 256 + cw; f32x4 bv[2][2];
            EPI_LOOP_B { bv[bj][0] = *(const f32x4*)(bgate + gc + bj * HALF); bv[bj][1] = *(const f32x4*)(bgate + gc + bj * HALF + 4); }
            EPI_LOOP_AM { bf16_t* rp = G + (size_t)(row0 + ai * HALF + m * 16) * 4096 + gc;
                EPI_LOOP_B { *(u32x4*)(rp + bj * HALF) = pack8(sigmoid4(acc[ai][bj][m][0] + bv[bj][0]), sigmoid4(acc[ai][bj][m][1] + bv[bj][1])); } }
        }
    }
};
struct EpiKRP {
    static constexpr bool PERM = true;
    float* KRP;
    __device__ __forceinline__ void operator()(const AccT& acc, const Unit& u, int wr, int wc, int fr, int fq) const {
        const int row0 = u.pm * BM + wr * 64 + fr, cw = wc * 32 + 8 * fq;
        if (wc < 2) { EPI_LOOP_AM { float* rp = KRP + ((size_t)u.pn * 8192 + (row0 + ai * HALF + m * 16)) * 64 + cw; *(f32x4*)rp = acc[ai][0][m][0]; *(f32x4*)(rp + 4) = acc[ai][0][m][1]; } }
    }
};
struct EpiBf16 {
    static constexpr bool PERM = true;
    bf16_t* O; int ldc;
    __device__ __forceinline__ void operator()(const AccT& acc, const Unit& u, int wr, int wc, int fr, int fq) const {
        const int row0 = u.pm * BM + wr * 64 + fr, col0 = u.pn * BM + wc * 32 + 8 * fq;
        EPI_LOOP_AM { bf16_t* rp = O + (size_t)(row0 + ai * HALF + m * 16) * ldc + col0;
            EPI_LOOP_B { *(u32x4*)(rp + bj * HALF) = pack8(acc[ai][bj][m][0], acc[ai][bj][m][1]); } }
    }
};
struct EpiKV {
    static constexpr bool PERM = true;
    bf16_t* K; bf16_t* V;
    __device__ __forceinline__ void operator()(const AccT& acc, const Unit& u, int wr, int wc, int fr, int fq) const {
        const int row0 = u.pm * BM + wr * 64 + fr, cw = wc * 32 + 8 * fq, h = u.pn;
        EPI_LOOP_AM { const size_t row = (size_t)(row0 + ai * HALF + m * 16);
            *(u32x4*)(K + row * 3072 + h * 192 + cw) = pack8(acc[ai][0][m][0], acc[ai][0][m][1]);
            *(u32x4*)(V + row * 2048 + h * 128 + cw) = pack8(acc[ai][1][m][0], acc[ai][1][m][1]); }
    }
};
struct EpiScale {
    static constexpr bool PERM = true;
    bf16_t* O; int ldc; const float* scale;
    __device__ __forceinline__ void operator()(const AccT& acc, const Unit& u, int wr, int wc, int fr, int fq) const {
        const int row0 = u.pm * BM + wr * 64 + fr, col0 = u.pn * BM + wc * 32 + 8 * fq; f32x4 sv[2][2];
        EPI_LOOP_B { sv[bj][0] = *(const f32x4*)(scale + col0 + bj * HALF); sv[bj][1] = *(const f32x4*)(scale + col0 + bj * HALF + 4); }
        EPI_LOOP_AM { bf16_t* rp = O + (size_t)(row0 + ai * HALF + m * 16) * ldc + col0;
            EPI_LOOP_B { *(u32x4*)(rp + bj * HALF) = pack8(acc[ai][bj][m][0] * sv[bj][0], acc[ai][bj][m][1] * sv[bj][1]); } }
    }
};
template <bool HAS_ADD> struct EpiGate {
    static constexpr bool PERM = true;
    bf16_t* O; const bf16_t* gate; const bf16_t* add; int gcol0;
    __device__ __forceinline__ void operator()(const AccT& acc, const Unit& u, int wr, int wc, int fr, int fq) const {
        const int row0 = u.pm * BM + wr * 64 + fr, col0 = u.pn * BM + wc * 32 + 8 * fq;
        EPI_LOOP_AM { const size_t row = (size_t)(row0 + ai * HALF + m * 16);
            EPI_LOOP_B { f32x4 g0, g1; unpack8(*(const u32x4*)(gate + row * 4096 + gcol0 + col0 + bj * HALF), g0, g1);
                f32x4 v0 = g0 * acc[ai][bj][m][0], v1 = g1 * acc[ai][bj][m][1];
                if (HAS_ADD) { f32x4 a0, a1; unpack8(*(const u32x4*)(add + row * 2048 + col0 + bj * HALF), a0, a1); v0 += a0; v1 += a1; }
                *(u32x4*)(O + row * 2048 + col0 + bj * HALF) = pack8(v0, v1); } }
    }
};
struct EpiRes {
    static constexpr bool PERM = false;
    const float* base; float* out; int ldc;
    __device__ __forceinline__ void operator()(const AccT& acc, const Unit& u, int wr, int wc, int fr, int fq) const {
        const int row0 = u.pm * BM + wr * 64 + fr, col0 = u.pn * BM + wc * 32 + 4 * fq;
        EPI_LOOP_AM { const size_t off = (size_t)(row0 + ai * HALF + m * 16) * ldc + col0;
            EPI_LOOP_B {
#pragma unroll
                for (int n = 0; n < 2; ++n) { const f32x4 b = *(const f32x4*)(base + off + bj * HALF + n * 16); *(f32x4*)(out + off + bj * HALF + n * 16) = b + acc[ai][bj][m][n]; } } }
    }
};
struct EpiResNorm {
    static constexpr bool PERM = false;
    const float* base; float* out; bf16_t* outb; float* ss; int ldc;
    __device__ __forceinline__ void operator()(const AccT& acc, const Unit& u, int wr, int wc, int fr, int fq) const {
        const int row0 = u.pm * BM + wr * 64 + fr, col0 = u.pn * BM + wc * 32 + 4 * fq;
        EPI_LOOP_AM { const int row = row0 + ai * HALF + m * 16; const size_t off = (size_t)row * ldc + col0; float s = 0.f;
            EPI_LOOP_B {
#pragma unroll
                for (int n = 0; n < 2; ++n) { const f32x4 v = *(const f32x4*)(base + off + bj * HALF + n * 16) + acc[ai][bj][m][n]; *(f32x4*)(out + off + bj * HALF + n * 16) = v;
                    typedef unsigned u32x2_ __attribute__((ext_vector_type(2))); u32x2_ w; w.x = cvt_pk_bf16(v[0], v[1]); w.y = cvt_pk_bf16(v[2], v[3]); *(u32x2_*)(outb + off + bj * HALF + n * 16) = w;
                    s += (v[0] * v[0] + v[1] * v[1]) + (v[2] * v[2] + v[3] * v[3]); } }
            s += __shfl_xor(s, 16); s += __shfl_xor(s, 32);
            if (fq == 0) atomicAdd(ss + row, s); }
    }
};
struct EpiSwiGLU {
    static constexpr bool PERM = true;
    bf16_t* O; int ldc; const float* ss;
    __device__ __forceinline__ void operator()(const AccT& acc, const Unit& u, int wr, int wc, int fr, int fq) const {
        const int row0 = u.pm * BM + wr * 64 + fr, col0 = u.pn * HALF + wc * 32 + 8 * fq;
        EPI_LOOP_AM { const int row = row0 + ai * HALF + m * 16; bf16_t* rp = O + (size_t)row * ldc + col0;
            const float inv = 1.0f / sqrtf(ss[row] * (1.f / 2048.f) + 1e-6f);
            const f32x4 g0 = acc[ai][0][m][0] * inv, g1 = acc[ai][0][m][1] * inv;
            *(u32x4*)rp = pack8(g0 * sigmoid4(g0) * (acc[ai][1][m][0] * inv), g1 * sigmoid4(g1) * (acc[ai][1][m][1] * inv)); }
    }
};

template <class Epi, class Sched, bool ALIGN_EPI = true>
__device__ __forceinline__ void gemm_phase(PG8_LAS unsigned char* lds, const Gemm g, const Sched& S, const Epi& E) {
    const int tid = threadIdx.x, wid = __builtin_amdgcn_readfirstlane(tid >> 6), lane = tid & 63, wr = wid >> 2, wc = wid & 3, fr = lane & 15, fq = lane >> 4;
    const int K = g.K, nt = K / BK;
    unsigned voffA[2], voffB[2];
#pragma unroll
    for (int i = 0; i < 2; ++i) { int R, C; stage_rc(tid * 16 + i * 8192, R, C); const int Rb = Epi::PERM ? ((R & ~31) + perm32(R & 31)) : R;
        voffA[i] = (unsigned)(R * g.lda + C) * 2u; voffB[i] = (unsigned)(Rb * g.ldb + C) * 2u; }
    const size_t kstep = (size_t)(BK * 2);
    const size_t hstepA = (size_t)HALF * g.lda * 2, hstepB = (size_t)HALF * g.ldb * 2;
    const size_t tstepA = 2 * hstepA, tstepB = g.b_pn_step ? (size_t)g.b_pn_step * 2 : 2 * hstepB, pstepA = (size_t)g.a_pn_step * 2;
    const unsigned ldsw = (unsigned)wid * 1024u;
    const int aoff = lds_byte(wr * 64 + fr, fq * 8), boff = lds_byte(wc * 32 + fr, fq * 8);
#define PG8_SA(b, h) (((b) * 2 + (h)) * HTB)
#define PG8_SB(b, h) ((4 + (b) * 2 + (h)) * HTB)
#define PG8_STAGE(bufoff, gbase, voff) do { _Pragma("unroll") for (int _i = 0; _i < 2; ++_i) \
        __builtin_amdgcn_global_load_lds((const unsigned*)((const char*)(gbase) + (voff)[_i]), (PG8_LAS unsigned*)(lds + (bufoff) + ldsw + _i * 8192), 16, 0, 0); } while (0)
#define PG8_LDA(dst, b, h) do { _Pragma("unroll") for (int m = 0; m < 4; ++m) _Pragma("unroll") for (int k = 0; k < 2; ++k) dst[m][k] = *(const PG8_LAS bf16x8*)(lds + PG8_SA(b, h) + aoff + m * 2048 + k * 1024); } while (0)
#define PG8_LDB(dst, b, h) do { _Pragma("unroll") for (int n = 0; n < 2; ++n) _Pragma("unroll") for (int k = 0; k < 2; ++k) dst[n][k] = *(const PG8_LAS bf16x8*)(lds + PG8_SB(b, h) + boff + n * 2048 + k * 1024); } while (0)
#define PG8_MMA(ai, bj, At, Bt) do { __builtin_amdgcn_s_setprio(1); _Pragma("unroll") for (int m = 0; m < 4; ++m) _Pragma("unroll") for (int n = 0; n < 2; ++n) _Pragma("unroll") for (int k = 0; k < 2; ++k) \
        acc[ai][bj][m][n] = __builtin_amdgcn_mfma_f32_16x16x32_bf16(Bt[n][k], At[m][k], acc[ai][bj][m][n], 0, 0, 0); __builtin_amdgcn_s_setprio(0); } while (0)
#define PG8_WAIT_V(n) asm volatile("s_waitcnt vmcnt(" #n ")" ::: "memory")
#define PG8_WAIT_L(n) asm volatile("s_waitcnt lgkmcnt(" #n ")" ::: "memory")
#define PG8_BAR __builtin_amdgcn_s_barrier()
#define PG8_SCHED __builtin_amdgcn_sched_barrier(0)
    Unit cur, nxt; int ui = 0;
    if (!S.next(0, cur)) return;
    f32x4 acc[2][2][4][2];
#pragma unroll
    for (int a = 0; a < 2; ++a)
#pragma unroll
        for (int b = 0; b < 2; ++b)
#pragma unroll
            for (int m = 0; m < 4; ++m)
#pragma unroll
                for (int n = 0; n < 2; ++n) acc[a][b][m][n] = (f32x4){0.f, 0.f, 0.f, 0.f};
    bf16x8 At[4][2], B0[2][2], B1[2][2];
    const char* cA = (const char*)g.A + (size_t)cur.pm * tstepA + (size_t)cur.pn * pstepA; const char* cB = (const char*)g.Bt + (size_t)cur.pn * tstepB;
    PG8_STAGE(PG8_SB(0, 0), cB, voffB); PG8_STAGE(PG8_SB(0, 1), cB + hstepB, voffB); PG8_STAGE(PG8_SA(0, 0), cA, voffA); PG8_STAGE(PG8_SA(0, 1), cA + hstepA, voffA);
    if (wr == 1) PG8_BAR;
    PG8_WAIT_V(2); PG8_BAR;
    PG8_STAGE(PG8_SB(1, 0), cB + kstep, voffB); PG8_STAGE(PG8_SA(1, 0), cA + kstep, voffA); PG8_STAGE(PG8_SB(1, 1), cB + hstepB + kstep, voffB);
    PG8_WAIT_V(6); PG8_BAR;
    for (;;) {
        const bool has_next = S.next(ui + 1, nxt);
        const char* nA = has_next ? (const char*)g.A + (size_t)nxt.pm * tstepA + (size_t)nxt.pn * pstepA : cA; const char* nB = has_next ? (const char*)g.Bt + (size_t)nxt.pn * tstepB : cB;
        for (int t = 0; t < nt; t += 2) {
            const bool last = (t == nt - 2);
            const char* a1 = cA + (size_t)(t + 1) * kstep;
            const char* a2 = last ? nA : cA + (size_t)(t + 2) * kstep; const char* b2 = last ? nB : cB + (size_t)(t + 2) * kstep;
            const char* a3 = a2 + kstep; const char* b3 = b2 + kstep;
            PG8_LDB(B0, 0, 0); PG8_LDB(B1, 0, 1); PG8_SCHED; PG8_LDA(At, 0, 0); PG8_STAGE(PG8_SA(1, 1), a1 + hstepA, voffA);
            PG8_WAIT_V(8); PG8_WAIT_L(0); PG8_BAR; PG8_MMA(0, 0, At, B0); PG8_MMA(0, 1, At, B1); PG8_BAR; PG8_SCHED;
            PG8_LDA(At, 0, 1); PG8_STAGE(PG8_SB(0, 0), b2, voffB); PG8_STAGE(PG8_SB(0, 1), b2 + hstepB, voffB); PG8_STAGE(PG8_SA(0, 0), a2, voffA);
            PG8_WAIT_V(8); PG8_WAIT_L(0); PG8_BAR; PG8_MMA(1, 0, At, B0); PG8_MMA(1, 1, At, B1); PG8_BAR; PG8_SCHED;
            PG8_LDB(B0, 1, 0); PG8_LDB(B1, 1, 1); PG8_SCHED; PG8_LDA(At, 1, 0); PG8_STAGE(PG8_SA(0, 1), a2 + hstepA, voffA);
            PG8_WAIT_V(8); PG8_WAIT_L(0); PG8_BAR; PG8_MMA(0, 0, At, B0); PG8_MMA(0, 1, At, B1); PG8_BAR; PG8_SCHED;
            PG8_LDA(At, 1, 1); PG8_STAGE(PG8_SB(1, 0), b3, voffB); PG8_STAGE(PG8_SB(1, 1), b3 + hstepB, voffB); PG8_STAGE(PG8_SA(1, 0), a3, voffA);
            PG8_WAIT_V(8); PG8_WAIT_L(0); PG8_BAR; PG8_MMA(1, 0, At, B0); PG8_MMA(1, 1, At, B1); PG8_BAR; PG8_SCHED;
        }
        if constexpr (ALIGN_EPI) { if (wr == 0) PG8_BAR; }
        E(acc, cur, wr, wc, fr, fq);
        if (!has_next) break;
#pragma unroll
        for (int a = 0; a < 2; ++a)
#pragma unroll
            for (int b = 0; b < 2; ++b)
#pragma unroll
                for (int m = 0; m < 4; ++m)
#pragma unroll
                    for (int n = 0; n < 2; ++n) acc[a][b][m][n] = (f32x4){0.f, 0.f, 0.f, 0.f};
        cur = nxt; cA = nA; cB = nB; ++ui;
        if constexpr (ALIGN_EPI) { if (wr == 1) PG8_BAR; }
    }
    PG8_WAIT_V(0);
    if constexpr (!ALIGN_EPI) { if (wr == 0) PG8_BAR; }
    PG8_BAR;
#undef PG8_SA
#undef PG8_SB
#undef PG8_STAGE
#undef PG8_LDA
#undef PG8_LDB
#undef PG8_MMA
#undef PG8_WAIT_V
#undef PG8_WAIT_L
#undef PG8_BAR
#undef PG8_SCHED
}
}

constexpr int BATCH = 2, SEQ = 4096, DM = 2048, M = BATCH * SEQ;
constexpr int NH = 16, DQK = 192, DNOPE = 128, DROPE = 64, DV = 128, QLORA = 512, KVLORA = 512;
constexpr int POOLW = 1024, DIN = 6208, DIN_PAD = 6400, DFF = 5632;
constexpr float EPS = 1e-6f;
constexpr int NWAVES = 8;

typedef unsigned short bf16;
typedef unsigned v4u __attribute__((ext_vector_type(4)));
typedef unsigned v2u __attribute__((ext_vector_type(2)));
typedef float f32x4 __attribute__((ext_vector_type(4)));
typedef short bf16x8 __attribute__((ext_vector_type(8)));
typedef short s16x4 __attribute__((ext_vector_type(4)));
typedef float f32x16 __attribute__((ext_vector_type(16)));
#define LAS __attribute__((address_space(3)))
#define LDS_WAIT() asm volatile("s_waitcnt lgkmcnt(0)" ::: "memory")

constexpr size_t MiB = 1u << 20;
constexpr size_t WS_WAO = 1 * MiB, WS_WOUT = 9 * MiB, WS_WPO = 17 * MiB, WS_WQB = 21 * MiB, WS_WKVB = 24 * MiB, WS_WPG = 28 * MiB, WS_KR = 29 * MiB;
constexpr size_t WS_G = 31 * MiB;
constexpr size_t WS_WIN = 95 * MiB, WS_XN = 120 * MiB, WS_C1 = 152 * MiB, WS_U = 184 * MiB;
constexpr size_t WS_Q = 95 * MiB, WS_K = 143 * MiB, WS_V = 191 * MiB, WS_CN = 223 * MiB, WS_POOLED = 239 * MiB, WS_PG = 255 * MiB;
constexpr size_t WS_MP = 223 * MiB, WS_O = 255 * MiB, WS_MIXED = 95 * MiB, WS_X1 = 127 * MiB, WS_H2 = 95 * MiB;
constexpr size_t WS_WGU = 191 * MiB, WS_WDN = 235 * MiB, WS_ACT = 1 * MiB;
constexpr size_t WS_END = 296 * MiB, WS_BAR = 512 * 1024, WS_KRP = 272 * MiB, WS_X1B = 257 * MiB;
constexpr int SV_BGATE = 0, SV_QAG = 4096, SV_KVAG = 4608, SV_QNG = 5120, SV_KNG = 5376, SV_PSC = 5632, SV_FNG = 6656, SV_POS = 8704, SV_END = 8704 + 8192, SV_SS = 32768;

constexpr int LDS_BYTES = 147456;

__device__ __forceinline__ unsigned cvtpk(float lo, float hi) { return pg8::cvt_pk_bf16(lo, hi); }
__device__ __forceinline__ float bflo(unsigned w) { return __uint_as_float(w << 16); }
__device__ __forceinline__ float bfhi(unsigned w) { return __uint_as_float(w & 0xffff0000u); }
__device__ __forceinline__ float wave_sum(float v) {
#pragma unroll
    for (int o = 1; o < 64; o <<= 1) v += __shfl_xor(v, o);
    return v;
}

__device__ __forceinline__ int dst_row(int mode, int n0) {
    if (mode == 1) { if (n0 < 1024) return n0; if (n0 < 1088) return 6144 + (n0 - 1024); if (n0 < 2112) return 1024 + (n0 - 1088); return 2048 + (n0 - 2112); }
    if (mode == 2) return (n0 >> 7) * 256 + (n0 & 127);
    if (mode == 3) return (n0 >> 7) * 256 + 128 + (n0 & 127);
    return n0;
}
__device__ __forceinline__ void transpose_item(const float* W, int K, int N, bf16* WT, int mode, int row_off, LAS float* scr, int item, int lane, const float* gk = nullptr) {
    const int nblk = N / 32, kb = item / nblk, nb = item % nblk, k0 = 64 * kb, n0 = 32 * nb;
    { float tv[32]; const float* wp = W + (size_t)(k0 + (lane >> 5)) * N + n0 + (lane & 31);
#pragma unroll
      for (int i = 0; i < 32; ++i) tv[i] = wp[(size_t)(2 * i) * N];
      if (gk) {
#pragma unroll
          for (int i = 0; i < 32; ++i) tv[i] *= gk[k0 + 2 * i + (lane >> 5)]; }
#pragma unroll
      for (int i = 0; i < 32; ++i) scr[(2 * i + (lane >> 5)) * 33 + (lane & 31)] = tv[i]; }
    LDS_WAIT(); asm volatile("" ::: "memory");
    const int c = lane & 7, dr = row_off + dst_row(mode, n0);
#pragma unroll
    for (int j = 0; j < 4; ++j) { const int n = (lane >> 3) + 8 * j; const LAS float* s = scr + (8 * c) * 33 + n;
        v4u o; o.x = cvtpk(s[0 * 33], s[1 * 33]); o.y = cvtpk(s[2 * 33], s[3 * 33]); o.z = cvtpk(s[4 * 33], s[5 * 33]); o.w = cvtpk(s[6 * 33], s[7 * 33]);
        *(v4u*)(WT + (size_t)(dr + n) * K + k0 + 8 * c) = o; }
    LDS_WAIT(); asm volatile("" ::: "memory");
}

__device__ __forceinline__ void rms_row_2048(const float* xrow, const float* g, bf16* orow, int lane) {
    const f32x4* xr = (const f32x4*)xrow + lane; const f32x4* gr = (const f32x4*)g + lane;
    f32x4 v[8]; float s = 0.f;
#pragma unroll
    for (int j = 0; j < 8; ++j) { v[j] = xr[64 * j]; s += (v[j].x * v[j].x + v[j].y * v[j].y) + (v[j].z * v[j].z + v[j].w * v[j].w); }
    const float inv = 1.0f / sqrtf(wave_sum(s) * (1.f / 2048.f) + EPS);
    v2u* o8 = (v2u*)orow + lane;
#pragma unroll
    for (int j = 0; j < 8; ++j) { const f32x4 gv = gr[64 * j]; v2u o; o.x = cvtpk(v[j].x * inv * gv.x, v[j].y * inv * gv.y); o.y = cvtpk(v[j].z * inv * gv.z, v[j].w * inv * gv.w); o8[64 * j] = o; }
}

namespace att {
constexpr int QBLK = 32, KVBLK = 64, QB = 256;
constexpr int SHM_V = KVBLK * DV * 2, SHM_K = KVBLK * DQK * 2;
constexpr int OFF_V = 0, OFF_K = 3 * SHM_V, OFF_WS = OFF_K + 2 * SHM_K;
constexpr float SCALE = 0.07216878364870322f;
constexpr float THR = 8.f;
#define KSWZ(row, colB) ((row) * 384 + ((colB) ^ (((row) & 7) << 4)))
#define SBAR() __builtin_amdgcn_sched_barrier(0)
__device__ __forceinline__ int v_st(int k, int c) { const int kk = (k & ~0xC) | ((k & 4) << 1) | ((k & 8) >> 1); return ((kk >> 3) * 4 + (c >> 5)) * 512 + ((kk & 7) * 32 + (c & 31)) * 2; }
__device__ __forceinline__ int v_rd_base(int lane) { return ((lane & 3) << 3) | (((lane >> 2) & 3) << 6) | (((lane >> 4) & 1) << 5) | (((lane >> 5) & 1) << 8); }
__device__ __forceinline__ int crow(int r, int hi) { return (r & 3) + 8 * (r >> 2) + 4 * hi; }
__device__ __forceinline__ void mask_tile(f32x16& p0, f32x16& p1, int dq) {
    const float NEG = -__builtin_inff();
#pragma unroll
    for (int r = 0; r < 16; ++r) {
        const int c = (r & 3) + 8 * (r >> 2);
        if (dq - c < 0) p0[r] = NEG;
        if (dq - c - 32 < 0) p1[r] = NEG;
    }
}
__device__ __forceinline__ void partialSM(f32x16& p0, f32x16& p1, float& m_reg, float& mn, float& alpha) {
    float pmax = p0[0];
#pragma unroll
    for (int r = 1; r < 16; ++r) pmax = fmaxf(pmax, p0[r]);
#pragma unroll
    for (int r = 0; r < 16; ++r) pmax = fmaxf(pmax, p1[r]);
    { auto rr = __builtin_amdgcn_permlane32_swap(__float_as_uint(pmax), __float_as_uint(pmax), false, false);
      pmax = fmaxf(__uint_as_float(rr[0]), __uint_as_float(rr[1])); }
    constexpr float C2 = 1.4426950408889634f * SCALE;
    if (__builtin_expect(__all((pmax - m_reg) * SCALE <= THR), 1)) { mn = m_reg; alpha = 1.f; }
    else { mn = fmaxf(m_reg, pmax); alpha = __builtin_amdgcn_exp2f((m_reg - mn) * C2); m_reg = mn; }
    const float mnL = -mn * C2;
#pragma unroll
    for (int r = 0; r < 16; ++r) p0[r] = fmaf(p0[r], C2, mnL);
#pragma unroll
    for (int r = 0; r < 16; ++r) p1[r] = fmaf(p1[r], C2, mnL);
#pragma unroll
    for (int r = 0; r < 16; ++r) p0[r] = __builtin_amdgcn_exp2f(p0[r]);
}
__device__ __forceinline__ void finishSM(f32x16& p0, f32x16& p1, float alpha, float& l_reg, bf16x8& pa0, bf16x8& pa1, bf16x8& pa2, bf16x8& pa3) {
#pragma unroll
    for (int r = 0; r < 16; ++r) p1[r] = __builtin_amdgcn_exp2f(p1[r]);
    float ps = 0;
#pragma unroll
    for (int r = 0; r < 16; ++r) ps += p0[r];
#pragma unroll
    for (int r = 0; r < 16; ++r) ps += p1[r];
    { auto rr = __builtin_amdgcn_permlane32_swap(__float_as_uint(ps), __float_as_uint(ps), false, false);
      ps = __uint_as_float(rr[0]) + __uint_as_float(rr[1]); }
    l_reg = l_reg * alpha + ps;
#define PK4(P, B_, OUT) do { unsigned a0 = cvtpk(P[B_+0], P[B_+1]), a1 = cvtpk(P[B_+2], P[B_+3]);                          \
        unsigned b0 = cvtpk(P[B_+4], P[B_+5]), b1 = cvtpk(P[B_+6], P[B_+7]);                                             \
        auto r0 = __builtin_amdgcn_permlane32_swap(a0, b0, false, false); auto r1 = __builtin_amdgcn_permlane32_swap(a1, b1, false, false); \
        v4u w = {r0[0], r1[0], r0[1], r1[1]}; OUT = *reinterpret_cast<bf16x8*>(&w); } while (0)
    PK4(p0, 0, pa0); PK4(p0, 8, pa1); PK4(p1, 0, pa2); PK4(p1, 8, pa3);
#undef PK4
}
__device__ __forceinline__ void qkt(f32x16& p0, f32x16& p1, const char* Kb, int r32, int hi, const bf16x8* qr) {
    p0 = f32x16{}; p1 = f32x16{};
    const char* kb[4];
#pragma unroll
    for (int dd = 0; dd < 4; ++dd) kb[dd] = Kb + KSWZ(r32, (dd * 16 + hi * 8) * 2);
#pragma unroll
    for (int g = 0; g < 2; ++g) { bf16x8 b0[6], b1[6];
#pragma unroll
        for (int i = 0; i < 6; ++i) { const int d0 = 6 * g + i; const char* a = kb[d0 & 3] + (d0 >> 2) * 128; b0[i] = *reinterpret_cast<const bf16x8*>(a); b1[i] = *reinterpret_cast<const bf16x8*>(a + 32 * 384); }
        SBAR();
#pragma unroll
        for (int i = 0; i < 6; ++i) { p0 = __builtin_amdgcn_mfma_f32_32x32x16_bf16(b0[i], qr[6 * g + i], p0, 0, 0, 0); p1 = __builtin_amdgcn_mfma_f32_32x32x16_bf16(b1[i], qr[6 * g + i], p1, 0, 0, 0); }
        SBAR(); }
}
__device__ __forceinline__ void pv_tile(f32x16* o, int vb0, bf16x8 pa0, bf16x8 pa1, bf16x8 pa2, bf16x8 pa3) {
#define TRRD(dst, off) asm volatile("ds_read_b64_tr_b16 %0, %1 offset:%2" : "=&v"(dst) : "v"(vb0), "i"(off) : "memory")
#define PV_D0(d0) do { s16x4 l0, l1, l2, l3, h0, h1, h2, h3; constexpr int b_ = (d0) * 512; \
        TRRD(l0, b_); TRRD(h0, b_ + 2048); TRRD(l1, b_ + 4096); TRRD(h1, b_ + 6144); TRRD(l2, b_ + 8192); TRRD(h2, b_ + 10240); TRRD(l3, b_ + 12288); TRRD(h3, b_ + 14336); \
        asm volatile("s_waitcnt lgkmcnt(0)" ::: "memory"); SBAR(); \
        o[d0] = __builtin_amdgcn_mfma_f32_32x32x16_bf16(pa0, (bf16x8){l0[0], l0[1], l0[2], l0[3], h0[0], h0[1], h0[2], h0[3]}, o[d0], 0, 0, 0);   \
        o[d0] = __builtin_amdgcn_mfma_f32_32x32x16_bf16(pa1, (bf16x8){l1[0], l1[1], l1[2], l1[3], h1[0], h1[1], h1[2], h1[3]}, o[d0], 0, 0, 0);   \
        o[d0] = __builtin_amdgcn_mfma_f32_32x32x16_bf16(pa2, (bf16x8){l2[0], l2[1], l2[2], l2[3], h2[0], h2[1], h2[2], h2[3]}, o[d0], 0, 0, 0);   \
        o[d0] = __builtin_amdgcn_mfma_f32_32x32x16_bf16(pa3, (bf16x8){l3[0], l3[1], l3[2], l3[3], h3[0], h3[1], h3[2], h3[3]}, o[d0], 0, 0, 0); } while (0)
    PV_D0(0); PV_D0(1); PV_D0(2); PV_D0(3);
#undef PV_D0
#undef TRRD
}
__device__ __forceinline__ void attn_unit(int b, int h, int qb, const bf16* Q, const bf16* K, const bf16* V, bf16* O, char* lds) {
    const int tid = threadIdx.x, wid = __builtin_amdgcn_readfirstlane(tid >> 6), lane = tid & 63, r32 = lane & 31, hi = lane >> 5;
    const size_t rowb = (size_t)b * SEQ;
    const int q0 = qb * QB, qlo = q0 + wid * QBLK;
    const int NT = (q0 + QB) / KVBLK;
    char* V_lds = lds + OFF_V; char* K_lds = lds + OFF_K;
#define WAVE_WS() ({ int t_ = (int)threadIdx.x; asm volatile("" : "+v"(t_)); (float*)(lds + OFF_WS) + (t_ >> 6) * 64; })
    LAS unsigned char* ldsl_ = (LAS unsigned char*)lds;
    unsigned ksrc[3], vsrc[2];
#pragma unroll
    for (int j = 0; j < 3; ++j) { const int s_ = (wid * 3 + j) * 64 + lane, row = s_ / 24, pc = s_ % 24; ksrc[j] = (unsigned)(row * 3072 * 2 + ((pc * 16) ^ ((row & 7) << 4))); }
#pragma unroll
    for (int j = 0; j < 2; ++j) { const int ob = ((wid * 2 + j) * 64 + lane) * 16, st = ob >> 9, kr_ = (ob >> 6) & 7, ch = (ob >> 4) & 3, c = (st & 3) * 32 + ch * 8, kk = (st >> 2) * 8 + kr_,
                                  k = (kk & ~0xC) | ((kk & 4) << 1) | ((kk & 8) >> 1); vsrc[j] = (unsigned)(k * 2048 * 2 + c * 2); }
    const char* Kh = (const char*)(K + rowb * 3072 + h * DQK); const char* Vh = (const char*)(V + rowb * 2048 + h * DV);
#define KDMA(k0, bf) do { _Pragma("unroll") for (int j = 0; j < 3; ++j) __builtin_amdgcn_global_load_lds((const unsigned*)(Kh + (size_t)(k0) * (3072 * 2) + ksrc[j]), \
        (LAS unsigned*)(ldsl_ + OFF_K + (bf) * SHM_K + (wid * 3 + j) * 1024), 16, 0, 0); } while (0)
#define VDMA(k0, sl) do { _Pragma("unroll") for (int j = 0; j < 2; ++j) __builtin_amdgcn_global_load_lds((const unsigned*)(Vh + (size_t)(k0) * (2048 * 2) + vsrc[j]), \
        (LAS unsigned*)(ldsl_ + OFF_V + (sl) * SHM_V + (wid * 2 + j) * 1024), 16, 0, 0); } while (0)
    KDMA(0, 0); VDMA(0, 0);
    bf16x8 qr[12];
    { const bf16* Qp = Q + (rowb + qlo + r32) * 3072 + h * DQK + hi * 8;
#pragma unroll
      for (int d0 = 0; d0 < 12; ++d0) qr[d0] = *(const bf16x8*)(Qp + d0 * 16); }
    asm volatile("s_waitcnt vmcnt(0)" ::: "memory");
    __syncthreads();
    float m_reg = -1e30f, l_reg = 0.f; f32x16 o[4] = {};
    const int vbase = (int)(uintptr_t)V_lds + v_rd_base(lane);
    const int qm = qlo + r32 - 4 * hi;
    f32x16 p0, p1;
#define SP_STAGE(VS) do { float mn, alpha; bf16x8 pa0, pa1, pa2, pa3; \
        partialSM(p0, p1, m_reg, mn, alpha); finishSM(p0, p1, alpha, l_reg, pa0, pa1, pa2, pa3); \
        if (__any(alpha < 1.f)) { float* al_l = WAVE_WS() + 32; if (hi == 0) al_l[r32] = alpha; asm volatile("s_waitcnt lgkmcnt(0)" ::: "memory"); \
            _Pragma("unroll") for (int d_ = 0; d_ < 4; ++d_) _Pragma("unroll") for (int r = 0; r < 16; ++r) o[d_][r] *= al_l[crow(r, hi)]; } \
        SBAR(); pv_tile(o, vbase + (VS) * SHM_V, pa0, pa1, pa2, pa3); } while (0)
    for (int t = 0; t < NT; ++t) {
        const int cur = t & 1, kb_ = t * KVBLK;
        if (t + 1 < NT) { KDMA((t + 1) * KVBLK, cur ^ 1); VDMA((t + 1) * KVBLK, cur ^ 1); }
        SBAR();
        qkt(p0, p1, K_lds + cur * SHM_K, r32, hi, qr); if (kb_ + KVBLK - 1 > qlo) mask_tile(p0, p1, qm - kb_);
        SBAR();
        SP_STAGE(cur);
        asm volatile("s_waitcnt vmcnt(0)" ::: "memory");
        __syncthreads();
    }
#undef SP_STAGE
    float* li_l = WAVE_WS();
    if (hi == 0) li_l[r32] = l_reg; asm volatile("s_waitcnt lgkmcnt(0)" ::: "memory");
    float rli[16];
#pragma unroll
    for (int r = 0; r < 16; ++r) rli[r] = __builtin_amdgcn_rcpf(li_l[crow(r, hi)]);
    bf16* Ow = O + (rowb + qlo) * 2048 + h * DV;
#pragma unroll
    for (int r = 0; r < 16; ++r) { const int orow = crow(r, hi);
#pragma unroll
        for (int d0 = 0; d0 < 4; ++d0) { const float v = o[d0][r] * rli[r];
            const float vn = __shfl_xor(v, 1);
            if ((r32 & 1) == 0) *(unsigned*)(Ow + (size_t)orow * 2048 + d0 * 32 + r32) = cvtpk(v, vn); } }
    __syncthreads();
#undef KDMA
#undef VDMA
#undef WAVE_WS
}
#undef SBAR
}

struct Args { const float* in[20]; float* out; unsigned char* ws; int ph_lo, ph_hi, coop, pad; };
#define XB_TMO      128
#define XB_XCNT(j)  (256  + 64 * (j))
#define XB_XSUB(j)  (1280 + 64 * (j))
#define XB_XGEN(j)  (2304 + 64 * (j))
#define XB_TOP      3328
#define XB_TOPGEN   3392
#define XCD_BAR_WORDS 3456
#define XB_SPIN_CAP (1u << 20)
__device__ __forceinline__ unsigned xb_ld(unsigned* p)              { return __hip_atomic_load(p, __ATOMIC_RELAXED, __HIP_MEMORY_SCOPE_AGENT); }
__device__ __forceinline__ unsigned xb_add(unsigned* p, unsigned v) { return __hip_atomic_fetch_add(p, v, __ATOMIC_RELAXED, __HIP_MEMORY_SCOPE_AGENT); }
__device__ __forceinline__ unsigned xb_xcc_id() { return (unsigned)__builtin_amdgcn_s_getreg((3 << 11) | 20) & 0xFu; }
#define XB_SPIN(cond, bar) do { unsigned _sp = 0; while (cond) { __builtin_amdgcn_s_sleep(1); \
    if ((++_sp & 255u) == 0u) { if (xb_ld(&(bar)[XB_TMO])) break; if (_sp > XB_SPIN_CAP) { atomicAdd(&(bar)[XB_TMO], 1u); break; } } } } while (0)
__device__ __forceinline__ void xcd_barrier_complete(unsigned* bar, unsigned x, unsigned& nloc, unsigned& nx) {
    const unsigned G = gridDim.x;
    unsigned sum, cnt, mine, sp = 0u;
    for (;;) {
        sum = 0u; cnt = 0u; mine = 0u;
#pragma unroll
        for (unsigned j = 0; j < 16; ++j) { const unsigned c = xb_ld(&bar[XB_XCNT(j)]); sum += c; cnt += (c > 0u) ? 1u : 0u; mine = (j == x) ? c : mine; }
        if (sum == G) break;
        __builtin_amdgcn_s_sleep(1);
        if ((++sp & 255u) == 0u) { if (xb_ld(&bar[XB_TMO])) break; if (sp > XB_SPIN_CAP) { atomicAdd(&bar[XB_TMO], 1u); break; } }
    }
    nloc = mine > 0u ? mine : 1u; nx = cnt > 0u ? cnt : 1u;
}
__device__ __forceinline__ void grid_bar(unsigned* bar, volatile LAS unsigned* st) {
    asm volatile("s_waitcnt vmcnt(0)" ::: "memory");
    __syncthreads();
    if (threadIdx.x == 0) {
        const unsigned x = xb_xcc_id();
        __builtin_amdgcn_s_waitcnt(0);
        unsigned nloc = st[0], nx = st[1];
        if (nloc == 0u) { xcd_barrier_complete(bar, x, nloc, nx); st[0] = nloc; st[1] = nx; }
        const unsigned old = xb_add(&bar[XB_XSUB(x)], 1u);
        const unsigned gen = old / nloc;
        if (old + 1u == (gen + 1u) * nloc) {
            __builtin_amdgcn_fence(__ATOMIC_RELEASE, "agent");
            asm volatile("s_waitcnt vmcnt(0)" ::: "memory");
            const unsigned og = xb_add(&bar[XB_TOP], 1u);
            const unsigned tg = og / nx;
            if (og + 1u == (tg + 1u) * nx) xb_add(&bar[XB_TOPGEN], 1u);
            else XB_SPIN(xb_ld(&bar[XB_TOPGEN]) == tg, bar);
            __builtin_amdgcn_fence(__ATOMIC_ACQUIRE, "agent");
            xb_add(&bar[XB_XGEN(x)], 1u);
            asm volatile("s_waitcnt vmcnt(0)" ::: "memory");
        } else {
            XB_SPIN(xb_ld(&bar[XB_XGEN(x)]) == gen, bar);
            __builtin_amdgcn_fence(__ATOMIC_ACQUIRE, "agent");
            asm volatile("s_waitcnt vmcnt(0)" ::: "memory");
        }
    }
    __syncthreads();
}
constexpr int NPH = 11;

__global__ void __launch_bounds__(NWAVES * 64, 2) mega_fwd(Args args) {
    extern __shared__ __attribute__((aligned(16))) unsigned char lds[];
    LAS unsigned char* ldsl = (LAS unsigned char*)lds;
    const int tid = threadIdx.x, lane = tid & 63, wave = __builtin_amdgcn_readfirstlane(tid >> 6);
    const int G = gridDim.x, bx = blockIdx.x;
    const int vcu = (G % 8 == 0) ? (bx % 8) * (G / 8) + bx / 8 : bx;
    const int gw = vcu * NWAVES + wave, NGW = G * NWAVES;
    unsigned char* ws = args.ws;
    const float* const* kin = (const float* const*)__builtin_amdgcn_kernarg_segment_ptr();
    const float* svec = (const float*)ws;
    const float* b_gate = svec + SV_BGATE; const float* q_a_norm_g = svec + SV_QAG; const float* kv_a_norm_g = svec + SV_KVAG; const float* q_norm_g = svec + SV_QNG;
    const float* k_norm_g = svec + SV_KNG; const float* pool_scale = svec + SV_PSC; const float* ffn_norm_g = svec + SV_FNG; const int* positions = (const int*)(svec + SV_POS);
    bf16* WIN_T = (bf16*)(ws + WS_WIN); bf16* WQB_T = (bf16*)(ws + WS_WQB); bf16* WKVB_T = (bf16*)(ws + WS_WKVB); bf16* WPG_T = (bf16*)(ws + WS_WPG);
    bf16* WPO_T = (bf16*)(ws + WS_WPO); bf16* WAO_T = (bf16*)(ws + WS_WAO); bf16* WOUT_T = (bf16*)(ws + WS_WOUT); bf16* WGU_T = (bf16*)(ws + WS_WGU); bf16* WDN_T = (bf16*)(ws + WS_WDN);
    bf16* XN = (bf16*)(ws + WS_XN); float* C1 = (float*)(ws + WS_C1); float* KRP = (float*)(ws + WS_KRP); bf16* U = (bf16*)(ws + WS_U); bf16* Gt = (bf16*)(ws + WS_G);
    bf16* CN = (bf16*)(ws + WS_CN); bf16* POOLED = (bf16*)(ws + WS_POOLED); bf16* Qb = (bf16*)(ws + WS_Q); bf16* Kb = (bf16*)(ws + WS_K); bf16* Vb = (bf16*)(ws + WS_V);
    bf16* PG = (bf16*)(ws + WS_PG); bf16* MP = (bf16*)(ws + WS_MP); bf16* Ob = (bf16*)(ws + WS_O); bf16* MIXED = (bf16*)(ws + WS_MIXED);
    float* X1 = (float*)(ws + WS_X1); bf16* H2 = (bf16*)(ws + WS_H2); bf16* ACT = (bf16*)(ws + WS_ACT);

    const int lo = args.ph_lo, hi_ph = args.ph_hi;
#ifndef PHMASK
#define PHMASK 0x7ff
#endif
#define IN(k) (((PHMASK >> (k)) & 1) && lo <= (k) && (k) < hi_ph)
#define SEAM(k) do { if (IN(k) && IN((k) + 1)) { unsigned char* w2_ = args.ws; asm volatile("" : "+s"(w2_)); grid_bar((unsigned*)(w2_ + WS_BAR), (volatile LAS unsigned*)(ldsl + 140032)); } } while (0)
    if (args.coop > 1) cg::this_grid().sync();
    if (threadIdx.x < 2) ((volatile LAS unsigned*)(ldsl + 140032))[threadIdx.x] = 0u;
    __syncthreads();
    if (args.coop && threadIdx.x == 0) { unsigned char* w2_ = args.ws; asm volatile("" : "+s"(w2_)); (void)xb_add(&((unsigned*)(w2_ + WS_BAR))[XB_XCNT(xb_xcc_id())], 1u); }
    LAS float* scr = (LAS float*)(ldsl + wave * 16384);
#ifdef TPROBE
#define TP_BEGIN(k) do { if ((TPROBE >> (k)) & 1) { if (blockIdx.x == 0 && threadIdx.x == 0) { *(volatile LAS unsigned*)(ldsl + 140000) = (unsigned)__builtin_amdgcn_s_memrealtime(); } } } while (0)
#define TP_END(k) do { if ((TPROBE >> (k)) & 1) { if (blockIdx.x == 0 && threadIdx.x == 0) { volatile LAS unsigned* tp_ = (volatile LAS unsigned*)(ldsl + 140000); tp_[1] += (unsigned)__builtin_amdgcn_s_memrealtime() - tp_[0]; } } } while (0)
    if (blockIdx.x == 0 && threadIdx.x == 0) { ((volatile LAS unsigned*)(ldsl + 140000))[1] = 0u; }
#else
#define TP_BEGIN(k) do {} while (0)
#define TP_END(k) do {} while (0)
#endif

    if (IN(0)) { TP_BEGIN(0);
        { float* sv = (float*)ws; const int gt = bx * (NWAVES * 64) + tid, GT = G * NWAVES * 64;
          for (int i = gt; i < M; i += GT) sv[SV_SS + i] = 0.f;
          for (int i = gt; i < SV_END; i += GT) { int idx, off, lim = 1 << 30;
              if (i < SV_QAG) { idx = 4; off = SV_BGATE; } else if (i < SV_KVAG) { idx = 5; off = SV_QAG; } else if (i < SV_QNG) { idx = 7; off = SV_KVAG; }
              else if (i < SV_KNG) { idx = 9; off = SV_QNG; lim = 192; } else if (i < SV_PSC) { idx = 10; off = SV_KNG; lim = 192; }
              else if (i < SV_FNG) { idx = 13; off = SV_PSC; } else if (i < SV_POS) { idx = 16; off = SV_FNG; } else { idx = 1; off = SV_POS; }
              const float* src = kin[idx]; sv[i] = (i - off < lim) ? src[i - off] : 0.f; } }
        constexpr int I_IN = (DM / 64) * (DIN / 32), I_QB = (QLORA / 64) * (NH * DQK / 32), I_KVB = (KVLORA / 64) * (NH * 256 / 32), I_PG = (256 / 64) * (256 / 32),
                      I_PO = (POOLW / 64) * (DM / 32), I_AO = (DM / 64) * (DM / 32), I_OUT = I_AO;
        constexpr int NITEMS = I_IN + I_QB + I_KVB + 4 * I_PG + I_PO + I_AO + I_OUT;
        for (int it = gw; it < NITEMS; it += NGW) {
            int r = it, idx, Kd, Nd, mode = 0, roff = 0; size_t dsto, srco = 0;
            if (r < I_IN) { idx = 3; Kd = DM; Nd = DIN; mode = 1; dsto = WS_WIN; }
            else if ((r -= I_IN) < I_QB) { idx = 6; Kd = QLORA; Nd = NH * DQK; dsto = WS_WQB; }
            else if ((r -= I_QB) < I_KVB) { idx = 8; Kd = KVLORA; Nd = NH * 256; dsto = WS_WKVB; }
            else if ((r -= I_KVB) < 4 * I_PG) { const int g = r / I_PG; r = r % I_PG; idx = 12; Kd = 256; Nd = 256; dsto = WS_WPG; roff = g * 256; srco = (size_t)g * 65536; }
            else if ((r -= 4 * I_PG) < I_PO) { idx = 14; Kd = POOLW; Nd = DM; dsto = WS_WPO; }
            else if ((r -= I_PO) < I_AO) { idx = 11; Kd = DM; Nd = DM; dsto = WS_WAO; }
            else { r -= I_AO; idx = 15; Kd = DM; Nd = DM; dsto = WS_WOUT; }
            transpose_item(kin[idx] + srco, Kd, Nd, (bf16*)(ws + dsto), mode, roff, scr, r, lane);
        }
        { v4u* z = (v4u*)(WIN_T + (size_t)DIN * DM); const int nz = (DIN_PAD - DIN) * DM / 8;
          for (int i = gw * 64 + lane; i < nz; i += NGW * 64) z[i] = (v4u){0u, 0u, 0u, 0u}; }
        { const float* x = kin[0]; const float* attn_norm_g = kin[2];
          for (int m = gw; m < M; m += NGW) rms_row_2048(x + (size_t)m * DM, attn_norm_g, XN + (size_t)m * DM, lane); }
    TP_END(0); }
    SEAM(0);
    if (IN(1)) { TP_BEGIN(1);
        { pg8::Gemm g{XN, WIN_T, M, 6144, DM, DM, DM, 0, 0}; pg8::StaticOrder S; S.init(M, 6144, G, bx);
          pg8::EpiIn E{C1, U, Gt, b_gate};
          pg8::gemm_phase<pg8::EpiIn, pg8::StaticOrder>(ldsl, g, S, E); }
        { pg8::Gemm g{XN, WIN_T + (size_t)6144 * DM, M, 2048, 256, DM, DM, 256, 256}; pg8::StaticOrder S; S.init(M, 2048, G, bx);
          pg8::EpiKRP E{KRP};
          pg8::gemm_phase<pg8::EpiKRP, pg8::StaticOrder>(ldsl, g, S, E); }
    TP_END(1); }
    SEAM(1);
    if (IN(2)) { TP_BEGIN(2);
        for (int m = gw; m < M; m += NGW) {
            const f32x4* c = (const f32x4*)(C1 + (size_t)m * 1024) + lane; f32x4 v[4]; float sq = 0.f, skv = 0.f;
#pragma unroll
            for (int j = 0; j < 4; ++j) { v[j] = c[64 * j]; const float s = (v[j].x * v[j].x + v[j].y * v[j].y) + (v[j].z * v[j].z + v[j].w * v[j].w); if (j < 2) sq += s; else skv += s; }
            const float iq = 1.0f / sqrtf(wave_sum(sq) * (1.f / 512.f) + EPS), ikv = 1.0f / sqrtf(wave_sum(skv) * (1.f / 512.f) + EPS);
            v2u* o8 = (v2u*)(CN + (size_t)m * 1024) + lane;
#pragma unroll
            for (int j = 0; j < 4; ++j) { const f32x4 gv = (j < 2) ? ((const f32x4*)q_a_norm_g)[lane + 64 * j] : ((const f32x4*)kv_a_norm_g)[lane + 64 * (j - 2)]; const float iv = (j < 2) ? iq : ikv;
                v2u o; o.x = cvtpk(v[j].x * iv * gv.x, v[j].y * iv * gv.y); o.y = cvtpk(v[j].z * iv * gv.z, v[j].w * iv * gv.w); o8[64 * j] = o; }
        }
        for (int m = gw; m < M; m += NGW) {
            const int s = m & (SEQ - 1);
#pragma unroll
            for (int jj = 0; jj < 2; ++jj) {
                const int col = 8 * lane + 512 * jj, grp = col >> 8, w = 2 << grp; const int cnt = (s + 1 < w) ? s + 1 : w;
                float a[8]; float u0[8];
#pragma unroll
                for (int e = 0; e < 8; ++e) a[e] = 0.f;
#pragma unroll
                for (int d = 0; d < 16; ++d) {
                    if (d < cnt) { const v4u q = *(const v4u*)(U + (size_t)(m - d) * 1024 + col);
                        const float f[8] = {bflo(q.x), bfhi(q.x), bflo(q.y), bfhi(q.y), bflo(q.z), bfhi(q.z), bflo(q.w), bfhi(q.w)};
#pragma unroll
                        for (int e = 0; e < 8; ++e) { a[e] += f[e]; if (d == 0) u0[e] = f[e]; } }
                }
                const float rc = 1.0f / (float)cnt;
                v4u o; o.x = cvtpk(a[0] * rc - u0[0], a[1] * rc - u0[1]); o.y = cvtpk(a[2] * rc - u0[2], a[3] * rc - u0[3]);
                o.z = cvtpk(a[4] * rc - u0[4], a[5] * rc - u0[5]); o.w = cvtpk(a[6] * rc - u0[6], a[7] * rc - u0[7]);
                *(v4u*)(POOLED + (size_t)m * 1024 + col) = o;
            }
        }
    TP_END(2); }
    SEAM(2);
    if (IN(3)) { TP_BEGIN(3);
        { pg8::Gemm g{CN, WQB_T, M, NH * DQK, QLORA, 1024, QLORA, 0, 0}; pg8::StaticOrder S; S.init(M, NH * DQK, G, bx);
          pg8::EpiBf16 E{Qb, 3072}; pg8::gemm_phase<pg8::EpiBf16, pg8::StaticOrder>(ldsl, g, S, E); }
        { pg8::Gemm g{CN + 512, WKVB_T, M, NH * 256, KVLORA, 1024, KVLORA, 0, 0}; pg8::StaticOrder S; S.init(M, NH * 256, G, bx);
          pg8::EpiKV E{Kb, Vb}; pg8::gemm_phase<pg8::EpiKV, pg8::StaticOrder>(ldsl, g, S, E); }
        { pg8::Gemm g{POOLED, WPG_T, M, POOLW, 256, 1024, 256, 256, 0}; pg8::StaticOrder S; S.init(M, POOLW, G, (bx + 128) % G);
          pg8::EpiScale E{PG, 1024, pool_scale}; pg8::gemm_phase<pg8::EpiScale, pg8::StaticOrder>(ldsl, g, S, E); }
    TP_END(3); }
    SEAM(3);
    if (IN(4)) { TP_BEGIN(4);
        for (int m = gw; m < M; m += NGW) {
            const float pos = (float)positions[m];
            const int sub = lane & 3, h = lane >> 2;
            float cs[8], sn[8];
#pragma unroll
            for (int j = 0; j < 8; ++j) { const int i = 8 * sub + j; const float invf = __builtin_amdgcn_exp2f(-(float)i * (13.287712379549449f / 32.f));
                const float ang = pos * invf; const float k = rintf(ang * 0.15915494309189535f);
                float r = fmaf(-k, 6.2831854820251465f, ang); r = fmaf(-k, -1.7484555e-7f, r);
                sn[j] = __sinf(r); cs[j] = __cosf(r); }
#pragma unroll
            for (int which = 0; which < 2; ++which) {
                bf16* base = (which == 0 ? Qb : Kb) + (size_t)m * 3072 + h * DQK;
                const float* gn = (which == 0) ? q_norm_g : k_norm_g;
                float nv[32], rl[8], rh[8]; float ss = 0.f;
#pragma unroll
                for (int jj = 0; jj < 4; ++jj) { const v4u q = *(const v4u*)(base + 32 * sub + 8 * jj);
                    nv[8 * jj + 0] = bflo(q.x); nv[8 * jj + 1] = bfhi(q.x); nv[8 * jj + 2] = bflo(q.y); nv[8 * jj + 3] = bfhi(q.y);
                    nv[8 * jj + 4] = bflo(q.z); nv[8 * jj + 5] = bfhi(q.z); nv[8 * jj + 6] = bflo(q.w); nv[8 * jj + 7] = bfhi(q.w); }
                if (which == 0) {
                    const v4u a = *(const v4u*)(base + 128 + 8 * sub), b = *(const v4u*)(base + 160 + 8 * sub);
                    rl[0] = bflo(a.x); rl[1] = bfhi(a.x); rl[2] = bflo(a.y); rl[3] = bfhi(a.y); rl[4] = bflo(a.z); rl[5] = bfhi(a.z); rl[6] = bflo(a.w); rl[7] = bfhi(a.w);
                    rh[0] = bflo(b.x); rh[1] = bfhi(b.x); rh[2] = bflo(b.y); rh[3] = bfhi(b.y); rh[4] = bflo(b.z); rh[5] = bfhi(b.z); rh[6] = bflo(b.w); rh[7] = bfhi(b.w);
                } else {
                    f32x4 a0 = {0.f, 0.f, 0.f, 0.f}, a1 = a0, b0 = a0, b1 = a0;
#pragma unroll
                    for (int ks = 0; ks < 8; ++ks) { const float* kp = KRP + ((size_t)ks * 8192 + m) * 64 + 8 * sub;
                        a0 += *(const f32x4*)kp; a1 += *(const f32x4*)(kp + 4); b0 += *(const f32x4*)(kp + 32); b1 += *(const f32x4*)(kp + 36); }
                    rl[0] = a0.x; rl[1] = a0.y; rl[2] = a0.z; rl[3] = a0.w; rl[4] = a1.x; rl[5] = a1.y; rl[6] = a1.z; rl[7] = a1.w;
                    rh[0] = b0.x; rh[1] = b0.y; rh[2] = b0.z; rh[3] = b0.w; rh[4] = b1.x; rh[5] = b1.y; rh[6] = b1.z; rh[7] = b1.w;
                }
#pragma unroll
                for (int e = 0; e < 32; ++e) ss += nv[e] * nv[e];
#pragma unroll
                for (int e = 0; e < 8; ++e) ss += rl[e] * rl[e] + rh[e] * rh[e];
                ss += __shfl_xor(ss, 1); ss += __shfl_xor(ss, 2);
                const float inv = 1.0f / sqrtf(ss * (1.f / 192.f) + EPS);
#pragma unroll
                for (int jj = 0; jj < 4; ++jj) { const f32x4 g0 = *(const f32x4*)(gn + 32 * sub + 8 * jj), g1 = *(const f32x4*)(gn + 32 * sub + 8 * jj + 4);
                    v4u o; o.x = cvtpk(nv[8 * jj + 0] * inv * g0.x, nv[8 * jj + 1] * inv * g0.y); o.y = cvtpk(nv[8 * jj + 2] * inv * g0.z, nv[8 * jj + 3] * inv * g0.w);
                    o.z = cvtpk(nv[8 * jj + 4] * inv * g1.x, nv[8 * jj + 5] * inv * g1.y); o.w = cvtpk(nv[8 * jj + 6] * inv * g1.z, nv[8 * jj + 7] * inv * g1.w);
                    *(v4u*)(base + 32 * sub + 8 * jj) = o; }
                float ol[8], oh[8];
#pragma unroll
                for (int e = 0; e < 8; ++e) { const float a = rl[e] * inv * gn[128 + 8 * sub + e], b = rh[e] * inv * gn[160 + 8 * sub + e];
                    ol[e] = a * cs[e] - b * sn[e]; oh[e] = b * cs[e] + a * sn[e]; }
                v4u o1, o2; o1.x = cvtpk(ol[0], ol[1]); o1.y = cvtpk(ol[2], ol[3]); o1.z = cvtpk(ol[4], ol[5]); o1.w = cvtpk(ol[6], ol[7]);
                o2.x = cvtpk(oh[0], oh[1]); o2.y = cvtpk(oh[2], oh[3]); o2.z = cvtpk(oh[4], oh[5]); o2.w = cvtpk(oh[6], oh[7]);
                *(v4u*)(base + 128 + 8 * sub) = o1; *(v4u*)(base + 160 + 8 * sub) = o2;
            }
        }
        { pg8::Gemm g{PG, WPO_T, M, DM, POOLW, POOLW, POOLW, 0, 0}; pg8::StaticOrder S; S.init(M, DM, G, bx);
          pg8::EpiGate<false> E{MP, Gt, nullptr, 0}; pg8::gemm_phase<pg8::EpiGate<false>, pg8::StaticOrder>(ldsl, g, S, E); }
    TP_END(4); }
    SEAM(4);
    if (IN(5)) { TP_BEGIN(5);
        const int npair = BATCH * NH * 8;
        for (int p = vcu; p < npair; p += G) {
            const int bh = p >> 3, s = p & 7;
            att::attn_unit(bh / NH, bh % NH, 15 - s, Qb, Kb, Vb, Ob, (char*)lds);
            att::attn_unit(bh / NH, bh % NH, s, Qb, Kb, Vb, Ob, (char*)lds);
        }
    TP_END(5); }
    SEAM(5);
    if (IN(6)) { TP_BEGIN(6);
        pg8::Gemm g{Ob, WAO_T, M, DM, DM, DM, DM, 0, 0}; pg8::StaticOrder S; S.init(M, DM, G, bx);
        pg8::EpiGate<true> E{MIXED, Gt, MP, 2048}; pg8::gemm_phase<pg8::EpiGate<true>, pg8::StaticOrder>(ldsl, g, S, E);
    TP_END(6); }
    SEAM(6);
    if (IN(7)) { TP_BEGIN(7);
        { constexpr int I_G = (DM / 64) * (DFF / 32);
          for (int it = gw; it < 2 * I_G; it += NGW) { int r = it, idx, mode; if (r < I_G) { idx = 17; mode = 2; } else { r -= I_G; idx = 18; mode = 3; }
              transpose_item(kin[idx], DM, DFF, (bf16*)(ws + WS_WGU), mode, 0, scr, r, lane, ffn_norm_g); }
          __syncthreads(); }
        pg8::Gemm g{MIXED, WOUT_T, M, DM, DM, DM, DM, 0, 0}; pg8::StaticOrder S; S.init(M, DM, G, bx);
        pg8::EpiResNorm E{kin[0], X1, (bf16*)(ws + WS_X1B), (float*)ws + SV_SS, DM}; pg8::gemm_phase<pg8::EpiResNorm, pg8::StaticOrder>(ldsl, g, S, E);
    TP_END(7); }
    SEAM(7);
    if (IN(9)) { TP_BEGIN(9);
        pg8::Gemm g{(bf16*)(ws + WS_X1B), WGU_T, M, 2 * DFF, DM, DM, DM, 0, 0}; pg8::StaticOrder S; S.init(M, 2 * DFF, G, bx);
        pg8::EpiSwiGLU E{ACT, DFF, (const float*)ws + SV_SS}; pg8::gemm_phase<pg8::EpiSwiGLU, pg8::StaticOrder>(ldsl, g, S, E);
        if (G == 256 ? (bx >= 128) : true) {
            constexpr int I_D2 = (DFF / 64) * (DM / 32);
            const int nw = (G == 256) ? 128 * NWAVES : NGW, w0 = (G == 256) ? (bx - 128) * NWAVES + wave : gw;
            for (int it = w0; it < I_D2; it += nw) transpose_item(kin[19], DFF, DM, (bf16*)(ws + WS_WDN), 0, 0, scr, it, lane);
        }
    TP_END(9); }
    SEAM(9);
    if (IN(10)) { TP_BEGIN(10);
        pg8::Gemm g{ACT, WDN_T, M, DM, DFF, DFF, DFF, 0, 0}; pg8::StaticOrder S; S.init(M, DM, G, bx);
        pg8::EpiRes E{X1, args.out, DM}; pg8::gemm_phase<pg8::EpiRes, pg8::StaticOrder>(ldsl, g, S, E);
    TP_END(10); }
#ifdef TPROBE
    if (blockIdx.x == 0 && threadIdx.x == 0) { const unsigned w_ = 4u * ((volatile LAS unsigned*)(ldsl + 140000))[1]; const unsigned long long t0_ = __builtin_amdgcn_s_memrealtime(); while ((unsigned)(__builtin_amdgcn_s_memrealtime() - t0_) < w_) __builtin_amdgcn_s_sleep(8); }
#endif
#undef IN
#undef SEAM
}

extern "C" void kernel_launch(void* const* d_in, const int* in_sizes, int n_in, void* d_out, int out_size, void* d_ws, size_t ws_size, hipStream_t stream) {
    static int grid = 0;
    if (grid == 0) {
        if (n_in != 20 || out_size != M * DM || ws_size < WS_END) { fprintf(stderr, "kernel_launch: unexpected shapes (n_in %d, out %d, ws %zu)\n", n_in, out_size, ws_size); grid = -1; return; }
        int dev = 0, cus = 0, per_cu = 0;
        (void)hipGetDevice(&dev); (void)hipDeviceGetAttribute(&cus, hipDeviceAttributeMultiprocessorCount, dev);
        if (hipFuncSetAttribute((const void*)mega_fwd, hipFuncAttributeMaxDynamicSharedMemorySize, LDS_BYTES) != hipSuccess) { fprintf(stderr, "kernel_launch: hipFuncSetAttribute failed\n"); grid = -1; return; }
        if (hipOccupancyMaxActiveBlocksPerMultiprocessor(&per_cu, (const void*)mega_fwd, NWAVES * 64, LDS_BYTES) != hipSuccess || per_cu < 1) { fprintf(stderr, "kernel_launch: occupancy query says %d\n", per_cu); per_cu = 1; }
        (void)hipGetLastError();
        grid = cus > 0 ? cus : 256;
    }
    if (grid < 0) return;
    Args a{};
    for (int i = 0; i < 20; ++i) a.in[i] = (const float*)d_in[i];
    a.out = (float*)d_out; a.ws = (unsigned char*)d_ws;
    if (MK_N_LAUNCHES == 1) {
        a.ph_lo = 0; a.ph_hi = NPH; a.coop = 1;
        (void)hipMemsetAsync((char*)d_ws + WS_BAR, 0, 16384, stream);
        void* kargs[] = {&a};
        hipError_t e = hipLaunchCooperativeKernel((const void*)mega_fwd, dim3(grid), dim3(NWAVES * 64), kargs, LDS_BYTES, stream);
        if (e != hipSuccess) fprintf(stderr, "kernel_launch: cooperative launch failed: %s (grid %d)\n", hipGetErrorString(e), grid);
    } else {
        for (int p = 0; p < NPH; ++p) {
            a.ph_lo = p; a.ph_hi = p + 1;
            hipLaunchKernelGGL(mega_fwd, dim3(grid), dim3(NWAVES * 64), LDS_BYTES, stream, a);
        }
    }
}
```

```cpp
#include <hip/hip_runtime.h>
#include <hip/hip_cooperative_groups.h>
#include <cstdio>
#include <cstdint>
namespace cg = cooperative_groups;

#ifndef MK_N_LAUNCHES
#define MK_N_LAUNCHES 1
#endif

namespace pg8 {
#define PG8_LAS __attribute__((address_space(3)))
typedef unsigned short bf16_t;
typedef short bf16x8 __attribute__((ext_vector_type(8)));
typedef float f32x4 __attribute__((ext_vector_type(4)));
typedef unsigned u32x4 __attribute__((ext_vector_type(4)));
constexpr int BM = 256, BK = 64, HALF = 128, HTB = HALF * BK * 2, STAGE_BYTES = 8 * HTB, NXCD = 8, WGM = 8;

__host__ __device__ __forceinline__ int lds_byte(int r, int c) { const int st = (r >> 4) * 2 + (c >> 5), rr = r & 15, cc = c & 31, ob = rr * 64 + cc * 2; return st * 1024 + (ob ^ (((ob >> 9) & 1) << 5)); }
__host__ __device__ __forceinline__ void stage_rc(int b, int& R, int& C) { const int st = b / 1024, sb = b % 1024, swz = sb ^ (((sb >> 9) & 1) << 5); R = (st >> 1) * 16 + swz / 64; C = (st & 1) * 32 + (swz % 64) / 2; }
__host__ __device__ __forceinline__ int perm32(int rho) { const int n = rho >> 4, i = rho & 15; return 8 * (i >> 2) + 4 * n + (i & 3); }

struct Unit { int pm, pn; };
struct Gemm { const bf16_t* A; const bf16_t* Bt; int M, N, K, lda, ldb, a_pn_step, b_pn_step; };

struct StaticOrder {
    int nM, nN, nwg, G, c;
    __host__ __device__ void init(int M, int N, int G_, int c_) { nM = M / BM; nN = N / BM; nwg = nM * nN; G = G_; c = c_; }
    __host__ __device__ bool next(int i, Unit& u) const {
        const long L = (long)i * G + c; if (L >= nwg) return false;
        int wgid = (int)L; { const int q = nwg / NXCD, r = nwg % NXCD, xcd = wgid % NXCD, off = wgid / NXCD; wgid = (xcd < r ? xcd * (q + 1) : r * (q + 1) + (xcd - r) * q) + off; }
        const int nig = WGM * nN, gid = wgid / nig, fm = gid * WGM, gsz = (nM - fm) < WGM ? (nM - fm) : WGM;
        u.pm = fm + ((wgid % nig) % gsz); u.pn = (wgid % nig) / gsz; return true;
    }
};

typedef float f32x2_t_ __attribute__((ext_vector_type(2))); typedef __bf16 bf16x2_t_ __attribute__((ext_vector_type(2)));
__device__ __forceinline__ unsigned cvt_pk_bf16(float lo, float hi) { f32x2_t_ v = {lo, hi}; bf16x2_t_ b = __builtin_convertvector(v, bf16x2_t_); return __builtin_bit_cast(unsigned, b); }
__device__ __forceinline__ u32x4 pack8(f32x4 a, f32x4 b) { u32x4 w; w.x = cvt_pk_bf16(a[0], a[1]); w.y = cvt_pk_bf16(a[2], a[3]); w.z = cvt_pk_bf16(b[0], b[1]); w.w = cvt_pk_bf16(b[2], b[3]); return w; }
__device__ __forceinline__ void unpack8(u32x4 w, f32x4& a, f32x4& b) {
    a[0] = __uint_as_float(w.x << 16); a[1] = __uint_as_float(w.x & 0xffff0000u); a[2] = __uint_as_float(w.y << 16); a[3] = __uint_as_float(w.y & 0xffff0000u);
    b[0] = __uint_as_float(w.z << 16); b[1] = __uint_as_float(w.z & 0xffff0000u); b[2] = __uint_as_float(w.w << 16); b[3] = __uint_as_float(w.w & 0xffff0000u); }
__device__ __forceinline__ float sigmoidf_(float v) { return __builtin_amdgcn_rcpf(1.0f + __builtin_amdgcn_exp2f(-1.4426950408889634f * v)); }
__device__ __forceinline__ f32x4 sigmoid4(f32x4 v) { f32x4 o; o[0] = sigmoidf_(v[0]); o[1] = sigmoidf_(v[1]); o[2] = sigmoidf_(v[2]); o[3] = sigmoidf_(v[3]); return o; }

typedef f32x4 AccT[2][2][4][2];
#define EPI_LOOP_AM _Pragma("unroll") for (int ai = 0; ai < 2; ++ai) _Pragma("unroll") for (int m = 0; m < 4; ++m)
#define EPI_LOOP_B _Pragma("unroll") for (int bj = 0; bj < 2; ++bj)

struct EpiIn {
    static constexpr bool PERM = true;
    float* C1; bf16_t* U; bf16_t* G; const float* bgate;
    __device__ __forceinline__ void operator()(const AccT& acc, const Unit& u, int wr, int wc, int fr, int fq) const {
        const int row0 = u.pm * BM + wr * 64 + fr, pn = u.pn, cw = wc * 32 + 8 * fq;
        if (pn < 4) {
            EPI_LOOP_AM { float* rp = C1 + (size_t)(row0 + ai * HALF + m * 16) * 1024 + pn * 256 + cw;
                EPI_LOOP_B { *(f32x4*)(rp + bj * HALF) = acc[ai][bj][m][0]; *(f32x4*)(rp + bj * HALF + 4) = acc[ai][bj][m][1]; } }
        } else if (pn < 8) {
            EPI_LOOP_AM { bf16_t* rp = U + (size_t)(row0 + ai * HALF + m * 16) * 1024 + (pn - 4) * 256 + cw;
                EPI_LOOP_B { *(u32x4*)(rp + bj * HALF) = pack8(acc[ai][bj][m][0], acc[ai][bj][m][1]); } }
        } else {
            const int gc = (pn - 8) * 256 + cw; f32x4 bv[2][2];
            EPI_LOOP_B { bv[bj][0] = *(const f32x4*)(bgate + gc + bj * HALF); bv[bj][1] = *(const f32x4*)(bgate + gc + bj * HALF + 4); }
            EPI_LOOP_AM { bf16_t* rp = G + (size_t)(row0 + ai * HALF + m * 16) * 4096 + gc;
                EPI_LOOP_B { *(u32x4*)(rp + bj * HALF) = pack8(sigmoid4(acc[ai][bj][m][0] + bv[bj][0]), sigmoid4(acc[ai][bj][m][1] + bv[bj][1])); } }
        }
    }
};
struct EpiKRP {
    static constexpr bool PERM = true;
    float* KRP;
    __device__ __forceinline__ void operator()(const AccT& acc, const Unit& u, int wr, int wc, int fr, int fq) const {
        const int row0 = u.pm * BM + wr * 64 + fr, cw = wc * 32 + 8 * fq;
        if (wc < 2) { EPI_LOOP_AM { float* rp = KRP + ((size_t)u.pn * 8192 + (row0 + ai * HALF + m * 16)) * 64 + cw; *(f32x4*)rp = acc[ai][0][m][0]; *(f32x4*)(rp + 4) = acc[ai][0][m][1]; } }
    }
};
struct EpiBf16 {
    static constexpr bool PERM = true;
    bf16_t* O; int ldc;
    __device__ __forceinline__ void operator()(const AccT& acc, const Unit& u, int wr, int wc, int fr, int fq) const {
        const int row0 = u.pm * BM + wr * 64 + fr, col0 = u.pn * BM + wc * 32 + 8 * fq;
        EPI_LOOP_AM { bf16_t* rp = O + (size_t)(row0 + ai * HALF + m * 16) * ldc + col0;
            EPI_LOOP_B { *(u32x4*)(rp + bj * HALF) = pack8(acc[ai][bj][m][0], acc[ai][bj][m][1]); } }
    }
};
struct EpiKV {
    static constexpr bool PERM = true;
    bf16_t* K; bf16_t* V;
    __device__ __forceinline__ void operator()(const AccT& acc, const Unit& u, int wr, int wc, int fr, int fq) const {
        const int row0 = u.pm * BM + wr * 64 + fr, cw = wc * 32 + 8 * fq, h = u.pn;
        EPI_LOOP_AM { const size_t row = (size_t)(row0 + ai * HALF + m * 16);
            *(u32x4*)(K + row * 3072 + h * 192 + cw) = pack8(acc[ai][0][m][0], acc[ai][0][m][1]);
            *(u32x4*)(V + row * 2048 + h * 128 + cw) = pack8(acc[ai][1][m][0], acc[ai][1][m][1]); }
    }
};
struct EpiScale {
    static constexpr bool PERM = true;
    bf16_t* O; int ldc; const float* scale;
    __device__ __forceinline__ void operator()(const AccT& acc, const Unit& u, int wr, int wc, int fr, int fq) const {
        const int row0 = u.pm * BM + wr * 64 + fr, col0 = u.pn * BM + wc * 32 + 8 * fq; f32x4 sv[2][2];
        EPI_LOOP_B { sv[bj][0] = *(const f32x4*)(scale + col0 + bj * HALF); sv[bj][1] = *(const f32x4*)(scale + col0 + bj * HALF + 4); }
        EPI_LOOP_AM { bf16_t* rp = O + (size_t)(row0 + ai * HALF + m * 16) * ldc + col0;
            EPI_LOOP_B { *(u32x4*)(rp + bj * HALF) = pack8(acc[ai][bj][m][0] * sv[bj][0], acc[ai][bj][m][1] * sv[bj][1]); } }
    }
};
template <bool HAS_ADD> struct EpiGate {
    static constexpr bool PERM = true;
    bf16_t* O; const bf16_t* gate; const bf16_t* add; int gcol0;
    __device__ __forceinline__ void operator()(const AccT& acc, const Unit& u, int wr, int wc, int fr, int fq) const {
        const int row0 = u.pm * BM + wr * 64 + fr, col0 = u.pn * BM + wc * 32 + 8 * fq;
        EPI_LOOP_AM { const size_t row = (size_t)(row0 + ai * HALF + m * 16);
            EPI_LOOP_B { f32x4 g0, g1; unpack8(*(const u32x4*)(gate + row * 4096 + gcol0 + col0 + bj * HALF), g0, g1);
                f32x4 v0 = g0 * acc[ai][bj][m][0], v1 = g1 * acc[ai][bj][m][1];
                if (HAS_ADD) { f32x4 a0, a1; unpack8(*(const u32x4*)(add + row * 2048 + col0 + bj * HALF), a0, a1); v0 += a0; v1 += a1; }
                *(u32x4*)(O + row * 2048 + col0 + bj * HALF) = pack8(v0, v1); } }
    }
};
struct EpiRes {
    static constexpr bool PERM = false;
    const float* base; float* out; int ldc;
    __device__ __forceinline__ void operator()(const AccT& acc, const Unit& u, int wr, int wc, int fr, int fq) const {
        const int row0 = u.pm * BM + wr * 64 + fr, col0 = u.pn * BM + wc * 32 + 4 * fq;
        EPI_LOOP_AM { const size_t off = (size_t)(row0 + ai * HALF + m * 16) * ldc + col0;
            EPI_LOOP_B {
#pragma unroll
                for (int n = 0; n < 2; ++n) { const f32x4 b = *(const f32x4*)(base + off + bj * HALF + n * 16); *(f32x4*)(out + off + bj * HALF + n * 16) = b + acc[ai][bj][m][n]; } } }
    }
};
struct EpiResNorm {
    static constexpr bool PERM = false;
    const float* base; float* out; bf16_t* outb; float* ss; int ldc;
    __device__ __forceinline__ void operator()(const AccT& acc, const Unit& u, int wr, int wc, int fr, int fq) const {
        const int row0 = u.pm * BM + wr * 64 + fr, col0 = u.pn * BM + wc * 32 + 4 * fq;
        EPI_LOOP_AM { const int row = row0 + ai * HALF + m * 16; const size_t off = (size_t)row * ldc + col0; float s = 0.f;
            EPI_LOOP_B {
#pragma unroll
                for (int n = 0; n < 2; ++n) { const f32x4 v = *(const f32x4*)(base + off + bj * HALF + n * 16) + acc[ai][bj][m][n]; *(f32x4*)(out + off + bj * HALF + n * 16) = v;
                    typedef unsigned u32x2_ __attribute__((ext_vector_type(2))); u32x2_ w; w.x = cvt_pk_bf16(v[0], v[1]); w.y = cvt_pk_bf16(v[2], v[3]); *(u32x2_*)(outb + off + bj * HALF + n * 16) = w;
                    s += (v[0] * v[0] + v[1] * v[1]) + (v[2] * v[2] + v[3] * v[3]); } }
            s += __shfl_xor(s, 16); s += __shfl_xor(s, 32);
            if (fq == 0) atomicAdd(ss + row, s); }
    }
};
struct EpiSwiGLU {
    static constexpr bool PERM = true;
    bf16_t* O; int ldc; const float* ss;
    __device__ __forceinline__ void operator()(const AccT& acc, const Unit& u, int wr, int wc, int fr, int fq) const {
        const int row0 = u.pm * BM + wr * 64 + fr, col0 = u.pn * HALF + wc * 32 + 8 * fq;
        EPI_LOOP_AM { const int row = row0 + ai * HALF + m * 16; bf16_t* rp = O + (size_t)row * ldc + col0;
            const float inv = 1.0f / sqrtf(ss[row] * (1.f / 2048.f) + 1e-6f);
            const f32x4 g0 = acc[ai][0][m][0] * inv, g1 = acc[ai][0][m][1] * inv;
            *(u32x4*)rp = pack8(g0 * sigmoid4(g0) * (acc[ai][1][m][0] * inv), g1 * sigmoid4(g1) * (acc[ai][1][m][1] * inv)); }
    }
};

template <class Epi, class Sched, bool ALIGN_EPI = true>
__device__ __forceinline__ void gemm_phase(PG8_LAS unsigned char* lds, const Gemm g, const Sched& S, const Epi& E) {
    const int tid = threadIdx.x, wid = __builtin_amdgcn_readfirstlane(tid >> 6), lane = tid & 63, wr = wid >> 2, wc = wid & 3, fr = lane & 15, fq = lane >> 4;
    const int K = g.K, nt = K / BK;
    unsigned voffA[2], voffB[2];
#pragma unroll
    for (int i = 0; i < 2; ++i) { int R, C; stage_rc(tid * 16 + i * 8192, R, C); const int Rb = Epi::PERM ? ((R & ~31) + perm32(R & 31)) : R;
        voffA[i] = (unsigned)(R * g.lda + C) * 2u; voffB[i] = (unsigned)(Rb * g.ldb + C) * 2u; }
    const size_t kstep = (size_t)(BK * 2);
    const size_t hstepA = (size_t)HALF * g.lda * 2, hstepB = (size_t)HALF * g.ldb * 2;
    const size_t tstepA = 2 * hstepA, tstepB = g.b_pn_step ? (size_t)g.b_pn_step * 2 : 2 * hstepB, pstepA = (size_t)g.a_pn_step * 2;
    const unsigned ldsw = (unsigned)wid * 1024u;
    const int aoff = lds_byte(wr * 64 + fr, fq * 8), boff = lds_byte(wc * 32 + fr, fq * 8);
#define PG8_SA(b, h) (((b) * 2 + (h)) * HTB)
#define PG8_SB(b, h) ((4 + (b) * 2 + (h)) * HTB)
#define PG8_STAGE(bufoff, gbase, voff) do { _Pragma("unroll") for (int _i = 0; _i < 2; ++_i) \
        __builtin_amdgcn_global_load_lds((const unsigned*)((const char*)(gbase) + (voff)[_i]), (PG8_LAS unsigned*)(lds + (bufoff) + ldsw + _i * 8192), 16, 0, 0); } while (0)
#define PG8_LDA(dst, b, h) do { _Pragma("unroll") for (int m = 0; m < 4; ++m) _Pragma("unroll") for (int k = 0; k < 2; ++k) dst[m][k] = *(const PG8_LAS bf16x8*)(lds + PG8_SA(b, h) + aoff + m * 2048 + k * 1024); } while (0)
#define PG8_LDB(dst, b, h) do { _Pragma("unroll") for (int n = 0; n < 2; ++n) _Pragma("unroll") for (int k = 0; k < 2; ++k) dst[n][k] = *(const PG8_LAS bf16x8*)(lds + PG8_SB(b, h) + boff + n * 2048 + k * 1024); } while (0)
#define PG8_MMA(ai, bj, At, Bt) do { __builtin_amdgcn_s_setprio(1); _Pragma("unroll") for (int m = 0; m < 4; ++m) _Pragma("unroll") for (int n = 0; n < 2; ++n) _Pragma("unroll") for (int k = 0; k < 2; ++k) \
        acc[ai][bj][m][n] = __builtin_amdgcn_mfma_f32_16x16x32_bf16(Bt[n][k], At[m][k], acc[ai][bj][m][n], 0, 0, 0); __builtin_amdgcn_s_setprio(0); } while (0)
#define PG8_WAIT_V(n) asm volatile("s_waitcnt vmcnt(" #n ")" ::: "memory")
#define PG8_WAIT_L(n) asm volatile("s_waitcnt lgkmcnt(" #n ")" ::: "memory")
#define PG8_BAR __builtin_amdgcn_s_barrier()
#define PG8_SCHED __builtin_amdgcn_sched_barrier(0)
    Unit cur, nxt; int ui = 0;
    if (!S.next(0, cur)) return;
    f32x4 acc[2][2][4][2];
#pragma unroll
    for (int a = 0; a < 2; ++a)
#pragma unroll
        for (int b = 0; b < 2; ++b)
#pragma unroll
            for (int m = 0; m < 4; ++m)
#pragma unroll
                for (int n = 0; n < 2; ++n) acc[a][b][m][n] = (f32x4){0.f, 0.f, 0.f, 0.f};
    bf16x8 At[4][2], B0[2][2], B1[2][2];
    const char* cA = (const char*)g.A + (size_t)cur.pm * tstepA + (size_t)cur.pn * pstepA; const char* cB = (const char*)g.Bt + (size_t)cur.pn * tstepB;
    PG8_STAGE(PG8_SB(0, 0), cB, voffB); PG8_STAGE(PG8_SB(0, 1), cB + hstepB, voffB); PG8_STAGE(PG8_SA(0, 0), cA, voffA); PG8_STAGE(PG8_SA(0, 1), cA + hstepA, voffA);
    if (wr == 1) PG8_BAR;
    PG8_WAIT_V(2); PG8_BAR;
    PG8_STAGE(PG8_SB(1, 0), cB + kstep, voffB); PG8_STAGE(PG8_SA(1, 0), cA + kstep, voffA); PG8_STAGE(PG8_SB(1, 1), cB + hstepB + kstep, voffB);
    PG8_WAIT_V(6); PG8_BAR;
    for (;;) {
        const bool has_next = S.next(ui + 1, nxt);
        const char* nA = has_next ? (const char*)g.A + (size_t)nxt.pm * tstepA + (size_t)nxt.pn * pstepA : cA; const char* nB = has_next ? (const char*)g.Bt + (size_t)nxt.pn * tstepB : cB;
        for (int t = 0; t < nt; t += 2) {
            const bool last = (t == nt - 2);
            const char* a1 = cA + (size_t)(t + 1) * kstep;
            const char* a2 = last ? nA : cA + (size_t)(t + 2) * kstep; const char* b2 = last ? nB : cB + (size_t)(t + 2) * kstep;
            const char* a3 = a2 + kstep; const char* b3 = b2 + kstep;
            PG8_LDB(B0, 0, 0); PG8_LDB(B1, 0, 1); PG8_SCHED; PG8_LDA(At, 0, 0); PG8_STAGE(PG8_SA(1, 1), a1 + hstepA, voffA);
            PG8_WAIT_V(8); PG8_WAIT_L(0); PG8_BAR; PG8_MMA(0, 0, At, B0); PG8_MMA(0, 1, At, B1); PG8_BAR; PG8_SCHED;
            PG8_LDA(At, 0, 1); PG8_STAGE(PG8_SB(0, 0), b2, voffB); PG8_STAGE(PG8_SB(0, 1), b2 + hstepB, voffB); PG8_STAGE(PG8_SA(0, 0), a2, voffA);
            PG8_WAIT_V(8); PG8_WAIT_L(0); PG8_BAR; PG8_MMA(1, 0, At, B0); PG8_MMA(1, 1, At, B1); PG8_BAR; PG8_SCHED;
            PG8_LDB(B0, 1, 0); PG8_LDB(B1, 1, 1); PG8_SCHED; PG8_LDA(At, 1, 0); PG8_STAGE(PG8_SA(0, 1), a2 + hstepA, voffA);
            PG8_WAIT_V(8); PG8_WAIT_L(0); PG8_BAR; PG8_MMA(0, 0, At, B0); PG8_MMA(0, 1, At, B1); PG8_BAR; PG8_SCHED;
            PG8_LDA(At, 1, 1); PG8_STAGE(PG8_SB(1, 0), b3, voffB); PG8_STAGE(PG8_SB(1, 1), b3 + hstepB, voffB); PG8_STAGE(PG8_SA(1, 0), a3, voffA);
            PG8_WAIT_V(8); PG8_WAIT_L(0); PG8_BAR; PG8_MMA(1, 0, At, B0); PG8_MMA(1, 1, At, B1); PG8_BAR; PG8_SCHED;
        }
        if constexpr (ALIGN_EPI) { if (wr == 0) PG8_BAR; }
        E(acc, cur, wr, wc, fr, fq);
        if (!has_next) break;
#pragma unroll
        for (int a = 0; a < 2; ++a)
#pragma unroll
            for (int b = 0; b < 2; ++b)
#pragma unroll
                for (int m = 0; m < 4; ++m)
#pragma unroll
                    for (int n = 0; n < 2; ++n) acc[a][b][m][n] = (f32x4){0.f, 0.f, 0.f, 0.f};
        cur = nxt; cA = nA; cB = nB; ++ui;
        if constexpr (ALIGN_EPI) { if (wr == 1) PG8_BAR; }
    }
    PG8_WAIT_V(0);
    if constexpr (!ALIGN_EPI) { if (wr == 0) PG8_BAR; }
    PG8_BAR;
#undef PG8_SA
#undef PG8_SB
#undef PG8_STAGE
#undef PG8_LDA
#undef PG8_LDB
#undef PG8_MMA
#undef PG8_WAIT_V
#undef PG8_WAIT_L
#undef PG8_BAR
#undef PG8_SCHED
}
}

constexpr int BATCH = 2, SEQ = 4096, DM = 2048, M = BATCH * SEQ;
constexpr int NH = 16, DQK = 192, DNOPE = 128, DROPE = 64, DV = 128, QLORA = 512, KVLORA = 512;
constexpr int POOLW = 1024, DIN = 6208, DIN_PAD = 6400, DFF = 5632;
constexpr float EPS = 1e-6f;
constexpr int NWAVES = 8;

typedef unsigned short bf16;
typedef unsigned v4u __attribute__((ext_vector_type(4)));
typedef unsigned v2u __attribute__((ext_vector_type(2)));
typedef float f32x4 __attribute__((ext_vector_type(4)));
typedef short bf16x8 __attribute__((ext_vector_type(8)));
typedef short s16x4 __attribute__((ext_vector_type(4)));
typedef float f32x16 __attribute__((ext_vector_type(16)));
#define LAS __attribute__((address_space(3)))
#define LDS_WAIT() asm volatile("s_waitcnt lgkmcnt(0)" ::: "memory")

constexpr size_t MiB = 1u << 20;
constexpr size_t WS_WAO = 1 * MiB, WS_WOUT = 9 * MiB, WS_WPO = 17 * MiB, WS_WQB = 21 * MiB, WS_WKVB = 24 * MiB, WS_WPG = 28 * MiB, WS_KR = 29 * MiB;
constexpr size_t WS_G = 31 * MiB;
constexpr size_t WS_WIN = 95 * MiB, WS_XN = 120 * MiB, WS_C1 = 152 * MiB, WS_U = 184 * MiB;
constexpr size_t WS_Q = 95 * MiB, WS_K = 143 * MiB, WS_V = 191 * MiB, WS_CN = 223 * MiB, WS_POOLED = 239 * MiB, WS_PG = 255 * MiB;
constexpr size_t WS_MP = 223 * MiB, WS_O = 255 * MiB, WS_MIXED = 95 * MiB, WS_X1 = 127 * MiB, WS_H2 = 95 * MiB;
constexpr size_t WS_WGU = 191 * MiB, WS_WDN = 235 * MiB, WS_ACT = 1 * MiB;
constexpr size_t WS_END = 296 * MiB, WS_BAR = 512 * 1024, WS_KRP = 272 * MiB, WS_X1B = 257 * MiB;
constexpr int SV_BGATE = 0, SV_QAG = 4096, SV_KVAG = 4608, SV_QNG = 5120, SV_KNG = 5376, SV_PSC = 5632, SV_FNG = 6656, SV_POS = 8704, SV_END = 8704 + 8192, SV_SS = 32768;

constexpr int LDS_BYTES = 147456;

__device__ __forceinline__ unsigned cvtpk(float lo, float hi) { return pg8::cvt_pk_bf16(lo, hi); }
__device__ __forceinline__ float bflo(unsigned w) { return __uint_as_float(w << 16); }
__device__ __forceinline__ float bfhi(unsigned w) { return __uint_as_float(w & 0xffff0000u); }
__device__ __forceinline__ float wave_sum(float v) {
#pragma unroll
    for (int o = 1; o < 64; o <<= 1) v += __shfl_xor(v, o);
    return v;
}

__device__ __forceinline__ int dst_row(int mode, int n0) {
    if (mode == 1) { if (n0 < 1024) return n0; if (n0 < 1088) return 6144 + (n0 - 1024); if (n0 < 2112) return 1024 + (n0 - 1088); return 2048 + (n0 - 2112); }
    if (mode == 2) return (n0 >> 7) * 256 + (n0 & 127);
    if (mode == 3) return (n0 >> 7) * 256 + 128 + (n0 & 127);
    return n0;
}
__device__ __forceinline__ void transpose_item(const float* W, int K, int N, bf16* WT, int mode, int row_off, LAS float* scr, int item, int lane, const float* gk = nullptr) {
    const int nblk = N / 32, kb = item / nblk, nb = item % nblk, k0 = 64 * kb, n0 = 32 * nb;
    { float tv[32]; const float* wp = W + (size_t)(k0 + (lane >> 5)) * N + n0 + (lane & 31);
#pragma unroll
      for (int i = 0; i < 32; ++i) tv[i] = wp[(size_t)(2 * i) * N];
      if (gk) {
#pragma unroll
          for (int i = 0; i < 32; ++i) tv[i] *= gk[k0 + 2 * i + (lane >> 5)]; }
#pragma unroll
      for (int i = 0; i < 32; ++i) scr[(2 * i + (lane >> 5)) * 33 + (lane & 31)] = tv[i]; }
    LDS_WAIT(); asm volatile("" ::: "memory");
    const int c = lane & 7, dr = row_off + dst_row(mode, n0);
#pragma unroll
    for (int j = 0; j < 4; ++j) { const int n = (lane >> 3) + 8 * j; const LAS float* s = scr + (8 * c) * 33 + n;
        v4u o; o.x = cvtpk(s[0 * 33], s[1 * 33]); o.y = cvtpk(s[2 * 33], s[3 * 33]); o.z = cvtpk(s[4 * 33], s[5 * 33]); o.w = cvtpk(s[6 * 33], s[7 * 33]);
        *(v4u*)(WT + (size_t)(dr + n) * K + k0 + 8 * c) = o; }
    LDS_WAIT(); asm volatile("" ::: "memory");
}

__device__ __forceinline__ void rms_row_2048(const float* xrow, const float* g, bf16* orow, int lane) {
    const f32x4* xr = (const f32x4*)xrow + lane; const f32x4* gr = (const f32x4*)g + lane;
    f32x4 v[8]; float s = 0.f;
#pragma unroll
    for (int j = 0; j < 8; ++j) { v[j] = xr[64 * j]; s += (v[j].x * v[j].x + v[j].y * v[j].y) + (v[j].z * v[j].z + v[j].w * v[j].w); }
    const float inv = 1.0f / sqrtf(wave_sum(s) * (1.f / 2048.f) + EPS);
    v2u* o8 = (v2u*)orow + lane;
#pragma unroll
    for (int j = 0; j < 8; ++j) { const f32x4 gv = gr[64 * j]; v2u o; o.x = cvtpk(v[j].x * inv * gv.x, v[j].y * inv * gv.y); o.y = cvtpk(v[j].z * inv * gv.z, v[j].w * inv * gv.w); o8[64 * j] = o; }
}

namespace att {
constexpr int QBLK = 32, KVBLK = 64, QB = 256;
constexpr int SHM_V = KVBLK * DV * 2, SHM_K = KVBLK * DQK * 2;
constexpr int OFF_V = 0, OFF_K = 3 * SHM_V, OFF_WS = OFF_K + 2 * SHM_K;
constexpr float SCALE = 0.07216878364870322f;
constexpr float THR = 8.f;
#define KSWZ(row, colB) ((row) * 384 + ((colB) ^ (((row) & 7) << 4)))
#define SBAR() __builtin_amdgcn_sched_barrier(0)
__device__ __forceinline__ int v_st(int k, int c) { const int kk = (k & ~0xC) | ((k & 4) << 1) | ((k & 8) >> 1); return ((kk >> 3) * 4 + (c >> 5)) * 512 + ((kk & 7) * 32 + (c & 31)) * 2; }
__device__ __forceinline__ int v_rd_base(int lane) { return ((lane & 3) << 3) | (((lane >> 2) & 3) << 6) | (((lane >> 4) & 1) << 5) | (((lane >> 5) & 1) << 8); }
__device__ __forceinline__ int crow(int r, int hi) { return (r & 3) + 8 * (r >> 2) + 4 * hi; }
__device__ __forceinline__ void mask_tile(f32x16& p0, f32x16& p1, int dq) {
    const float NEG = -__builtin_inff();
#pragma unroll
    for (int r = 0; r < 16; ++r) {
        const int c = (r & 3) + 8 * (r >> 2);
        if (dq - c < 0) p0[r] = NEG;
        if (dq - c - 32 < 0) p1[r] = NEG;
    }
}
__device__ __forceinline__ void partialSM(f32x16& p0, f32x16& p1, float& m_reg, float& mn, float& alpha) {
    float pmax = p0[0];
#pragma unroll
    for (int r = 1; r < 16; ++r) pmax = fmaxf(pmax, p0[r]);
#pragma unroll
    for (int r = 0; r < 16; ++r) pmax = fmaxf(pmax, p1[r]);
    { auto rr = __builtin_amdgcn_permlane32_swap(__float_as_uint(pmax), __float_as_uint(pmax), false, false);
      pmax = fmaxf(__uint_as_float(rr[0]), __uint_as_float(rr[1])); }
    constexpr float C2 = 1.4426950408889634f * SCALE;
    if (__builtin_expect(__all((pmax - m_reg) * SCALE <= THR), 1)) { mn = m_reg; alpha = 1.f; }
    else { mn = fmaxf(m_reg, pmax); alpha = __builtin_amdgcn_exp2f((m_reg - mn) * C2); m_reg = mn; }
    const float mnL = -mn * C2;
#pragma unroll
    for (int r = 0; r < 16; ++r) p0[r] = fmaf(p0[r], C2, mnL);
#pragma unroll
    for (int r = 0; r < 16; ++r) p1[r] = fmaf(p1[r], C2, mnL);
#pragma unroll
    for (int r = 0; r < 16; ++r) p0[r] = __builtin_amdgcn_exp2f(p0[r]);
}
__device__ __forceinline__ void finishSM(f32x16& p0, f32x16& p1, float alpha, float& l_reg, bf16x8& pa0, bf16x8& pa1, bf16x8& pa2, bf16x8& pa3) {
#pragma unroll
    for (int r = 0; r < 16; ++r) p1[r] = __builtin_amdgcn_exp2f(p1[r]);
    float ps = 0;
#pragma unroll
    for (int r = 0; r < 16; ++r) ps += p0[r];
#pragma unroll
    for (int r = 0; r < 16; ++r) ps += p1[r];
    { auto rr = __builtin_amdgcn_permlane32_swap(__float_as_uint(ps), __float_as_uint(ps), false, false);
      ps = __uint_as_float(rr[0]) + __uint_as_float(rr[1]); }
    l_reg = l_reg * alpha + ps;
#define PK4(P, B_, OUT) do { unsigned a0 = cvtpk(P[B_+0], P[B_+1]), a1 = cvtpk(P[B_+2], P[B_+3]);                          \
        unsigned b0 = cvtpk(P[B_+4], P[B_+5]), b1 = cvtpk(P[B_+6], P[B_+7]);                                             \
        auto r0 = __builtin_amdgcn_permlane32_swap(a0, b0, false, false); auto r1 = __builtin_amdgcn_permlane32_swap(a1, b1, false, false); \
        v4u w = {r0[0], r1[0], r0[1], r1[1]}; OUT = *reinterpret_cast<bf16x8*>(&w); } while (0)
    PK4(p0, 0, pa0); PK4(p0, 8, pa1); PK4(p1, 0, pa2); PK4(p1, 8, pa3);
#undef PK4
}
__device__ __forceinline__ void qkt(f32x16& p0, f32x16& p1, const char* Kb, int r32, int hi, const bf16x8* qr) {
    p0 = f32x16{}; p1 = f32x16{};
    const char* kb[4];
#pragma unroll
    for (int dd = 0; dd < 4; ++dd) kb[dd] = Kb + KSWZ(r32, (dd * 16 + hi * 8) * 2);
#pragma unroll
    for (int g = 0; g < 2; ++g) { bf16x8 b0[6], b1[6];
#pragma unroll
        for (int i = 0; i < 6; ++i) { const int d0 = 6 * g + i; const char* a = kb[d0 & 3] + (d0 >> 2) * 128; b0[i] = *reinterpret_cast<const bf16x8*>(a); b1[i] = *reinterpret_cast<const bf16x8*>(a + 32 * 384); }
        SBAR();
#pragma unroll
        for (int i = 0; i < 6; ++i) { p0 = __builtin_amdgcn_mfma_f32_32x32x16_bf16(b0[i], qr[6 * g + i], p0, 0, 0, 0); p1 = __builtin_amdgcn_mfma_f32_32x32x16_bf16(b1[i], qr[6 * g + i], p1, 0, 0, 0); }
        SBAR(); }
}
__device__ __forceinline__ void pv_tile(f32x16* o, int vb0, bf16x8 pa0, bf16x8 pa1, bf16x8 pa2, bf16x8 pa3) {
#define TRRD(dst, off) asm volatile("ds_read_b64_tr_b16 %0, %1 offset:%2" : "=&v"(dst) : "v"(vb0), "i"(off) : "memory")
#define PV_RD(S, d0) do { constexpr int b_ = (d0) * 512; TRRD(S##l0, b_); TRRD(S##h0, b_ + 2048); TRRD(S##l1, b_ + 4096); TRRD(S##h1, b_ + 6144); TRRD(S##l2, b_ + 8192); TRRD(S##h2, b_ + 10240); TRRD(S##l3, b_ + 12288); TRRD(S##h3, b_ + 14336); } while (0)
#define PV_MM(S, d0) do { \
        o[d0] = __builtin_amdgcn_mfma_f32_32x32x16_bf16(pa0, (bf16x8){S##l0[0], S##l0[1], S##l0[2], S##l0[3], S##h0[0], S##h0[1], S##h0[2], S##h0[3]}, o[d0], 0, 0, 0);   \
        o[d0] = __builtin_amdgcn_mfma_f32_32x32x16_bf16(pa1, (bf16x8){S##l1[0], S##l1[1], S##l1[2], S##l1[3], S##h1[0], S##h1[1], S##h1[2], S##h1[3]}, o[d0], 0, 0, 0);   \
        o[d0] = __builtin_amdgcn_mfma_f32_32x32x16_bf16(pa2, (bf16x8){S##l2[0], S##l2[1], S##l2[2], S##l2[3], S##h2[0], S##h2[1], S##h2[2], S##h2[3]}, o[d0], 0, 0, 0);   \
        o[d0] = __builtin_amdgcn_mfma_f32_32x32x16_bf16(pa3, (bf16x8){S##l3[0], S##l3[1], S##l3[2], S##l3[3], S##h3[0], S##h3[1], S##h3[2], S##h3[3]}, o[d0], 0, 0, 0); } while (0)
    s16x4 Al0, Al1, Al2, Al3, Ah0, Ah1, Ah2, Ah3, Bl0, Bl1, Bl2, Bl3, Bh0, Bh1, Bh2, Bh3;
    PV_RD(A, 0); PV_RD(B, 1);
    asm volatile("s_waitcnt lgkmcnt(8)" ::: "memory"); SBAR(); PV_MM(A, 0); SBAR();
    PV_RD(A, 2);
    asm volatile("s_waitcnt lgkmcnt(8)" ::: "memory"); SBAR(); PV_MM(B, 1); SBAR();
    PV_RD(B, 3);
    asm volatile("s_waitcnt lgkmcnt(8)" ::: "memory"); SBAR(); PV_MM(A, 2); SBAR();
    asm volatile("s_waitcnt lgkmcnt(0)" ::: "memory"); SBAR(); PV_MM(B, 3);
#undef PV_MM
#undef PV_RD
#undef TRRD
}
__device__ __forceinline__ void attn_unit(int b, int h, int qb, const bf16* Q, const bf16* K, const bf16* V, bf16* O, char* lds) {
    const int tid = threadIdx.x, wid = __builtin_amdgcn_readfirstlane(tid >> 6), lane = tid & 63, r32 = lane & 31, hi = lane >> 5;
    const size_t rowb = (size_t)b * SEQ;
    const int q0 = qb * QB, qlo = q0 + wid * QBLK;
    const int NT = (q0 + QB) / KVBLK;
    char* V_lds = lds + OFF_V; char* K_lds = lds + OFF_K;
#define WAVE_WS() ({ int t_ = (int)threadIdx.x; asm volatile("" : "+v"(t_)); (float*)(lds + OFF_WS) + (t_ >> 6) * 64; })
    LAS unsigned char* ldsl_ = (LAS unsigned char*)lds;
    unsigned ksrc[3], vsrc[2];
#pragma unroll
    for (int j = 0; j < 3; ++j) { const int s_ = (wid * 3 + j) * 64 + lane, row = s_ / 24, pc = s_ % 24; ksrc[j] = (unsigned)(row * 3072 * 2 + ((pc * 16) ^ ((row & 7) << 4))); }
#pragma unroll
    for (int j = 0; j < 2; ++j) { const int ob = ((wid * 2 + j) * 64 + lane) * 16, st = ob >> 9, kr_ = (ob >> 6) & 7, ch = (ob >> 4) & 3, c = (st & 3) * 32 + ch * 8, kk = (st >> 2) * 8 + kr_,
                                  k = (kk & ~0xC) | ((kk & 4) << 1) | ((kk & 8) >> 1); vsrc[j] = (unsigned)(k * 2048 * 2 + c * 2); }
    const char* Kh = (const char*)(K + rowb * 3072 + h * DQK); const char* Vh = (const char*)(V + rowb * 2048 + h * DV);
#define KDMA(k0, bf) do { _Pragma("unroll") for (int j = 0; j < 3; ++j) __builtin_amdgcn_global_load_lds((const unsigned*)(Kh + (size_t)(k0) * (3072 * 2) + ksrc[j]), \
        (LAS unsigned*)(ldsl_ + OFF_K + (bf) * SHM_K + (wid * 3 + j) * 1024), 16, 0, 0); } while (0)
#define VDMA(k0, sl) do { _Pragma("unroll") for (int j = 0; j < 2; ++j) __builtin_amdgcn_global_load_lds((const unsigned*)(Vh + (size_t)(k0) * (2048 * 2) + vsrc[j]), \
        (LAS unsigned*)(ldsl_ + OFF_V + (sl) * SHM_V + (wid * 2 + j) * 1024), 16, 0, 0); } while (0)
    KDMA(0, 0); VDMA(0, 0);
    bf16x8 qr[12];
    { const bf16* Qp = Q + (rowb + qlo + r32) * 3072 + h * DQK + hi * 8;
#pragma unroll
      for (int d0 = 0; d0 < 12; ++d0) qr[d0] = *(const bf16x8*)(Qp + d0 * 16); }
    asm volatile("s_waitcnt vmcnt(0)" ::: "memory");
    __syncthreads();
    float m_reg = -1e30f, l_reg = 0.f; f32x16 o[4] = {};
    const int vbase = (int)(uintptr_t)V_lds + v_rd_base(lane);
    const int qm = qlo + r32 - 4 * hi;
    f32x16 p0, p1;
#define SP_STAGE(VS) do { float mn, alpha; bf16x8 pa0, pa1, pa2, pa3; \
        partialSM(p0, p1, m_reg, mn, alpha); finishSM(p0, p1, alpha, l_reg, pa0, pa1, pa2, pa3); \
        if (__any(alpha < 1.f)) { float* al_l = WAVE_WS() + 32; if (hi == 0) al_l[r32] = alpha; asm volatile("s_waitcnt lgkmcnt(0)" ::: "memory"); \
            _Pragma("unroll") for (int d_ = 0; d_ < 4; ++d_) _Pragma("unroll") for (int r = 0; r < 16; ++r) o[d_][r] *= al_l[crow(r, hi)]; } \
        SBAR(); pv_tile(o, vbase + (VS) * SHM_V, pa0, pa1, pa2, pa3); } while (0)
    for (int t = 0; t < NT; ++t) {
        const int cur = t & 1, kb_ = t * KVBLK;
        if (t + 1 < NT) { KDMA((t + 1) * KVBLK, cur ^ 1); VDMA((t + 1) * KVBLK, cur ^ 1); }
        SBAR();
        qkt(p0, p1, K_lds + cur * SHM_K, r32, hi, qr); if (kb_ + KVBLK - 1 > qlo) mask_tile(p0, p1, qm - kb_);
        SBAR();
        SP_STAGE(cur);
        asm volatile("s_waitcnt vmcnt(0)" ::: "memory");
        __syncthreads();
    }
#undef SP_STAGE
    float* li_l = WAVE_WS();
    if (hi == 0) li_l[r32] = l_reg; asm volatile("s_waitcnt lgkmcnt(0)" ::: "memory");
    float rli[16];
#pragma unroll
    for (int r = 0; r < 16; ++r) rli[r] = __builtin_amdgcn_rcpf(li_l[crow(r, hi)]);
    bf16* Ow = O + (rowb + qlo) * 2048 + h * DV;
#pragma unroll
    for (int r = 0; r < 16; ++r) { const int orow = crow(r, hi);
#pragma unroll
        for (int d0 = 0; d0 < 4; ++d0) { const float v = o[d0][r] * rli[r];
            const float vn = __shfl_xor(v, 1);
            if ((r32 & 1) == 0) *(unsigned*)(Ow + (size_t)orow * 2048 + d0 * 32 + r32) = cvtpk(v, vn); } }
    __syncthreads();
#undef KDMA
#undef VDMA
#undef WAVE_WS
}
#undef SBAR
}

struct Args { const float* in[20]; float* out; unsigned char* ws; int ph_lo, ph_hi, coop, pad; };
#define XB_TMO      128
#define XB_XCNT(j)  (256  + 64 * (j))
#define XB_XSUB(j)  (1280 + 64 * (j))
#define XB_XGEN(j)  (2304 + 64 * (j))
#define XB_TOP      3328
#define XB_TOPGEN   3392
#define XCD_BAR_WORDS 3456
#define XB_SPIN_CAP (1u << 20)
__device__ __forceinline__ unsigned xb_ld(unsigned* p)              { return __hip_atomic_load(p, __ATOMIC_RELAXED, __HIP_MEMORY_SCOPE_AGENT); }
__device__ __forceinline__ unsigned xb_add(unsigned* p, unsigned v) { return __hip_atomic_fetch_add(p, v, __ATOMIC_RELAXED, __HIP_MEMORY_SCOPE_AGENT); }
__device__ __forceinline__ unsigned xb_xcc_id() { return (unsigned)__builtin_amdgcn_s_getreg((3 << 11) | 20) & 0xFu; }
#define XB_SPIN(cond, bar) do { unsigned _sp = 0; while (cond) { __builtin_amdgcn_s_sleep(1); \
    if ((++_sp & 255u) == 0u) { if (xb_ld(&(bar)[XB_TMO])) break; if (_sp > XB_SPIN_CAP) { atomicAdd(&(bar)[XB_TMO], 1u); break; } } } } while (0)
__device__ __forceinline__ void xcd_barrier_complete(unsigned* bar, unsigned x, unsigned& nloc, unsigned& nx) {
    const unsigned G = gridDim.x;
    unsigned sum, cnt, mine, sp = 0u;
    for (;;) {
        sum = 0u; cnt = 0u; mine = 0u;
#pragma unroll
        for (unsigned j = 0; j < 16; ++j) { const unsigned c = xb_ld(&bar[XB_XCNT(j)]); sum += c; cnt += (c > 0u) ? 1u : 0u; mine = (j == x) ? c : mine; }
        if (sum == G) break;
        __builtin_amdgcn_s_sleep(1);
        if ((++sp & 255u) == 0u) { if (xb_ld(&bar[XB_TMO])) break; if (sp > XB_SPIN_CAP) { atomicAdd(&bar[XB_TMO], 1u); break; } }
    }
    nloc = mine > 0u ? mine : 1u; nx = cnt > 0u ? cnt : 1u;
}
__device__ __forceinline__ void grid_bar(unsigned* bar, volatile LAS unsigned* st) {
    asm volatile("s_waitcnt vmcnt(0)" ::: "memory");
    __syncthreads();
    if (threadIdx.x == 0) {
        const unsigned x = xb_xcc_id();
        __builtin_amdgcn_s_waitcnt(0);
        unsigned nloc = st[0], nx = st[1];
        if (nloc == 0u) { xcd_barrier_complete(bar, x, nloc, nx); st[0] = nloc; st[1] = nx; }
        const unsigned old = xb_add(&bar[XB_XSUB(x)], 1u);
        const unsigned gen = old / nloc;
        if (old + 1u == (gen + 1u) * nloc) {
            __builtin_amdgcn_fence(__ATOMIC_RELEASE, "agent");
            asm volatile("s_waitcnt vmcnt(0)" ::: "memory");
            const unsigned og = xb_add(&bar[XB_TOP], 1u);
            const unsigned tg = og / nx;
            if (og + 1u == (tg + 1u) * nx) xb_add(&bar[XB_TOPGEN], 1u);
            else XB_SPIN(xb_ld(&bar[XB_TOPGEN]) == tg, bar);
            __builtin_amdgcn_fence(__ATOMIC_ACQUIRE, "agent");
            xb_add(&bar[XB_XGEN(x)], 1u);
            asm volatile("s_waitcnt vmcnt(0)" ::: "memory");
        } else {
            XB_SPIN(xb_ld(&bar[XB_XGEN(x)]) == gen, bar);
            __builtin_amdgcn_fence(__ATOMIC_ACQUIRE, "agent");
            asm volatile("s_waitcnt vmcnt(0)" ::: "memory");
        }
    }
    __syncthreads();
}
constexpr int NPH = 11;

__global__ void __launch_bounds__(NWAVES * 64, 2) mega_fwd(Args args) {
    extern __shared__ __attribute__((aligned(16))) unsigned char lds[];
    LAS unsigned char* ldsl = (LAS unsigned char*)lds;
    const int tid = threadIdx.x, lane = tid & 63, wave = __builtin_amdgcn_readfirstlane(tid >> 6);
    const int G = gridDim.x, bx = blockIdx.x;
    const int vcu = (G % 8 == 0) ? (bx % 8) * (G / 8) + bx / 8 : bx;
    const int gw = vcu * NWAVES + wave, NGW = G * NWAVES;
    unsigned char* ws = args.ws;
    const float* const* kin = (const float* const*)__builtin_amdgcn_kernarg_segment_ptr();
    const float* svec = (const float*)ws;
    const float* b_gate = svec + SV_BGATE; const float* q_a_norm_g = svec + SV_QAG; const float* kv_a_norm_g = svec + SV_KVAG; const float* q_norm_g = svec + SV_QNG;
    const float* k_norm_g = svec + SV_KNG; const float* pool_scale = svec + SV_PSC; const float* ffn_norm_g = svec + SV_FNG; const int* positions = (const int*)(svec + SV_POS);
    bf16* WIN_T = (bf16*)(ws + WS_WIN); bf16* WQB_T = (bf16*)(ws + WS_WQB); bf16* WKVB_T = (bf16*)(ws + WS_WKVB); bf16* WPG_T = (bf16*)(ws + WS_WPG);
    bf16* WPO_T = (bf16*)(ws + WS_WPO); bf16* WAO_T = (bf16*)(ws + WS_WAO); bf16* WOUT_T = (bf16*)(ws + WS_WOUT); bf16* WGU_T = (bf16*)(ws + WS_WGU); bf16* WDN_T = (bf16*)(ws + WS_WDN);
    bf16* XN = (bf16*)(ws + WS_XN); float* C1 = (float*)(ws + WS_C1); float* KRP = (float*)(ws + WS_KRP); bf16* U = (bf16*)(ws + WS_U); bf16* Gt = (bf16*)(ws + WS_G);
    bf16* CN = (bf16*)(ws + WS_CN); bf16* POOLED = (bf16*)(ws + WS_POOLED); bf16* Qb = (bf16*)(ws + WS_Q); bf16* Kb = (bf16*)(ws + WS_K); bf16* Vb = (bf16*)(ws + WS_V);
    bf16* PG = (bf16*)(ws + WS_PG); bf16* MP = (bf16*)(ws + WS_MP); bf16* Ob = (bf16*)(ws + WS_O); bf16* MIXED = (bf16*)(ws + WS_MIXED);
    float* X1 = (float*)(ws + WS_X1); bf16* H2 = (bf16*)(ws + WS_H2); bf16* ACT = (bf16*)(ws + WS_ACT);

    const int lo = args.ph_lo, hi_ph = args.ph_hi;
#ifndef PHMASK
#define PHMASK 0x7ff
#endif
#define IN(k) (((PHMASK >> (k)) & 1) && lo <= (k) && (k) < hi_ph)
#define SEAM(k) do { if (IN(k) && IN((k) + 1)) { unsigned char* w2_ = args.ws; asm volatile("" : "+s"(w2_)); grid_bar((unsigned*)(w2_ + WS_BAR), (volatile LAS unsigned*)(ldsl + 140032)); } } while (0)
    if (args.coop > 1) cg::this_grid().sync();
    if (threadIdx.x < 2) ((volatile LAS unsigned*)(ldsl + 140032))[threadIdx.x] = 0u;
    __syncthreads();
    if (args.coop && threadIdx.x == 0) { unsigned char* w2_ = args.ws; asm volatile("" : "+s"(w2_)); (void)xb_add(&((unsigned*)(w2_ + WS_BAR))[XB_XCNT(xb_xcc_id())], 1u); }
    LAS float* scr = (LAS float*)(ldsl + wave * 16384);
#ifdef TPROBE
#define TP_BEGIN(k) do { if ((TPROBE >> (k)) & 1) { if (blockIdx.x == 0 && threadIdx.x == 0) { *(volatile LAS unsigned*)(ldsl + 140000) = (unsigned)__builtin_amdgcn_s_memrealtime(); } } } while (0)
#define TP_END(k) do { if ((TPROBE >> (k)) & 1) { if (blockIdx.x == 0 && threadIdx.x == 0) { volatile LAS unsigned* tp_ = (volatile LAS unsigned*)(ldsl + 140000); tp_[1] += (unsigned)__builtin_amdgcn_s_memrealtime() - tp_[0]; } } } while (0)
    if (blockIdx.x == 0 && threadIdx.x == 0) { ((volatile LAS unsigned*)(ldsl + 140000))[1] = 0u; }
#else
#define TP_BEGIN(k) do {} while (0)
#define TP_END(k) do {} while (0)
#endif

    if (IN(0)) { TP_BEGIN(0);
        { float* sv = (float*)ws; const int gt = bx * (NWAVES * 64) + tid, GT = G * NWAVES * 64;
          for (int i = gt; i < M; i += GT) sv[SV_SS + i] = 0.f;
          for (int i = gt; i < SV_END; i += GT) { int idx, off, lim = 1 << 30;
              if (i < SV_QAG) { idx = 4; off = SV_BGATE; } else if (i < SV_KVAG) { idx = 5; off = SV_QAG; } else if (i < SV_QNG) { idx = 7; off = SV_KVAG; }
              else if (i < SV_KNG) { idx = 9; off = SV_QNG; lim = 192; } else if (i < SV_PSC) { idx = 10; off = SV_KNG; lim = 192; }
              else if (i < SV_FNG) { idx = 13; off = SV_PSC; } else if (i < SV_POS) { idx = 16; off = SV_FNG; } else { idx = 1; off = SV_POS; }
              const float* src = kin[idx]; sv[i] = (i - off < lim) ? src[i - off] : 0.f; } }
        constexpr int I_IN = (DM / 64) * (DIN / 32), I_QB = (QLORA / 64) * (NH * DQK / 32), I_KVB = (KVLORA / 64) * (NH * 256 / 32), I_PG = (256 / 64) * (256 / 32),
                      I_PO = (POOLW / 64) * (DM / 32), I_AO = (DM / 64) * (DM / 32), I_OUT = I_AO;
        constexpr int NITEMS = I_IN + I_QB + I_KVB + 4 * I_PG + I_PO + I_AO + I_OUT;
        for (int it = gw; it < NITEMS; it += NGW) {
            int r = it, idx, Kd, Nd, mode = 0, roff = 0; size_t dsto, srco = 0;
            if (r < I_IN) { idx = 3; Kd = DM; Nd = DIN; mode = 1; dsto = WS_WIN; }
            else if ((r -= I_IN) < I_QB) { idx = 6; Kd = QLORA; Nd = NH * DQK; dsto = WS_WQB; }
            else if ((r -= I_QB) < I_KVB) { idx = 8; Kd = KVLORA; Nd = NH * 256; dsto = WS_WKVB; }
            else if ((r -= I_KVB) < 4 * I_PG) { const int g = r / I_PG; r = r % I_PG; idx = 12; Kd = 256; Nd = 256; dsto = WS_WPG; roff = g * 256; srco = (size_t)g * 65536; }
            else if ((r -= 4 * I_PG) < I_PO) { idx = 14; Kd = POOLW; Nd = DM; dsto = WS_WPO; }
            else if ((r -= I_PO) < I_AO) { idx = 11; Kd = DM; Nd = DM; dsto = WS_WAO; }
            else { r -= I_AO; idx = 15; Kd = DM; Nd = DM; dsto = WS_WOUT; }
            transpose_item(kin[idx] + srco, Kd, Nd, (bf16*)(ws + dsto), mode, roff, scr, r, lane);
        }
        { v4u* z = (v4u*)(WIN_T + (size_t)DIN * DM); const int nz = (DIN_PAD - DIN) * DM / 8;
          for (int i = gw * 64 + lane; i < nz; i += NGW * 64) z[i] = (v4u){0u, 0u, 0u, 0u}; }
        { const float* x = kin[0]; const float* attn_norm_g = kin[2];
          for (int m = gw; m < M; m += NGW) rms_row_2048(x + (size_t)m * DM, attn_norm_g, XN + (size_t)m * DM, lane); }
    TP_END(0); }
    SEAM(0);
    if (IN(1)) { TP_BEGIN(1);
        { pg8::Gemm g{XN, WIN_T, M, 6144, DM, DM, DM, 0, 0}; pg8::StaticOrder S; S.init(M, 6144, G, bx);
          pg8::EpiIn E{C1, U, Gt, b_gate};
          pg8::gemm_phase<pg8::EpiIn, pg8::StaticOrder>(ldsl, g, S, E); }
        { pg8::Gemm g{XN, WIN_T + (size_t)6144 * DM, M, 2048, 256, DM, DM, 256, 256}; pg8::StaticOrder S; S.init(M, 2048, G, bx);
          pg8::EpiKRP E{KRP};
          pg8::gemm_phase<pg8::EpiKRP, pg8::StaticOrder>(ldsl, g, S, E); }
    TP_END(1); }
    SEAM(1);
    if (IN(2)) { TP_BEGIN(2);
        for (int m = gw; m < M; m += NGW) {
            const f32x4* c = (const f32x4*)(C1 + (size_t)m * 1024) + lane; f32x4 v[4]; float sq = 0.f, skv = 0.f;
#pragma unroll
            for (int j = 0; j < 4; ++j) { v[j] = c[64 * j]; const float s = (v[j].x * v[j].x + v[j].y * v[j].y) + (v[j].z * v[j].z + v[j].w * v[j].w); if (j < 2) sq += s; else skv += s; }
            const float iq = 1.0f / sqrtf(wave_sum(sq) * (1.f / 512.f) + EPS), ikv = 1.0f / sqrtf(wave_sum(skv) * (1.f / 512.f) + EPS);
            v2u* o8 = (v2u*)(CN + (size_t)m * 1024) + lane;
#pragma unroll
            for (int j = 0; j < 4; ++j) { const f32x4 gv = (j < 2) ? ((const f32x4*)q_a_norm_g)[lane + 64 * j] : ((const f32x4*)kv_a_norm_g)[lane + 64 * (j - 2)]; const float iv = (j < 2) ? iq : ikv;
                v2u o; o.x = cvtpk(v[j].x * iv * gv.x, v[j].y * iv * gv.y); o.y = cvtpk(v[j].z * iv * gv.z, v[j].w * iv * gv.w); o8[64 * j] = o; }
        }
        for (int m = gw; m < M; m += NGW) {
            const int s = m & (SEQ - 1);
#pragma unroll
            for (int jj = 0; jj < 2; ++jj) {
                const int col = 8 * lane + 512 * jj, grp = col >> 8, w = 2 << grp; const int cnt = (s + 1 < w) ? s + 1 : w;
                float a[8]; float u0[8];
#pragma unroll
                for (int e = 0; e < 8; ++e) a[e] = 0.f;
#pragma unroll
                for (int d = 0; d < 16; ++d) {
                    if (d < cnt) { const v4u q = *(const v4u*)(U + (size_t)(m - d) * 1024 + col);
                        const float f[8] = {bflo(q.x), bfhi(q.x), bflo(q.y), bfhi(q.y), bflo(q.z), bfhi(q.z), bflo(q.w), bfhi(q.w)};
#pragma unroll
                        for (int e = 0; e < 8; ++e) { a[e] += f[e]; if (d == 0) u0[e] = f[e]; } }
                }
                const float rc = 1.0f / (float)cnt;
                v4u o; o.x = cvtpk(a[0] * rc - u0[0], a[1] * rc - u0[1]); o.y = cvtpk(a[2] * rc - u0[2], a[3] * rc - u0[3]);
                o.z = cvtpk(a[4] * rc - u0[4], a[5] * rc - u0[5]); o.w = cvtpk(a[6] * rc - u0[6], a[7] * rc - u0[7]);
                *(v4u*)(POOLED + (size_t)m * 1024 + col) = o;
            }
        }
    TP_END(2); }
    SEAM(2);
    if (IN(3)) { TP_BEGIN(3);
        { pg8::Gemm g{CN, WQB_T, M, NH * DQK, QLORA, 1024, QLORA, 0, 0}; pg8::StaticOrder S; S.init(M, NH * DQK, G, bx);
          pg8::EpiBf16 E{Qb, 3072}; pg8::gemm_phase<pg8::EpiBf16, pg8::StaticOrder>(ldsl, g, S, E); }
        { pg8::Gemm g{CN + 512, WKVB_T, M, NH * 256, KVLORA, 1024, KVLORA, 0, 0}; pg8::StaticOrder S; S.init(M, NH * 256, G, bx);
          pg8::EpiKV E{Kb, Vb}; pg8::gemm_phase<pg8::EpiKV, pg8::StaticOrder>(ldsl, g, S, E); }
        { pg8::Gemm g{POOLED, WPG_T, M, POOLW, 256, 1024, 256, 256, 0}; pg8::StaticOrder S; S.init(M, POOLW, G, (bx + 128) % G);
          pg8::EpiScale E{PG, 1024, pool_scale}; pg8::gemm_phase<pg8::EpiScale, pg8::StaticOrder>(ldsl, g, S, E); }
    TP_END(3); }
    SEAM(3);
    if (IN(4)) { TP_BEGIN(4);
        for (int m = gw; m < M; m += NGW) {
            const float pos = (float)positions[m];
            const int sub = lane & 3, h = lane >> 2;
            float cs[8], sn[8];
#pragma unroll
            for (int j = 0; j < 8; ++j) { const int i = 8 * sub + j; const float invf = __builtin_amdgcn_exp2f(-(float)i * (13.287712379549449f / 32.f));
                const float ang = pos * invf; const float k = rintf(ang * 0.15915494309189535f);
                float r = fmaf(-k, 6.2831854820251465f, ang); r = fmaf(-k, -1.7484555e-7f, r);
                sn[j] = __sinf(r); cs[j] = __cosf(r); }
#pragma unroll
            for (int which = 0; which < 2; ++which) {
                bf16* base = (which == 0 ? Qb : Kb) + (size_t)m * 3072 + h * DQK;
                const float* gn = (which == 0) ? q_norm_g : k_norm_g;
                float nv[32], rl[8], rh[8]; float ss = 0.f;
#pragma unroll
                for (int jj = 0; jj < 4; ++jj) { const v4u q = *(const v4u*)(base + 32 * sub + 8 * jj);
                    nv[8 * jj + 0] = bflo(q.x); nv[8 * jj + 1] = bfhi(q.x); nv[8 * jj + 2] = bflo(q.y); nv[8 * jj + 3] = bfhi(q.y);
                    nv[8 * jj + 4] = bflo(q.z); nv[8 * jj + 5] = bfhi(q.z); nv[8 * jj + 6] = bflo(q.w); nv[8 * jj + 7] = bfhi(q.w); }
                if (which == 0) {
                    const v4u a = *(const v4u*)(base + 128 + 8 * sub), b = *(const v4u*)(base + 160 + 8 * sub);
                    rl[0] = bflo(a.x); rl[1] = bfhi(a.x); rl[2] = bflo(a.y); rl[3] = bfhi(a.y); rl[4] = bflo(a.z); rl[5] = bfhi(a.z); rl[6] = bflo(a.w); rl[7] = bfhi(a.w);
                    rh[0] = bflo(b.x); rh[1] = bfhi(b.x); rh[2] = bflo(b.y); rh[3] = bfhi(b.y); rh[4] = bflo(b.z); rh[5] = bfhi(b.z); rh[6] = bflo(b.w); rh[7] = bfhi(b.w);
                } else {
                    f32x4 a0 = {0.f, 0.f, 0.f, 0.f}, a1 = a0, b0 = a0, b1 = a0;
#pragma unroll
                    for (int ks = 0; ks < 8; ++ks) { const float* kp = KRP + ((size_t)ks * 8192 + m) * 64 + 8 * sub;
                        a0 += *(const f32x4*)kp; a1 += *(const f32x4*)(kp + 4); b0 += *(const f32x4*)(kp + 32); b1 += *(const f32x4*)(kp + 36); }
                    rl[0] = a0.x; rl[1] = a0.y; rl[2] = a0.z; rl[3] = a0.w; rl[4] = a1.x; rl[5] = a1.y; rl[6] = a1.z; rl[7] = a1.w;
                    rh[0] = b0.x; rh[1] = b0.y; rh[2] = b0.z; rh[3] = b0.w; rh[4] = b1.x; rh[5] = b1.y; rh[6] = b1.z; rh[7] = b1.w;
                }
#pragma unroll
                for (int e = 0; e < 32; ++e) ss += nv[e] * nv[e];
#pragma unroll
                for (int e = 0; e < 8; ++e) ss += rl[e] * rl[e] + rh[e] * rh[e];
                ss += __shfl_xor(ss, 1); ss += __shfl_xor(ss, 2);
                const float inv = 1.0f / sqrtf(ss * (1.f / 192.f) + EPS);
#pragma unroll
                for (int jj = 0; jj < 4; ++jj) { const f32x4 g0 = *(const f32x4*)(gn + 32 * sub + 8 * jj), g1 = *(const f32x4*)(gn + 32 * sub + 8 * jj + 4);
                    v4u o; o.x = cvtpk(nv[8 * jj + 0] * inv * g0.x, nv[8 * jj + 1] * inv * g0.y); o.y = cvtpk(nv[8 * jj + 2] * inv * g0.z, nv[8 * jj + 3] * inv * g0.w);
                    o.z = cvtpk(nv[8 * jj + 4] * inv * g1.x, nv[8 * jj + 5] * inv * g1.y); o.w = cvtpk(nv[8 * jj + 6] * inv * g1.z, nv[8 * jj + 7] * inv * g1.w);
                    *(v4u*)(base + 32 * sub + 8 * jj) = o; }
                float ol[8], oh[8];
#pragma unroll
                for (int e = 0; e < 8; ++e) { const float a = rl[e] * inv * gn[128 + 8 * sub + e], b = rh[e] * inv * gn[160 + 8 * sub + e];
                    ol[e] = a * cs[e] - b * sn[e]; oh[e] = b * cs[e] + a * sn[e]; }
                v4u o1, o2; o1.x = cvtpk(ol[0], ol[1]); o1.y = cvtpk(ol[2], ol[3]); o1.z = cvtpk(ol[4], ol[5]); o1.w = cvtpk(ol[6], ol[7]);
                o2.x = cvtpk(oh[0], oh[1]); o2.y = cvtpk(oh[2], oh[3]); o2.z = cvtpk(oh[4], oh[5]); o2.w = cvtpk(oh[6], oh[7]);
                *(v4u*)(base + 128 + 8 * sub) = o1; *(v4u*)(base + 160 + 8 * sub) = o2;
            }
        }
        { pg8::Gemm g{PG, WPO_T, M, DM, POOLW, POOLW, POOLW, 0, 0}; pg8::StaticOrder S; S.init(M, DM, G, bx);
          pg8::EpiGate<false> E{MP, Gt, nullptr, 0}; pg8::gemm_phase<pg8::EpiGate<false>, pg8::StaticOrder>(ldsl, g, S, E); }
    TP_END(4); }
    SEAM(4);
    if (IN(5)) { TP_BEGIN(5);
        const int npair = BATCH * NH * 8;
        for (int p = vcu; p < npair; p += G) {
            const int bh = p >> 3, s = p & 7;
            att::attn_unit(bh / NH, bh % NH, 15 - s, Qb, Kb, Vb, Ob, (char*)lds);
            att::attn_unit(bh / NH, bh % NH, s, Qb, Kb, Vb, Ob, (char*)lds);
        }
    TP_END(5); }
    SEAM(5);
    if (IN(6)) { TP_BEGIN(6);
        pg8::Gemm g{Ob, WAO_T, M, DM, DM, DM, DM, 0, 0}; pg8::StaticOrder S; S.init(M, DM, G, bx);
        pg8::EpiGate<true> E{MIXED, Gt, MP, 2048}; pg8::gemm_phase<pg8::EpiGate<true>, pg8::StaticOrder>(ldsl, g, S, E);
    TP_END(6); }
    SEAM(6);
    if (IN(7)) { TP_BEGIN(7);
        { constexpr int I_G = (DM / 64) * (DFF / 32);
          for (int it = gw; it < 2 * I_G; it += NGW) { int r = it, idx, mode; if (r < I_G) { idx = 17; mode = 2; } else { r -= I_G; idx = 18; mode = 3; }
              transpose_item(kin[idx], DM, DFF, (bf16*)(ws + WS_WGU), mode, 0, scr, r, lane, ffn_norm_g); }
          __syncthreads(); }
        pg8::Gemm g{MIXED, WOUT_T, M, DM, DM, DM, DM, 0, 0}; pg8::StaticOrder S; S.init(M, DM, G, bx);
        pg8::EpiResNorm E{kin[0], X1, (bf16*)(ws + WS_X1B), (float*)ws + SV_SS, DM}; pg8::gemm_phase<pg8::EpiResNorm, pg8::StaticOrder>(ldsl, g, S, E);
    TP_END(7); }
    SEAM(7);
    if (IN(9)) { TP_BEGIN(9);
        pg8::Gemm g{(bf16*)(ws + WS_X1B), WGU_T, M, 2 * DFF, DM, DM, DM, 0, 0}; pg8::StaticOrder S; S.init(M, 2 * DFF, G, bx);
        pg8::EpiSwiGLU E{ACT, DFF, (const float*)ws + SV_SS}; pg8::gemm_phase<pg8::EpiSwiGLU, pg8::StaticOrder>(ldsl, g, S, E);
        if (G == 256 ? (bx >= 128) : true) {
            constexpr int I_D2 = (DFF / 64) * (DM / 32);
            const int nw = (G == 256) ? 128 * NWAVES : NGW, w0 = (G == 256) ? (bx - 128) * NWAVES + wave : gw;
            for (int it = w0; it < I_D2; it += nw) transpose_item(kin[19], DFF, DM, (bf16*)(ws + WS_WDN), 0, 0, scr, it, lane);
        }
    TP_END(9); }
    SEAM(9);
    if (IN(10)) { TP_BEGIN(10);
        pg8::Gemm g{ACT, WDN_T, M, DM, DFF, DFF, DFF, 0, 0}; pg8::StaticOrder S; S.init(M, DM, G, bx);
        pg8::EpiRes E{X1, args.out, DM}; pg8::gemm_phase<pg8::EpiRes, pg8::StaticOrder>(ldsl, g, S, E);
    TP_END(10); }
#ifdef TPROBE
    if (blockIdx.x == 0 && threadIdx.x == 0) { const unsigned w_ = 4u * ((volatile LAS unsigned*)(ldsl + 140000))[1]; const unsigned long long t0_ = __builtin_amdgcn_s_memrealtime(); while ((unsigned)(__builtin_amdgcn_s_memrealtime() - t0_) < w_) __builtin_amdgcn_s_sleep(8); }
#endif
#undef IN
#undef SEAM
}

extern "C" void kernel_launch(void* const* d_in, const int* in_sizes, int n_in, void* d_out, int out_size, void* d_ws, size_t ws_size, hipStream_t stream) {
    static int grid = 0;
    if (grid == 0) {
        if (n_in != 20 || out_size != M * DM || ws_size < WS_END) { fprintf(stderr, "kernel_launch: unexpected shapes (n_in %d, out %d, ws %zu)\n", n_in, out_size, ws_size); grid = -1; return; }
        int dev = 0, cus = 0, per_cu = 0;
        (void)hipGetDevice(&dev); (void)hipDeviceGetAttribute(&cus, hipDeviceAttributeMultiprocessorCount, dev);
        if (hipFuncSetAttribute((const void*)mega_fwd, hipFuncAttributeMaxDynamicSharedMemorySize, LDS_BYTES) != hipSuccess) { fprintf(stderr, "kernel_launch: hipFuncSetAttribute failed\n"); grid = -1; return; }
        if (hipOccupancyMaxActiveBlocksPerMultiprocessor(&per_cu, (const void*)mega_fwd, NWAVES * 64, LDS_BYTES) != hipSuccess || per_cu < 1) { fprintf(stderr, "kernel_launch: occupancy query says %d\n", per_cu); per_cu = 1; }
        (void)hipGetLastError();
        grid = cus > 0 ? cus : 256;
    }
    if (grid < 0) return;
    Args a{};
    for (int i = 0; i < 20; ++i) a.in[i] = (const float*)d_in[i];
    a.out = (float*)d_out; a.ws = (unsigned char*)d_ws;
    if (MK_N_LAUNCHES == 1) {
        a.ph_lo = 0; a.ph_hi = NPH; a.coop = 1;
        (void)hipMemsetAsync((char*)d_ws + WS_BAR, 0, 16384, stream);
        void* kargs[] = {&a};
        hipError_t e = hipLaunchCooperativeKernel((const void*)mega_fwd, dim3(grid), dim3(NWAVES * 64), kargs, LDS_BYTES, stream);
        if (e != hipSuccess) fprintf(stderr, "kernel_launch: cooperative launch failed: %s (grid %d)\n", hipGetErrorString(e), grid);
    } else {
        for (int p = 0; p < NPH; ++p) {
            a.ph_lo = p; a.ph_hi = p + 1;
            hipLaunchKernelGGL(mega_fwd, dim3(grid), dim3(NWAVES * 64), LDS_BYTES, stream, a);
        }
    }
}
```

```cpp
#include <hip/hip_runtime.h>
#include <hip/hip_cooperative_groups.h>
#include <cstdio>
#include <cstdint>
namespace cg = cooperative_groups;

#ifndef MK_N_LAUNCHES
#define MK_N_LAUNCHES 1
#endif

namespace pg8 {
#define PG8_LAS __attribute__((address_space(3)))
typedef unsigned short bf16_t;
typedef short bf16x8 __attribute__((ext_vector_type(8)));
typedef float f32x4 __attribute__((ext_vector_type(4)));
typedef unsigned u32x4 __attribute__((ext_vector_type(4)));
constexpr int BM = 256, BK = 64, HALF = 128, HTB = HALF * BK * 2, STAGE_BYTES = 8 * HTB, NXCD = 8, WGM = 8;

__host__ __device__ __forceinline__ int lds_byte(int r, int c) { const int st = (r >> 4) * 2 + (c >> 5), rr = r & 15, cc = c & 31, ob = rr * 64 + cc * 2; return st * 1024 + (ob ^ (((ob >> 9) & 1) << 5)); }
__host__ __device__ __forceinline__ void stage_rc(int b, int& R, int& C) { const int st = b / 1024, sb = b % 1024, swz = sb ^ (((sb >> 9) & 1) << 5); R = (st >> 1) * 16 + swz / 64; C = (st & 1) * 32 + (swz % 64) / 2; }
__host__ __device__ __forceinline__ int perm32(int rho) { const int n = rho >> 4, i = rho & 15; return 8 * (i >> 2) + 4 * n + (i & 3); }

struct Unit { int pm, pn; };
struct Gemm { const bf16_t* A; const bf16_t* Bt; int M, N, K, lda, ldb, a_pn_step, b_pn_step; };

struct StaticOrder {
    int nM, nN, nwg, G, c;
    __host__ __device__ void init(int M, int N, int G_, int c_) { nM = M / BM; nN = N / BM; nwg = nM * nN; G = G_; c = c_; }
    __host__ __device__ bool next(int i, Unit& u) const {
        const long L = (long)i * G + c; if (L >= nwg) return false;
        int wgid = (int)L; { const int q = nwg / NXCD, r = nwg % NXCD, xcd = wgid % NXCD, off = wgid / NXCD; wgid = (xcd < r ? xcd * (q + 1) : r * (q + 1) + (xcd - r) * q) + off; }
        const int nig = WGM * nN, gid = wgid / nig, fm = gid * WGM, gsz = (nM - fm) < WGM ? (nM - fm) : WGM;
        u.pm = fm + ((wgid % nig) % gsz); u.pn = (wgid % nig) / gsz; return true;
    }
};

typedef float f32x2_t_ __attribute__((ext_vector_type(2))); typedef __bf16 bf16x2_t_ __attribute__((ext_vector_type(2)));
__device__ __forceinline__ unsigned cvt_pk_bf16(float lo, float hi) { f32x2_t_ v = {lo, hi}; bf16x2_t_ b = __builtin_convertvector(v, bf16x2_t_); return __builtin_bit_cast(unsigned, b); }
__device__ __forceinline__ u32x4 pack8(f32x4 a, f32x4 b) { u32x4 w; w.x = cvt_pk_bf16(a[0], a[1]); w.y = cvt_pk_bf16(a[2], a[3]); w.z = cvt_pk_bf16(b[0], b[1]); w.w = cvt_pk_bf16(b[2], b[3]); return w; }
__device__ __forceinline__ void unpack8(u32x4 w, f32x4& a, f32x4& b) {
    a[0] = __uint_as_float(w.x << 16); a[1] = __uint_as_float(w.x & 0xffff0000u); a[2] = __uint_as_float(w.y << 16); a[3] = __uint_as_float(w.y & 0xffff0000u);
    b[0] = __uint_as_float(w.z << 16); b[1] = __uint_as_float(w.z & 0xffff0000u); b[2] = __uint_as_float(w.w << 16); b[3] = __uint_as_float(w.w & 0xffff0000u); }
__device__ __forceinline__ float sigmoidf_(float v) { return __builtin_amdgcn_rcpf(1.0f + __builtin_amdgcn_exp2f(-1.4426950408889634f * v)); }
__device__ __forceinline__ f32x4 sigmoid4(f32x4 v) { f32x4 o; o[0] = sigmoidf_(v[0]); o[1] = sigmoidf_(v[1]); o[2] = sigmoidf_(v[2]); o[3] = sigmoidf_(v[3]); return o; }

typedef f32x4 AccT[2][2][4][2];
#define EPI_LOOP_AM _Pragma("unroll") for (int ai = 0; ai < 2; ++ai) _Pragma("unroll") for (int m = 0; m < 4; ++m)
#define EPI_LOOP_B _Pragma("unroll") for (int bj = 0; bj < 2; ++bj)

struct EpiIn {
    static constexpr bool PERM = true;
    float* C1; bf16_t* U; bf16_t* G; const float* bgate;
    __device__ __forceinline__ void operator()(const AccT& acc, const Unit& u, int wr, int wc, int fr, int fq) const {
        const int row0 = u.pm * BM + wr * 64 + fr, pn = u.pn, cw = wc * 32 + 8 * fq;
        if (pn < 4) {
            EPI_LOOP_AM { float* rp = C1 + (size_t)(row0 + ai * HALF + m * 16) * 1024 + pn * 256 + cw;
                EPI_LOOP_B { *(f32x4*)(rp + bj * HALF) = acc[ai][bj][m][0]; *(f32x4*)(rp + bj * HALF + 4) = acc[ai][bj][m][1]; } }
        } else if (pn < 8) {
            EPI_LOOP_AM { bf16_t* rp = U + (size_t)(row0 + ai * HALF + m * 16) * 1024 + (pn - 4) * 256 + cw;
                EPI_LOOP_B { *(u32x4*)(rp + bj * HALF) = pack8(acc[ai][bj][m][0], acc[ai][bj][m][1]); } }
        } else {
            const int gc = (pn - 8) * 256 + cw; f32x4 bv[2][2];
            EPI_LOOP_B { bv[bj][0] = *(const f32x4*)(bgate + gc + bj * HALF); bv[bj][1] = *(const f32x4*)(bgate + gc + bj * HALF + 4); }
            EPI_LOOP_AM { bf16_t* rp = G + (size_t)(row0 + ai * HALF + m * 16) * 4096 + gc;
                EPI_LOOP_B { *(u32x4*)(rp + bj * HALF) = pack8(sigmoid4(acc[ai][bj][m][0] + bv[bj][0]), sigmoid4(acc[ai][bj][m][1] + bv[bj][1])); } }
        }
    }
};
struct EpiKRP {
    static constexpr bool PERM = true;
    float* KRP;
    __device__ __forceinline__ void operator()(const AccT& acc, const Unit& u, int wr, int wc, int fr, int fq) const {
        const int row0 = u.pm * BM + wr * 64 + fr, cw = wc * 32 + 8 * fq;
        if (wc < 2) { EPI_LOOP_AM { float* rp = KRP + ((size_t)u.pn * 8192 + (row0 + ai * HALF + m * 16)) * 64 + cw; *(f32x4*)rp = acc[ai][0][m][0]; *(f32x4*)(rp + 4) = acc[ai][0][m][1]; } }
    }
};
struct EpiBf16 {
    static constexpr bool PERM = true;
    bf16_t* O; int ldc;
    __device__ __forceinline__ void operator()(const AccT& acc, const Unit& u, int wr, int wc, int fr, int fq) const {
        const int row0 = u.pm * BM + wr * 64 + fr, col0 = u.pn * BM + wc * 32 + 8 * fq;
        EPI_LOOP_AM { bf16_t* rp = O + (size_t)(row0 + ai * HALF + m * 16) * ldc + col0;
            EPI_LOOP_B { *(u32x4*)(rp + bj * HALF) = pack8(acc[ai][bj][m][0], acc[ai][bj][m][1]); } }
    }
};
struct EpiKV {
    static constexpr bool PERM = true;
    bf16_t* K; bf16_t* V;
    __device__ __forceinline__ void operator()(const AccT& acc, const Unit& u, int wr, int wc, int fr, int fq) const {
        const int row0 = u.pm * BM + wr * 64 + fr, cw = wc * 32 + 8 * fq, h = u.pn;
        EPI_LOOP_AM { const size_t row = (size_t)(row0 + ai * HALF + m * 16);
            *(u32x4*)(K + row * 3072 + h * 192 + cw) = pack8(acc[ai][0][m][0], acc[ai][0][m][1]);
            *(u32x4*)(V + row * 2048 + h * 128 + cw) = pack8(acc[ai][1][m][0], acc[ai][1][m][1]); }
    }
};
struct EpiScale {
    static constexpr bool PERM = true;
    bf16_t* O; int ldc; const float* scale;
    __device__ __forceinline__ void operator()(const AccT& acc, const Unit& u, int wr, int wc, int fr, int fq) const {
        const int row0 = u.pm * BM + wr * 64 + fr, col0 = u.pn * BM + wc * 32 + 8 * fq; f32x4 sv[2][2];
        EPI_LOOP_B { sv[bj][0] = *(const f32x4*)(scale + col0 + bj * HALF); sv[bj][1] = *(const f32x4*)(scale + col0 + bj * HALF + 4); }
        EPI_LOOP_AM { bf16_t* rp = O + (size_t)(row0 + ai * HALF + m * 16) * ldc + col0;
            EPI_LOOP_B { *(u32x4*)(rp + bj * HALF) = pack8(acc[ai][bj][m][0] * sv[bj][0], acc[ai][bj][m][1] * sv[bj][1]); } }
    }
};
template <bool HAS_ADD> struct EpiGate {
    static constexpr bool PERM = true;
    bf16_t* O; const bf16_t* gate; const bf16_t* add; int gcol0;
    __device__ __forceinline__ void operator()(const AccT& acc, const Unit& u, int wr, int wc, int fr, int fq) const {
        const int row0 = u.pm * BM + wr * 64 + fr, col0 = u.pn * BM + wc * 32 + 8 * fq;
        EPI_LOOP_AM { const size_t row = (size_t)(row0 + ai * HALF + m * 16);
            EPI_LOOP_B { f32x4 g0, g1; unpack8(*(const u32x4*)(gate + row * 4096 + gcol0 + col0 + bj * HALF), g0, g1);
                f32x4 v0 = g0 * acc[ai][bj][m][0], v1 = g1 * acc[ai][bj][m][1];
                if (HAS_ADD) { f32x4 a0, a1; unpack8(*(const u32x4*)(add + row * 2048 + col0 + bj * HALF), a0, a1); v0 += a0; v1 += a1; }
                *(u32x4*)(O + row * 2048 + col0 + bj * HALF) = pack8(v0, v1); } }
    }
};
struct EpiRes {
    static constexpr bool PERM = false;
    const float* base; float* out; int ldc;
    __device__ __forceinline__ void operator()(const AccT& acc, const Unit& u, int wr, int wc, int fr, int fq) const {
        const int row0 = u.pm * BM + wr * 64 + fr, col0 = u.pn * BM + wc * 32 + 4 * fq;
        EPI_LOOP_AM { const size_t off = (size_t)(row0 + ai * HALF + m * 16) * ldc + col0;
            EPI_LOOP_B {
#pragma unroll
                for (int n = 0; n < 2; ++n) { const f32x4 b = *(const f32x4*)(base + off + bj * HALF + n * 16); *(f32x4*)(out + off + bj * HALF + n * 16) = b + acc[ai][bj][m][n]; } } }
    }
};
struct EpiResNorm {
    static constexpr bool PERM = false;
    const float* base; float* out; bf16_t* outb; float* ss; int ldc;
    __device__ __forceinline__ void operator()(const AccT& acc, const Unit& u, int wr, int wc, int fr, int fq) const {
        const int row0 = u.pm * BM + wr * 64 + fr, col0 = u.pn * BM + wc * 32 + 4 * fq;
        EPI_LOOP_AM { const int row = row0 + ai * HALF + m * 16; const size_t off = (size_t)row * ldc + col0; float s = 0.f;
            EPI_LOOP_B {
#pragma unroll
                for (int n = 0; n < 2; ++n) { const f32x4 v = *(const f32x4*)(base + off + bj * HALF + n * 16) + acc[ai][bj][m][n]; *(f32x4*)(out + off + bj * HALF + n * 16) = v;
                    typedef unsigned u32x2_ __attribute__((ext_vector_type(2))); u32x2_ w; w.x = cvt_pk_bf16(v[0], v[1]); w.y = cvt_pk_bf16(v[2], v[3]); *(u32x2_*)(outb + off + bj * HALF + n * 16) = w;
                    s += (v[0] * v[0] + v[1] * v[1]) + (v[2] * v[2] + v[3] * v[3]); } }
            s += __shfl_xor(s, 16); s += __shfl_xor(s, 32);
            if (fq == 0) atomicAdd(ss + row, s); }
    }
};
struct EpiSwiGLU {
    static constexpr bool PERM = true;
    bf16_t* O; int ldc; const float* ss;
    __device__ __forceinline__ void operator()(const AccT& acc, const Unit& u, int wr, int wc, int fr, int fq) const {
        const int row0 = u.pm * BM + wr * 64 + fr, col0 = u.pn * HALF + wc * 32 + 8 * fq;
        EPI_LOOP_AM { const int row = row0 + ai * HALF + m * 16; bf16_t* rp = O + (size_t)row * ldc + col0;
            const float inv = 1.0f / sqrtf(ss[row] * (1.f / 2048.f) + 1e-6f);
            const f32x4 g0 = acc[ai][0][m][0] * inv, g1 = acc[ai][0][m][1] * inv;
            *(u32x4*)rp = pack8(g0 * sigmoid4(g0) * (acc[ai][1][m][0] * inv), g1 * sigmoid4(g1) * (acc[ai][1][m][1] * inv)); }
    }
};

template <class Epi, class Sched, bool ALIGN_EPI = true>
__device__ __forceinline__ void gemm_phase(PG8_LAS unsigned char* lds, const Gemm g, const Sched& S, const Epi& E) {
    const int tid = threadIdx.x, wid = __builtin_amdgcn_readfirstlane(tid >> 6), lane = tid & 63, wr = wid >> 2, wc = wid & 3, fr = lane & 15, fq = lane >> 4;
    const int K = g.K, nt = K / BK;
    unsigned voffA[2], voffB[2];
#pragma unroll
    for (int i = 0; i < 2; ++i) { int R, C; stage_rc(tid * 16 + i * 8192, R, C); const int Rb = Epi::PERM ? ((R & ~31) + perm32(R & 31)) : R;
        voffA[i] = (unsigned)(R * g.lda + C) * 2u; voffB[i] = (unsigned)(Rb * g.ldb + C) * 2u; }
    const size_t kstep = (size_t)(BK * 2);
    const size_t hstepA = (size_t)HALF * g.lda * 2, hstepB = (size_t)HALF * g.ldb * 2;
    const size_t tstepA = 2 * hstepA, tstepB = g.b_pn_step ? (size_t)g.b_pn_step * 2 : 2 * hstepB, pstepA = (size_t)g.a_pn_step * 2;
    const unsigned ldsw = (unsigned)wid * 1024u;
    const int aoff = lds_byte(wr * 64 + fr, fq * 8), boff = lds_byte(wc * 32 + fr, fq * 8);
#define PG8_SA(b, h) (((b) * 2 + (h)) * HTB)
#define PG8_SB(b, h) ((4 + (b) * 2 + (h)) * HTB)
#define PG8_STAGE(bufoff, gbase, voff) do { _Pragma("unroll") for (int _i = 0; _i < 2; ++_i) \
        __builtin_amdgcn_global_load_lds((const unsigned*)((const char*)(gbase) + (voff)[_i]), (PG8_LAS unsigned*)(lds + (bufoff) + ldsw + _i * 8192), 16, 0, 0); } while (0)
#define PG8_LDA(dst, b, h) do { _Pragma("unroll") for (int m = 0; m < 4; ++m) _Pragma("unroll") for (int k = 0; k < 2; ++k) dst[m][k] = *(const PG8_LAS bf16x8*)(lds + PG8_SA(b, h) + aoff + m * 2048 + k * 1024); } while (0)
#define PG8_LDB(dst, b, h) do { _Pragma("unroll") for (int n = 0; n < 2; ++n) _Pragma("unroll") for (int k = 0; k < 2; ++k) dst[n][k] = *(const PG8_LAS bf16x8*)(lds + PG8_SB(b, h) + boff + n * 2048 + k * 1024); } while (0)
#define PG8_MMA(ai, bj, At, Bt) do { __builtin_amdgcn_s_setprio(1); _Pragma("unroll") for (int m = 0; m < 4; ++m) _Pragma("unroll") for (int n = 0; n < 2; ++n) _Pragma("unroll") for (int k = 0; k < 2; ++k) \
        acc[ai][bj][m][n] = __builtin_amdgcn_mfma_f32_16x16x32_bf16(Bt[n][k], At[m][k], acc[ai][bj][m][n], 0, 0, 0); __builtin_amdgcn_s_setprio(0); } while (0)
#define PG8_WAIT_V(n) asm volatile("s_waitcnt vmcnt(" #n ")" ::: "memory")
#define PG8_WAIT_L(n) asm volatile("s_waitcnt lgkmcnt(" #n ")" ::: "memory")
#define PG8_BAR __builtin_amdgcn_s_barrier()
#define PG8_SCHED __builtin_amdgcn_sched_barrier(0)
    Unit cur, nxt; int ui = 0;
    if (!S.next(0, cur)) return;
    f32x4 acc[2][2][4][2];
#pragma unroll
    for (int a = 0; a < 2; ++a)
#pragma unroll
        for (int b = 0; b < 2; ++b)
#pragma unroll
            for (int m = 0; m < 4; ++m)
#pragma unroll
                for (int n = 0; n < 2; ++n) acc[a][b][m][n] = (f32x4){0.f, 0.f, 0.f, 0.f};
    bf16x8 At[4][2], B0[2][2], B1[2][2];
    const char* cA = (const char*)g.A + (size_t)cur.pm * tstepA + (size_t)cur.pn * pstepA; const char* cB = (const char*)g.Bt + (size_t)cur.pn * tstepB;
    PG8_STAGE(PG8_SB(0, 0), cB, voffB); PG8_STAGE(PG8_SB(0, 1), cB + hstepB, voffB); PG8_STAGE(PG8_SA(0, 0), cA, voffA); PG8_STAGE(PG8_SA(0, 1), cA + hstepA, voffA);
    if (wr == 1) PG8_BAR;
    PG8_WAIT_V(2); PG8_BAR;
    PG8_STAGE(PG8_SB(1, 0), cB + kstep, voffB); PG8_STAGE(PG8_SA(1, 0), cA + kstep, voffA); PG8_STAGE(PG8_SB(1, 1), cB + hstepB + kstep, voffB);
    PG8_WAIT_V(6); PG8_BAR;
    for (;;) {
        const bool has_next = S.next(ui + 1, nxt);
        const char* nA = has_next ? (const char*)g.A + (size_t)nxt.pm * tstepA + (size_t)nxt.pn * pstepA : cA; const char* nB = has_next ? (const char*)g.Bt + (size_t)nxt.pn * tstepB : cB;
        for (int t = 0; t < nt; t += 2) {
            const bool last = (t == nt - 2);
            const char* a1 = cA + (size_t)(t + 1) * kstep;
            const char* a2 = last ? nA : cA + (size_t)(t + 2) * kstep; const char* b2 = last ? nB : cB + (size_t)(t + 2) * kstep;
            const char* a3 = a2 + kstep; const char* b3 = b2 + kstep;
            PG8_LDB(B0, 0, 0); PG8_LDB(B1, 0, 1); PG8_SCHED; PG8_LDA(At, 0, 0); PG8_STAGE(PG8_SA(1, 1), a1 + hstepA, voffA);
            PG8_WAIT_V(8); PG8_WAIT_L(0); PG8_BAR; PG8_MMA(0, 0, At, B0); PG8_MMA(0, 1, At, B1); PG8_BAR; PG8_SCHED;
            PG8_LDA(At, 0, 1); PG8_STAGE(PG8_SB(0, 0), b2, voffB); PG8_STAGE(PG8_SB(0, 1), b2 + hstepB, voffB); PG8_STAGE(PG8_SA(0, 0), a2, voffA);
            PG8_WAIT_V(8); PG8_WAIT_L(0); PG8_BAR; PG8_MMA(1, 0, At, B0); PG8_MMA(1, 1, At, B1); PG8_BAR; PG8_SCHED;
            PG8_LDB(B0, 1, 0); PG8_LDB(B1, 1, 1); PG8_SCHED; PG8_LDA(At, 1, 0); PG8_STAGE(PG8_SA(0, 1), a2 + hstepA, voffA);
            PG8_WAIT_V(8); PG8_WAIT_L(0); PG8_BAR; PG8_MMA(0, 0, At, B0); PG8_MMA(0, 1, At, B1); PG8_BAR; PG8_SCHED;
            PG8_LDA(At, 1, 1); PG8_STAGE(PG8_SB(1, 0), b3, voffB); PG8_STAGE(PG8_SB(1, 1), b3 + hstepB, voffB); PG8_STAGE(PG8_SA(1, 0), a3, voffA);
            PG8_WAIT_V(8); PG8_WAIT_L(0); PG8_BAR; PG8_MMA(1, 0, At, B0); PG8_MMA(1, 1, At, B1); PG8_BAR; PG8_SCHED;
        }
        if constexpr (ALIGN_EPI) { if (wr == 0) PG8_BAR; }
        E(acc, cur, wr, wc, fr, fq);
        if (!has_next) break;
#pragma unroll
        for (int a = 0; a < 2; ++a)
#pragma unroll
            for (int b = 0; b < 2; ++b)
#pragma unroll
                for (int m = 0; m < 4; ++m)
#pragma unroll
                    for (int n = 0; n < 2; ++n) acc[a][b][m][n] = (f32x4){0.f, 0.f, 0.f, 0.f};
        cur = nxt; cA = nA; cB = nB; ++ui;
        if constexpr (ALIGN_EPI) { if (wr == 1) PG8_BAR; }
    }
    PG8_WAIT_V(0);
    if constexpr (!ALIGN_EPI) { if (wr == 0) PG8_BAR; }
    PG8_BAR;
#undef PG8_SA
#undef PG8_SB
#undef PG8_STAGE
#undef PG8_LDA
#undef PG8_LDB
#undef PG8_MMA
#undef PG8_WAIT_V
#undef PG8_WAIT_L
#undef PG8_BAR
#undef PG8_SCHED
}
}

constexpr int BATCH = 2, SEQ = 4096, DM = 2048, M = BATCH * SEQ;
constexpr int NH = 16, DQK = 192, DNOPE = 128, DROPE = 64, DV = 128, QLORA = 512, KVLORA = 512;
constexpr int POOLW = 1024, DIN = 6208, DIN_PAD = 6400, DFF = 5632;
constexpr float EPS = 1e-6f;
constexpr int NWAVES = 8;

typedef unsigned short bf16;
typedef unsigned v4u __attribute__((ext_vector_type(4)));
typedef unsigned v2u __attribute__((ext_vector_type(2)));
typedef float f32x4 __attribute__((ext_vector_type(4)));
typedef short bf16x8 __attribute__((ext_vector_type(8)));
typedef short s16x4 __attribute__((ext_vector_type(4)));
typedef float f32x16 __attribute__((ext_vector_type(16)));
#define LAS __attribute__((address_space(3)))
#define LDS_WAIT() asm volatile("s_waitcnt lgkmcnt(0)" ::: "memory")

constexpr size_t MiB = 1u << 20;
constexpr size_t WS_WAO = 1 * MiB, WS_WOUT = 9 * MiB, WS_WPO = 17 * MiB, WS_WQB = 21 * MiB, WS_WKVB = 24 * MiB, WS_WPG = 28 * MiB, WS_KR = 29 * MiB;
constexpr size_t WS_G = 31 * MiB;
constexpr size_t WS_WIN = 95 * MiB, WS_XN = 120 * MiB, WS_C1 = 152 * MiB, WS_U = 184 * MiB;
constexpr size_t WS_Q = 95 * MiB, WS_K = 143 * MiB, WS_V = 191 * MiB, WS_CN = 223 * MiB, WS_POOLED = 239 * MiB, WS_PG = 255 * MiB;
constexpr size_t WS_MP = 223 * MiB, WS_O = 255 * MiB, WS_MIXED = 95 * MiB, WS_X1 = 127 * MiB, WS_H2 = 95 * MiB;
constexpr size_t WS_WGU = 191 * MiB, WS_WDN = 235 * MiB, WS_ACT = 1 * MiB;
constexpr size_t WS_END = 296 * MiB, WS_BAR = 512 * 1024, WS_KRP = 272 * MiB, WS_X1B = 257 * MiB;
constexpr int SV_BGATE = 0, SV_QAG = 4096, SV_KVAG = 4608, SV_QNG = 5120, SV_KNG = 5376, SV_PSC = 5632, SV_FNG = 6656, SV_POS = 8704, SV_END = 8704 + 8192, SV_SS = 32768;

constexpr int LDS_BYTES = 147456;

__device__ __forceinline__ unsigned cvtpk(float lo, float hi) { return pg8::cvt_pk_bf16(lo, hi); }
__device__ __forceinline__ float bflo(unsigned w) { return __uint_as_float(w << 16); }
__device__ __forceinline__ float bfhi(unsigned w) { return __uint_as_float(w & 0xffff0000u); }
__device__ __forceinline__ float wave_sum(float v) {
#pragma unroll
    for (int o = 1; o < 64; o <<= 1) v += __shfl_xor(v, o);
    return v;
}

__device__ __forceinline__ int dst_row(int mode, int n0) {
    if (mode == 1) { if (n0 < 1024) return n0; if (n0 < 1088) return 6144 + (n0 - 1024); if (n0 < 2112) return 1024 + (n0 - 1088); return 2048 + (n0 - 2112); }
    if (mode == 2) return (n0 >> 7) * 256 + (n0 & 127);
    if (mode == 3) return (n0 >> 7) * 256 + 128 + (n0 & 127);
    return n0;
}
__device__ __forceinline__ void transpose_item(const float* W, int K, int N, bf16* WT, int mode, int row_off, LAS float* scr, int item, int lane, const float* gk = nullptr) {
    const int nblk = N / 32, kb = item / nblk, nb = item % nblk, k0 = 64 * kb, n0 = 32 * nb;
    { float tv[32]; const float* wp = W + (size_t)(k0 + (lane >> 5)) * N + n0 + (lane & 31);
#pragma unroll
      for (int i = 0; i < 32; ++i) tv[i] = wp[(size_t)(2 * i) * N];
      if (gk) {
#pragma unroll
          for (int i = 0; i < 32; ++i) tv[i] *= gk[k0 + 2 * i + (lane >> 5)]; }
#pragma unroll
      for (int i = 0; i < 32; ++i) scr[(2 * i + (lane >> 5)) * 33 + (lane & 31)] = tv[i]; }
    LDS_WAIT(); asm volatile("" ::: "memory");
    const int c = lane & 7, dr = row_off + dst_row(mode, n0);
#pragma unroll
    for (int j = 0; j < 4; ++j) { const int n = (lane >> 3) + 8 * j; const LAS float* s = scr + (8 * c) * 33 + n;
        v4u o; o.x = cvtpk(s[0 * 33], s[1 * 33]); o.y = cvtpk(s[2 * 33], s[3 * 33]); o.z = cvtpk(s[4 * 33], s[5 * 33]); o.w = cvtpk(s[6 * 33], s[7 * 33]);
        *(v4u*)(WT + (size_t)(dr + n) * K + k0 + 8 * c) = o; }
    LDS_WAIT(); asm volatile("" ::: "memory");
}

struct TrDesc { const float* W; bf16* WT; const float* gk; int K, N, k0, n0, dr; };
__device__ __forceinline__ TrDesc tr_desc(const float* W, int K, int N, bf16* WT, int mode, int row_off, int item, const float* gk) {
    const int nblk = N / 32, kb = item / nblk, nb = item % nblk; TrDesc d; d.W = W; d.WT = WT; d.gk = gk; d.K = K; d.N = N; d.k0 = 64 * kb; d.n0 = 32 * nb; d.dr = row_off + dst_row(mode, d.n0); return d; }
__device__ __forceinline__ void tr_load(const TrDesc& d, float (&tv)[32], int lane) {
    const float* wp = d.W + (size_t)(d.k0 + (lane >> 5)) * d.N + d.n0 + (lane & 31);
#pragma unroll
    for (int i = 0; i < 32; ++i) tv[i] = wp[(size_t)(2 * i) * d.N];
}
__device__ __forceinline__ void tr_finish(const TrDesc& d, float (&tv)[32], LAS float* scr, int lane) {
    if (d.gk) {
#pragma unroll
        for (int i = 0; i < 32; ++i) tv[i] *= d.gk[d.k0 + 2 * i + (lane >> 5)]; }
#pragma unroll
    for (int i = 0; i < 32; ++i) scr[(2 * i + (lane >> 5)) * 33 + (lane & 31)] = tv[i];
    LDS_WAIT(); asm volatile("" ::: "memory");
    const int c = lane & 7;
#pragma unroll
    for (int j = 0; j < 4; ++j) { const int n = (lane >> 3) + 8 * j; const LAS float* s_ = scr + (8 * c) * 33 + n;
        v4u o; o.x = cvtpk(s_[0 * 33], s_[1 * 33]); o.y = cvtpk(s_[2 * 33], s_[3 * 33]); o.z = cvtpk(s_[4 * 33], s_[5 * 33]); o.w = cvtpk(s_[6 * 33], s_[7 * 33]);
        *(v4u*)(d.WT + (size_t)(d.dr + n) * d.K + d.k0 + 8 * c) = o; }
    LDS_WAIT(); asm volatile("" ::: "memory");
}
#define TR_PIPELINE(FIRST, LIMIT, STRIDE, MAKE_DESC) do { int it_ = (FIRST); if (it_ < (LIMIT)) { TrDesc dA_ = MAKE_DESC(it_); float tvA_[32]; tr_load(dA_, tvA_, lane); \
        for (;;) { const int nx_ = it_ + (STRIDE); const bool more_ = nx_ < (LIMIT); TrDesc dB_ = dA_; float tvB_[32]; \
            if (more_) { dB_ = MAKE_DESC(nx_); tr_load(dB_, tvB_, lane); } \
            tr_finish(dA_, tvA_, scr, lane); if (!more_) break; \
            dA_ = dB_; _Pragma("unroll") for (int i_ = 0; i_ < 32; ++i_) tvA_[i_] = tvB_[i_]; it_ = nx_; } } } while (0)

__device__ __forceinline__ void rms_row_2048(const float* xrow, const float* g, bf16* orow, int lane) {
    const f32x4* xr = (const f32x4*)xrow + lane; const f32x4* gr = (const f32x4*)g + lane;
    f32x4 v[8]; float s = 0.f;
#pragma unroll
    for (int j = 0; j < 8; ++j) { v[j] = xr[64 * j]; s += (v[j].x * v[j].x + v[j].y * v[j].y) + (v[j].z * v[j].z + v[j].w * v[j].w); }
    const float inv = 1.0f / sqrtf(wave_sum(s) * (1.f / 2048.f) + EPS);
    v2u* o8 = (v2u*)orow + lane;
#pragma unroll
    for (int j = 0; j < 8; ++j) { const f32x4 gv = gr[64 * j]; v2u o; o.x = cvtpk(v[j].x * inv * gv.x, v[j].y * inv * gv.y); o.y = cvtpk(v[j].z * inv * gv.z, v[j].w * inv * gv.w); o8[64 * j] = o; }
}

namespace att {
constexpr int QBLK = 32, KVBLK = 64, QB = 256;
constexpr int SHM_V = KVBLK * DV * 2, SHM_K = KVBLK * DQK * 2;
constexpr int OFF_V = 0, OFF_K = 3 * SHM_V, OFF_WS = OFF_K + 2 * SHM_K;
constexpr float SCALE = 0.07216878364870322f;
constexpr float THR = 8.f;
#define KSWZ(row, colB) ((row) * 384 + ((colB) ^ (((row) & 7) << 4)))
#define SBAR() __builtin_amdgcn_sched_barrier(0)
__device__ __forceinline__ int v_st(int k, int c) { const int kk = (k & ~0xC) | ((k & 4) << 1) | ((k & 8) >> 1); return ((kk >> 3) * 4 + (c >> 5)) * 512 + ((kk & 7) * 32 + (c & 31)) * 2; }
__device__ __forceinline__ int v_rd_base(int lane) { return ((lane & 3) << 3) | (((lane >> 2) & 3) << 6) | (((lane >> 4) & 1) << 5) | (((lane >> 5) & 1) << 8); }
__device__ __forceinline__ int crow(int r, int hi) { return (r & 3) + 8 * (r >> 2) + 4 * hi; }
__device__ __forceinline__ void mask_tile(f32x16& p0, f32x16& p1, int dq) {
    const float NEG = -__builtin_inff();
#pragma unroll
    for (int r = 0; r < 16; ++r) {
        const int c = (r & 3) + 8 * (r >> 2);
        if (dq - c < 0) p0[r] = NEG;
        if (dq - c - 32 < 0) p1[r] = NEG;
    }
}
__device__ __forceinline__ void partialSM(f32x16& p0, f32x16& p1, float& m_reg, float& mn, float& alpha) {
    float pmax = p0[0];
#pragma unroll
    for (int r = 1; r < 16; ++r) pmax = fmaxf(pmax, p0[r]);
#pragma unroll
    for (int r = 0; r < 16; ++r) pmax = fmaxf(pmax, p1[r]);
    { auto rr = __builtin_amdgcn_permlane32_swap(__float_as_uint(pmax), __float_as_uint(pmax), false, false);
      pmax = fmaxf(__uint_as_float(rr[0]), __uint_as_float(rr[1])); }
    constexpr float C2 = 1.4426950408889634f * SCALE;
    if (__builtin_expect(__all((pmax - m_reg) * SCALE <= THR), 1)) { mn = m_reg; alpha = 1.f; }
    else { mn = fmaxf(m_reg, pmax); alpha = __builtin_amdgcn_exp2f((m_reg - mn) * C2); m_reg = mn; }
    const float mnL = -mn * C2;
#pragma unroll
    for (int r = 0; r < 16; ++r) p0[r] = fmaf(p0[r], C2, mnL);
#pragma unroll
    for (int r = 0; r < 16; ++r) p1[r] = fmaf(p1[r], C2, mnL);
#pragma unroll
    for (int r = 0; r < 16; ++r) p0[r] = __builtin_amdgcn_exp2f(p0[r]);
}
__device__ __forceinline__ void finishSM(f32x16& p0, f32x16& p1, float alpha, float& l_reg, bf16x8& pa0, bf16x8& pa1, bf16x8& pa2, bf16x8& pa3) {
#pragma unroll
    for (int r = 0; r < 16; ++r) p1[r] = __builtin_amdgcn_exp2f(p1[r]);
    float ps = 0;
#pragma unroll
    for (int r = 0; r < 16; ++r) ps += p0[r];
#pragma unroll
    for (int r = 0; r < 16; ++r) ps += p1[r];
    { auto rr = __builtin_amdgcn_permlane32_swap(__float_as_uint(ps), __float_as_uint(ps), false, false);
      ps = __uint_as_float(rr[0]) + __uint_as_float(rr[1]); }
    l_reg = l_reg * alpha + ps;
#define PK4(P, B_, OUT) do { unsigned a0 = cvtpk(P[B_+0], P[B_+1]), a1 = cvtpk(P[B_+2], P[B_+3]);                          \
        unsigned b0 = cvtpk(P[B_+4], P[B_+5]), b1 = cvtpk(P[B_+6], P[B_+7]);                                             \
        auto r0 = __builtin_amdgcn_permlane32_swap(a0, b0, false, false); auto r1 = __builtin_amdgcn_permlane32_swap(a1, b1, false, false); \
        v4u w = {r0[0], r1[0], r0[1], r1[1]}; OUT = *reinterpret_cast<bf16x8*>(&w); } while (0)
    PK4(p0, 0, pa0); PK4(p0, 8, pa1); PK4(p1, 0, pa2); PK4(p1, 8, pa3);
#undef PK4
}
__device__ __forceinline__ void qkt(f32x16& p0, f32x16& p1, const char* Kb, int r32, int hi, const bf16x8* qr) {
    p0 = f32x16{}; p1 = f32x16{};
    const char* kb[4];
#pragma unroll
    for (int dd = 0; dd < 4; ++dd) kb[dd] = Kb + KSWZ(r32, (dd * 16 + hi * 8) * 2);
#pragma unroll
    for (int g = 0; g < 2; ++g) { bf16x8 b0[6], b1[6];
#pragma unroll
        for (int i = 0; i < 6; ++i) { const int d0 = 6 * g + i; const char* a = kb[d0 & 3] + (d0 >> 2) * 128; b0[i] = *reinterpret_cast<const bf16x8*>(a); b1[i] = *reinterpret_cast<const bf16x8*>(a + 32 * 384); }
        SBAR();
#pragma unroll
        for (int i = 0; i < 6; ++i) { p0 = __builtin_amdgcn_mfma_f32_32x32x16_bf16(b0[i], qr[6 * g + i], p0, 0, 0, 0); p1 = __builtin_amdgcn_mfma_f32_32x32x16_bf16(b1[i], qr[6 * g + i], p1, 0, 0, 0); }
        SBAR(); }
}
__device__ __forceinline__ void pv_tile(f32x16* o, int vb0, bf16x8 pa0, bf16x8 pa1, bf16x8 pa2, bf16x8 pa3) {
#define TRRD(dst, off) asm volatile("ds_read_b64_tr_b16 %0, %1 offset:%2" : "=&v"(dst) : "v"(vb0), "i"(off) : "memory")
#define PV_RD(S, d0) do { constexpr int b_ = (d0) * 512; TRRD(S##l0, b_); TRRD(S##h0, b_ + 2048); TRRD(S##l1, b_ + 4096); TRRD(S##h1, b_ + 6144); TRRD(S##l2, b_ + 8192); TRRD(S##h2, b_ + 10240); TRRD(S##l3, b_ + 12288); TRRD(S##h3, b_ + 14336); } while (0)
#define PV_MM(S, d0) do { \
        o[d0] = __builtin_amdgcn_mfma_f32_32x32x16_bf16(pa0, (bf16x8){S##l0[0], S##l0[1], S##l0[2], S##l0[3], S##h0[0], S##h0[1], S##h0[2], S##h0[3]}, o[d0], 0, 0, 0);   \
        o[d0] = __builtin_amdgcn_mfma_f32_32x32x16_bf16(pa1, (bf16x8){S##l1[0], S##l1[1], S##l1[2], S##l1[3], S##h1[0], S##h1[1], S##h1[2], S##h1[3]}, o[d0], 0, 0, 0);   \
        o[d0] = __builtin_amdgcn_mfma_f32_32x32x16_bf16(pa2, (bf16x8){S##l2[0], S##l2[1], S##l2[2], S##l2[3], S##h2[0], S##h2[1], S##h2[2], S##h2[3]}, o[d0], 0, 0, 0);   \
        o[d0] = __builtin_amdgcn_mfma_f32_32x32x16_bf16(pa3, (bf16x8){S##l3[0], S##l3[1], S##l3[2], S##l3[3], S##h3[0], S##h3[1], S##h3[2], S##h3[3]}, o[d0], 0, 0, 0); } while (0)
    s16x4 Al0, Al1, Al2, Al3, Ah0, Ah1, Ah2, Ah3, Bl0, Bl1, Bl2, Bl3, Bh0, Bh1, Bh2, Bh3;
    PV_RD(A, 0); PV_RD(B, 1);
    asm volatile("s_waitcnt lgkmcnt(8)" ::: "memory"); SBAR(); PV_MM(A, 0); SBAR();
    PV_RD(A, 2);
    asm volatile("s_waitcnt lgkmcnt(8)" ::: "memory"); SBAR(); PV_MM(B, 1); SBAR();
    PV_RD(B, 3);
    asm volatile("s_waitcnt lgkmcnt(8)" ::: "memory"); SBAR(); PV_MM(A, 2); SBAR();
    asm volatile("s_waitcnt lgkmcnt(0)" ::: "memory"); SBAR(); PV_MM(B, 3);
#undef PV_MM
#undef PV_RD
#undef TRRD
}
__device__ __forceinline__ void attn_unit(int b, int h, int qb, const bf16* Q, const bf16* K, const bf16* V, bf16* O, char* lds) {
    const int tid = threadIdx.x, wid = __builtin_amdgcn_readfirstlane(tid >> 6), lane = tid & 63, r32 = lane & 31, hi = lane >> 5;
    const size_t rowb = (size_t)b * SEQ;
    const int q0 = qb * QB, qlo = q0 + wid * QBLK;
    const int NT = (q0 + QB) / KVBLK;
    char* V_lds = lds + OFF_V; char* K_lds = lds + OFF_K;
#define WAVE_WS() ({ int t_ = (int)threadIdx.x; asm volatile("" : "+v"(t_)); (float*)(lds + OFF_WS) + (t_ >> 6) * 64; })
    LAS unsigned char* ldsl_ = (LAS unsigned char*)lds;
    unsigned ksrc[3], vsrc[2];
#pragma unroll
    for (int j = 0; j < 3; ++j) { const int s_ = (wid * 3 + j) * 64 + lane, row = s_ / 24, pc = s_ % 24; ksrc[j] = (unsigned)(row * 3072 * 2 + ((pc * 16) ^ ((row & 7) << 4))); }
#pragma unroll
    for (int j = 0; j < 2; ++j) { const int ob = ((wid * 2 + j) * 64 + lane) * 16, st = ob >> 9, kr_ = (ob >> 6) & 7, ch = (ob >> 4) & 3, c = (st & 3) * 32 + ch * 8, kk = (st >> 2) * 8 + kr_,
                                  k = (kk & ~0xC) | ((kk & 4) << 1) | ((kk & 8) >> 1); vsrc[j] = (unsigned)(k * 2048 * 2 + c * 2); }
    const char* Kh = (const char*)(K + rowb * 3072 + h * DQK); const char* Vh = (const char*)(V + rowb * 2048 + h * DV);
#define KDMA(k0, bf) do { _Pragma("unroll") for (int j = 0; j < 3; ++j) __builtin_amdgcn_global_load_lds((const unsigned*)(Kh + (size_t)(k0) * (3072 * 2) + ksrc[j]), \
        (LAS unsigned*)(ldsl_ + OFF_K + (bf) * SHM_K + (wid * 3 + j) * 1024), 16, 0, 0); } while (0)
#define VDMA(k0, sl) do { _Pragma("unroll") for (int j = 0; j < 2; ++j) __builtin_amdgcn_global_load_lds((const unsigned*)(Vh + (size_t)(k0) * (2048 * 2) + vsrc[j]), \
        (LAS unsigned*)(ldsl_ + OFF_V + (sl) * SHM_V + (wid * 2 + j) * 1024), 16, 0, 0); } while (0)
    KDMA(0, 0); VDMA(0, 0);
    bf16x8 qr[12];
    { const bf16* Qp = Q + (rowb + qlo + r32) * 3072 + h * DQK + hi * 8;
#pragma unroll
      for (int d0 = 0; d0 < 12; ++d0) qr[d0] = *(const bf16x8*)(Qp + d0 * 16); }
    asm volatile("s_waitcnt vmcnt(0)" ::: "memory");
    __syncthreads();
    float m_reg = -1e30f, l_reg = 0.f; f32x16 o[4] = {};
    const int vbase = (int)(uintptr_t)V_lds + v_rd_base(lane);
    const int qm = qlo + r32 - 4 * hi;
    f32x16 p0, p1;
#define SP_STAGE(VS) do { float mn, alpha; bf16x8 pa0, pa1, pa2, pa3; \
        partialSM(p0, p1, m_reg, mn, alpha); finishSM(p0, p1, alpha, l_reg, pa0, pa1, pa2, pa3); \
        if (__any(alpha < 1.f)) { float* al_l = WAVE_WS() + 32; if (hi == 0) al_l[r32] = alpha; asm volatile("s_waitcnt lgkmcnt(0)" ::: "memory"); \
            _Pragma("unroll") for (int d_ = 0; d_ < 4; ++d_) _Pragma("unroll") for (int r = 0; r < 16; ++r) o[d_][r] *= al_l[crow(r, hi)]; } \
        SBAR(); pv_tile(o, vbase + (VS) * SHM_V, pa0, pa1, pa2, pa3); } while (0)
    for (int t = 0; t < NT; ++t) {
        const int cur = t & 1, kb_ = t * KVBLK;
        if (t + 1 < NT) { KDMA((t + 1) * KVBLK, cur ^ 1); VDMA((t + 1) * KVBLK, cur ^ 1); }
        SBAR();
        qkt(p0, p1, K_lds + cur * SHM_K, r32, hi, qr); if (kb_ + KVBLK - 1 > qlo) mask_tile(p0, p1, qm - kb_);
        SBAR();
        SP_STAGE(cur);
        asm volatile("s_waitcnt vmcnt(0)" ::: "memory");
        __syncthreads();
    }
#undef SP_STAGE
    float* li_l = WAVE_WS();
    if (hi == 0) li_l[r32] = l_reg; asm volatile("s_waitcnt lgkmcnt(0)" ::: "memory");
    float rli[16];
#pragma unroll
    for (int r = 0; r < 16; ++r) rli[r] = __builtin_amdgcn_rcpf(li_l[crow(r, hi)]);
    bf16* Ow = O + (rowb + qlo) * 2048 + h * DV;
#pragma unroll
    for (int r = 0; r < 16; ++r) { const int orow = crow(r, hi);
#pragma unroll
        for (int d0 = 0; d0 < 4; ++d0) { const float v = o[d0][r] * rli[r];
            const float vn = __shfl_xor(v, 1);
            if ((r32 & 1) == 0) *(unsigned*)(Ow + (size_t)orow * 2048 + d0 * 32 + r32) = cvtpk(v, vn); } }
    __syncthreads();
#undef KDMA
#undef VDMA
#undef WAVE_WS
}
#undef SBAR
}

struct Args { const float* in[20]; float* out; unsigned char* ws; int ph_lo, ph_hi, coop, pad; };
#define XB_TMO      128
#define XB_XCNT(j)  (256  + 64 * (j))
#define XB_XSUB(j)  (1280 + 64 * (j))
#define XB_XGEN(j)  (2304 + 64 * (j))
#define XB_TOP      3328
#define XB_TOPGEN   3392
#define XCD_BAR_WORDS 3456
#define XB_SPIN_CAP (1u << 20)
__device__ __forceinline__ unsigned xb_ld(unsigned* p)              { return __hip_atomic_load(p, __ATOMIC_RELAXED, __HIP_MEMORY_SCOPE_AGENT); }
__device__ __forceinline__ unsigned xb_add(unsigned* p, unsigned v) { return __hip_atomic_fetch_add(p, v, __ATOMIC_RELAXED, __HIP_MEMORY_SCOPE_AGENT); }
__device__ __forceinline__ unsigned xb_xcc_id() { return (unsigned)__builtin_amdgcn_s_getreg((3 << 11) | 20) & 0xFu; }
#define XB_SPIN(cond, bar) do { unsigned _sp = 0; while (cond) { __builtin_amdgcn_s_sleep(1); \
    if ((++_sp & 255u) == 0u) { if (xb_ld(&(bar)[XB_TMO])) break; if (_sp > XB_SPIN_CAP) { atomicAdd(&(bar)[XB_TMO], 1u); break; } } } } while (0)
__device__ __forceinline__ void xcd_barrier_complete(unsigned* bar, unsigned x, unsigned& nloc, unsigned& nx) {
    const unsigned G = gridDim.x;
    unsigned sum, cnt, mine, sp = 0u;
    for (;;) {
        sum = 0u; cnt = 0u; mine = 0u;
#pragma unroll
        for (unsigned j = 0; j < 16; ++j) { const unsigned c = xb_ld(&bar[XB_XCNT(j)]); sum += c; cnt += (c > 0u) ? 1u : 0u; mine = (j == x) ? c : mine; }
        if (sum == G) break;
        __builtin_amdgcn_s_sleep(1);
        if ((++sp & 255u) == 0u) { if (xb_ld(&bar[XB_TMO])) break; if (sp > XB_SPIN_CAP) { atomicAdd(&bar[XB_TMO], 1u); break; } }
    }
    nloc = mine > 0u ? mine : 1u; nx = cnt > 0u ? cnt : 1u;
}
__device__ __forceinline__ void grid_bar(unsigned* bar, volatile LAS unsigned* st) {
    asm volatile("s_waitcnt vmcnt(0)" ::: "memory");
    __syncthreads();
    if (threadIdx.x == 0) {
        const unsigned x = xb_xcc_id();
        __builtin_amdgcn_s_waitcnt(0);
        unsigned nloc = st[0], nx = st[1];
        if (nloc == 0u) { xcd_barrier_complete(bar, x, nloc, nx); st[0] = nloc; st[1] = nx; }
        const unsigned old = xb_add(&bar[XB_XSUB(x)], 1u);
        const unsigned gen = old / nloc;
        if (old + 1u == (gen + 1u) * nloc) {
            __builtin_amdgcn_fence(__ATOMIC_RELEASE, "agent");
            asm volatile("s_waitcnt vmcnt(0)" ::: "memory");
            const unsigned og = xb_add(&bar[XB_TOP], 1u);
            const unsigned tg = og / nx;
            if (og + 1u == (tg + 1u) * nx) xb_add(&bar[XB_TOPGEN], 1u);
            else XB_SPIN(xb_ld(&bar[XB_TOPGEN]) == tg, bar);
            __builtin_amdgcn_fence(__ATOMIC_ACQUIRE, "agent");
            xb_add(&bar[XB_XGEN(x)], 1u);
            asm volatile("s_waitcnt vmcnt(0)" ::: "memory");
        } else {
            XB_SPIN(xb_ld(&bar[XB_XGEN(x)]) == gen, bar);
            __builtin_amdgcn_fence(__ATOMIC_ACQUIRE, "agent");
            asm volatile("s_waitcnt vmcnt(0)" ::: "memory");
        }
    }
    __syncthreads();
}
constexpr int NPH = 11;

__global__ void __launch_bounds__(NWAVES * 64, 2) mega_fwd(Args args) {
    extern __shared__ __attribute__((aligned(16))) unsigned char lds[];
    LAS unsigned char* ldsl = (LAS unsigned char*)lds;
    const int tid = threadIdx.x, lane = tid & 63, wave = __builtin_amdgcn_readfirstlane(tid >> 6);
    const int G = gridDim.x, bx = blockIdx.x;
    const int vcu = (G % 8 == 0) ? (bx % 8) * (G / 8) + bx / 8 : bx;
    const int gw = vcu * NWAVES + wave, NGW = G * NWAVES;
    unsigned char* ws = args.ws;
    const float* const* kin = (const float* const*)__builtin_amdgcn_kernarg_segment_ptr();
    const float* svec = (const float*)ws;
    const float* b_gate = svec + SV_BGATE; const float* q_a_norm_g = svec + SV_QAG; const float* kv_a_norm_g = svec + SV_KVAG; const float* q_norm_g = svec + SV_QNG;
    const float* k_norm_g = svec + SV_KNG; const float* pool_scale = svec + SV_PSC; const float* ffn_norm_g = svec + SV_FNG; const int* positions = (const int*)(svec + SV_POS);
    bf16* WIN_T = (bf16*)(ws + WS_WIN); bf16* WQB_T = (bf16*)(ws + WS_WQB); bf16* WKVB_T = (bf16*)(ws + WS_WKVB); bf16* WPG_T = (bf16*)(ws + WS_WPG);
    bf16* WPO_T = (bf16*)(ws + WS_WPO); bf16* WAO_T = (bf16*)(ws + WS_WAO); bf16* WOUT_T = (bf16*)(ws + WS_WOUT); bf16* WGU_T = (bf16*)(ws + WS_WGU); bf16* WDN_T = (bf16*)(ws + WS_WDN);
    bf16* XN = (bf16*)(ws + WS_XN); float* C1 = (float*)(ws + WS_C1); float* KRP = (float*)(ws + WS_KRP); bf16* U = (bf16*)(ws + WS_U); bf16* Gt = (bf16*)(ws + WS_G);
    bf16* CN = (bf16*)(ws + WS_CN); bf16* POOLED = (bf16*)(ws + WS_POOLED); bf16* Qb = (bf16*)(ws + WS_Q); bf16* Kb = (bf16*)(ws + WS_K); bf16* Vb = (bf16*)(ws + WS_V);
    bf16* PG = (bf16*)(ws + WS_PG); bf16* MP = (bf16*)(ws + WS_MP); bf16* Ob = (bf16*)(ws + WS_O); bf16* MIXED = (bf16*)(ws + WS_MIXED);
    float* X1 = (float*)(ws + WS_X1); bf16* H2 = (bf16*)(ws + WS_H2); bf16* ACT = (bf16*)(ws + WS_ACT);

    const int lo = args.ph_lo, hi_ph = args.ph_hi;
#ifndef PHMASK
#define PHMASK 0x7ff
#endif
#define IN(k) (((PHMASK >> (k)) & 1) && lo <= (k) && (k) < hi_ph)
#define SEAM(k) do { if (IN(k) && IN((k) + 1)) { unsigned char* w2_ = args.ws; asm volatile("" : "+s"(w2_)); grid_bar((unsigned*)(w2_ + WS_BAR), (volatile LAS unsigned*)(ldsl + 140032)); } } while (0)
    if (args.coop > 1) cg::this_grid().sync();
    if (threadIdx.x < 2) ((volatile LAS unsigned*)(ldsl + 140032))[threadIdx.x] = 0u;
    __syncthreads();
    if (args.coop && threadIdx.x == 0) { unsigned char* w2_ = args.ws; asm volatile("" : "+s"(w2_)); (void)xb_add(&((unsigned*)(w2_ + WS_BAR))[XB_XCNT(xb_xcc_id())], 1u); }
    LAS float* scr = (LAS float*)(ldsl + wave * 16384);
#ifdef TPROBE
#define TP_BEGIN(k) do { if ((TPROBE >> (k)) & 1) { if (blockIdx.x == 0 && threadIdx.x == 0) { *(volatile LAS unsigned*)(ldsl + 140000) = (unsigned)__builtin_amdgcn_s_memrealtime(); } } } while (0)
#define TP_END(k) do { if ((TPROBE >> (k)) & 1) { if (blockIdx.x == 0 && threadIdx.x == 0) { volatile LAS unsigned* tp_ = (volatile LAS unsigned*)(ldsl + 140000); tp_[1] += (unsigned)__builtin_amdgcn_s_memrealtime() - tp_[0]; } } } while (0)
    if (blockIdx.x == 0 && threadIdx.x == 0) { ((volatile LAS unsigned*)(ldsl + 140000))[1] = 0u; }
#else
#define TP_BEGIN(k) do {} while (0)
#define TP_END(k) do {} while (0)
#endif

    if (IN(0)) { TP_BEGIN(0);
        { float* sv = (float*)ws; const int gt = bx * (NWAVES * 64) + tid, GT = G * NWAVES * 64;
          for (int i = gt; i < M; i += GT) sv[SV_SS + i] = 0.f;
          for (int i = gt; i < SV_END; i += GT) { int idx, off, lim = 1 << 30;
              if (i < SV_QAG) { idx = 4; off = SV_BGATE; } else if (i < SV_KVAG) { idx = 5; off = SV_QAG; } else if (i < SV_QNG) { idx = 7; off = SV_KVAG; }
              else if (i < SV_KNG) { idx = 9; off = SV_QNG; lim = 192; } else if (i < SV_PSC) { idx = 10; off = SV_KNG; lim = 192; }
              else if (i < SV_FNG) { idx = 13; off = SV_PSC; } else if (i < SV_POS) { idx = 16; off = SV_FNG; } else { idx = 1; off = SV_POS; }
              const float* src = kin[idx]; sv[i] = (i - off < lim) ? src[i - off] : 0.f; } }
        constexpr int I_IN = (DM / 64) * (DIN / 32), I_QB = (QLORA / 64) * (NH * DQK / 32), I_KVB = (KVLORA / 64) * (NH * 256 / 32), I_PG = (256 / 64) * (256 / 32),
                      I_PO = (POOLW / 64) * (DM / 32), I_AO = (DM / 64) * (DM / 32), I_OUT = I_AO;
        constexpr int NITEMS = I_IN + I_QB + I_KVB + 4 * I_PG + I_PO + I_AO + I_OUT;
#define P0_DESC(it__) ([&]() { int r = (it__), idx, Kd, Nd, mode = 0, roff = 0; size_t dsto, srco = 0; \
            if (r < I_IN) { idx = 3; Kd = DM; Nd = DIN; mode = 1; dsto = WS_WIN; } \
            else if ((r -= I_IN) < I_QB) { idx = 6; Kd = QLORA; Nd = NH * DQK; dsto = WS_WQB; } \
            else if ((r -= I_QB) < I_KVB) { idx = 8; Kd = KVLORA; Nd = NH * 256; dsto = WS_WKVB; } \
            else if ((r -= I_KVB) < 4 * I_PG) { const int g = r / I_PG; r = r % I_PG; idx = 12; Kd = 256; Nd = 256; dsto = WS_WPG; roff = g * 256; srco = (size_t)g * 65536; } \
            else if ((r -= 4 * I_PG) < I_PO) { idx = 14; Kd = POOLW; Nd = DM; dsto = WS_WPO; } \
            else if ((r -= I_PO) < I_AO) { idx = 11; Kd = DM; Nd = DM; dsto = WS_WAO; } \
            else { r -= I_AO; idx = 15; Kd = DM; Nd = DM; dsto = WS_WOUT; } \
            return tr_desc(kin[idx] + srco, Kd, Nd, (bf16*)(ws + dsto), mode, roff, r, nullptr); }())
        TR_PIPELINE(gw, NITEMS, NGW, P0_DESC);
#undef P0_DESC
        { v4u* z = (v4u*)(WIN_T + (size_t)DIN * DM); const int nz = (DIN_PAD - DIN) * DM / 8;
          for (int i = gw * 64 + lane; i < nz; i += NGW * 64) z[i] = (v4u){0u, 0u, 0u, 0u}; }
        { const float* x = kin[0]; const float* attn_norm_g = kin[2];
          for (int m = gw; m < M; m += NGW) rms_row_2048(x + (size_t)m * DM, attn_norm_g, XN + (size_t)m * DM, lane); }
    TP_END(0); }
    SEAM(0);
    if (IN(1)) { TP_BEGIN(1);
        { pg8::Gemm g{XN, WIN_T, M, 6144, DM, DM, DM, 0, 0}; pg8::StaticOrder S; S.init(M, 6144, G, bx);
          pg8::EpiIn E{C1, U, Gt, b_gate};
          pg8::gemm_phase<pg8::EpiIn, pg8::StaticOrder>(ldsl, g, S, E); }
        { pg8::Gemm g{XN, WIN_T + (size_t)6144 * DM, M, 2048, 256, DM, DM, 256, 256}; pg8::StaticOrder S; S.init(M, 2048, G, bx);
          pg8::EpiKRP E{KRP};
          pg8::gemm_phase<pg8::EpiKRP, pg8::StaticOrder>(ldsl, g, S, E); }
    TP_END(1); }
    SEAM(1);
    if (IN(2)) { TP_BEGIN(2);
        for (int m = gw; m < M; m += NGW) {
            const f32x4* c = (const f32x4*)(C1 + (size_t)m * 1024) + lane; f32x4 v[4]; float sq = 0.f, skv = 0.f;
#pragma unroll
            for (int j = 0; j < 4; ++j) { v[j] = c[64 * j]; const float s = (v[j].x * v[j].x + v[j].y * v[j].y) + (v[j].z * v[j].z + v[j].w * v[j].w); if (j < 2) sq += s; else skv += s; }
            const float iq = 1.0f / sqrtf(wave_sum(sq) * (1.f / 512.f) + EPS), ikv = 1.0f / sqrtf(wave_sum(skv) * (1.f / 512.f) + EPS);
            v2u* o8 = (v2u*)(CN + (size_t)m * 1024) + lane;
#pragma unroll
            for (int j = 0; j < 4; ++j) { const f32x4 gv = (j < 2) ? ((const f32x4*)q_a_norm_g)[lane + 64 * j] : ((const f32x4*)kv_a_norm_g)[lane + 64 * (j - 2)]; const float iv = (j < 2) ? iq : ikv;
                v2u o; o.x = cvtpk(v[j].x * iv * gv.x, v[j].y * iv * gv.y); o.y = cvtpk(v[j].z * iv * gv.z, v[j].w * iv * gv.w); o8[64 * j] = o; }
        }
        for (int m = gw; m < M; m += NGW) {
            const int s = m & (SEQ - 1);
#pragma unroll
            for (int jj = 0; jj < 2; ++jj) {
                const int col = 8 * lane + 512 * jj, grp = col >> 8, w = 2 << grp; const int cnt = (s + 1 < w) ? s + 1 : w;
                float a[8]; float u0[8];
#pragma unroll
                for (int e = 0; e < 8; ++e) a[e] = 0.f;
#pragma unroll
                for (int d = 0; d < 16; ++d) {
                    if (d < cnt) { const v4u q = *(const v4u*)(U + (size_t)(m - d) * 1024 + col);
                        const float f[8] = {bflo(q.x), bfhi(q.x), bflo(q.y), bfhi(q.y), bflo(q.z), bfhi(q.z), bflo(q.w), bfhi(q.w)};
#pragma unroll
                        for (int e = 0; e < 8; ++e) { a[e] += f[e]; if (d == 0) u0[e] = f[e]; } }
                }
                const float rc = 1.0f / (float)cnt;
                v4u o; o.x = cvtpk(a[0] * rc - u0[0], a[1] * rc - u0[1]); o.y = cvtpk(a[2] * rc - u0[2], a[3] * rc - u0[3]);
                o.z = cvtpk(a[4] * rc - u0[4], a[5] * rc - u0[5]); o.w = cvtpk(a[6] * rc - u0[6], a[7] * rc - u0[7]);
                *(v4u*)(POOLED + (size_t)m * 1024 + col) = o;
            }
        }
    TP_END(2); }
    SEAM(2);
    if (IN(3)) { TP_BEGIN(3);
        { pg8::Gemm g{CN, WQB_T, M, NH * DQK, QLORA, 1024, QLORA, 0, 0}; pg8::StaticOrder S; S.init(M, NH * DQK, G, bx);
          pg8::EpiBf16 E{Qb, 3072}; pg8::gemm_phase<pg8::EpiBf16, pg8::StaticOrder>(ldsl, g, S, E); }
        { pg8::Gemm g{CN + 512, WKVB_T, M, NH * 256, KVLORA, 1024, KVLORA, 0, 0}; pg8::StaticOrder S; S.init(M, NH * 256, G, bx);
          pg8::EpiKV E{Kb, Vb}; pg8::gemm_phase<pg8::EpiKV, pg8::StaticOrder>(ldsl, g, S, E); }
        { pg8::Gemm g{POOLED, WPG_T, M, POOLW, 256, 1024, 256, 256, 0}; pg8::StaticOrder S; S.init(M, POOLW, G, (bx + 128) % G);
          pg8::EpiScale E{PG, 1024, pool_scale}; pg8::gemm_phase<pg8::EpiScale, pg8::StaticOrder>(ldsl, g, S, E); }
    TP_END(3); }
    SEAM(3);
    if (IN(4)) { TP_BEGIN(4);
        for (int m = gw; m < M; m += NGW) {
            const float pos = (float)positions[m];
            const int sub = lane & 3, h = lane >> 2;
            float cs[8], sn[8];
#pragma unroll
            for (int j = 0; j < 8; ++j) { const int i = 8 * sub + j; const float invf = __builtin_amdgcn_exp2f(-(float)i * (13.287712379549449f / 32.f));
                const float ang = pos * invf; const float k = rintf(ang * 0.15915494309189535f);
                float r = fmaf(-k, 6.2831854820251465f, ang); r = fmaf(-k, -1.7484555e-7f, r);
                sn[j] = __sinf(r); cs[j] = __cosf(r); }
#pragma unroll
            for (int which = 0; which < 2; ++which) {
                bf16* base = (which == 0 ? Qb : Kb) + (size_t)m * 3072 + h * DQK;
                const float* gn = (which == 0) ? q_norm_g : k_norm_g;
                float nv[32], rl[8], rh[8]; float ss = 0.f;
#pragma unroll
                for (int jj = 0; jj < 4; ++jj) { const v4u q = *(const v4u*)(base + 32 * sub + 8 * jj);
                    nv[8 * jj + 0] = bflo(q.x); nv[8 * jj + 1] = bfhi(q.x); nv[8 * jj + 2] = bflo(q.y); nv[8 * jj + 3] = bfhi(q.y);
                    nv[8 * jj + 4] = bflo(q.z); nv[8 * jj + 5] = bfhi(q.z); nv[8 * jj + 6] = bflo(q.w); nv[8 * jj + 7] = bfhi(q.w); }
                if (which == 0) {
                    const v4u a = *(const v4u*)(base + 128 + 8 * sub), b = *(const v4u*)(base + 160 + 8 * sub);
                    rl[0] = bflo(a.x); rl[1] = bfhi(a.x); rl[2] = bflo(a.y); rl[3] = bfhi(a.y); rl[4] = bflo(a.z); rl[5] = bfhi(a.z); rl[6] = bflo(a.w); rl[7] = bfhi(a.w);
                    rh[0] = bflo(b.x); rh[1] = bfhi(b.x); rh[2] = bflo(b.y); rh[3] = bfhi(b.y); rh[4] = bflo(b.z); rh[5] = bfhi(b.z); rh[6] = bflo(b.w); rh[7] = bfhi(b.w);
                } else {
                    f32x4 a0 = {0.f, 0.f, 0.f, 0.f}, a1 = a0, b0 = a0, b1 = a0;
#pragma unroll
                    for (int ks = 0; ks < 8; ++ks) { const float* kp = KRP + ((size_t)ks * 8192 + m) * 64 + 8 * sub;
                        a0 += *(const f32x4*)kp; a1 += *(const f32x4*)(kp + 4); b0 += *(const f32x4*)(kp + 32); b1 += *(const f32x4*)(kp + 36); }
                    rl[0] = a0.x; rl[1] = a0.y; rl[2] = a0.z; rl[3] = a0.w; rl[4] = a1.x; rl[5] = a1.y; rl[6] = a1.z; rl[7] = a1.w;
                    rh[0] = b0.x; rh[1] = b0.y; rh[2] = b0.z; rh[3] = b0.w; rh[4] = b1.x; rh[5] = b1.y; rh[6] = b1.z; rh[7] = b1.w;
                }
#pragma unroll
                for (int e = 0; e < 32; ++e) ss += nv[e] * nv[e];
#pragma unroll
                for (int e = 0; e < 8; ++e) ss += rl[e] * rl[e] + rh[e] * rh[e];
                ss += __shfl_xor(ss, 1); ss += __shfl_xor(ss, 2);
                const float inv = 1.0f / sqrtf(ss * (1.f / 192.f) + EPS);
#pragma unroll
                for (int jj = 0; jj < 4; ++jj) { const f32x4 g0 = *(const f32x4*)(gn + 32 * sub + 8 * jj), g1 = *(const f32x4*)(gn + 32 * sub + 8 * jj + 4);
                    v4u o; o.x = cvtpk(nv[8 * jj + 0] * inv * g0.x, nv[8 * jj + 1] * inv * g0.y); o.y = cvtpk(nv[8 * jj + 2] * inv * g0.z, nv[8 * jj + 3] * inv * g0.w);
                    o.z = cvtpk(nv[8 * jj + 4] * inv * g1.x, nv[8 * jj + 5] * inv * g1.y); o.w = cvtpk(nv[8 * jj + 6] * inv * g1.z, nv[8 * jj + 7] * inv * g1.w);
                    *(v4u*)(base + 32 * sub + 8 * jj) = o; }
                float ol[8], oh[8];
#pragma unroll
                for (int e = 0; e < 8; ++e) { const float a = rl[e] * inv * gn[128 + 8 * sub + e], b = rh[e] * inv * gn[160 + 8 * sub + e];
                    ol[e] = a * cs[e] - b * sn[e]; oh[e] = b * cs[e] + a * sn[e]; }
                v4u o1, o2; o1.x = cvtpk(ol[0], ol[1]); o1.y = cvtpk(ol[2], ol[3]); o1.z = cvtpk(ol[4], ol[5]); o1.w = cvtpk(ol[6], ol[7]);
                o2.x = cvtpk(oh[0], oh[1]); o2.y = cvtpk(oh[2], oh[3]); o2.z = cvtpk(oh[4], oh[5]); o2.w = cvtpk(oh[6], oh[7]);
                *(v4u*)(base + 128 + 8 * sub) = o1; *(v4u*)(base + 160 + 8 * sub) = o2;
            }
        }
        { pg8::Gemm g{PG, WPO_T, M, DM, POOLW, POOLW, POOLW, 0, 0}; pg8::StaticOrder S; S.init(M, DM, G, bx);
          pg8::EpiGate<false> E{MP, Gt, nullptr, 0}; pg8::gemm_phase<pg8::EpiGate<false>, pg8::StaticOrder>(ldsl, g, S, E); }
    TP_END(4); }
    SEAM(4);
    if (IN(5)) { TP_BEGIN(5);
        const int npair = BATCH * NH * 8;
        for (int p = vcu; p < npair; p += G) {
            const int bh = p >> 3, s = p & 7;
            att::attn_unit(bh / NH, bh % NH, 15 - s, Qb, Kb, Vb, Ob, (char*)lds);
            att::attn_unit(bh / NH, bh % NH, s, Qb, Kb, Vb, Ob, (char*)lds);
        }
    TP_END(5); }
    SEAM(5);
    if (IN(6)) { TP_BEGIN(6);
        pg8::Gemm g{Ob, WAO_T, M, DM, DM, DM, DM, 0, 0}; pg8::StaticOrder S; S.init(M, DM, G, bx);
        pg8::EpiGate<true> E{MIXED, Gt, MP, 2048}; pg8::gemm_phase<pg8::EpiGate<true>, pg8::StaticOrder>(ldsl, g, S, E);
    TP_END(6); }
    SEAM(6);
    if (IN(7)) { TP_BEGIN(7);
        { constexpr int I_G = (DM / 64) * (DFF / 32);
#define GU_DESC(it__) ((it__) < I_G ? tr_desc(kin[17], DM, DFF, (bf16*)(ws + WS_WGU), 2, 0, (it__), ffn_norm_g) : tr_desc(kin[18], DM, DFF, (bf16*)(ws + WS_WGU), 3, 0, (it__) - I_G, ffn_norm_g))
          TR_PIPELINE(gw, 2 * I_G, NGW, GU_DESC);
#undef GU_DESC
          __syncthreads(); }
        pg8::Gemm g{MIXED, WOUT_T, M, DM, DM, DM, DM, 0, 0}; pg8::StaticOrder S; S.init(M, DM, G, bx);
        pg8::EpiResNorm E{kin[0], X1, (bf16*)(ws + WS_X1B), (float*)ws + SV_SS, DM}; pg8::gemm_phase<pg8::EpiResNorm, pg8::StaticOrder>(ldsl, g, S, E);
    TP_END(7); }
    SEAM(7);
    if (IN(9)) { TP_BEGIN(9);
        pg8::Gemm g{(bf16*)(ws + WS_X1B), WGU_T, M, 2 * DFF, DM, DM, DM, 0, 0}; pg8::StaticOrder S; S.init(M, 2 * DFF, G, bx);
        pg8::EpiSwiGLU E{ACT, DFF, (const float*)ws + SV_SS}; pg8::gemm_phase<pg8::EpiSwiGLU, pg8::StaticOrder>(ldsl, g, S, E);
        if (G == 256 ? (bx >= 128) : true) {
            constexpr int I_D2 = (DFF / 64) * (DM / 32);
            const int nw = (G == 256) ? 128 * NWAVES : NGW, w0 = (G == 256) ? (bx - 128) * NWAVES + wave : gw;
#define DN_DESC(it__) tr_desc(kin[19], DFF, DM, (bf16*)(ws + WS_WDN), 0, 0, (it__), nullptr)
            TR_PIPELINE(w0, I_D2, nw, DN_DESC);
#undef DN_DESC
        }
    TP_END(9); }
    SEAM(9);
    if (IN(10)) { TP_BEGIN(10);
        pg8::Gemm g{ACT, WDN_T, M, DM, DFF, DFF, DFF, 0, 0}; pg8::StaticOrder S; S.init(M, DM, G, bx);
        pg8::EpiRes E{X1, args.out, DM}; pg8::gemm_phase<pg8::EpiRes, pg8::StaticOrder>(ldsl, g, S, E);
    TP_END(10); }
#ifdef TPROBE
    if (blockIdx.x == 0 && threadIdx.x == 0) { const unsigned w_ = 4u * ((volatile LAS unsigned*)(ldsl + 140000))[1]; const unsigned long long t0_ = __builtin_amdgcn_s_memrealtime(); while ((unsigned)(__builtin_amdgcn_s_memrealtime() - t0_) < w_) __builtin_amdgcn_s_sleep(8); }
#endif
#undef IN
#undef SEAM
}

extern "C" void kernel_launch(void* const* d_in, const int* in_sizes, int n_in, void* d_out, int out_size, void* d_ws, size_t ws_size, hipStream_t stream) {
    static int grid = 0;
    if (grid == 0) {
        if (n_in != 20 || out_size != M * DM || ws_size < WS_END) { fprintf(stderr, "kernel_launch: unexpected shapes (n_in %d, out %d, ws %zu)\n", n_in, out_size, ws_size); grid = -1; return; }
        int dev = 0, cus = 0, per_cu = 0;
        (void)hipGetDevice(&dev); (void)hipDeviceGetAttribute(&cus, hipDeviceAttributeMultiprocessorCount, dev);
        if (hipFuncSetAttribute((const void*)mega_fwd, hipFuncAttributeMaxDynamicSharedMemorySize, LDS_BYTES) != hipSuccess) { fprintf(stderr, "kernel_launch: hipFuncSetAttribute failed\n"); grid = -1; return; }
        if (hipOccupancyMaxActiveBlocksPerMultiprocessor(&per_cu, (const void*)mega_fwd, NWAVES * 64, LDS_BYTES) != hipSuccess || per_cu < 1) { fprintf(stderr, "kernel_launch: occupancy query says %d\n", per_cu); per_cu = 1; }
        (void)hipGetLastError();
        grid = cus > 0 ? cus : 256;
    }
    if (grid < 0) return;
    Args a{};
    for (int i = 0; i < 20; ++i) a.in[i] = (const float*)d_in[i];
    a.out = (float*)d_out; a.ws = (unsigned char*)d_ws;
    if (MK_N_LAUNCHES == 1) {
        a.ph_lo = 0; a.ph_hi = NPH; a.coop = 1;
        (void)hipMemsetAsync((char*)d_ws + WS_BAR, 0, 16384, stream);
        void* kargs[] = {&a};
        hipError_t e = hipLaunchCooperativeKernel((const void*)mega_fwd, dim3(grid), dim3(NWAVES * 64), kargs, LDS_BYTES, stream);
        if (e != hipSuccess) fprintf(stderr, "kernel_launch: cooperative launch failed: %s (grid %d)\n", hipGetErrorString(e), grid);
    } else {
        for (int p = 0; p < NPH; ++p) {
            a.ph_lo = p; a.ph_hi = p + 1;
            hipLaunchKernelGGL(mega_fwd, dim3(grid), dim3(NWAVES * 64), LDS_BYTES, stream, a);
        }
    }
}
```

```cpp
#include <hip/hip_runtime.h>
#include <hip/hip_cooperative_groups.h>
#include <cstdio>
#include <cstdint>
namespace cg = cooperative_groups;

#ifndef MK_N_LAUNCHES
#define MK_N_LAUNCHES 1
#endif

namespace pg8 {
#define PG8_LAS __attribute__((address_space(3)))
typedef unsigned short bf16_t;
typedef short bf16x8 __attribute__((ext_vector_type(8)));
typedef float f32x4 __attribute__((ext_vector_type(4)));
typedef unsigned u32x4 __attribute__((ext_vector_type(4)));
constexpr int BM = 256, BK = 64, HALF = 128, HTB = HALF * BK * 2, STAGE_BYTES = 8 * HTB, NXCD = 8, WGM = 8;

__host__ __device__ __forceinline__ int lds_byte(int r, int c) { const int st = (r >> 4) * 2 + (c >> 5), rr = r & 15, cc = c & 31, ob = rr * 64 + cc * 2; return st * 1024 + (ob ^ (((ob >> 9) & 1) << 5)); }
__host__ __device__ __forceinline__ void stage_rc(int b, int& R, int& C) { const int st = b / 1024, sb = b % 1024, swz = sb ^ (((sb >> 9) & 1) << 5); R = (st >> 1) * 16 + swz / 64; C = (st & 1) * 32 + (swz % 64) / 2; }
__host__ __device__ __forceinline__ int perm32(int rho) { const int n = rho >> 4, i = rho & 15; return 8 * (i >> 2) + 4 * n + (i & 3); }

struct Unit { int pm, pn; };
struct Gemm { const bf16_t* A; const bf16_t* Bt; int M, N, K, lda, ldb, a_pn_step, b_pn_step; };

struct StaticOrder {
    int nM, nN, nwg, G, c;
    __host__ __device__ void init(int M, int N, int G_, int c_) { nM = M / BM; nN = N / BM; nwg = nM * nN; G = G_; c = c_; }
    __host__ __device__ bool next(int i, Unit& u) const {
        const long L = (long)i * G + c; if (L >= nwg) return false;
        int wgid = (int)L; { const int q = nwg / NXCD, r = nwg % NXCD, xcd = wgid % NXCD, off = wgid / NXCD; wgid = (xcd < r ? xcd * (q + 1) : r * (q + 1) + (xcd - r) * q) + off; }
        const int nig = WGM * nN, gid = wgid / nig, fm = gid * WGM, gsz = (nM - fm) < WGM ? (nM - fm) : WGM;
        u.pm = fm + ((wgid % nig) % gsz); u.pn = (wgid % nig) / gsz; return true;
    }
};

typedef float f32x2_t_ __attribute__((ext_vector_type(2))); typedef __bf16 bf16x2_t_ __attribute__((ext_vector_type(2)));
__device__ __forceinline__ unsigned cvt_pk_bf16(float lo, float hi) { f32x2_t_ v = {lo, hi}; bf16x2_t_ b = __builtin_convertvector(v, bf16x2_t_); return __builtin_bit_cast(unsigned, b); }
__device__ __forceinline__ u32x4 pack8(f32x4 a, f32x4 b) { u32x4 w; w.x = cvt_pk_bf16(a[0], a[1]); w.y = cvt_pk_bf16(a[2], a[3]); w.z = cvt_pk_bf16(b[0], b[1]); w.w = cvt_pk_bf16(b[2], b[3]); return w; }
__device__ __forceinline__ void unpack8(u32x4 w, f32x4& a, f32x4& b) {
    a[0] = __uint_as_float(w.x << 16); a[1] = __uint_as_float(w.x & 0xffff0000u); a[2] = __uint_as_float(w.y << 16); a[3] = __uint_as_float(w.y & 0xffff0000u);
    b[0] = __uint_as_float(w.z << 16); b[1] = __uint_as_float(w.z & 0xffff0000u); b[2] = __uint_as_float(w.w << 16); b[3] = __uint_as_float(w.w & 0xffff0000u); }
__device__ __forceinline__ float sigmoidf_(float v) { return __builtin_amdgcn_rcpf(1.0f + __builtin_amdgcn_exp2f(-1.4426950408889634f * v)); }
__device__ __forceinline__ f32x4 sigmoid4(f32x4 v) { f32x4 o; o[0] = sigmoidf_(v[0]); o[1] = sigmoidf_(v[1]); o[2] = sigmoidf_(v[2]); o[3] = sigmoidf_(v[3]); return o; }

typedef f32x4 AccT[2][2][4][2];
#define EPI_LOOP_AM _Pragma("unroll") for (int ai = 0; ai < 2; ++ai) _Pragma("unroll") for (int m = 0; m < 4; ++m)
#define EPI_LOOP_B _Pragma("unroll") for (int bj = 0; bj < 2; ++bj)

struct EpiIn {
    static constexpr bool PERM = true;
    float* C1; bf16_t* U; bf16_t* G; const float* bgate;
    __device__ __forceinline__ void operator()(const AccT& acc, const Unit& u, int wr, int wc, int fr, int fq) const {
        const int row0 = u.pm * BM + wr * 64 + fr, pn = u.pn, cw = wc * 32 + 8 * fq;
        if (pn < 4) {
            EPI_LOOP_AM { float* rp = C1 + (size_t)(row0 + ai * HALF + m * 16) * 1024 + pn * 256 + cw;
                EPI_LOOP_B { *(f32x4*)(rp + bj * HALF) = acc[ai][bj][m][0]; *(f32x4*)(rp + bj * HALF + 4) = acc[ai][bj][m][1]; } }
        } else if (pn < 8) {
            EPI_LOOP_AM { bf16_t* rp = U + (size_t)(row0 + ai * HALF + m * 16) * 1024 + (pn - 4) * 256 + cw;
                EPI_LOOP_B { *(u32x4*)(rp + bj * HALF) = pack8(acc[ai][bj][m][0], acc[ai][bj][m][1]); } }
        } else {
            const int gc = (pn - 8) * 256 + cw; f32x4 bv[2][2];
            EPI_LOOP_B { bv[bj][0] = *(const f32x4*)(bgate + gc + bj * HALF); bv[bj][1] = *(const f32x4*)(bgate + gc + bj * HALF + 4); }
            EPI_LOOP_AM { bf16_t* rp = G + (size_t)(row0 + ai * HALF + m * 16) * 4096 + gc;
                EPI_LOOP_B { *(u32x4*)(rp + bj * HALF) = pack8(sigmoid4(acc[ai][bj][m][0] + bv[bj][0]), sigmoid4(acc[ai][bj][m][1] + bv[bj][1])); } }
        }
    }
};
struct EpiKRP {
    static constexpr bool PERM = true;
    float* KRP;
    __device__ __forceinline__ void operator()(const AccT& acc, const Unit& u, int wr, int wc, int fr, int fq) const {
        const int row0 = u.pm * BM + wr * 64 + fr, cw = wc * 32 + 8 * fq;
        if (wc < 2) { EPI_LOOP_AM { float* rp = KRP + ((size_t)u.pn * 8192 + (row0 + ai * HALF + m * 16)) * 64 + cw; *(f32x4*)rp = acc[ai][0][m][0]; *(f32x4*)(rp + 4) = acc[ai][0][m][1]; } }
    }
};
struct EpiBf16 {
    static constexpr bool PERM = true;
    bf16_t* O; int ldc;
    __device__ __forceinline__ void operator()(const AccT& acc, const Unit& u, int wr, int wc, int fr, int fq) const {
        const int row0 = u.pm * BM + wr * 64 + fr, col0 = u.pn * BM + wc * 32 + 8 * fq;
        EPI_LOOP_AM { bf16_t* rp = O + (size_t)(row0 + ai * HALF + m * 16) * ldc + col0;
            EPI_LOOP_B { *(u32x4*)(rp + bj * HALF) = pack8(acc[ai][bj][m][0], acc[ai][bj][m][1]); } }
    }
};
struct EpiKV {
    static constexpr bool PERM = true;
    bf16_t* K; bf16_t* V;
    __device__ __forceinline__ void operator()(const AccT& acc, const Unit& u, int wr, int wc, int fr, int fq) const {
        const int row0 = u.pm * BM + wr * 64 + fr, cw = wc * 32 + 8 * fq, h = u.pn;
        EPI_LOOP_AM { const size_t row = (size_t)(row0 + ai * HALF + m * 16);
            *(u32x4*)(K + row * 3072 + h * 192 + cw) = pack8(acc[ai][0][m][0], acc[ai][0][m][1]);
            *(u32x4*)(V + row * 2048 + h * 128 + cw) = pack8(acc[ai][1][m][0], acc[ai][1][m][1]); }
    }
};
struct EpiScale {
    static constexpr bool PERM = true;
    bf16_t* O; int ldc; const float* scale;
    __device__ __forceinline__ void operator()(const AccT& acc, const Unit& u, int wr, int wc, int fr, int fq) const {
        const int row0 = u.pm * BM + wr * 64 + fr, col0 = u.pn * BM + wc * 32 + 8 * fq; f32x4 sv[2][2];
        EPI_LOOP_B { sv[bj][0] = *(const f32x4*)(scale + col0 + bj * HALF); sv[bj][1] = *(const f32x4*)(scale + col0 + bj * HALF + 4); }
        EPI_LOOP_AM { bf16_t* rp = O + (size_t)(row0 + ai * HALF + m * 16) * ldc + col0;
            EPI_LOOP_B { *(u32x4*)(rp + bj * HALF) = pack8(acc[ai][bj][m][0] * sv[bj][0], acc[ai][bj][m][1] * sv[bj][1]); } }
    }
};
template <bool HAS_ADD> struct EpiGate {
    static constexpr bool PERM = true;
    bf16_t* O; const bf16_t* gate; const bf16_t* add; int gcol0;
    __device__ __forceinline__ void operator()(const AccT& acc, const Unit& u, int wr, int wc, int fr, int fq) const {
        const int row0 = u.pm * BM + wr * 64 + fr, col0 = u.pn * BM + wc * 32 + 8 * fq;
        EPI_LOOP_AM { const size_t row = (size_t)(row0 + ai * HALF + m * 16);
            EPI_LOOP_B { f32x4 g0, g1; unpack8(*(const u32x4*)(gate + row * 4096 + gcol0 + col0 + bj * HALF), g0, g1);
                f32x4 v0 = g0 * acc[ai][bj][m][0], v1 = g1 * acc[ai][bj][m][1];
                if (HAS_ADD) { f32x4 a0, a1; unpack8(*(const u32x4*)(add + row * 2048 + col0 + bj * HALF), a0, a1); v0 += a0; v1 += a1; }
                *(u32x4*)(O + row * 2048 + col0 + bj * HALF) = pack8(v0, v1); } }
    }
};
struct EpiRes {
    static constexpr bool PERM = false;
    const float* base; float* out; int ldc;
    __device__ __forceinline__ void operator()(const AccT& acc, const Unit& u, int wr, int wc, int fr, int fq) const {
        const int row0 = u.pm * BM + wr * 64 + fr, col0 = u.pn * BM + wc * 32 + 4 * fq;
        EPI_LOOP_AM { const size_t off = (size_t)(row0 + ai * HALF + m * 16) * ldc + col0;
            EPI_LOOP_B {
#pragma unroll
                for (int n = 0; n < 2; ++n) { const f32x4 b = *(const f32x4*)(base + off + bj * HALF + n * 16); *(f32x4*)(out + off + bj * HALF + n * 16) = b + acc[ai][bj][m][n]; } } }
    }
};
struct EpiResNorm {
    static constexpr bool PERM = false;
    const float* base; float* out; bf16_t* outb; float* ss; int ldc;
    __device__ __forceinline__ void operator()(const AccT& acc, const Unit& u, int wr, int wc, int fr, int fq) const {
        const int row0 = u.pm * BM + wr * 64 + fr, col0 = u.pn * BM + wc * 32 + 4 * fq;
        EPI_LOOP_AM { const int row = row0 + ai * HALF + m * 16; const size_t off = (size_t)row * ldc + col0; float s = 0.f;
            EPI_LOOP_B {
#pragma unroll
                for (int n = 0; n < 2; ++n) { const f32x4 v = *(const f32x4*)(base + off + bj * HALF + n * 16) + acc[ai][bj][m][n]; *(f32x4*)(out + off + bj * HALF + n * 16) = v;
                    typedef unsigned u32x2_ __attribute__((ext_vector_type(2))); u32x2_ w; w.x = cvt_pk_bf16(v[0], v[1]); w.y = cvt_pk_bf16(v[2], v[3]); *(u32x2_*)(outb + off + bj * HALF + n * 16) = w;
                    s += (v[0] * v[0] + v[1] * v[1]) + (v[2] * v[2] + v[3] * v[3]); } }
            s += __shfl_xor(s, 16); s += __shfl_xor(s, 32);
            if (fq == 0) atomicAdd(ss + row, s); }
    }
};
struct EpiSwiGLU {
    static constexpr bool PERM = true;
    bf16_t* O; int ldc; const float* ss;
    __device__ __forceinline__ void operator()(const AccT& acc, const Unit& u, int wr, int wc, int fr, int fq) const {
        const int row0 = u.pm * BM + wr * 64 + fr, col0 = u.pn * HALF + wc * 32 + 8 * fq;
        EPI_LOOP_AM { const int row = row0 + ai * HALF + m * 16; bf16_t* rp = O + (size_t)row * ldc + col0;
            const float inv = 1.0f / sqrtf(ss[row] * (1.f / 2048.f) + 1e-6f);
            const f32x4 g0 = acc[ai][0][m][0] * inv, g1 = acc[ai][0][m][1] * inv;
            *(u32x4*)rp = pack8(g0 * sigmoid4(g0) * (acc[ai][1][m][0] * inv), g1 * sigmoid4(g1) * (acc[ai][1][m][1] * inv)); }
    }
};

template <class Epi, class Sched, bool ALIGN_EPI = true>
__device__ __forceinline__ void gemm_phase(PG8_LAS unsigned char* lds, const Gemm g, const Sched& S, const Epi& E) {
    const int tid = threadIdx.x, wid = __builtin_amdgcn_readfirstlane(tid >> 6), lane = tid & 63, wr = wid >> 2, wc = wid & 3, fr = lane & 15, fq = lane >> 4;
    const int K = g.K, nt = K / BK;
    unsigned voffA[2], voffB[2];
#pragma unroll
    for (int i = 0; i < 2; ++i) { int R, C; stage_rc(tid * 16 + i * 8192, R, C); const int Rb = Epi::PERM ? ((R & ~31) + perm32(R & 31)) : R;
        voffA[i] = (unsigned)(R * g.lda + C) * 2u; voffB[i] = (unsigned)(Rb * g.ldb + C) * 2u; }
    const size_t kstep = (size_t)(BK * 2);
    const size_t hstepA = (size_t)HALF * g.lda * 2, hstepB = (size_t)HALF * g.ldb * 2;
    const size_t tstepA = 2 * hstepA, tstepB = g.b_pn_step ? (size_t)g.b_pn_step * 2 : 2 * hstepB, pstepA = (size_t)g.a_pn_step * 2;
    const unsigned ldsw = (unsigned)wid * 1024u;
    const int aoff = lds_byte(wr * 64 + fr, fq * 8), boff = lds_byte(wc * 32 + fr, fq * 8);
#define PG8_SA(b, h) (((b) * 2 + (h)) * HTB)
#define PG8_SB(b, h) ((4 + (b) * 2 + (h)) * HTB)
#define PG8_STAGE(bufoff, gbase, voff) do { _Pragma("unroll") for (int _i = 0; _i < 2; ++_i) \
        __builtin_amdgcn_global_load_lds((const unsigned*)((const char*)(gbase) + (voff)[_i]), (PG8_LAS unsigned*)(lds + (bufoff) + ldsw + _i * 8192), 16, 0, 0); } while (0)
#define PG8_LDA(dst, b, h) do { _Pragma("unroll") for (int m = 0; m < 4; ++m) _Pragma("unroll") for (int k = 0; k < 2; ++k) dst[m][k] = *(const PG8_LAS bf16x8*)(lds + PG8_SA(b, h) + aoff + m * 2048 + k * 1024); } while (0)
#define PG8_LDB(dst, b, h) do { _Pragma("unroll") for (int n = 0; n < 2; ++n) _Pragma("unroll") for (int k = 0; k < 2; ++k) dst[n][k] = *(const PG8_LAS bf16x8*)(lds + PG8_SB(b, h) + boff + n * 2048 + k * 1024); } while (0)
#define PG8_MMA(ai, bj, At, Bt) do { __builtin_amdgcn_s_setprio(1); _Pragma("unroll") for (int m = 0; m < 4; ++m) _Pragma("unroll") for (int n = 0; n < 2; ++n) _Pragma("unroll") for (int k = 0; k < 2; ++k) \
        acc[ai][bj][m][n] = __builtin_amdgcn_mfma_f32_16x16x32_bf16(Bt[n][k], At[m][k], acc[ai][bj][m][n], 0, 0, 0); __builtin_amdgcn_s_setprio(0); } while (0)
#define PG8_WAIT_V(n) asm volatile("s_waitcnt vmcnt(" #n ")" ::: "memory")
#define PG8_WAIT_L(n) asm volatile("s_waitcnt lgkmcnt(" #n ")" ::: "memory")
#define PG8_BAR __builtin_amdgcn_s_barrier()
#define PG8_SCHED __builtin_amdgcn_sched_barrier(0)
    Unit cur, nxt; int ui = 0;
    if (!S.next(0, cur)) return;
    f32x4 acc[2][2][4][2];
#pragma unroll
    for (int a = 0; a < 2; ++a)
#pragma unroll
        for (int b = 0; b < 2; ++b)
#pragma unroll
            for (int m = 0; m < 4; ++m)
#pragma unroll
                for (int n = 0; n < 2; ++n) acc[a][b][m][n] = (f32x4){0.f, 0.f, 0.f, 0.f};
    bf16x8 At[4][2], B0[2][2], B1[2][2];
    const char* cA = (const char*)g.A + (size_t)cur.pm * tstepA + (size_t)cur.pn * pstepA; const char* cB = (const char*)g.Bt + (size_t)cur.pn * tstepB;
    PG8_STAGE(PG8_SB(0, 0), cB, voffB); PG8_STAGE(PG8_SB(0, 1), cB + hstepB, voffB); PG8_STAGE(PG8_SA(0, 0), cA, voffA); PG8_STAGE(PG8_SA(0, 1), cA + hstepA, voffA);
    if (wr == 1) PG8_BAR;
    PG8_WAIT_V(2); PG8_BAR;
    PG8_STAGE(PG8_SB(1, 0), cB + kstep, voffB); PG8_STAGE(PG8_SA(1, 0), cA + kstep, voffA); PG8_STAGE(PG8_SB(1, 1), cB + hstepB + kstep, voffB);
    PG8_WAIT_V(6); PG8_BAR;
    for (;;) {
        const bool has_next = S.next(ui + 1, nxt);
        const char* nA = has_next ? (const char*)g.A + (size_t)nxt.pm * tstepA + (size_t)nxt.pn * pstepA : cA; const char* nB = has_next ? (const char*)g.Bt + (size_t)nxt.pn * tstepB : cB;
        for (int t = 0; t < nt; t += 2) {
            const bool last = (t == nt - 2);
            const char* a1 = cA + (size_t)(t + 1) * kstep;
            const char* a2 = last ? nA : cA + (size_t)(t + 2) * kstep; const char* b2 = last ? nB : cB + (size_t)(t + 2) * kstep;
            const char* a3 = a2 + kstep; const char* b3 = b2 + kstep;
            PG8_LDB(B0, 0, 0); PG8_LDB(B1, 0, 1); PG8_SCHED; PG8_LDA(At, 0, 0); PG8_STAGE(PG8_SA(1, 1), a1 + hstepA, voffA);
            PG8_WAIT_V(8); PG8_WAIT_L(0); PG8_BAR; PG8_MMA(0, 0, At, B0); PG8_MMA(0, 1, At, B1); PG8_BAR; PG8_SCHED;
            PG8_LDA(At, 0, 1); PG8_STAGE(PG8_SB(0, 0), b2, voffB); PG8_STAGE(PG8_SB(0, 1), b2 + hstepB, voffB); PG8_STAGE(PG8_SA(0, 0), a2, voffA);
            PG8_WAIT_V(8); PG8_WAIT_L(0); PG8_BAR; PG8_MMA(1, 0, At, B0); PG8_MMA(1, 1, At, B1); PG8_BAR; PG8_SCHED;
            PG8_LDB(B0, 1, 0); PG8_LDB(B1, 1, 1); PG8_SCHED; PG8_LDA(At, 1, 0); PG8_STAGE(PG8_SA(0, 1), a2 + hstepA, voffA);
            PG8_WAIT_V(8); PG8_WAIT_L(0); PG8_BAR; PG8_MMA(0, 0, At, B0); PG8_MMA(0, 1, At, B1); PG8_BAR; PG8_SCHED;
            PG8_LDA(At, 1, 1); PG8_STAGE(PG8_SB(1, 0), b3, voffB); PG8_STAGE(PG8_SB(1, 1), b3 + hstepB, voffB); PG8_STAGE(PG8_SA(1, 0), a3, voffA);
            PG8_WAIT_V(8); PG8_WAIT_L(0); PG8_BAR; PG8_MMA(1, 0, At, B0); PG8_MMA(1, 1, At, B1); PG8_BAR; PG8_SCHED;
        }
        if constexpr (ALIGN_EPI) { if (wr == 0) PG8_BAR; }
        E(acc, cur, wr, wc, fr, fq);
        if (!has_next) break;
#pragma unroll
        for (int a = 0; a < 2; ++a)
#pragma unroll
            for (int b = 0; b < 2; ++b)
#pragma unroll
                for (int m = 0; m < 4; ++m)
#pragma unroll
                    for (int n = 0; n < 2; ++n) acc[a][b][m][n] = (f32x4){0.f, 0.f, 0.f, 0.f};
        cur = nxt; cA = nA; cB = nB; ++ui;
        if constexpr (ALIGN_EPI) { if (wr == 1) PG8_BAR; }
    }
    PG8_WAIT_V(0);
    if constexpr (!ALIGN_EPI) { if (wr == 0) PG8_BAR; }
    PG8_BAR;
#undef PG8_SA
#undef PG8_SB
#undef PG8_STAGE
#undef PG8_LDA
#undef PG8_LDB
#undef PG8_MMA
#undef PG8_WAIT_V
#undef PG8_WAIT_L
#undef PG8_BAR
#undef PG8_SCHED
}
}

constexpr int BATCH = 2, SEQ = 4096, DM = 2048, M = BATCH * SEQ;
constexpr int NH = 16, DQK = 192, DNOPE = 128, DROPE = 64, DV = 128, QLORA = 512, KVLORA = 512;
constexpr int POOLW = 1024, DIN = 6208, DIN_PAD = 6400, DFF = 5632;
constexpr float EPS = 1e-6f;
constexpr int NWAVES = 8;

typedef unsigned short bf16;
typedef unsigned v4u __attribute__((ext_vector_type(4)));
typedef unsigned v2u __attribute__((ext_vector_type(2)));
typedef float f32x4 __attribute__((ext_vector_type(4)));
typedef short bf16x8 __attribute__((ext_vector_type(8)));
typedef short s16x4 __attribute__((ext_vector_type(4)));
typedef float f32x16 __attribute__((ext_vector_type(16)));
#define LAS __attribute__((address_space(3)))
#define LDS_WAIT() asm volatile("s_waitcnt lgkmcnt(0)" ::: "memory")

constexpr size_t MiB = 1u << 20;
constexpr size_t WS_WAO = 1 * MiB, WS_WOUT = 9 * MiB, WS_WPO = 17 * MiB, WS_WQB = 21 * MiB, WS_WKVB = 24 * MiB, WS_WPG = 28 * MiB, WS_KR = 29 * MiB;
constexpr size_t WS_G = 31 * MiB;
constexpr size_t WS_WIN = 95 * MiB, WS_XN = 120 * MiB, WS_C1 = 152 * MiB, WS_U = 184 * MiB;
constexpr size_t WS_Q = 95 * MiB, WS_K = 143 * MiB, WS_V = 191 * MiB, WS_CN = 223 * MiB, WS_POOLED = 239 * MiB, WS_PG = 255 * MiB;
constexpr size_t WS_MP = 223 * MiB, WS_O = 255 * MiB, WS_MIXED = 95 * MiB, WS_X1 = 127 * MiB, WS_H2 = 95 * MiB;
constexpr size_t WS_WGU = 191 * MiB, WS_WDN = 235 * MiB, WS_ACT = 1 * MiB;
constexpr size_t WS_END = 296 * MiB, WS_BAR = 512 * 1024, WS_KRP = 272 * MiB, WS_X1B = 257 * MiB;
constexpr int SV_BGATE = 0, SV_QAG = 4096, SV_KVAG = 4608, SV_QNG = 5120, SV_KNG = 5376, SV_PSC = 5632, SV_FNG = 6656, SV_POS = 8704, SV_END = 8704 + 8192, SV_SS = 32768;

constexpr int LDS_BYTES = 147456;

__device__ __forceinline__ unsigned cvtpk(float lo, float hi) { return pg8::cvt_pk_bf16(lo, hi); }
__device__ __forceinline__ float bflo(unsigned w) { return __uint_as_float(w << 16); }
__device__ __forceinline__ float bfhi(unsigned w) { return __uint_as_float(w & 0xffff0000u); }
__device__ __forceinline__ float wave_sum(float v) {
#pragma unroll
    for (int o = 1; o < 64; o <<= 1) v += __shfl_xor(v, o);
    return v;
}

__device__ __forceinline__ int dst_row(int mode, int n0) {
    if (mode == 1) { if (n0 < 1024) return n0; if (n0 < 1088) return 6144 + (n0 - 1024); if (n0 < 2112) return 1024 + (n0 - 1088); return 2048 + (n0 - 2112); }
    if (mode == 2) return (n0 >> 7) * 256 + (n0 & 127);
    if (mode == 3) return (n0 >> 7) * 256 + 128 + (n0 & 127);
    return n0;
}
__device__ __forceinline__ void transpose_item(const float* W, int K, int N, bf16* WT, int mode, int row_off, LAS float* scr, int item, int lane, const float* gk = nullptr) {
    const int nblk = N / 32, kb = item / nblk, nb = item % nblk, k0 = 64 * kb, n0 = 32 * nb;
    { float tv[32]; const float* wp = W + (size_t)(k0 + (lane >> 5)) * N + n0 + (lane & 31);
#pragma unroll
      for (int i = 0; i < 32; ++i) tv[i] = wp[(size_t)(2 * i) * N];
      if (gk) {
#pragma unroll
          for (int i = 0; i < 32; ++i) tv[i] *= gk[k0 + 2 * i + (lane >> 5)]; }
#pragma unroll
      for (int i = 0; i < 32; ++i) scr[(2 * i + (lane >> 5)) * 33 + (lane & 31)] = tv[i]; }
    LDS_WAIT(); asm volatile("" ::: "memory");
    const int c = lane & 7, dr = row_off + dst_row(mode, n0);
#pragma unroll
    for (int j = 0; j < 4; ++j) { const int n = (lane >> 3) + 8 * j; const LAS float* s = scr + (8 * c) * 33 + n;
        v4u o; o.x = cvtpk(s[0 * 33], s[1 * 33]); o.y = cvtpk(s[2 * 33], s[3 * 33]); o.z = cvtpk(s[4 * 33], s[5 * 33]); o.w = cvtpk(s[6 * 33], s[7 * 33]);
        *(v4u*)(WT + (size_t)(dr + n) * K + k0 + 8 * c) = o; }
    LDS_WAIT(); asm volatile("" ::: "memory");
}

struct TrDesc { const float* W; bf16* WT; const float* gk; int K, N, k0, n0, dr; };
__device__ __forceinline__ TrDesc tr_desc(const float* W, int K, int N, bf16* WT, int mode, int row_off, int item, const float* gk) {
    const int nblk = N / 32, kb = item / nblk, nb = item % nblk; TrDesc d; d.W = W; d.WT = WT; d.gk = gk; d.K = K; d.N = N; d.k0 = 64 * kb; d.n0 = 32 * nb; d.dr = row_off + dst_row(mode, d.n0); return d; }
__device__ __forceinline__ void tr_load(const TrDesc& d, float (&tv)[32], int lane) {
    const float* wp = d.W + (size_t)(d.k0 + (lane >> 5)) * d.N + d.n0 + (lane & 31);
#pragma unroll
    for (int i = 0; i < 32; ++i) tv[i] = wp[(size_t)(2 * i) * d.N];
}
__device__ __forceinline__ void tr_finish(const TrDesc& d, float (&tv)[32], LAS float* scr, int lane) {
    if (d.gk) {
#pragma unroll
        for (int i = 0; i < 32; ++i) tv[i] *= d.gk[d.k0 + 2 * i + (lane >> 5)]; }
#pragma unroll
    for (int i = 0; i < 32; ++i) scr[(2 * i + (lane >> 5)) * 33 + (lane & 31)] = tv[i];
    LDS_WAIT(); asm volatile("" ::: "memory");
    const int c = lane & 7;
#pragma unroll
    for (int j = 0; j < 4; ++j) { const int n = (lane >> 3) + 8 * j; const LAS float* s_ = scr + (8 * c) * 33 + n;
        v4u o; o.x = cvtpk(s_[0 * 33], s_[1 * 33]); o.y = cvtpk(s_[2 * 33], s_[3 * 33]); o.z = cvtpk(s_[4 * 33], s_[5 * 33]); o.w = cvtpk(s_[6 * 33], s_[7 * 33]);
        *(v4u*)(d.WT + (size_t)(d.dr + n) * d.K + d.k0 + 8 * c) = o; }
    LDS_WAIT(); asm volatile("" ::: "memory");
}
#define TR_PIPELINE(FIRST, LIMIT, STRIDE, MAKE_DESC) do { int it_ = (FIRST); if (it_ < (LIMIT)) { TrDesc dA_ = MAKE_DESC(it_); float tvA_[32]; tr_load(dA_, tvA_, lane); \
        for (;;) { const int nx_ = it_ + (STRIDE); const bool more_ = nx_ < (LIMIT); TrDesc dB_ = dA_; float tvB_[32]; \
            if (more_) { dB_ = MAKE_DESC(nx_); tr_load(dB_, tvB_, lane); } \
            tr_finish(dA_, tvA_, scr, lane); if (!more_) break; \
            dA_ = dB_; _Pragma("unroll") for (int i_ = 0; i_ < 32; ++i_) tvA_[i_] = tvB_[i_]; it_ = nx_; } } } while (0)

__device__ __forceinline__ void rms_row_2048(const float* xrow, const float* g, bf16* orow, int lane) {
    const f32x4* xr = (const f32x4*)xrow + lane; const f32x4* gr = (const f32x4*)g + lane;
    f32x4 v[8]; float s = 0.f;
#pragma unroll
    for (int j = 0; j < 8; ++j) { v[j] = xr[64 * j]; s += (v[j].x * v[j].x + v[j].y * v[j].y) + (v[j].z * v[j].z + v[j].w * v[j].w); }
    const float inv = 1.0f / sqrtf(wave_sum(s) * (1.f / 2048.f) + EPS);
    v2u* o8 = (v2u*)orow + lane;
#pragma unroll
    for (int j = 0; j < 8; ++j) { const f32x4 gv = gr[64 * j]; v2u o; o.x = cvtpk(v[j].x * inv * gv.x, v[j].y * inv * gv.y); o.y = cvtpk(v[j].z * inv * gv.z, v[j].w * inv * gv.w); o8[64 * j] = o; }
}

namespace att {
constexpr int QBLK = 32, KVBLK = 64, QB = 256;
constexpr int SHM_V = KVBLK * DV * 2, SHM_K = KVBLK * DQK * 2;
constexpr int OFF_V = 0, OFF_K = 3 * SHM_V, OFF_WS = OFF_K + 2 * SHM_K;
constexpr float SCALE = 0.07216878364870322f;
constexpr float THR = 8.f;
#define KSWZ(row, colB) ((row) * 384 + ((colB) ^ (((row) & 7) << 4)))
#define SBAR() __builtin_amdgcn_sched_barrier(0)
__device__ __forceinline__ int v_st(int k, int c) { const int kk = (k & ~0xC) | ((k & 4) << 1) | ((k & 8) >> 1); return ((kk >> 3) * 4 + (c >> 5)) * 512 + ((kk & 7) * 32 + (c & 31)) * 2; }
__device__ __forceinline__ int v_rd_base(int lane) { return ((lane & 3) << 3) | (((lane >> 2) & 3) << 6) | (((lane >> 4) & 1) << 5) | (((lane >> 5) & 1) << 8); }
__device__ __forceinline__ int crow(int r, int hi) { return (r & 3) + 8 * (r >> 2) + 4 * hi; }
__device__ __forceinline__ void mask_tile(f32x16& p0, f32x16& p1, int dq) {
    const float NEG = -__builtin_inff();
#pragma unroll
    for (int r = 0; r < 16; ++r) {
        const int c = (r & 3) + 8 * (r >> 2);
        if (dq - c < 0) p0[r] = NEG;
        if (dq - c - 32 < 0) p1[r] = NEG;
    }
}
__device__ __forceinline__ void partialSM(f32x16& p0, f32x16& p1, float& m_reg, float& mn, float& alpha) {
    float pmax = p0[0];
#pragma unroll
    for (int r = 1; r < 16; ++r) pmax = fmaxf(pmax, p0[r]);
#pragma unroll
    for (int r = 0; r < 16; ++r) pmax = fmaxf(pmax, p1[r]);
    { auto rr = __builtin_amdgcn_permlane32_swap(__float_as_uint(pmax), __float_as_uint(pmax), false, false);
      pmax = fmaxf(__uint_as_float(rr[0]), __uint_as_float(rr[1])); }
    constexpr float C2 = 1.4426950408889634f * SCALE;
    if (__builtin_expect(__all((pmax - m_reg) * SCALE <= THR), 1)) { mn = m_reg; alpha = 1.f; }
    else { mn = fmaxf(m_reg, pmax); alpha = __builtin_amdgcn_exp2f((m_reg - mn) * C2); m_reg = mn; }
    const float mnL = -mn * C2;
#pragma unroll
    for (int r = 0; r < 16; ++r) p0[r] = fmaf(p0[r], C2, mnL);
#pragma unroll
    for (int r = 0; r < 16; ++r) p1[r] = fmaf(p1[r], C2, mnL);
#pragma unroll
    for (int r = 0; r < 16; ++r) p0[r] = __builtin_amdgcn_exp2f(p0[r]);
}
__device__ __forceinline__ void finishSM(f32x16& p0, f32x16& p1, float alpha, float& l_reg, bf16x8& pa0, bf16x8& pa1, bf16x8& pa2, bf16x8& pa3) {
#pragma unroll
    for (int r = 0; r < 16; ++r) p1[r] = __builtin_amdgcn_exp2f(p1[r]);
    float ps = 0;
#pragma unroll
    for (int r = 0; r < 16; ++r) ps += p0[r];
#pragma unroll
    for (int r = 0; r < 16; ++r) ps += p1[r];
    { auto rr = __builtin_amdgcn_permlane32_swap(__float_as_uint(ps), __float_as_uint(ps), false, false);
      ps = __uint_as_float(rr[0]) + __uint_as_float(rr[1]); }
    l_reg = l_reg * alpha + ps;
#define PK4(P, B_, OUT) do { unsigned a0 = cvtpk(P[B_+0], P[B_+1]), a1 = cvtpk(P[B_+2], P[B_+3]);                          \
        unsigned b0 = cvtpk(P[B_+4], P[B_+5]), b1 = cvtpk(P[B_+6], P[B_+7]);                                             \
        auto r0 = __builtin_amdgcn_permlane32_swap(a0, b0, false, false); auto r1 = __builtin_amdgcn_permlane32_swap(a1, b1, false, false); \
        v4u w = {r0[0], r1[0], r0[1], r1[1]}; OUT = *reinterpret_cast<bf16x8*>(&w); } while (0)
    PK4(p0, 0, pa0); PK4(p0, 8, pa1); PK4(p1, 0, pa2); PK4(p1, 8, pa3);
#undef PK4
}
__device__ __forceinline__ void qkt(f32x16& p0, f32x16& p1, const char* Kb, int r32, int hi, const bf16x8* qr) {
    p0 = f32x16{}; p1 = f32x16{};
    const char* kb[4];
#pragma unroll
    for (int dd = 0; dd < 4; ++dd) kb[dd] = Kb + KSWZ(r32, (dd * 16 + hi * 8) * 2);
#pragma unroll
    for (int g = 0; g < 2; ++g) { bf16x8 b0[6], b1[6];
#pragma unroll
        for (int i = 0; i < 6; ++i) { const int d0 = 6 * g + i; const char* a = kb[d0 & 3] + (d0 >> 2) * 128; b0[i] = *reinterpret_cast<const bf16x8*>(a); b1[i] = *reinterpret_cast<const bf16x8*>(a + 32 * 384); }
        SBAR();
        __builtin_amdgcn_s_setprio(1);
#pragma unroll
        for (int i = 0; i < 6; ++i) { p0 = __builtin_amdgcn_mfma_f32_32x32x16_bf16(b0[i], qr[6 * g + i], p0, 0, 0, 0); p1 = __builtin_amdgcn_mfma_f32_32x32x16_bf16(b1[i], qr[6 * g + i], p1, 0, 0, 0); }
        __builtin_amdgcn_s_setprio(0);
        SBAR(); }
}
__device__ __forceinline__ void pv_tile(f32x16* o, int vb0, bf16x8 pa0, bf16x8 pa1, bf16x8 pa2, bf16x8 pa3) {
#define TRRD(dst, off) asm volatile("ds_read_b64_tr_b16 %0, %1 offset:%2" : "=&v"(dst) : "v"(vb0), "i"(off) : "memory")
#define PV_RD(S, d0) do { constexpr int b_ = (d0) * 512; TRRD(S##l0, b_); TRRD(S##h0, b_ + 2048); TRRD(S##l1, b_ + 4096); TRRD(S##h1, b_ + 6144); TRRD(S##l2, b_ + 8192); TRRD(S##h2, b_ + 10240); TRRD(S##l3, b_ + 12288); TRRD(S##h3, b_ + 14336); } while (0)
#define PV_MM(S, d0) do { \
        o[d0] = __builtin_amdgcn_mfma_f32_32x32x16_bf16(pa0, (bf16x8){S##l0[0], S##l0[1], S##l0[2], S##l0[3], S##h0[0], S##h0[1], S##h0[2], S##h0[3]}, o[d0], 0, 0, 0);   \
        o[d0] = __builtin_amdgcn_mfma_f32_32x32x16_bf16(pa1, (bf16x8){S##l1[0], S##l1[1], S##l1[2], S##l1[3], S##h1[0], S##h1[1], S##h1[2], S##h1[3]}, o[d0], 0, 0, 0);   \
        o[d0] = __builtin_amdgcn_mfma_f32_32x32x16_bf16(pa2, (bf16x8){S##l2[0], S##l2[1], S##l2[2], S##l2[3], S##h2[0], S##h2[1], S##h2[2], S##h2[3]}, o[d0], 0, 0, 0);   \
        o[d0] = __builtin_amdgcn_mfma_f32_32x32x16_bf16(pa3, (bf16x8){S##l3[0], S##l3[1], S##l3[2], S##l3[3], S##h3[0], S##h3[1], S##h3[2], S##h3[3]}, o[d0], 0, 0, 0); } while (0)
    s16x4 Al0, Al1, Al2, Al3, Ah0, Ah1, Ah2, Ah3, Bl0, Bl1, Bl2, Bl3, Bh0, Bh1, Bh2, Bh3;
    PV_RD(A, 0); PV_RD(B, 1);
    asm volatile("s_waitcnt lgkmcnt(8)" ::: "memory"); SBAR(); PV_MM(A, 0); SBAR();
    PV_RD(A, 2);
    asm volatile("s_waitcnt lgkmcnt(8)" ::: "memory"); SBAR(); PV_MM(B, 1); SBAR();
    PV_RD(B, 3);
    asm volatile("s_waitcnt lgkmcnt(8)" ::: "memory"); SBAR(); PV_MM(A, 2); SBAR();
    asm volatile("s_waitcnt lgkmcnt(0)" ::: "memory"); SBAR(); PV_MM(B, 3);
#undef PV_MM
#undef PV_RD
#undef TRRD
}
__device__ __forceinline__ void attn_unit(int b, int h, int qb, const bf16* Q, const bf16* K, const bf16* V, bf16* O, char* lds) {
    const int tid = threadIdx.x, wid = __builtin_amdgcn_readfirstlane(tid >> 6), lane = tid & 63, r32 = lane & 31, hi = lane >> 5;
    const size_t rowb = (size_t)b * SEQ;
    const int q0 = qb * QB, qlo = q0 + wid * QBLK;
    const int NT = (q0 + QB) / KVBLK;
    char* V_lds = lds + OFF_V; char* K_lds = lds + OFF_K;
#define WAVE_WS() ({ int t_ = (int)threadIdx.x; asm volatile("" : "+v"(t_)); (float*)(lds + OFF_WS) + (t_ >> 6) * 64; })
    LAS unsigned char* ldsl_ = (LAS unsigned char*)lds;
    unsigned ksrc[3], vsrc[2];
#pragma unroll
    for (int j = 0; j < 3; ++j) { const int s_ = (wid * 3 + j) * 64 + lane, row = s_ / 24, pc = s_ % 24; ksrc[j] = (unsigned)(row * 3072 * 2 + ((pc * 16) ^ ((row & 7) << 4))); }
#pragma unroll
    for (int j = 0; j < 2; ++j) { const int ob = ((wid * 2 + j) * 64 + lane) * 16, st = ob >> 9, kr_ = (ob >> 6) & 7, ch = (ob >> 4) & 3, c = (st & 3) * 32 + ch * 8, kk = (st >> 2) * 8 + kr_,
                                  k = (kk & ~0xC) | ((kk & 4) << 1) | ((kk & 8) >> 1); vsrc[j] = (unsigned)(k * 2048 * 2 + c * 2); }
    const char* Kh = (const char*)(K + rowb * 3072 + h * DQK); const char* Vh = (const char*)(V + rowb * 2048 + h * DV);
#define KDMA(k0, bf) do { _Pragma("unroll") for (int j = 0; j < 3; ++j) __builtin_amdgcn_global_load_lds((const unsigned*)(Kh + (size_t)(k0) * (3072 * 2) + ksrc[j]), \
        (LAS unsigned*)(ldsl_ + OFF_K + (bf) * SHM_K + (wid * 3 + j) * 1024), 16, 0, 0); } while (0)
#define VDMA(k0, sl) do { _Pragma("unroll") for (int j = 0; j < 2; ++j) __builtin_amdgcn_global_load_lds((const unsigned*)(Vh + (size_t)(k0) * (2048 * 2) + vsrc[j]), \
        (LAS unsigned*)(ldsl_ + OFF_V + (sl) * SHM_V + (wid * 2 + j) * 1024), 16, 0, 0); } while (0)
    KDMA(0, 0); VDMA(0, 0);
    bf16x8 qr[12];
    { const bf16* Qp = Q + (rowb + qlo + r32) * 3072 + h * DQK + hi * 8;
#pragma unroll
      for (int d0 = 0; d0 < 12; ++d0) qr[d0] = *(const bf16x8*)(Qp + d0 * 16); }
    asm volatile("s_waitcnt vmcnt(0)" ::: "memory");
    __syncthreads();
    float m_reg = -1e30f, l_reg = 0.f; f32x16 o[4] = {};
    const int vbase = (int)(uintptr_t)V_lds + v_rd_base(lane);
    const int qm = qlo + r32 - 4 * hi;
    f32x16 p0, p1;
#define SP_STAGE(VS) do { float mn, alpha; bf16x8 pa0, pa1, pa2, pa3; \
        partialSM(p0, p1, m_reg, mn, alpha); finishSM(p0, p1, alpha, l_reg, pa0, pa1, pa2, pa3); \
        if (__any(alpha < 1.f)) { float* al_l = WAVE_WS() + 32; if (hi == 0) al_l[r32] = alpha; asm volatile("s_waitcnt lgkmcnt(0)" ::: "memory"); \
            _Pragma("unroll") for (int d_ = 0; d_ < 4; ++d_) _Pragma("unroll") for (int r = 0; r < 16; ++r) o[d_][r] *= al_l[crow(r, hi)]; } \
        SBAR(); pv_tile(o, vbase + (VS) * SHM_V, pa0, pa1, pa2, pa3); } while (0)
    for (int t = 0; t < NT; ++t) {
        const int cur = t & 1, kb_ = t * KVBLK;
        if (t + 1 < NT) { KDMA((t + 1) * KVBLK, cur ^ 1); VDMA((t + 1) * KVBLK, cur ^ 1); }
        SBAR();
        qkt(p0, p1, K_lds + cur * SHM_K, r32, hi, qr); if (kb_ + KVBLK - 1 > qlo) mask_tile(p0, p1, qm - kb_);
        SBAR();
        SP_STAGE(cur);
        asm volatile("s_waitcnt vmcnt(0)" ::: "memory");
        __syncthreads();
    }
#undef SP_STAGE
    float* li_l = WAVE_WS();
    if (hi == 0) li_l[r32] = l_reg; asm volatile("s_waitcnt lgkmcnt(0)" ::: "memory");
    float rli[16];
#pragma unroll
    for (int r = 0; r < 16; ++r) rli[r] = __builtin_amdgcn_rcpf(li_l[crow(r, hi)]);
    bf16* Ow = O + (rowb + qlo) * 2048 + h * DV;
#pragma unroll
    for (int r = 0; r < 16; ++r) { const int orow = crow(r, hi);
#pragma unroll
        for (int d0 = 0; d0 < 4; ++d0) { const float v = o[d0][r] * rli[r];
            const float vn = __shfl_xor(v, 1);
            if ((r32 & 1) == 0) *(unsigned*)(Ow + (size_t)orow * 2048 + d0 * 32 + r32) = cvtpk(v, vn); } }
    __syncthreads();
#undef KDMA
#undef VDMA
#undef WAVE_WS
}
#undef SBAR
}

struct Args { const float* in[20]; float* out; unsigned char* ws; int ph_lo, ph_hi, coop, pad; };
#define XB_TMO      128
#define XB_XCNT(j)  (256  + 64 * (j))
#define XB_XSUB(j)  (1280 + 64 * (j))
#define XB_XGEN(j)  (2304 + 64 * (j))
#define XB_TOP      3328
#define XB_TOPGEN   3392
#define XCD_BAR_WORDS 3456
#define XB_SPIN_CAP (1u << 20)
__device__ __forceinline__ unsigned xb_ld(unsigned* p)              { return __hip_atomic_load(p, __ATOMIC_RELAXED, __HIP_MEMORY_SCOPE_AGENT); }
__device__ __forceinline__ unsigned xb_add(unsigned* p, unsigned v) { return __hip_atomic_fetch_add(p, v, __ATOMIC_RELAXED, __HIP_MEMORY_SCOPE_AGENT); }
__device__ __forceinline__ unsigned xb_xcc_id() { return (unsigned)__builtin_amdgcn_s_getreg((3 << 11) | 20) & 0xFu; }
#define XB_SPIN(cond, bar) do { unsigned _sp = 0; while (cond) { __builtin_amdgcn_s_sleep(1); \
    if ((++_sp & 255u) == 0u) { if (xb_ld(&(bar)[XB_TMO])) break; if (_sp > XB_SPIN_CAP) { atomicAdd(&(bar)[XB_TMO], 1u); break; } } } } while (0)
__device__ __forceinline__ void xcd_barrier_complete(unsigned* bar, unsigned x, unsigned& nloc, unsigned& nx) {
    const unsigned G = gridDim.x;
    unsigned sum, cnt, mine, sp = 0u;
    for (;;) {
        sum = 0u; cnt = 0u; mine = 0u;
#pragma unroll
        for (unsigned j = 0; j < 16; ++j) { const unsigned c = xb_ld(&bar[XB_XCNT(j)]); sum += c; cnt += (c > 0u) ? 1u : 0u; mine = (j == x) ? c : mine; }
        if (sum == G) break;
        __builtin_amdgcn_s_sleep(1);
        if ((++sp & 255u) == 0u) { if (xb_ld(&bar[XB_TMO])) break; if (sp > XB_SPIN_CAP) { atomicAdd(&bar[XB_TMO], 1u); break; } }
    }
    nloc = mine > 0u ? mine : 1u; nx = cnt > 0u ? cnt : 1u;
}
__device__ __forceinline__ void grid_bar(unsigned* bar, volatile LAS unsigned* st) {
    asm volatile("s_waitcnt vmcnt(0)" ::: "memory");
    __syncthreads();
    if (threadIdx.x == 0) {
        const unsigned x = xb_xcc_id();
        __builtin_amdgcn_s_waitcnt(0);
        unsigned nloc = st[0], nx = st[1];
        if (nloc == 0u) { xcd_barrier_complete(bar, x, nloc, nx); st[0] = nloc; st[1] = nx; }
        const unsigned old = xb_add(&bar[XB_XSUB(x)], 1u);
        const unsigned gen = old / nloc;
        if (old + 1u == (gen + 1u) * nloc) {
            __builtin_amdgcn_fence(__ATOMIC_RELEASE, "agent");
            asm volatile("s_waitcnt vmcnt(0)" ::: "memory");
            const unsigned og = xb_add(&bar[XB_TOP], 1u);
            const unsigned tg = og / nx;
            if (og + 1u == (tg + 1u) * nx) xb_add(&bar[XB_TOPGEN], 1u);
            else XB_SPIN(xb_ld(&bar[XB_TOPGEN]) == tg, bar);
            __builtin_amdgcn_fence(__ATOMIC_ACQUIRE, "agent");
            xb_add(&bar[XB_XGEN(x)], 1u);
            asm volatile("s_waitcnt vmcnt(0)" ::: "memory");
        } else {
            XB_SPIN(xb_ld(&bar[XB_XGEN(x)]) == gen, bar);
            __builtin_amdgcn_fence(__ATOMIC_ACQUIRE, "agent");
            asm volatile("s_waitcnt vmcnt(0)" ::: "memory");
        }
    }
    __syncthreads();
}
constexpr int NPH = 11;

__global__ void __launch_bounds__(NWAVES * 64, 2) mega_fwd(Args args) {
    extern __shared__ __attribute__((aligned(16))) unsigned char lds[];
    LAS unsigned char* ldsl = (LAS unsigned char*)lds;
    const int tid = threadIdx.x, lane = tid & 63, wave = __builtin_amdgcn_readfirstlane(tid >> 6);
    const int G = gridDim.x, bx = blockIdx.x;
    const int vcu = (G % 8 == 0) ? (bx % 8) * (G / 8) + bx / 8 : bx;
    const int gw = vcu * NWAVES + wave, NGW = G * NWAVES;
    unsigned char* ws = args.ws;
    const float* const* kin = (const float* const*)__builtin_amdgcn_kernarg_segment_ptr();
    const float* svec = (const float*)ws;
    const float* b_gate = svec + SV_BGATE; const float* q_a_norm_g = svec + SV_QAG; const float* kv_a_norm_g = svec + SV_KVAG; const float* q_norm_g = svec + SV_QNG;
    const float* k_norm_g = svec + SV_KNG; const float* pool_scale = svec + SV_PSC; const float* ffn_norm_g = svec + SV_FNG; const int* positions = (const int*)(svec + SV_POS);
    bf16* WIN_T = (bf16*)(ws + WS_WIN); bf16* WQB_T = (bf16*)(ws + WS_WQB); bf16* WKVB_T = (bf16*)(ws + WS_WKVB); bf16* WPG_T = (bf16*)(ws + WS_WPG);
    bf16* WPO_T = (bf16*)(ws + WS_WPO); bf16* WAO_T = (bf16*)(ws + WS_WAO); bf16* WOUT_T = (bf16*)(ws + WS_WOUT); bf16* WGU_T = (bf16*)(ws + WS_WGU); bf16* WDN_T = (bf16*)(ws + WS_WDN);
    bf16* XN = (bf16*)(ws + WS_XN); float* C1 = (float*)(ws + WS_C1); float* KRP = (float*)(ws + WS_KRP); bf16* U = (bf16*)(ws + WS_U); bf16* Gt = (bf16*)(ws + WS_G);
    bf16* CN = (bf16*)(ws + WS_CN); bf16* POOLED = (bf16*)(ws + WS_POOLED); bf16* Qb = (bf16*)(ws + WS_Q); bf16* Kb = (bf16*)(ws + WS_K); bf16* Vb = (bf16*)(ws + WS_V);
    bf16* PG = (bf16*)(ws + WS_PG); bf16* MP = (bf16*)(ws + WS_MP); bf16* Ob = (bf16*)(ws + WS_O); bf16* MIXED = (bf16*)(ws + WS_MIXED);
    float* X1 = (float*)(ws + WS_X1); bf16* H2 = (bf16*)(ws + WS_H2); bf16* ACT = (bf16*)(ws + WS_ACT);

    const int lo = args.ph_lo, hi_ph = args.ph_hi;
#ifndef PHMASK
#define PHMASK 0x7ff
#endif
#define IN(k) (((PHMASK >> (k)) & 1) && lo <= (k) && (k) < hi_ph)
#define SEAM(k) do { if (IN(k) && IN((k) + 1)) { unsigned char* w2_ = args.ws; asm volatile("" : "+s"(w2_)); grid_bar((unsigned*)(w2_ + WS_BAR), (volatile LAS unsigned*)(ldsl + 140032)); } } while (0)
    if (args.coop > 1) cg::this_grid().sync();
    if (threadIdx.x < 2) ((volatile LAS unsigned*)(ldsl + 140032))[threadIdx.x] = 0u;
    __syncthreads();
    if (args.coop && threadIdx.x == 0) { unsigned char* w2_ = args.ws; asm volatile("" : "+s"(w2_)); (void)xb_add(&((unsigned*)(w2_ + WS_BAR))[XB_XCNT(xb_xcc_id())], 1u); }
    LAS float* scr = (LAS float*)(ldsl + wave * 16384);
#ifdef TPROBE
#define TP_BEGIN(k) do { if ((TPROBE >> (k)) & 1) { if (blockIdx.x == 0 && threadIdx.x == 0) { *(volatile LAS unsigned*)(ldsl + 140000) = (unsigned)__builtin_amdgcn_s_memrealtime(); } } } while (0)
#define TP_END(k) do { if ((TPROBE >> (k)) & 1) { if (blockIdx.x == 0 && threadIdx.x == 0) { volatile LAS unsigned* tp_ = (volatile LAS unsigned*)(ldsl + 140000); tp_[1] += (unsigned)__builtin_amdgcn_s_memrealtime() - tp_[0]; } } } while (0)
    if (blockIdx.x == 0 && threadIdx.x == 0) { ((volatile LAS unsigned*)(ldsl + 140000))[1] = 0u; }
#else
#define TP_BEGIN(k) do {} while (0)
#define TP_END(k) do {} while (0)
#endif

    if (IN(0)) { TP_BEGIN(0);
        { float* sv = (float*)ws; const int gt = bx * (NWAVES * 64) + tid, GT = G * NWAVES * 64;
          for (int i = gt; i < M; i += GT) sv[SV_SS + i] = 0.f;
          for (int i = gt; i < SV_END; i += GT) { int idx, off, lim = 1 << 30;
              if (i < SV_QAG) { idx = 4; off = SV_BGATE; } else if (i < SV_KVAG) { idx = 5; off = SV_QAG; } else if (i < SV_QNG) { idx = 7; off = SV_KVAG; }
              else if (i < SV_KNG) { idx = 9; off = SV_QNG; lim = 192; } else if (i < SV_PSC) { idx = 10; off = SV_KNG; lim = 192; }
              else if (i < SV_FNG) { idx = 13; off = SV_PSC; } else if (i < SV_POS) { idx = 16; off = SV_FNG; } else { idx = 1; off = SV_POS; }
              const float* src = kin[idx]; sv[i] = (i - off < lim) ? src[i - off] : 0.f; } }
        constexpr int I_IN = (DM / 64) * (DIN / 32), I_QB = (QLORA / 64) * (NH * DQK / 32), I_KVB = (KVLORA / 64) * (NH * 256 / 32), I_PG = (256 / 64) * (256 / 32),
                      I_PO = (POOLW / 64) * (DM / 32), I_AO = (DM / 64) * (DM / 32), I_OUT = I_AO;
        constexpr int NITEMS = I_IN + I_QB + I_KVB + 4 * I_PG + I_PO + I_AO + I_OUT;
#define P0_DESC(it__) ([&]() { int r = (it__), idx, Kd, Nd, mode = 0, roff = 0; size_t dsto, srco = 0; \
            if (r < I_IN) { idx = 3; Kd = DM; Nd = DIN; mode = 1; dsto = WS_WIN; } \
            else if ((r -= I_IN) < I_QB) { idx = 6; Kd = QLORA; Nd = NH * DQK; dsto = WS_WQB; } \
            else if ((r -= I_QB) < I_KVB) { idx = 8; Kd = KVLORA; Nd = NH * 256; dsto = WS_WKVB; } \
            else if ((r -= I_KVB) < 4 * I_PG) { const int g = r / I_PG; r = r % I_PG; idx = 12; Kd = 256; Nd = 256; dsto = WS_WPG; roff = g * 256; srco = (size_t)g * 65536; } \
            else if ((r -= 4 * I_PG) < I_PO) { idx = 14; Kd = POOLW; Nd = DM; dsto = WS_WPO; } \
            else if ((r -= I_PO) < I_AO) { idx = 11; Kd = DM; Nd = DM; dsto = WS_WAO; } \
            else { r -= I_AO; idx = 15; Kd = DM; Nd = DM; dsto = WS_WOUT; } \
            return tr_desc(kin[idx] + srco, Kd, Nd, (bf16*)(ws + dsto), mode, roff, r, nullptr); }())
        TR_PIPELINE(gw, NITEMS, NGW, P0_DESC);
#undef P0_DESC
        { v4u* z = (v4u*)(WIN_T + (size_t)DIN * DM); const int nz = (DIN_PAD - DIN) * DM / 8;
          for (int i = gw * 64 + lane; i < nz; i += NGW * 64) z[i] = (v4u){0u, 0u, 0u, 0u}; }
        { const float* x = kin[0]; const float* attn_norm_g = kin[2];
          for (int m = gw; m < M; m += NGW) rms_row_2048(x + (size_t)m * DM, attn_norm_g, XN + (size_t)m * DM, lane); }
    TP_END(0); }
    SEAM(0);
    if (IN(1)) { TP_BEGIN(1);
        { pg8::Gemm g{XN, WIN_T, M, 6144, DM, DM, DM, 0, 0}; pg8::StaticOrder S; S.init(M, 6144, G, bx);
          pg8::EpiIn E{C1, U, Gt, b_gate};
          pg8::gemm_phase<pg8::EpiIn, pg8::StaticOrder>(ldsl, g, S, E); }
        { pg8::Gemm g{XN, WIN_T + (size_t)6144 * DM, M, 2048, 256, DM, DM, 256, 256}; pg8::StaticOrder S; S.init(M, 2048, G, bx);
          pg8::EpiKRP E{KRP};
          pg8::gemm_phase<pg8::EpiKRP, pg8::StaticOrder>(ldsl, g, S, E); }
    TP_END(1); }
    SEAM(1);
    if (IN(2)) { TP_BEGIN(2);
        for (int m = gw; m < M; m += NGW) {
            const f32x4* c = (const f32x4*)(C1 + (size_t)m * 1024) + lane; f32x4 v[4]; float sq = 0.f, skv = 0.f;
#pragma unroll
            for (int j = 0; j < 4; ++j) { v[j] = c[64 * j]; const float s = (v[j].x * v[j].x + v[j].y * v[j].y) + (v[j].z * v[j].z + v[j].w * v[j].w); if (j < 2) sq += s; else skv += s; }
            const float iq = 1.0f / sqrtf(wave_sum(sq) * (1.f / 512.f) + EPS), ikv = 1.0f / sqrtf(wave_sum(skv) * (1.f / 512.f) + EPS);
            v2u* o8 = (v2u*)(CN + (size_t)m * 1024) + lane;
#pragma unroll
            for (int j = 0; j < 4; ++j) { const f32x4 gv = (j < 2) ? ((const f32x4*)q_a_norm_g)[lane + 64 * j] : ((const f32x4*)kv_a_norm_g)[lane + 64 * (j - 2)]; const float iv = (j < 2) ? iq : ikv;
                v2u o; o.x = cvtpk(v[j].x * iv * gv.x, v[j].y * iv * gv.y); o.y = cvtpk(v[j].z * iv * gv.z, v[j].w * iv * gv.w); o8[64 * j] = o; }
        }
        for (int m = gw; m < M; m += NGW) {
            const int s = m & (SEQ - 1);
#pragma unroll
            for (int jj = 0; jj < 2; ++jj) {
                const int col = 8 * lane + 512 * jj, grp = col >> 8, w = 2 << grp; const int cnt = (s + 1 < w) ? s + 1 : w;
                float a[8]; float u0[8];
#pragma unroll
                for (int e = 0; e < 8; ++e) a[e] = 0.f;
#pragma unroll
                for (int d = 0; d < 16; ++d) {
                    if (d < cnt) { const v4u q = *(const v4u*)(U + (size_t)(m - d) * 1024 + col);
                        const float f[8] = {bflo(q.x), bfhi(q.x), bflo(q.y), bfhi(q.y), bflo(q.z), bfhi(q.z), bflo(q.w), bfhi(q.w)};
#pragma unroll
                        for (int e = 0; e < 8; ++e) { a[e] += f[e]; if (d == 0) u0[e] = f[e]; } }
                }
                const float rc = 1.0f / (float)cnt;
                v4u o; o.x = cvtpk(a[0] * rc - u0[0], a[1] * rc - u0[1]); o.y = cvtpk(a[2] * rc - u0[2], a[3] * rc - u0[3]);
                o.z = cvtpk(a[4] * rc - u0[4], a[5] * rc - u0[5]); o.w = cvtpk(a[6] * rc - u0[6], a[7] * rc - u0[7]);
                *(v4u*)(POOLED + (size_t)m * 1024 + col) = o;
            }
        }
    TP_END(2); }
    SEAM(2);
    if (IN(3)) { TP_BEGIN(3);
        { pg8::Gemm g{CN, WQB_T, M, NH * DQK, QLORA, 1024, QLORA, 0, 0}; pg8::StaticOrder S; S.init(M, NH * DQK, G, bx);
          pg8::EpiBf16 E{Qb, 3072}; pg8::gemm_phase<pg8::EpiBf16, pg8::StaticOrder>(ldsl, g, S, E); }
        { pg8::Gemm g{CN + 512, WKVB_T, M, NH * 256, KVLORA, 1024, KVLORA, 0, 0}; pg8::StaticOrder S; S.init(M, NH * 256, G, bx);
          pg8::EpiKV E{Kb, Vb}; pg8::gemm_phase<pg8::EpiKV, pg8::StaticOrder>(ldsl, g, S, E); }
        { pg8::Gemm g{POOLED, WPG_T, M, POOLW, 256, 1024, 256, 256, 0}; pg8::StaticOrder S; S.init(M, POOLW, G, (bx + 128) % G);
          pg8::EpiScale E{PG, 1024, pool_scale}; pg8::gemm_phase<pg8::EpiScale, pg8::StaticOrder>(ldsl, g, S, E); }
    TP_END(3); }
    SEAM(3);
    if (IN(4)) { TP_BEGIN(4);
        for (int m = gw; m < M; m += NGW) {
            const float pos = (float)positions[m];
            const int sub = lane & 3, h = lane >> 2;
            float cs[8], sn[8];
#pragma unroll
            for (int j = 0; j < 8; ++j) { const int i = 8 * sub + j; const float invf = __builtin_amdgcn_exp2f(-(float)i * (13.287712379549449f / 32.f));
                const float ang = pos * invf; const float k = rintf(ang * 0.15915494309189535f);
                float r = fmaf(-k, 6.2831854820251465f, ang); r = fmaf(-k, -1.7484555e-7f, r);
                sn[j] = __sinf(r); cs[j] = __cosf(r); }
#pragma unroll
            for (int which = 0; which < 2; ++which) {
                bf16* base = (which == 0 ? Qb : Kb) + (size_t)m * 3072 + h * DQK;
                const float* gn = (which == 0) ? q_norm_g : k_norm_g;
                float nv[32], rl[8], rh[8]; float ss = 0.f;
#pragma unroll
                for (int jj = 0; jj < 4; ++jj) { const v4u q = *(const v4u*)(base + 32 * sub + 8 * jj);
                    nv[8 * jj + 0] = bflo(q.x); nv[8 * jj + 1] = bfhi(q.x); nv[8 * jj + 2] = bflo(q.y); nv[8 * jj + 3] = bfhi(q.y);
                    nv[8 * jj + 4] = bflo(q.z); nv[8 * jj + 5] = bfhi(q.z); nv[8 * jj + 6] = bflo(q.w); nv[8 * jj + 7] = bfhi(q.w); }
                if (which == 0) {
                    const v4u a = *(const v4u*)(base + 128 + 8 * sub), b = *(const v4u*)(base + 160 + 8 * sub);
                    rl[0] = bflo(a.x); rl[1] = bfhi(a.x); rl[2] = bflo(a.y); rl[3] = bfhi(a.y); rl[4] = bflo(a.z); rl[5] = bfhi(a.z); rl[6] = bflo(a.w); rl[7] = bfhi(a.w);
                    rh[0] = bflo(b.x); rh[1] = bfhi(b.x); rh[2] = bflo(b.y); rh[3] = bfhi(b.y); rh[4] = bflo(b.z); rh[5] = bfhi(b.z); rh[6] = bflo(b.w); rh[7] = bfhi(b.w);
                } else {
                    f32x4 a0 = {0.f, 0.f, 0.f, 0.f}, a1 = a0, b0 = a0, b1 = a0;
#pragma unroll
                    for (int ks = 0; ks < 8; ++ks) { const float* kp = KRP + ((size_t)ks * 8192 + m) * 64 + 8 * sub;
                        a0 += *(const f32x4*)kp; a1 += *(const f32x4*)(kp + 4); b0 += *(const f32x4*)(kp + 32); b1 += *(const f32x4*)(kp + 36); }
                    rl[0] = a0.x; rl[1] = a0.y; rl[2] = a0.z; rl[3] = a0.w; rl[4] = a1.x; rl[5] = a1.y; rl[6] = a1.z; rl[7] = a1.w;
                    rh[0] = b0.x; rh[1] = b0.y; rh[2] = b0.z; rh[3] = b0.w; rh[4] = b1.x; rh[5] = b1.y; rh[6] = b1.z; rh[7] = b1.w;
                }
#pragma unroll
                for (int e = 0; e < 32; ++e) ss += nv[e] * nv[e];
#pragma unroll
                for (int e = 0; e < 8; ++e) ss += rl[e] * rl[e] + rh[e] * rh[e];
                ss += __shfl_xor(ss, 1); ss += __shfl_xor(ss, 2);
                const float inv = 1.0f / sqrtf(ss * (1.f / 192.f) + EPS);
#pragma unroll
                for (int jj = 0; jj < 4; ++jj) { const f32x4 g0 = *(const f32x4*)(gn + 32 * sub + 8 * jj), g1 = *(const f32x4*)(gn + 32 * sub + 8 * jj + 4);
                    v4u o; o.x = cvtpk(nv[8 * jj + 0] * inv * g0.x, nv[8 * jj + 1] * inv * g0.y); o.y = cvtpk(nv[8 * jj + 2] * inv * g0.z, nv[8 * jj + 3] * inv * g0.w);
                    o.z = cvtpk(nv[8 * jj + 4] * inv * g1.x, nv[8 * jj + 5] * inv * g1.y); o.w = cvtpk(nv[8 * jj + 6] * inv * g1.z, nv[8 * jj + 7] * inv * g1.w);
                    *(v4u*)(base + 32 * sub + 8 * jj) = o; }
                float ol[8], oh[8];
#pragma unroll
                for (int e = 0; e < 8; ++e) { const float a = rl[e] * inv * gn[128 + 8 * sub + e], b = rh[e] * inv * gn[160 + 8 * sub + e];
                    ol[e] = a * cs[e] - b * sn[e]; oh[e] = b * cs[e] + a * sn[e]; }
                v4u o1, o2; o1.x = cvtpk(ol[0], ol[1]); o1.y = cvtpk(ol[2], ol[3]); o1.z = cvtpk(ol[4], ol[5]); o1.w = cvtpk(ol[6], ol[7]);
                o2.x = cvtpk(oh[0], oh[1]); o2.y = cvtpk(oh[2], oh[3]); o2.z = cvtpk(oh[4], oh[5]); o2.w = cvtpk(oh[6], oh[7]);
                *(v4u*)(base + 128 + 8 * sub) = o1; *(v4u*)(base + 160 + 8 * sub) = o2;
            }
        }
        { pg8::Gemm g{PG, WPO_T, M, DM, POOLW, POOLW, POOLW, 0, 0}; pg8::StaticOrder S; S.init(M, DM, G, bx);
          pg8::EpiGate<false> E{MP, Gt, nullptr, 0}; pg8::gemm_phase<pg8::EpiGate<false>, pg8::StaticOrder>(ldsl, g, S, E); }
    TP_END(4); }
    SEAM(4);
    if (IN(5)) { TP_BEGIN(5);
        const int npair = BATCH * NH * 8;
        for (int p = vcu; p < npair; p += G) {
            const int bh = p >> 3, s = p & 7;
            att::attn_unit(bh / NH, bh % NH, 15 - s, Qb, Kb, Vb, Ob, (char*)lds);
            att::attn_unit(bh / NH, bh % NH, s, Qb, Kb, Vb, Ob, (char*)lds);
        }
    TP_END(5); }
    SEAM(5);
    if (IN(6)) { TP_BEGIN(6);
        pg8::Gemm g{Ob, WAO_T, M, DM, DM, DM, DM, 0, 0}; pg8::StaticOrder S; S.init(M, DM, G, bx);
        pg8::EpiGate<true> E{MIXED, Gt, MP, 2048}; pg8::gemm_phase<pg8::EpiGate<true>, pg8::StaticOrder>(ldsl, g, S, E);
    TP_END(6); }
    SEAM(6);
    if (IN(7)) { TP_BEGIN(7);
        { constexpr int I_G = (DM / 64) * (DFF / 32);
#define GU_DESC(it__) ((it__) < I_G ? tr_desc(kin[17], DM, DFF, (bf16*)(ws + WS_WGU), 2, 0, (it__), ffn_norm_g) : tr_desc(kin[18], DM, DFF, (bf16*)(ws + WS_WGU), 3, 0, (it__) - I_G, ffn_norm_g))
          TR_PIPELINE(gw, 2 * I_G, NGW, GU_DESC);
#undef GU_DESC
          __syncthreads(); }
        pg8::Gemm g{MIXED, WOUT_T, M, DM, DM, DM, DM, 0, 0}; pg8::StaticOrder S; S.init(M, DM, G, bx);
        pg8::EpiResNorm E{kin[0], X1, (bf16*)(ws + WS_X1B), (float*)ws + SV_SS, DM}; pg8::gemm_phase<pg8::EpiResNorm, pg8::StaticOrder>(ldsl, g, S, E);
    TP_END(7); }
    SEAM(7);
    if (IN(9)) { TP_BEGIN(9);
        pg8::Gemm g{(bf16*)(ws + WS_X1B), WGU_T, M, 2 * DFF, DM, DM, DM, 0, 0}; pg8::StaticOrder S; S.init(M, 2 * DFF, G, bx);
        pg8::EpiSwiGLU E{ACT, DFF, (const float*)ws + SV_SS}; pg8::gemm_phase<pg8::EpiSwiGLU, pg8::StaticOrder>(ldsl, g, S, E);
        if (G == 256 ? (bx >= 128) : true) {
            constexpr int I_D2 = (DFF / 64) * (DM / 32);
            const int nw = (G == 256) ? 128 * NWAVES : NGW, w0 = (G == 256) ? (bx - 128) * NWAVES + wave : gw;
#define DN_DESC(it__) tr_desc(kin[19], DFF, DM, (bf16*)(ws + WS_WDN), 0, 0, (it__), nullptr)
            TR_PIPELINE(w0, I_D2, nw, DN_DESC);
#undef DN_DESC
        }
    TP_END(9); }
    SEAM(9);
    if (IN(10)) { TP_BEGIN(10);
        pg8::Gemm g{ACT, WDN_T, M, DM, DFF, DFF, DFF, 0, 0}; pg8::StaticOrder S; S.init(M, DM, G, bx);
        pg8::EpiRes E{X1, args.out, DM}; pg8::gemm_phase<pg8::EpiRes, pg8::StaticOrder>(ldsl, g, S, E);
    TP_END(10); }
#ifdef TPROBE
    if (blockIdx.x == 0 && threadIdx.x == 0) { const unsigned w_ = 4u * ((volatile LAS unsigned*)(ldsl + 140000))[1]; const unsigned long long t0_ = __builtin_amdgcn_s_memrealtime(); while ((unsigned)(__builtin_amdgcn_s_memrealtime() - t0_) < w_) __builtin_amdgcn_s_sleep(8); }
#endif
#undef IN
#undef SEAM
}

extern "C" void kernel_launch(void* const* d_in, const int* in_sizes, int n_in, void* d_out, int out_size, void* d_ws, size_t ws_size, hipStream_t stream) {
    static int grid = 0;
    if (grid == 0) {
        if (n_in != 20 || out_size != M * DM || ws_size < WS_END) { fprintf(stderr, "kernel_launch: unexpected shapes (n_in %d, out %d, ws %zu)\n", n_in, out_size, ws_size); grid = -1; return; }
        int dev = 0, cus = 0, per_cu = 0;
        (void)hipGetDevice(&dev); (void)hipDeviceGetAttribute(&cus, hipDeviceAttributeMultiprocessorCount, dev);
        if (hipFuncSetAttribute((const void*)mega_fwd, hipFuncAttributeMaxDynamicSharedMemorySize, LDS_BYTES) != hipSuccess) { fprintf(stderr, "kernel_launch: hipFuncSetAttribute failed\n"); grid = -1; return; }
        if (hipOccupancyMaxActiveBlocksPerMultiprocessor(&per_cu, (const void*)mega_fwd, NWAVES * 64, LDS_BYTES) != hipSuccess || per_cu < 1) { fprintf(stderr, "kernel_launch: occupancy query says %d\n", per_cu); per_cu = 1; }
        (void)hipGetLastError();
        grid = cus > 0 ? cus : 256;
    }
    if (grid < 0) return;
    Args a{};
    for (int i = 0; i < 20; ++i) a.in[i] = (const float*)d_in[i];
    a.out = (float*)d_out; a.ws = (unsigned char*)d_ws;
    if (MK_N_LAUNCHES == 1) {
        a.ph_lo = 0; a.ph_hi = NPH; a.coop = 1;
        (void)hipMemsetAsync((char*)d_ws + WS_BAR, 0, 16384, stream);
        void* kargs[] = {&a};
        hipError_t e = hipLaunchCooperativeKernel((const void*)mega_fwd, dim3(grid), dim3(NWAVES * 64), kargs, LDS_BYTES, stream);
        if (e != hipSuccess) fprintf(stderr, "kernel_launch: cooperative launch failed: %s (grid %d)\n", hipGetErrorString(e), grid);
    } else {
        for (int p = 0; p < NPH; ++p) {
            a.ph_lo = p; a.ph_hi = p + 1;
            hipLaunchKernelGGL(mega_fwd, dim3(grid), dim3(NWAVES * 64), LDS_BYTES, stream, a);
        }
    }
}
```

```cpp
#include <hip/hip_runtime.h>
#include <hip/hip_cooperative_groups.h>
#include <cstdio>
#include <cstdint>
namespace cg = cooperative_groups;

#ifndef MK_N_LAUNCHES
#define MK_N_LAUNCHES 1
#endif

namespace pg8 {
#define PG8_LAS __attribute__((address_space(3)))
typedef unsigned short bf16_t;
typedef short bf16x8 __attribute__((ext_vector_type(8)));
typedef float f32x4 __attribute__((ext_vector_type(4)));
typedef unsigned u32x4 __attribute__((ext_vector_type(4)));
constexpr int BM = 256, BK = 64, HALF = 128, HTB = HALF * BK * 2, STAGE_BYTES = 8 * HTB, NXCD = 8, WGM = 8;

__host__ __device__ __forceinline__ int lds_byte(int r, int c) { const int st = (r >> 4) * 2 + (c >> 5), rr = r & 15, cc = c & 31, ob = rr * 64 + cc * 2; return st * 1024 + (ob ^ (((ob >> 9) & 1) << 5)); }
__host__ __device__ __forceinline__ void stage_rc(int b, int& R, int& C) { const int st = b / 1024, sb = b % 1024, swz = sb ^ (((sb >> 9) & 1) << 5); R = (st >> 1) * 16 + swz / 64; C = (st & 1) * 32 + (swz % 64) / 2; }
__host__ __device__ __forceinline__ int perm32(int rho) { const int n = rho >> 4, i = rho & 15; return 8 * (i >> 2) + 4 * n + (i & 3); }

struct Unit { int pm, pn; };
struct Gemm { const bf16_t* A; const bf16_t* Bt; int M, N, K, lda, ldb, a_pn_step, b_pn_step; };

struct StaticOrder {
    int nM, nN, nwg, G, c;
    __host__ __device__ void init(int M, int N, int G_, int c_) { nM = M / BM; nN = N / BM; nwg = nM * nN; G = G_; c = c_; }
    __host__ __device__ bool next(int i, Unit& u) const {
        const long L = (long)i * G + c; if (L >= nwg) return false;
        int wgid = (int)L; { const int q = nwg / NXCD, r = nwg % NXCD, xcd = wgid % NXCD, off = wgid / NXCD; wgid = (xcd < r ? xcd * (q + 1) : r * (q + 1) + (xcd - r) * q) + off; }
        const int nig = WGM * nN, gid = wgid / nig, fm = gid * WGM, gsz = (nM - fm) < WGM ? (nM - fm) : WGM;
        u.pm = fm + ((wgid % nig) % gsz); u.pn = (wgid % nig) / gsz; return true;
    }
};

typedef float f32x2_t_ __attribute__((ext_vector_type(2))); typedef __bf16 bf16x2_t_ __attribute__((ext_vector_type(2)));
__device__ __forceinline__ unsigned cvt_pk_bf16(float lo, float hi) { f32x2_t_ v = {lo, hi}; bf16x2_t_ b = __builtin_convertvector(v, bf16x2_t_); return __builtin_bit_cast(unsigned, b); }
__device__ __forceinline__ u32x4 pack8(f32x4 a, f32x4 b) { u32x4 w; w.x = cvt_pk_bf16(a[0], a[1]); w.y = cvt_pk_bf16(a[2], a[3]); w.z = cvt_pk_bf16(b[0], b[1]); w.w = cvt_pk_bf16(b[2], b[3]); return w; }
__device__ __forceinline__ void unpack8(u32x4 w, f32x4& a, f32x4& b) {
    a[0] = __uint_as_float(w.x << 16); a[1] = __uint_as_float(w.x & 0xffff0000u); a[2] = __uint_as_float(w.y << 16); a[3] = __uint_as_float(w.y & 0xffff0000u);
    b[0] = __uint_as_float(w.z << 16); b[1] = __uint_as_float(w.z & 0xffff0000u); b[2] = __uint_as_float(w.w << 16); b[3] = __uint_as_float(w.w & 0xffff0000u); }
__device__ __forceinline__ float sigmoidf_(float v) { return __builtin_amdgcn_rcpf(1.0f + __builtin_amdgcn_exp2f(-1.4426950408889634f * v)); }
__device__ __forceinline__ f32x4 sigmoid4(f32x4 v) { f32x4 o; o[0] = sigmoidf_(v[0]); o[1] = sigmoidf_(v[1]); o[2] = sigmoidf_(v[2]); o[3] = sigmoidf_(v[3]); return o; }

typedef f32x4 AccT[2][2][4][2];
#define EPI_LOOP_AM _Pragma("unroll") for (int ai = 0; ai < 2; ++ai) _Pragma("unroll") for (int m = 0; m < 4; ++m)
#define EPI_LOOP_B _Pragma("unroll") for (int bj = 0; bj < 2; ++bj)

struct EpiIn {
    static constexpr bool PERM = true;
    float* C1; bf16_t* U; bf16_t* G; const float* bgate;
    __device__ __forceinline__ void operator()(const AccT& acc, const Unit& u, int wr, int wc, int fr, int fq) const {
        const int row0 = u.pm * BM + wr * 64 + fr, pn = u.pn, cw = wc * 32 + 8 * fq;
        if (pn < 4) {
            EPI_LOOP_AM { float* rp = C1 + (size_t)(row0 + ai * HALF + m * 16) * 1024 + pn * 256 + cw;
                EPI_LOOP_B { *(f32x4*)(rp + bj * HALF) = acc[ai][bj][m][0]; *(f32x4*)(rp + bj * HALF + 4) = acc[ai][bj][m][1]; } }
        } else if (pn < 8) {
            EPI_LOOP_AM { bf16_t* rp = U + (size_t)(row0 + ai * HALF + m * 16) * 1024 + (pn - 4) * 256 + cw;
                EPI_LOOP_B { *(u32x4*)(rp + bj * HALF) = pack8(acc[ai][bj][m][0], acc[ai][bj][m][1]); } }
        } else {
            const int gc = (pn - 8) * 256 + cw; f32x4 bv[2][2];
            EPI_LOOP_B { bv[bj][0] = *(const f32x4*)(bgate + gc + bj * HALF); bv[bj][1] = *(const f32x4*)(bgate + gc + bj * HALF + 4); }
            EPI_LOOP_AM { bf16_t* rp = G + (size_t)(row0 + ai * HALF + m * 16) * 4096 + gc;
                EPI_LOOP_B { *(u32x4*)(rp + bj * HALF) = pack8(sigmoid4(acc[ai][bj][m][0] + bv[bj][0]), sigmoid4(acc[ai][bj][m][1] + bv[bj][1])); } }
        }
    }
};
struct EpiKRP {
    static constexpr bool PERM = true;
    float* KRP;
    __device__ __forceinline__ void operator()(const AccT& acc, const Unit& u, int wr, int wc, int fr, int fq) const {
        const int row0 = u.pm * BM + wr * 64 + fr, cw = wc * 32 + 8 * fq;
        if (wc < 2) { EPI_LOOP_AM { float* rp = KRP + ((size_t)u.pn * 8192 + (row0 + ai * HALF + m * 16)) * 64 + cw; *(f32x4*)rp = acc[ai][0][m][0]; *(f32x4*)(rp + 4) = acc[ai][0][m][1]; } }
    }
};
struct EpiBf16 {
    static constexpr bool PERM = true;
    bf16_t* O; int ldc;
    __device__ __forceinline__ void operator()(const AccT& acc, const Unit& u, int wr, int wc, int fr, int fq) const {
        const int row0 = u.pm * BM + wr * 64 + fr, col0 = u.pn * BM + wc * 32 + 8 * fq;
        EPI_LOOP_AM { bf16_t* rp = O + (size_t)(row0 + ai * HALF + m * 16) * ldc + col0;
            EPI_LOOP_B { *(u32x4*)(rp + bj * HALF) = pack8(acc[ai][bj][m][0], acc[ai][bj][m][1]); } }
    }
};
struct EpiKV {
    static constexpr bool PERM = true;
    bf16_t* K; bf16_t* V;
    __device__ __forceinline__ void operator()(const AccT& acc, const Unit& u, int wr, int wc, int fr, int fq) const {
        const int row0 = u.pm * BM + wr * 64 + fr, cw = wc * 32 + 8 * fq, h = u.pn;
        EPI_LOOP_AM { const size_t row = (size_t)(row0 + ai * HALF + m * 16);
            *(u32x4*)(K + row * 3072 + h * 192 + cw) = pack8(acc[ai][0][m][0], acc[ai][0][m][1]);
            *(u32x4*)(V + row * 2048 + h * 128 + cw) = pack8(acc[ai][1][m][0], acc[ai][1][m][1]); }
    }
};
struct EpiScale {
    static constexpr bool PERM = true;
    bf16_t* O; int ldc; const float* scale;
    __device__ __forceinline__ void operator()(const AccT& acc, const Unit& u, int wr, int wc, int fr, int fq) const {
        const int row0 = u.pm * BM + wr * 64 + fr, col0 = u.pn * BM + wc * 32 + 8 * fq; f32x4 sv[2][2];
        EPI_LOOP_B { sv[bj][0] = *(const f32x4*)(scale + col0 + bj * HALF); sv[bj][1] = *(const f32x4*)(scale + col0 + bj * HALF + 4); }
        EPI_LOOP_AM { bf16_t* rp = O + (size_t)(row0 + ai * HALF + m * 16) * ldc + col0;
            EPI_LOOP_B { *(u32x4*)(rp + bj * HALF) = pack8(acc[ai][bj][m][0] * sv[bj][0], acc[ai][bj][m][1] * sv[bj][1]); } }
    }
};
template <bool HAS_ADD> struct EpiGate {
    static constexpr bool PERM = true;
    bf16_t* O; const bf16_t* gate; const bf16_t* add; int gcol0;
    __device__ __forceinline__ void operator()(const AccT& acc, const Unit& u, int wr, int wc, int fr, int fq) const {
        const int row0 = u.pm * BM + wr * 64 + fr, col0 = u.pn * BM + wc * 32 + 8 * fq;
        EPI_LOOP_AM { const size_t row = (size_t)(row0 + ai * HALF + m * 16);
            EPI_LOOP_B { f32x4 g0, g1; unpack8(*(const u32x4*)(gate + row * 4096 + gcol0 + col0 + bj * HALF), g0, g1);
                f32x4 v0 = g0 * acc[ai][bj][m][0], v1 = g1 * acc[ai][bj][m][1];
                if (HAS_ADD) { f32x4 a0, a1; unpack8(*(const u32x4*)(add + row * 2048 + col0 + bj * HALF), a0, a1); v0 += a0; v1 += a1; }
                *(u32x4*)(O + row * 2048 + col0 + bj * HALF) = pack8(v0, v1); } }
    }
};
struct EpiRes {
    static constexpr bool PERM = false;
    const float* base; float* out; int ldc;
    __device__ __forceinline__ void operator()(const AccT& acc, const Unit& u, int wr, int wc, int fr, int fq) const {
        const int row0 = u.pm * BM + wr * 64 + fr, col0 = u.pn * BM + wc * 32 + 4 * fq;
        EPI_LOOP_AM { const size_t off = (size_t)(row0 + ai * HALF + m * 16) * ldc + col0;
            EPI_LOOP_B {
#pragma unroll
                for (int n = 0; n < 2; ++n) { const f32x4 b = *(const f32x4*)(base + off + bj * HALF + n * 16); *(f32x4*)(out + off + bj * HALF + n * 16) = b + acc[ai][bj][m][n]; } } }
    }
};
struct EpiResNorm {
    static constexpr bool PERM = false;
    const float* base; float* out; bf16_t* outb; float* ss; int ldc;
    __device__ __forceinline__ void operator()(const AccT& acc, const Unit& u, int wr, int wc, int fr, int fq) const {
        const int row0 = u.pm * BM + wr * 64 + fr, col0 = u.pn * BM + wc * 32 + 4 * fq;
        EPI_LOOP_AM { const int row = row0 + ai * HALF + m * 16; const size_t off = (size_t)row * ldc + col0; float s = 0.f;
            EPI_LOOP_B {
#pragma unroll
                for (int n = 0; n < 2; ++n) { const f32x4 v = *(const f32x4*)(base + off + bj * HALF + n * 16) + acc[ai][bj][m][n]; *(f32x4*)(out + off + bj * HALF + n * 16) = v;
                    typedef unsigned u32x2_ __attribute__((ext_vector_type(2))); u32x2_ w; w.x = cvt_pk_bf16(v[0], v[1]); w.y = cvt_pk_bf16(v[2], v[3]); *(u32x2_*)(outb + off + bj * HALF + n * 16) = w;
                    s += (v[0] * v[0] + v[1] * v[1]) + (v[2] * v[2] + v[3] * v[3]); } }
            s += __shfl_xor(s, 16); s += __shfl_xor(s, 32);
            if (fq == 0) atomicAdd(ss + row, s); }
    }
};
struct EpiSwiGLU {
    static constexpr bool PERM = true;
    bf16_t* O; int ldc; const float* ss;
    __device__ __forceinline__ void operator()(const AccT& acc, const Unit& u, int wr, int wc, int fr, int fq) const {
        const int row0 = u.pm * BM + wr * 64 + fr, col0 = u.pn * HALF + wc * 32 + 8 * fq;
        EPI_LOOP_AM { const int row = row0 + ai * HALF + m * 16; bf16_t* rp = O + (size_t)row * ldc + col0;
            const float inv = 1.0f / sqrtf(ss[row] * (1.f / 2048.f) + 1e-6f);
            const f32x4 g0 = acc[ai][0][m][0] * inv, g1 = acc[ai][0][m][1] * inv;
            *(u32x4*)rp = pack8(g0 * sigmoid4(g0) * (acc[ai][1][m][0] * inv), g1 * sigmoid4(g1) * (acc[ai][1][m][1] * inv)); }
    }
};

template <class Epi, class Sched, bool ALIGN_EPI = true>
__device__ __forceinline__ void gemm_phase(PG8_LAS unsigned char* lds, const Gemm g, const Sched& S, const Epi& E) {
    const int tid = threadIdx.x, wid = __builtin_amdgcn_readfirstlane(tid >> 6), lane = tid & 63, wr = wid >> 2, wc = wid & 3, fr = lane & 15, fq = lane >> 4;
    const int K = g.K, nt = K / BK;
    unsigned voffA[2], voffB[2];
#pragma unroll
    for (int i = 0; i < 2; ++i) { int R, C; stage_rc(tid * 16 + i * 8192, R, C); const int Rb = Epi::PERM ? ((R & ~31) + perm32(R & 31)) : R;
        voffA[i] = (unsigned)(R * g.lda + C) * 2u; voffB[i] = (unsigned)(Rb * g.ldb + C) * 2u; }
    const size_t kstep = (size_t)(BK * 2);
    const size_t hstepA = (size_t)HALF * g.lda * 2, hstepB = (size_t)HALF * g.ldb * 2;
    const size_t tstepA = 2 * hstepA, tstepB = g.b_pn_step ? (size_t)g.b_pn_step * 2 : 2 * hstepB, pstepA = (size_t)g.a_pn_step * 2;
    const unsigned ldsw = (unsigned)wid * 1024u;
    const int aoff = lds_byte(wr * 64 + fr, fq * 8), boff = lds_byte(wc * 32 + fr, fq * 8);
#define PG8_SA(b, h) (((b) * 2 + (h)) * HTB)
#define PG8_SB(b, h) ((4 + (b) * 2 + (h)) * HTB)
#define PG8_STAGE(bufoff, gbase, voff) do { _Pragma("unroll") for (int _i = 0; _i < 2; ++_i) \
        __builtin_amdgcn_global_load_lds((const unsigned*)((const char*)(gbase) + (voff)[_i]), (PG8_LAS unsigned*)(lds + (bufoff) + ldsw + _i * 8192), 16, 0, 0); } while (0)
#define PG8_LDA(dst, b, h) do { _Pragma("unroll") for (int m = 0; m < 4; ++m) _Pragma("unroll") for (int k = 0; k < 2; ++k) dst[m][k] = *(const PG8_LAS bf16x8*)(lds + PG8_SA(b, h) + aoff + m * 2048 + k * 1024); } while (0)
#define PG8_LDB(dst, b, h) do { _Pragma("unroll") for (int n = 0; n < 2; ++n) _Pragma("unroll") for (int k = 0; k < 2; ++k) dst[n][k] = *(const PG8_LAS bf16x8*)(lds + PG8_SB(b, h) + boff + n * 2048 + k * 1024); } while (0)
#define PG8_MMA(ai, bj, At, Bt) do { __builtin_amdgcn_s_setprio(1); _Pragma("unroll") for (int m = 0; m < 4; ++m) _Pragma("unroll") for (int n = 0; n < 2; ++n) _Pragma("unroll") for (int k = 0; k < 2; ++k) \
        acc[ai][bj][m][n] = __builtin_amdgcn_mfma_f32_16x16x32_bf16(Bt[n][k], At[m][k], acc[ai][bj][m][n], 0, 0, 0); __builtin_amdgcn_s_setprio(0); } while (0)
#define PG8_WAIT_V(n) asm volatile("s_waitcnt vmcnt(" #n ")" ::: "memory")
#define PG8_WAIT_L(n) asm volatile("s_waitcnt lgkmcnt(" #n ")" ::: "memory")
#define PG8_BAR __builtin_amdgcn_s_barrier()
#define PG8_SCHED __builtin_amdgcn_sched_barrier(0)
    Unit cur, nxt; int ui = 0;
    if (!S.next(0, cur)) return;
    f32x4 acc[2][2][4][2];
#pragma unroll
    for (int a = 0; a < 2; ++a)
#pragma unroll
        for (int b = 0; b < 2; ++b)
#pragma unroll
            for (int m = 0; m < 4; ++m)
#pragma unroll
                for (int n = 0; n < 2; ++n) acc[a][b][m][n] = (f32x4){0.f, 0.f, 0.f, 0.f};
    bf16x8 At[4][2], B0[2][2], B1[2][2];
    const char* cA = (const char*)g.A + (size_t)cur.pm * tstepA + (size_t)cur.pn * pstepA; const char* cB = (const char*)g.Bt + (size_t)cur.pn * tstepB;
    PG8_STAGE(PG8_SB(0, 0), cB, voffB); PG8_STAGE(PG8_SB(0, 1), cB + hstepB, voffB); PG8_STAGE(PG8_SA(0, 0), cA, voffA); PG8_STAGE(PG8_SA(0, 1), cA + hstepA, voffA);
    if (wr == 1) PG8_BAR;
    PG8_WAIT_V(2); PG8_BAR;
    PG8_STAGE(PG8_SB(1, 0), cB + kstep, voffB); PG8_STAGE(PG8_SA(1, 0), cA + kstep, voffA); PG8_STAGE(PG8_SB(1, 1), cB + hstepB + kstep, voffB);
    PG8_WAIT_V(6); PG8_BAR;
    for (;;) {
        const bool has_next = S.next(ui + 1, nxt);
        const char* nA = has_next ? (const char*)g.A + (size_t)nxt.pm * tstepA + (size_t)nxt.pn * pstepA : cA; const char* nB = has_next ? (const char*)g.Bt + (size_t)nxt.pn * tstepB : cB;
        for (int t = 0; t < nt; t += 2) {
            const bool last = (t == nt - 2);
            const char* a1 = cA + (size_t)(t + 1) * kstep;
            const char* a2 = last ? nA : cA + (size_t)(t + 2) * kstep; const char* b2 = last ? nB : cB + (size_t)(t + 2) * kstep;
            const char* a3 = a2 + kstep; const char* b3 = b2 + kstep;
            PG8_LDB(B0, 0, 0); PG8_LDB(B1, 0, 1); PG8_SCHED; PG8_LDA(At, 0, 0); PG8_STAGE(PG8_SA(1, 1), a1 + hstepA, voffA);
            PG8_WAIT_V(8); PG8_WAIT_L(0); PG8_BAR; PG8_MMA(0, 0, At, B0); PG8_MMA(0, 1, At, B1); PG8_BAR; PG8_SCHED;
            PG8_LDA(At, 0, 1); PG8_STAGE(PG8_SB(0, 0), b2, voffB); PG8_STAGE(PG8_SB(0, 1), b2 + hstepB, voffB); PG8_STAGE(PG8_SA(0, 0), a2, voffA);
            PG8_WAIT_V(8); PG8_WAIT_L(0); PG8_BAR; PG8_MMA(1, 0, At, B0); PG8_MMA(1, 1, At, B1); PG8_BAR; PG8_SCHED;
            PG8_LDB(B0, 1, 0); PG8_LDB(B1, 1, 1); PG8_SCHED; PG8_LDA(At, 1, 0); PG8_STAGE(PG8_SA(0, 1), a2 + hstepA, voffA);
            PG8_WAIT_V(8); PG8_WAIT_L(0); PG8_BAR; PG8_MMA(0, 0, At, B0); PG8_MMA(0, 1, At, B1); PG8_BAR; PG8_SCHED;
            PG8_LDA(At, 1, 1); PG8_STAGE(PG8_SB(1, 0), b3, voffB); PG8_STAGE(PG8_SB(1, 1), b3 + hstepB, voffB); PG8_STAGE(PG8_SA(1, 0), a3, voffA);
            PG8_WAIT_V(8); PG8_WAIT_L(0); PG8_BAR; PG8_MMA(1, 0, At, B0); PG8_MMA(1, 1, At, B1); PG8_BAR; PG8_SCHED;
        }
        if constexpr (ALIGN_EPI) { if (wr == 0) PG8_BAR; }
        E(acc, cur, wr, wc, fr, fq);
        if (!has_next) break;
#pragma unroll
        for (int a = 0; a < 2; ++a)
#pragma unroll
            for (int b = 0; b < 2; ++b)
#pragma unroll
                for (int m = 0; m < 4; ++m)
#pragma unroll
                    for (int n = 0; n < 2; ++n) acc[a][b][m][n] = (f32x4){0.f, 0.f, 0.f, 0.f};
        cur = nxt; cA = nA; cB = nB; ++ui;
        if constexpr (ALIGN_EPI) { if (wr == 1) PG8_BAR; }
    }
    PG8_WAIT_V(0);
    if constexpr (!ALIGN_EPI) { if (wr == 0) PG8_BAR; }
    PG8_BAR;
#undef PG8_SA
#undef PG8_SB
#undef PG8_STAGE
#undef PG8_LDA
#undef PG8_LDB
#undef PG8_MMA
#undef PG8_WAIT_V
#undef PG8_WAIT_L
#undef PG8_BAR
#undef PG8_SCHED
}
}

constexpr int BATCH = 2, SEQ = 4096, DM = 2048, M = BATCH * SEQ;
constexpr int NH = 16, DQK = 192, DNOPE = 128, DROPE = 64, DV = 128, QLORA = 512, KVLORA = 512;
constexpr int POOLW = 1024, DIN = 6208, DIN_PAD = 6400, DFF = 5632;
constexpr float EPS = 1e-6f;
constexpr int NWAVES = 8;

typedef unsigned short bf16;
typedef unsigned v4u __attribute__((ext_vector_type(4)));
typedef unsigned v2u __attribute__((ext_vector_type(2)));
typedef float f32x4 __attribute__((ext_vector_type(4)));
typedef short bf16x8 __attribute__((ext_vector_type(8)));
typedef short s16x4 __attribute__((ext_vector_type(4)));
typedef float f32x16 __attribute__((ext_vector_type(16)));
#define LAS __attribute__((address_space(3)))
#define LDS_WAIT() asm volatile("s_waitcnt lgkmcnt(0)" ::: "memory")

constexpr size_t MiB = 1u << 20;
constexpr size_t WS_WAO = 1 * MiB, WS_WOUT = 9 * MiB, WS_WPO = 17 * MiB, WS_WQB = 21 * MiB, WS_WKVB = 24 * MiB, WS_WPG = 28 * MiB, WS_KR = 29 * MiB;
constexpr size_t WS_G = 31 * MiB;
constexpr size_t WS_WIN = 95 * MiB, WS_XN = 120 * MiB, WS_C1 = 152 * MiB, WS_U = 184 * MiB;
constexpr size_t WS_Q = 95 * MiB, WS_K = 143 * MiB, WS_V = 191 * MiB, WS_CN = 223 * MiB, WS_POOLED = 239 * MiB, WS_PG = 255 * MiB;
constexpr size_t WS_MP = 223 * MiB, WS_O = 255 * MiB, WS_MIXED = 95 * MiB, WS_X1 = 127 * MiB, WS_H2 = 95 * MiB;
constexpr size_t WS_WGU = 191 * MiB, WS_WDN = 235 * MiB, WS_ACT = 1 * MiB;
constexpr size_t WS_END = 296 * MiB, WS_BAR = 512 * 1024, WS_KRP = 272 * MiB, WS_X1B = 257 * MiB;
constexpr int SV_BGATE = 0, SV_QAG = 4096, SV_KVAG = 4608, SV_QNG = 5120, SV_KNG = 5376, SV_PSC = 5632, SV_FNG = 6656, SV_POS = 8704, SV_END = 8704 + 8192, SV_SS = 32768;

constexpr int LDS_BYTES = 147456;

__device__ __forceinline__ unsigned cvtpk(float lo, float hi) { return pg8::cvt_pk_bf16(lo, hi); }
__device__ __forceinline__ float bflo(unsigned w) { return __uint_as_float(w << 16); }
__device__ __forceinline__ float bfhi(unsigned w) { return __uint_as_float(w & 0xffff0000u); }
__device__ __forceinline__ float wave_sum(float v) {
#pragma unroll
    for (int o = 1; o < 64; o <<= 1) v += __shfl_xor(v, o);
    return v;
}

__device__ __forceinline__ int dst_row(int mode, int n0) {
    if (mode == 1) { if (n0 < 1024) return n0; if (n0 < 1088) return 6144 + (n0 - 1024); if (n0 < 2112) return 1024 + (n0 - 1088); return 2048 + (n0 - 2112); }
    if (mode == 2) return (n0 >> 7) * 256 + (n0 & 127);
    if (mode == 3) return (n0 >> 7) * 256 + 128 + (n0 & 127);
    return n0;
}
__device__ __forceinline__ void transpose_item(const float* W, int K, int N, bf16* WT, int mode, int row_off, LAS float* scr, int item, int lane, const float* gk = nullptr) {
    const int nblk = N / 32, kb = item / nblk, nb = item % nblk, k0 = 64 * kb, n0 = 32 * nb;
    { float tv[32]; const float* wp = W + (size_t)(k0 + (lane >> 5)) * N + n0 + (lane & 31);
#pragma unroll
      for (int i = 0; i < 32; ++i) tv[i] = wp[(size_t)(2 * i) * N];
      if (gk) {
#pragma unroll
          for (int i = 0; i < 32; ++i) tv[i] *= gk[k0 + 2 * i + (lane >> 5)]; }
#pragma unroll
      for (int i = 0; i < 32; ++i) scr[(2 * i + (lane >> 5)) * 33 + (lane & 31)] = tv[i]; }
    LDS_WAIT(); asm volatile("" ::: "memory");
    const int c = lane & 7, dr = row_off + dst_row(mode, n0);
#pragma unroll
    for (int j = 0; j < 4; ++j) { const int n = (lane >> 3) + 8 * j; const LAS float* s = scr + (8 * c) * 33 + n;
        v4u o; o.x = cvtpk(s[0 * 33], s[1 * 33]); o.y = cvtpk(s[2 * 33], s[3 * 33]); o.z = cvtpk(s[4 * 33], s[5 * 33]); o.w = cvtpk(s[6 * 33], s[7 * 33]);
        *(v4u*)(WT + (size_t)(dr + n) * K + k0 + 8 * c) = o; }
    LDS_WAIT(); asm volatile("" ::: "memory");
}

struct TrDesc { const float* W; bf16* WT; const float* gk; int K, N, k0, n0, dr; };
__device__ __forceinline__ TrDesc tr_desc(const float* W, int K, int N, bf16* WT, int mode, int row_off, int item, const float* gk) {
    const int nblk = N / 32, kb = item / nblk, nb = item % nblk; TrDesc d; d.W = W; d.WT = WT; d.gk = gk; d.K = K; d.N = N; d.k0 = 64 * kb; d.n0 = 32 * nb; d.dr = row_off + dst_row(mode, d.n0); return d; }
__device__ __forceinline__ void tr_load(const TrDesc& d, float (&tv)[32], int lane) {
    const float* wp = d.W + (size_t)(d.k0 + (lane >> 5)) * d.N + d.n0 + (lane & 31);
#pragma unroll
    for (int i = 0; i < 32; ++i) tv[i] = __builtin_nontemporal_load(wp + (size_t)(2 * i) * d.N);
}
__device__ __forceinline__ void tr_finish(const TrDesc& d, float (&tv)[32], LAS float* scr, int lane) {
    if (d.gk) {
#pragma unroll
        for (int i = 0; i < 32; ++i) tv[i] *= d.gk[d.k0 + 2 * i + (lane >> 5)]; }
#pragma unroll
    for (int i = 0; i < 32; ++i) scr[(2 * i + (lane >> 5)) * 33 + (lane & 31)] = tv[i];
    LDS_WAIT(); asm volatile("" ::: "memory");
    const int c = lane & 7;
#pragma unroll
    for (int j = 0; j < 4; ++j) { const int n = (lane >> 3) + 8 * j; const LAS float* s_ = scr + (8 * c) * 33 + n;
        v4u o; o.x = cvtpk(s_[0 * 33], s_[1 * 33]); o.y = cvtpk(s_[2 * 33], s_[3 * 33]); o.z = cvtpk(s_[4 * 33], s_[5 * 33]); o.w = cvtpk(s_[6 * 33], s_[7 * 33]);
        *(v4u*)(d.WT + (size_t)(d.dr + n) * d.K + d.k0 + 8 * c) = o; }
    LDS_WAIT(); asm volatile("" ::: "memory");
}
#define TR_PIPELINE(FIRST, LIMIT, STRIDE, MAKE_DESC) do { int it_ = (FIRST); if (it_ < (LIMIT)) { TrDesc dA_ = MAKE_DESC(it_); float tvA_[32]; tr_load(dA_, tvA_, lane); \
        for (;;) { const int nx_ = it_ + (STRIDE); const bool more_ = nx_ < (LIMIT); TrDesc dB_ = dA_; float tvB_[32]; \
            if (more_) { dB_ = MAKE_DESC(nx_); tr_load(dB_, tvB_, lane); } \
            tr_finish(dA_, tvA_, scr, lane); if (!more_) break; \
            dA_ = dB_; _Pragma("unroll") for (int i_ = 0; i_ < 32; ++i_) tvA_[i_] = tvB_[i_]; it_ = nx_; } } } while (0)

__device__ __forceinline__ void rms_row_2048(const float* xrow, const float* g, bf16* orow, int lane) {
    const f32x4* xr = (const f32x4*)xrow + lane; const f32x4* gr = (const f32x4*)g + lane;
    f32x4 v[8]; float s = 0.f;
#pragma unroll
    for (int j = 0; j < 8; ++j) { v[j] = xr[64 * j]; s += (v[j].x * v[j].x + v[j].y * v[j].y) + (v[j].z * v[j].z + v[j].w * v[j].w); }
    const float inv = 1.0f / sqrtf(wave_sum(s) * (1.f / 2048.f) + EPS);
    v2u* o8 = (v2u*)orow + lane;
#pragma unroll
    for (int j = 0; j < 8; ++j) { const f32x4 gv = gr[64 * j]; v2u o; o.x = cvtpk(v[j].x * inv * gv.x, v[j].y * inv * gv.y); o.y = cvtpk(v[j].z * inv * gv.z, v[j].w * inv * gv.w); o8[64 * j] = o; }
}

namespace att {
constexpr int QBLK = 32, KVBLK = 64, QB = 256;
constexpr int SHM_V = KVBLK * DV * 2, SHM_K = KVBLK * DQK * 2;
constexpr int OFF_V = 0, OFF_K = 3 * SHM_V, OFF_WS = OFF_K + 2 * SHM_K;
constexpr float SCALE = 0.07216878364870322f;
constexpr float THR = 8.f;
#define KSWZ(row, colB) ((row) * 384 + ((colB) ^ (((row) & 7) << 4)))
#define SBAR() __builtin_amdgcn_sched_barrier(0)
__device__ __forceinline__ int v_st(int k, int c) { const int kk = (k & ~0xC) | ((k & 4) << 1) | ((k & 8) >> 1); return ((kk >> 3) * 4 + (c >> 5)) * 512 + ((kk & 7) * 32 + (c & 31)) * 2; }
__device__ __forceinline__ int v_rd_base(int lane) { return ((lane & 3) << 3) | (((lane >> 2) & 3) << 6) | (((lane >> 4) & 1) << 5) | (((lane >> 5) & 1) << 8); }
__device__ __forceinline__ int crow(int r, int hi) { return (r & 3) + 8 * (r >> 2) + 4 * hi; }
__device__ __forceinline__ void mask_tile(f32x16& p0, f32x16& p1, int dq) {
    const float NEG = -__builtin_inff();
#pragma unroll
    for (int r = 0; r < 16; ++r) {
        const int c = (r & 3) + 8 * (r >> 2);
        if (dq - c < 0) p0[r] = NEG;
        if (dq - c - 32 < 0) p1[r] = NEG;
    }
}
__device__ __forceinline__ void partialSM(f32x16& p0, f32x16& p1, float& m_reg, float& mn, float& alpha) {
    float pmax = p0[0];
#pragma unroll
    for (int r = 1; r < 16; ++r) pmax = fmaxf(pmax, p0[r]);
#pragma unroll
    for (int r = 0; r < 16; ++r) pmax = fmaxf(pmax, p1[r]);
    { auto rr = __builtin_amdgcn_permlane32_swap(__float_as_uint(pmax), __float_as_uint(pmax), false, false);
      pmax = fmaxf(__uint_as_float(rr[0]), __uint_as_float(rr[1])); }
    constexpr float C2 = 1.4426950408889634f * SCALE;
    if (__builtin_expect(__all((pmax - m_reg) * SCALE <= THR), 1)) { mn = m_reg; alpha = 1.f; }
    else { mn = fmaxf(m_reg, pmax); alpha = __builtin_amdgcn_exp2f((m_reg - mn) * C2); m_reg = mn; }
    const float mnL = -mn * C2;
#pragma unroll
    for (int r = 0; r < 16; ++r) p0[r] = fmaf(p0[r], C2, mnL);
#pragma unroll
    for (int r = 0; r < 16; ++r) p1[r] = fmaf(p1[r], C2, mnL);
#pragma unroll
    for (int r = 0; r < 16; ++r) p0[r] = __builtin_amdgcn_exp2f(p0[r]);
}
__device__ __forceinline__ void finishSM(f32x16& p0, f32x16& p1, float alpha, float& l_reg, bf16x8& pa0, bf16x8& pa1, bf16x8& pa2, bf16x8& pa3) {
#pragma unroll
    for (int r = 0; r < 16; ++r) p1[r] = __builtin_amdgcn_exp2f(p1[r]);
    float ps = 0;
#pragma unroll
    for (int r = 0; r < 16; ++r) ps += p0[r];
#pragma unroll
    for (int r = 0; r < 16; ++r) ps += p1[r];
    { auto rr = __builtin_amdgcn_permlane32_swap(__float_as_uint(ps), __float_as_uint(ps), false, false);
      ps = __uint_as_float(rr[0]) + __uint_as_float(rr[1]); }
    l_reg = l_reg * alpha + ps;
#define PK4(P, B_, OUT) do { unsigned a0 = cvtpk(P[B_+0], P[B_+1]), a1 = cvtpk(P[B_+2], P[B_+3]);                          \
        unsigned b0 = cvtpk(P[B_+4], P[B_+5]), b1 = cvtpk(P[B_+6], P[B_+7]);                                             \
        auto r0 = __builtin_amdgcn_permlane32_swap(a0, b0, false, false); auto r1 = __builtin_amdgcn_permlane32_swap(a1, b1, false, false); \
        v4u w = {r0[0], r1[0], r0[1], r1[1]}; OUT = *reinterpret_cast<bf16x8*>(&w); } while (0)
    PK4(p0, 0, pa0); PK4(p0, 8, pa1); PK4(p1, 0, pa2); PK4(p1, 8, pa3);
#undef PK4
}
__device__ __forceinline__ void qkt(f32x16& p0, f32x16& p1, const char* Kb, int r32, int hi, const bf16x8* qr) {
    p0 = f32x16{}; p1 = f32x16{};
    const char* kb[4];
#pragma unroll
    for (int dd = 0; dd < 4; ++dd) kb[dd] = Kb + KSWZ(r32, (dd * 16 + hi * 8) * 2);
#pragma unroll
    for (int g = 0; g < 2; ++g) { bf16x8 b0[6], b1[6];
#pragma unroll
        for (int i = 0; i < 6; ++i) { const int d0 = 6 * g + i; const char* a = kb[d0 & 3] + (d0 >> 2) * 128; b0[i] = *reinterpret_cast<const bf16x8*>(a); b1[i] = *reinterpret_cast<const bf16x8*>(a + 32 * 384); }
        SBAR();
        __builtin_amdgcn_s_setprio(1);
#pragma unroll
        for (int i = 0; i < 6; ++i) { p0 = __builtin_amdgcn_mfma_f32_32x32x16_bf16(b0[i], qr[6 * g + i], p0, 0, 0, 0); p1 = __builtin_amdgcn_mfma_f32_32x32x16_bf16(b1[i], qr[6 * g + i], p1, 0, 0, 0); }
        __builtin_amdgcn_s_setprio(0);
        SBAR(); }
}
__device__ __forceinline__ void pv_tile(f32x16* o, int vb0, bf16x8 pa0, bf16x8 pa1, bf16x8 pa2, bf16x8 pa3) {
#define TRRD(dst, off) asm volatile("ds_read_b64_tr_b16 %0, %1 offset:%2" : "=&v"(dst) : "v"(vb0), "i"(off) : "memory")
#define PV_RD(S, d0) do { constexpr int b_ = (d0) * 512; TRRD(S##l0, b_); TRRD(S##h0, b_ + 2048); TRRD(S##l1, b_ + 4096); TRRD(S##h1, b_ + 6144); TRRD(S##l2, b_ + 8192); TRRD(S##h2, b_ + 10240); TRRD(S##l3, b_ + 12288); TRRD(S##h3, b_ + 14336); } while (0)
#define PV_MM(S, d0) do { \
        o[d0] = __builtin_amdgcn_mfma_f32_32x32x16_bf16(pa0, (bf16x8){S##l0[0], S##l0[1], S##l0[2], S##l0[3], S##h0[0], S##h0[1], S##h0[2], S##h0[3]}, o[d0], 0, 0, 0);   \
        o[d0] = __builtin_amdgcn_mfma_f32_32x32x16_bf16(pa1, (bf16x8){S##l1[0], S##l1[1], S##l1[2], S##l1[3], S##h1[0], S##h1[1], S##h1[2], S##h1[3]}, o[d0], 0, 0, 0);   \
        o[d0] = __builtin_amdgcn_mfma_f32_32x32x16_bf16(pa2, (bf16x8){S##l2[0], S##l2[1], S##l2[2], S##l2[3], S##h2[0], S##h2[1], S##h2[2], S##h2[3]}, o[d0], 0, 0, 0);   \
        o[d0] = __builtin_amdgcn_mfma_f32_32x32x16_bf16(pa3, (bf16x8){S##l3[0], S##l3[1], S##l3[2], S##l3[3], S##h3[0], S##h3[1], S##h3[2], S##h3[3]}, o[d0], 0, 0, 0); } while (0)
    s16x4 Al0, Al1, Al2, Al3, Ah0, Ah1, Ah2, Ah3, Bl0, Bl1, Bl2, Bl3, Bh0, Bh1, Bh2, Bh3;
    PV_RD(A, 0); PV_RD(B, 1);
    asm volatile("s_waitcnt lgkmcnt(8)" ::: "memory"); SBAR(); PV_MM(A, 0); SBAR();
    PV_RD(A, 2);
    asm volatile("s_waitcnt lgkmcnt(8)" ::: "memory"); SBAR(); PV_MM(B, 1); SBAR();
    PV_RD(B, 3);
    asm volatile("s_waitcnt lgkmcnt(8)" ::: "memory"); SBAR(); PV_MM(A, 2); SBAR();
    asm volatile("s_waitcnt lgkmcnt(0)" ::: "memory"); SBAR(); PV_MM(B, 3);
#undef PV_MM
#undef PV_RD
#undef TRRD
}
__device__ __forceinline__ void attn_unit(int b, int h, int qb, const bf16* Q, const bf16* K, const bf16* V, bf16* O, char* lds) {
    const int tid = threadIdx.x, wid = __builtin_amdgcn_readfirstlane(tid >> 6), lane = tid & 63, r32 = lane & 31, hi = lane >> 5;
    const size_t rowb = (size_t)b * SEQ;
    const int q0 = qb * QB, qlo = q0 + wid * QBLK;
    const int NT = (q0 + QB) / KVBLK;
    char* V_lds = lds + OFF_V; char* K_lds = lds + OFF_K;
#define WAVE_WS() ({ int t_ = (int)threadIdx.x; asm volatile("" : "+v"(t_)); (float*)(lds + OFF_WS) + (t_ >> 6) * 64; })
    LAS unsigned char* ldsl_ = (LAS unsigned char*)lds;
    unsigned ksrc[3], vsrc[2];
#pragma unroll
    for (int j = 0; j < 3; ++j) { const int s_ = (wid * 3 + j) * 64 + lane, row = s_ / 24, pc = s_ % 24; ksrc[j] = (unsigned)(row * 3072 * 2 + ((pc * 16) ^ ((row & 7) << 4))); }
#pragma unroll
    for (int j = 0; j < 2; ++j) { const int ob = ((wid * 2 + j) * 64 + lane) * 16, st = ob >> 9, kr_ = (ob >> 6) & 7, ch = (ob >> 4) & 3, c = (st & 3) * 32 + ch * 8, kk = (st >> 2) * 8 + kr_,
                                  k = (kk & ~0xC) | ((kk & 4) << 1) | ((kk & 8) >> 1); vsrc[j] = (unsigned)(k * 2048 * 2 + c * 2); }
    const char* Kh = (const char*)(K + rowb * 3072 + h * DQK); const char* Vh = (const char*)(V + rowb * 2048 + h * DV);
#define KDMA(k0, bf) do { _Pragma("unroll") for (int j = 0; j < 3; ++j) __builtin_amdgcn_global_load_lds((const unsigned*)(Kh + (size_t)(k0) * (3072 * 2) + ksrc[j]), \
        (LAS unsigned*)(ldsl_ + OFF_K + (bf) * SHM_K + (wid * 3 + j) * 1024), 16, 0, 0); } while (0)
#define VDMA(k0, sl) do { _Pragma("unroll") for (int j = 0; j < 2; ++j) __builtin_amdgcn_global_load_lds((const unsigned*)(Vh + (size_t)(k0) * (2048 * 2) + vsrc[j]), \
        (LAS unsigned*)(ldsl_ + OFF_V + (sl) * SHM_V + (wid * 2 + j) * 1024), 16, 0, 0); } while (0)
    KDMA(0, 0); VDMA(0, 0);
    bf16x8 qr[12];
    { const bf16* Qp = Q + (rowb + qlo + r32) * 3072 + h * DQK + hi * 8;
#pragma unroll
      for (int d0 = 0; d0 < 12; ++d0) qr[d0] = *(const bf16x8*)(Qp + d0 * 16); }
    asm volatile("s_waitcnt vmcnt(0)" ::: "memory");
    __syncthreads();
    float m_reg = -1e30f, l_reg = 0.f; f32x16 o[4] = {};
    const int vbase = (int)(uintptr_t)V_lds + v_rd_base(lane);
    const int qm = qlo + r32 - 4 * hi;
    f32x16 p0, p1;
#define SP_STAGE(VS) do { float mn, alpha; bf16x8 pa0, pa1, pa2, pa3; \
        partialSM(p0, p1, m_reg, mn, alpha); finishSM(p0, p1, alpha, l_reg, pa0, pa1, pa2, pa3); \
        if (__any(alpha < 1.f)) { float* al_l = WAVE_WS() + 32; if (hi == 0) al_l[r32] = alpha; asm volatile("s_waitcnt lgkmcnt(0)" ::: "memory"); \
            _Pragma("unroll") for (int d_ = 0; d_ < 4; ++d_) _Pragma("unroll") for (int r = 0; r < 16; ++r) o[d_][r] *= al_l[crow(r, hi)]; } \
        SBAR(); pv_tile(o, vbase + (VS) * SHM_V, pa0, pa1, pa2, pa3); } while (0)
    for (int t = 0; t < NT; ++t) {
        const int cur = t & 1, kb_ = t * KVBLK;
        if (t + 1 < NT) { KDMA((t + 1) * KVBLK, cur ^ 1); VDMA((t + 1) * KVBLK, cur ^ 1); }
        SBAR();
        qkt(p0, p1, K_lds + cur * SHM_K, r32, hi, qr); if (kb_ + KVBLK - 1 > qlo) mask_tile(p0, p1, qm - kb_);
        SBAR();
        SP_STAGE(cur);
        asm volatile("s_waitcnt vmcnt(0)" ::: "memory");
        __syncthreads();
    }
#undef SP_STAGE
    float* li_l = WAVE_WS();
    if (hi == 0) li_l[r32] = l_reg; asm volatile("s_waitcnt lgkmcnt(0)" ::: "memory");
    float rli[16];
#pragma unroll
    for (int r = 0; r < 16; ++r) rli[r] = __builtin_amdgcn_rcpf(li_l[crow(r, hi)]);
    bf16* Ow = O + (rowb + qlo) * 2048 + h * DV;
#pragma unroll
    for (int r = 0; r < 16; ++r) { const int orow = crow(r, hi);
#pragma unroll
        for (int d0 = 0; d0 < 4; ++d0) { const float v = o[d0][r] * rli[r];
            const float vn = __shfl_xor(v, 1);
            if ((r32 & 1) == 0) *(unsigned*)(Ow + (size_t)orow * 2048 + d0 * 32 + r32) = cvtpk(v, vn); } }
    __syncthreads();
#undef KDMA
#undef VDMA
#undef WAVE_WS
}
#undef SBAR
}

struct Args { const float* in[20]; float* out; unsigned char* ws; int ph_lo, ph_hi, coop, pad; };
#define XB_TMO      128
#define XB_XCNT(j)  (256  + 64 * (j))
#define XB_XSUB(j)  (1280 + 64 * (j))
#define XB_XGEN(j)  (2304 + 64 * (j))
#define XB_TOP      3328
#define XB_TOPGEN   3392
#define XCD_BAR_WORDS 3456
#define XB_SPIN_CAP (1u << 20)
__device__ __forceinline__ unsigned xb_ld(unsigned* p)              { return __hip_atomic_load(p, __ATOMIC_RELAXED, __HIP_MEMORY_SCOPE_AGENT); }
__device__ __forceinline__ unsigned xb_add(unsigned* p, unsigned v) { return __hip_atomic_fetch_add(p, v, __ATOMIC_RELAXED, __HIP_MEMORY_SCOPE_AGENT); }
__device__ __forceinline__ unsigned xb_xcc_id() { return (unsigned)__builtin_amdgcn_s_getreg((3 << 11) | 20) & 0xFu; }
#define XB_SPIN(cond, bar) do { unsigned _sp = 0; while (cond) { __builtin_amdgcn_s_sleep(1); \
    if ((++_sp & 255u) == 0u) { if (xb_ld(&(bar)[XB_TMO])) break; if (_sp > XB_SPIN_CAP) { atomicAdd(&(bar)[XB_TMO], 1u); break; } } } } while (0)
__device__ __forceinline__ void xcd_barrier_complete(unsigned* bar, unsigned x, unsigned& nloc, unsigned& nx) {
    const unsigned G = gridDim.x;
    unsigned sum, cnt, mine, sp = 0u;
    for (;;) {
        sum = 0u; cnt = 0u; mine = 0u;
#pragma unroll
        for (unsigned j = 0; j < 16; ++j) { const unsigned c = xb_ld(&bar[XB_XCNT(j)]); sum += c; cnt += (c > 0u) ? 1u : 0u; mine = (j == x) ? c : mine; }
        if (sum == G) break;
        __builtin_amdgcn_s_sleep(1);
        if ((++sp & 255u) == 0u) { if (xb_ld(&bar[XB_TMO])) break; if (sp > XB_SPIN_CAP) { atomicAdd(&bar[XB_TMO], 1u); break; } }
    }
    nloc = mine > 0u ? mine : 1u; nx = cnt > 0u ? cnt : 1u;
}
__device__ __forceinline__ void grid_bar(unsigned* bar, volatile LAS unsigned* st) {
    asm volatile("s_waitcnt vmcnt(0)" ::: "memory");
    __syncthreads();
    if (threadIdx.x == 0) {
        const unsigned x = xb_xcc_id();
        __builtin_amdgcn_s_waitcnt(0);
        unsigned nloc = st[0], nx = st[1];
        if (nloc == 0u) { xcd_barrier_complete(bar, x, nloc, nx); st[0] = nloc; st[1] = nx; }
        const unsigned old = xb_add(&bar[XB_XSUB(x)], 1u);
        const unsigned gen = old / nloc;
        if (old + 1u == (gen + 1u) * nloc) {
            __builtin_amdgcn_fence(__ATOMIC_RELEASE, "agent");
            asm volatile("s_waitcnt vmcnt(0)" ::: "memory");
            const unsigned og = xb_add(&bar[XB_TOP], 1u);
            const unsigned tg = og / nx;
            if (og + 1u == (tg + 1u) * nx) xb_add(&bar[XB_TOPGEN], 1u);
            else XB_SPIN(xb_ld(&bar[XB_TOPGEN]) == tg, bar);
            __builtin_amdgcn_fence(__ATOMIC_ACQUIRE, "agent");
            xb_add(&bar[XB_XGEN(x)], 1u);
            asm volatile("s_waitcnt vmcnt(0)" ::: "memory");
        } else {
            XB_SPIN(xb_ld(&bar[XB_XGEN(x)]) == gen, bar);
            __builtin_amdgcn_fence(__ATOMIC_ACQUIRE, "agent");
            asm volatile("s_waitcnt vmcnt(0)" ::: "memory");
        }
    }
    __syncthreads();
}
constexpr int NPH = 11;

__global__ void __launch_bounds__(NWAVES * 64, 2) mega_fwd(Args args) {
    extern __shared__ __attribute__((aligned(16))) unsigned char lds[];
    LAS unsigned char* ldsl = (LAS unsigned char*)lds;
    const int tid = threadIdx.x, lane = tid & 63, wave = __builtin_amdgcn_readfirstlane(tid >> 6);
    const int G = gridDim.x, bx = blockIdx.x;
    const int vcu = (G % 8 == 0) ? (bx % 8) * (G / 8) + bx / 8 : bx;
    const int gw = vcu * NWAVES + wave, NGW = G * NWAVES;
    unsigned char* ws = args.ws;
    const float* const* kin = (const float* const*)__builtin_amdgcn_kernarg_segment_ptr();
    const float* svec = (const float*)ws;
    const float* b_gate = svec + SV_BGATE; const float* q_a_norm_g = svec + SV_QAG; const float* kv_a_norm_g = svec + SV_KVAG; const float* q_norm_g = svec + SV_QNG;
    const float* k_norm_g = svec + SV_KNG; const float* pool_scale = svec + SV_PSC; const float* ffn_norm_g = svec + SV_FNG; const int* positions = (const int*)(svec + SV_POS);
    bf16* WIN_T = (bf16*)(ws + WS_WIN); bf16* WQB_T = (bf16*)(ws + WS_WQB); bf16* WKVB_T = (bf16*)(ws + WS_WKVB); bf16* WPG_T = (bf16*)(ws + WS_WPG);
    bf16* WPO_T = (bf16*)(ws + WS_WPO); bf16* WAO_T = (bf16*)(ws + WS_WAO); bf16* WOUT_T = (bf16*)(ws + WS_WOUT); bf16* WGU_T = (bf16*)(ws + WS_WGU); bf16* WDN_T = (bf16*)(ws + WS_WDN);
    bf16* XN = (bf16*)(ws + WS_XN); float* C1 = (float*)(ws + WS_C1); float* KRP = (float*)(ws + WS_KRP); bf16* U = (bf16*)(ws + WS_U); bf16* Gt = (bf16*)(ws + WS_G);
    bf16* CN = (bf16*)(ws + WS_CN); bf16* POOLED = (bf16*)(ws + WS_POOLED); bf16* Qb = (bf16*)(ws + WS_Q); bf16* Kb = (bf16*)(ws + WS_K); bf16* Vb = (bf16*)(ws + WS_V);
    bf16* PG = (bf16*)(ws + WS_PG); bf16* MP = (bf16*)(ws + WS_MP); bf16* Ob = (bf16*)(ws + WS_O); bf16* MIXED = (bf16*)(ws + WS_MIXED);
    float* X1 = (float*)(ws + WS_X1); bf16* H2 = (bf16*)(ws + WS_H2); bf16* ACT = (bf16*)(ws + WS_ACT);

    const int lo = args.ph_lo, hi_ph = args.ph_hi;
#ifndef PHMASK
#define PHMASK 0x7ff
#endif
#define IN(k) (((PHMASK >> (k)) & 1) && lo <= (k) && (k) < hi_ph)
#define SEAM(k) do { if (IN(k) && IN((k) + 1)) { unsigned char* w2_ = args.ws; asm volatile("" : "+s"(w2_)); grid_bar((unsigned*)(w2_ + WS_BAR), (volatile LAS unsigned*)(ldsl + 140032)); } } while (0)
    if (args.coop > 1) cg::this_grid().sync();
    if (threadIdx.x < 2) ((volatile LAS unsigned*)(ldsl + 140032))[threadIdx.x] = 0u;
    __syncthreads();
    if (args.coop && threadIdx.x == 0) { unsigned char* w2_ = args.ws; asm volatile("" : "+s"(w2_)); (void)xb_add(&((unsigned*)(w2_ + WS_BAR))[XB_XCNT(xb_xcc_id())], 1u); }
    LAS float* scr = (LAS float*)(ldsl + wave * 16384);
#ifdef TPROBE
#define TP_BEGIN(k) do { if ((TPROBE >> (k)) & 1) { if (blockIdx.x == 0 && threadIdx.x == 0) { *(volatile LAS unsigned*)(ldsl + 140000) = (unsigned)__builtin_amdgcn_s_memrealtime(); } } } while (0)
#define TP_END(k) do { if ((TPROBE >> (k)) & 1) { if (blockIdx.x == 0 && threadIdx.x == 0) { volatile LAS unsigned* tp_ = (volatile LAS unsigned*)(ldsl + 140000); tp_[1] += (unsigned)__builtin_amdgcn_s_memrealtime() - tp_[0]; } } } while (0)
    if (blockIdx.x == 0 && threadIdx.x == 0) { ((volatile LAS unsigned*)(ldsl + 140000))[1] = 0u; }
#else
#define TP_BEGIN(k) do {} while (0)
#define TP_END(k) do {} while (0)
#endif

    if (IN(0)) { TP_BEGIN(0);
        { float* sv = (float*)ws; const int gt = bx * (NWAVES * 64) + tid, GT = G * NWAVES * 64;
          for (int i = gt; i < M; i += GT) sv[SV_SS + i] = 0.f;
          for (int i = gt; i < SV_END; i += GT) { int idx, off, lim = 1 << 30;
              if (i < SV_QAG) { idx = 4; off = SV_BGATE; } else if (i < SV_KVAG) { idx = 5; off = SV_QAG; } else if (i < SV_QNG) { idx = 7; off = SV_KVAG; }
              else if (i < SV_KNG) { idx = 9; off = SV_QNG; lim = 192; } else if (i < SV_PSC) { idx = 10; off = SV_KNG; lim = 192; }
              else if (i < SV_FNG) { idx = 13; off = SV_PSC; } else if (i < SV_POS) { idx = 16; off = SV_FNG; } else { idx = 1; off = SV_POS; }
              const float* src = kin[idx]; sv[i] = (i - off < lim) ? src[i - off] : 0.f; } }
        constexpr int I_IN = (DM / 64) * (DIN / 32), I_QB = (QLORA / 64) * (NH * DQK / 32), I_KVB = (KVLORA / 64) * (NH * 256 / 32), I_PG = (256 / 64) * (256 / 32),
                      I_PO = (POOLW / 64) * (DM / 32), I_AO = (DM / 64) * (DM / 32), I_OUT = I_AO;
        constexpr int NITEMS = I_IN + I_QB + I_KVB + 4 * I_PG + I_PO + I_AO + I_OUT;
#define P0_DESC(it__) ([&]() { int r = (it__), idx, Kd, Nd, mode = 0, roff = 0; size_t dsto, srco = 0; \
            if (r < I_IN) { idx = 3; Kd = DM; Nd = DIN; mode = 1; dsto = WS_WIN; } \
            else if ((r -= I_IN) < I_QB) { idx = 6; Kd = QLORA; Nd = NH * DQK; dsto = WS_WQB; } \
            else if ((r -= I_QB) < I_KVB) { idx = 8; Kd = KVLORA; Nd = NH * 256; dsto = WS_WKVB; } \
            else if ((r -= I_KVB) < 4 * I_PG) { const int g = r / I_PG; r = r % I_PG; idx = 12; Kd = 256; Nd = 256; dsto = WS_WPG; roff = g * 256; srco = (size_t)g * 65536; } \
            else if ((r -= 4 * I_PG) < I_PO) { idx = 14; Kd = POOLW; Nd = DM; dsto = WS_WPO; } \
            else if ((r -= I_PO) < I_AO) { idx = 11; Kd = DM; Nd = DM; dsto = WS_WAO; } \
            else { r -= I_AO; idx = 15; Kd = DM; Nd = DM; dsto = WS_WOUT; } \
            return tr_desc(kin[idx] + srco, Kd, Nd, (bf16*)(ws + dsto), mode, roff, r, nullptr); }())
        TR_PIPELINE(gw, NITEMS, NGW, P0_DESC);
#undef P0_DESC
        { v4u* z = (v4u*)(WIN_T + (size_t)DIN * DM); const int nz = (DIN_PAD - DIN) * DM / 8;
          for (int i = gw * 64 + lane; i < nz; i += NGW * 64) z[i] = (v4u){0u, 0u, 0u, 0u}; }
        { const float* x = kin[0]; const float* attn_norm_g = kin[2];
          for (int m = gw; m < M; m += NGW) rms_row_2048(x + (size_t)m * DM, attn_norm_g, XN + (size_t)m * DM, lane); }
    TP_END(0); }
    SEAM(0);
    if (IN(1)) { TP_BEGIN(1);
        { pg8::Gemm g{XN, WIN_T, M, 6144, DM, DM, DM, 0, 0}; pg8::StaticOrder S; S.init(M, 6144, G, bx);
          pg8::EpiIn E{C1, U, Gt, b_gate};
          pg8::gemm_phase<pg8::EpiIn, pg8::StaticOrder>(ldsl, g, S, E); }
        { pg8::Gemm g{XN, WIN_T + (size_t)6144 * DM, M, 2048, 256, DM, DM, 256, 256}; pg8::StaticOrder S; S.init(M, 2048, G, bx);
          pg8::EpiKRP E{KRP};
          pg8::gemm_phase<pg8::EpiKRP, pg8::StaticOrder>(ldsl, g, S, E); }
    TP_END(1); }
    SEAM(1);
    if (IN(2)) { TP_BEGIN(2);
        for (int m = gw; m < M; m += NGW) {
            const f32x4* c = (const f32x4*)(C1 + (size_t)m * 1024) + lane; f32x4 v[4]; float sq = 0.f, skv = 0.f;
#pragma unroll
            for (int j = 0; j < 4; ++j) { v[j] = c[64 * j]; const float s = (v[j].x * v[j].x + v[j].y * v[j].y) + (v[j].z * v[j].z + v[j].w * v[j].w); if (j < 2) sq += s; else skv += s; }
            const float iq = 1.0f / sqrtf(wave_sum(sq) * (1.f / 512.f) + EPS), ikv = 1.0f / sqrtf(wave_sum(skv) * (1.f / 512.f) + EPS);
            v2u* o8 = (v2u*)(CN + (size_t)m * 1024) + lane;
#pragma unroll
            for (int j = 0; j < 4; ++j) { const f32x4 gv = (j < 2) ? ((const f32x4*)q_a_norm_g)[lane + 64 * j] : ((const f32x4*)kv_a_norm_g)[lane + 64 * (j - 2)]; const float iv = (j < 2) ? iq : ikv;
                v2u o; o.x = cvtpk(v[j].x * iv * gv.x, v[j].y * iv * gv.y); o.y = cvtpk(v[j].z * iv * gv.z, v[j].w * iv * gv.w); o8[64 * j] = o; }
        }
        for (int m = gw; m < M; m += NGW) {
            const int s = m & (SEQ - 1);
#pragma unroll
            for (int jj = 0; jj < 2; ++jj) {
                const int col = 8 * lane + 512 * jj, grp = col >> 8, w = 2 << grp; const int cnt = (s + 1 < w) ? s + 1 : w;
                float a[8]; float u0[8];
#pragma unroll
                for (int e = 0; e < 8; ++e) a[e] = 0.f;
#pragma unroll
                for (int d = 0; d < 16; ++d) {
                    if (d < cnt) { const v4u q = *(const v4u*)(U + (size_t)(m - d) * 1024 + col);
                        const float f[8] = {bflo(q.x), bfhi(q.x), bflo(q.y), bfhi(q.y), bflo(q.z), bfhi(q.z), bflo(q.w), bfhi(q.w)};
#pragma unroll
                        for (int e = 0; e < 8; ++e) { a[e] += f[e]; if (d == 0) u0[e] = f[e]; } }
                }
                const float rc = 1.0f / (float)cnt;
                v4u o; o.x = cvtpk(a[0] * rc - u0[0], a[1] * rc - u0[1]); o.y = cvtpk(a[2] * rc - u0[2], a[3] * rc - u0[3]);
                o.z = cvtpk(a[4] * rc - u0[4], a[5] * rc - u0[5]); o.w = cvtpk(a[6] * rc - u0[6], a[7] * rc - u0[7]);
                *(v4u*)(POOLED + (size_t)m * 1024 + col) = o;
            }
        }
    TP_END(2); }
    SEAM(2);
    if (IN(3)) { TP_BEGIN(3);
        { pg8::Gemm g{CN, WQB_T, M, NH * DQK, QLORA, 1024, QLORA, 0, 0}; pg8::StaticOrder S; S.init(M, NH * DQK, G, bx);
          pg8::EpiBf16 E{Qb, 3072}; pg8::gemm_phase<pg8::EpiBf16, pg8::StaticOrder>(ldsl, g, S, E); }
        { pg8::Gemm g{CN + 512, WKVB_T, M, NH * 256, KVLORA, 1024, KVLORA, 0, 0}; pg8::StaticOrder S; S.init(M, NH * 256, G, bx);
          pg8::EpiKV E{Kb, Vb}; pg8::gemm_phase<pg8::EpiKV, pg8::StaticOrder>(ldsl, g, S, E); }
        { pg8::Gemm g{POOLED, WPG_T, M, POOLW, 256, 1024, 256, 256, 0}; pg8::StaticOrder S; S.init(M, POOLW, G, (bx + 128) % G);
          pg8::EpiScale E{PG, 1024, pool_scale}; pg8::gemm_phase<pg8::EpiScale, pg8::StaticOrder>(ldsl, g, S, E); }
    TP_END(3); }
    SEAM(3);
    if (IN(4)) { TP_BEGIN(4);
        for (int m = gw; m < M; m += NGW) {
            const float pos = (float)positions[m];
            const int sub = lane & 3, h = lane >> 2;
            float cs[8], sn[8];
#pragma unroll
            for (int j = 0; j < 8; ++j) { const int i = 8 * sub + j; const float invf = __builtin_amdgcn_exp2f(-(float)i * (13.287712379549449f / 32.f));
                const float ang = pos * invf; const float k = rintf(ang * 0.15915494309189535f);
                float r = fmaf(-k, 6.2831854820251465f, ang); r = fmaf(-k, -1.7484555e-7f, r);
                sn[j] = __sinf(r); cs[j] = __cosf(r); }
#pragma unroll
            for (int which = 0; which < 2; ++which) {
                bf16* base = (which == 0 ? Qb : Kb) + (size_t)m * 3072 + h * DQK;
                const float* gn = (which == 0) ? q_norm_g : k_norm_g;
                float nv[32], rl[8], rh[8]; float ss = 0.f;
#pragma unroll
                for (int jj = 0; jj < 4; ++jj) { const v4u q = *(const v4u*)(base + 32 * sub + 8 * jj);
                    nv[8 * jj + 0] = bflo(q.x); nv[8 * jj + 1] = bfhi(q.x); nv[8 * jj + 2] = bflo(q.y); nv[8 * jj + 3] = bfhi(q.y);
                    nv[8 * jj + 4] = bflo(q.z); nv[8 * jj + 5] = bfhi(q.z); nv[8 * jj + 6] = bflo(q.w); nv[8 * jj + 7] = bfhi(q.w); }
                if (which == 0) {
                    const v4u a = *(const v4u*)(base + 128 + 8 * sub), b = *(const v4u*)(base + 160 + 8 * sub);
                    rl[0] = bflo(a.x); rl[1] = bfhi(a.x); rl[2] = bflo(a.y); rl[3] = bfhi(a.y); rl[4] = bflo(a.z); rl[5] = bfhi(a.z); rl[6] = bflo(a.w); rl[7] = bfhi(a.w);
                    rh[0] = bflo(b.x); rh[1] = bfhi(b.x); rh[2] = bflo(b.y); rh[3] = bfhi(b.y); rh[4] = bflo(b.z); rh[5] = bfhi(b.z); rh[6] = bflo(b.w); rh[7] = bfhi(b.w);
                } else {
                    f32x4 a0 = {0.f, 0.f, 0.f, 0.f}, a1 = a0, b0 = a0, b1 = a0;
#pragma unroll
                    for (int ks = 0; ks < 8; ++ks) { const float* kp = KRP + ((size_t)ks * 8192 + m) * 64 + 8 * sub;
                        a0 += *(const f32x4*)kp; a1 += *(const f32x4*)(kp + 4); b0 += *(const f32x4*)(kp + 32); b1 += *(const f32x4*)(kp + 36); }
                    rl[0] = a0.x; rl[1] = a0.y; rl[2] = a0.z; rl[3] = a0.w; rl[4] = a1.x; rl[5] = a1.y; rl[6] = a1.z; rl[7] = a1.w;
                    rh[0] = b0.x; rh[1] = b0.y; rh[2] = b0.z; rh[3] = b0.w; rh[4] = b1.x; rh[5] = b1.y; rh[6] = b1.z; rh[7] = b1.w;
                }
#pragma unroll
                for (int e = 0; e < 32; ++e) ss += nv[e] * nv[e];
#pragma unroll
                for (int e = 0; e < 8; ++e) ss += rl[e] * rl[e] + rh[e] * rh[e];
                ss += __shfl_xor(ss, 1); ss += __shfl_xor(ss, 2);
                const float inv = 1.0f / sqrtf(ss * (1.f / 192.f) + EPS);
#pragma unroll
                for (int jj = 0; jj < 4; ++jj) { const f32x4 g0 = *(const f32x4*)(gn + 32 * sub + 8 * jj), g1 = *(const f32x4*)(gn + 32 * sub + 8 * jj + 4);
                    v4u o; o.x = cvtpk(nv[8 * jj + 0] * inv * g0.x, nv[8 * jj + 1] * inv * g0.y); o.y = cvtpk(nv[8 * jj + 2] * inv * g0.z, nv[8 * jj + 3] * inv * g0.w);
                    o.z = cvtpk(nv[8 * jj + 4] * inv * g1.x, nv[8 * jj + 5] * inv * g1.y); o.w = cvtpk(nv[8 * jj + 6] * inv * g1.z, nv[8 * jj + 7] * inv * g1.w);
                    *(v4u*)(base + 32 * sub + 8 * jj) = o; }
                float ol[8], oh[8];
#pragma unroll
                for (int e = 0; e < 8; ++e) { const float a = rl[e] * inv * gn[128 + 8 * sub + e], b = rh[e] * inv * gn[160 + 8 * sub + e];
                    ol[e] = a * cs[e] - b * sn[e]; oh[e] = b * cs[e] + a * sn[e]; }
                v4u o1, o2; o1.x = cvtpk(ol[0], ol[1]); o1.y = cvtpk(ol[2], ol[3]); o1.z = cvtpk(ol[4], ol[5]); o1.w = cvtpk(ol[6], ol[7]);
                o2.x = cvtpk(oh[0], oh[1]); o2.y = cvtpk(oh[2], oh[3]); o2.z = cvtpk(oh[4], oh[5]); o2.w = cvtpk(oh[6], oh[7]);
                *(v4u*)(base + 128 + 8 * sub) = o1; *(v4u*)(base + 160 + 8 * sub) = o2;
            }
        }
        { pg8::Gemm g{PG, WPO_T, M, DM, POOLW, POOLW, POOLW, 0, 0}; pg8::StaticOrder S; S.init(M, DM, G, bx);
          pg8::EpiGate<false> E{MP, Gt, nullptr, 0}; pg8::gemm_phase<pg8::EpiGate<false>, pg8::StaticOrder>(ldsl, g, S, E); }
    TP_END(4); }
    SEAM(4);
    if (IN(5)) { TP_BEGIN(5);
        const int npair = BATCH * NH * 8;
        for (int p = vcu; p < npair; p += G) {
            const int bh = p >> 3, s = p & 7;
            att::attn_unit(bh / NH, bh % NH, 15 - s, Qb, Kb, Vb, Ob, (char*)lds);
            att::attn_unit(bh / NH, bh % NH, s, Qb, Kb, Vb, Ob, (char*)lds);
        }
    TP_END(5); }
    SEAM(5);
    if (IN(6)) { TP_BEGIN(6);
        pg8::Gemm g{Ob, WAO_T, M, DM, DM, DM, DM, 0, 0}; pg8::StaticOrder S; S.init(M, DM, G, bx);
        pg8::EpiGate<true> E{MIXED, Gt, MP, 2048}; pg8::gemm_phase<pg8::EpiGate<true>, pg8::StaticOrder>(ldsl, g, S, E);
    TP_END(6); }
    SEAM(6);
    if (IN(7)) { TP_BEGIN(7);
        { constexpr int I_G = (DM / 64) * (DFF / 32);
#define GU_DESC(it__) ((it__) < I_G ? tr_desc(kin[17], DM, DFF, (bf16*)(ws + WS_WGU), 2, 0, (it__), ffn_norm_g) : tr_desc(kin[18], DM, DFF, (bf16*)(ws + WS_WGU), 3, 0, (it__) - I_G, ffn_norm_g))
          TR_PIPELINE(gw, 2 * I_G, NGW, GU_DESC);
#undef GU_DESC
          __syncthreads(); }
        pg8::Gemm g{MIXED, WOUT_T, M, DM, DM, DM, DM, 0, 0}; pg8::StaticOrder S; S.init(M, DM, G, bx);
        pg8::EpiResNorm E{kin[0], X1, (bf16*)(ws + WS_X1B), (float*)ws + SV_SS, DM}; pg8::gemm_phase<pg8::EpiResNorm, pg8::StaticOrder>(ldsl, g, S, E);
    TP_END(7); }
    SEAM(7);
    if (IN(9)) { TP_BEGIN(9);
        pg8::Gemm g{(bf16*)(ws + WS_X1B), WGU_T, M, 2 * DFF, DM, DM, DM, 0, 0}; pg8::StaticOrder S; S.init(M, 2 * DFF, G, bx);
        pg8::EpiSwiGLU E{ACT, DFF, (const float*)ws + SV_SS}; pg8::gemm_phase<pg8::EpiSwiGLU, pg8::StaticOrder>(ldsl, g, S, E);
        if (G == 256 ? (bx >= 128) : true) {
            constexpr int I_D2 = (DFF / 64) * (DM / 32);
            const int nw = (G == 256) ? 128 * NWAVES : NGW, w0 = (G == 256) ? (bx - 128) * NWAVES + wave : gw;
#define DN_DESC(it__) tr_desc(kin[19], DFF, DM, (bf16*)(ws + WS_WDN), 0, 0, (it__), nullptr)
            TR_PIPELINE(w0, I_D2, nw, DN_DESC);
#undef DN_DESC
        }
    TP_END(9); }
    SEAM(9);
    if (IN(10)) { TP_BEGIN(10);
        pg8::Gemm g{ACT, WDN_T, M, DM, DFF, DFF, DFF, 0, 0}; pg8::StaticOrder S; S.init(M, DM, G, bx);
        pg8::EpiRes E{X1, args.out, DM}; pg8::gemm_phase<pg8::EpiRes, pg8::StaticOrder>(ldsl, g, S, E);
    TP_END(10); }
#ifdef TPROBE
    if (blockIdx.x == 0 && threadIdx.x == 0) { const unsigned w_ = 4u * ((volatile LAS unsigned*)(ldsl + 140000))[1]; const unsigned long long t0_ = __builtin_amdgcn_s_memrealtime(); while ((unsigned)(__builtin_amdgcn_s_memrealtime() - t0_) < w_) __builtin_amdgcn_s_sleep(8); }
#endif
#undef IN
#undef SEAM
}

extern "C" void kernel_launch(void* const* d_in, const int* in_sizes, int n_in, void* d_out, int out_size, void* d_ws, size_t ws_size, hipStream_t stream) {
    static int grid = 0;
    if (grid == 0) {
        if (n_in != 20 || out_size != M * DM || ws_size < WS_END) { fprintf(stderr, "kernel_launch: unexpected shapes (n_in %d, out %d, ws %zu)\n", n_in, out_size, ws_size); grid = -1; return; }
        int dev = 0, cus = 0, per_cu = 0;
        (void)hipGetDevice(&dev); (void)hipDeviceGetAttribute(&cus, hipDeviceAttributeMultiprocessorCount, dev);
        if (hipFuncSetAttribute((const void*)mega_fwd, hipFuncAttributeMaxDynamicSharedMemorySize, LDS_BYTES) != hipSuccess) { fprintf(stderr, "kernel_launch: hipFuncSetAttribute failed\n"); grid = -1; return; }
        if (hipOccupancyMaxActiveBlocksPerMultiprocessor(&per_cu, (const void*)mega_fwd, NWAVES * 64, LDS_BYTES) != hipSuccess || per_cu < 1) { fprintf(stderr, "kernel_launch: occupancy query says %d\n", per_cu); per_cu = 1; }
        (void)hipGetLastError();
        grid = cus > 0 ? cus : 256;
    }
    if (grid < 0) return;
    Args a{};
    for (int i = 0; i < 20; ++i) a.in[i] = (const float*)d_in[i];
    a.out = (float*)d_out; a.ws = (unsigned char*)d_ws;
    if (MK_N_LAUNCHES == 1) {
        a.ph_lo = 0; a.ph_hi = NPH; a.coop = 1;
        (void)hipMemsetAsync((char*)d_ws + WS_BAR, 0, 16384, stream);
        void* kargs[] = {&a};
        hipError_t e = hipLaunchCooperativeKernel((const void*)mega_fwd, dim3(grid), dim3(NWAVES * 64), kargs, LDS_BYTES, stream);
        if (e != hipSuccess) fprintf(stderr, "kernel_launch: cooperative launch failed: %s (grid %d)\n", hipGetErrorString(e), grid);
    } else {
        for (int p = 0; p < NPH; ++p) {
            a.ph_lo = p; a.ph_hi = p + 1;
            hipLaunchKernelGGL(mega_fwd, dim3(grid), dim3(NWAVES * 64), LDS_BYTES, stream, a);
        }
    }
}
```

```cpp
#include <hip/hip_runtime.h>
#include <hip/hip_cooperative_groups.h>
#include <cstdio>
#include <cstdint>
namespace cg = cooperative_groups;

#ifndef MK_N_LAUNCHES
#define MK_N_LAUNCHES 1
#endif

namespace pg8 {
#define PG8_LAS __attribute__((address_space(3)))
typedef unsigned short bf16_t;
typedef short bf16x8 __attribute__((ext_vector_type(8)));
typedef float f32x4 __attribute__((ext_vector_type(4)));
typedef unsigned u32x4 __attribute__((ext_vector_type(4)));
constexpr int BM = 256, BK = 64, HALF = 128, HTB = HALF * BK * 2, STAGE_BYTES = 8 * HTB, NXCD = 8, WGM = 8;

__host__ __device__ __forceinline__ int lds_byte(int r, int c) { const int st = (r >> 4) * 2 + (c >> 5), rr = r & 15, cc = c & 31, ob = rr * 64 + cc * 2; return st * 1024 + (ob ^ (((ob >> 9) & 1) << 5)); }
__host__ __device__ __forceinline__ void stage_rc(int b, int& R, int& C) { const int st = b / 1024, sb = b % 1024, swz = sb ^ (((sb >> 9) & 1) << 5); R = (st >> 1) * 16 + swz / 64; C = (st & 1) * 32 + (swz % 64) / 2; }
__host__ __device__ __forceinline__ int perm32(int rho) { const int n = rho >> 4, i = rho & 15; return 8 * (i >> 2) + 4 * n + (i & 3); }

struct Unit { int pm, pn; };
struct Gemm { const bf16_t* A; const bf16_t* Bt; int M, N, K, lda, ldb, a_pn_step, b_pn_step; };

struct StaticOrder {
    int nM, nN, nwg, G, c;
    __host__ __device__ void init(int M, int N, int G_, int c_) { nM = M / BM; nN = N / BM; nwg = nM * nN; G = G_; c = c_; }
    __host__ __device__ bool next(int i, Unit& u) const {
        const long L = (long)i * G + c; if (L >= nwg) return false;
        int wgid = (int)L; { const int q = nwg / NXCD, r = nwg % NXCD, xcd = wgid % NXCD, off = wgid / NXCD; wgid = (xcd < r ? xcd * (q + 1) : r * (q + 1) + (xcd - r) * q) + off; }
        const int nig = WGM * nN, gid = wgid / nig, fm = gid * WGM, gsz = (nM - fm) < WGM ? (nM - fm) : WGM;
        u.pm = fm + ((wgid % nig) % gsz); u.pn = (wgid % nig) / gsz; return true;
    }
};

typedef float f32x2_t_ __attribute__((ext_vector_type(2))); typedef __bf16 bf16x2_t_ __attribute__((ext_vector_type(2)));
__device__ __forceinline__ unsigned cvt_pk_bf16(float lo, float hi) { f32x2_t_ v = {lo, hi}; bf16x2_t_ b = __builtin_convertvector(v, bf16x2_t_); return __builtin_bit_cast(unsigned, b); }
__device__ __forceinline__ u32x4 pack8(f32x4 a, f32x4 b) { u32x4 w; w.x = cvt_pk_bf16(a[0], a[1]); w.y = cvt_pk_bf16(a[2], a[3]); w.z = cvt_pk_bf16(b[0], b[1]); w.w = cvt_pk_bf16(b[2], b[3]); return w; }
__device__ __forceinline__ void unpack8(u32x4 w, f32x4& a, f32x4& b) {
    a[0] = __uint_as_float(w.x << 16); a[1] = __uint_as_float(w.x & 0xffff0000u); a[2] = __uint_as_float(w.y << 16); a[3] = __uint_as_float(w.y & 0xffff0000u);
    b[0] = __uint_as_float(w.z << 16); b[1] = __uint_as_float(w.z & 0xffff0000u); b[2] = __uint_as_float(w.w << 16); b[3] = __uint_as_float(w.w & 0xffff0000u); }
__device__ __forceinline__ float sigmoidf_(float v) { return __builtin_amdgcn_rcpf(1.0f + __builtin_amdgcn_exp2f(-1.4426950408889634f * v)); }
__device__ __forceinline__ f32x4 sigmoid4(f32x4 v) { f32x4 o; o[0] = sigmoidf_(v[0]); o[1] = sigmoidf_(v[1]); o[2] = sigmoidf_(v[2]); o[3] = sigmoidf_(v[3]); return o; }

typedef f32x4 AccT[2][2][4][2];
#define EPI_LOOP_AM _Pragma("unroll") for (int ai = 0; ai < 2; ++ai) _Pragma("unroll") for (int m = 0; m < 4; ++m)
#define EPI_LOOP_B _Pragma("unroll") for (int bj = 0; bj < 2; ++bj)

struct EpiIn {
    static constexpr bool PERM = true;
    float* C1; bf16_t* U; bf16_t* G; const float* bgate;
    __device__ __forceinline__ void operator()(const AccT& acc, const Unit& u, int wr, int wc, int fr, int fq) const {
        const int row0 = u.pm * BM + wr * 64 + fr, pn = u.pn, cw = wc * 32 + 8 * fq;
        if (pn < 4) {
            EPI_LOOP_AM { float* rp = C1 + (size_t)(row0 + ai * HALF + m * 16) * 1024 + pn * 256 + cw;
                EPI_LOOP_B { *(f32x4*)(rp + bj * HALF) = acc[ai][bj][m][0]; *(f32x4*)(rp + bj * HALF + 4) = acc[ai][bj][m][1]; } }
        } else if (pn < 8) {
            EPI_LOOP_AM { bf16_t* rp = U + (size_t)(row0 + ai * HALF + m * 16) * 1024 + (pn - 4) * 256 + cw;
                EPI_LOOP_B { *(u32x4*)(rp + bj * HALF) = pack8(acc[ai][bj][m][0], acc[ai][bj][m][1]); } }
        } else {
            const int gc = (pn - 8) * 256 + cw; f32x4 bv[2][2];
            EPI_LOOP_B { bv[bj][0] = *(const f32x4*)(bgate + gc + bj * HALF); bv[bj][1] = *(const f32x4*)(bgate + gc + bj * HALF + 4); }
            EPI_LOOP_AM { bf16_t* rp = G + (size_t)(row0 + ai * HALF + m * 16) * 4096 + gc;
                EPI_LOOP_B { *(u32x4*)(rp + bj * HALF) = pack8(sigmoid4(acc[ai][bj][m][0] + bv[bj][0]), sigmoid4(acc[ai][bj][m][1] + bv[bj][1])); } }
        }
    }
};
struct EpiKRP {
    static constexpr bool PERM = true;
    float* KRP;
    __device__ __forceinline__ void operator()(const AccT& acc, const Unit& u, int wr, int wc, int fr, int fq) const {
        const int row0 = u.pm * BM + wr * 64 + fr, cw = wc * 32 + 8 * fq;
        if (wc < 2) { EPI_LOOP_AM { float* rp = KRP + ((size_t)u.pn * 8192 + (row0 + ai * HALF + m * 16)) * 64 + cw; *(f32x4*)rp = acc[ai][0][m][0]; *(f32x4*)(rp + 4) = acc[ai][0][m][1]; } }
    }
};
struct EpiBf16 {
    static constexpr bool PERM = true;
    bf16_t* O; int ldc;
    __device__ __forceinline__ void operator()(const AccT& acc, const Unit& u, int wr, int wc, int fr, int fq) const {
        const int row0 = u.pm * BM + wr * 64 + fr, col0 = u.pn * BM + wc * 32 + 8 * fq;
        EPI_LOOP_AM { bf16_t* rp = O + (size_t)(row0 + ai * HALF + m * 16) * ldc + col0;
            EPI_LOOP_B { *(u32x4*)(rp + bj * HALF) = pack8(acc[ai][bj][m][0], acc[ai][bj][m][1]); } }
    }
};
struct EpiKV {
    static constexpr bool PERM = true;
    bf16_t* K; bf16_t* V;
    __device__ __forceinline__ void operator()(const AccT& acc, const Unit& u, int wr, int wc, int fr, int fq) const {
        const int row0 = u.pm * BM + wr * 64 + fr, cw = wc * 32 + 8 * fq, h = u.pn;
        EPI_LOOP_AM { const size_t row = (size_t)(row0 + ai * HALF + m * 16);
            *(u32x4*)(K + row * 3072 + h * 192 + cw) = pack8(acc[ai][0][m][0], acc[ai][0][m][1]);
            *(u32x4*)(V + row * 2048 + h * 128 + cw) = pack8(acc[ai][1][m][0], acc[ai][1][m][1]); }
    }
};
struct EpiScale {
    static constexpr bool PERM = true;
    bf16_t* O; int ldc; const float* scale;
    __device__ __forceinline__ void operator()(const AccT& acc, const Unit& u, int wr, int wc, int fr, int fq) const {
        const int row0 = u.pm * BM + wr * 64 + fr, col0 = u.pn * BM + wc * 32 + 8 * fq; f32x4 sv[2][2];
        EPI_LOOP_B { sv[bj][0] = *(const f32x4*)(scale + col0 + bj * HALF); sv[bj][1] = *(const f32x4*)(scale + col0 + bj * HALF + 4); }
        EPI_LOOP_AM { bf16_t* rp = O + (size_t)(row0 + ai * HALF + m * 16) * ldc + col0;
            EPI_LOOP_B { *(u32x4*)(rp + bj * HALF) = pack8(acc[ai][bj][m][0] * sv[bj][0], acc[ai][bj][m][1] * sv[bj][1]); } }
    }
};
template <bool HAS_ADD> struct EpiGate {
    static constexpr bool PERM = true;
    bf16_t* O; const bf16_t* gate; const bf16_t* add; int gcol0;
    __device__ __forceinline__ void operator()(const AccT& acc, const Unit& u, int wr, int wc, int fr, int fq) const {
        const int row0 = u.pm * BM + wr * 64 + fr, col0 = u.pn * BM + wc * 32 + 8 * fq;
        EPI_LOOP_AM { const size_t row = (size_t)(row0 + ai * HALF + m * 16);
            EPI_LOOP_B { f32x4 g0, g1; unpack8(__builtin_nontemporal_load((const u32x4*)(gate + row * 4096 + gcol0 + col0 + bj * HALF)), g0, g1);
                f32x4 v0 = g0 * acc[ai][bj][m][0], v1 = g1 * acc[ai][bj][m][1];
                if (HAS_ADD) { f32x4 a0, a1; unpack8(__builtin_nontemporal_load((const u32x4*)(add + row * 2048 + col0 + bj * HALF)), a0, a1); v0 += a0; v1 += a1; }
                *(u32x4*)(O + row * 2048 + col0 + bj * HALF) = pack8(v0, v1); } }
    }
};
struct EpiRes {
    static constexpr bool PERM = false;
    const float* base; float* out; int ldc;
    __device__ __forceinline__ void operator()(const AccT& acc, const Unit& u, int wr, int wc, int fr, int fq) const {
        const int row0 = u.pm * BM + wr * 64 + fr, col0 = u.pn * BM + wc * 32 + 4 * fq;
        EPI_LOOP_AM { const size_t off = (size_t)(row0 + ai * HALF + m * 16) * ldc + col0;
            EPI_LOOP_B {
#pragma unroll
                for (int n = 0; n < 2; ++n) { const f32x4 b = __builtin_nontemporal_load((const f32x4*)(base + off + bj * HALF + n * 16)); __builtin_nontemporal_store(b + acc[ai][bj][m][n], (f32x4*)(out + off + bj * HALF + n * 16)); } } }
    }
};
struct EpiResNorm {
    static constexpr bool PERM = false;
    const float* base; float* out; bf16_t* outb; float* ss; int ldc;
    __device__ __forceinline__ void operator()(const AccT& acc, const Unit& u, int wr, int wc, int fr, int fq) const {
        const int row0 = u.pm * BM + wr * 64 + fr, col0 = u.pn * BM + wc * 32 + 4 * fq;
        EPI_LOOP_AM { const int row = row0 + ai * HALF + m * 16; const size_t off = (size_t)row * ldc + col0; float s = 0.f;
            EPI_LOOP_B {
#pragma unroll
                for (int n = 0; n < 2; ++n) { const f32x4 v = __builtin_nontemporal_load((const f32x4*)(base + off + bj * HALF + n * 16)) + acc[ai][bj][m][n]; *(f32x4*)(out + off + bj * HALF + n * 16) = v;
                    typedef unsigned u32x2_ __attribute__((ext_vector_type(2))); u32x2_ w; w.x = cvt_pk_bf16(v[0], v[1]); w.y = cvt_pk_bf16(v[2], v[3]); *(u32x2_*)(outb + off + bj * HALF + n * 16) = w;
                    s += (v[0] * v[0] + v[1] * v[1]) + (v[2] * v[2] + v[3] * v[3]); } }
            s += __shfl_xor(s, 16); s += __shfl_xor(s, 32);
            if (fq == 0) atomicAdd(ss + row, s); }
    }
};
struct EpiSwiGLU {
    static constexpr bool PERM = true;
    bf16_t* O; int ldc; const float* ss;
    __device__ __forceinline__ void operator()(const AccT& acc, const Unit& u, int wr, int wc, int fr, int fq) const {
        const int row0 = u.pm * BM + wr * 64 + fr, col0 = u.pn * HALF + wc * 32 + 8 * fq;
        EPI_LOOP_AM { const int row = row0 + ai * HALF + m * 16; bf16_t* rp = O + (size_t)row * ldc + col0;
            const float inv = 1.0f / sqrtf(ss[row] * (1.f / 2048.f) + 1e-6f);
            const f32x4 g0 = acc[ai][0][m][0] * inv, g1 = acc[ai][0][m][1] * inv;
            *(u32x4*)rp = pack8(g0 * sigmoid4(g0) * (acc[ai][1][m][0] * inv), g1 * sigmoid4(g1) * (acc[ai][1][m][1] * inv)); }
    }
};

template <class Epi, class Sched, bool ALIGN_EPI = true>
__device__ __forceinline__ void gemm_phase(PG8_LAS unsigned char* lds, const Gemm g, const Sched& S, const Epi& E) {
    const int tid = threadIdx.x, wid = __builtin_amdgcn_readfirstlane(tid >> 6), lane = tid & 63, wr = wid >> 2, wc = wid & 3, fr = lane & 15, fq = lane >> 4;
    const int K = g.K, nt = K / BK;
    unsigned voffA[2], voffB[2];
#pragma unroll
    for (int i = 0; i < 2; ++i) { int R, C; stage_rc(tid * 16 + i * 8192, R, C); const int Rb = Epi::PERM ? ((R & ~31) + perm32(R & 31)) : R;
        voffA[i] = (unsigned)(R * g.lda + C) * 2u; voffB[i] = (unsigned)(Rb * g.ldb + C) * 2u; }
    const size_t kstep = (size_t)(BK * 2);
    const size_t hstepA = (size_t)HALF * g.lda * 2, hstepB = (size_t)HALF * g.ldb * 2;
    const size_t tstepA = 2 * hstepA, tstepB = g.b_pn_step ? (size_t)g.b_pn_step * 2 : 2 * hstepB, pstepA = (size_t)g.a_pn_step * 2;
    const unsigned ldsw = (unsigned)wid * 1024u;
    const int aoff = lds_byte(wr * 64 + fr, fq * 8), boff = lds_byte(wc * 32 + fr, fq * 8);
#define PG8_SA(b, h) (((b) * 2 + (h)) * HTB)
#define PG8_SB(b, h) ((4 + (b) * 2 + (h)) * HTB)
#define PG8_STAGE(bufoff, gbase, voff) do { _Pragma("unroll") for (int _i = 0; _i < 2; ++_i) \
        __builtin_amdgcn_global_load_lds((const unsigned*)((const char*)(gbase) + (voff)[_i]), (PG8_LAS unsigned*)(lds + (bufoff) + ldsw + _i * 8192), 16, 0, 0); } while (0)
#define PG8_LDA(dst, b, h) do { _Pragma("unroll") for (int m = 0; m < 4; ++m) _Pragma("unroll") for (int k = 0; k < 2; ++k) dst[m][k] = *(const PG8_LAS bf16x8*)(lds + PG8_SA(b, h) + aoff + m * 2048 + k * 1024); } while (0)
#define PG8_LDB(dst, b, h) do { _Pragma("unroll") for (int n = 0; n < 2; ++n) _Pragma("unroll") for (int k = 0; k < 2; ++k) dst[n][k] = *(const PG8_LAS bf16x8*)(lds + PG8_SB(b, h) + boff + n * 2048 + k * 1024); } while (0)
#define PG8_MMA(ai, bj, At, Bt) do { __builtin_amdgcn_s_setprio(1); _Pragma("unroll") for (int m = 0; m < 4; ++m) _Pragma("unroll") for (int n = 0; n < 2; ++n) _Pragma("unroll") for (int k = 0; k < 2; ++k) \
        acc[ai][bj][m][n] = __builtin_amdgcn_mfma_f32_16x16x32_bf16(Bt[n][k], At[m][k], acc[ai][bj][m][n], 0, 0, 0); __builtin_amdgcn_s_setprio(0); } while (0)
#define PG8_WAIT_V(n) asm volatile("s_waitcnt vmcnt(" #n ")" ::: "memory")
#define PG8_WAIT_L(n) asm volatile("s_waitcnt lgkmcnt(" #n ")" ::: "memory")
#define PG8_BAR __builtin_amdgcn_s_barrier()
#define PG8_SCHED __builtin_amdgcn_sched_barrier(0)
    Unit cur, nxt; int ui = 0;
    if (!S.next(0, cur)) return;
    f32x4 acc[2][2][4][2];
#pragma unroll
    for (int a = 0; a < 2; ++a)
#pragma unroll
        for (int b = 0; b < 2; ++b)
#pragma unroll
            for (int m = 0; m < 4; ++m)
#pragma unroll
                for (int n = 0; n < 2; ++n) acc[a][b][m][n] = (f32x4){0.f, 0.f, 0.f, 0.f};
    bf16x8 At[4][2], B0[2][2], B1[2][2];
    const char* cA = (const char*)g.A + (size_t)cur.pm * tstepA + (size_t)cur.pn * pstepA; const char* cB = (const char*)g.Bt + (size_t)cur.pn * tstepB;
    PG8_STAGE(PG8_SB(0, 0), cB, voffB); PG8_STAGE(PG8_SB(0, 1), cB + hstepB, voffB); PG8_STAGE(PG8_SA(0, 0), cA, voffA); PG8_STAGE(PG8_SA(0, 1), cA + hstepA, voffA);
    if (wr == 1) PG8_BAR;
    PG8_WAIT_V(2); PG8_BAR;
    PG8_STAGE(PG8_SB(1, 0), cB + kstep, voffB); PG8_STAGE(PG8_SA(1, 0), cA + kstep, voffA); PG8_STAGE(PG8_SB(1, 1), cB + hstepB + kstep, voffB);
    PG8_WAIT_V(6); PG8_BAR;
    for (;;) {
        const bool has_next = S.next(ui + 1, nxt);
        const char* nA = has_next ? (const char*)g.A + (size_t)nxt.pm * tstepA + (size_t)nxt.pn * pstepA : cA; const char* nB = has_next ? (const char*)g.Bt + (size_t)nxt.pn * tstepB : cB;
        for (int t = 0; t < nt; t += 2) {
            const bool last = (t == nt - 2);
            const char* a1 = cA + (size_t)(t + 1) * kstep;
            const char* a2 = last ? nA : cA + (size_t)(t + 2) * kstep; const char* b2 = last ? nB : cB + (size_t)(t + 2) * kstep;
            const char* a3 = a2 + kstep; const char* b3 = b2 + kstep;
            PG8_LDB(B0, 0, 0); PG8_LDB(B1, 0, 1); PG8_SCHED; PG8_LDA(At, 0, 0); PG8_STAGE(PG8_SA(1, 1), a1 + hstepA, voffA);
            PG8_WAIT_V(8); PG8_WAIT_L(0); PG8_BAR; PG8_MMA(0, 0, At, B0); PG8_MMA(0, 1, At, B1); PG8_BAR; PG8_SCHED;
            PG8_LDA(At, 0, 1); PG8_STAGE(PG8_SB(0, 0), b2, voffB); PG8_STAGE(PG8_SB(0, 1), b2 + hstepB, voffB); PG8_STAGE(PG8_SA(0, 0), a2, voffA);
            PG8_WAIT_V(8); PG8_WAIT_L(0); PG8_BAR; PG8_MMA(1, 0, At, B0); PG8_MMA(1, 1, At, B1); PG8_BAR; PG8_SCHED;
            PG8_LDB(B0, 1, 0); PG8_LDB(B1, 1, 1); PG8_SCHED; PG8_LDA(At, 1, 0); PG8_STAGE(PG8_SA(0, 1), a2 + hstepA, voffA);
            PG8_WAIT_V(8); PG8_WAIT_L(0); PG8_BAR; PG8_MMA(0, 0, At, B0); PG8_MMA(0, 1, At, B1); PG8_BAR; PG8_SCHED;
            PG8_LDA(At, 1, 1); PG8_STAGE(PG8_SB(1, 0), b3, voffB); PG8_STAGE(PG8_SB(1, 1), b3 + hstepB, voffB); PG8_STAGE(PG8_SA(1, 0), a3, voffA);
            PG8_WAIT_V(8); PG8_WAIT_L(0); PG8_BAR; PG8_MMA(1, 0, At, B0); PG8_MMA(1, 1, At, B1); PG8_BAR; PG8_SCHED;
        }
        if constexpr (ALIGN_EPI) { if (wr == 0) PG8_BAR; }
        E(acc, cur, wr, wc, fr, fq);
        if (!has_next) break;
#pragma unroll
        for (int a = 0; a < 2; ++a)
#pragma unroll
            for (int b = 0; b < 2; ++b)
#pragma unroll
                for (int m = 0; m < 4; ++m)
#pragma unroll
                    for (int n = 0; n < 2; ++n) acc[a][b][m][n] = (f32x4){0.f, 0.f, 0.f, 0.f};
        cur = nxt; cA = nA; cB = nB; ++ui;
        if constexpr (ALIGN_EPI) { if (wr == 1) PG8_BAR; }
    }
    PG8_WAIT_V(0);
    if constexpr (!ALIGN_EPI) { if (wr == 0) PG8_BAR; }
    PG8_BAR;
#undef PG8_SA
#undef PG8_SB
#undef PG8_STAGE
#undef PG8_LDA
#undef PG8_LDB
#undef PG8_MMA
#undef PG8_WAIT_V
#undef PG8_WAIT_L
#undef PG8_BAR
#undef PG8_SCHED
}
}

constexpr int BATCH = 2, SEQ = 4096, DM = 2048, M = BATCH * SEQ;
constexpr int NH = 16, DQK = 192, DNOPE = 128, DROPE = 64, DV = 128, QLORA = 512, KVLORA = 512;
constexpr int POOLW = 1024, DIN = 6208, DIN_PAD = 6400, DFF = 5632;
constexpr float EPS = 1e-6f;
constexpr int NWAVES = 8;

typedef unsigned short bf16;
typedef unsigned v4u __attribute__((ext_vector_type(4)));
typedef unsigned v2u __attribute__((ext_vector_type(2)));
typedef float f32x4 __attribute__((ext_vector_type(4)));
typedef short bf16x8 __attribute__((ext_vector_type(8)));
typedef short s16x4 __attribute__((ext_vector_type(4)));
typedef float f32x16 __attribute__((ext_vector_type(16)));
#define LAS __attribute__((address_space(3)))
#define LDS_WAIT() asm volatile("s_waitcnt lgkmcnt(0)" ::: "memory")

constexpr size_t MiB = 1u << 20;
constexpr size_t WS_WAO = 1 * MiB, WS_WOUT = 9 * MiB, WS_WPO = 17 * MiB, WS_WQB = 21 * MiB, WS_WKVB = 24 * MiB, WS_WPG = 28 * MiB, WS_KR = 29 * MiB;
constexpr size_t WS_G = 31 * MiB;
constexpr size_t WS_WIN = 95 * MiB, WS_XN = 120 * MiB, WS_C1 = 152 * MiB, WS_U = 184 * MiB;
constexpr size_t WS_Q = 95 * MiB, WS_K = 143 * MiB, WS_V = 191 * MiB, WS_CN = 223 * MiB, WS_POOLED = 239 * MiB, WS_PG = 255 * MiB;
constexpr size_t WS_MP = 223 * MiB, WS_O = 255 * MiB, WS_MIXED = 95 * MiB, WS_X1 = 127 * MiB, WS_H2 = 95 * MiB;
constexpr size_t WS_WGU = 191 * MiB, WS_WDN = 235 * MiB, WS_ACT = 1 * MiB;
constexpr size_t WS_END = 296 * MiB, WS_BAR = 512 * 1024, WS_KRP = 272 * MiB, WS_X1B = 257 * MiB;
constexpr int SV_BGATE = 0, SV_QAG = 4096, SV_KVAG = 4608, SV_QNG = 5120, SV_KNG = 5376, SV_PSC = 5632, SV_FNG = 6656, SV_POS = 8704, SV_END = 8704 + 8192, SV_SS = 32768;

constexpr int LDS_BYTES = 147456;

__device__ __forceinline__ unsigned cvtpk(float lo, float hi) { return pg8::cvt_pk_bf16(lo, hi); }
__device__ __forceinline__ float bflo(unsigned w) { return __uint_as_float(w << 16); }
__device__ __forceinline__ float bfhi(unsigned w) { return __uint_as_float(w & 0xffff0000u); }
__device__ __forceinline__ float wave_sum(float v) {
#pragma unroll
    for (int o = 1; o < 64; o <<= 1) v += __shfl_xor(v, o);
    return v;
}

__device__ __forceinline__ int dst_row(int mode, int n0) {
    if (mode == 1) { if (n0 < 1024) return n0; if (n0 < 1088) return 6144 + (n0 - 1024); if (n0 < 2112) return 1024 + (n0 - 1088); return 2048 + (n0 - 2112); }
    if (mode == 2) return (n0 >> 7) * 256 + (n0 & 127);
    if (mode == 3) return (n0 >> 7) * 256 + 128 + (n0 & 127);
    return n0;
}
__device__ __forceinline__ void transpose_item(const float* W, int K, int N, bf16* WT, int mode, int row_off, LAS float* scr, int item, int lane, const float* gk = nullptr) {
    const int nblk = N / 32, kb = item / nblk, nb = item % nblk, k0 = 64 * kb, n0 = 32 * nb;
    { float tv[32]; const float* wp = W + (size_t)(k0 + (lane >> 5)) * N + n0 + (lane & 31);
#pragma unroll
      for (int i = 0; i < 32; ++i) tv[i] = wp[(size_t)(2 * i) * N];
      if (gk) {
#pragma unroll
          for (int i = 0; i < 32; ++i) tv[i] *= gk[k0 + 2 * i + (lane >> 5)]; }
#pragma unroll
      for (int i = 0; i < 32; ++i) scr[(2 * i + (lane >> 5)) * 33 + (lane & 31)] = tv[i]; }
    LDS_WAIT(); asm volatile("" ::: "memory");
    const int c = lane & 7, dr = row_off + dst_row(mode, n0);
#pragma unroll
    for (int j = 0; j < 4; ++j) { const int n = (lane >> 3) + 8 * j; const LAS float* s = scr + (8 * c) * 33 + n;
        v4u o; o.x = cvtpk(s[0 * 33], s[1 * 33]); o.y = cvtpk(s[2 * 33], s[3 * 33]); o.z = cvtpk(s[4 * 33], s[5 * 33]); o.w = cvtpk(s[6 * 33], s[7 * 33]);
        *(v4u*)(WT + (size_t)(dr + n) * K + k0 + 8 * c) = o; }
    LDS_WAIT(); asm volatile("" ::: "memory");
}

struct TrDesc { const float* W; bf16* WT; const float* gk; int K, N, k0, n0, dr; };
__device__ __forceinline__ TrDesc tr_desc(const float* W, int K, int N, bf16* WT, int mode, int row_off, int item, const float* gk) {
    const int nblk = N / 32, kb = item / nblk, nb = item % nblk; TrDesc d; d.W = W; d.WT = WT; d.gk = gk; d.K = K; d.N = N; d.k0 = 64 * kb; d.n0 = 32 * nb; d.dr = row_off + dst_row(mode, d.n0); return d; }
__device__ __forceinline__ void tr_load(const TrDesc& d, float (&tv)[32], int lane) {
    const float* wp = d.W + (size_t)(d.k0 + (lane >> 5)) * d.N + d.n0 + (lane & 31);
#pragma unroll
    for (int i = 0; i < 32; ++i) tv[i] = __builtin_nontemporal_load(wp + (size_t)(2 * i) * d.N);
}
__device__ __forceinline__ void tr_finish(const TrDesc& d, float (&tv)[32], LAS float* scr, int lane) {
    if (d.gk) {
#pragma unroll
        for (int i = 0; i < 32; ++i) tv[i] *= d.gk[d.k0 + 2 * i + (lane >> 5)]; }
#pragma unroll
    for (int i = 0; i < 32; ++i) scr[(2 * i + (lane >> 5)) * 33 + (lane & 31)] = tv[i];
    LDS_WAIT(); asm volatile("" ::: "memory");
    const int c = lane & 7;
#pragma unroll
    for (int j = 0; j < 4; ++j) { const int n = (lane >> 3) + 8 * j; const LAS float* s_ = scr + (8 * c) * 33 + n;
        v4u o; o.x = cvtpk(s_[0 * 33], s_[1 * 33]); o.y = cvtpk(s_[2 * 33], s_[3 * 33]); o.z = cvtpk(s_[4 * 33], s_[5 * 33]); o.w = cvtpk(s_[6 * 33], s_[7 * 33]);
        *(v4u*)(d.WT + (size_t)(d.dr + n) * d.K + d.k0 + 8 * c) = o; }
    LDS_WAIT(); asm volatile("" ::: "memory");
}
#define TR_PIPELINE(FIRST, LIMIT, STRIDE, MAKE_DESC) do { int it_ = (FIRST); if (it_ < (LIMIT)) { TrDesc dA_ = MAKE_DESC(it_); float tvA_[32]; tr_load(dA_, tvA_, lane); \
        for (;;) { const int nx_ = it_ + (STRIDE); const bool more_ = nx_ < (LIMIT); TrDesc dB_ = dA_; float tvB_[32]; \
            if (more_) { dB_ = MAKE_DESC(nx_); tr_load(dB_, tvB_, lane); } \
            tr_finish(dA_, tvA_, scr, lane); if (!more_) break; \
            dA_ = dB_; _Pragma("unroll") for (int i_ = 0; i_ < 32; ++i_) tvA_[i_] = tvB_[i_]; it_ = nx_; } } } while (0)

__device__ __forceinline__ void rms_row_2048(const float* xrow, const float* g, bf16* orow, int lane) {
    const f32x4* xr = (const f32x4*)xrow + lane; const f32x4* gr = (const f32x4*)g + lane;
    f32x4 v[8]; float s = 0.f;
#pragma unroll
    for (int j = 0; j < 8; ++j) { v[j] = __builtin_nontemporal_load(xr + 64 * j); s += (v[j].x * v[j].x + v[j].y * v[j].y) + (v[j].z * v[j].z + v[j].w * v[j].w); }
    const float inv = 1.0f / sqrtf(wave_sum(s) * (1.f / 2048.f) + EPS);
    v2u* o8 = (v2u*)orow + lane;
#pragma unroll
    for (int j = 0; j < 8; ++j) { const f32x4 gv = gr[64 * j]; v2u o; o.x = cvtpk(v[j].x * inv * gv.x, v[j].y * inv * gv.y); o.y = cvtpk(v[j].z * inv * gv.z, v[j].w * inv * gv.w); o8[64 * j] = o; }
}

namespace att {
constexpr int QBLK = 32, KVBLK = 64, QB = 256;
constexpr int SHM_V = KVBLK * DV * 2, SHM_K = KVBLK * DQK * 2;
constexpr int OFF_V = 0, OFF_K = 3 * SHM_V, OFF_WS = OFF_K + 2 * SHM_K;
constexpr float SCALE = 0.07216878364870322f;
constexpr float THR = 8.f;
#define KSWZ(row, colB) ((row) * 384 + ((colB) ^ (((row) & 7) << 4)))
#define SBAR() __builtin_amdgcn_sched_barrier(0)
__device__ __forceinline__ int v_st(int k, int c) { const int kk = (k & ~0xC) | ((k & 4) << 1) | ((k & 8) >> 1); return ((kk >> 3) * 4 + (c >> 5)) * 512 + ((kk & 7) * 32 + (c & 31)) * 2; }
__device__ __forceinline__ int v_rd_base(int lane) { return ((lane & 3) << 3) | (((lane >> 2) & 3) << 6) | (((lane >> 4) & 1) << 5) | (((lane >> 5) & 1) << 8); }
__device__ __forceinline__ int crow(int r, int hi) { return (r & 3) + 8 * (r >> 2) + 4 * hi; }
__device__ __forceinline__ void mask_tile(f32x16& p0, f32x16& p1, int dq) {
    const float NEG = -__builtin_inff();
#pragma unroll
    for (int r = 0; r < 16; ++r) {
        const int c = (r & 3) + 8 * (r >> 2);
        if (dq - c < 0) p0[r] = NEG;
        if (dq - c - 32 < 0) p1[r] = NEG;
    }
}
__device__ __forceinline__ void partialSM(f32x16& p0, f32x16& p1, float& m_reg, float& mn, float& alpha) {
    float pmax = p0[0];
#pragma unroll
    for (int r = 1; r < 16; ++r) pmax = fmaxf(pmax, p0[r]);
#pragma unroll
    for (int r = 0; r < 16; ++r) pmax = fmaxf(pmax, p1[r]);
    { auto rr = __builtin_amdgcn_permlane32_swap(__float_as_uint(pmax), __float_as_uint(pmax), false, false);
      pmax = fmaxf(__uint_as_float(rr[0]), __uint_as_float(rr[1])); }
    constexpr float C2 = 1.4426950408889634f * SCALE;
    if (__builtin_expect(__all((pmax - m_reg) * SCALE <= THR), 1)) { mn = m_reg; alpha = 1.f; }
    else { mn = fmaxf(m_reg, pmax); alpha = __builtin_amdgcn_exp2f((m_reg - mn) * C2); m_reg = mn; }
    const float mnL = -mn * C2;
#pragma unroll
    for (int r = 0; r < 16; ++r) p0[r] = fmaf(p0[r], C2, mnL);
#pragma unroll
    for (int r = 0; r < 16; ++r) p1[r] = fmaf(p1[r], C2, mnL);
#pragma unroll
    for (int r = 0; r < 16; ++r) p0[r] = __builtin_amdgcn_exp2f(p0[r]);
}
__device__ __forceinline__ void finishSM(f32x16& p0, f32x16& p1, float alpha, float& l_reg, bf16x8& pa0, bf16x8& pa1, bf16x8& pa2, bf16x8& pa3) {
#pragma unroll
    for (int r = 0; r < 16; ++r) p1[r] = __builtin_amdgcn_exp2f(p1[r]);
    float ps = 0;
#pragma unroll
    for (int r = 0; r < 16; ++r) ps += p0[r];
#pragma unroll
    for (int r = 0; r < 16; ++r) ps += p1[r];
    { auto rr = __builtin_amdgcn_permlane32_swap(__float_as_uint(ps), __float_as_uint(ps), false, false);
      ps = __uint_as_float(rr[0]) + __uint_as_float(rr[1]); }
    l_reg = l_reg * alpha + ps;
#define PK4(P, B_, OUT) do { unsigned a0 = cvtpk(P[B_+0], P[B_+1]), a1 = cvtpk(P[B_+2], P[B_+3]);                          \
        unsigned b0 = cvtpk(P[B_+4], P[B_+5]), b1 = cvtpk(P[B_+6], P[B_+7]);                                             \
        auto r0 = __builtin_amdgcn_permlane32_swap(a0, b0, false, false); auto r1 = __builtin_amdgcn_permlane32_swap(a1, b1, false, false); \
        v4u w = {r0[0], r1[0], r0[1], r1[1]}; OUT = *reinterpret_cast<bf16x8*>(&w); } while (0)
    PK4(p0, 0, pa0); PK4(p0, 8, pa1); PK4(p1, 0, pa2); PK4(p1, 8, pa3);
#undef PK4
}
__device__ __forceinline__ void qkt(f32x16& p0, f32x16& p1, const char* Kb, int r32, int hi, const bf16x8* qr) {
    p0 = f32x16{}; p1 = f32x16{};
    const char* kb[4];
#pragma unroll
    for (int dd = 0; dd < 4; ++dd) kb[dd] = Kb + KSWZ(r32, (dd * 16 + hi * 8) * 2);
#pragma unroll
    for (int g = 0; g < 2; ++g) { bf16x8 b0[6], b1[6];
#pragma unroll
        for (int i = 0; i < 6; ++i) { const int d0 = 6 * g + i; const char* a = kb[d0 & 3] + (d0 >> 2) * 128; b0[i] = *reinterpret_cast<const bf16x8*>(a); b1[i] = *reinterpret_cast<const bf16x8*>(a + 32 * 384); }
        SBAR();
        __builtin_amdgcn_s_setprio(1);
#pragma unroll
        for (int i = 0; i < 6; ++i) { p0 = __builtin_amdgcn_mfma_f32_32x32x16_bf16(b0[i], qr[6 * g + i], p0, 0, 0, 0); p1 = __builtin_amdgcn_mfma_f32_32x32x16_bf16(b1[i], qr[6 * g + i], p1, 0, 0, 0); }
        __builtin_amdgcn_s_setprio(0);
        SBAR(); }
}
__device__ __forceinline__ void pv_tile(f32x16* o, int vb0, bf16x8 pa0, bf16x8 pa1, bf16x8 pa2, bf16x8 pa3) {
#define TRRD(dst, off) asm volatile("ds_read_b64_tr_b16 %0, %1 offset:%2" : "=&v"(dst) : "v"(vb0), "i"(off) : "memory")
#define PV_RD(S, d0) do { constexpr int b_ = (d0) * 512; TRRD(S##l0, b_); TRRD(S##h0, b_ + 2048); TRRD(S##l1, b_ + 4096); TRRD(S##h1, b_ + 6144); TRRD(S##l2, b_ + 8192); TRRD(S##h2, b_ + 10240); TRRD(S##l3, b_ + 12288); TRRD(S##h3, b_ + 14336); } while (0)
#define PV_MM(S, d0) do { \
        o[d0] = __builtin_amdgcn_mfma_f32_32x32x16_bf16(pa0, (bf16x8){S##l0[0], S##l0[1], S##l0[2], S##l0[3], S##h0[0], S##h0[1], S##h0[2], S##h0[3]}, o[d0], 0, 0, 0);   \
        o[d0] = __builtin_amdgcn_mfma_f32_32x32x16_bf16(pa1, (bf16x8){S##l1[0], S##l1[1], S##l1[2], S##l1[3], S##h1[0], S##h1[1], S##h1[2], S##h1[3]}, o[d0], 0, 0, 0);   \
        o[d0] = __builtin_amdgcn_mfma_f32_32x32x16_bf16(pa2, (bf16x8){S##l2[0], S##l2[1], S##l2[2], S##l2[3], S##h2[0], S##h2[1], S##h2[2], S##h2[3]}, o[d0], 0, 0, 0);   \
        o[d0] = __builtin_amdgcn_mfma_f32_32x32x16_bf16(pa3, (bf16x8){S##l3[0], S##l3[1], S##l3[2], S##l3[3], S##h3[0], S##h3[1], S##h3[2], S##h3[3]}, o[d0], 0, 0, 0); } while (0)
    s16x4 Al0, Al1, Al2, Al3, Ah0, Ah1, Ah2, Ah3, Bl0, Bl1, Bl2, Bl3, Bh0, Bh1, Bh2, Bh3;
    PV_RD(A, 0); PV_RD(B, 1);
    asm volatile("s_waitcnt lgkmcnt(8)" ::: "memory"); SBAR(); PV_MM(A, 0); SBAR();
    PV_RD(A, 2);
    asm volatile("s_waitcnt lgkmcnt(8)" ::: "memory"); SBAR(); PV_MM(B, 1); SBAR();
    PV_RD(B, 3);
    asm volatile("s_waitcnt lgkmcnt(8)" ::: "memory"); SBAR(); PV_MM(A, 2); SBAR();
    asm volatile("s_waitcnt lgkmcnt(0)" ::: "memory"); SBAR(); PV_MM(B, 3);
#undef PV_MM
#undef PV_RD
#undef TRRD
}
__device__ __forceinline__ void attn_unit(int b, int h, int qb, const bf16* Q, const bf16* K, const bf16* V, bf16* O, char* lds) {
    const int tid = threadIdx.x, wid = __builtin_amdgcn_readfirstlane(tid >> 6), lane = tid & 63, r32 = lane & 31, hi = lane >> 5;
    const size_t rowb = (size_t)b * SEQ;
    const int q0 = qb * QB, qlo = q0 + wid * QBLK;
    const int NT = (q0 + QB) / KVBLK;
    char* V_lds = lds + OFF_V; char* K_lds = lds + OFF_K;
#define WAVE_WS() ({ int t_ = (int)threadIdx.x; asm volatile("" : "+v"(t_)); (float*)(lds + OFF_WS) + (t_ >> 6) * 64; })
    LAS unsigned char* ldsl_ = (LAS unsigned char*)lds;
    unsigned ksrc[3], vsrc[2];
#pragma unroll
    for (int j = 0; j < 3; ++j) { const int s_ = (wid * 3 + j) * 64 + lane, row = s_ / 24, pc = s_ % 24; ksrc[j] = (unsigned)(row * 3072 * 2 + ((pc * 16) ^ ((row & 7) << 4))); }
#pragma unroll
    for (int j = 0; j < 2; ++j) { const int ob = ((wid * 2 + j) * 64 + lane) * 16, st = ob >> 9, kr_ = (ob >> 6) & 7, ch = (ob >> 4) & 3, c = (st & 3) * 32 + ch * 8, kk = (st >> 2) * 8 + kr_,
                                  k = (kk & ~0xC) | ((kk & 4) << 1) | ((kk & 8) >> 1); vsrc[j] = (unsigned)(k * 2048 * 2 + c * 2); }
    const char* Kh = (const char*)(K + rowb * 3072 + h * DQK); const char* Vh = (const char*)(V + rowb * 2048 + h * DV);
#define KDMA(k0, bf) do { _Pragma("unroll") for (int j = 0; j < 3; ++j) __builtin_amdgcn_global_load_lds((const unsigned*)(Kh + (size_t)(k0) * (3072 * 2) + ksrc[j]), \
        (LAS unsigned*)(ldsl_ + OFF_K + (bf) * SHM_K + (wid * 3 + j) * 1024), 16, 0, 0); } while (0)
#define VDMA(k0, sl) do { _Pragma("unroll") for (int j = 0; j < 2; ++j) __builtin_amdgcn_global_load_lds((const unsigned*)(Vh + (size_t)(k0) * (2048 * 2) + vsrc[j]), \
        (LAS unsigned*)(ldsl_ + OFF_V + (sl) * SHM_V + (wid * 2 + j) * 1024), 16, 0, 0); } while (0)
    KDMA(0, 0); VDMA(0, 0);
    bf16x8 qr[12];
    { const bf16* Qp = Q + (rowb + qlo + r32) * 3072 + h * DQK + hi * 8;
#pragma unroll
      for (int d0 = 0; d0 < 12; ++d0) qr[d0] = *(const bf16x8*)(Qp + d0 * 16); }
    asm volatile("s_waitcnt vmcnt(0)" ::: "memory");
    __syncthreads();
    float m_reg = -1e30f, l_reg = 0.f; f32x16 o[4] = {};
    const int vbase = (int)(uintptr_t)V_lds + v_rd_base(lane);
    const int qm = qlo + r32 - 4 * hi;
    f32x16 p0, p1;
#define SP_STAGE(VS) do { float mn, alpha; bf16x8 pa0, pa1, pa2, pa3; \
        partialSM(p0, p1, m_reg, mn, alpha); finishSM(p0, p1, alpha, l_reg, pa0, pa1, pa2, pa3); \
        if (__any(alpha < 1.f)) { float* al_l = WAVE_WS() + 32; if (hi == 0) al_l[r32] = alpha; asm volatile("s_waitcnt lgkmcnt(0)" ::: "memory"); \
            _Pragma("unroll") for (int d_ = 0; d_ < 4; ++d_) _Pragma("unroll") for (int r = 0; r < 16; ++r) o[d_][r] *= al_l[crow(r, hi)]; } \
        SBAR(); pv_tile(o, vbase + (VS) * SHM_V, pa0, pa1, pa2, pa3); } while (0)
    for (int t = 0; t < NT; ++t) {
        const int cur = t & 1, kb_ = t * KVBLK;
        if (t + 1 < NT) { KDMA((t + 1) * KVBLK, cur ^ 1); VDMA((t + 1) * KVBLK, cur ^ 1); }
        SBAR();
        qkt(p0, p1, K_lds + cur * SHM_K, r32, hi, qr); if (kb_ + KVBLK - 1 > qlo) mask_tile(p0, p1, qm - kb_);
        SBAR();
        SP_STAGE(cur);
        asm volatile("s_waitcnt vmcnt(0)" ::: "memory");
        __syncthreads();
    }
#undef SP_STAGE
    float* li_l = WAVE_WS();
    if (hi == 0) li_l[r32] = l_reg; asm volatile("s_waitcnt lgkmcnt(0)" ::: "memory");
    float rli[16];
#pragma unroll
    for (int r = 0; r < 16; ++r) rli[r] = __builtin_amdgcn_rcpf(li_l[crow(r, hi)]);
    bf16* Ow = O + (rowb + qlo) * 2048 + h * DV;
#pragma unroll
    for (int r = 0; r < 16; ++r) { const int orow = crow(r, hi);
#pragma unroll
        for (int d0 = 0; d0 < 4; ++d0) { const float v = o[d0][r] * rli[r];
            const float vn = __shfl_xor(v, 1);
            if ((r32 & 1) == 0) *(unsigned*)(Ow + (size_t)orow * 2048 + d0 * 32 + r32) = cvtpk(v, vn); } }
    __syncthreads();
#undef KDMA
#undef VDMA
#undef WAVE_WS
}
#undef SBAR
}

struct Args { const float* in[20]; float* out; unsigned char* ws; int ph_lo, ph_hi, coop, pad; };
#define XB_TMO      128
#define XB_XCNT(j)  (256  + 64 * (j))
#define XB_XSUB(j)  (1280 + 64 * (j))
#define XB_XGEN(j)  (2304 + 64 * (j))
#define XB_TOP      3328
#define XB_TOPGEN   3392
#define XCD_BAR_WORDS 3456
#define XB_SPIN_CAP (1u << 20)
__device__ __forceinline__ unsigned xb_ld(unsigned* p)              { return __hip_atomic_load(p, __ATOMIC_RELAXED, __HIP_MEMORY_SCOPE_AGENT); }
__device__ __forceinline__ unsigned xb_add(unsigned* p, unsigned v) { return __hip_atomic_fetch_add(p, v, __ATOMIC_RELAXED, __HIP_MEMORY_SCOPE_AGENT); }
__device__ __forceinline__ unsigned xb_xcc_id() { return (unsigned)__builtin_amdgcn_s_getreg((3 << 11) | 20) & 0xFu; }
#define XB_SPIN(cond, bar) do { unsigned _sp = 0; while (cond) { __builtin_amdgcn_s_sleep(1); \
    if ((++_sp & 255u) == 0u) { if (xb_ld(&(bar)[XB_TMO])) break; if (_sp > XB_SPIN_CAP) { atomicAdd(&(bar)[XB_TMO], 1u); break; } } } } while (0)
__device__ __forceinline__ void xcd_barrier_complete(unsigned* bar, unsigned x, unsigned& nloc, unsigned& nx) {
    const unsigned G = gridDim.x;
    unsigned sum, cnt, mine, sp = 0u;
    for (;;) {
        sum = 0u; cnt = 0u; mine = 0u;
#pragma unroll
        for (unsigned j = 0; j < 16; ++j) { const unsigned c = xb_ld(&bar[XB_XCNT(j)]); sum += c; cnt += (c > 0u) ? 1u : 0u; mine = (j == x) ? c : mine; }
        if (sum == G) break;
        __builtin_amdgcn_s_sleep(1);
        if ((++sp & 255u) == 0u) { if (xb_ld(&bar[XB_TMO])) break; if (sp > XB_SPIN_CAP) { atomicAdd(&bar[XB_TMO], 1u); break; } }
    }
    nloc = mine > 0u ? mine : 1u; nx = cnt > 0u ? cnt : 1u;
}
__device__ __forceinline__ void grid_bar(unsigned* bar, volatile LAS unsigned* st) {
    asm volatile("s_waitcnt vmcnt(0)" ::: "memory");
    __syncthreads();
    if (threadIdx.x == 0) {
        const unsigned x = xb_xcc_id();
        __builtin_amdgcn_s_waitcnt(0);
        unsigned nloc = st[0], nx = st[1];
        if (nloc == 0u) { xcd_barrier_complete(bar, x, nloc, nx); st[0] = nloc; st[1] = nx; }
        const unsigned old = xb_add(&bar[XB_XSUB(x)], 1u);
        const unsigned gen = old / nloc;
        if (old + 1u == (gen + 1u) * nloc) {
            __builtin_amdgcn_fence(__ATOMIC_RELEASE, "agent");
            asm volatile("s_waitcnt vmcnt(0)" ::: "memory");
            const unsigned og = xb_add(&bar[XB_TOP], 1u);
            const unsigned tg = og / nx;
            if (og + 1u == (tg + 1u) * nx) xb_add(&bar[XB_TOPGEN], 1u);
            else XB_SPIN(xb_ld(&bar[XB_TOPGEN]) == tg, bar);
            __builtin_amdgcn_fence(__ATOMIC_ACQUIRE, "agent");
            xb_add(&bar[XB_XGEN(x)], 1u);
            asm volatile("s_waitcnt vmcnt(0)" ::: "memory");
        } else {
            XB_SPIN(xb_ld(&bar[XB_XGEN(x)]) == gen, bar);
            __builtin_amdgcn_fence(__ATOMIC_ACQUIRE, "agent");
            asm volatile("s_waitcnt vmcnt(0)" ::: "memory");
        }
    }
    __syncthreads();
}
constexpr int NPH = 11;

__global__ void __launch_bounds__(NWAVES * 64, 2) mega_fwd(Args args) {
    extern __shared__ __attribute__((aligned(16))) unsigned char lds[];
    LAS unsigned char* ldsl = (LAS unsigned char*)lds;
    const int tid = threadIdx.x, lane = tid & 63, wave = __builtin_amdgcn_readfirstlane(tid >> 6);
    const int G = gridDim.x, bx = blockIdx.x;
    const int vcu = (G % 8 == 0) ? (bx % 8) * (G / 8) + bx / 8 : bx;
    const int gw = vcu * NWAVES + wave, NGW = G * NWAVES;
    unsigned char* ws = args.ws;
    const float* const* kin = (const float* const*)__builtin_amdgcn_kernarg_segment_ptr();
    const float* svec = (const float*)ws;
    const float* b_gate = svec + SV_BGATE; const float* q_a_norm_g = svec + SV_QAG; const float* kv_a_norm_g = svec + SV_KVAG; const float* q_norm_g = svec + SV_QNG;
    const float* k_norm_g = svec + SV_KNG; const float* pool_scale = svec + SV_PSC; const float* ffn_norm_g = svec + SV_FNG; const int* positions = (const int*)(svec + SV_POS);
    bf16* WIN_T = (bf16*)(ws + WS_WIN); bf16* WQB_T = (bf16*)(ws + WS_WQB); bf16* WKVB_T = (bf16*)(ws + WS_WKVB); bf16* WPG_T = (bf16*)(ws + WS_WPG);
    bf16* WPO_T = (bf16*)(ws + WS_WPO); bf16* WAO_T = (bf16*)(ws + WS_WAO); bf16* WOUT_T = (bf16*)(ws + WS_WOUT); bf16* WGU_T = (bf16*)(ws + WS_WGU); bf16* WDN_T = (bf16*)(ws + WS_WDN);
    bf16* XN = (bf16*)(ws + WS_XN); float* C1 = (float*)(ws + WS_C1); float* KRP = (float*)(ws + WS_KRP); bf16* U = (bf16*)(ws + WS_U); bf16* Gt = (bf16*)(ws + WS_G);
    bf16* CN = (bf16*)(ws + WS_CN); bf16* POOLED = (bf16*)(ws + WS_POOLED); bf16* Qb = (bf16*)(ws + WS_Q); bf16* Kb = (bf16*)(ws + WS_K); bf16* Vb = (bf16*)(ws + WS_V);
    bf16* PG = (bf16*)(ws + WS_PG); bf16* MP = (bf16*)(ws + WS_MP); bf16* Ob = (bf16*)(ws + WS_O); bf16* MIXED = (bf16*)(ws + WS_MIXED);
    float* X1 = (float*)(ws + WS_X1); bf16* H2 = (bf16*)(ws + WS_H2); bf16* ACT = (bf16*)(ws + WS_ACT);

    const int lo = args.ph_lo, hi_ph = args.ph_hi;
#ifndef PHMASK
#define PHMASK 0x7ff
#endif
#define IN(k) (((PHMASK >> (k)) & 1) && lo <= (k) && (k) < hi_ph)
#define SEAM(k) do { if (IN(k) && IN((k) + 1)) { unsigned char* w2_ = args.ws; asm volatile("" : "+s"(w2_)); grid_bar((unsigned*)(w2_ + WS_BAR), (volatile LAS unsigned*)(ldsl + 140032)); } } while (0)
    if (args.coop > 1) cg::this_grid().sync();
    if (threadIdx.x < 2) ((volatile LAS unsigned*)(ldsl + 140032))[threadIdx.x] = 0u;
    __syncthreads();
    if (args.coop && threadIdx.x == 0) { unsigned char* w2_ = args.ws; asm volatile("" : "+s"(w2_)); (void)xb_add(&((unsigned*)(w2_ + WS_BAR))[XB_XCNT(xb_xcc_id())], 1u); }
    LAS float* scr = (LAS float*)(ldsl + wave * 16384);
#ifdef TPROBE
#define TP_BEGIN(k) do { if ((TPROBE >> (k)) & 1) { if (blockIdx.x == 0 && threadIdx.x == 0) { *(volatile LAS unsigned*)(ldsl + 140000) = (unsigned)__builtin_amdgcn_s_memrealtime(); } } } while (0)
#define TP_END(k) do { if ((TPROBE >> (k)) & 1) { if (blockIdx.x == 0 && threadIdx.x == 0) { volatile LAS unsigned* tp_ = (volatile LAS unsigned*)(ldsl + 140000); tp_[1] += (unsigned)__builtin_amdgcn_s_memrealtime() - tp_[0]; } } } while (0)
    if (blockIdx.x == 0 && threadIdx.x == 0) { ((volatile LAS unsigned*)(ldsl + 140000))[1] = 0u; }
#else
#define TP_BEGIN(k) do {} while (0)
#define TP_END(k) do {} while (0)
#endif

    if (IN(0)) { TP_BEGIN(0);
        { float* sv = (float*)ws; const int gt = bx * (NWAVES * 64) + tid, GT = G * NWAVES * 64;
          for (int i = gt; i < M; i += GT) sv[SV_SS + i] = 0.f;
          for (int i = gt; i < SV_END; i += GT) { int idx, off, lim = 1 << 30;
              if (i < SV_QAG) { idx = 4; off = SV_BGATE; } else if (i < SV_KVAG) { idx = 5; off = SV_QAG; } else if (i < SV_QNG) { idx = 7; off = SV_KVAG; }
              else if (i < SV_KNG) { idx = 9; off = SV_QNG; lim = 192; } else if (i < SV_PSC) { idx = 10; off = SV_KNG; lim = 192; }
              else if (i < SV_FNG) { idx = 13; off = SV_PSC; } else if (i < SV_POS) { idx = 16; off = SV_FNG; } else { idx = 1; off = SV_POS; }
              const float* src = kin[idx]; sv[i] = (i - off < lim) ? src[i - off] : 0.f; } }
        constexpr int I_IN = (DM / 64) * (DIN / 32), I_QB = (QLORA / 64) * (NH * DQK / 32), I_KVB = (KVLORA / 64) * (NH * 256 / 32), I_PG = (256 / 64) * (256 / 32),
                      I_PO = (POOLW / 64) * (DM / 32), I_AO = (DM / 64) * (DM / 32), I_OUT = I_AO;
        constexpr int NITEMS = I_IN + I_QB + I_KVB + 4 * I_PG + I_PO + I_AO + I_OUT;
#define P0_DESC(it__) ([&]() { int r = (it__), idx, Kd, Nd, mode = 0, roff = 0; size_t dsto, srco = 0; \
            if (r < I_IN) { idx = 3; Kd = DM; Nd = DIN; mode = 1; dsto = WS_WIN; } \
            else if ((r -= I_IN) < I_QB) { idx = 6; Kd = QLORA; Nd = NH * DQK; dsto = WS_WQB; } \
            else if ((r -= I_QB) < I_KVB) { idx = 8; Kd = KVLORA; Nd = NH * 256; dsto = WS_WKVB; } \
            else if ((r -= I_KVB) < 4 * I_PG) { const int g = r / I_PG; r = r % I_PG; idx = 12; Kd = 256; Nd = 256; dsto = WS_WPG; roff = g * 256; srco = (size_t)g * 65536; } \
            else if ((r -= 4 * I_PG) < I_PO) { idx = 14; Kd = POOLW; Nd = DM; dsto = WS_WPO; } \
            else if ((r -= I_PO) < I_AO) { idx = 11; Kd = DM; Nd = DM; dsto = WS_WAO; } \
            else { r -= I_AO; idx = 15; Kd = DM; Nd = DM; dsto = WS_WOUT; } \
            return tr_desc(kin[idx] + srco, Kd, Nd, (bf16*)(ws + dsto), mode, roff, r, nullptr); }())
        TR_PIPELINE(gw, NITEMS, NGW, P0_DESC);
#undef P0_DESC
        { v4u* z = (v4u*)(WIN_T + (size_t)DIN * DM); const int nz = (DIN_PAD - DIN) * DM / 8;
          for (int i = gw * 64 + lane; i < nz; i += NGW * 64) z[i] = (v4u){0u, 0u, 0u, 0u}; }
        { const float* x = kin[0]; const float* attn_norm_g = kin[2];
          for (int m = gw; m < M; m += NGW) rms_row_2048(x + (size_t)m * DM, attn_norm_g, XN + (size_t)m * DM, lane); }
    TP_END(0); }
    SEAM(0);
    if (IN(1)) { TP_BEGIN(1);
        { pg8::Gemm g{XN, WIN_T, M, 6144, DM, DM, DM, 0, 0}; pg8::StaticOrder S; S.init(M, 6144, G, bx);
          pg8::EpiIn E{C1, U, Gt, b_gate};
          pg8::gemm_phase<pg8::EpiIn, pg8::StaticOrder>(ldsl, g, S, E); }
        { pg8::Gemm g{XN, WIN_T + (size_t)6144 * DM, M, 2048, 256, DM, DM, 256, 256}; pg8::StaticOrder S; S.init(M, 2048, G, bx);
          pg8::EpiKRP E{KRP};
          pg8::gemm_phase<pg8::EpiKRP, pg8::StaticOrder>(ldsl, g, S, E); }
    TP_END(1); }
    SEAM(1);
    if (IN(2)) { TP_BEGIN(2);
        for (int m = gw; m < M; m += NGW) {
            const f32x4* c = (const f32x4*)(C1 + (size_t)m * 1024) + lane; f32x4 v[4]; float sq = 0.f, skv = 0.f;
#pragma unroll
            for (int j = 0; j < 4; ++j) { v[j] = __builtin_nontemporal_load(c + 64 * j); const float s = (v[j].x * v[j].x + v[j].y * v[j].y) + (v[j].z * v[j].z + v[j].w * v[j].w); if (j < 2) sq += s; else skv += s; }
            const float iq = 1.0f / sqrtf(wave_sum(sq) * (1.f / 512.f) + EPS), ikv = 1.0f / sqrtf(wave_sum(skv) * (1.f / 512.f) + EPS);
            v2u* o8 = (v2u*)(CN + (size_t)m * 1024) + lane;
#pragma unroll
            for (int j = 0; j < 4; ++j) { const f32x4 gv = (j < 2) ? ((const f32x4*)q_a_norm_g)[lane + 64 * j] : ((const f32x4*)kv_a_norm_g)[lane + 64 * (j - 2)]; const float iv = (j < 2) ? iq : ikv;
                v2u o; o.x = cvtpk(v[j].x * iv * gv.x, v[j].y * iv * gv.y); o.y = cvtpk(v[j].z * iv * gv.z, v[j].w * iv * gv.w); o8[64 * j] = o; }
        }
        for (int m = gw; m < M; m += NGW) {
            const int s = m & (SEQ - 1);
#pragma unroll
            for (int jj = 0; jj < 2; ++jj) {
                const int col = 8 * lane + 512 * jj, grp = col >> 8, w = 2 << grp; const int cnt = (s + 1 < w) ? s + 1 : w;
                float a[8]; float u0[8];
#pragma unroll
                for (int e = 0; e < 8; ++e) a[e] = 0.f;
#pragma unroll
                for (int d = 0; d < 16; ++d) {
                    if (d < cnt) { const v4u q = *(const v4u*)(U + (size_t)(m - d) * 1024 + col);
                        const float f[8] = {bflo(q.x), bfhi(q.x), bflo(q.y), bfhi(q.y), bflo(q.z), bfhi(q.z), bflo(q.w), bfhi(q.w)};
#pragma unroll
                        for (int e = 0; e < 8; ++e) { a[e] += f[e]; if (d == 0) u0[e] = f[e]; } }
                }
                const float rc = 1.0f / (float)cnt;
                v4u o; o.x = cvtpk(a[0] * rc - u0[0], a[1] * rc - u0[1]); o.y = cvtpk(a[2] * rc - u0[2], a[3] * rc - u0[3]);
                o.z = cvtpk(a[4] * rc - u0[4], a[5] * rc - u0[5]); o.w = cvtpk(a[6] * rc - u0[6], a[7] * rc - u0[7]);
                *(v4u*)(POOLED + (size_t)m * 1024 + col) = o;
            }
        }
    TP_END(2); }
    SEAM(2);
    if (IN(3)) { TP_BEGIN(3);
        { pg8::Gemm g{CN, WQB_T, M, NH * DQK, QLORA, 1024, QLORA, 0, 0}; pg8::StaticOrder S; S.init(M, NH * DQK, G, bx);
          pg8::EpiBf16 E{Qb, 3072}; pg8::gemm_phase<pg8::EpiBf16, pg8::StaticOrder>(ldsl, g, S, E); }
        { pg8::Gemm g{CN + 512, WKVB_T, M, NH * 256, KVLORA, 1024, KVLORA, 0, 0}; pg8::StaticOrder S; S.init(M, NH * 256, G, bx);
          pg8::EpiKV E{Kb, Vb}; pg8::gemm_phase<pg8::EpiKV, pg8::StaticOrder>(ldsl, g, S, E); }
        { pg8::Gemm g{POOLED, WPG_T, M, POOLW, 256, 1024, 256, 256, 0}; pg8::StaticOrder S; S.init(M, POOLW, G, (bx + 128) % G);
          pg8::EpiScale E{PG, 1024, pool_scale}; pg8::gemm_phase<pg8::EpiScale, pg8::StaticOrder>(ldsl, g, S, E); }
    TP_END(3); }
    SEAM(3);
    if (IN(4)) { TP_BEGIN(4);
        for (int m = gw; m < M; m += NGW) {
            const float pos = (float)positions[m];
            const int sub = lane & 3, h = lane >> 2;
            float cs[8], sn[8];
#pragma unroll
            for (int j = 0; j < 8; ++j) { const int i = 8 * sub + j; const float invf = __builtin_amdgcn_exp2f(-(float)i * (13.287712379549449f / 32.f));
                const float ang = pos * invf; const float k = rintf(ang * 0.15915494309189535f);
                float r = fmaf(-k, 6.2831854820251465f, ang); r = fmaf(-k, -1.7484555e-7f, r);
                sn[j] = __sinf(r); cs[j] = __cosf(r); }
#pragma unroll
            for (int which = 0; which < 2; ++which) {
                bf16* base = (which == 0 ? Qb : Kb) + (size_t)m * 3072 + h * DQK;
                const float* gn = (which == 0) ? q_norm_g : k_norm_g;
                float nv[32], rl[8], rh[8]; float ss = 0.f;
#pragma unroll
                for (int jj = 0; jj < 4; ++jj) { const v4u q = *(const v4u*)(base + 32 * sub + 8 * jj);
                    nv[8 * jj + 0] = bflo(q.x); nv[8 * jj + 1] = bfhi(q.x); nv[8 * jj + 2] = bflo(q.y); nv[8 * jj + 3] = bfhi(q.y);
                    nv[8 * jj + 4] = bflo(q.z); nv[8 * jj + 5] = bfhi(q.z); nv[8 * jj + 6] = bflo(q.w); nv[8 * jj + 7] = bfhi(q.w); }
                if (which == 0) {
                    const v4u a = *(const v4u*)(base + 128 + 8 * sub), b = *(const v4u*)(base + 160 + 8 * sub);
                    rl[0] = bflo(a.x); rl[1] = bfhi(a.x); rl[2] = bflo(a.y); rl[3] = bfhi(a.y); rl[4] = bflo(a.z); rl[5] = bfhi(a.z); rl[6] = bflo(a.w); rl[7] = bfhi(a.w);
                    rh[0] = bflo(b.x); rh[1] = bfhi(b.x); rh[2] = bflo(b.y); rh[3] = bfhi(b.y); rh[4] = bflo(b.z); rh[5] = bfhi(b.z); rh[6] = bflo(b.w); rh[7] = bfhi(b.w);
                } else {
                    f32x4 a0 = {0.f, 0.f, 0.f, 0.f}, a1 = a0, b0 = a0, b1 = a0;
#pragma unroll
                    for (int ks = 0; ks < 8; ++ks) { const float* kp = KRP + ((size_t)ks * 8192 + m) * 64 + 8 * sub;
                        a0 += *(const f32x4*)kp; a1 += *(const f32x4*)(kp + 4); b0 += *(const f32x4*)(kp + 32); b1 += *(const f32x4*)(kp + 36); }
                    rl[0] = a0.x; rl[1] = a0.y; rl[2] = a0.z; rl[3] = a0.w; rl[4] = a1.x; rl[5] = a1.y; rl[6] = a1.z; rl[7] = a1.w;
                    rh[0] = b0.x; rh[1] = b0.y; rh[2] = b0.z; rh[3] = b0.w; rh[4] = b1.x; rh[5] = b1.y; rh[6] = b1.z; rh[7] = b1.w;
                }
#pragma unroll
                for (int e = 0; e < 32; ++e) ss += nv[e] * nv[e];
#pragma unroll
                for (int e = 0; e < 8; ++e) ss += rl[e] * rl[e] + rh[e] * rh[e];
                ss += __shfl_xor(ss, 1); ss += __shfl_xor(ss, 2);
                const float inv = 1.0f / sqrtf(ss * (1.f / 192.f) + EPS);
#pragma unroll
                for (int jj = 0; jj < 4; ++jj) { const f32x4 g0 = *(const f32x4*)(gn + 32 * sub + 8 * jj), g1 = *(const f32x4*)(gn + 32 * sub + 8 * jj + 4);
                    v4u o; o.x = cvtpk(nv[8 * jj + 0] * inv * g0.x, nv[8 * jj + 1] * inv * g0.y); o.y = cvtpk(nv[8 * jj + 2] * inv * g0.z, nv[8 * jj + 3] * inv * g0.w);
                    o.z = cvtpk(nv[8 * jj + 4] * inv * g1.x, nv[8 * jj + 5] * inv * g1.y); o.w = cvtpk(nv[8 * jj + 6] * inv * g1.z, nv[8 * jj + 7] * inv * g1.w);
                    *(v4u*)(base + 32 * sub + 8 * jj) = o; }
                float ol[8], oh[8];
#pragma unroll
                for (int e = 0; e < 8; ++e) { const float a = rl[e] * inv * gn[128 + 8 * sub + e], b = rh[e] * inv * gn[160 + 8 * sub + e];
                    ol[e] = a * cs[e] - b * sn[e]; oh[e] = b * cs[e] + a * sn[e]; }
                v4u o1, o2; o1.x = cvtpk(ol[0], ol[1]); o1.y = cvtpk(ol[2], ol[3]); o1.z = cvtpk(ol[4], ol[5]); o1.w = cvtpk(ol[6], ol[7]);
                o2.x = cvtpk(oh[0], oh[1]); o2.y = cvtpk(oh[2], oh[3]); o2.z = cvtpk(oh[4], oh[5]); o2.w = cvtpk(oh[6], oh[7]);
                *(v4u*)(base + 128 + 8 * sub) = o1; *(v4u*)(base + 160 + 8 * sub) = o2;
            }
        }
        { pg8::Gemm g{PG, WPO_T, M, DM, POOLW, POOLW, POOLW, 0, 0}; pg8::StaticOrder S; S.init(M, DM, G, bx);
          pg8::EpiGate<false> E{MP, Gt, nullptr, 0}; pg8::gemm_phase<pg8::EpiGate<false>, pg8::StaticOrder>(ldsl, g, S, E); }
    TP_END(4); }
    SEAM(4);
    if (IN(5)) { TP_BEGIN(5);
        const int npair = BATCH * NH * 8;
        for (int p = vcu; p < npair; p += G) {
            const int bh = p >> 3, s = p & 7;
            att::attn_unit(bh / NH, bh % NH, 15 - s, Qb, Kb, Vb, Ob, (char*)lds);
            att::attn_unit(bh / NH, bh % NH, s, Qb, Kb, Vb, Ob, (char*)lds);
        }
    TP_END(5); }
    SEAM(5);
    if (IN(6)) { TP_BEGIN(6);
        pg8::Gemm g{Ob, WAO_T, M, DM, DM, DM, DM, 0, 0}; pg8::StaticOrder S; S.init(M, DM, G, bx);
        pg8::EpiGate<true> E{MIXED, Gt, MP, 2048}; pg8::gemm_phase<pg8::EpiGate<true>, pg8::StaticOrder>(ldsl, g, S, E);
    TP_END(6); }
    SEAM(6);
    if (IN(7)) { TP_BEGIN(7);
        { constexpr int I_G = (DM / 64) * (DFF / 32);
#define GU_DESC(it__) ((it__) < I_G ? tr_desc(kin[17], DM, DFF, (bf16*)(ws + WS_WGU), 2, 0, (it__), ffn_norm_g) : tr_desc(kin[18], DM, DFF, (bf16*)(ws + WS_WGU), 3, 0, (it__) - I_G, ffn_norm_g))
          TR_PIPELINE(gw, 2 * I_G, NGW, GU_DESC);
#undef GU_DESC
          __syncthreads(); }
        pg8::Gemm g{MIXED, WOUT_T, M, DM, DM, DM, DM, 0, 0}; pg8::StaticOrder S; S.init(M, DM, G, bx);
        pg8::EpiResNorm E{kin[0], X1, (bf16*)(ws + WS_X1B), (float*)ws + SV_SS, DM}; pg8::gemm_phase<pg8::EpiResNorm, pg8::StaticOrder>(ldsl, g, S, E);
    TP_END(7); }
    SEAM(7);
    if (IN(9)) { TP_BEGIN(9);
        pg8::Gemm g{(bf16*)(ws + WS_X1B), WGU_T, M, 2 * DFF, DM, DM, DM, 0, 0}; pg8::StaticOrder S; S.init(M, 2 * DFF, G, bx);
        pg8::EpiSwiGLU E{ACT, DFF, (const float*)ws + SV_SS}; pg8::gemm_phase<pg8::EpiSwiGLU, pg8::StaticOrder>(ldsl, g, S, E);
        if (G == 256 ? (bx >= 128) : true) {
            constexpr int I_D2 = (DFF / 64) * (DM / 32);
            const int nw = (G == 256) ? 128 * NWAVES : NGW, w0 = (G == 256) ? (bx - 128) * NWAVES + wave : gw;
#define DN_DESC(it__) tr_desc(kin[19], DFF, DM, (bf16*)(ws + WS_WDN), 0, 0, (it__), nullptr)
            TR_PIPELINE(w0, I_D2, nw, DN_DESC);
#undef DN_DESC
        }
    TP_END(9); }
    SEAM(9);
    if (IN(10)) { TP_BEGIN(10);
        pg8::Gemm g{ACT, WDN_T, M, DM, DFF, DFF, DFF, 0, 0}; pg8::StaticOrder S; S.init(M, DM, G, bx);
        pg8::EpiRes E{X1, args.out, DM}; pg8::gemm_phase<pg8::EpiRes, pg8::StaticOrder>(ldsl, g, S, E);
    TP_END(10); }
#ifdef TPROBE
    if (blockIdx.x == 0 && threadIdx.x == 0) { const unsigned w_ = 4u * ((volatile LAS unsigned*)(ldsl + 140000))[1]; const unsigned long long t0_ = __builtin_amdgcn_s_memrealtime(); while ((unsigned)(__builtin_amdgcn_s_memrealtime() - t0_) < w_) __builtin_amdgcn_s_sleep(8); }
#endif
#undef IN
#undef SEAM
}

extern "C" void kernel_launch(void* const* d_in, const int* in_sizes, int n_in, void* d_out, int out_size, void* d_ws, size_t ws_size, hipStream_t stream) {
    static int grid = 0;
    if (grid == 0) {
        if (n_in != 20 || out_size != M * DM || ws_size < WS_END) { fprintf(stderr, "kernel_launch: unexpected shapes (n_in %d, out %d, ws %zu)\n", n_in, out_size, ws_size); grid = -1; return; }
        int dev = 0, cus = 0, per_cu = 0;
        (void)hipGetDevice(&dev); (void)hipDeviceGetAttribute(&cus, hipDeviceAttributeMultiprocessorCount, dev);
        if (hipFuncSetAttribute((const void*)mega_fwd, hipFuncAttributeMaxDynamicSharedMemorySize, LDS_BYTES) != hipSuccess) { fprintf(stderr, "kernel_launch: hipFuncSetAttribute failed\n"); grid = -1; return; }
        if (hipOccupancyMaxActiveBlocksPerMultiprocessor(&per_cu, (const void*)mega_fwd, NWAVES * 64, LDS_BYTES) != hipSuccess || per_cu < 1) { fprintf(stderr, "kernel_launch: occupancy query says %d\n", per_cu); per_cu = 1; }
        (void)hipGetLastError();
        grid = cus > 0 ? cus : 256;
    }
    if (grid < 0) return;
    Args a{};
    for (int i = 0; i < 20; ++i) a.in[i] = (const float*)d_in[i];
    a.out = (float*)d_out; a.ws = (unsigned char*)d_ws;
    if (MK_N_LAUNCHES == 1) {
        a.ph_lo = 0; a.ph_hi = NPH; a.coop = 1;
        (void)hipMemsetAsync((char*)d_ws + WS_BAR, 0, 16384, stream);
        void* kargs[] = {&a};
        hipError_t e = hipLaunchCooperativeKernel((const void*)mega_fwd, dim3(grid), dim3(NWAVES * 64), kargs, LDS_BYTES, stream);
        if (e != hipSuccess) fprintf(stderr, "kernel_launch: cooperative launch failed: %s (grid %d)\n", hipGetErrorString(e), grid);
    } else {
        for (int p = 0; p < NPH; ++p) {
            a.ph_lo = p; a.ph_hi = p + 1;
            hipLaunchKernelGGL(mega_fwd, dim3(grid), dim3(NWAVES * 64), LDS_BYTES, stream, a);
        }
    }
}
```

```cpp
#include <hip/hip_runtime.h>
#include <hip/hip_cooperative_groups.h>
#include <cstdio>
#include <cstdint>
namespace cg = cooperative_groups;

#ifndef MK_N_LAUNCHES
#define MK_N_LAUNCHES 1
#endif

namespace pg8 {
#define PG8_LAS __attribute__((address_space(3)))
typedef unsigned short bf16_t;
typedef short bf16x8 __attribute__((ext_vector_type(8)));
typedef float f32x4 __attribute__((ext_vector_type(4)));
typedef unsigned u32x4 __attribute__((ext_vector_type(4)));
constexpr int BM = 256, BK = 64, HALF = 128, HTB = HALF * BK * 2, STAGE_BYTES = 8 * HTB, NXCD = 8, WGM = 8;

__host__ __device__ __forceinline__ int lds_byte(int r, int c) { const int st = (r >> 4) * 2 + (c >> 5), rr = r & 15, cc = c & 31, ob = rr * 64 + cc * 2; return st * 1024 + (ob ^ (((ob >> 9) & 1) << 5)); }
__host__ __device__ __forceinline__ void stage_rc(int b, int& R, int& C) { const int st = b / 1024, sb = b % 1024, swz = sb ^ (((sb >> 9) & 1) << 5); R = (st >> 1) * 16 + swz / 64; C = (st & 1) * 32 + (swz % 64) / 2; }
__host__ __device__ __forceinline__ int perm32(int rho) { const int n = rho >> 4, i = rho & 15; return 8 * (i >> 2) + 4 * n + (i & 3); }

struct Unit { int pm, pn; };
struct Gemm { const bf16_t* A; const bf16_t* Bt; int M, N, K, lda, ldb, a_pn_step, b_pn_step; };

struct StaticOrder {
    int nM, nN, nwg, G, c;
    __host__ __device__ void init(int M, int N, int G_, int c_) { nM = M / BM; nN = N / BM; nwg = nM * nN; G = G_; c = c_; }
    __host__ __device__ bool next(int i, Unit& u) const {
        const long L = (long)i * G + c; if (L >= nwg) return false;
        int wgid = (int)L; { const int q = nwg / NXCD, r = nwg % NXCD, xcd = wgid % NXCD, off = wgid / NXCD; wgid = (xcd < r ? xcd * (q + 1) : r * (q + 1) + (xcd - r) * q) + off; }
        const int nig = WGM * nN, gid = wgid / nig, fm = gid * WGM, gsz = (nM - fm) < WGM ? (nM - fm) : WGM;
        u.pm = fm + ((wgid % nig) % gsz); u.pn = (wgid % nig) / gsz; return true;
    }
};

typedef float f32x2_t_ __attribute__((ext_vector_type(2))); typedef __bf16 bf16x2_t_ __attribute__((ext_vector_type(2)));
__device__ __forceinline__ unsigned cvt_pk_bf16(float lo, float hi) { f32x2_t_ v = {lo, hi}; bf16x2_t_ b = __builtin_convertvector(v, bf16x2_t_); return __builtin_bit_cast(unsigned, b); }
__device__ __forceinline__ u32x4 pack8(f32x4 a, f32x4 b) { u32x4 w; w.x = cvt_pk_bf16(a[0], a[1]); w.y = cvt_pk_bf16(a[2], a[3]); w.z = cvt_pk_bf16(b[0], b[1]); w.w = cvt_pk_bf16(b[2], b[3]); return w; }
__device__ __forceinline__ void unpack8(u32x4 w, f32x4& a, f32x4& b) {
    a[0] = __uint_as_float(w.x << 16); a[1] = __uint_as_float(w.x & 0xffff0000u); a[2] = __uint_as_float(w.y << 16); a[3] = __uint_as_float(w.y & 0xffff0000u);
    b[0] = __uint_as_float(w.z << 16); b[1] = __uint_as_float(w.z & 0xffff0000u); b[2] = __uint_as_float(w.w << 16); b[3] = __uint_as_float(w.w & 0xffff0000u); }
__device__ __forceinline__ float sigmoidf_(float v) { return __builtin_amdgcn_rcpf(1.0f + __builtin_amdgcn_exp2f(-1.4426950408889634f * v)); }
__device__ __forceinline__ f32x4 sigmoid4(f32x4 v) { f32x4 o; o[0] = sigmoidf_(v[0]); o[1] = sigmoidf_(v[1]); o[2] = sigmoidf_(v[2]); o[3] = sigmoidf_(v[3]); return o; }

typedef f32x4 AccT[2][2][4][2];
#define EPI_LOOP_AM _Pragma("unroll") for (int ai = 0; ai < 2; ++ai) _Pragma("unroll") for (int m = 0; m < 4; ++m)
#define EPI_LOOP_B _Pragma("unroll") for (int bj = 0; bj < 2; ++bj)

struct EpiIn {
    static constexpr bool PERM = true;
    float* C1; bf16_t* U; bf16_t* G; const float* bgate;
    __device__ __forceinline__ void operator()(const AccT& acc, const Unit& u, int wr, int wc, int fr, int fq) const {
        const int row0 = u.pm * BM + wr * 64 + fr, pn = u.pn, cw = wc * 32 + 8 * fq;
        if (pn < 4) {
            EPI_LOOP_AM { float* rp = C1 + (size_t)(row0 + ai * HALF + m * 16) * 1024 + pn * 256 + cw;
                EPI_LOOP_B { *(f32x4*)(rp + bj * HALF) = acc[ai][bj][m][0]; *(f32x4*)(rp + bj * HALF + 4) = acc[ai][bj][m][1]; } }
        } else if (pn < 8) {
            EPI_LOOP_AM { bf16_t* rp = U + (size_t)(row0 + ai * HALF + m * 16) * 1024 + (pn - 4) * 256 + cw;
                EPI_LOOP_B { *(u32x4*)(rp + bj * HALF) = pack8(acc[ai][bj][m][0], acc[ai][bj][m][1]); } }
        } else {
            const int gc = (pn - 8) * 256 + cw; f32x4 bv[2][2];
            EPI_LOOP_B { bv[bj][0] = *(const f32x4*)(bgate + gc + bj * HALF); bv[bj][1] = *(const f32x4*)(bgate + gc + bj * HALF + 4); }
            EPI_LOOP_AM { bf16_t* rp = G + (size_t)(row0 + ai * HALF + m * 16) * 4096 + gc;
                EPI_LOOP_B { *(u32x4*)(rp + bj * HALF) = pack8(sigmoid4(acc[ai][bj][m][0] + bv[bj][0]), sigmoid4(acc[ai][bj][m][1] + bv[bj][1])); } }
        }
    }
};
struct EpiKRP {
    static constexpr bool PERM = true;
    float* KRP;
    __device__ __forceinline__ void operator()(const AccT& acc, const Unit& u, int wr, int wc, int fr, int fq) const {
        const int row0 = u.pm * BM + wr * 64 + fr, cw = wc * 32 + 8 * fq;
        if (wc < 2) { EPI_LOOP_AM { float* rp = KRP + ((size_t)u.pn * 8192 + (row0 + ai * HALF + m * 16)) * 64 + cw; *(f32x4*)rp = acc[ai][0][m][0]; *(f32x4*)(rp + 4) = acc[ai][0][m][1]; } }
    }
};
struct EpiBf16 {
    static constexpr bool PERM = true;
    bf16_t* O; int ldc;
    __device__ __forceinline__ void operator()(const AccT& acc, const Unit& u, int wr, int wc, int fr, int fq) const {
        const int row0 = u.pm * BM + wr * 64 + fr, col0 = u.pn * BM + wc * 32 + 8 * fq;
        EPI_LOOP_AM { bf16_t* rp = O + (size_t)(row0 + ai * HALF + m * 16) * ldc + col0;
            EPI_LOOP_B { *(u32x4*)(rp + bj * HALF) = pack8(acc[ai][bj][m][0], acc[ai][bj][m][1]); } }
    }
};
struct EpiKV {
    static constexpr bool PERM = true;
    bf16_t* K; bf16_t* V;
    __device__ __forceinline__ void operator()(const AccT& acc, const Unit& u, int wr, int wc, int fr, int fq) const {
        const int row0 = u.pm * BM + wr * 64 + fr, cw = wc * 32 + 8 * fq, h = u.pn;
        EPI_LOOP_AM { const size_t row = (size_t)(row0 + ai * HALF + m * 16);
            *(u32x4*)(K + row * 3072 + h * 192 + cw) = pack8(acc[ai][0][m][0], acc[ai][0][m][1]);
            *(u32x4*)(V + row * 2048 + h * 128 + cw) = pack8(acc[ai][1][m][0], acc[ai][1][m][1]); }
    }
};
struct EpiScale {
    static constexpr bool PERM = true;
    bf16_t* O; int ldc; const float* scale;
    __device__ __forceinline__ void operator()(const AccT& acc, const Unit& u, int wr, int wc, int fr, int fq) const {
        const int row0 = u.pm * BM + wr * 64 + fr, col0 = u.pn * BM + wc * 32 + 8 * fq; f32x4 sv[2][2];
        EPI_LOOP_B { sv[bj][0] = *(const f32x4*)(scale + col0 + bj * HALF); sv[bj][1] = *(const f32x4*)(scale + col0 + bj * HALF + 4); }
        EPI_LOOP_AM { bf16_t* rp = O + (size_t)(row0 + ai * HALF + m * 16) * ldc + col0;
            EPI_LOOP_B { *(u32x4*)(rp + bj * HALF) = pack8(acc[ai][bj][m][0] * sv[bj][0], acc[ai][bj][m][1] * sv[bj][1]); } }
    }
};
template <bool HAS_ADD> struct EpiGate {
    static constexpr bool PERM = true;
    bf16_t* O; const bf16_t* gate; const bf16_t* add; int gcol0;
    __device__ __forceinline__ void operator()(const AccT& acc, const Unit& u, int wr, int wc, int fr, int fq) const {
        const int row0 = u.pm * BM + wr * 64 + fr, col0 = u.pn * BM + wc * 32 + 8 * fq;
        EPI_LOOP_AM { const size_t row = (size_t)(row0 + ai * HALF + m * 16);
            EPI_LOOP_B { f32x4 g0, g1; unpack8(__builtin_nontemporal_load((const u32x4*)(gate + row * 4096 + gcol0 + col0 + bj * HALF)), g0, g1);
                f32x4 v0 = g0 * acc[ai][bj][m][0], v1 = g1 * acc[ai][bj][m][1];
                if (HAS_ADD) { f32x4 a0, a1; unpack8(__builtin_nontemporal_load((const u32x4*)(add + row * 2048 + col0 + bj * HALF)), a0, a1); v0 += a0; v1 += a1; }
                *(u32x4*)(O + row * 2048 + col0 + bj * HALF) = pack8(v0, v1); } }
    }
};
struct EpiRes {
    static constexpr bool PERM = false;
    const float* base; float* out; int ldc;
    __device__ __forceinline__ void operator()(const AccT& acc, const Unit& u, int wr, int wc, int fr, int fq) const {
        const int row0 = u.pm * BM + wr * 64 + fr, col0 = u.pn * BM + wc * 32 + 4 * fq;
        EPI_LOOP_AM { const size_t off = (size_t)(row0 + ai * HALF + m * 16) * ldc + col0;
            EPI_LOOP_B {
#pragma unroll
                for (int n = 0; n < 2; ++n) { const f32x4 b = __builtin_nontemporal_load((const f32x4*)(base + off + bj * HALF + n * 16)); __builtin_nontemporal_store(b + acc[ai][bj][m][n], (f32x4*)(out + off + bj * HALF + n * 16)); } } }
    }
};
struct EpiResNorm {
    static constexpr bool PERM = false;
    const float* base; float* out; bf16_t* outb; float* ss; int ldc;
    __device__ __forceinline__ void operator()(const AccT& acc, const Unit& u, int wr, int wc, int fr, int fq) const {
        const int row0 = u.pm * BM + wr * 64 + fr, col0 = u.pn * BM + wc * 32 + 4 * fq;
        EPI_LOOP_AM { const int row = row0 + ai * HALF + m * 16; const size_t off = (size_t)row * ldc + col0; float s = 0.f;
            EPI_LOOP_B {
#pragma unroll
                for (int n = 0; n < 2; ++n) { const f32x4 v = __builtin_nontemporal_load((const f32x4*)(base + off + bj * HALF + n * 16)) + acc[ai][bj][m][n]; *(f32x4*)(out + off + bj * HALF + n * 16) = v;
                    typedef unsigned u32x2_ __attribute__((ext_vector_type(2))); u32x2_ w; w.x = cvt_pk_bf16(v[0], v[1]); w.y = cvt_pk_bf16(v[2], v[3]); *(u32x2_*)(outb + off + bj * HALF + n * 16) = w;
                    s += (v[0] * v[0] + v[1] * v[1]) + (v[2] * v[2] + v[3] * v[3]); } }
            s += __shfl_xor(s, 16); s += __shfl_xor(s, 32);
            if (fq == 0) atomicAdd(ss + row, s); }
    }
};
struct EpiSwiGLU {
    static constexpr bool PERM = true;
    bf16_t* O; int ldc; const float* ss;
    __device__ __forceinline__ void operator()(const AccT& acc, const Unit& u, int wr, int wc, int fr, int fq) const {
        const int row0 = u.pm * BM + wr * 64 + fr, col0 = u.pn * HALF + wc * 32 + 8 * fq;
        EPI_LOOP_AM { const int row = row0 + ai * HALF + m * 16; bf16_t* rp = O + (size_t)row * ldc + col0;
            const float inv = 1.0f / sqrtf(ss[row] * (1.f / 2048.f) + 1e-6f);
            const f32x4 g0 = acc[ai][0][m][0] * inv, g1 = acc[ai][0][m][1] * inv;
            *(u32x4*)rp = pack8(g0 * sigmoid4(g0) * (acc[ai][1][m][0] * inv), g1 * sigmoid4(g1) * (acc[ai][1][m][1] * inv)); }
    }
};

template <class Epi, class Sched, bool ALIGN_EPI = true>
__device__ __forceinline__ void gemm_phase(PG8_LAS unsigned char* lds, const Gemm g, const Sched& S, const Epi& E) {
    const int tid = threadIdx.x, wid = __builtin_amdgcn_readfirstlane(tid >> 6), lane = tid & 63, wr = wid >> 2, wc = wid & 3, fr = lane & 15, fq = lane >> 4;
    const int K = g.K, nt = K / BK;
    unsigned voffA[2], voffB[2];
#pragma unroll
    for (int i = 0; i < 2; ++i) { int R, C; stage_rc(tid * 16 + i * 8192, R, C); const int Rb = Epi::PERM ? ((R & ~31) + perm32(R & 31)) : R;
        voffA[i] = (unsigned)(R * g.lda + C) * 2u; voffB[i] = (unsigned)(Rb * g.ldb + C) * 2u; }
    const size_t kstep = (size_t)(BK * 2);
    const size_t hstepA = (size_t)HALF * g.lda * 2, hstepB = (size_t)HALF * g.ldb * 2;
    const size_t tstepA = 2 * hstepA, tstepB = g.b_pn_step ? (size_t)g.b_pn_step * 2 : 2 * hstepB, pstepA = (size_t)g.a_pn_step * 2;
    const unsigned ldsw = (unsigned)wid * 1024u;
    const int aoff = lds_byte(wr * 64 + fr, fq * 8), boff = lds_byte(wc * 32 + fr, fq * 8);
#define PG8_SA(b, h) (((b) * 2 + (h)) * HTB)
#define PG8_SB(b, h) ((4 + (b) * 2 + (h)) * HTB)
#define PG8_STAGE(bufoff, gbase, voff) do { _Pragma("unroll") for (int _i = 0; _i < 2; ++_i) \
        __builtin_amdgcn_global_load_lds((const unsigned*)((const char*)(gbase) + (voff)[_i]), (PG8_LAS unsigned*)(lds + (bufoff) + ldsw + _i * 8192), 16, 0, 0); } while (0)
#define PG8_LDA(dst, b, h) do { _Pragma("unroll") for (int m = 0; m < 4; ++m) _Pragma("unroll") for (int k = 0; k < 2; ++k) dst[m][k] = *(const PG8_LAS bf16x8*)(lds + PG8_SA(b, h) + aoff + m * 2048 + k * 1024); } while (0)
#define PG8_LDB(dst, b, h) do { _Pragma("unroll") for (int n = 0; n < 2; ++n) _Pragma("unroll") for (int k = 0; k < 2; ++k) dst[n][k] = *(const PG8_LAS bf16x8*)(lds + PG8_SB(b, h) + boff + n * 2048 + k * 1024); } while (0)
#define PG8_MMA(ai, bj, At, Bt) do { __builtin_amdgcn_s_setprio(1); _Pragma("unroll") for (int m = 0; m < 4; ++m) _Pragma("unroll") for (int n = 0; n < 2; ++n) _Pragma("unroll") for (int k = 0; k < 2; ++k) \
        acc[ai][bj][m][n] = __builtin_amdgcn_mfma_f32_16x16x32_bf16(Bt[n][k], At[m][k], acc[ai][bj][m][n], 0, 0, 0); __builtin_amdgcn_s_setprio(0); } while (0)
#define PG8_WAIT_V(n) asm volatile("s_waitcnt vmcnt(" #n ")" ::: "memory")
#define PG8_WAIT_L(n) asm volatile("s_waitcnt lgkmcnt(" #n ")" ::: "memory")
#define PG8_BAR __builtin_amdgcn_s_barrier()
#define PG8_SCHED __builtin_amdgcn_sched_barrier(0)
    Unit cur, nxt; int ui = 0;
    if (!S.next(0, cur)) return;
    f32x4 acc[2][2][4][2];
#pragma unroll
    for (int a = 0; a < 2; ++a)
#pragma unroll
        for (int b = 0; b < 2; ++b)
#pragma unroll
            for (int m = 0; m < 4; ++m)
#pragma unroll
                for (int n = 0; n < 2; ++n) acc[a][b][m][n] = (f32x4){0.f, 0.f, 0.f, 0.f};
    bf16x8 At[4][2], B0[2][2], B1[2][2];
    const char* cA = (const char*)g.A + (size_t)cur.pm * tstepA + (size_t)cur.pn * pstepA; const char* cB = (const char*)g.Bt + (size_t)cur.pn * tstepB;
    PG8_STAGE(PG8_SB(0, 0), cB, voffB); PG8_STAGE(PG8_SB(0, 1), cB + hstepB, voffB); PG8_STAGE(PG8_SA(0, 0), cA, voffA); PG8_STAGE(PG8_SA(0, 1), cA + hstepA, voffA);
    if (wr == 1) PG8_BAR;
    PG8_WAIT_V(2); PG8_BAR;
    PG8_STAGE(PG8_SB(1, 0), cB + kstep, voffB); PG8_STAGE(PG8_SA(1, 0), cA + kstep, voffA); PG8_STAGE(PG8_SB(1, 1), cB + hstepB + kstep, voffB);
    PG8_WAIT_V(6); PG8_BAR;
    for (;;) {
        const bool has_next = S.next(ui + 1, nxt);
        const char* nA = has_next ? (const char*)g.A + (size_t)nxt.pm * tstepA + (size_t)nxt.pn * pstepA : cA; const char* nB = has_next ? (const char*)g.Bt + (size_t)nxt.pn * tstepB : cB;
        for (int t = 0; t < nt; t += 2) {
            const bool last = (t == nt - 2);
            const char* a1 = cA + (size_t)(t + 1) * kstep;
            const char* a2 = last ? nA : cA + (size_t)(t + 2) * kstep; const char* b2 = last ? nB : cB + (size_t)(t + 2) * kstep;
            const char* a3 = a2 + kstep; const char* b3 = b2 + kstep;
            PG8_LDB(B0, 0, 0); PG8_LDB(B1, 0, 1); PG8_SCHED; PG8_LDA(At, 0, 0); PG8_STAGE(PG8_SA(1, 1), a1 + hstepA, voffA);
            PG8_WAIT_V(8); PG8_WAIT_L(0); PG8_BAR; PG8_MMA(0, 0, At, B0); PG8_MMA(0, 1, At, B1); PG8_BAR; PG8_SCHED;
            PG8_LDA(At, 0, 1); PG8_STAGE(PG8_SB(0, 0), b2, voffB); PG8_STAGE(PG8_SB(0, 1), b2 + hstepB, voffB); PG8_STAGE(PG8_SA(0, 0), a2, voffA);
            PG8_WAIT_V(8); PG8_WAIT_L(0); PG8_BAR; PG8_MMA(1, 0, At, B0); PG8_MMA(1, 1, At, B1); PG8_BAR; PG8_SCHED;
            PG8_LDB(B0, 1, 0); PG8_LDB(B1, 1, 1); PG8_SCHED; PG8_LDA(At, 1, 0); PG8_STAGE(PG8_SA(0, 1), a2 + hstepA, voffA);
            PG8_WAIT_V(8); PG8_WAIT_L(0); PG8_BAR; PG8_MMA(0, 0, At, B0); PG8_MMA(0, 1, At, B1); PG8_BAR; PG8_SCHED;
            PG8_LDA(At, 1, 1); PG8_STAGE(PG8_SB(1, 0), b3, voffB); PG8_STAGE(PG8_SB(1, 1), b3 + hstepB, voffB); PG8_STAGE(PG8_SA(1, 0), a3, voffA);
            PG8_WAIT_V(8); PG8_WAIT_L(0); PG8_BAR; PG8_MMA(1, 0, At, B0); PG8_MMA(1, 1, At, B1); PG8_BAR; PG8_SCHED;
        }
        if constexpr (ALIGN_EPI) { if (wr == 0) PG8_BAR; }
        E(acc, cur, wr, wc, fr, fq);
        if (!has_next) break;
#pragma unroll
        for (int a = 0; a < 2; ++a)
#pragma unroll
            for (int b = 0; b < 2; ++b)
#pragma unroll
                for (int m = 0; m < 4; ++m)
#pragma unroll
                    for (int n = 0; n < 2; ++n) acc[a][b][m][n] = (f32x4){0.f, 0.f, 0.f, 0.f};
        cur = nxt; cA = nA; cB = nB; ++ui;
        if constexpr (ALIGN_EPI) { if (wr == 1) PG8_BAR; }
    }
    PG8_WAIT_V(0);
    if constexpr (!ALIGN_EPI) { if (wr == 0) PG8_BAR; }
    PG8_BAR;
#undef PG8_SA
#undef PG8_SB
#undef PG8_STAGE
#undef PG8_LDA
#undef PG8_LDB
#undef PG8_MMA
#undef PG8_WAIT_V
#undef PG8_WAIT_L
#undef PG8_BAR
#undef PG8_SCHED
}
}

constexpr int BATCH = 2, SEQ = 4096, DM = 2048, M = BATCH * SEQ;
constexpr int NH = 16, DQK = 192, DNOPE = 128, DROPE = 64, DV = 128, QLORA = 512, KVLORA = 512;
constexpr int POOLW = 1024, DIN = 6208, DIN_PAD = 6400, DFF = 5632;
constexpr float EPS = 1e-6f;
constexpr int NWAVES = 8;

typedef unsigned short bf16;
typedef unsigned v4u __attribute__((ext_vector_type(4)));
typedef unsigned v2u __attribute__((ext_vector_type(2)));
typedef float f32x4 __attribute__((ext_vector_type(4)));
typedef short bf16x8 __attribute__((ext_vector_type(8)));
typedef short s16x4 __attribute__((ext_vector_type(4)));
typedef float f32x16 __attribute__((ext_vector_type(16)));
#define LAS __attribute__((address_space(3)))
#define LDS_WAIT() asm volatile("s_waitcnt lgkmcnt(0)" ::: "memory")

constexpr size_t MiB = 1u << 20;
constexpr size_t WS_WAO = 1 * MiB, WS_WOUT = 9 * MiB, WS_WPO = 17 * MiB, WS_WQB = 21 * MiB, WS_WKVB = 24 * MiB, WS_WPG = 28 * MiB, WS_KR = 29 * MiB;
constexpr size_t WS_G = 31 * MiB;
constexpr size_t WS_WIN = 95 * MiB, WS_XN = 120 * MiB, WS_C1 = 152 * MiB, WS_U = 184 * MiB;
constexpr size_t WS_Q = 95 * MiB, WS_K = 143 * MiB, WS_V = 191 * MiB, WS_CN = 223 * MiB, WS_POOLED = 239 * MiB, WS_PG = 255 * MiB;
constexpr size_t WS_MP = 223 * MiB, WS_O = 255 * MiB, WS_MIXED = 95 * MiB, WS_X1 = 127 * MiB, WS_H2 = 95 * MiB;
constexpr size_t WS_WGU = 191 * MiB, WS_WDN = 235 * MiB, WS_ACT = 1 * MiB;
constexpr size_t WS_END = 296 * MiB, WS_BAR = 512 * 1024, WS_KRP = 272 * MiB, WS_X1B = 257 * MiB;
constexpr int SV_BGATE = 0, SV_QAG = 4096, SV_KVAG = 4608, SV_QNG = 5120, SV_KNG = 5376, SV_PSC = 5632, SV_FNG = 6656, SV_POS = 8704, SV_END = 8704 + 8192, SV_SS = 32768;

constexpr int LDS_BYTES = 147456;

__device__ __forceinline__ unsigned cvtpk(float lo, float hi) { return pg8::cvt_pk_bf16(lo, hi); }
__device__ __forceinline__ float bflo(unsigned w) { return __uint_as_float(w << 16); }
__device__ __forceinline__ float bfhi(unsigned w) { return __uint_as_float(w & 0xffff0000u); }
__device__ __forceinline__ float wave_sum(float v) {
#pragma unroll
    for (int o = 1; o < 64; o <<= 1) v += __shfl_xor(v, o);
    return v;
}

__device__ __forceinline__ int dst_row(int mode, int n0) {
    if (mode == 1) { if (n0 < 1024) return n0; if (n0 < 1088) return 6144 + (n0 - 1024); if (n0 < 2112) return 1024 + (n0 - 1088); return 2048 + (n0 - 2112); }
    if (mode == 2) return (n0 >> 7) * 256 + (n0 & 127);
    if (mode == 3) return (n0 >> 7) * 256 + 128 + (n0 & 127);
    return n0;
}
__device__ __forceinline__ void transpose_item(const float* W, int K, int N, bf16* WT, int mode, int row_off, LAS float* scr, int item, int lane, const float* gk = nullptr) {
    const int nblk = N / 32, kb = item / nblk, nb = item % nblk, k0 = 64 * kb, n0 = 32 * nb;
    { float tv[32]; const float* wp = W + (size_t)(k0 + (lane >> 5)) * N + n0 + (lane & 31);
#pragma unroll
      for (int i = 0; i < 32; ++i) tv[i] = wp[(size_t)(2 * i) * N];
      if (gk) {
#pragma unroll
          for (int i = 0; i < 32; ++i) tv[i] *= gk[k0 + 2 * i + (lane >> 5)]; }
#pragma unroll
      for (int i = 0; i < 32; ++i) scr[(2 * i + (lane >> 5)) * 33 + (lane & 31)] = tv[i]; }
    LDS_WAIT(); asm volatile("" ::: "memory");
    const int c = lane & 7, dr = row_off + dst_row(mode, n0);
#pragma unroll
    for (int j = 0; j < 4; ++j) { const int n = (lane >> 3) + 8 * j; const LAS float* s = scr + (8 * c) * 33 + n;
        v4u o; o.x = cvtpk(s[0 * 33], s[1 * 33]); o.y = cvtpk(s[2 * 33], s[3 * 33]); o.z = cvtpk(s[4 * 33], s[5 * 33]); o.w = cvtpk(s[6 * 33], s[7 * 33]);
        *(v4u*)(WT + (size_t)(dr + n) * K + k0 + 8 * c) = o; }
    LDS_WAIT(); asm volatile("" ::: "memory");
}

struct TrDesc { const float* W; bf16* WT; const float* gk; int K, N, k0, n0, dr; };
__device__ __forceinline__ TrDesc tr_desc(const float* W, int K, int N, bf16* WT, int mode, int row_off, int item, const float* gk) {
    const int nblk = N / 32, kb = item / nblk, nb = item % nblk; TrDesc d; d.W = W; d.WT = WT; d.gk = gk; d.K = K; d.N = N; d.k0 = 64 * kb; d.n0 = 32 * nb; d.dr = row_off + dst_row(mode, d.n0); return d; }
__device__ __forceinline__ void tr_load(const TrDesc& d, float (&tv)[32], int lane) {
    const float* wp = d.W + (size_t)(d.k0 + (lane >> 5)) * d.N + d.n0 + (lane & 31);
#pragma unroll
    for (int i = 0; i < 32; ++i) tv[i] = __builtin_nontemporal_load(wp + (size_t)(2 * i) * d.N);
}
__device__ __forceinline__ void tr_finish(const TrDesc& d, float (&tv)[32], LAS float* scr, int lane) {
    if (d.gk) {
#pragma unroll
        for (int i = 0; i < 32; ++i) tv[i] *= d.gk[d.k0 + 2 * i + (lane >> 5)]; }
#pragma unroll
    for (int i = 0; i < 32; ++i) scr[(2 * i + (lane >> 5)) * 33 + (lane & 31)] = tv[i];
    LDS_WAIT(); asm volatile("" ::: "memory");
    const int c = lane & 7;
#pragma unroll
    for (int j = 0; j < 4; ++j) { const int n = (lane >> 3) + 8 * j; const LAS float* s_ = scr + (8 * c) * 33 + n;
        v4u o; o.x = cvtpk(s_[0 * 33], s_[1 * 33]); o.y = cvtpk(s_[2 * 33], s_[3 * 33]); o.z = cvtpk(s_[4 * 33], s_[5 * 33]); o.w = cvtpk(s_[6 * 33], s_[7 * 33]);
        *(v4u*)(d.WT + (size_t)(d.dr + n) * d.K + d.k0 + 8 * c) = o; }
    LDS_WAIT(); asm volatile("" ::: "memory");
}
#define TR_PIPELINE(FIRST, LIMIT, STRIDE, MAKE_DESC) do { int it_ = (FIRST); if (it_ < (LIMIT)) { TrDesc dA_ = MAKE_DESC(it_); float tvA_[32]; tr_load(dA_, tvA_, lane); \
        for (;;) { const int nx_ = it_ + (STRIDE); const bool more_ = nx_ < (LIMIT); TrDesc dB_ = dA_; float tvB_[32]; \
            if (more_) { dB_ = MAKE_DESC(nx_); tr_load(dB_, tvB_, lane); } \
            tr_finish(dA_, tvA_, scr, lane); if (!more_) break; \
            dA_ = dB_; _Pragma("unroll") for (int i_ = 0; i_ < 32; ++i_) tvA_[i_] = tvB_[i_]; it_ = nx_; } } } while (0)

__device__ __forceinline__ void rms_row_2048(const float* xrow, const float* g, bf16* orow, int lane) {
    const f32x4* xr = (const f32x4*)xrow + lane; const f32x4* gr = (const f32x4*)g + lane;
    f32x4 v[8]; float s = 0.f;
#pragma unroll
    for (int j = 0; j < 8; ++j) { v[j] = __builtin_nontemporal_load(xr + 64 * j); s += (v[j].x * v[j].x + v[j].y * v[j].y) + (v[j].z * v[j].z + v[j].w * v[j].w); }
    const float inv = 1.0f / sqrtf(wave_sum(s) * (1.f / 2048.f) + EPS);
    v2u* o8 = (v2u*)orow + lane;
#pragma unroll
    for (int j = 0; j < 8; ++j) { const f32x4 gv = gr[64 * j]; v2u o; o.x = cvtpk(v[j].x * inv * gv.x, v[j].y * inv * gv.y); o.y = cvtpk(v[j].z * inv * gv.z, v[j].w * inv * gv.w); o8[64 * j] = o; }
}

namespace att {
constexpr int QBLK = 32, KVBLK = 64, QB = 256;
constexpr int SHM_V = KVBLK * DV * 2, SHM_K = KVBLK * DQK * 2;
constexpr int OFF_V = 0, OFF_K = 3 * SHM_V, OFF_WS = OFF_K + 2 * SHM_K;
constexpr float SCALE = 0.07216878364870322f;
constexpr float THR = 8.f;
#define KSWZ(row, colB) ((row) * 384 + ((colB) ^ (((row) & 7) << 4)))
#define SBAR() __builtin_amdgcn_sched_barrier(0)
__device__ __forceinline__ int v_st(int k, int c) { const int kk = (k & ~0xC) | ((k & 4) << 1) | ((k & 8) >> 1); return ((kk >> 3) * 4 + (c >> 5)) * 512 + ((kk & 7) * 32 + (c & 31)) * 2; }
__device__ __forceinline__ int v_rd_base(int lane) { return ((lane & 3) << 3) | (((lane >> 2) & 3) << 6) | (((lane >> 4) & 1) << 5) | (((lane >> 5) & 1) << 8); }
__device__ __forceinline__ int crow(int r, int hi) { return (r & 3) + 8 * (r >> 2) + 4 * hi; }
__device__ __forceinline__ void mask_tile(f32x16& p0, f32x16& p1, int dq) {
    const float NEG = -__builtin_inff();
#pragma unroll
    for (int r = 0; r < 16; ++r) {
        const int c = (r & 3) + 8 * (r >> 2);
        if (dq - c < 0) p0[r] = NEG;
        if (dq - c - 32 < 0) p1[r] = NEG;
    }
}
__device__ __forceinline__ void partialSM(f32x16& p0, f32x16& p1, float& m_reg, float& mn, float& alpha) {
    float pmax = p0[0];
#pragma unroll
    for (int r = 1; r < 16; ++r) pmax = fmaxf(pmax, p0[r]);
#pragma unroll
    for (int r = 0; r < 16; ++r) pmax = fmaxf(pmax, p1[r]);
    { auto rr = __builtin_amdgcn_permlane32_swap(__float_as_uint(pmax), __float_as_uint(pmax), false, false);
      pmax = fmaxf(__uint_as_float(rr[0]), __uint_as_float(rr[1])); }
    constexpr float C2 = 1.4426950408889634f * SCALE;
    if (__builtin_expect(__all((pmax - m_reg) * SCALE <= THR), 1)) { mn = m_reg; alpha = 1.f; }
    else { mn = fmaxf(m_reg, pmax); alpha = __builtin_amdgcn_exp2f((m_reg - mn) * C2); m_reg = mn; }
    const float mnL = -mn * C2;
#pragma unroll
    for (int r = 0; r < 16; ++r) p0[r] = fmaf(p0[r], C2, mnL);
#pragma unroll
    for (int r = 0; r < 16; ++r) p1[r] = fmaf(p1[r], C2, mnL);
#pragma unroll
    for (int r = 0; r < 16; ++r) p0[r] = __builtin_amdgcn_exp2f(p0[r]);
}
__device__ __forceinline__ void finishSM(f32x16& p0, f32x16& p1, float alpha, float& l_reg, bf16x8& pa0, bf16x8& pa1, bf16x8& pa2, bf16x8& pa3) {
#pragma unroll
    for (int r = 0; r < 16; ++r) p1[r] = __builtin_amdgcn_exp2f(p1[r]);
    float ps = 0;
#pragma unroll
    for (int r = 0; r < 16; ++r) ps += p0[r];
#pragma unroll
    for (int r = 0; r < 16; ++r) ps += p1[r];
    { auto rr = __builtin_amdgcn_permlane32_swap(__float_as_uint(ps), __float_as_uint(ps), false, false);
      ps = __uint_as_float(rr[0]) + __uint_as_float(rr[1]); }
    l_reg = l_reg * alpha + ps;
#define PK4(P, B_, OUT) do { unsigned a0 = cvtpk(P[B_+0], P[B_+1]), a1 = cvtpk(P[B_+2], P[B_+3]);                          \
        unsigned b0 = cvtpk(P[B_+4], P[B_+5]), b1 = cvtpk(P[B_+6], P[B_+7]);                                             \
        auto r0 = __builtin_amdgcn_permlane32_swap(a0, b0, false, false); auto r1 = __builtin_amdgcn_permlane32_swap(a1, b1, false, false); \
        v4u w = {r0[0], r1[0], r0[1], r1[1]}; OUT = *reinterpret_cast<bf16x8*>(&w); } while (0)
    PK4(p0, 0, pa0); PK4(p0, 8, pa1); PK4(p1, 0, pa2); PK4(p1, 8, pa3);
#undef PK4
}
__device__ __forceinline__ void qkt(f32x16& p0, f32x16& p1, const char* Kb, int r32, int hi, const bf16x8* qr) {
    p0 = f32x16{}; p1 = f32x16{};
    const char* kb[4];
#pragma unroll
    for (int dd = 0; dd < 4; ++dd) kb[dd] = Kb + KSWZ(r32, (dd * 16 + hi * 8) * 2);
#pragma unroll
    for (int g = 0; g < 2; ++g) { bf16x8 b0[6], b1[6];
#pragma unroll
        for (int i = 0; i < 6; ++i) { const int d0 = 6 * g + i; const char* a = kb[d0 & 3] + (d0 >> 2) * 128; b0[i] = *reinterpret_cast<const bf16x8*>(a); b1[i] = *reinterpret_cast<const bf16x8*>(a + 32 * 384); }
        SBAR();
        __builtin_amdgcn_s_setprio(1);
#pragma unroll
        for (int i = 0; i < 6; ++i) { p0 = __builtin_amdgcn_mfma_f32_32x32x16_bf16(b0[i], qr[6 * g + i], p0, 0, 0, 0); p1 = __builtin_amdgcn_mfma_f32_32x32x16_bf16(b1[i], qr[6 * g + i], p1, 0, 0, 0); }
        __builtin_amdgcn_s_setprio(0);
        SBAR(); }
}
__device__ __forceinline__ void pv_tile(f32x16* o, int vb0, bf16x8 pa0, bf16x8 pa1, bf16x8 pa2, bf16x8 pa3) {
#define TRRD(dst, off) asm volatile("ds_read_b64_tr_b16 %0, %1 offset:%2" : "=&v"(dst) : "v"(vb0), "i"(off) : "memory")
#define PV_RD(S, d0) do { constexpr int b_ = (d0) * 512; TRRD(S##l0, b_); TRRD(S##h0, b_ + 2048); TRRD(S##l1, b_ + 4096); TRRD(S##h1, b_ + 6144); TRRD(S##l2, b_ + 8192); TRRD(S##h2, b_ + 10240); TRRD(S##l3, b_ + 12288); TRRD(S##h3, b_ + 14336); } while (0)
#define PV_MM(S, d0) do { \
        o[d0] = __builtin_amdgcn_mfma_f32_32x32x16_bf16(pa0, (bf16x8){S##l0[0], S##l0[1], S##l0[2], S##l0[3], S##h0[0], S##h0[1], S##h0[2], S##h0[3]}, o[d0], 0, 0, 0);   \
        o[d0] = __builtin_amdgcn_mfma_f32_32x32x16_bf16(pa1, (bf16x8){S##l1[0], S##l1[1], S##l1[2], S##l1[3], S##h1[0], S##h1[1], S##h1[2], S##h1[3]}, o[d0], 0, 0, 0);   \
        o[d0] = __builtin_amdgcn_mfma_f32_32x32x16_bf16(pa2, (bf16x8){S##l2[0], S##l2[1], S##l2[2], S##l2[3], S##h2[0], S##h2[1], S##h2[2], S##h2[3]}, o[d0], 0, 0, 0);   \
        o[d0] = __builtin_amdgcn_mfma_f32_32x32x16_bf16(pa3, (bf16x8){S##l3[0], S##l3[1], S##l3[2], S##l3[3], S##h3[0], S##h3[1], S##h3[2], S##h3[3]}, o[d0], 0, 0, 0); } while (0)
    s16x4 Al0, Al1, Al2, Al3, Ah0, Ah1, Ah2, Ah3, Bl0, Bl1, Bl2, Bl3, Bh0, Bh1, Bh2, Bh3;
    PV_RD(A, 0); PV_RD(B, 1);
    asm volatile("s_waitcnt lgkmcnt(8)" ::: "memory"); SBAR(); PV_MM(A, 0); SBAR();
    PV_RD(A, 2);
    asm volatile("s_waitcnt lgkmcnt(8)" ::: "memory"); SBAR(); PV_MM(B, 1); SBAR();
    PV_RD(B, 3);
    asm volatile("s_waitcnt lgkmcnt(8)" ::: "memory"); SBAR(); PV_MM(A, 2); SBAR();
    asm volatile("s_waitcnt lgkmcnt(0)" ::: "memory"); SBAR(); PV_MM(B, 3);
#undef PV_MM
#undef PV_RD
#undef TRRD
}
__device__ __forceinline__ void attn_unit(int b, int h, int qb, const bf16* Q, const bf16* K, const bf16* V, bf16* O, char* lds) {
    const int tid = threadIdx.x, wid = __builtin_amdgcn_readfirstlane(tid >> 6), lane = tid & 63, r32 = lane & 31, hi = lane >> 5;
    const size_t rowb = (size_t)b * SEQ;
    const int q0 = qb * QB, qlo = q0 + wid * QBLK;
    const int NT = (q0 + QB) / KVBLK;
    char* V_lds = lds + OFF_V; char* K_lds = lds + OFF_K;
#define WAVE_WS() ({ int t_ = (int)threadIdx.x; asm volatile("" : "+v"(t_)); (float*)(lds + OFF_WS) + (t_ >> 6) * 64; })
    LAS unsigned char* ldsl_ = (LAS unsigned char*)lds;
    unsigned ksrc[3], vsrc[2];
#pragma unroll
    for (int j = 0; j < 3; ++j) { const int s_ = (wid * 3 + j) * 64 + lane, row = s_ / 24, pc = s_ % 24; ksrc[j] = (unsigned)(row * 3072 * 2 + ((pc * 16) ^ ((row & 7) << 4))); }
#pragma unroll
    for (int j = 0; j < 2; ++j) { const int ob = ((wid * 2 + j) * 64 + lane) * 16, st = ob >> 9, kr_ = (ob >> 6) & 7, ch = (ob >> 4) & 3, c = (st & 3) * 32 + ch * 8, kk = (st >> 2) * 8 + kr_,
                                  k = (kk & ~0xC) | ((kk & 4) << 1) | ((kk & 8) >> 1); vsrc[j] = (unsigned)(k * 2048 * 2 + c * 2); }
    const char* Kh = (const char*)(K + rowb * 3072 + h * DQK); const char* Vh = (const char*)(V + rowb * 2048 + h * DV);
#define KDMA(k0, bf) do { _Pragma("unroll") for (int j = 0; j < 3; ++j) __builtin_amdgcn_global_load_lds((const unsigned*)(Kh + (size_t)(k0) * (3072 * 2) + ksrc[j]), \
        (LAS unsigned*)(ldsl_ + OFF_K + (bf) * SHM_K + (wid * 3 + j) * 1024), 16, 0, 0); } while (0)
#define VDMA(k0, sl) do { _Pragma("unroll") for (int j = 0; j < 2; ++j) __builtin_amdgcn_global_load_lds((const unsigned*)(Vh + (size_t)(k0) * (2048 * 2) + vsrc[j]), \
        (LAS unsigned*)(ldsl_ + OFF_V + (sl) * SHM_V + (wid * 2 + j) * 1024), 16, 0, 0); } while (0)
    KDMA(0, 0); VDMA(0, 0);
    bf16x8 qr[12];
    { const bf16* Qp = Q + (rowb + qlo + r32) * 3072 + h * DQK + hi * 8;
#pragma unroll
      for (int d0 = 0; d0 < 12; ++d0) qr[d0] = *(const bf16x8*)(Qp + d0 * 16); }
    asm volatile("s_waitcnt vmcnt(0)" ::: "memory");
    __syncthreads();
    float m_reg = -1e30f, l_reg = 0.f; f32x16 o[4] = {};
    const int vbase = (int)(uintptr_t)V_lds + v_rd_base(lane);
    const int qm = qlo + r32 - 4 * hi;
    f32x16 p0, p1;
#define SP_STAGE(VS) do { float mn, alpha; bf16x8 pa0, pa1, pa2, pa3; \
        partialSM(p0, p1, m_reg, mn, alpha); finishSM(p0, p1, alpha, l_reg, pa0, pa1, pa2, pa3); \
        if (__any(alpha < 1.f)) { float* al_l = WAVE_WS() + 32; if (hi == 0) al_l[r32] = alpha; asm volatile("s_waitcnt lgkmcnt(0)" ::: "memory"); \
            _Pragma("unroll") for (int d_ = 0; d_ < 4; ++d_) _Pragma("unroll") for (int r = 0; r < 16; ++r) o[d_][r] *= al_l[crow(r, hi)]; } \
        SBAR(); pv_tile(o, vbase + (VS) * SHM_V, pa0, pa1, pa2, pa3); } while (0)
    for (int t = 0; t < NT; ++t) {
        const int cur = t & 1, kb_ = t * KVBLK;
        if (t + 1 < NT) { KDMA((t + 1) * KVBLK, cur ^ 1); VDMA((t + 1) * KVBLK, cur ^ 1); }
        SBAR();
        qkt(p0, p1, K_lds + cur * SHM_K, r32, hi, qr); if (kb_ + KVBLK - 1 > qlo) mask_tile(p0, p1, qm - kb_);
        SBAR();
        SP_STAGE(cur);
        asm volatile("s_waitcnt vmcnt(0)" ::: "memory");
        __syncthreads();
    }
#undef SP_STAGE
    float* li_l = WAVE_WS();
    if (hi == 0) li_l[r32] = l_reg; asm volatile("s_waitcnt lgkmcnt(0)" ::: "memory");
    float rli[16];
#pragma unroll
    for (int r = 0; r < 16; ++r) rli[r] = __builtin_amdgcn_rcpf(li_l[crow(r, hi)]);
    bf16* Ow = O + (rowb + qlo) * 2048 + h * DV;
#pragma unroll
    for (int r = 0; r < 16; ++r) { const int orow = crow(r, hi);
#pragma unroll
        for (int d0 = 0; d0 < 4; ++d0) { const float v = o[d0][r] * rli[r];
            const float vn = __shfl_xor(v, 1);
            if ((r32 & 1) == 0) *(unsigned*)(Ow + (size_t)orow * 2048 + d0 * 32 + r32) = cvtpk(v, vn); } }
    __syncthreads();
#undef KDMA
#undef VDMA
#undef WAVE_WS
}
#undef SBAR
}

struct Args { const float* in[20]; float* out; unsigned char* ws; int ph_lo, ph_hi, coop, pad; };
#define XB_TMO      128
#define XB_XCNT(j)  (256  + 64 * (j))
#define XB_XSUB(j)  (1280 + 64 * (j))
#define XB_XGEN(j)  (2304 + 64 * (j))
#define XB_TOP      3328
#define XB_TOPGEN   3392
#define XCD_BAR_WORDS 3456
#define XB_SPIN_CAP (1u << 20)
__device__ __forceinline__ unsigned xb_ld(unsigned* p)              { return __hip_atomic_load(p, __ATOMIC_RELAXED, __HIP_MEMORY_SCOPE_AGENT); }
__device__ __forceinline__ unsigned xb_add(unsigned* p, unsigned v) { return __hip_atomic_fetch_add(p, v, __ATOMIC_RELAXED, __HIP_MEMORY_SCOPE_AGENT); }
__device__ __forceinline__ unsigned xb_xcc_id() { return (unsigned)__builtin_amdgcn_s_getreg((3 << 11) | 20) & 0xFu; }
#define XB_SPIN(cond, bar) do { unsigned _sp = 0; while (cond) { __builtin_amdgcn_s_sleep(1); \
    if ((++_sp & 255u) == 0u) { if (xb_ld(&(bar)[XB_TMO])) break; if (_sp > XB_SPIN_CAP) { atomicAdd(&(bar)[XB_TMO], 1u); break; } } } } while (0)
__device__ __forceinline__ void xcd_barrier_complete(unsigned* bar, unsigned x, unsigned& nloc, unsigned& nx) {
    const unsigned G = gridDim.x;
    unsigned sum, cnt, mine, sp = 0u;
    for (;;) {
        sum = 0u; cnt = 0u; mine = 0u;
#pragma unroll
        for (unsigned j = 0; j < 16; ++j) { const unsigned c = xb_ld(&bar[XB_XCNT(j)]); sum += c; cnt += (c > 0u) ? 1u : 0u; mine = (j == x) ? c : mine; }
        if (sum == G) break;
        __builtin_amdgcn_s_sleep(1);
        if ((++sp & 255u) == 0u) { if (xb_ld(&bar[XB_TMO])) break; if (sp > XB_SPIN_CAP) { atomicAdd(&bar[XB_TMO], 1u); break; } }
    }
    nloc = mine > 0u ? mine : 1u; nx = cnt > 0u ? cnt : 1u;
}
__device__ __forceinline__ void grid_bar(unsigned* bar, volatile LAS unsigned* st) {
    asm volatile("s_waitcnt vmcnt(0)" ::: "memory");
    __syncthreads();
    if (threadIdx.x == 0) {
        const unsigned x = xb_xcc_id();
        __builtin_amdgcn_s_waitcnt(0);
        unsigned nloc = st[0], nx = st[1];
        if (nloc == 0u) { xcd_barrier_complete(bar, x, nloc, nx); st[0] = nloc; st[1] = nx; }
        const unsigned old = xb_add(&bar[XB_XSUB(x)], 1u);
        const unsigned gen = old / nloc;
        if (old + 1u == (gen + 1u) * nloc) {
            __builtin_amdgcn_fence(__ATOMIC_RELEASE, "agent");
            asm volatile("s_waitcnt vmcnt(0)" ::: "memory");
            const unsigned og = xb_add(&bar[XB_TOP], 1u);
            const unsigned tg = og / nx;
            if (og + 1u == (tg + 1u) * nx) xb_add(&bar[XB_TOPGEN], 1u);
            else XB_SPIN(xb_ld(&bar[XB_TOPGEN]) == tg, bar);
            __builtin_amdgcn_fence(__ATOMIC_ACQUIRE, "agent");
            xb_add(&bar[XB_XGEN(x)], 1u);
            asm volatile("s_waitcnt vmcnt(0)" ::: "memory");
        } else {
            XB_SPIN(xb_ld(&bar[XB_XGEN(x)]) == gen, bar);
            __builtin_amdgcn_fence(__ATOMIC_ACQUIRE, "agent");
            asm volatile("s_waitcnt vmcnt(0)" ::: "memory");
        }
    }
    __syncthreads();
}
constexpr int NPH = 11;

__global__ void __launch_bounds__(NWAVES * 64, 2) mega_fwd(Args args) {
    extern __shared__ __attribute__((aligned(16))) unsigned char lds[];
    LAS unsigned char* ldsl = (LAS unsigned char*)lds;
    const int tid = threadIdx.x, lane = tid & 63, wave = __builtin_amdgcn_readfirstlane(tid >> 6);
    const int G = gridDim.x, bx = blockIdx.x;
    const int vcu = (G % 8 == 0) ? (bx % 8) * (G / 8) + bx / 8 : bx;
    const int gw = vcu * NWAVES + wave, NGW = G * NWAVES;
    unsigned char* ws = args.ws;
    const float* const* kin = (const float* const*)__builtin_amdgcn_kernarg_segment_ptr();
    const float* svec = (const float*)ws;
    const float* b_gate = svec + SV_BGATE; const float* q_a_norm_g = svec + SV_QAG; const float* kv_a_norm_g = svec + SV_KVAG; const float* q_norm_g = svec + SV_QNG;
    const float* k_norm_g = svec + SV_KNG; const float* pool_scale = svec + SV_PSC; const float* ffn_norm_g = svec + SV_FNG; const int* positions = (const int*)(svec + SV_POS);
    bf16* WIN_T = (bf16*)(ws + WS_WIN); bf16* WQB_T = (bf16*)(ws + WS_WQB); bf16* WKVB_T = (bf16*)(ws + WS_WKVB); bf16* WPG_T = (bf16*)(ws + WS_WPG);
    bf16* WPO_T = (bf16*)(ws + WS_WPO); bf16* WAO_T = (bf16*)(ws + WS_WAO); bf16* WOUT_T = (bf16*)(ws + WS_WOUT); bf16* WGU_T = (bf16*)(ws + WS_WGU); bf16* WDN_T = (bf16*)(ws + WS_WDN);
    bf16* XN = (bf16*)(ws + WS_XN); float* C1 = (float*)(ws + WS_C1); float* KRP = (float*)(ws + WS_KRP); bf16* U = (bf16*)(ws + WS_U); bf16* Gt = (bf16*)(ws + WS_G);
    bf16* CN = (bf16*)(ws + WS_CN); bf16* POOLED = (bf16*)(ws + WS_POOLED); bf16* Qb = (bf16*)(ws + WS_Q); bf16* Kb = (bf16*)(ws + WS_K); bf16* Vb = (bf16*)(ws + WS_V);
    bf16* PG = (bf16*)(ws + WS_PG); bf16* MP = (bf16*)(ws + WS_MP); bf16* Ob = (bf16*)(ws + WS_O); bf16* MIXED = (bf16*)(ws + WS_MIXED);
    float* X1 = (float*)(ws + WS_X1); bf16* H2 = (bf16*)(ws + WS_H2); bf16* ACT = (bf16*)(ws + WS_ACT);

    const int lo = args.ph_lo, hi_ph = args.ph_hi;
#ifndef PHMASK
#define PHMASK 0x7ff
#endif
#define IN(k) (((PHMASK >> (k)) & 1) && lo <= (k) && (k) < hi_ph)
#define SEAM(k) do { if (IN(k) && IN((k) + 1)) { unsigned char* w2_ = args.ws; asm volatile("" : "+s"(w2_)); grid_bar((unsigned*)(w2_ + WS_BAR), (volatile LAS unsigned*)(ldsl + 140032)); } } while (0)
    if (args.coop > 1) cg::this_grid().sync();
    if (threadIdx.x < 2) ((volatile LAS unsigned*)(ldsl + 140032))[threadIdx.x] = 0u;
    __syncthreads();
    if (args.coop && threadIdx.x == 0) { unsigned char* w2_ = args.ws; asm volatile("" : "+s"(w2_)); (void)xb_add(&((unsigned*)(w2_ + WS_BAR))[XB_XCNT(xb_xcc_id())], 1u); }
    LAS float* scr = (LAS float*)(ldsl + wave * 16384);
#ifdef TPROBE
#define TP_BEGIN(k) do { if ((TPROBE >> (k)) & 1) { if (blockIdx.x == 0 && threadIdx.x == 0) { *(volatile LAS unsigned*)(ldsl + 140000) = (unsigned)__builtin_amdgcn_s_memrealtime(); } } } while (0)
#define TP_END(k) do { if ((TPROBE >> (k)) & 1) { if (blockIdx.x == 0 && threadIdx.x == 0) { volatile LAS unsigned* tp_ = (volatile LAS unsigned*)(ldsl + 140000); tp_[1] += (unsigned)__builtin_amdgcn_s_memrealtime() - tp_[0]; } } } while (0)
    if (blockIdx.x == 0 && threadIdx.x == 0) { ((volatile LAS unsigned*)(ldsl + 140000))[1] = 0u; }
#else
#define TP_BEGIN(k) do {} while (0)
#define TP_END(k) do {} while (0)
#endif

    if (IN(0)) { TP_BEGIN(0);
        { float* sv = (float*)ws; const int gt = bx * (NWAVES * 64) + tid, GT = G * NWAVES * 64;
          for (int i = gt; i < M; i += GT) sv[SV_SS + i] = 0.f;
          for (int i = gt; i < SV_END; i += GT) { int idx, off, lim = 1 << 30;
              if (i < SV_QAG) { idx = 4; off = SV_BGATE; } else if (i < SV_KVAG) { idx = 5; off = SV_QAG; } else if (i < SV_QNG) { idx = 7; off = SV_KVAG; }
              else if (i < SV_KNG) { idx = 9; off = SV_QNG; lim = 192; } else if (i < SV_PSC) { idx = 10; off = SV_KNG; lim = 192; }
              else if (i < SV_FNG) { idx = 13; off = SV_PSC; } else if (i < SV_POS) { idx = 16; off = SV_FNG; } else { idx = 1; off = SV_POS; }
              const float* src = kin[idx]; sv[i] = (i - off < lim) ? src[i - off] : 0.f; } }
        constexpr int I_IN = (DM / 64) * (DIN / 32), I_QB = (QLORA / 64) * (NH * DQK / 32), I_KVB = (KVLORA / 64) * (NH * 256 / 32), I_PG = (256 / 64) * (256 / 32),
                      I_PO = (POOLW / 64) * (DM / 32), I_AO = (DM / 64) * (DM / 32), I_OUT = I_AO;
        constexpr int NITEMS = I_IN + I_QB + I_KVB + 4 * I_PG + I_PO + I_AO + I_OUT;
#define P0_DESC(it__) ([&]() { int r = (it__), idx, Kd, Nd, mode = 0, roff = 0; size_t dsto, srco = 0; \
            if (r < I_IN) { idx = 3; Kd = DM; Nd = DIN; mode = 1; dsto = WS_WIN; } \
            else if ((r -= I_IN) < I_QB) { idx = 6; Kd = QLORA; Nd = NH * DQK; dsto = WS_WQB; } \
            else if ((r -= I_QB) < I_KVB) { idx = 8; Kd = KVLORA; Nd = NH * 256; dsto = WS_WKVB; } \
            else if ((r -= I_KVB) < 4 * I_PG) { const int g = r / I_PG; r = r % I_PG; idx = 12; Kd = 256; Nd = 256; dsto = WS_WPG; roff = g * 256; srco = (size_t)g * 65536; } \
            else if ((r -= 4 * I_PG) < I_PO) { idx = 14; Kd = POOLW; Nd = DM; dsto = WS_WPO; } \
            else if ((r -= I_PO) < I_AO) { idx = 11; Kd = DM; Nd = DM; dsto = WS_WAO; } \
            else { r -= I_AO; idx = 15; Kd = DM; Nd = DM; dsto = WS_WOUT; } \
            return tr_desc(kin[idx] + srco, Kd, Nd, (bf16*)(ws + dsto), mode, roff, r, nullptr); }())
        TR_PIPELINE(gw, NITEMS, NGW, P0_DESC);
#undef P0_DESC
        { v4u* z = (v4u*)(WIN_T + (size_t)DIN * DM); const int nz = (DIN_PAD - DIN) * DM / 8;
          for (int i = gw * 64 + lane; i < nz; i += NGW * 64) z[i] = (v4u){0u, 0u, 0u, 0u}; }
        { const float* x = kin[0]; const float* attn_norm_g = kin[2];
          for (int m = gw; m < M; m += NGW) rms_row_2048(x + (size_t)m * DM, attn_norm_g, XN + (size_t)m * DM, lane); }
    TP_END(0); }
    SEAM(0);
    if (IN(1)) { TP_BEGIN(1);
        { pg8::Gemm g{XN, WIN_T, M, 6144, DM, DM, DM, 0, 0}; pg8::StaticOrder S; S.init(M, 6144, G, bx);
          pg8::EpiIn E{C1, U, Gt, b_gate};
          pg8::gemm_phase<pg8::EpiIn, pg8::StaticOrder>(ldsl, g, S, E); }
        { pg8::Gemm g{XN, WIN_T + (size_t)6144 * DM, M, 2048, 256, DM, DM, 256, 256}; pg8::StaticOrder S; S.init(M, 2048, G, bx);
          pg8::EpiKRP E{KRP};
          pg8::gemm_phase<pg8::EpiKRP, pg8::StaticOrder>(ldsl, g, S, E); }
    TP_END(1); }
    SEAM(1);
    if (IN(2)) { TP_BEGIN(2);
        for (int m = gw; m < M; m += NGW) {
            const f32x4* c = (const f32x4*)(C1 + (size_t)m * 1024) + lane; f32x4 v[4]; float sq = 0.f, skv = 0.f;
#pragma unroll
            for (int j = 0; j < 4; ++j) { v[j] = __builtin_nontemporal_load(c + 64 * j); const float s = (v[j].x * v[j].x + v[j].y * v[j].y) + (v[j].z * v[j].z + v[j].w * v[j].w); if (j < 2) sq += s; else skv += s; }
            const float iq = 1.0f / sqrtf(wave_sum(sq) * (1.f / 512.f) + EPS), ikv = 1.0f / sqrtf(wave_sum(skv) * (1.f / 512.f) + EPS);
            v2u* o8 = (v2u*)(CN + (size_t)m * 1024) + lane;
#pragma unroll
            for (int j = 0; j < 4; ++j) { const f32x4 gv = (j < 2) ? ((const f32x4*)q_a_norm_g)[lane + 64 * j] : ((const f32x4*)kv_a_norm_g)[lane + 64 * (j - 2)]; const float iv = (j < 2) ? iq : ikv;
                v2u o; o.x = cvtpk(v[j].x * iv * gv.x, v[j].y * iv * gv.y); o.y = cvtpk(v[j].z * iv * gv.z, v[j].w * iv * gv.w); o8[64 * j] = o; }
        }
        for (int base = gw * 4; base < M; base += NGW * 4) {
            const int s0 = base & (SEQ - 1);
#pragma unroll
            for (int jj = 0; jj < 2; ++jj) {
                const int col = 8 * lane + 512 * jj, grp = col >> 8, w = 2 << grp; int cnt = (s0 + 1 < w) ? s0 + 1 : w;
                float a[8], uc[8];
#pragma unroll
                for (int e = 0; e < 8; ++e) a[e] = 0.f;
#pragma unroll
                for (int d = 0; d < 16; ++d) {
                    if (d < cnt) { const v4u q = *(const v4u*)(U + (size_t)(base - d) * 1024 + col);
                        const float f[8] = {bflo(q.x), bfhi(q.x), bflo(q.y), bfhi(q.y), bflo(q.z), bfhi(q.z), bflo(q.w), bfhi(q.w)};
#pragma unroll
                        for (int e = 0; e < 8; ++e) { a[e] += f[e]; if (d == 0) uc[e] = f[e]; } }
                }
#pragma unroll
                for (int i = 0; i < 4; ++i) {
                    const int m = base + i;
                    if (i > 0) { const int s = s0 + i;
                        { const v4u q = *(const v4u*)(U + (size_t)m * 1024 + col);
                          uc[0] = bflo(q.x); uc[1] = bfhi(q.x); uc[2] = bflo(q.y); uc[3] = bfhi(q.y); uc[4] = bflo(q.z); uc[5] = bfhi(q.z); uc[6] = bflo(q.w); uc[7] = bfhi(q.w); }
#pragma unroll
                        for (int e = 0; e < 8; ++e) a[e] += uc[e];
                        if (s >= w) { const v4u q = *(const v4u*)(U + (size_t)(m - w) * 1024 + col);
                            a[0] -= bflo(q.x); a[1] -= bfhi(q.x); a[2] -= bflo(q.y); a[3] -= bfhi(q.y); a[4] -= bflo(q.z); a[5] -= bfhi(q.z); a[6] -= bflo(q.w); a[7] -= bfhi(q.w); }
                        cnt = (s + 1 < w) ? s + 1 : w; }
                    const float rc = 1.0f / (float)cnt;
                    v4u o; o.x = cvtpk(a[0] * rc - uc[0], a[1] * rc - uc[1]); o.y = cvtpk(a[2] * rc - uc[2], a[3] * rc - uc[3]);
                    o.z = cvtpk(a[4] * rc - uc[4], a[5] * rc - uc[5]); o.w = cvtpk(a[6] * rc - uc[6], a[7] * rc - uc[7]);
                    *(v4u*)(POOLED + (size_t)m * 1024 + col) = o;
                }
            }
        }
    TP_END(2); }
    SEAM(2);
    if (IN(3)) { TP_BEGIN(3);
        { pg8::Gemm g{CN, WQB_T, M, NH * DQK, QLORA, 1024, QLORA, 0, 0}; pg8::StaticOrder S; S.init(M, NH * DQK, G, bx);
          pg8::EpiBf16 E{Qb, 3072}; pg8::gemm_phase<pg8::EpiBf16, pg8::StaticOrder>(ldsl, g, S, E); }
        { pg8::Gemm g{CN + 512, WKVB_T, M, NH * 256, KVLORA, 1024, KVLORA, 0, 0}; pg8::StaticOrder S; S.init(M, NH * 256, G, bx);
          pg8::EpiKV E{Kb, Vb}; pg8::gemm_phase<pg8::EpiKV, pg8::StaticOrder>(ldsl, g, S, E); }
        { pg8::Gemm g{POOLED, WPG_T, M, POOLW, 256, 1024, 256, 256, 0}; pg8::StaticOrder S; S.init(M, POOLW, G, (bx + 128) % G);
          pg8::EpiScale E{PG, 1024, pool_scale}; pg8::gemm_phase<pg8::EpiScale, pg8::StaticOrder>(ldsl, g, S, E); }
    TP_END(3); }
    SEAM(3);
    if (IN(4)) { TP_BEGIN(4);
        for (int m = gw; m < M; m += NGW) {
            const float pos = (float)positions[m];
            const int sub = lane & 3, h = lane >> 2;
            float cs[8], sn[8];
#pragma unroll
            for (int j = 0; j < 8; ++j) { const int i = 8 * sub + j; const float invf = __builtin_amdgcn_exp2f(-(float)i * (13.287712379549449f / 32.f));
                const float ang = pos * invf; const float k = rintf(ang * 0.15915494309189535f);
                float r = fmaf(-k, 6.2831854820251465f, ang); r = fmaf(-k, -1.7484555e-7f, r);
                sn[j] = __sinf(r); cs[j] = __cosf(r); }
#pragma unroll
            for (int which = 0; which < 2; ++which) {
                bf16* base = (which == 0 ? Qb : Kb) + (size_t)m * 3072 + h * DQK;
                const float* gn = (which == 0) ? q_norm_g : k_norm_g;
                float nv[32], rl[8], rh[8]; float ss = 0.f;
#pragma unroll
                for (int jj = 0; jj < 4; ++jj) { const v4u q = *(const v4u*)(base + 32 * sub + 8 * jj);
                    nv[8 * jj + 0] = bflo(q.x); nv[8 * jj + 1] = bfhi(q.x); nv[8 * jj + 2] = bflo(q.y); nv[8 * jj + 3] = bfhi(q.y);
                    nv[8 * jj + 4] = bflo(q.z); nv[8 * jj + 5] = bfhi(q.z); nv[8 * jj + 6] = bflo(q.w); nv[8 * jj + 7] = bfhi(q.w); }
                if (which == 0) {
                    const v4u a = *(const v4u*)(base + 128 + 8 * sub), b = *(const v4u*)(base + 160 + 8 * sub);
                    rl[0] = bflo(a.x); rl[1] = bfhi(a.x); rl[2] = bflo(a.y); rl[3] = bfhi(a.y); rl[4] = bflo(a.z); rl[5] = bfhi(a.z); rl[6] = bflo(a.w); rl[7] = bfhi(a.w);
                    rh[0] = bflo(b.x); rh[1] = bfhi(b.x); rh[2] = bflo(b.y); rh[3] = bfhi(b.y); rh[4] = bflo(b.z); rh[5] = bfhi(b.z); rh[6] = bflo(b.w); rh[7] = bfhi(b.w);
                } else {
                    f32x4 a0 = {0.f, 0.f, 0.f, 0.f}, a1 = a0, b0 = a0, b1 = a0;
#pragma unroll
                    for (int ks = 0; ks < 8; ++ks) { const float* kp = KRP + ((size_t)ks * 8192 + m) * 64 + 8 * sub;
                        a0 += *(const f32x4*)kp; a1 += *(const f32x4*)(kp + 4); b0 += *(const f32x4*)(kp + 32); b1 += *(const f32x4*)(kp + 36); }
                    rl[0] = a0.x; rl[1] = a0.y; rl[2] = a0.z; rl[3] = a0.w; rl[4] = a1.x; rl[5] = a1.y; rl[6] = a1.z; rl[7] = a1.w;
                    rh[0] = b0.x; rh[1] = b0.y; rh[2] = b0.z; rh[3] = b0.w; rh[4] = b1.x; rh[5] = b1.y; rh[6] = b1.z; rh[7] = b1.w;
                }
#pragma unroll
                for (int e = 0; e < 32; ++e) ss += nv[e] * nv[e];
#pragma unroll
                for (int e = 0; e < 8; ++e) ss += rl[e] * rl[e] + rh[e] * rh[e];
                ss += __shfl_xor(ss, 1); ss += __shfl_xor(ss, 2);
                const float inv = 1.0f / sqrtf(ss * (1.f / 192.f) + EPS);
#pragma unroll
                for (int jj = 0; jj < 4; ++jj) { const f32x4 g0 = *(const f32x4*)(gn + 32 * sub + 8 * jj), g1 = *(const f32x4*)(gn + 32 * sub + 8 * jj + 4);
                    v4u o; o.x = cvtpk(nv[8 * jj + 0] * inv * g0.x, nv[8 * jj + 1] * inv * g0.y); o.y = cvtpk(nv[8 * jj + 2] * inv * g0.z, nv[8 * jj + 3] * inv * g0.w);
                    o.z = cvtpk(nv[8 * jj + 4] * inv * g1.x, nv[8 * jj + 5] * inv * g1.y); o.w = cvtpk(nv[8 * jj + 6] * inv * g1.z, nv[8 * jj + 7] * inv * g1.w);
                    *(v4u*)(base + 32 * sub + 8 * jj) = o; }
                float ol[8], oh[8];
#pragma unroll
                for (int e = 0; e < 8; ++e) { const float a = rl[e] * inv * gn[128 + 8 * sub + e], b = rh[e] * inv * gn[160 + 8 * sub + e];
                    ol[e] = a * cs[e] - b * sn[e]; oh[e] = b * cs[e] + a * sn[e]; }
                v4u o1, o2; o1.x = cvtpk(ol[0], ol[1]); o1.y = cvtpk(ol[2], ol[3]); o1.z = cvtpk(ol[4], ol[5]); o1.w = cvtpk(ol[6], ol[7]);
                o2.x = cvtpk(oh[0], oh[1]); o2.y = cvtpk(oh[2], oh[3]); o2.z = cvtpk(oh[4], oh[5]); o2.w = cvtpk(oh[6], oh[7]);
                *(v4u*)(base + 128 + 8 * sub) = o1; *(v4u*)(base + 160 + 8 * sub) = o2;
            }
        }
        { pg8::Gemm g{PG, WPO_T, M, DM, POOLW, POOLW, POOLW, 0, 0}; pg8::StaticOrder S; S.init(M, DM, G, bx);
          pg8::EpiGate<false> E{MP, Gt, nullptr, 0}; pg8::gemm_phase<pg8::EpiGate<false>, pg8::StaticOrder>(ldsl, g, S, E); }
    TP_END(4); }
    SEAM(4);
    if (IN(5)) { TP_BEGIN(5);
        const int npair = BATCH * NH * 8;
        for (int p = vcu; p < npair; p += G) {
            const int bh = p >> 3, s = p & 7;
            att::attn_unit(bh / NH, bh % NH, 15 - s, Qb, Kb, Vb, Ob, (char*)lds);
            att::attn_unit(bh / NH, bh % NH, s, Qb, Kb, Vb, Ob, (char*)lds);
        }
    TP_END(5); }
    SEAM(5);
    if (IN(6)) { TP_BEGIN(6);
        pg8::Gemm g{Ob, WAO_T, M, DM, DM, DM, DM, 0, 0}; pg8::StaticOrder S; S.init(M, DM, G, bx);
        pg8::EpiGate<true> E{MIXED, Gt, MP, 2048}; pg8::gemm_phase<pg8::EpiGate<true>, pg8::StaticOrder>(ldsl, g, S, E);
    TP_END(6); }
    SEAM(6);
    if (IN(7)) { TP_BEGIN(7);
        { constexpr int I_G = (DM / 64) * (DFF / 32);
#define GU_DESC(it__) ((it__) < I_G ? tr_desc(kin[17], DM, DFF, (bf16*)(ws + WS_WGU), 2, 0, (it__), ffn_norm_g) : tr_desc(kin[18], DM, DFF, (bf16*)(ws + WS_WGU), 3, 0, (it__) - I_G, ffn_norm_g))
          TR_PIPELINE(gw, 2 * I_G, NGW, GU_DESC);
#undef GU_DESC
          __syncthreads(); }
        pg8::Gemm g{MIXED, WOUT_T, M, DM, DM, DM, DM, 0, 0}; pg8::StaticOrder S; S.init(M, DM, G, bx);
        pg8::EpiResNorm E{kin[0], X1, (bf16*)(ws + WS_X1B), (float*)ws + SV_SS, DM}; pg8::gemm_phase<pg8::EpiResNorm, pg8::StaticOrder>(ldsl, g, S, E);
    TP_END(7); }
    SEAM(7);
    if (IN(9)) { TP_BEGIN(9);
        pg8::Gemm g{(bf16*)(ws + WS_X1B), WGU_T, M, 2 * DFF, DM, DM, DM, 0, 0}; pg8::StaticOrder S; S.init(M, 2 * DFF, G, bx);
        pg8::EpiSwiGLU E{ACT, DFF, (const float*)ws + SV_SS}; pg8::gemm_phase<pg8::EpiSwiGLU, pg8::StaticOrder>(ldsl, g, S, E);
        if (G == 256 ? (bx >= 128) : true) {
            constexpr int I_D2 = (DFF / 64) * (DM / 32);
            const int nw = (G == 256) ? 128 * NWAVES : NGW, w0 = (G == 256) ? (bx - 128) * NWAVES + wave : gw;
#define DN_DESC(it__) tr_desc(kin[19], DFF, DM, (bf16*)(ws + WS_WDN), 0, 0, (it__), nullptr)
            TR_PIPELINE(w0, I_D2, nw, DN_DESC);
#undef DN_DESC
        }
    TP_END(9); }
    SEAM(9);
    if (IN(10)) { TP_BEGIN(10);
        pg8::Gemm g{ACT, WDN_T, M, DM, DFF, DFF, DFF, 0, 0}; pg8::StaticOrder S; S.init(M, DM, G, bx);
        pg8::EpiRes E{X1, args.out, DM}; pg8::gemm_phase<pg8::EpiRes, pg8::StaticOrder>(ldsl, g, S, E);
    TP_END(10); }
#ifdef TPROBE
    if (blockIdx.x == 0 && threadIdx.x == 0) { const unsigned w_ = 4u * ((volatile LAS unsigned*)(ldsl + 140000))[1]; const unsigned long long t0_ = __builtin_amdgcn_s_memrealtime(); while ((unsigned)(__builtin_amdgcn_s_memrealtime() - t0_) < w_) __builtin_amdgcn_s_sleep(8); }
#endif
#undef IN
#undef SEAM
}

extern "C" void kernel_launch(void* const* d_in, const int* in_sizes, int n_in, void* d_out, int out_size, void* d_ws, size_t ws_size, hipStream_t stream) {
    static int grid = 0;
    if (grid == 0) {
        if (n_in != 20 || out_size != M * DM || ws_size < WS_END) { fprintf(stderr, "kernel_launch: unexpected shapes (n_in %d, out %d, ws %zu)\n", n_in, out_size, ws_size); grid = -1; return; }
        int dev = 0, cus = 0, per_cu = 0;
        (void)hipGetDevice(&dev); (void)hipDeviceGetAttribute(&cus, hipDeviceAttributeMultiprocessorCount, dev);
        if (hipFuncSetAttribute((const void*)mega_fwd, hipFuncAttributeMaxDynamicSharedMemorySize, LDS_BYTES) != hipSuccess) { fprintf(stderr, "kernel_launch: hipFuncSetAttribute failed\n"); grid = -1; return; }
        if (hipOccupancyMaxActiveBlocksPerMultiprocessor(&per_cu, (const void*)mega_fwd, NWAVES * 64, LDS_BYTES) != hipSuccess || per_cu < 1) { fprintf(stderr, "kernel_launch: occupancy query says %d\n", per_cu); per_cu = 1; }
        (void)hipGetLastError();
        grid = cus > 0 ? cus : 256;
    }
    if (grid < 0) return;
    Args a{};
    for (int i = 0; i < 20; ++i) a.in[i] = (const float*)d_in[i];
    a.out = (float*)d_out; a.ws = (unsigned char*)d_ws;
    if (MK_N_LAUNCHES == 1) {
        a.ph_lo = 0; a.ph_hi = NPH; a.coop = 1;
        (void)hipMemsetAsync((char*)d_ws + WS_BAR, 0, 16384, stream);
        void* kargs[] = {&a};
        hipError_t e = hipLaunchCooperativeKernel((const void*)mega_fwd, dim3(grid), dim3(NWAVES * 64), kargs, LDS_BYTES, stream);
        if (e != hipSuccess) fprintf(stderr, "kernel_launch: cooperative launch failed: %s (grid %d)\n", hipGetErrorString(e), grid);
    } else {
        for (int p = 0; p < NPH; ++p) {
            a.ph_lo = p; a.ph_hi = p + 1;
            hipLaunchKernelGGL(mega_fwd, dim3(grid), dim3(NWAVES * 64), LDS_BYTES, stream, a);
        }
    }
}
```

```cpp
#include <hip/hip_runtime.h>
#include <hip/hip_cooperative_groups.h>
#include <cstdio>
#include <cstdint>
namespace cg = cooperative_groups;

#ifndef MK_N_LAUNCHES
#define MK_N_LAUNCHES 1
#endif

namespace pg8 {
#define PG8_LAS __attribute__((address_space(3)))
typedef unsigned short bf16_t;
typedef short bf16x8 __attribute__((ext_vector_type(8)));
typedef float f32x4 __attribute__((ext_vector_type(4)));
typedef unsigned u32x4 __attribute__((ext_vector_type(4)));
constexpr int BM = 256, BK = 64, HALF = 128, HTB = HALF * BK * 2, STAGE_BYTES = 8 * HTB, NXCD = 8, WGM = 8;

__host__ __device__ __forceinline__ int lds_byte(int r, int c) { const int st = (r >> 4) * 2 + (c >> 5), rr = r & 15, cc = c & 31, ob = rr * 64 + cc * 2; return st * 1024 + (ob ^ (((ob >> 9) & 1) << 5)); }
__host__ __device__ __forceinline__ void stage_rc(int b, int& R, int& C) { const int st = b / 1024, sb = b % 1024, swz = sb ^ (((sb >> 9) & 1) << 5); R = (st >> 1) * 16 + swz / 64; C = (st & 1) * 32 + (swz % 64) / 2; }
__host__ __device__ __forceinline__ int perm32(int rho) { const int n = rho >> 4, i = rho & 15; return 8 * (i >> 2) + 4 * n + (i & 3); }

struct Unit { int pm, pn; };
struct Gemm { const bf16_t* A; const bf16_t* Bt; int M, N, K, lda, ldb, a_pn_step, b_pn_step; };

struct StaticOrder {
    int nM, nN, nwg, G, c;
    __host__ __device__ void init(int M, int N, int G_, int c_) { nM = M / BM; nN = N / BM; nwg = nM * nN; G = G_; c = c_; }
    __host__ __device__ bool next(int i, Unit& u) const {
        const long L = (long)i * G + c; if (L >= nwg) return false;
        int wgid = (int)L; { const int q = nwg / NXCD, r = nwg % NXCD, xcd = wgid % NXCD, off = wgid / NXCD; wgid = (xcd < r ? xcd * (q + 1) : r * (q + 1) + (xcd - r) * q) + off; }
        const int nig = WGM * nN, gid = wgid / nig, fm = gid * WGM, gsz = (nM - fm) < WGM ? (nM - fm) : WGM;
        u.pm = fm + ((wgid % nig) % gsz); u.pn = (wgid % nig) / gsz; return true;
    }
};

typedef float f32x2_t_ __attribute__((ext_vector_type(2))); typedef __bf16 bf16x2_t_ __attribute__((ext_vector_type(2)));
__device__ __forceinline__ unsigned cvt_pk_bf16(float lo, float hi) { f32x2_t_ v = {lo, hi}; bf16x2_t_ b = __builtin_convertvector(v, bf16x2_t_); return __builtin_bit_cast(unsigned, b); }
__device__ __forceinline__ u32x4 pack8(f32x4 a, f32x4 b) { u32x4 w; w.x = cvt_pk_bf16(a[0], a[1]); w.y = cvt_pk_bf16(a[2], a[3]); w.z = cvt_pk_bf16(b[0], b[1]); w.w = cvt_pk_bf16(b[2], b[3]); return w; }
__device__ __forceinline__ void unpack8(u32x4 w, f32x4& a, f32x4& b) {
    a[0] = __uint_as_float(w.x << 16); a[1] = __uint_as_float(w.x & 0xffff0000u); a[2] = __uint_as_float(w.y << 16); a[3] = __uint_as_float(w.y & 0xffff0000u);
    b[0] = __uint_as_float(w.z << 16); b[1] = __uint_as_float(w.z & 0xffff0000u); b[2] = __uint_as_float(w.w << 16); b[3] = __uint_as_float(w.w & 0xffff0000u); }
__device__ __forceinline__ float sigmoidf_(float v) { return __builtin_amdgcn_rcpf(1.0f + __builtin_amdgcn_exp2f(-1.4426950408889634f * v)); }
__device__ __forceinline__ f32x4 sigmoid4(f32x4 v) { f32x4 o; o[0] = sigmoidf_(v[0]); o[1] = sigmoidf_(v[1]); o[2] = sigmoidf_(v[2]); o[3] = sigmoidf_(v[3]); return o; }

typedef f32x4 AccT[2][2][4][2];
#define EPI_LOOP_AM _Pragma("unroll") for (int ai = 0; ai < 2; ++ai) _Pragma("unroll") for (int m = 0; m < 4; ++m)
#define EPI_LOOP_B _Pragma("unroll") for (int bj = 0; bj < 2; ++bj)

struct EpiIn {
    static constexpr bool PERM = true;
    float* C1; bf16_t* U; bf16_t* G; const float* bgate;
    __device__ __forceinline__ void operator()(const AccT& acc, const Unit& u, int wr, int wc, int fr, int fq) const {
        const int row0 = u.pm * BM + wr * 64 + fr, pn = u.pn, cw = wc * 32 + 8 * fq;
        if (pn < 4) {
            EPI_LOOP_AM { float* rp = C1 + (size_t)(row0 + ai * HALF + m * 16) * 1024 + pn * 256 + cw;
                EPI_LOOP_B { *(f32x4*)(rp + bj * HALF) = acc[ai][bj][m][0]; *(f32x4*)(rp + bj * HALF + 4) = acc[ai][bj][m][1]; } }
        } else if (pn < 8) {
            EPI_LOOP_AM { bf16_t* rp = U + (size_t)(row0 + ai * HALF + m * 16) * 1024 + (pn - 4) * 256 + cw;
                EPI_LOOP_B { *(u32x4*)(rp + bj * HALF) = pack8(acc[ai][bj][m][0], acc[ai][bj][m][1]); } }
        } else {
            const int gc = (pn - 8) * 256 + cw; f32x4 bv[2][2];
            EPI_LOOP_B { bv[bj][0] = *(const f32x4*)(bgate + gc + bj * HALF); bv[bj][1] = *(const f32x4*)(bgate + gc + bj * HALF + 4); }
            EPI_LOOP_AM { bf16_t* rp = G + (size_t)(row0 + ai * HALF + m * 16) * 4096 + gc;
                EPI_LOOP_B { *(u32x4*)(rp + bj * HALF) = pack8(sigmoid4(acc[ai][bj][m][0] + bv[bj][0]), sigmoid4(acc[ai][bj][m][1] + bv[bj][1])); } }
        }
    }
};
struct EpiKRP {
    static constexpr bool PERM = true;
    float* KRP;
    __device__ __forceinline__ void operator()(const AccT& acc, const Unit& u, int wr, int wc, int fr, int fq) const {
        const int row0 = u.pm * BM + wr * 64 + fr, cw = wc * 32 + 8 * fq;
        if (wc < 2) { EPI_LOOP_AM { float* rp = KRP + ((size_t)u.pn * 8192 + (row0 + ai * HALF + m * 16)) * 64 + cw; *(f32x4*)rp = acc[ai][0][m][0]; *(f32x4*)(rp + 4) = acc[ai][0][m][1]; } }
    }
};
struct EpiBf16 {
    static constexpr bool PERM = true;
    bf16_t* O; int ldc;
    __device__ __forceinline__ void operator()(const AccT& acc, const Unit& u, int wr, int wc, int fr, int fq) const {
        const int row0 = u.pm * BM + wr * 64 + fr, col0 = u.pn * BM + wc * 32 + 8 * fq;
        EPI_LOOP_AM { bf16_t* rp = O + (size_t)(row0 + ai * HALF + m * 16) * ldc + col0;
            EPI_LOOP_B { *(u32x4*)(rp + bj * HALF) = pack8(acc[ai][bj][m][0], acc[ai][bj][m][1]); } }
    }
};
struct EpiKV {
    static constexpr bool PERM = true;
    bf16_t* K; bf16_t* V;
    __device__ __forceinline__ void operator()(const AccT& acc, const Unit& u, int wr, int wc, int fr, int fq) const {
        const int row0 = u.pm * BM + wr * 64 + fr, cw = wc * 32 + 8 * fq, h = u.pn;
        EPI_LOOP_AM { const size_t row = (size_t)(row0 + ai * HALF + m * 16);
            *(u32x4*)(K + row * 3072 + h * 192 + cw) = pack8(acc[ai][0][m][0], acc[ai][0][m][1]);
            *(u32x4*)(V + row * 2048 + h * 128 + cw) = pack8(acc[ai][1][m][0], acc[ai][1][m][1]); }
    }
};
struct EpiScale {
    static constexpr bool PERM = true;
    bf16_t* O; int ldc; const float* scale;
    __device__ __forceinline__ void operator()(const AccT& acc, const Unit& u, int wr, int wc, int fr, int fq) const {
        const int row0 = u.pm * BM + wr * 64 + fr, col0 = u.pn * BM + wc * 32 + 8 * fq; f32x4 sv[2][2];
        EPI_LOOP_B { sv[bj][0] = *(const f32x4*)(scale + col0 + bj * HALF); sv[bj][1] = *(const f32x4*)(scale + col0 + bj * HALF + 4); }
        EPI_LOOP_AM { bf16_t* rp = O + (size_t)(row0 + ai * HALF + m * 16) * ldc + col0;
            EPI_LOOP_B { *(u32x4*)(rp + bj * HALF) = pack8(acc[ai][bj][m][0] * sv[bj][0], acc[ai][bj][m][1] * sv[bj][1]); } }
    }
};
template <bool HAS_ADD> struct EpiGate {
    static constexpr bool PERM = true;
    bf16_t* O; const bf16_t* gate; const bf16_t* add; int gcol0;
    __device__ __forceinline__ void operator()(const AccT& acc, const Unit& u, int wr, int wc, int fr, int fq) const {
        const int row0 = u.pm * BM + wr * 64 + fr, col0 = u.pn * BM + wc * 32 + 8 * fq;
        EPI_LOOP_AM { const size_t row = (size_t)(row0 + ai * HALF + m * 16);
            EPI_LOOP_B { f32x4 g0, g1; unpack8(__builtin_nontemporal_load((const u32x4*)(gate + row * 4096 + gcol0 + col0 + bj * HALF)), g0, g1);
                f32x4 v0 = g0 * acc[ai][bj][m][0], v1 = g1 * acc[ai][bj][m][1];
                if (HAS_ADD) { f32x4 a0, a1; unpack8(__builtin_nontemporal_load((const u32x4*)(add + row * 2048 + col0 + bj * HALF)), a0, a1); v0 += a0; v1 += a1; }
                *(u32x4*)(O + row * 2048 + col0 + bj * HALF) = pack8(v0, v1); } }
    }
};
struct EpiRes {
    static constexpr bool PERM = false;
    const float* base; float* out; int ldc;
    __device__ __forceinline__ void operator()(const AccT& acc, const Unit& u, int wr, int wc, int fr, int fq) const {
        const int row0 = u.pm * BM + wr * 64 + fr, col0 = u.pn * BM + wc * 32 + 4 * fq;
        EPI_LOOP_AM { const size_t off = (size_t)(row0 + ai * HALF + m * 16) * ldc + col0;
            EPI_LOOP_B {
#pragma unroll
                for (int n = 0; n < 2; ++n) { const f32x4 b = __builtin_nontemporal_load((const f32x4*)(base + off + bj * HALF + n * 16)); __builtin_nontemporal_store(b + acc[ai][bj][m][n], (f32x4*)(out + off + bj * HALF + n * 16)); } } }
    }
};
struct EpiResNorm {
    static constexpr bool PERM = false;
    const float* base; float* out; bf16_t* outb; float* ss; int ldc;
    __device__ __forceinline__ void operator()(const AccT& acc, const Unit& u, int wr, int wc, int fr, int fq) const {
        const int row0 = u.pm * BM + wr * 64 + fr, col0 = u.pn * BM + wc * 32 + 4 * fq;
        EPI_LOOP_AM { const int row = row0 + ai * HALF + m * 16; const size_t off = (size_t)row * ldc + col0; float s = 0.f;
            EPI_LOOP_B {
#pragma unroll
                for (int n = 0; n < 2; ++n) { const f32x4 v = __builtin_nontemporal_load((const f32x4*)(base + off + bj * HALF + n * 16)) + acc[ai][bj][m][n]; *(f32x4*)(out + off + bj * HALF + n * 16) = v;
                    typedef unsigned u32x2_ __attribute__((ext_vector_type(2))); u32x2_ w; w.x = cvt_pk_bf16(v[0], v[1]); w.y = cvt_pk_bf16(v[2], v[3]); *(u32x2_*)(outb + off + bj * HALF + n * 16) = w;
                    s += (v[0] * v[0] + v[1] * v[1]) + (v[2] * v[2] + v[3] * v[3]); } }
            s += __shfl_xor(s, 16); s += __shfl_xor(s, 32);
            if (fq == 0) atomicAdd(ss + row, s); }
    }
};
struct EpiSwiGLU {
    static constexpr bool PERM = true;
    bf16_t* O; int ldc; const float* ss;
    __device__ __forceinline__ void operator()(const AccT& acc, const Unit& u, int wr, int wc, int fr, int fq) const {
        const int row0 = u.pm * BM + wr * 64 + fr, col0 = u.pn * HALF + wc * 32 + 8 * fq;
        EPI_LOOP_AM { const int row = row0 + ai * HALF + m * 16; bf16_t* rp = O + (size_t)row * ldc + col0;
            const float inv = 1.0f / sqrtf(ss[row] * (1.f / 2048.f) + 1e-6f);
            const f32x4 g0 = acc[ai][0][m][0] * inv, g1 = acc[ai][0][m][1] * inv;
            *(u32x4*)rp = pack8(g0 * sigmoid4(g0) * (acc[ai][1][m][0] * inv), g1 * sigmoid4(g1) * (acc[ai][1][m][1] * inv)); }
    }
};

template <class Epi, class Sched, bool ALIGN_EPI = true>
__device__ __forceinline__ void gemm_phase(PG8_LAS unsigned char* lds, const Gemm g, const Sched& S, const Epi& E) {
    const int tid = threadIdx.x, wid = __builtin_amdgcn_readfirstlane(tid >> 6), lane = tid & 63, wr = wid >> 2, wc = wid & 3, fr = lane & 15, fq = lane >> 4;
    const int K = g.K, nt = K / BK;
    unsigned voffA[2], voffB[2];
#pragma unroll
    for (int i = 0; i < 2; ++i) { int R, C; stage_rc(tid * 16 + i * 8192, R, C); const int Rb = Epi::PERM ? ((R & ~31) + perm32(R & 31)) : R;
        voffA[i] = (unsigned)(R * g.lda + C) * 2u; voffB[i] = (unsigned)(Rb * g.ldb + C) * 2u; }
    const size_t kstep = (size_t)(BK * 2);
    const size_t hstepA = (size_t)HALF * g.lda * 2, hstepB = (size_t)HALF * g.ldb * 2;
    const size_t tstepA = 2 * hstepA, tstepB = g.b_pn_step ? (size_t)g.b_pn_step * 2 : 2 * hstepB, pstepA = (size_t)g.a_pn_step * 2;
    const unsigned ldsw = (unsigned)wid * 1024u;
    const int aoff = lds_byte(wr * 64 + fr, fq * 8), boff = lds_byte(wc * 32 + fr, fq * 8);
#define PG8_SA(b, h) (((b) * 2 + (h)) * HTB)
#define PG8_SB(b, h) ((4 + (b) * 2 + (h)) * HTB)
#define PG8_STAGE(bufoff, gbase, voff) do { _Pragma("unroll") for (int _i = 0; _i < 2; ++_i) \
        __builtin_amdgcn_global_load_lds((const unsigned*)((const char*)(gbase) + (voff)[_i]), (PG8_LAS unsigned*)(lds + (bufoff) + ldsw + _i * 8192), 16, 0, 0); } while (0)
#define PG8_LDA(dst, b, h) do { _Pragma("unroll") for (int m = 0; m < 4; ++m) _Pragma("unroll") for (int k = 0; k < 2; ++k) dst[m][k] = *(const PG8_LAS bf16x8*)(lds + PG8_SA(b, h) + aoff + m * 2048 + k * 1024); } while (0)
#define PG8_LDB(dst, b, h) do { _Pragma("unroll") for (int n = 0; n < 2; ++n) _Pragma("unroll") for (int k = 0; k < 2; ++k) dst[n][k] = *(const PG8_LAS bf16x8*)(lds + PG8_SB(b, h) + boff + n * 2048 + k * 1024); } while (0)
#define PG8_MMA(ai, bj, At, Bt) do { __builtin_amdgcn_s_setprio(1); _Pragma("unroll") for (int m = 0; m < 4; ++m) _Pragma("unroll") for (int n = 0; n < 2; ++n) _Pragma("unroll") for (int k = 0; k < 2; ++k) \
        acc[ai][bj][m][n] = __builtin_amdgcn_mfma_f32_16x16x32_bf16(Bt[n][k], At[m][k], acc[ai][bj][m][n], 0, 0, 0); __builtin_amdgcn_s_setprio(0); } while (0)
#define PG8_WAIT_V(n) asm volatile("s_waitcnt vmcnt(" #n ")" ::: "memory")
#define PG8_WAIT_L(n) asm volatile("s_waitcnt lgkmcnt(" #n ")" ::: "memory")
#define PG8_BAR __builtin_amdgcn_s_barrier()
#define PG8_SCHED __builtin_amdgcn_sched_barrier(0)
    Unit cur, nxt; int ui = 0;
    if (!S.next(0, cur)) return;
    f32x4 acc[2][2][4][2];
#pragma unroll
    for (int a = 0; a < 2; ++a)
#pragma unroll
        for (int b = 0; b < 2; ++b)
#pragma unroll
            for (int m = 0; m < 4; ++m)
#pragma unroll
                for (int n = 0; n < 2; ++n) acc[a][b][m][n] = (f32x4){0.f, 0.f, 0.f, 0.f};
    bf16x8 At[4][2], B0[2][2], B1[2][2];
    const char* cA = (const char*)g.A + (size_t)cur.pm * tstepA + (size_t)cur.pn * pstepA; const char* cB = (const char*)g.Bt + (size_t)cur.pn * tstepB;
    PG8_STAGE(PG8_SB(0, 0), cB, voffB); PG8_STAGE(PG8_SB(0, 1), cB + hstepB, voffB); PG8_STAGE(PG8_SA(0, 0), cA, voffA); PG8_STAGE(PG8_SA(0, 1), cA + hstepA, voffA);
    if (wr == 1) PG8_BAR;
    PG8_WAIT_V(2); PG8_BAR;
    PG8_STAGE(PG8_SB(1, 0), cB + kstep, voffB); PG8_STAGE(PG8_SA(1, 0), cA + kstep, voffA); PG8_STAGE(PG8_SB(1, 1), cB + hstepB + kstep, voffB);
    PG8_WAIT_V(6); PG8_BAR;
    for (;;) {
        const bool has_next = S.next(ui + 1, nxt);
        const char* nA = has_next ? (const char*)g.A + (size_t)nxt.pm * tstepA + (size_t)nxt.pn * pstepA : cA; const char* nB = has_next ? (const char*)g.Bt + (size_t)nxt.pn * tstepB : cB;
        for (int t = 0; t < nt; t += 2) {
            const bool last = (t == nt - 2);
            const char* a1 = cA + (size_t)(t + 1) * kstep;
            const char* a2 = last ? nA : cA + (size_t)(t + 2) * kstep; const char* b2 = last ? nB : cB + (size_t)(t + 2) * kstep;
            const char* a3 = a2 + kstep; const char* b3 = b2 + kstep;
            PG8_LDB(B0, 0, 0); PG8_LDB(B1, 0, 1); PG8_SCHED; PG8_LDA(At, 0, 0); PG8_STAGE(PG8_SA(1, 1), a1 + hstepA, voffA);
            PG8_WAIT_V(8); PG8_WAIT_L(0); PG8_BAR; PG8_MMA(0, 0, At, B0); PG8_MMA(0, 1, At, B1); PG8_BAR; PG8_SCHED;
            PG8_LDA(At, 0, 1); PG8_STAGE(PG8_SB(0, 0), b2, voffB); PG8_STAGE(PG8_SB(0, 1), b2 + hstepB, voffB); PG8_STAGE(PG8_SA(0, 0), a2, voffA);
            PG8_WAIT_V(8); PG8_WAIT_L(0); PG8_BAR; PG8_MMA(1, 0, At, B0); PG8_MMA(1, 1, At, B1); PG8_BAR; PG8_SCHED;
            PG8_LDB(B0, 1, 0); PG8_LDB(B1, 1, 1); PG8_SCHED; PG8_LDA(At, 1, 0); PG8_STAGE(PG8_SA(0, 1), a2 + hstepA, voffA);
            PG8_WAIT_V(8); PG8_WAIT_L(0); PG8_BAR; PG8_MMA(0, 0, At, B0); PG8_MMA(0, 1, At, B1); PG8_BAR; PG8_SCHED;
            PG8_LDA(At, 1, 1); PG8_STAGE(PG8_SB(1, 0), b3, voffB); PG8_STAGE(PG8_SB(1, 1), b3 + hstepB, voffB); PG8_STAGE(PG8_SA(1, 0), a3, voffA);
            PG8_WAIT_V(8); PG8_WAIT_L(0); PG8_BAR; PG8_MMA(1, 0, At, B0); PG8_MMA(1, 1, At, B1); PG8_BAR; PG8_SCHED;
        }
        if constexpr (ALIGN_EPI) { if (wr == 0) PG8_BAR; }
        E(acc, cur, wr, wc, fr, fq);
        if (!has_next) break;
#pragma unroll
        for (int a = 0; a < 2; ++a)
#pragma unroll
            for (int b = 0; b < 2; ++b)
#pragma unroll
                for (int m = 0; m < 4; ++m)
#pragma unroll
                    for (int n = 0; n < 2; ++n) acc[a][b][m][n] = (f32x4){0.f, 0.f, 0.f, 0.f};
        cur = nxt; cA = nA; cB = nB; ++ui;
        if constexpr (ALIGN_EPI) { if (wr == 1) PG8_BAR; }
    }
    PG8_WAIT_V(0);
    if constexpr (!ALIGN_EPI) { if (wr == 0) PG8_BAR; }
    PG8_BAR;
#undef PG8_SA
#undef PG8_SB
#undef PG8_STAGE
#undef PG8_LDA
#undef PG8_LDB
#undef PG8_MMA
#undef PG8_WAIT_V
#undef PG8_WAIT_L
#undef PG8_BAR
#undef PG8_SCHED
}
}

constexpr int BATCH = 2, SEQ = 4096, DM = 2048, M = BATCH * SEQ;
constexpr int NH = 16, DQK = 192, DNOPE = 128, DROPE = 64, DV = 128, QLORA = 512, KVLORA = 512;
constexpr int POOLW = 1024, DIN = 6208, DIN_PAD = 6400, DFF = 5632;
constexpr float EPS = 1e-6f;
constexpr int NWAVES = 8;

typedef unsigned short bf16;
typedef unsigned v4u __attribute__((ext_vector_type(4)));
typedef unsigned v2u __attribute__((ext_vector_type(2)));
typedef float f32x4 __attribute__((ext_vector_type(4)));
typedef short bf16x8 __attribute__((ext_vector_type(8)));
typedef short s16x4 __attribute__((ext_vector_type(4)));
typedef float f32x16 __attribute__((ext_vector_type(16)));
#define LAS __attribute__((address_space(3)))
#define LDS_WAIT() asm volatile("s_waitcnt lgkmcnt(0)" ::: "memory")

constexpr size_t MiB = 1u << 20;
constexpr size_t WS_WAO = 1 * MiB, WS_WOUT = 9 * MiB, WS_WPO = 17 * MiB, WS_WQB = 21 * MiB, WS_WKVB = 24 * MiB, WS_WPG = 28 * MiB, WS_KR = 29 * MiB;
constexpr size_t WS_G = 31 * MiB;
constexpr size_t WS_WIN = 95 * MiB, WS_XN = 120 * MiB, WS_C1 = 152 * MiB, WS_U = 184 * MiB;
constexpr size_t WS_Q = 95 * MiB, WS_K = 143 * MiB, WS_V = 191 * MiB, WS_CN = 223 * MiB, WS_POOLED = 239 * MiB, WS_PG = 255 * MiB;
constexpr size_t WS_MP = 223 * MiB, WS_O = 255 * MiB, WS_MIXED = 95 * MiB, WS_X1 = 127 * MiB, WS_H2 = 95 * MiB;
constexpr size_t WS_WGU = 191 * MiB, WS_WDN = 235 * MiB, WS_ACT = 1 * MiB;
constexpr size_t WS_END = 296 * MiB, WS_BAR = 512 * 1024, WS_KRP = 272 * MiB, WS_X1B = 257 * MiB;
constexpr int SV_BGATE = 0, SV_QAG = 4096, SV_KVAG = 4608, SV_QNG = 5120, SV_KNG = 5376, SV_PSC = 5632, SV_FNG = 6656, SV_POS = 8704, SV_END = 8704 + 8192, SV_SS = 32768;

constexpr int LDS_BYTES = 147456;

__device__ __forceinline__ unsigned cvtpk(float lo, float hi) { return pg8::cvt_pk_bf16(lo, hi); }
__device__ __forceinline__ float bflo(unsigned w) { return __uint_as_float(w << 16); }
__device__ __forceinline__ float bfhi(unsigned w) { return __uint_as_float(w & 0xffff0000u); }
__device__ __forceinline__ float wave_sum(float v) {
#pragma unroll
    for (int o = 1; o < 64; o <<= 1) v += __shfl_xor(v, o);
    return v;
}

__device__ __forceinline__ int dst_row(int mode, int n0) {
    if (mode == 1) { if (n0 < 1024) return n0; if (n0 < 1088) return 6144 + (n0 - 1024); if (n0 < 2112) return 1024 + (n0 - 1088); return 2048 + (n0 - 2112); }
    if (mode == 2) return (n0 >> 7) * 256 + (n0 & 127);
    if (mode == 3) return (n0 >> 7) * 256 + 128 + (n0 & 127);
    return n0;
}
__device__ __forceinline__ void transpose_item(const float* W, int K, int N, bf16* WT, int mode, int row_off, LAS float* scr, int item, int lane, const float* gk = nullptr) {
    const int nblk = N / 32, kb = item / nblk, nb = item % nblk, k0 = 64 * kb, n0 = 32 * nb;
    { float tv[32]; const float* wp = W + (size_t)(k0 + (lane >> 5)) * N + n0 + (lane & 31);
#pragma unroll
      for (int i = 0; i < 32; ++i) tv[i] = wp[(size_t)(2 * i) * N];
      if (gk) {
#pragma unroll
          for (int i = 0; i < 32; ++i) tv[i] *= gk[k0 + 2 * i + (lane >> 5)]; }
#pragma unroll
      for (int i = 0; i < 32; ++i) scr[(2 * i + (lane >> 5)) * 33 + (lane & 31)] = tv[i]; }
    LDS_WAIT(); asm volatile("" ::: "memory");
    const int c = lane & 7, dr = row_off + dst_row(mode, n0);
#pragma unroll
    for (int j = 0; j < 4; ++j) { const int n = (lane >> 3) + 8 * j; const LAS float* s = scr + (8 * c) * 33 + n;
        v4u o; o.x = cvtpk(s[0 * 33], s[1 * 33]); o.y = cvtpk(s[2 * 33], s[3 * 33]); o.z = cvtpk(s[4 * 33], s[5 * 33]); o.w = cvtpk(s[6 * 33], s[7 * 33]);
        *(v4u*)(WT + (size_t)(dr + n) * K + k0 + 8 * c) = o; }
    LDS_WAIT(); asm volatile("" ::: "memory");
}

struct TrDesc { const float* W; bf16* WT; const float* gk; int K, N, k0, n0, dr; };
__device__ __forceinline__ TrDesc tr_desc(const float* W, int K, int N, bf16* WT, int mode, int row_off, int item, const float* gk) {
    const int nblk = N / 32, kb = item / nblk, nb = item % nblk; TrDesc d; d.W = W; d.WT = WT; d.gk = gk; d.K = K; d.N = N; d.k0 = 64 * kb; d.n0 = 32 * nb; d.dr = row_off + dst_row(mode, d.n0); return d; }
__device__ __forceinline__ void tr_load(const TrDesc& d, float (&tv)[32], int lane) {
    const float* wp = d.W + (size_t)(d.k0 + (lane >> 5)) * d.N + d.n0 + (lane & 31);
#pragma unroll
    for (int i = 0; i < 32; ++i) tv[i] = __builtin_nontemporal_load(wp + (size_t)(2 * i) * d.N);
}
__device__ __forceinline__ void tr_finish(const TrDesc& d, float (&tv)[32], LAS float* scr, int lane) {
    if (d.gk) {
#pragma unroll
        for (int i = 0; i < 32; ++i) tv[i] *= d.gk[d.k0 + 2 * i + (lane >> 5)]; }
#pragma unroll
    for (int i = 0; i < 32; ++i) scr[(2 * i + (lane >> 5)) * 33 + (lane & 31)] = tv[i];
    LDS_WAIT(); asm volatile("" ::: "memory");
    const int c = lane & 7;
#pragma unroll
    for (int j = 0; j < 4; ++j) { const int n = (lane >> 3) + 8 * j; const LAS float* s_ = scr + (8 * c) * 33 + n;
        v4u o; o.x = cvtpk(s_[0 * 33], s_[1 * 33]); o.y = cvtpk(s_[2 * 33], s_[3 * 33]); o.z = cvtpk(s_[4 * 33], s_[5 * 33]); o.w = cvtpk(s_[6 * 33], s_[7 * 33]);
        *(v4u*)(d.WT + (size_t)(d.dr + n) * d.K + d.k0 + 8 * c) = o; }
    LDS_WAIT(); asm volatile("" ::: "memory");
}
#define TR_PIPELINE(FIRST, LIMIT, STRIDE, MAKE_DESC) do { int it_ = (FIRST); if (it_ < (LIMIT)) { TrDesc dA_ = MAKE_DESC(it_); float tvA_[32]; tr_load(dA_, tvA_, lane); \
        for (;;) { const int nx_ = it_ + (STRIDE); const bool more_ = nx_ < (LIMIT); TrDesc dB_ = dA_; float tvB_[32]; \
            if (more_) { dB_ = MAKE_DESC(nx_); tr_load(dB_, tvB_, lane); } \
            tr_finish(dA_, tvA_, scr, lane); if (!more_) break; \
            dA_ = dB_; _Pragma("unroll") for (int i_ = 0; i_ < 32; ++i_) tvA_[i_] = tvB_[i_]; it_ = nx_; } } } while (0)

__device__ __forceinline__ void rms_row_2048(const float* xrow, const float* g, bf16* orow, int lane) {
    const f32x4* xr = (const f32x4*)xrow + lane; const f32x4* gr = (const f32x4*)g + lane;
    f32x4 v[8]; float s = 0.f;
#pragma unroll
    for (int j = 0; j < 8; ++j) { v[j] = __builtin_nontemporal_load(xr + 64 * j); s += (v[j].x * v[j].x + v[j].y * v[j].y) + (v[j].z * v[j].z + v[j].w * v[j].w); }
    const float inv = 1.0f / sqrtf(wave_sum(s) * (1.f / 2048.f) + EPS);
    v2u* o8 = (v2u*)orow + lane;
#pragma unroll
    for (int j = 0; j < 8; ++j) { const f32x4 gv = gr[64 * j]; v2u o; o.x = cvtpk(v[j].x * inv * gv.x, v[j].y * inv * gv.y); o.y = cvtpk(v[j].z * inv * gv.z, v[j].w * inv * gv.w); o8[64 * j] = o; }
}

namespace att {
constexpr int QBLK = 32, KVBLK = 64, QB = 256;
constexpr int SHM_V = KVBLK * DV * 2, SHM_K = KVBLK * DQK * 2;
constexpr int OFF_V = 0, OFF_K = 3 * SHM_V, OFF_WS = OFF_K + 2 * SHM_K;
constexpr float SCALE = 0.07216878364870322f;
constexpr float THR = 8.f;
#define KSWZ(row, colB) ((row) * 384 + ((colB) ^ (((row) & 7) << 4)))
#define SBAR() __builtin_amdgcn_sched_barrier(0)
__device__ __forceinline__ int v_st(int k, int c) { const int kk = (k & ~0xC) | ((k & 4) << 1) | ((k & 8) >> 1); return ((kk >> 3) * 4 + (c >> 5)) * 512 + ((kk & 7) * 32 + (c & 31)) * 2; }
__device__ __forceinline__ int v_rd_base(int lane) { return ((lane & 3) << 3) | (((lane >> 2) & 3) << 6) | (((lane >> 4) & 1) << 5) | (((lane >> 5) & 1) << 8); }
__device__ __forceinline__ int crow(int r, int hi) { return (r & 3) + 8 * (r >> 2) + 4 * hi; }
__device__ __forceinline__ void mask_tile(f32x16& p0, f32x16& p1, int dq) {
    const float NEG = -__builtin_inff();
#pragma unroll
    for (int r = 0; r < 16; ++r) {
        const int c = (r & 3) + 8 * (r >> 2);
        if (dq - c < 0) p0[r] = NEG;
        if (dq - c - 32 < 0) p1[r] = NEG;
    }
}
__device__ __forceinline__ void partialSM(f32x16& p0, f32x16& p1, float& m_reg, float& mn, float& alpha) {
    float pmax = p0[0];
#pragma unroll
    for (int r = 1; r < 16; ++r) pmax = fmaxf(pmax, p0[r]);
#pragma unroll
    for (int r = 0; r < 16; ++r) pmax = fmaxf(pmax, p1[r]);
    { auto rr = __builtin_amdgcn_permlane32_swap(__float_as_uint(pmax), __float_as_uint(pmax), false, false);
      pmax = fmaxf(__uint_as_float(rr[0]), __uint_as_float(rr[1])); }
    constexpr float C2 = 1.4426950408889634f * SCALE;
    if (__builtin_expect(__all((pmax - m_reg) * SCALE <= THR), 1)) { mn = m_reg; alpha = 1.f; }
    else { mn = fmaxf(m_reg, pmax); alpha = __builtin_amdgcn_exp2f((m_reg - mn) * C2); m_reg = mn; }
    const float mnL = -mn * C2;
#pragma unroll
    for (int r = 0; r < 16; ++r) p0[r] = fmaf(p0[r], C2, mnL);
#pragma unroll
    for (int r = 0; r < 16; ++r) p1[r] = fmaf(p1[r], C2, mnL);
#pragma unroll
    for (int r = 0; r < 16; ++r) p0[r] = __builtin_amdgcn_exp2f(p0[r]);
}
__device__ __forceinline__ void finishSM(f32x16& p0, f32x16& p1, float alpha, float& l_reg, bf16x8& pa0, bf16x8& pa1, bf16x8& pa2, bf16x8& pa3) {
#pragma unroll
    for (int r = 0; r < 16; ++r) p1[r] = __builtin_amdgcn_exp2f(p1[r]);
    float ps = 0;
#pragma unroll
    for (int r = 0; r < 16; ++r) ps += p0[r];
#pragma unroll
    for (int r = 0; r < 16; ++r) ps += p1[r];
    { auto rr = __builtin_amdgcn_permlane32_swap(__float_as_uint(ps), __float_as_uint(ps), false, false);
      ps = __uint_as_float(rr[0]) + __uint_as_float(rr[1]); }
    l_reg = l_reg * alpha + ps;
#define PK4(P, B_, OUT) do { unsigned a0 = cvtpk(P[B_+0], P[B_+1]), a1 = cvtpk(P[B_+2], P[B_+3]);                          \
        unsigned b0 = cvtpk(P[B_+4], P[B_+5]), b1 = cvtpk(P[B_+6], P[B_+7]);                                             \
        auto r0 = __builtin_amdgcn_permlane32_swap(a0, b0, false, false); auto r1 = __builtin_amdgcn_permlane32_swap(a1, b1, false, false); \
        v4u w = {r0[0], r1[0], r0[1], r1[1]}; OUT = *reinterpret_cast<bf16x8*>(&w); } while (0)
    PK4(p0, 0, pa0); PK4(p0, 8, pa1); PK4(p1, 0, pa2); PK4(p1, 8, pa3);
#undef PK4
}
__device__ __forceinline__ void qkt(f32x16& p0, f32x16& p1, const char* Kb, int r32, int hi, const bf16x8* qr) {
    p0 = f32x16{}; p1 = f32x16{};
    const char* kb[4];
#pragma unroll
    for (int dd = 0; dd < 4; ++dd) kb[dd] = Kb + KSWZ(r32, (dd * 16 + hi * 8) * 2);
#pragma unroll
    for (int g = 0; g < 2; ++g) { bf16x8 b0[6], b1[6];
#pragma unroll
        for (int i = 0; i < 6; ++i) { const int d0 = 6 * g + i; const char* a = kb[d0 & 3] + (d0 >> 2) * 128; b0[i] = *reinterpret_cast<const bf16x8*>(a); b1[i] = *reinterpret_cast<const bf16x8*>(a + 32 * 384); }
        SBAR();
        __builtin_amdgcn_s_setprio(1);
#pragma unroll
        for (int i = 0; i < 6; ++i) { p0 = __builtin_amdgcn_mfma_f32_32x32x16_bf16(b0[i], qr[6 * g + i], p0, 0, 0, 0); p1 = __builtin_amdgcn_mfma_f32_32x32x16_bf16(b1[i], qr[6 * g + i], p1, 0, 0, 0); }
        __builtin_amdgcn_s_setprio(0);
        SBAR(); }
}
__device__ __forceinline__ void pv_tile(f32x16* o, int vb0, bf16x8 pa0, bf16x8 pa1, bf16x8 pa2, bf16x8 pa3) {
#define TRRD(dst, off) asm volatile("ds_read_b64_tr_b16 %0, %1 offset:%2" : "=&v"(dst) : "v"(vb0), "i"(off) : "memory")
#define PV_RD(S, d0) do { constexpr int b_ = (d0) * 512; TRRD(S##l0, b_); TRRD(S##h0, b_ + 2048); TRRD(S##l1, b_ + 4096); TRRD(S##h1, b_ + 6144); TRRD(S##l2, b_ + 8192); TRRD(S##h2, b_ + 10240); TRRD(S##l3, b_ + 12288); TRRD(S##h3, b_ + 14336); } while (0)
#define PV_MM(S, d0) do { \
        o[d0] = __builtin_amdgcn_mfma_f32_32x32x16_bf16(pa0, (bf16x8){S##l0[0], S##l0[1], S##l0[2], S##l0[3], S##h0[0], S##h0[1], S##h0[2], S##h0[3]}, o[d0], 0, 0, 0);   \
        o[d0] = __builtin_amdgcn_mfma_f32_32x32x16_bf16(pa1, (bf16x8){S##l1[0], S##l1[1], S##l1[2], S##l1[3], S##h1[0], S##h1[1], S##h1[2], S##h1[3]}, o[d0], 0, 0, 0);   \
        o[d0] = __builtin_amdgcn_mfma_f32_32x32x16_bf16(pa2, (bf16x8){S##l2[0], S##l2[1], S##l2[2], S##l2[3], S##h2[0], S##h2[1], S##h2[2], S##h2[3]}, o[d0], 0, 0, 0);   \
        o[d0] = __builtin_amdgcn_mfma_f32_32x32x16_bf16(pa3, (bf16x8){S##l3[0], S##l3[1], S##l3[2], S##l3[3], S##h3[0], S##h3[1], S##h3[2], S##h3[3]}, o[d0], 0, 0, 0); } while (0)
    s16x4 Al0, Al1, Al2, Al3, Ah0, Ah1, Ah2, Ah3, Bl0, Bl1, Bl2, Bl3, Bh0, Bh1, Bh2, Bh3;
    PV_RD(A, 0); PV_RD(B, 1);
    asm volatile("s_waitcnt lgkmcnt(8)" ::: "memory"); SBAR(); PV_MM(A, 0); SBAR();
    PV_RD(A, 2);
    asm volatile("s_waitcnt lgkmcnt(8)" ::: "memory"); SBAR(); PV_MM(B, 1); SBAR();
    PV_RD(B, 3);
    asm volatile("s_waitcnt lgkmcnt(8)" ::: "memory"); SBAR(); PV_MM(A, 2); SBAR();
    asm volatile("s_waitcnt lgkmcnt(0)" ::: "memory"); SBAR(); PV_MM(B, 3);
#undef PV_MM
#undef PV_RD
#undef TRRD
}
__device__ __forceinline__ void attn_unit(int b, int h, int qb, const bf16* Q, const bf16* K, const bf16* V, bf16* O, char* lds) {
    const int tid = threadIdx.x, wid = __builtin_amdgcn_readfirstlane(tid >> 6), lane = tid & 63, r32 = lane & 31, hi = lane >> 5;
    const size_t rowb = (size_t)b * SEQ;
    const int q0 = qb * QB, qlo = q0 + wid * QBLK;
    const int NT = (q0 + QB) / KVBLK;
    char* V_lds = lds + OFF_V; char* K_lds = lds + OFF_K;
#define WAVE_WS() ({ int t_ = (int)threadIdx.x; asm volatile("" : "+v"(t_)); (float*)(lds + OFF_WS) + (t_ >> 6) * 64; })
    LAS unsigned char* ldsl_ = (LAS unsigned char*)lds;
    unsigned ksrc[3], vsrc[2];
#pragma unroll
    for (int j = 0; j < 3; ++j) { const int s_ = (wid * 3 + j) * 64 + lane, row = s_ / 24, pc = s_ % 24; ksrc[j] = (unsigned)(row * 3072 * 2 + ((pc * 16) ^ ((row & 7) << 4))); }
#pragma unroll
    for (int j = 0; j < 2; ++j) { const int ob = ((wid * 2 + j) * 64 + lane) * 16, st = ob >> 9, kr_ = (ob >> 6) & 7, ch = (ob >> 4) & 3, c = (st & 3) * 32 + ch * 8, kk = (st >> 2) * 8 + kr_,
                                  k = (kk & ~0xC) | ((kk & 4) << 1) | ((kk & 8) >> 1); vsrc[j] = (unsigned)(k * 2048 * 2 + c * 2); }
    const char* Kh = (const char*)(K + rowb * 3072 + h * DQK); const char* Vh = (const char*)(V + rowb * 2048 + h * DV);
#define KDMA(k0, bf) do { _Pragma("unroll") for (int j = 0; j < 3; ++j) __builtin_amdgcn_global_load_lds((const unsigned*)(Kh + (size_t)(k0) * (3072 * 2) + ksrc[j]), \
        (LAS unsigned*)(ldsl_ + OFF_K + (bf) * SHM_K + (wid * 3 + j) * 1024), 16, 0, 0); } while (0)
#define VDMA(k0, sl) do { _Pragma("unroll") for (int j = 0; j < 2; ++j) __builtin_amdgcn_global_load_lds((const unsigned*)(Vh + (size_t)(k0) * (2048 * 2) + vsrc[j]), \
        (LAS unsigned*)(ldsl_ + OFF_V + (sl) * SHM_V + (wid * 2 + j) * 1024), 16, 0, 0); } while (0)
    KDMA(0, 0); VDMA(0, 0);
    bf16x8 qr[12];
    { const bf16* Qp = Q + (rowb + qlo + r32) * 3072 + h * DQK + hi * 8;
#pragma unroll
      for (int d0 = 0; d0 < 12; ++d0) qr[d0] = *(const bf16x8*)(Qp + d0 * 16); }
    asm volatile("s_waitcnt vmcnt(0)" ::: "memory");
    __syncthreads();
    float m_reg = -1e30f, l_reg = 0.f; f32x16 o[4] = {};
    const int vbase = (int)(uintptr_t)V_lds + v_rd_base(lane);
    const int qm = qlo + r32 - 4 * hi;
    f32x16 p0, p1;
#define SP_STAGE(VS) do { float mn, alpha; bf16x8 pa0, pa1, pa2, pa3; \
        partialSM(p0, p1, m_reg, mn, alpha); finishSM(p0, p1, alpha, l_reg, pa0, pa1, pa2, pa3); \
        if (__any(alpha < 1.f)) { float* al_l = WAVE_WS() + 32; if (hi == 0) al_l[r32] = alpha; asm volatile("s_waitcnt lgkmcnt(0)" ::: "memory"); \
            _Pragma("unroll") for (int d_ = 0; d_ < 4; ++d_) _Pragma("unroll") for (int r = 0; r < 16; ++r) o[d_][r] *= al_l[crow(r, hi)]; } \
        SBAR(); pv_tile(o, vbase + (VS) * SHM_V, pa0, pa1, pa2, pa3); } while (0)
    for (int t = 0; t < NT; ++t) {
        const int cur = t & 1, kb_ = t * KVBLK;
        if (t + 1 < NT) { KDMA((t + 1) * KVBLK, cur ^ 1); VDMA((t + 1) * KVBLK, cur ^ 1); }
        SBAR();
        qkt(p0, p1, K_lds + cur * SHM_K, r32, hi, qr); if (kb_ + KVBLK - 1 > qlo) mask_tile(p0, p1, qm - kb_);
        SBAR();
        SP_STAGE(cur);
        asm volatile("s_waitcnt vmcnt(0)" ::: "memory");
        __syncthreads();
    }
#undef SP_STAGE
    float* li_l = WAVE_WS();
    if (hi == 0) li_l[r32] = l_reg; asm volatile("s_waitcnt lgkmcnt(0)" ::: "memory");
    float rli[16];
#pragma unroll
    for (int r = 0; r < 16; ++r) rli[r] = __builtin_amdgcn_rcpf(li_l[crow(r, hi)]);
    bf16* Ow = O + (rowb + qlo) * 2048 + h * DV;
#pragma unroll
    for (int r = 0; r < 16; ++r) { const int orow = crow(r, hi);
#pragma unroll
        for (int d0 = 0; d0 < 4; ++d0) { const float v = o[d0][r] * rli[r];
            const float vn = __shfl_xor(v, 1);
            if ((r32 & 1) == 0) *(unsigned*)(Ow + (size_t)orow * 2048 + d0 * 32 + r32) = cvtpk(v, vn); } }
    __syncthreads();
#undef KDMA
#undef VDMA
#undef WAVE_WS
}
#undef SBAR
}

struct Args { const float* in[20]; float* out; unsigned char* ws; int ph_lo, ph_hi, coop, pad; };
#define XB_TMO      128
#define XB_XCNT(j)  (256  + 64 * (j))
#define XB_XSUB(j)  (1280 + 64 * (j))
#define XB_XGEN(j)  (2304 + 64 * (j))
#define XB_TOP      3328
#define XB_TOPGEN   3392
#define XCD_BAR_WORDS 3456
#define XB_SPIN_CAP (1u << 20)
__device__ __forceinline__ unsigned xb_ld(unsigned* p)              { return __hip_atomic_load(p, __ATOMIC_RELAXED, __HIP_MEMORY_SCOPE_AGENT); }
__device__ __forceinline__ unsigned xb_add(unsigned* p, unsigned v) { return __hip_atomic_fetch_add(p, v, __ATOMIC_RELAXED, __HIP_MEMORY_SCOPE_AGENT); }
__device__ __forceinline__ unsigned xb_xcc_id() { return (unsigned)__builtin_amdgcn_s_getreg((3 << 11) | 20) & 0xFu; }
#define XB_SPIN(cond, bar) do { unsigned _sp = 0; while (cond) { __builtin_amdgcn_s_sleep(1); \
    if ((++_sp & 255u) == 0u) { if (xb_ld(&(bar)[XB_TMO])) break; if (_sp > XB_SPIN_CAP) { atomicAdd(&(bar)[XB_TMO], 1u); break; } } } } while (0)
__device__ __forceinline__ void xcd_barrier_complete(unsigned* bar, unsigned x, unsigned& nloc, unsigned& nx) {
    const unsigned G = gridDim.x;
    unsigned sum, cnt, mine, sp = 0u;
    for (;;) {
        sum = 0u; cnt = 0u; mine = 0u;
#pragma unroll
        for (unsigned j = 0; j < 16; ++j) { const unsigned c = xb_ld(&bar[XB_XCNT(j)]); sum += c; cnt += (c > 0u) ? 1u : 0u; mine = (j == x) ? c : mine; }
        if (sum == G) break;
        __builtin_amdgcn_s_sleep(1);
        if ((++sp & 255u) == 0u) { if (xb_ld(&bar[XB_TMO])) break; if (sp > XB_SPIN_CAP) { atomicAdd(&bar[XB_TMO], 1u); break; } }
    }
    nloc = mine > 0u ? mine : 1u; nx = cnt > 0u ? cnt : 1u;
}
__device__ __forceinline__ void grid_bar(unsigned* bar, volatile LAS unsigned* st) {
    asm volatile("s_waitcnt vmcnt(0)" ::: "memory");
    __syncthreads();
    if (threadIdx.x == 0) {
        const unsigned x = xb_xcc_id();
        __builtin_amdgcn_s_waitcnt(0);
        unsigned nloc = st[0], nx = st[1];
        if (nloc == 0u) { xcd_barrier_complete(bar, x, nloc, nx); st[0] = nloc; st[1] = nx; }
        const unsigned old = xb_add(&bar[XB_XSUB(x)], 1u);
        const unsigned gen = old / nloc;
        if (old + 1u == (gen + 1u) * nloc) {
            __builtin_amdgcn_fence(__ATOMIC_RELEASE, "agent");
            asm volatile("s_waitcnt vmcnt(0)" ::: "memory");
            const unsigned og = xb_add(&bar[XB_TOP], 1u);
            const unsigned tg = og / nx;
            if (og + 1u == (tg + 1u) * nx) xb_add(&bar[XB_TOPGEN], 1u);
            else XB_SPIN(xb_ld(&bar[XB_TOPGEN]) == tg, bar);
            __builtin_amdgcn_fence(__ATOMIC_ACQUIRE, "agent");
            xb_add(&bar[XB_XGEN(x)], 1u);
            asm volatile("s_waitcnt vmcnt(0)" ::: "memory");
        } else {
            XB_SPIN(xb_ld(&bar[XB_XGEN(x)]) == gen, bar);
            __builtin_amdgcn_fence(__ATOMIC_ACQUIRE, "agent");
            asm volatile("s_waitcnt vmcnt(0)" ::: "memory");
        }
    }
    __syncthreads();
}
constexpr int NPH = 11;

__global__ void __launch_bounds__(NWAVES * 64, 2) mega_fwd(Args args) {
    extern __shared__ __attribute__((aligned(16))) unsigned char lds[];
    LAS unsigned char* ldsl = (LAS unsigned char*)lds;
    const int tid = threadIdx.x, lane = tid & 63, wave = __builtin_amdgcn_readfirstlane(tid >> 6);
    const int G = gridDim.x, bx = blockIdx.x;
    const int vcu = (G % 8 == 0) ? (bx % 8) * (G / 8) + bx / 8 : bx;
    const int gw = vcu * NWAVES + wave, NGW = G * NWAVES;
    unsigned char* ws = args.ws;
    const float* const* kin = (const float* const*)__builtin_amdgcn_kernarg_segment_ptr();
    const float* svec = (const float*)ws;
    const float* b_gate = svec + SV_BGATE; const float* q_a_norm_g = svec + SV_QAG; const float* kv_a_norm_g = svec + SV_KVAG; const float* q_norm_g = svec + SV_QNG;
    const float* k_norm_g = svec + SV_KNG; const float* pool_scale = svec + SV_PSC; const float* ffn_norm_g = svec + SV_FNG; const int* positions = (const int*)(svec + SV_POS);
    bf16* WIN_T = (bf16*)(ws + WS_WIN); bf16* WQB_T = (bf16*)(ws + WS_WQB); bf16* WKVB_T = (bf16*)(ws + WS_WKVB); bf16* WPG_T = (bf16*)(ws + WS_WPG);
    bf16* WPO_T = (bf16*)(ws + WS_WPO); bf16* WAO_T = (bf16*)(ws + WS_WAO); bf16* WOUT_T = (bf16*)(ws + WS_WOUT); bf16* WGU_T = (bf16*)(ws + WS_WGU); bf16* WDN_T = (bf16*)(ws + WS_WDN);
    bf16* XN = (bf16*)(ws + WS_XN); float* C1 = (float*)(ws + WS_C1); float* KRP = (float*)(ws + WS_KRP); bf16* U = (bf16*)(ws + WS_U); bf16* Gt = (bf16*)(ws + WS_G);
    bf16* CN = (bf16*)(ws + WS_CN); bf16* POOLED = (bf16*)(ws + WS_POOLED); bf16* Qb = (bf16*)(ws + WS_Q); bf16* Kb = (bf16*)(ws + WS_K); bf16* Vb = (bf16*)(ws + WS_V);
    bf16* PG = (bf16*)(ws + WS_PG); bf16* MP = (bf16*)(ws + WS_MP); bf16* Ob = (bf16*)(ws + WS_O); bf16* MIXED = (bf16*)(ws + WS_MIXED);
    float* X1 = (float*)(ws + WS_X1); bf16* H2 = (bf16*)(ws + WS_H2); bf16* ACT = (bf16*)(ws + WS_ACT);

    const int lo = args.ph_lo, hi_ph = args.ph_hi;
#ifndef PHMASK
#define PHMASK 0x7ff
#endif
#define IN(k) (((PHMASK >> (k)) & 1) && lo <= (k) && (k) < hi_ph)
#define SEAM(k) do { if (IN(k) && IN((k) + 1)) { unsigned char* w2_ = args.ws; asm volatile("" : "+s"(w2_)); grid_bar((unsigned*)(w2_ + WS_BAR), (volatile LAS unsigned*)(ldsl + 140032)); } } while (0)
    if (args.coop > 1) cg::this_grid().sync();
    if (threadIdx.x < 2) ((volatile LAS unsigned*)(ldsl + 140032))[threadIdx.x] = 0u;
    __syncthreads();
    if (args.coop && threadIdx.x == 0) { unsigned char* w2_ = args.ws; asm volatile("" : "+s"(w2_)); (void)xb_add(&((unsigned*)(w2_ + WS_BAR))[XB_XCNT(xb_xcc_id())], 1u); }
    LAS float* scr = (LAS float*)(ldsl + wave * 16384);
#ifdef TPROBE
#define TP_BEGIN(k) do { if ((TPROBE >> (k)) & 1) { if (blockIdx.x == 0 && threadIdx.x == 0) { *(volatile LAS unsigned*)(ldsl + 140000) = (unsigned)__builtin_amdgcn_s_memrealtime(); } } } while (0)
#define TP_END(k) do { if ((TPROBE >> (k)) & 1) { if (blockIdx.x == 0 && threadIdx.x == 0) { volatile LAS unsigned* tp_ = (volatile LAS unsigned*)(ldsl + 140000); tp_[1] += (unsigned)__builtin_amdgcn_s_memrealtime() - tp_[0]; } } } while (0)
    if (blockIdx.x == 0 && threadIdx.x == 0) { ((volatile LAS unsigned*)(ldsl + 140000))[1] = 0u; }
#else
#define TP_BEGIN(k) do {} while (0)
#define TP_END(k) do {} while (0)
#endif

    if (IN(0)) { TP_BEGIN(0);
        { float* sv = (float*)ws; const int gt = bx * (NWAVES * 64) + tid, GT = G * NWAVES * 64;
          for (int i = gt; i < M; i += GT) sv[SV_SS + i] = 0.f;
          for (int i = gt; i < SV_END; i += GT) { int idx, off, lim = 1 << 30;
              if (i < SV_QAG) { idx = 4; off = SV_BGATE; } else if (i < SV_KVAG) { idx = 5; off = SV_QAG; } else if (i < SV_QNG) { idx = 7; off = SV_KVAG; }
              else if (i < SV_KNG) { idx = 9; off = SV_QNG; lim = 192; } else if (i < SV_PSC) { idx = 10; off = SV_KNG; lim = 192; }
              else if (i < SV_FNG) { idx = 13; off = SV_PSC; } else if (i < SV_POS) { idx = 16; off = SV_FNG; } else { idx = 1; off = SV_POS; }
              const float* src = kin[idx]; sv[i] = (i - off < lim) ? src[i - off] : 0.f; } }
        constexpr int I_IN = (DM / 64) * (DIN / 32), I_QB = (QLORA / 64) * (NH * DQK / 32), I_KVB = (KVLORA / 64) * (NH * 256 / 32), I_PG = (256 / 64) * (256 / 32),
                      I_PO = (POOLW / 64) * (DM / 32), I_AO = (DM / 64) * (DM / 32), I_OUT = I_AO;
        constexpr int NITEMS = I_IN + I_QB + I_KVB + 4 * I_PG + I_PO + I_AO + I_OUT;
#define P0_DESC(it__) ([&]() { int r = (it__), idx, Kd, Nd, mode = 0, roff = 0; size_t dsto, srco = 0; \
            if (r < I_IN) { idx = 3; Kd = DM; Nd = DIN; mode = 1; dsto = WS_WIN; } \
            else if ((r -= I_IN) < I_QB) { idx = 6; Kd = QLORA; Nd = NH * DQK; dsto = WS_WQB; } \
            else if ((r -= I_QB) < I_KVB) { idx = 8; Kd = KVLORA; Nd = NH * 256; dsto = WS_WKVB; } \
            else if ((r -= I_KVB) < 4 * I_PG) { const int g = r / I_PG; r = r % I_PG; idx = 12; Kd = 256; Nd = 256; dsto = WS_WPG; roff = g * 256; srco = (size_t)g * 65536; } \
            else if ((r -= 4 * I_PG) < I_PO) { idx = 14; Kd = POOLW; Nd = DM; dsto = WS_WPO; } \
            else if ((r -= I_PO) < I_AO) { idx = 11; Kd = DM; Nd = DM; dsto = WS_WAO; } \
            else { r -= I_AO; idx = 15; Kd = DM; Nd = DM; dsto = WS_WOUT; } \
            return tr_desc(kin[idx] + srco, Kd, Nd, (bf16*)(ws + dsto), mode, roff, r, nullptr); }())
        TR_PIPELINE(gw, NITEMS, NGW, P0_DESC);
#undef P0_DESC
        { v4u* z = (v4u*)(WIN_T + (size_t)DIN * DM); const int nz = (DIN_PAD - DIN) * DM / 8;
          for (int i = gw * 64 + lane; i < nz; i += NGW * 64) z[i] = (v4u){0u, 0u, 0u, 0u}; }
        { const float* x = kin[0]; const float* attn_norm_g = kin[2];
          for (int m = gw; m < M; m += NGW) rms_row_2048(x + (size_t)m * DM, attn_norm_g, XN + (size_t)m * DM, lane); }
    TP_END(0); }
    SEAM(0);
    if (IN(1)) { TP_BEGIN(1);
        { pg8::Gemm g{XN, WIN_T, M, 6144, DM, DM, DM, 0, 0}; pg8::StaticOrder S; S.init(M, 6144, G, bx);
          pg8::EpiIn E{C1, U, Gt, b_gate};
          pg8::gemm_phase<pg8::EpiIn, pg8::StaticOrder>(ldsl, g, S, E); }
        { pg8::Gemm g{XN, WIN_T + (size_t)6144 * DM, M, 2048, 256, DM, DM, 256, 256}; pg8::StaticOrder S; S.init(M, 2048, G, bx);
          pg8::EpiKRP E{KRP};
          pg8::gemm_phase<pg8::EpiKRP, pg8::StaticOrder>(ldsl, g, S, E); }
    TP_END(1); }
    SEAM(1);
    if (IN(2)) { TP_BEGIN(2);
        for (int m = gw; m < M; m += NGW) {
            const f32x4* c = (const f32x4*)(C1 + (size_t)m * 1024) + lane; f32x4 v[4]; float sq = 0.f, skv = 0.f;
#pragma unroll
            for (int j = 0; j < 4; ++j) { v[j] = __builtin_nontemporal_load(c + 64 * j); const float s = (v[j].x * v[j].x + v[j].y * v[j].y) + (v[j].z * v[j].z + v[j].w * v[j].w); if (j < 2) sq += s; else skv += s; }
            const float iq = 1.0f / sqrtf(wave_sum(sq) * (1.f / 512.f) + EPS), ikv = 1.0f / sqrtf(wave_sum(skv) * (1.f / 512.f) + EPS);
            if (lane < 16) { f32x4 acc4 = {0.f, 0.f, 0.f, 0.f};
#pragma unroll
                for (int ks = 0; ks < 8; ++ks) acc4 += __builtin_nontemporal_load((const f32x4*)(KRP + ((size_t)ks * 8192 + m) * 64 + 4 * lane));
                *(f32x4*)((float*)(ws + WS_KR) + (size_t)m * 64 + 4 * lane) = acc4; }
            v2u* o8 = (v2u*)(CN + (size_t)m * 1024) + lane;
#pragma unroll
            for (int j = 0; j < 4; ++j) { const f32x4 gv = (j < 2) ? ((const f32x4*)q_a_norm_g)[lane + 64 * j] : ((const f32x4*)kv_a_norm_g)[lane + 64 * (j - 2)]; const float iv = (j < 2) ? iq : ikv;
                v2u o; o.x = cvtpk(v[j].x * iv * gv.x, v[j].y * iv * gv.y); o.y = cvtpk(v[j].z * iv * gv.z, v[j].w * iv * gv.w); o8[64 * j] = o; }
        }
        for (int base = gw * 4; base < M; base += NGW * 4) {
            const int s0 = base & (SEQ - 1);
#pragma unroll
            for (int jj = 0; jj < 2; ++jj) {
                const int col = 8 * lane + 512 * jj, grp = col >> 8, w = 2 << grp; int cnt = (s0 + 1 < w) ? s0 + 1 : w;
                float a[8], uc[8];
#pragma unroll
                for (int e = 0; e < 8; ++e) a[e] = 0.f;
#pragma unroll
                for (int d = 0; d < 16; ++d) {
                    if (d < cnt) { const v4u q = *(const v4u*)(U + (size_t)(base - d) * 1024 + col);
                        const float f[8] = {bflo(q.x), bfhi(q.x), bflo(q.y), bfhi(q.y), bflo(q.z), bfhi(q.z), bflo(q.w), bfhi(q.w)};
#pragma unroll
                        for (int e = 0; e < 8; ++e) { a[e] += f[e]; if (d == 0) uc[e] = f[e]; } }
                }
#pragma unroll
                for (int i = 0; i < 4; ++i) {
                    const int m = base + i;
                    if (i > 0) { const int s = s0 + i;
                        { const v4u q = *(const v4u*)(U + (size_t)m * 1024 + col);
                          uc[0] = bflo(q.x); uc[1] = bfhi(q.x); uc[2] = bflo(q.y); uc[3] = bfhi(q.y); uc[4] = bflo(q.z); uc[5] = bfhi(q.z); uc[6] = bflo(q.w); uc[7] = bfhi(q.w); }
#pragma unroll
                        for (int e = 0; e < 8; ++e) a[e] += uc[e];
                        if (s >= w) { const v4u q = *(const v4u*)(U + (size_t)(m - w) * 1024 + col);
                            a[0] -= bflo(q.x); a[1] -= bfhi(q.x); a[2] -= bflo(q.y); a[3] -= bfhi(q.y); a[4] -= bflo(q.z); a[5] -= bfhi(q.z); a[6] -= bflo(q.w); a[7] -= bfhi(q.w); }
                        cnt = (s + 1 < w) ? s + 1 : w; }
                    const float rc = 1.0f / (float)cnt;
                    v4u o; o.x = cvtpk(a[0] * rc - uc[0], a[1] * rc - uc[1]); o.y = cvtpk(a[2] * rc - uc[2], a[3] * rc - uc[3]);
                    o.z = cvtpk(a[4] * rc - uc[4], a[5] * rc - uc[5]); o.w = cvtpk(a[6] * rc - uc[6], a[7] * rc - uc[7]);
                    *(v4u*)(POOLED + (size_t)m * 1024 + col) = o;
                }
            }
        }
    TP_END(2); }
    SEAM(2);
    if (IN(3)) { TP_BEGIN(3);
        { pg8::Gemm g{CN, WQB_T, M, NH * DQK, QLORA, 1024, QLORA, 0, 0}; pg8::StaticOrder S; S.init(M, NH * DQK, G, bx);
          pg8::EpiBf16 E{Qb, 3072}; pg8::gemm_phase<pg8::EpiBf16, pg8::StaticOrder>(ldsl, g, S, E); }
        { pg8::Gemm g{CN + 512, WKVB_T, M, NH * 256, KVLORA, 1024, KVLORA, 0, 0}; pg8::StaticOrder S; S.init(M, NH * 256, G, bx);
          pg8::EpiKV E{Kb, Vb}; pg8::gemm_phase<pg8::EpiKV, pg8::StaticOrder>(ldsl, g, S, E); }
        { pg8::Gemm g{POOLED, WPG_T, M, POOLW, 256, 1024, 256, 256, 0}; pg8::StaticOrder S; S.init(M, POOLW, G, (bx + 128) % G);
          pg8::EpiScale E{PG, 1024, pool_scale}; pg8::gemm_phase<pg8::EpiScale, pg8::StaticOrder>(ldsl, g, S, E); }
    TP_END(3); }
    SEAM(3);
    if (IN(4)) { TP_BEGIN(4);
        for (int m = gw; m < M; m += NGW) {
            const float pos = (float)positions[m];
            const int sub = lane & 3, h = lane >> 2;
            float cs[8], sn[8];
#pragma unroll
            for (int j = 0; j < 8; ++j) { const int i = 8 * sub + j; const float invf = __builtin_amdgcn_exp2f(-(float)i * (13.287712379549449f / 32.f));
                const float ang = pos * invf; const float k = rintf(ang * 0.15915494309189535f);
                float r = fmaf(-k, 6.2831854820251465f, ang); r = fmaf(-k, -1.7484555e-7f, r);
                sn[j] = __sinf(r); cs[j] = __cosf(r); }
#pragma unroll
            for (int which = 0; which < 2; ++which) {
                bf16* base = (which == 0 ? Qb : Kb) + (size_t)m * 3072 + h * DQK;
                const float* gn = (which == 0) ? q_norm_g : k_norm_g;
                float nv[32], rl[8], rh[8]; float ss = 0.f;
#pragma unroll
                for (int jj = 0; jj < 4; ++jj) { const v4u q = *(const v4u*)(base + 32 * sub + 8 * jj);
                    nv[8 * jj + 0] = bflo(q.x); nv[8 * jj + 1] = bfhi(q.x); nv[8 * jj + 2] = bflo(q.y); nv[8 * jj + 3] = bfhi(q.y);
                    nv[8 * jj + 4] = bflo(q.z); nv[8 * jj + 5] = bfhi(q.z); nv[8 * jj + 6] = bflo(q.w); nv[8 * jj + 7] = bfhi(q.w); }
                if (which == 0) {
                    const v4u a = *(const v4u*)(base + 128 + 8 * sub), b = *(const v4u*)(base + 160 + 8 * sub);
                    rl[0] = bflo(a.x); rl[1] = bfhi(a.x); rl[2] = bflo(a.y); rl[3] = bfhi(a.y); rl[4] = bflo(a.z); rl[5] = bfhi(a.z); rl[6] = bflo(a.w); rl[7] = bfhi(a.w);
                    rh[0] = bflo(b.x); rh[1] = bfhi(b.x); rh[2] = bflo(b.y); rh[3] = bfhi(b.y); rh[4] = bflo(b.z); rh[5] = bfhi(b.z); rh[6] = bflo(b.w); rh[7] = bfhi(b.w);
                } else {
                    const float* kp = (const float*)(ws + WS_KR) + (size_t)m * 64 + 8 * sub;
                    const f32x4 a0 = *(const f32x4*)kp, a1 = *(const f32x4*)(kp + 4), b0 = *(const f32x4*)(kp + 32), b1 = *(const f32x4*)(kp + 36);
                    rl[0] = a0.x; rl[1] = a0.y; rl[2] = a0.z; rl[3] = a0.w; rl[4] = a1.x; rl[5] = a1.y; rl[6] = a1.z; rl[7] = a1.w;
                    rh[0] = b0.x; rh[1] = b0.y; rh[2] = b0.z; rh[3] = b0.w; rh[4] = b1.x; rh[5] = b1.y; rh[6] = b1.z; rh[7] = b1.w;
                }
#pragma unroll
                for (int e = 0; e < 32; ++e) ss += nv[e] * nv[e];
#pragma unroll
                for (int e = 0; e < 8; ++e) ss += rl[e] * rl[e] + rh[e] * rh[e];
                ss += __shfl_xor(ss, 1); ss += __shfl_xor(ss, 2);
                const float inv = 1.0f / sqrtf(ss * (1.f / 192.f) + EPS);
#pragma unroll
                for (int jj = 0; jj < 4; ++jj) { const f32x4 g0 = *(const f32x4*)(gn + 32 * sub + 8 * jj), g1 = *(const f32x4*)(gn + 32 * sub + 8 * jj + 4);
                    v4u o; o.x = cvtpk(nv[8 * jj + 0] * inv * g0.x, nv[8 * jj + 1] * inv * g0.y); o.y = cvtpk(nv[8 * jj + 2] * inv * g0.z, nv[8 * jj + 3] * inv * g0.w);
                    o.z = cvtpk(nv[8 * jj + 4] * inv * g1.x, nv[8 * jj + 5] * inv * g1.y); o.w = cvtpk(nv[8 * jj + 6] * inv * g1.z, nv[8 * jj + 7] * inv * g1.w);
                    *(v4u*)(base + 32 * sub + 8 * jj) = o; }
                float ol[8], oh[8];
#pragma unroll
                for (int e = 0; e < 8; ++e) { const float a = rl[e] * inv * gn[128 + 8 * sub + e], b = rh[e] * inv * gn[160 + 8 * sub + e];
                    ol[e] = a * cs[e] - b * sn[e]; oh[e] = b * cs[e] + a * sn[e]; }
                v4u o1, o2; o1.x = cvtpk(ol[0], ol[1]); o1.y = cvtpk(ol[2], ol[3]); o1.z = cvtpk(ol[4], ol[5]); o1.w = cvtpk(ol[6], ol[7]);
                o2.x = cvtpk(oh[0], oh[1]); o2.y = cvtpk(oh[2], oh[3]); o2.z = cvtpk(oh[4], oh[5]); o2.w = cvtpk(oh[6], oh[7]);
                *(v4u*)(base + 128 + 8 * sub) = o1; *(v4u*)(base + 160 + 8 * sub) = o2;
            }
        }
        { pg8::Gemm g{PG, WPO_T, M, DM, POOLW, POOLW, POOLW, 0, 0}; pg8::StaticOrder S; S.init(M, DM, G, bx);
          pg8::EpiGate<false> E{MP, Gt, nullptr, 0}; pg8::gemm_phase<pg8::EpiGate<false>, pg8::StaticOrder>(ldsl, g, S, E); }
    TP_END(4); }
    SEAM(4);
    if (IN(5)) { TP_BEGIN(5);
        const int npair = BATCH * NH * 8;
        for (int p = vcu; p < npair; p += G) {
            const int bh = p >> 3, s = p & 7;
            att::attn_unit(bh / NH, bh % NH, 15 - s, Qb, Kb, Vb, Ob, (char*)lds);
            att::attn_unit(bh / NH, bh % NH, s, Qb, Kb, Vb, Ob, (char*)lds);
        }
    TP_END(5); }
    SEAM(5);
    if (IN(6)) { TP_BEGIN(6);
        pg8::Gemm g{Ob, WAO_T, M, DM, DM, DM, DM, 0, 0}; pg8::StaticOrder S; S.init(M, DM, G, bx);
        pg8::EpiGate<true> E{MIXED, Gt, MP, 2048}; pg8::gemm_phase<pg8::EpiGate<true>, pg8::StaticOrder>(ldsl, g, S, E);
    TP_END(6); }
    SEAM(6);
    if (IN(7)) { TP_BEGIN(7);
        { constexpr int I_G = (DM / 64) * (DFF / 32);
#define GU_DESC(it__) ((it__) < I_G ? tr_desc(kin[17], DM, DFF, (bf16*)(ws + WS_WGU), 2, 0, (it__), ffn_norm_g) : tr_desc(kin[18], DM, DFF, (bf16*)(ws + WS_WGU), 3, 0, (it__) - I_G, ffn_norm_g))
          TR_PIPELINE(gw, 2 * I_G, NGW, GU_DESC);
#undef GU_DESC
          __syncthreads(); }
        pg8::Gemm g{MIXED, WOUT_T, M, DM, DM, DM, DM, 0, 0}; pg8::StaticOrder S; S.init(M, DM, G, bx);
        pg8::EpiResNorm E{kin[0], X1, (bf16*)(ws + WS_X1B), (float*)ws + SV_SS, DM}; pg8::gemm_phase<pg8::EpiResNorm, pg8::StaticOrder>(ldsl, g, S, E);
    TP_END(7); }
    SEAM(7);
    if (IN(9)) { TP_BEGIN(9);
        pg8::Gemm g{(bf16*)(ws + WS_X1B), WGU_T, M, 2 * DFF, DM, DM, DM, 0, 0}; pg8::StaticOrder S; S.init(M, 2 * DFF, G, bx);
        pg8::EpiSwiGLU E{ACT, DFF, (const float*)ws + SV_SS}; pg8::gemm_phase<pg8::EpiSwiGLU, pg8::StaticOrder>(ldsl, g, S, E);
        if (G == 256 ? (bx >= 128) : true) {
            constexpr int I_D2 = (DFF / 64) * (DM / 32);
            const int nw = (G == 256) ? 128 * NWAVES : NGW, w0 = (G == 256) ? (bx - 128) * NWAVES + wave : gw;
#define DN_DESC(it__) tr_desc(kin[19], DFF, DM, (bf16*)(ws + WS_WDN), 0, 0, (it__), nullptr)
            TR_PIPELINE(w0, I_D2, nw, DN_DESC);
#undef DN_DESC
        }
    TP_END(9); }
    SEAM(9);
    if (IN(10)) { TP_BEGIN(10);
        pg8::Gemm g{ACT, WDN_T, M, DM, DFF, DFF, DFF, 0, 0}; pg8::StaticOrder S; S.init(M, DM, G, bx);
        pg8::EpiRes E{X1, args.out, DM}; pg8::gemm_phase<pg8::EpiRes, pg8::StaticOrder>(ldsl, g, S, E);
    TP_END(10); }
#ifdef TPROBE
    if (blockIdx.x == 0 && threadIdx.x == 0) { const unsigned w_ = 4u * ((volatile LAS unsigned*)(ldsl + 140000))[1]; const unsigned long long t0_ = __builtin_amdgcn_s_memrealtime(); while ((unsigned)(__builtin_amdgcn_s_memrealtime() - t0_) < w_) __builtin_amdgcn_s_sleep(8); }
#endif
#undef IN
#undef SEAM
}

extern "C" void kernel_launch(void* const* d_in, const int* in_sizes, int n_in, void* d_out, int out_size, void* d_ws, size_t ws_size, hipStream_t stream) {
    static int grid = 0;
    if (grid == 0) {
        if (n_in != 20 || out_size != M * DM || ws_size < WS_END) { fprintf(stderr, "kernel_launch: unexpected shapes (n_in %d, out %d, ws %zu)\n", n_in, out_size, ws_size); grid = -1; return; }
        int dev = 0, cus = 0, per_cu = 0;
        (void)hipGetDevice(&dev); (void)hipDeviceGetAttribute(&cus, hipDeviceAttributeMultiprocessorCount, dev);
        if (hipFuncSetAttribute((const void*)mega_fwd, hipFuncAttributeMaxDynamicSharedMemorySize, LDS_BYTES) != hipSuccess) { fprintf(stderr, "kernel_launch: hipFuncSetAttribute failed\n"); grid = -1; return; }
        if (hipOccupancyMaxActiveBlocksPerMultiprocessor(&per_cu, (const void*)mega_fwd, NWAVES * 64, LDS_BYTES) != hipSuccess || per_cu < 1) { fprintf(stderr, "kernel_launch: occupancy query says %d\n", per_cu); per_cu = 1; }
        (void)hipGetLastError();
        grid = cus > 0 ? cus : 256;
    }
    if (grid < 0) return;
    Args a{};
    for (int i = 0; i < 20; ++i) a.in[i] = (const float*)d_in[i];
    a.out = (float*)d_out; a.ws = (unsigned char*)d_ws;
    if (MK_N_LAUNCHES == 1) {
        a.ph_lo = 0; a.ph_hi = NPH; a.coop = 1;
        (void)hipMemsetAsync((char*)d_ws + WS_BAR, 0, 16384, stream);
        void* kargs[] = {&a};
        hipError_t e = hipLaunchCooperativeKernel((const void*)mega_fwd, dim3(grid), dim3(NWAVES * 64), kargs, LDS_BYTES, stream);
        if (e != hipSuccess) fprintf(stderr, "kernel_launch: cooperative launch failed: %s (grid %d)\n", hipGetErrorString(e), grid);
    } else {
        for (int p = 0; p < NPH; ++p) {
            a.ph_lo = p; a.ph_hi = p + 1;
            hipLaunchKernelGGL(mega_fwd, dim3(grid), dim3(NWAVES * 64), LDS_BYTES, stream, a);
        }
    }
}
```

```cpp
#include <hip/hip_runtime.h>
#include <hip/hip_cooperative_groups.h>
#include <cstdio>
#include <cstdint>
namespace cg = cooperative_groups;

#ifndef MK_N_LAUNCHES
#define MK_N_LAUNCHES 1
#endif

namespace pg8 {
#define PG8_LAS __attribute__((address_space(3)))
typedef unsigned short bf16_t;
typedef short bf16x8 __attribute__((ext_vector_type(8)));
typedef float f32x4 __attribute__((ext_vector_type(4)));
typedef unsigned u32x4 __attribute__((ext_vector_type(4)));
constexpr int BM = 256, BK = 64, HALF = 128, HTB = HALF * BK * 2, STAGE_BYTES = 8 * HTB, NXCD = 8, WGM = 8;

__host__ __device__ __forceinline__ int lds_byte(int r, int c) { const int st = (r >> 4) * 2 + (c >> 5), rr = r & 15, cc = c & 31, ob = rr * 64 + cc * 2; return st * 1024 + (ob ^ (((ob >> 9) & 1) << 5)); }
__host__ __device__ __forceinline__ void stage_rc(int b, int& R, int& C) { const int st = b / 1024, sb = b % 1024, swz = sb ^ (((sb >> 9) & 1) << 5); R = (st >> 1) * 16 + swz / 64; C = (st & 1) * 32 + (swz % 64) / 2; }
__host__ __device__ __forceinline__ int perm32(int rho) { const int n = rho >> 4, i = rho & 15; return 8 * (i >> 2) + 4 * n + (i & 3); }

struct Unit { int pm, pn; };
struct Gemm { const bf16_t* A; const bf16_t* Bt; int M, N, K, lda, ldb, a_pn_step, b_pn_step; };

struct StaticOrder {
    int nM, nN, nwg, G, c;
    __host__ __device__ void init(int M, int N, int G_, int c_) { nM = M / BM; nN = N / BM; nwg = nM * nN; G = G_; c = c_; }
    __host__ __device__ bool next(int i, Unit& u) const {
        const long L = (long)i * G + c; if (L >= nwg) return false;
        int wgid = (int)L; { const int q = nwg / NXCD, r = nwg % NXCD, xcd = wgid % NXCD, off = wgid / NXCD; wgid = (xcd < r ? xcd * (q + 1) : r * (q + 1) + (xcd - r) * q) + off; }
        const int nig = WGM * nN, gid = wgid / nig, fm = gid * WGM, gsz = (nM - fm) < WGM ? (nM - fm) : WGM;
        u.pm = fm + ((wgid % nig) % gsz); u.pn = (wgid % nig) / gsz; return true;
    }
};

typedef float f32x2_t_ __attribute__((ext_vector_type(2))); typedef __bf16 bf16x2_t_ __attribute__((ext_vector_type(2)));
__device__ __forceinline__ unsigned cvt_pk_bf16(float lo, float hi) { f32x2_t_ v = {lo, hi}; bf16x2_t_ b = __builtin_convertvector(v, bf16x2_t_); return __builtin_bit_cast(unsigned, b); }
__device__ __forceinline__ u32x4 pack8(f32x4 a, f32x4 b) { u32x4 w; w.x = cvt_pk_bf16(a[0], a[1]); w.y = cvt_pk_bf16(a[2], a[3]); w.z = cvt_pk_bf16(b[0], b[1]); w.w = cvt_pk_bf16(b[2], b[3]); return w; }
__device__ __forceinline__ void unpack8(u32x4 w, f32x4& a, f32x4& b) {
    a[0] = __uint_as_float(w.x << 16); a[1] = __uint_as_float(w.x & 0xffff0000u); a[2] = __uint_as_float(w.y << 16); a[3] = __uint_as_float(w.y & 0xffff0000u);
    b[0] = __uint_as_float(w.z << 16); b[1] = __uint_as_float(w.z & 0xffff0000u); b[2] = __uint_as_float(w.w << 16); b[3] = __uint_as_float(w.w & 0xffff0000u); }
__device__ __forceinline__ float sigmoidf_(float v) { return __builtin_amdgcn_rcpf(1.0f + __builtin_amdgcn_exp2f(-1.4426950408889634f * v)); }
__device__ __forceinline__ f32x4 sigmoid4(f32x4 v) { f32x4 o; o[0] = sigmoidf_(v[0]); o[1] = sigmoidf_(v[1]); o[2] = sigmoidf_(v[2]); o[3] = sigmoidf_(v[3]); return o; }

typedef f32x4 AccT[2][2][4][2];
#define EPI_LOOP_AM _Pragma("unroll") for (int ai = 0; ai < 2; ++ai) _Pragma("unroll") for (int m = 0; m < 4; ++m)
#define EPI_LOOP_B _Pragma("unroll") for (int bj = 0; bj < 2; ++bj)

struct EpiIn {
    static constexpr bool PERM = true;
    bf16_t* C1; bf16_t* U; bf16_t* G; const float* bgate;
    __device__ __forceinline__ void operator()(const AccT& acc, const Unit& u, int wr, int wc, int fr, int fq) const {
        const int row0 = u.pm * BM + wr * 64 + fr, pn = u.pn, cw = wc * 32 + 8 * fq;
        if (pn < 4) {
            EPI_LOOP_AM { bf16_t* rp = C1 + (size_t)(row0 + ai * HALF + m * 16) * 1024 + pn * 256 + cw;
                EPI_LOOP_B { *(u32x4*)(rp + bj * HALF) = pack8(acc[ai][bj][m][0], acc[ai][bj][m][1]); } }
        } else if (pn < 8) {
            EPI_LOOP_AM { bf16_t* rp = U + (size_t)(row0 + ai * HALF + m * 16) * 1024 + (pn - 4) * 256 + cw;
                EPI_LOOP_B { *(u32x4*)(rp + bj * HALF) = pack8(acc[ai][bj][m][0], acc[ai][bj][m][1]); } }
        } else {
            const int gc = (pn - 8) * 256 + cw; f32x4 bv[2][2];
            EPI_LOOP_B { bv[bj][0] = *(const f32x4*)(bgate + gc + bj * HALF); bv[bj][1] = *(const f32x4*)(bgate + gc + bj * HALF + 4); }
            EPI_LOOP_AM { bf16_t* rp = G + (size_t)(row0 + ai * HALF + m * 16) * 4096 + gc;
                EPI_LOOP_B { *(u32x4*)(rp + bj * HALF) = pack8(sigmoid4(acc[ai][bj][m][0] + bv[bj][0]), sigmoid4(acc[ai][bj][m][1] + bv[bj][1])); } }
        }
    }
};
struct EpiKRP {
    static constexpr bool PERM = true;
    float* KRP;
    __device__ __forceinline__ void operator()(const AccT& acc, const Unit& u, int wr, int wc, int fr, int fq) const {
        const int row0 = u.pm * BM + wr * 64 + fr, cw = wc * 32 + 8 * fq;
        if (wc < 2) { EPI_LOOP_AM { float* rp = KRP + ((size_t)u.pn * 8192 + (row0 + ai * HALF + m * 16)) * 64 + cw; *(f32x4*)rp = acc[ai][0][m][0]; *(f32x4*)(rp + 4) = acc[ai][0][m][1]; } }
    }
};
struct EpiBf16 {
    static constexpr bool PERM = true;
    bf16_t* O; int ldc;
    __device__ __forceinline__ void operator()(const AccT& acc, const Unit& u, int wr, int wc, int fr, int fq) const {
        const int row0 = u.pm * BM + wr * 64 + fr, col0 = u.pn * BM + wc * 32 + 8 * fq;
        EPI_LOOP_AM { bf16_t* rp = O + (size_t)(row0 + ai * HALF + m * 16) * ldc + col0;
            EPI_LOOP_B { *(u32x4*)(rp + bj * HALF) = pack8(acc[ai][bj][m][0], acc[ai][bj][m][1]); } }
    }
};
struct EpiKV {
    static constexpr bool PERM = true;
    bf16_t* K; bf16_t* V;
    __device__ __forceinline__ void operator()(const AccT& acc, const Unit& u, int wr, int wc, int fr, int fq) const {
        const int row0 = u.pm * BM + wr * 64 + fr, cw = wc * 32 + 8 * fq, h = u.pn;
        EPI_LOOP_AM { const size_t row = (size_t)(row0 + ai * HALF + m * 16);
            *(u32x4*)(K + row * 3072 + h * 192 + cw) = pack8(acc[ai][0][m][0], acc[ai][0][m][1]);
            *(u32x4*)(V + row * 2048 + h * 128 + cw) = pack8(acc[ai][1][m][0], acc[ai][1][m][1]); }
    }
};
struct EpiScale {
    static constexpr bool PERM = true;
    bf16_t* O; int ldc; const float* scale;
    __device__ __forceinline__ void operator()(const AccT& acc, const Unit& u, int wr, int wc, int fr, int fq) const {
        const int row0 = u.pm * BM + wr * 64 + fr, col0 = u.pn * BM + wc * 32 + 8 * fq; f32x4 sv[2][2];
        EPI_LOOP_B { sv[bj][0] = *(const f32x4*)(scale + col0 + bj * HALF); sv[bj][1] = *(const f32x4*)(scale + col0 + bj * HALF + 4); }
        EPI_LOOP_AM { bf16_t* rp = O + (size_t)(row0 + ai * HALF + m * 16) * ldc + col0;
            EPI_LOOP_B { *(u32x4*)(rp + bj * HALF) = pack8(acc[ai][bj][m][0] * sv[bj][0], acc[ai][bj][m][1] * sv[bj][1]); } }
    }
};
template <bool HAS_ADD> struct EpiGate {
    static constexpr bool PERM = true;
    bf16_t* O; const bf16_t* gate; const bf16_t* add; int gcol0;
    __device__ __forceinline__ void operator()(const AccT& acc, const Unit& u, int wr, int wc, int fr, int fq) const {
        const int row0 = u.pm * BM + wr * 64 + fr, col0 = u.pn * BM + wc * 32 + 8 * fq;
        EPI_LOOP_AM { const size_t row = (size_t)(row0 + ai * HALF + m * 16);
            EPI_LOOP_B { f32x4 g0, g1; unpack8(__builtin_nontemporal_load((const u32x4*)(gate + row * 4096 + gcol0 + col0 + bj * HALF)), g0, g1);
                f32x4 v0 = g0 * acc[ai][bj][m][0], v1 = g1 * acc[ai][bj][m][1];
                if (HAS_ADD) { f32x4 a0, a1; unpack8(__builtin_nontemporal_load((const u32x4*)(add + row * 2048 + col0 + bj * HALF)), a0, a1); v0 += a0; v1 += a1; }
                *(u32x4*)(O + row * 2048 + col0 + bj * HALF) = pack8(v0, v1); } }
    }
};
struct EpiRes {
    static constexpr bool PERM = false;
    const float* base; float* out; int ldc;
    __device__ __forceinline__ void operator()(const AccT& acc, const Unit& u, int wr, int wc, int fr, int fq) const {
        const int row0 = u.pm * BM + wr * 64 + fr, col0 = u.pn * BM + wc * 32 + 4 * fq;
        EPI_LOOP_AM { const size_t off = (size_t)(row0 + ai * HALF + m * 16) * ldc + col0;
            EPI_LOOP_B {
#pragma unroll
                for (int n = 0; n < 2; ++n) { const f32x4 b = __builtin_nontemporal_load((const f32x4*)(base + off + bj * HALF + n * 16)); __builtin_nontemporal_store(b + acc[ai][bj][m][n], (f32x4*)(out + off + bj * HALF + n * 16)); } } }
    }
};
struct EpiResNorm {
    static constexpr bool PERM = false;
    const float* base; float* out; bf16_t* outb; float* ss; int ldc;
    __device__ __forceinline__ void operator()(const AccT& acc, const Unit& u, int wr, int wc, int fr, int fq) const {
        const int row0 = u.pm * BM + wr * 64 + fr, col0 = u.pn * BM + wc * 32 + 4 * fq;
        EPI_LOOP_AM { const int row = row0 + ai * HALF + m * 16; const size_t off = (size_t)row * ldc + col0; float s = 0.f;
            EPI_LOOP_B {
#pragma unroll
                for (int n = 0; n < 2; ++n) { const f32x4 v = __builtin_nontemporal_load((const f32x4*)(base + off + bj * HALF + n * 16)) + acc[ai][bj][m][n]; *(f32x4*)(out + off + bj * HALF + n * 16) = v;
                    typedef unsigned u32x2_ __attribute__((ext_vector_type(2))); u32x2_ w; w.x = cvt_pk_bf16(v[0], v[1]); w.y = cvt_pk_bf16(v[2], v[3]); *(u32x2_*)(outb + off + bj * HALF + n * 16) = w;
                    s += (v[0] * v[0] + v[1] * v[1]) + (v[2] * v[2] + v[3] * v[3]); } }
            s += __shfl_xor(s, 16); s += __shfl_xor(s, 32);
            if (fq == 0) atomicAdd(ss + row, s); }
    }
};
struct EpiSwiGLU {
    static constexpr bool PERM = true;
    bf16_t* O; int ldc; const float* ss;
    __device__ __forceinline__ void operator()(const AccT& acc, const Unit& u, int wr, int wc, int fr, int fq) const {
        const int row0 = u.pm * BM + wr * 64 + fr, col0 = u.pn * HALF + wc * 32 + 8 * fq;
        EPI_LOOP_AM { const int row = row0 + ai * HALF + m * 16; bf16_t* rp = O + (size_t)row * ldc + col0;
            const float inv = 1.0f / sqrtf(ss[row] * (1.f / 2048.f) + 1e-6f);
            const f32x4 g0 = acc[ai][0][m][0] * inv, g1 = acc[ai][0][m][1] * inv;
            *(u32x4*)rp = pack8(g0 * sigmoid4(g0) * (acc[ai][1][m][0] * inv), g1 * sigmoid4(g1) * (acc[ai][1][m][1] * inv)); }
    }
};

template <class Epi, class Sched, bool ALIGN_EPI = true>
__device__ __forceinline__ void gemm_phase(PG8_LAS unsigned char* lds, const Gemm g, const Sched& S, const Epi& E) {
    const int tid = threadIdx.x, wid = __builtin_amdgcn_readfirstlane(tid >> 6), lane = tid & 63, wr = wid >> 2, wc = wid & 3, fr = lane & 15, fq = lane >> 4;
    const int K = g.K, nt = K / BK;
    unsigned voffA[2], voffB[2];
#pragma unroll
    for (int i = 0; i < 2; ++i) { int R, C; stage_rc(tid * 16 + i * 8192, R, C); const int Rb = Epi::PERM ? ((R & ~31) + perm32(R & 31)) : R;
        voffA[i] = (unsigned)(R * g.lda + C) * 2u; voffB[i] = (unsigned)(Rb * g.ldb + C) * 2u; }
    const size_t kstep = (size_t)(BK * 2);
    const size_t hstepA = (size_t)HALF * g.lda * 2, hstepB = (size_t)HALF * g.ldb * 2;
    const size_t tstepA = 2 * hstepA, tstepB = g.b_pn_step ? (size_t)g.b_pn_step * 2 : 2 * hstepB, pstepA = (size_t)g.a_pn_step * 2;
    const unsigned ldsw = (unsigned)wid * 1024u;
    const int aoff = lds_byte(wr * 64 + fr, fq * 8), boff = lds_byte(wc * 32 + fr, fq * 8);
#define PG8_SA(b, h) (((b) * 2 + (h)) * HTB)
#define PG8_SB(b, h) ((4 + (b) * 2 + (h)) * HTB)
#define PG8_STAGE(bufoff, gbase, voff) do { _Pragma("unroll") for (int _i = 0; _i < 2; ++_i) \
        __builtin_amdgcn_global_load_lds((const unsigned*)((const char*)(gbase) + (voff)[_i]), (PG8_LAS unsigned*)(lds + (bufoff) + ldsw + _i * 8192), 16, 0, 0); } while (0)
#define PG8_LDA(dst, b, h) do { _Pragma("unroll") for (int m = 0; m < 4; ++m) _Pragma("unroll") for (int k = 0; k < 2; ++k) dst[m][k] = *(const PG8_LAS bf16x8*)(lds + PG8_SA(b, h) + aoff + m * 2048 + k * 1024); } while (0)
#define PG8_LDB(dst, b, h) do { _Pragma("unroll") for (int n = 0; n < 2; ++n) _Pragma("unroll") for (int k = 0; k < 2; ++k) dst[n][k] = *(const PG8_LAS bf16x8*)(lds + PG8_SB(b, h) + boff + n * 2048 + k * 1024); } while (0)
#define PG8_MMA(ai, bj, At, Bt) do { __builtin_amdgcn_s_setprio(1); _Pragma("unroll") for (int m = 0; m < 4; ++m) _Pragma("unroll") for (int n = 0; n < 2; ++n) _Pragma("unroll") for (int k = 0; k < 2; ++k) \
        acc[ai][bj][m][n] = __builtin_amdgcn_mfma_f32_16x16x32_bf16(Bt[n][k], At[m][k], acc[ai][bj][m][n], 0, 0, 0); __builtin_amdgcn_s_setprio(0); } while (0)
#define PG8_WAIT_V(n) asm volatile("s_waitcnt vmcnt(" #n ")" ::: "memory")
#define PG8_WAIT_L(n) asm volatile("s_waitcnt lgkmcnt(" #n ")" ::: "memory")
#define PG8_BAR __builtin_amdgcn_s_barrier()
#define PG8_SCHED __builtin_amdgcn_sched_barrier(0)
    Unit cur, nxt; int ui = 0;
    if (!S.next(0, cur)) return;
    f32x4 acc[2][2][4][2];
#pragma unroll
    for (int a = 0; a < 2; ++a)
#pragma unroll
        for (int b = 0; b < 2; ++b)
#pragma unroll
            for (int m = 0; m < 4; ++m)
#pragma unroll
                for (int n = 0; n < 2; ++n) acc[a][b][m][n] = (f32x4){0.f, 0.f, 0.f, 0.f};
    bf16x8 At[4][2], B0[2][2], B1[2][2];
    const char* cA = (const char*)g.A + (size_t)cur.pm * tstepA + (size_t)cur.pn * pstepA; const char* cB = (const char*)g.Bt + (size_t)cur.pn * tstepB;
    PG8_STAGE(PG8_SB(0, 0), cB, voffB); PG8_STAGE(PG8_SB(0, 1), cB + hstepB, voffB); PG8_STAGE(PG8_SA(0, 0), cA, voffA); PG8_STAGE(PG8_SA(0, 1), cA + hstepA, voffA);
    if (wr == 1) PG8_BAR;
    PG8_WAIT_V(2); PG8_BAR;
    PG8_STAGE(PG8_SB(1, 0), cB + kstep, voffB); PG8_STAGE(PG8_SA(1, 0), cA + kstep, voffA); PG8_STAGE(PG8_SB(1, 1), cB + hstepB + kstep, voffB);
    PG8_WAIT_V(6); PG8_BAR;
    for (;;) {
        const bool has_next = S.next(ui + 1, nxt);
        const char* nA = has_next ? (const char*)g.A + (size_t)nxt.pm * tstepA + (size_t)nxt.pn * pstepA : cA; const char* nB = has_next ? (const char*)g.Bt + (size_t)nxt.pn * tstepB : cB;
        for (int t = 0; t < nt; t += 2) {
            const bool last = (t == nt - 2);
            const char* a1 = cA + (size_t)(t + 1) * kstep;
            const char* a2 = last ? nA : cA + (size_t)(t + 2) * kstep; const char* b2 = last ? nB : cB + (size_t)(t + 2) * kstep;
            const char* a3 = a2 + kstep; const char* b3 = b2 + kstep;
            PG8_LDB(B0, 0, 0); PG8_LDB(B1, 0, 1); PG8_SCHED; PG8_LDA(At, 0, 0); PG8_STAGE(PG8_SA(1, 1), a1 + hstepA, voffA);
            PG8_WAIT_V(8); PG8_WAIT_L(0); PG8_BAR; PG8_MMA(0, 0, At, B0); PG8_MMA(0, 1, At, B1); PG8_BAR; PG8_SCHED;
            PG8_LDA(At, 0, 1); PG8_STAGE(PG8_SB(0, 0), b2, voffB); PG8_STAGE(PG8_SB(0, 1), b2 + hstepB, voffB); PG8_STAGE(PG8_SA(0, 0), a2, voffA);
            PG8_WAIT_V(8); PG8_WAIT_L(0); PG8_BAR; PG8_MMA(1, 0, At, B0); PG8_MMA(1, 1, At, B1); PG8_BAR; PG8_SCHED;
            PG8_LDB(B0, 1, 0); PG8_LDB(B1, 1, 1); PG8_SCHED; PG8_LDA(At, 1, 0); PG8_STAGE(PG8_SA(0, 1), a2 + hstepA, voffA);
            PG8_WAIT_V(8); PG8_WAIT_L(0); PG8_BAR; PG8_MMA(0, 0, At, B0); PG8_MMA(0, 1, At, B1); PG8_BAR; PG8_SCHED;
            PG8_LDA(At, 1, 1); PG8_STAGE(PG8_SB(1, 0), b3, voffB); PG8_STAGE(PG8_SB(1, 1), b3 + hstepB, voffB); PG8_STAGE(PG8_SA(1, 0), a3, voffA);
            PG8_WAIT_V(8); PG8_WAIT_L(0); PG8_BAR; PG8_MMA(1, 0, At, B0); PG8_MMA(1, 1, At, B1); PG8_BAR; PG8_SCHED;
        }
        if constexpr (ALIGN_EPI) { if (wr == 0) PG8_BAR; }
        E(acc, cur, wr, wc, fr, fq);
        if (!has_next) break;
#pragma unroll
        for (int a = 0; a < 2; ++a)
#pragma unroll
            for (int b = 0; b < 2; ++b)
#pragma unroll
                for (int m = 0; m < 4; ++m)
#pragma unroll
                    for (int n = 0; n < 2; ++n) acc[a][b][m][n] = (f32x4){0.f, 0.f, 0.f, 0.f};
        cur = nxt; cA = nA; cB = nB; ++ui;
        if constexpr (ALIGN_EPI) { if (wr == 1) PG8_BAR; }
    }
    PG8_WAIT_V(0);
    if constexpr (!ALIGN_EPI) { if (wr == 0) PG8_BAR; }
    PG8_BAR;
#undef PG8_SA
#undef PG8_SB
#undef PG8_STAGE
#undef PG8_LDA
#undef PG8_LDB
#undef PG8_MMA
#undef PG8_WAIT_V
#undef PG8_WAIT_L
#undef PG8_BAR
#undef PG8_SCHED
}
}

constexpr int BATCH = 2, SEQ = 4096, DM = 2048, M = BATCH * SEQ;
constexpr int NH = 16, DQK = 192, DNOPE = 128, DROPE = 64, DV = 128, QLORA = 512, KVLORA = 512;
constexpr int POOLW = 1024, DIN = 6208, DIN_PAD = 6400, DFF = 5632;
constexpr float EPS = 1e-6f;
constexpr int NWAVES = 8;

typedef unsigned short bf16;
typedef unsigned v4u __attribute__((ext_vector_type(4)));
typedef unsigned v2u __attribute__((ext_vector_type(2)));
typedef float f32x4 __attribute__((ext_vector_type(4)));
typedef short bf16x8 __attribute__((ext_vector_type(8)));
typedef short s16x4 __attribute__((ext_vector_type(4)));
typedef float f32x16 __attribute__((ext_vector_type(16)));
#define LAS __attribute__((address_space(3)))
#define LDS_WAIT() asm volatile("s_waitcnt lgkmcnt(0)" ::: "memory")

constexpr size_t MiB = 1u << 20;
constexpr size_t WS_WAO = 1 * MiB, WS_WOUT = 9 * MiB, WS_WPO = 17 * MiB, WS_WQB = 21 * MiB, WS_WKVB = 24 * MiB, WS_WPG = 28 * MiB, WS_KR = 29 * MiB;
constexpr size_t WS_G = 31 * MiB;
constexpr size_t WS_WIN = 95 * MiB, WS_XN = 120 * MiB, WS_C1 = 152 * MiB, WS_U = 184 * MiB;
constexpr size_t WS_Q = 95 * MiB, WS_K = 143 * MiB, WS_V = 191 * MiB, WS_CN = 223 * MiB, WS_POOLED = 239 * MiB, WS_PG = 255 * MiB;
constexpr size_t WS_MP = 223 * MiB, WS_O = 255 * MiB, WS_MIXED = 95 * MiB, WS_X1 = 127 * MiB, WS_H2 = 95 * MiB;
constexpr size_t WS_WGU = 191 * MiB, WS_WDN = 235 * MiB, WS_ACT = 1 * MiB;
constexpr size_t WS_END = 296 * MiB, WS_BAR = 512 * 1024, WS_KRP = 272 * MiB, WS_X1B = 257 * MiB;
constexpr int SV_BGATE = 0, SV_QAG = 4096, SV_KVAG = 4608, SV_QNG = 5120, SV_KNG = 5376, SV_PSC = 5632, SV_FNG = 6656, SV_POS = 8704, SV_END = 8704 + 8192, SV_SS = 32768;

constexpr int LDS_BYTES = 147456;

__device__ __forceinline__ unsigned cvtpk(float lo, float hi) { return pg8::cvt_pk_bf16(lo, hi); }
__device__ __forceinline__ float bflo(unsigned w) { return __uint_as_float(w << 16); }
__device__ __forceinline__ float bfhi(unsigned w) { return __uint_as_float(w & 0xffff0000u); }
__device__ __forceinline__ float wave_sum(float v) {
#pragma unroll
    for (int o = 1; o < 64; o <<= 1) v += __shfl_xor(v, o);
    return v;
}

__device__ __forceinline__ int dst_row(int mode, int n0) {
    if (mode == 1) { if (n0 < 1024) return n0; if (n0 < 1088) return 6144 + (n0 - 1024); if (n0 < 2112) return 1024 + (n0 - 1088); return 2048 + (n0 - 2112); }
    if (mode == 2) return (n0 >> 7) * 256 + (n0 & 127);
    if (mode == 3) return (n0 >> 7) * 256 + 128 + (n0 & 127);
    return n0;
}
__device__ __forceinline__ void transpose_item(const float* W, int K, int N, bf16* WT, int mode, int row_off, LAS float* scr, int item, int lane, const float* gk = nullptr) {
    const int nblk = N / 32, kb = item / nblk, nb = item % nblk, k0 = 64 * kb, n0 = 32 * nb;
    { float tv[32]; const float* wp = W + (size_t)(k0 + (lane >> 5)) * N + n0 + (lane & 31);
#pragma unroll
      for (int i = 0; i < 32; ++i) tv[i] = wp[(size_t)(2 * i) * N];
      if (gk) {
#pragma unroll
          for (int i = 0; i < 32; ++i) tv[i] *= gk[k0 + 2 * i + (lane >> 5)]; }
#pragma unroll
      for (int i = 0; i < 32; ++i) scr[(2 * i + (lane >> 5)) * 33 + (lane & 31)] = tv[i]; }
    LDS_WAIT(); asm volatile("" ::: "memory");
    const int c = lane & 7, dr = row_off + dst_row(mode, n0);
#pragma unroll
    for (int j = 0; j < 4; ++j) { const int n = (lane >> 3) + 8 * j; const LAS float* s = scr + (8 * c) * 33 + n;
        v4u o; o.x = cvtpk(s[0 * 33], s[1 * 33]); o.y = cvtpk(s[2 * 33], s[3 * 33]); o.z = cvtpk(s[4 * 33], s[5 * 33]); o.w = cvtpk(s[6 * 33], s[7 * 33]);
        *(v4u*)(WT + (size_t)(dr + n) * K + k0 + 8 * c) = o; }
    LDS_WAIT(); asm volatile("" ::: "memory");
}

struct TrDesc { const float* W; bf16* WT; const float* gk; int K, N, k0, n0, dr; };
__device__ __forceinline__ TrDesc tr_desc(const float* W, int K, int N, bf16* WT, int mode, int row_off, int item, const float* gk) {
    const int nblk = N / 32, kb = item / nblk, nb = item % nblk; TrDesc d; d.W = W; d.WT = WT; d.gk = gk; d.K = K; d.N = N; d.k0 = 64 * kb; d.n0 = 32 * nb; d.dr = row_off + dst_row(mode, d.n0); return d; }
__device__ __forceinline__ void tr_load(const TrDesc& d, float (&tv)[32], int lane) {
    const float* wp = d.W + (size_t)(d.k0 + (lane >> 5)) * d.N + d.n0 + (lane & 31);
#pragma unroll
    for (int i = 0; i < 32; ++i) tv[i] = __builtin_nontemporal_load(wp + (size_t)(2 * i) * d.N);
}
__device__ __forceinline__ void tr_finish(const TrDesc& d, float (&tv)[32], LAS float* scr, int lane) {
    if (d.gk) {
#pragma unroll
        for (int i = 0; i < 32; ++i) tv[i] *= d.gk[d.k0 + 2 * i + (lane >> 5)]; }
#pragma unroll
    for (int i = 0; i < 32; ++i) scr[(2 * i + (lane >> 5)) * 33 + (lane & 31)] = tv[i];
    LDS_WAIT(); asm volatile("" ::: "memory");
    const int c = lane & 7;
#pragma unroll
    for (int j = 0; j < 4; ++j) { const int n = (lane >> 3) + 8 * j; const LAS float* s_ = scr + (8 * c) * 33 + n;
        v4u o; o.x = cvtpk(s_[0 * 33], s_[1 * 33]); o.y = cvtpk(s_[2 * 33], s_[3 * 33]); o.z = cvtpk(s_[4 * 33], s_[5 * 33]); o.w = cvtpk(s_[6 * 33], s_[7 * 33]);
        *(v4u*)(d.WT + (size_t)(d.dr + n) * d.K + d.k0 + 8 * c) = o; }
    LDS_WAIT(); asm volatile("" ::: "memory");
}
#define TR_PIPELINE(FIRST, LIMIT, STRIDE, MAKE_DESC) do { int it_ = (FIRST); if (it_ < (LIMIT)) { TrDesc dA_ = MAKE_DESC(it_); float tvA_[32]; tr_load(dA_, tvA_, lane); \
        for (;;) { const int nx_ = it_ + (STRIDE); const bool more_ = nx_ < (LIMIT); TrDesc dB_ = dA_; float tvB_[32]; \
            if (more_) { dB_ = MAKE_DESC(nx_); tr_load(dB_, tvB_, lane); } \
            tr_finish(dA_, tvA_, scr, lane); if (!more_) break; \
            dA_ = dB_; _Pragma("unroll") for (int i_ = 0; i_ < 32; ++i_) tvA_[i_] = tvB_[i_]; it_ = nx_; } } } while (0)

__device__ __forceinline__ void rms_row_2048(const float* xrow, const float* g, bf16* orow, int lane) {
    const f32x4* xr = (const f32x4*)xrow + lane; const f32x4* gr = (const f32x4*)g + lane;
    f32x4 v[8]; float s = 0.f;
#pragma unroll
    for (int j = 0; j < 8; ++j) { v[j] = __builtin_nontemporal_load(xr + 64 * j); s += (v[j].x * v[j].x + v[j].y * v[j].y) + (v[j].z * v[j].z + v[j].w * v[j].w); }
    const float inv = 1.0f / sqrtf(wave_sum(s) * (1.f / 2048.f) + EPS);
    v2u* o8 = (v2u*)orow + lane;
#pragma unroll
    for (int j = 0; j < 8; ++j) { const f32x4 gv = gr[64 * j]; v2u o; o.x = cvtpk(v[j].x * inv * gv.x, v[j].y * inv * gv.y); o.y = cvtpk(v[j].z * inv * gv.z, v[j].w * inv * gv.w); o8[64 * j] = o; }
}

namespace att {
constexpr int QBLK = 32, KVBLK = 64, QB = 256;
constexpr int SHM_V = KVBLK * DV * 2, SHM_K = KVBLK * DQK * 2;
constexpr int OFF_V = 0, OFF_K = 3 * SHM_V, OFF_WS = OFF_K + 2 * SHM_K;
constexpr float SCALE = 0.07216878364870322f;
constexpr float THR = 8.f;
#define KSWZ(row, colB) ((row) * 384 + ((colB) ^ (((row) & 7) << 4)))
#define SBAR() __builtin_amdgcn_sched_barrier(0)
__device__ __forceinline__ int v_st(int k, int c) { const int kk = (k & ~0xC) | ((k & 4) << 1) | ((k & 8) >> 1); return ((kk >> 3) * 4 + (c >> 5)) * 512 + ((kk & 7) * 32 + (c & 31)) * 2; }
__device__ __forceinline__ int v_rd_base(int lane) { return ((lane & 3) << 3) | (((lane >> 2) & 3) << 6) | (((lane >> 4) & 1) << 5) | (((lane >> 5) & 1) << 8); }
__device__ __forceinline__ int crow(int r, int hi) { return (r & 3) + 8 * (r >> 2) + 4 * hi; }
__device__ __forceinline__ void mask_tile(f32x16& p0, f32x16& p1, int dq) {
    const float NEG = -__builtin_inff();
#pragma unroll
    for (int r = 0; r < 16; ++r) {
        const int c = (r & 3) + 8 * (r >> 2);
        if (dq - c < 0) p0[r] = NEG;
        if (dq - c - 32 < 0) p1[r] = NEG;
    }
}
__device__ __forceinline__ void partialSM(f32x16& p0, f32x16& p1, float& m_reg, float& mn, float& alpha) {
    float pmax = p0[0];
#pragma unroll
    for (int r = 1; r < 16; ++r) pmax = fmaxf(pmax, p0[r]);
#pragma unroll
    for (int r = 0; r < 16; ++r) pmax = fmaxf(pmax, p1[r]);
    { auto rr = __builtin_amdgcn_permlane32_swap(__float_as_uint(pmax), __float_as_uint(pmax), false, false);
      pmax = fmaxf(__uint_as_float(rr[0]), __uint_as_float(rr[1])); }
    constexpr float C2 = 1.4426950408889634f * SCALE;
    if (__builtin_expect(__all((pmax - m_reg) * SCALE <= THR), 1)) { mn = m_reg; alpha = 1.f; }
    else { mn = fmaxf(m_reg, pmax); alpha = __builtin_amdgcn_exp2f((m_reg - mn) * C2); m_reg = mn; }
    const float mnL = -mn * C2;
#pragma unroll
    for (int r = 0; r < 16; ++r) p0[r] = fmaf(p0[r], C2, mnL);
#pragma unroll
    for (int r = 0; r < 16; ++r) p1[r] = fmaf(p1[r], C2, mnL);
#pragma unroll
    for (int r = 0; r < 16; ++r) p0[r] = __builtin_amdgcn_exp2f(p0[r]);
}
__device__ __forceinline__ void finishSM(f32x16& p0, f32x16& p1, float alpha, float& l_reg, bf16x8& pa0, bf16x8& pa1, bf16x8& pa2, bf16x8& pa3) {
#pragma unroll
    for (int r = 0; r < 16; ++r) p1[r] = __builtin_amdgcn_exp2f(p1[r]);
    float ps = 0;
#pragma unroll
    for (int r = 0; r < 16; ++r) ps += p0[r];
#pragma unroll
    for (int r = 0; r < 16; ++r) ps += p1[r];
    { auto rr = __builtin_amdgcn_permlane32_swap(__float_as_uint(ps), __float_as_uint(ps), false, false);
      ps = __uint_as_float(rr[0]) + __uint_as_float(rr[1]); }
    l_reg = l_reg * alpha + ps;
#define PK4(P, B_, OUT) do { unsigned a0 = cvtpk(P[B_+0], P[B_+1]), a1 = cvtpk(P[B_+2], P[B_+3]);                          \
        unsigned b0 = cvtpk(P[B_+4], P[B_+5]), b1 = cvtpk(P[B_+6], P[B_+7]);                                             \
        auto r0 = __builtin_amdgcn_permlane32_swap(a0, b0, false, false); auto r1 = __builtin_amdgcn_permlane32_swap(a1, b1, false, false); \
        v4u w = {r0[0], r1[0], r0[1], r1[1]}; OUT = *reinterpret_cast<bf16x8*>(&w); } while (0)
    PK4(p0, 0, pa0); PK4(p0, 8, pa1); PK4(p1, 0, pa2); PK4(p1, 8, pa3);
#undef PK4
}
__device__ __forceinline__ void qkt(f32x16& p0, f32x16& p1, const char* Kb, int r32, int hi, const bf16x8* qr) {
    p0 = f32x16{}; p1 = f32x16{};
    const char* kb[4];
#pragma unroll
    for (int dd = 0; dd < 4; ++dd) kb[dd] = Kb + KSWZ(r32, (dd * 16 + hi * 8) * 2);
#pragma unroll
    for (int g = 0; g < 2; ++g) { bf16x8 b0[6], b1[6];
#pragma unroll
        for (int i = 0; i < 6; ++i) { const int d0 = 6 * g + i; const char* a = kb[d0 & 3] + (d0 >> 2) * 128; b0[i] = *reinterpret_cast<const bf16x8*>(a); b1[i] = *reinterpret_cast<const bf16x8*>(a + 32 * 384); }
        SBAR();
        __builtin_amdgcn_s_setprio(1);
#pragma unroll
        for (int i = 0; i < 6; ++i) { p0 = __builtin_amdgcn_mfma_f32_32x32x16_bf16(b0[i], qr[6 * g + i], p0, 0, 0, 0); p1 = __builtin_amdgcn_mfma_f32_32x32x16_bf16(b1[i], qr[6 * g + i], p1, 0, 0, 0); }
        __builtin_amdgcn_s_setprio(0);
        SBAR(); }
}
__device__ __forceinline__ void pv_tile(f32x16* o, int vb0, bf16x8 pa0, bf16x8 pa1, bf16x8 pa2, bf16x8 pa3) {
#define TRRD(dst, off) asm volatile("ds_read_b64_tr_b16 %0, %1 offset:%2" : "=&v"(dst) : "v"(vb0), "i"(off) : "memory")
#define PV_RD(S, d0) do { constexpr int b_ = (d0) * 512; TRRD(S##l0, b_); TRRD(S##h0, b_ + 2048); TRRD(S##l1, b_ + 4096); TRRD(S##h1, b_ + 6144); TRRD(S##l2, b_ + 8192); TRRD(S##h2, b_ + 10240); TRRD(S##l3, b_ + 12288); TRRD(S##h3, b_ + 14336); } while (0)
#define PV_MM(S, d0) do { \
        o[d0] = __builtin_amdgcn_mfma_f32_32x32x16_bf16(pa0, (bf16x8){S##l0[0], S##l0[1], S##l0[2], S##l0[3], S##h0[0], S##h0[1], S##h0[2], S##h0[3]}, o[d0], 0, 0, 0);   \
        o[d0] = __builtin_amdgcn_mfma_f32_32x32x16_bf16(pa1, (bf16x8){S##l1[0], S##l1[1], S##l1[2], S##l1[3], S##h1[0], S##h1[1], S##h1[2], S##h1[3]}, o[d0], 0, 0, 0);   \
        o[d0] = __builtin_amdgcn_mfma_f32_32x32x16_bf16(pa2, (bf16x8){S##l2[0], S##l2[1], S##l2[2], S##l2[3], S##h2[0], S##h2[1], S##h2[2], S##h2[3]}, o[d0], 0, 0, 0);   \
        o[d0] = __builtin_amdgcn_mfma_f32_32x32x16_bf16(pa3, (bf16x8){S##l3[0], S##l3[1], S##l3[2], S##l3[3], S##h3[0], S##h3[1], S##h3[2], S##h3[3]}, o[d0], 0, 0, 0); } while (0)
    s16x4 Al0, Al1, Al2, Al3, Ah0, Ah1, Ah2, Ah3, Bl0, Bl1, Bl2, Bl3, Bh0, Bh1, Bh2, Bh3;
    PV_RD(A, 0); PV_RD(B, 1);
    asm volatile("s_waitcnt lgkmcnt(8)" ::: "memory"); SBAR(); PV_MM(A, 0); SBAR();
    PV_RD(A, 2);
    asm volatile("s_waitcnt lgkmcnt(8)" ::: "memory"); SBAR(); PV_MM(B, 1); SBAR();
    PV_RD(B, 3);
    asm volatile("s_waitcnt lgkmcnt(8)" ::: "memory"); SBAR(); PV_MM(A, 2); SBAR();
    asm volatile("s_waitcnt lgkmcnt(0)" ::: "memory"); SBAR(); PV_MM(B, 3);
#undef PV_MM
#undef PV_RD
#undef TRRD
}
__device__ __forceinline__ void attn_unit(int b, int h, int qb, const bf16* Q, const bf16* K, const bf16* V, bf16* O, char* lds) {
    const int tid = threadIdx.x, wid = __builtin_amdgcn_readfirstlane(tid >> 6), lane = tid & 63, r32 = lane & 31, hi = lane >> 5;
    const size_t rowb = (size_t)b * SEQ;
    const int q0 = qb * QB, qlo = q0 + wid * QBLK;
    const int NT = (q0 + QB) / KVBLK;
    char* V_lds = lds + OFF_V; char* K_lds = lds + OFF_K;
#define WAVE_WS() ({ int t_ = (int)threadIdx.x; asm volatile("" : "+v"(t_)); (float*)(lds + OFF_WS) + (t_ >> 6) * 64; })
    LAS unsigned char* ldsl_ = (LAS unsigned char*)lds;
    unsigned ksrc[3], vsrc[2];
#pragma unroll
    for (int j = 0; j < 3; ++j) { const int s_ = (wid * 3 + j) * 64 + lane, row = s_ / 24, pc = s_ % 24; ksrc[j] = (unsigned)(row * 3072 * 2 + ((pc * 16) ^ ((row & 7) << 4))); }
#pragma unroll
    for (int j = 0; j < 2; ++j) { const int ob = ((wid * 2 + j) * 64 + lane) * 16, st = ob >> 9, kr_ = (ob >> 6) & 7, ch = (ob >> 4) & 3, c = (st & 3) * 32 + ch * 8, kk = (st >> 2) * 8 + kr_,
                                  k = (kk & ~0xC) | ((kk & 4) << 1) | ((kk & 8) >> 1); vsrc[j] = (unsigned)(k * 2048 * 2 + c * 2); }
    const char* Kh = (const char*)(K + rowb * 3072 + h * DQK); const char* Vh = (const char*)(V + rowb * 2048 + h * DV);
#define KDMA(k0, bf) do { _Pragma("unroll") for (int j = 0; j < 3; ++j) __builtin_amdgcn_global_load_lds((const unsigned*)(Kh + (size_t)(k0) * (3072 * 2) + ksrc[j]), \
        (LAS unsigned*)(ldsl_ + OFF_K + (bf) * SHM_K + (wid * 3 + j) * 1024), 16, 0, 0); } while (0)
#define VDMA(k0, sl) do { _Pragma("unroll") for (int j = 0; j < 2; ++j) __builtin_amdgcn_global_load_lds((const unsigned*)(Vh + (size_t)(k0) * (2048 * 2) + vsrc[j]), \
        (LAS unsigned*)(ldsl_ + OFF_V + (sl) * SHM_V + (wid * 2 + j) * 1024), 16, 0, 0); } while (0)
    KDMA(0, 0); VDMA(0, 0);
    bf16x8 qr[12];
    { const bf16* Qp = Q + (rowb + qlo + r32) * 3072 + h * DQK + hi * 8;
#pragma unroll
      for (int d0 = 0; d0 < 12; ++d0) qr[d0] = *(const bf16x8*)(Qp + d0 * 16); }
    asm volatile("s_waitcnt vmcnt(0)" ::: "memory");
    __syncthreads();
    float m_reg = -1e30f, l_reg = 0.f; f32x16 o[4] = {};
    const int vbase = (int)(uintptr_t)V_lds + v_rd_base(lane);
    const int qm = qlo + r32 - 4 * hi;
    f32x16 p0, p1;
#define SP_STAGE(VS) do { float mn, alpha; bf16x8 pa0, pa1, pa2, pa3; \
        partialSM(p0, p1, m_reg, mn, alpha); finishSM(p0, p1, alpha, l_reg, pa0, pa1, pa2, pa3); \
        if (__any(alpha < 1.f)) { float* al_l = WAVE_WS() + 32; if (hi == 0) al_l[r32] = alpha; asm volatile("s_waitcnt lgkmcnt(0)" ::: "memory"); \
            _Pragma("unroll") for (int d_ = 0; d_ < 4; ++d_) _Pragma("unroll") for (int r = 0; r < 16; ++r) o[d_][r] *= al_l[crow(r, hi)]; } \
        SBAR(); pv_tile(o, vbase + (VS) * SHM_V, pa0, pa1, pa2, pa3); } while (0)
    for (int t = 0; t < NT; ++t) {
        const int cur = t & 1, kb_ = t * KVBLK;
        if (t + 1 < NT) { KDMA((t + 1) * KVBLK, cur ^ 1); VDMA((t + 1) * KVBLK, cur ^ 1); }
        SBAR();
        qkt(p0, p1, K_lds + cur * SHM_K, r32, hi, qr); if (kb_ + KVBLK - 1 > qlo) mask_tile(p0, p1, qm - kb_);
        SBAR();
        SP_STAGE(cur);
        asm volatile("s_waitcnt vmcnt(0)" ::: "memory");
        __syncthreads();
    }
#undef SP_STAGE
    float* li_l = WAVE_WS();
    if (hi == 0) li_l[r32] = l_reg; asm volatile("s_waitcnt lgkmcnt(0)" ::: "memory");
    float rli[16];
#pragma unroll
    for (int r = 0; r < 16; ++r) rli[r] = __builtin_amdgcn_rcpf(li_l[crow(r, hi)]);
    bf16* Ow = O + (rowb + qlo) * 2048 + h * DV;
#pragma unroll
    for (int r = 0; r < 16; ++r) { const int orow = crow(r, hi);
#pragma unroll
        for (int d0 = 0; d0 < 4; ++d0) { const float v = o[d0][r] * rli[r];
            const float vn = __shfl_xor(v, 1);
            if ((r32 & 1) == 0) *(unsigned*)(Ow + (size_t)orow * 2048 + d0 * 32 + r32) = cvtpk(v, vn); } }
    __syncthreads();
#undef KDMA
#undef VDMA
#undef WAVE_WS
}
#undef SBAR
}

struct Args { const float* in[20]; float* out; unsigned char* ws; int ph_lo, ph_hi, coop, pad; };
#define XB_TMO      128
#define XB_XCNT(j)  (256  + 64 * (j))
#define XB_XSUB(j)  (1280 + 64 * (j))
#define XB_XGEN(j)  (2304 + 64 * (j))
#define XB_TOP      3328
#define XB_TOPGEN   3392
#define XCD_BAR_WORDS 3456
#define XB_SPIN_CAP (1u << 20)
__device__ __forceinline__ unsigned xb_ld(unsigned* p)              { return __hip_atomic_load(p, __ATOMIC_RELAXED, __HIP_MEMORY_SCOPE_AGENT); }
__device__ __forceinline__ unsigned xb_add(unsigned* p, unsigned v) { return __hip_atomic_fetch_add(p, v, __ATOMIC_RELAXED, __HIP_MEMORY_SCOPE_AGENT); }
__device__ __forceinline__ unsigned xb_xcc_id() { return (unsigned)__builtin_amdgcn_s_getreg((3 << 11) | 20) & 0xFu; }
#define XB_SPIN(cond, bar) do { unsigned _sp = 0; while (cond) { __builtin_amdgcn_s_sleep(1); \
    if ((++_sp & 255u) == 0u) { if (xb_ld(&(bar)[XB_TMO])) break; if (_sp > XB_SPIN_CAP) { atomicAdd(&(bar)[XB_TMO], 1u); break; } } } } while (0)
__device__ __forceinline__ void xcd_barrier_complete(unsigned* bar, unsigned x, unsigned& nloc, unsigned& nx) {
    const unsigned G = gridDim.x;
    unsigned sum, cnt, mine, sp = 0u;
    for (;;) {
        sum = 0u; cnt = 0u; mine = 0u;
#pragma unroll
        for (unsigned j = 0; j < 16; ++j) { const unsigned c = xb_ld(&bar[XB_XCNT(j)]); sum += c; cnt += (c > 0u) ? 1u : 0u; mine = (j == x) ? c : mine; }
        if (sum == G) break;
        __builtin_amdgcn_s_sleep(1);
        if ((++sp & 255u) == 0u) { if (xb_ld(&bar[XB_TMO])) break; if (sp > XB_SPIN_CAP) { atomicAdd(&bar[XB_TMO], 1u); break; } }
    }
    nloc = mine > 0u ? mine : 1u; nx = cnt > 0u ? cnt : 1u;
}
__device__ __forceinline__ void grid_bar(unsigned* bar, volatile LAS unsigned* st) {
    asm volatile("s_waitcnt vmcnt(0)" ::: "memory");
    __syncthreads();
    if (threadIdx.x == 0) {
        const unsigned x = xb_xcc_id();
        __builtin_amdgcn_s_waitcnt(0);
        unsigned nloc = st[0], nx = st[1];
        if (nloc == 0u) { xcd_barrier_complete(bar, x, nloc, nx); st[0] = nloc; st[1] = nx; }
        const unsigned old = xb_add(&bar[XB_XSUB(x)], 1u);
        const unsigned gen = old / nloc;
        if (old + 1u == (gen + 1u) * nloc) {
            __builtin_amdgcn_fence(__ATOMIC_RELEASE, "agent");
            asm volatile("s_waitcnt vmcnt(0)" ::: "memory");
            const unsigned og = xb_add(&bar[XB_TOP], 1u);
            const unsigned tg = og / nx;
            if (og + 1u == (tg + 1u) * nx) xb_add(&bar[XB_TOPGEN], 1u);
            else XB_SPIN(xb_ld(&bar[XB_TOPGEN]) == tg, bar);
            __builtin_amdgcn_fence(__ATOMIC_ACQUIRE, "agent");
            xb_add(&bar[XB_XGEN(x)], 1u);
            asm volatile("s_waitcnt vmcnt(0)" ::: "memory");
        } else {
            XB_SPIN(xb_ld(&bar[XB_XGEN(x)]) == gen, bar);
            __builtin_amdgcn_fence(__ATOMIC_ACQUIRE, "agent");
            asm volatile("s_waitcnt vmcnt(0)" ::: "memory");
        }
    }
    __syncthreads();
}
constexpr int NPH = 11;

__global__ void __launch_bounds__(NWAVES * 64, 2) mega_fwd(Args args) {
    extern __shared__ __attribute__((aligned(16))) unsigned char lds[];
    LAS unsigned char* ldsl = (LAS unsigned char*)lds;
    const int tid = threadIdx.x, lane = tid & 63, wave = __builtin_amdgcn_readfirstlane(tid >> 6);
    const int G = gridDim.x, bx = blockIdx.x;
    const int vcu = (G % 8 == 0) ? (bx % 8) * (G / 8) + bx / 8 : bx;
    const int gw = vcu * NWAVES + wave, NGW = G * NWAVES;
    unsigned char* ws = args.ws;
    const float* const* kin = (const float* const*)__builtin_amdgcn_kernarg_segment_ptr();
    const float* svec = (const float*)ws;
    const float* b_gate = svec + SV_BGATE; const float* q_a_norm_g = svec + SV_QAG; const float* kv_a_norm_g = svec + SV_KVAG; const float* q_norm_g = svec + SV_QNG;
    const float* k_norm_g = svec + SV_KNG; const float* pool_scale = svec + SV_PSC; const float* ffn_norm_g = svec + SV_FNG; const int* positions = (const int*)(svec + SV_POS);
    bf16* WIN_T = (bf16*)(ws + WS_WIN); bf16* WQB_T = (bf16*)(ws + WS_WQB); bf16* WKVB_T = (bf16*)(ws + WS_WKVB); bf16* WPG_T = (bf16*)(ws + WS_WPG);
    bf16* WPO_T = (bf16*)(ws + WS_WPO); bf16* WAO_T = (bf16*)(ws + WS_WAO); bf16* WOUT_T = (bf16*)(ws + WS_WOUT); bf16* WGU_T = (bf16*)(ws + WS_WGU); bf16* WDN_T = (bf16*)(ws + WS_WDN);
    bf16* XN = (bf16*)(ws + WS_XN); bf16* C1 = (bf16*)(ws + WS_C1); float* KRP = (float*)(ws + WS_KRP); bf16* U = (bf16*)(ws + WS_U); bf16* Gt = (bf16*)(ws + WS_G);
    bf16* CN = (bf16*)(ws + WS_CN); bf16* POOLED = (bf16*)(ws + WS_POOLED); bf16* Qb = (bf16*)(ws + WS_Q); bf16* Kb = (bf16*)(ws + WS_K); bf16* Vb = (bf16*)(ws + WS_V);
    bf16* PG = (bf16*)(ws + WS_PG); bf16* MP = (bf16*)(ws + WS_MP); bf16* Ob = (bf16*)(ws + WS_O); bf16* MIXED = (bf16*)(ws + WS_MIXED);
    float* X1 = (float*)(ws + WS_X1); bf16* H2 = (bf16*)(ws + WS_H2); bf16* ACT = (bf16*)(ws + WS_ACT);

    const int lo = args.ph_lo, hi_ph = args.ph_hi;
#ifndef PHMASK
#define PHMASK 0x7ff
#endif
#define IN(k) (((PHMASK >> (k)) & 1) && lo <= (k) && (k) < hi_ph)
#define SEAM(k) do { if (IN(k) && IN((k) + 1)) { unsigned char* w2_ = args.ws; asm volatile("" : "+s"(w2_)); grid_bar((unsigned*)(w2_ + WS_BAR), (volatile LAS unsigned*)(ldsl + 140032)); } } while (0)
    if (args.coop > 1) cg::this_grid().sync();
    if (threadIdx.x < 2) ((volatile LAS unsigned*)(ldsl + 140032))[threadIdx.x] = 0u;
    __syncthreads();
    if (args.coop && threadIdx.x == 0) { unsigned char* w2_ = args.ws; asm volatile("" : "+s"(w2_)); (void)xb_add(&((unsigned*)(w2_ + WS_BAR))[XB_XCNT(xb_xcc_id())], 1u); }
    LAS float* scr = (LAS float*)(ldsl + wave * 16384);
#ifdef TPROBE
#define TP_BEGIN(k) do { if ((TPROBE >> (k)) & 1) { if (blockIdx.x == 0 && threadIdx.x == 0) { *(volatile LAS unsigned*)(ldsl + 140000) = (unsigned)__builtin_amdgcn_s_memrealtime(); } } } while (0)
#define TP_END(k) do { if ((TPROBE >> (k)) & 1) { if (blockIdx.x == 0 && threadIdx.x == 0) { volatile LAS unsigned* tp_ = (volatile LAS unsigned*)(ldsl + 140000); tp_[1] += (unsigned)__builtin_amdgcn_s_memrealtime() - tp_[0]; } } } while (0)
    if (blockIdx.x == 0 && threadIdx.x == 0) { ((volatile LAS unsigned*)(ldsl + 140000))[1] = 0u; }
#else
#define TP_BEGIN(k) do {} while (0)
#define TP_END(k) do {} while (0)
#endif

    if (IN(0)) { TP_BEGIN(0);
        { float* sv = (float*)ws; const int gt = bx * (NWAVES * 64) + tid, GT = G * NWAVES * 64;
          for (int i = gt; i < M; i += GT) sv[SV_SS + i] = 0.f;
          for (int i = gt; i < SV_END; i += GT) { int idx, off, lim = 1 << 30;
              if (i < SV_QAG) { idx = 4; off = SV_BGATE; } else if (i < SV_KVAG) { idx = 5; off = SV_QAG; } else if (i < SV_QNG) { idx = 7; off = SV_KVAG; }
              else if (i < SV_KNG) { idx = 9; off = SV_QNG; lim = 192; } else if (i < SV_PSC) { idx = 10; off = SV_KNG; lim = 192; }
              else if (i < SV_FNG) { idx = 13; off = SV_PSC; } else if (i < SV_POS) { idx = 16; off = SV_FNG; } else { idx = 1; off = SV_POS; }
              const float* src = kin[idx]; sv[i] = (i - off < lim) ? src[i - off] : 0.f; } }
        constexpr int I_IN = (DM / 64) * (DIN / 32), I_QB = (QLORA / 64) * (NH * DQK / 32), I_KVB = (KVLORA / 64) * (NH * 256 / 32), I_PG = (256 / 64) * (256 / 32),
                      I_PO = (POOLW / 64) * (DM / 32), I_AO = (DM / 64) * (DM / 32), I_OUT = I_AO;
        constexpr int NITEMS = I_IN + I_QB + I_KVB + 4 * I_PG + I_PO + I_AO + I_OUT;
#define P0_DESC(it__) ([&]() { int r = (it__), idx, Kd, Nd, mode = 0, roff = 0; size_t dsto, srco = 0; \
            if (r < I_IN) { idx = 3; Kd = DM; Nd = DIN; mode = 1; dsto = WS_WIN; } \
            else if ((r -= I_IN) < I_QB) { idx = 6; Kd = QLORA; Nd = NH * DQK; dsto = WS_WQB; } \
            else if ((r -= I_QB) < I_KVB) { idx = 8; Kd = KVLORA; Nd = NH * 256; dsto = WS_WKVB; } \
            else if ((r -= I_KVB) < 4 * I_PG) { const int g = r / I_PG; r = r % I_PG; idx = 12; Kd = 256; Nd = 256; dsto = WS_WPG; roff = g * 256; srco = (size_t)g * 65536; } \
            else if ((r -= 4 * I_PG) < I_PO) { idx = 14; Kd = POOLW; Nd = DM; dsto = WS_WPO; } \
            else if ((r -= I_PO) < I_AO) { idx = 11; Kd = DM; Nd = DM; dsto = WS_WAO; } \
            else { r -= I_AO; idx = 15; Kd = DM; Nd = DM; dsto = WS_WOUT; } \
            return tr_desc(kin[idx] + srco, Kd, Nd, (bf16*)(ws + dsto), mode, roff, r, nullptr); }())
        TR_PIPELINE(gw, NITEMS, NGW, P0_DESC);
#undef P0_DESC
        { v4u* z = (v4u*)(WIN_T + (size_t)DIN * DM); const int nz = (DIN_PAD - DIN) * DM / 8;
          for (int i = gw * 64 + lane; i < nz; i += NGW * 64) z[i] = (v4u){0u, 0u, 0u, 0u}; }
        { const float* x = kin[0]; const float* attn_norm_g = kin[2];
          for (int m = gw; m < M; m += NGW) rms_row_2048(x + (size_t)m * DM, attn_norm_g, XN + (size_t)m * DM, lane); }
    TP_END(0); }
    SEAM(0);
    if (IN(1)) { TP_BEGIN(1);
        { pg8::Gemm g{XN, WIN_T, M, 6144, DM, DM, DM, 0, 0}; pg8::StaticOrder S; S.init(M, 6144, G, bx);
          pg8::EpiIn E{C1, U, Gt, b_gate};
          pg8::gemm_phase<pg8::EpiIn, pg8::StaticOrder>(ldsl, g, S, E); }
        { pg8::Gemm g{XN, WIN_T + (size_t)6144 * DM, M, 2048, 256, DM, DM, 256, 256}; pg8::StaticOrder S; S.init(M, 2048, G, bx);
          pg8::EpiKRP E{KRP};
          pg8::gemm_phase<pg8::EpiKRP, pg8::StaticOrder>(ldsl, g, S, E); }
    TP_END(1); }
    SEAM(1);
    if (IN(2)) { TP_BEGIN(2);
        for (int m = gw; m < M; m += NGW) {
            const v4u cq = __builtin_nontemporal_load((const v4u*)(C1 + (size_t)m * 1024 + 8 * lane)), ck = __builtin_nontemporal_load((const v4u*)(C1 + (size_t)m * 1024 + 512 + 8 * lane));
            const float fq_[8] = {bflo(cq.x), bfhi(cq.x), bflo(cq.y), bfhi(cq.y), bflo(cq.z), bfhi(cq.z), bflo(cq.w), bfhi(cq.w)};
            const float fk_[8] = {bflo(ck.x), bfhi(ck.x), bflo(ck.y), bfhi(ck.y), bflo(ck.z), bfhi(ck.z), bflo(ck.w), bfhi(ck.w)};
            float sq = 0.f, skv = 0.f;
#pragma unroll
            for (int e = 0; e < 8; ++e) { sq += fq_[e] * fq_[e]; skv += fk_[e] * fk_[e]; }
            const float iq = 1.0f / sqrtf(wave_sum(sq) * (1.f / 512.f) + EPS), ikv = 1.0f / sqrtf(wave_sum(skv) * (1.f / 512.f) + EPS);
            if (lane < 16) { f32x4 acc4 = {0.f, 0.f, 0.f, 0.f};
#pragma unroll
                for (int ks = 0; ks < 8; ++ks) acc4 += __builtin_nontemporal_load((const f32x4*)(KRP + ((size_t)ks * 8192 + m) * 64 + 4 * lane));
                *(f32x4*)((float*)(ws + WS_KR) + (size_t)m * 64 + 4 * lane) = acc4; }
            const f32x4 gq0 = ((const f32x4*)q_a_norm_g)[2 * lane], gq1 = ((const f32x4*)q_a_norm_g)[2 * lane + 1], gk0 = ((const f32x4*)kv_a_norm_g)[2 * lane], gk1 = ((const f32x4*)kv_a_norm_g)[2 * lane + 1];
            v4u oq, ok;
            oq.x = cvtpk(fq_[0] * iq * gq0.x, fq_[1] * iq * gq0.y); oq.y = cvtpk(fq_[2] * iq * gq0.z, fq_[3] * iq * gq0.w); oq.z = cvtpk(fq_[4] * iq * gq1.x, fq_[5] * iq * gq1.y); oq.w = cvtpk(fq_[6] * iq * gq1.z, fq_[7] * iq * gq1.w);
            ok.x = cvtpk(fk_[0] * ikv * gk0.x, fk_[1] * ikv * gk0.y); ok.y = cvtpk(fk_[2] * ikv * gk0.z, fk_[3] * ikv * gk0.w); ok.z = cvtpk(fk_[4] * ikv * gk1.x, fk_[5] * ikv * gk1.y); ok.w = cvtpk(fk_[6] * ikv * gk1.z, fk_[7] * ikv * gk1.w);
            *(v4u*)(CN + (size_t)m * 1024 + 8 * lane) = oq; *(v4u*)(CN + (size_t)m * 1024 + 512 + 8 * lane) = ok;
        }
        for (int base = gw * 4; base < M; base += NGW * 4) {
            const int s0 = base & (SEQ - 1);
#pragma unroll
            for (int jj = 0; jj < 2; ++jj) {
                const int col = 8 * lane + 512 * jj, grp = col >> 8, w = 2 << grp; int cnt = (s0 + 1 < w) ? s0 + 1 : w;
                float a[8], uc[8];
#pragma unroll
                for (int e = 0; e < 8; ++e) a[e] = 0.f;
#pragma unroll
                for (int d = 0; d < 16; ++d) {
                    if (d < cnt) { const v4u q = *(const v4u*)(U + (size_t)(base - d) * 1024 + col);
                        const float f[8] = {bflo(q.x), bfhi(q.x), bflo(q.y), bfhi(q.y), bflo(q.z), bfhi(q.z), bflo(q.w), bfhi(q.w)};
#pragma unroll
                        for (int e = 0; e < 8; ++e) { a[e] += f[e]; if (d == 0) uc[e] = f[e]; } }
                }
#pragma unroll
                for (int i = 0; i < 4; ++i) {
                    const int m = base + i;
                    if (i > 0) { const int s = s0 + i;
                        { const v4u q = *(const v4u*)(U + (size_t)m * 1024 + col);
                          uc[0] = bflo(q.x); uc[1] = bfhi(q.x); uc[2] = bflo(q.y); uc[3] = bfhi(q.y); uc[4] = bflo(q.z); uc[5] = bfhi(q.z); uc[6] = bflo(q.w); uc[7] = bfhi(q.w); }
#pragma unroll
                        for (int e = 0; e < 8; ++e) a[e] += uc[e];
                        if (s >= w) { const v4u q = *(const v4u*)(U + (size_t)(m - w) * 1024 + col);
                            a[0] -= bflo(q.x); a[1] -= bfhi(q.x); a[2] -= bflo(q.y); a[3] -= bfhi(q.y); a[4] -= bflo(q.z); a[5] -= bfhi(q.z); a[6] -= bflo(q.w); a[7] -= bfhi(q.w); }
                        cnt = (s + 1 < w) ? s + 1 : w; }
                    const float rc = 1.0f / (float)cnt;
                    v4u o; o.x = cvtpk(a[0] * rc - uc[0], a[1] * rc - uc[1]); o.y = cvtpk(a[2] * rc - uc[2], a[3] * rc - uc[3]);
                    o.z = cvtpk(a[4] * rc - uc[4], a[5] * rc - uc[5]); o.w = cvtpk(a[6] * rc - uc[6], a[7] * rc - uc[7]);
                    *(v4u*)(POOLED + (size_t)m * 1024 + col) = o;
                }
            }
        }
    TP_END(2); }
    SEAM(2);
    if (IN(3)) { TP_BEGIN(3);
        { pg8::Gemm g{CN, WQB_T, M, NH * DQK, QLORA, 1024, QLORA, 0, 0}; pg8::StaticOrder S; S.init(M, NH * DQK, G, bx);
          pg8::EpiBf16 E{Qb, 3072}; pg8::gemm_phase<pg8::EpiBf16, pg8::StaticOrder>(ldsl, g, S, E); }
        { pg8::Gemm g{CN + 512, WKVB_T, M, NH * 256, KVLORA, 1024, KVLORA, 0, 0}; pg8::StaticOrder S; S.init(M, NH * 256, G, bx);
          pg8::EpiKV E{Kb, Vb}; pg8::gemm_phase<pg8::EpiKV, pg8::StaticOrder>(ldsl, g, S, E); }
        { pg8::Gemm g{POOLED, WPG_T, M, POOLW, 256, 1024, 256, 256, 0}; pg8::StaticOrder S; S.init(M, POOLW, G, (bx + 128) % G);
          pg8::EpiScale E{PG, 1024, pool_scale}; pg8::gemm_phase<pg8::EpiScale, pg8::StaticOrder>(ldsl, g, S, E); }
    TP_END(3); }
    SEAM(3);
    if (IN(4)) { TP_BEGIN(4);
        for (int m = gw; m < M; m += NGW) {
            const float pos = (float)positions[m];
            const int sub = lane & 3, h = lane >> 2;
            float cs[8], sn[8];
#pragma unroll
            for (int j = 0; j < 8; ++j) { const int i = 8 * sub + j; const float invf = __builtin_amdgcn_exp2f(-(float)i * (13.287712379549449f / 32.f));
                const float ang = pos * invf; const float k = rintf(ang * 0.15915494309189535f);
                float r = fmaf(-k, 6.2831854820251465f, ang); r = fmaf(-k, -1.7484555e-7f, r);
                sn[j] = __sinf(r); cs[j] = __cosf(r); }
#pragma unroll
            for (int which = 0; which < 2; ++which) {
                bf16* base = (which == 0 ? Qb : Kb) + (size_t)m * 3072 + h * DQK;
                const float* gn = (which == 0) ? q_norm_g : k_norm_g;
                float nv[32], rl[8], rh[8]; float ss = 0.f;
#pragma unroll
                for (int jj = 0; jj < 4; ++jj) { const v4u q = *(const v4u*)(base + 32 * sub + 8 * jj);
                    nv[8 * jj + 0] = bflo(q.x); nv[8 * jj + 1] = bfhi(q.x); nv[8 * jj + 2] = bflo(q.y); nv[8 * jj + 3] = bfhi(q.y);
                    nv[8 * jj + 4] = bflo(q.z); nv[8 * jj + 5] = bfhi(q.z); nv[8 * jj + 6] = bflo(q.w); nv[8 * jj + 7] = bfhi(q.w); }
                if (which == 0) {
                    const v4u a = *(const v4u*)(base + 128 + 8 * sub), b = *(const v4u*)(base + 160 + 8 * sub);
                    rl[0] = bflo(a.x); rl[1] = bfhi(a.x); rl[2] = bflo(a.y); rl[3] = bfhi(a.y); rl[4] = bflo(a.z); rl[5] = bfhi(a.z); rl[6] = bflo(a.w); rl[7] = bfhi(a.w);
                    rh[0] = bflo(b.x); rh[1] = bfhi(b.x); rh[2] = bflo(b.y); rh[3] = bfhi(b.y); rh[4] = bflo(b.z); rh[5] = bfhi(b.z); rh[6] = bflo(b.w); rh[7] = bfhi(b.w);
                } else {
                    const float* kp = (const float*)(ws + WS_KR) + (size_t)m * 64 + 8 * sub;
                    const f32x4 a0 = *(const f32x4*)kp, a1 = *(const f32x4*)(kp + 4), b0 = *(const f32x4*)(kp + 32), b1 = *(const f32x4*)(kp + 36);
                    rl[0] = a0.x; rl[1] = a0.y; rl[2] = a0.z; rl[3] = a0.w; rl[4] = a1.x; rl[5] = a1.y; rl[6] = a1.z; rl[7] = a1.w;
                    rh[0] = b0.x; rh[1] = b0.y; rh[2] = b0.z; rh[3] = b0.w; rh[4] = b1.x; rh[5] = b1.y; rh[6] = b1.z; rh[7] = b1.w;
                }
#pragma unroll
                for (int e = 0; e < 32; ++e) ss += nv[e] * nv[e];
#pragma unroll
                for (int e = 0; e < 8; ++e) ss += rl[e] * rl[e] + rh[e] * rh[e];
                ss += __shfl_xor(ss, 1); ss += __shfl_xor(ss, 2);
                const float inv = 1.0f / sqrtf(ss * (1.f / 192.f) + EPS);
#pragma unroll
                for (int jj = 0; jj < 4; ++jj) { const f32x4 g0 = *(const f32x4*)(gn + 32 * sub + 8 * jj), g1 = *(const f32x4*)(gn + 32 * sub + 8 * jj + 4);
                    v4u o; o.x = cvtpk(nv[8 * jj + 0] * inv * g0.x, nv[8 * jj + 1] * inv * g0.y); o.y = cvtpk(nv[8 * jj + 2] * inv * g0.z, nv[8 * jj + 3] * inv * g0.w);
                    o.z = cvtpk(nv[8 * jj + 4] * inv * g1.x, nv[8 * jj + 5] * inv * g1.y); o.w = cvtpk(nv[8 * jj + 6] * inv * g1.z, nv[8 * jj + 7] * inv * g1.w);
                    *(v4u*)(base + 32 * sub + 8 * jj) = o; }
                float ol[8], oh[8];
#pragma unroll
                for (int e = 0; e < 8; ++e) { const float a = rl[e] * inv * gn[128 + 8 * sub + e], b = rh[e] * inv * gn[160 + 8 * sub + e];
                    ol[e] = a * cs[e] - b * sn[e]; oh[e] = b * cs[e] + a * sn[e]; }
                v4u o1, o2; o1.x = cvtpk(ol[0], ol[1]); o1.y = cvtpk(ol[2], ol[3]); o1.z = cvtpk(ol[4], ol[5]); o1.w = cvtpk(ol[6], ol[7]);
                o2.x = cvtpk(oh[0], oh[1]); o2.y = cvtpk(oh[2], oh[3]); o2.z = cvtpk(oh[4], oh[5]); o2.w = cvtpk(oh[6], oh[7]);
                *(v4u*)(base + 128 + 8 * sub) = o1; *(v4u*)(base + 160 + 8 * sub) = o2;
            }
        }
        { pg8::Gemm g{PG, WPO_T, M, DM, POOLW, POOLW, POOLW, 0, 0}; pg8::StaticOrder S; S.init(M, DM, G, bx);
          pg8::EpiGate<false> E{MP, Gt, nullptr, 0}; pg8::gemm_phase<pg8::EpiGate<false>, pg8::StaticOrder>(ldsl, g, S, E); }
    TP_END(4); }
    SEAM(4);
    if (IN(5)) { TP_BEGIN(5);
        const int npair = BATCH * NH * 8;
        for (int p = vcu; p < npair; p += G) {
            const int bh = p >> 3, s = p & 7;
            att::attn_unit(bh / NH, bh % NH, 15 - s, Qb, Kb, Vb, Ob, (char*)lds);
            att::attn_unit(bh / NH, bh % NH, s, Qb, Kb, Vb, Ob, (char*)lds);
        }
    TP_END(5); }
    SEAM(5);
    if (IN(6)) { TP_BEGIN(6);
        pg8::Gemm g{Ob, WAO_T, M, DM, DM, DM, DM, 0, 0}; pg8::StaticOrder S; S.init(M, DM, G, bx);
        pg8::EpiGate<true> E{MIXED, Gt, MP, 2048}; pg8::gemm_phase<pg8::EpiGate<true>, pg8::StaticOrder>(ldsl, g, S, E);
    TP_END(6); }
    SEAM(6);
    if (IN(7)) { TP_BEGIN(7);
        { constexpr int I_G = (DM / 64) * (DFF / 32);
#define GU_DESC(it__) ((it__) < I_G ? tr_desc(kin[17], DM, DFF, (bf16*)(ws + WS_WGU), 2, 0, (it__), ffn_norm_g) : tr_desc(kin[18], DM, DFF, (bf16*)(ws + WS_WGU), 3, 0, (it__) - I_G, ffn_norm_g))
          TR_PIPELINE(gw, 2 * I_G, NGW, GU_DESC);
#undef GU_DESC
          __syncthreads(); }
        pg8::Gemm g{MIXED, WOUT_T, M, DM, DM, DM, DM, 0, 0}; pg8::StaticOrder S; S.init(M, DM, G, bx);
        pg8::EpiResNorm E{kin[0], X1, (bf16*)(ws + WS_X1B), (float*)ws + SV_SS, DM}; pg8::gemm_phase<pg8::EpiResNorm, pg8::StaticOrder>(ldsl, g, S, E);
    TP_END(7); }
    SEAM(7);
    if (IN(9)) { TP_BEGIN(9);
        pg8::Gemm g{(bf16*)(ws + WS_X1B), WGU_T, M, 2 * DFF, DM, DM, DM, 0, 0}; pg8::StaticOrder S; S.init(M, 2 * DFF, G, bx);
        pg8::EpiSwiGLU E{ACT, DFF, (const float*)ws + SV_SS}; pg8::gemm_phase<pg8::EpiSwiGLU, pg8::StaticOrder>(ldsl, g, S, E);
        if (G == 256 ? (bx >= 128) : true) {
            constexpr int I_D2 = (DFF / 64) * (DM / 32);
            const int nw = (G == 256) ? 128 * NWAVES : NGW, w0 = (G == 256) ? (bx - 128) * NWAVES + wave : gw;
#define DN_DESC(it__) tr_desc(kin[19], DFF, DM, (bf16*)(ws + WS_WDN), 0, 0, (it__), nullptr)
            TR_PIPELINE(w0, I_D2, nw, DN_DESC);
#undef DN_DESC
        }
    TP_END(9); }
    SEAM(9);
    if (IN(10)) { TP_BEGIN(10);
        pg8::Gemm g{ACT, WDN_T, M, DM, DFF, DFF, DFF, 0, 0}; pg8::StaticOrder S; S.init(M, DM, G, bx);
        pg8::EpiRes E{X1, args.out, DM}; pg8::gemm_phase<pg8::EpiRes, pg8::StaticOrder>(ldsl, g, S, E);
    TP_END(10); }
#ifdef TPROBE
    if (blockIdx.x == 0 && threadIdx.x == 0) { const unsigned w_ = 4u * ((volatile LAS unsigned*)(ldsl + 140000))[1]; const unsigned long long t0_ = __builtin_amdgcn_s_memrealtime(); while ((unsigned)(__builtin_amdgcn_s_memrealtime() - t0_) < w_) __builtin_amdgcn_s_sleep(8); }
#endif
#undef IN
#undef SEAM
}

extern "C" void kernel_launch(void* const* d_in, const int* in_sizes, int n_in, void* d_out, int out_size, void* d_ws, size_t ws_size, hipStream_t stream) {
    static int grid = 0;
    if (grid == 0) {
        if (n_in != 20 || out_size != M * DM || ws_size < WS_END) { fprintf(stderr, "kernel_launch: unexpected shapes (n_in %d, out %d, ws %zu)\n", n_in, out_size, ws_size); grid = -1; return; }
        int dev = 0, cus = 0, per_cu = 0;
        (void)hipGetDevice(&dev); (void)hipDeviceGetAttribute(&cus, hipDeviceAttributeMultiprocessorCount, dev);
        if (hipFuncSetAttribute((const void*)mega_fwd, hipFuncAttributeMaxDynamicSharedMemorySize, LDS_BYTES) != hipSuccess) { fprintf(stderr, "kernel_launch: hipFuncSetAttribute failed\n"); grid = -1; return; }
        if (hipOccupancyMaxActiveBlocksPerMultiprocessor(&per_cu, (const void*)mega_fwd, NWAVES * 64, LDS_BYTES) != hipSuccess || per_cu < 1) { fprintf(stderr, "kernel_launch: occupancy query says %d\n", per_cu); per_cu = 1; }
        (void)hipGetLastError();
        grid = cus > 0 ? cus : 256;
    }
    if (grid < 0) return;
    Args a{};
    for (int i = 0; i < 20; ++i) a.in[i] = (const float*)d_in[i];
    a.out = (float*)d_out; a.ws = (unsigned char*)d_ws;
    if (MK_N_LAUNCHES == 1) {
        a.ph_lo = 0; a.ph_hi = NPH; a.coop = 1;
        (void)hipMemsetAsync((char*)d_ws + WS_BAR, 0, 16384, stream);
        void* kargs[] = {&a};
        hipError_t e = hipLaunchCooperativeKernel((const void*)mega_fwd, dim3(grid), dim3(NWAVES * 64), kargs, LDS_BYTES, stream);
        if (e != hipSuccess) fprintf(stderr, "kernel_launch: cooperative launch failed: %s (grid %d)\n", hipGetErrorString(e), grid);
    } else {
        for (int p = 0; p < NPH; ++p) {
            a.ph_lo = p; a.ph_hi = p + 1;
            hipLaunchKernelGGL(mega_fwd, dim3(grid), dim3(NWAVES * 64), LDS_BYTES, stream, a);
        }
    }
}
```

```cpp
#include <hip/hip_runtime.h>
#include <hip/hip_cooperative_groups.h>
#include <cstdio>
#include <cstdint>
namespace cg = cooperative_groups;

#ifndef MK_N_LAUNCHES
#define MK_N_LAUNCHES 1
#endif

namespace pg8 {
#define PG8_LAS __attribute__((address_space(3)))
typedef unsigned short bf16_t;
typedef short bf16x8 __attribute__((ext_vector_type(8)));
typedef float f32x4 __attribute__((ext_vector_type(4)));
typedef unsigned u32x4 __attribute__((ext_vector_type(4)));
constexpr int BM = 256, BK = 64, HALF = 128, HTB = HALF * BK * 2, STAGE_BYTES = 8 * HTB, NXCD = 8, WGM = 8;

__host__ __device__ __forceinline__ int lds_byte(int r, int c) { const int st = (r >> 4) * 2 + (c >> 5), rr = r & 15, cc = c & 31, ob = rr * 64 + cc * 2; return st * 1024 + (ob ^ (((ob >> 9) & 1) << 5)); }
__host__ __device__ __forceinline__ void stage_rc(int b, int& R, int& C) { const int st = b / 1024, sb = b % 1024, swz = sb ^ (((sb >> 9) & 1) << 5); R = (st >> 1) * 16 + swz / 64; C = (st & 1) * 32 + (swz % 64) / 2; }
__host__ __device__ __forceinline__ int perm32(int rho) { const int n = rho >> 4, i = rho & 15; return 8 * (i >> 2) + 4 * n + (i & 3); }

struct Unit { int pm, pn; };
struct Gemm { const bf16_t* A; const bf16_t* Bt; int M, N, K, lda, ldb, a_pn_step, b_pn_step; };

struct StaticOrder {
    int nM, nN, nwg, G, c;
    __host__ __device__ void init(int M, int N, int G_, int c_) { nM = M / BM; nN = N / BM; nwg = nM * nN; G = G_; c = c_; }
    __host__ __device__ bool next(int i, Unit& u) const {
        const long L = (long)i * G + c; if (L >= nwg) return false;
        int wgid = (int)L; { const int q = nwg / NXCD, r = nwg % NXCD, xcd = wgid % NXCD, off = wgid / NXCD; wgid = (xcd < r ? xcd * (q + 1) : r * (q + 1) + (xcd - r) * q) + off; }
        const int nig = WGM * nN, gid = wgid / nig, fm = gid * WGM, gsz = (nM - fm) < WGM ? (nM - fm) : WGM;
        u.pm = fm + ((wgid % nig) % gsz); u.pn = (wgid % nig) / gsz; return true;
    }
};

typedef float f32x2_t_ __attribute__((ext_vector_type(2))); typedef __bf16 bf16x2_t_ __attribute__((ext_vector_type(2)));
__device__ __forceinline__ unsigned cvt_pk_bf16(float lo, float hi) { f32x2_t_ v = {lo, hi}; bf16x2_t_ b = __builtin_convertvector(v, bf16x2_t_); return __builtin_bit_cast(unsigned, b); }
__device__ __forceinline__ u32x4 pack8(f32x4 a, f32x4 b) { u32x4 w; w.x = cvt_pk_bf16(a[0], a[1]); w.y = cvt_pk_bf16(a[2], a[3]); w.z = cvt_pk_bf16(b[0], b[1]); w.w = cvt_pk_bf16(b[2], b[3]); return w; }
__device__ __forceinline__ void unpack8(u32x4 w, f32x4& a, f32x4& b) {
    a[0] = __uint_as_float(w.x << 16); a[1] = __uint_as_float(w.x & 0xffff0000u); a[2] = __uint_as_float(w.y << 16); a[3] = __uint_as_float(w.y & 0xffff0000u);
    b[0] = __uint_as_float(w.z << 16); b[1] = __uint_as_float(w.z & 0xffff0000u); b[2] = __uint_as_float(w.w << 16); b[3] = __uint_as_float(w.w & 0xffff0000u); }
__device__ __forceinline__ float sigmoidf_(float v) { return __builtin_amdgcn_rcpf(1.0f + __builtin_amdgcn_exp2f(-1.4426950408889634f * v)); }
__device__ __forceinline__ f32x4 sigmoid4(f32x4 v) { f32x4 o; o[0] = sigmoidf_(v[0]); o[1] = sigmoidf_(v[1]); o[2] = sigmoidf_(v[2]); o[3] = sigmoidf_(v[3]); return o; }

typedef f32x4 AccT[2][2][4][2];
#define EPI_LOOP_AM _Pragma("unroll") for (int ai = 0; ai < 2; ++ai) _Pragma("unroll") for (int m = 0; m < 4; ++m)
#define EPI_LOOP_B _Pragma("unroll") for (int bj = 0; bj < 2; ++bj)

struct EpiIn {
    static constexpr bool PERM = true;
    bf16_t* C1; bf16_t* U; bf16_t* G; const float* bgate;
    __device__ __forceinline__ void operator()(const AccT& acc, const Unit& u, int wr, int wc, int fr, int fq) const {
        const int row0 = u.pm * BM + wr * 64 + fr, pn = u.pn, cw = wc * 32 + 8 * fq;
        if (pn < 4) {
            EPI_LOOP_AM { bf16_t* rp = C1 + (size_t)(row0 + ai * HALF + m * 16) * 1024 + pn * 256 + cw;
                EPI_LOOP_B { *(u32x4*)(rp + bj * HALF) = pack8(acc[ai][bj][m][0], acc[ai][bj][m][1]); } }
        } else if (pn < 8) {
            EPI_LOOP_AM { bf16_t* rp = U + (size_t)(row0 + ai * HALF + m * 16) * 1024 + (pn - 4) * 256 + cw;
                EPI_LOOP_B { *(u32x4*)(rp + bj * HALF) = pack8(acc[ai][bj][m][0], acc[ai][bj][m][1]); } }
        } else {
            const int gc = (pn - 8) * 256 + cw; f32x4 bv[2][2];
            EPI_LOOP_B { bv[bj][0] = *(const f32x4*)(bgate + gc + bj * HALF); bv[bj][1] = *(const f32x4*)(bgate + gc + bj * HALF + 4); }
            EPI_LOOP_AM { bf16_t* rp = G + (size_t)(row0 + ai * HALF + m * 16) * 4096 + gc;
                EPI_LOOP_B { *(u32x4*)(rp + bj * HALF) = pack8(sigmoid4(acc[ai][bj][m][0] + bv[bj][0]), sigmoid4(acc[ai][bj][m][1] + bv[bj][1])); } }
        }
    }
};
struct EpiKRP {
    static constexpr bool PERM = true;
    float* KRP;
    __device__ __forceinline__ void operator()(const AccT& acc, const Unit& u, int wr, int wc, int fr, int fq) const {
        const int row0 = u.pm * BM + wr * 64 + fr, cw = wc * 32 + 8 * fq;
        if (wc < 2) { EPI_LOOP_AM { float* rp = KRP + ((size_t)u.pn * 8192 + (row0 + ai * HALF + m * 16)) * 64 + cw; *(f32x4*)rp = acc[ai][0][m][0]; *(f32x4*)(rp + 4) = acc[ai][0][m][1]; } }
    }
};
struct EpiBf16 {
    static constexpr bool PERM = true;
    bf16_t* O; int ldc;
    __device__ __forceinline__ void operator()(const AccT& acc, const Unit& u, int wr, int wc, int fr, int fq) const {
        const int row0 = u.pm * BM + wr * 64 + fr, col0 = u.pn * BM + wc * 32 + 8 * fq;
        EPI_LOOP_AM { bf16_t* rp = O + (size_t)(row0 + ai * HALF + m * 16) * ldc + col0;
            EPI_LOOP_B { *(u32x4*)(rp + bj * HALF) = pack8(acc[ai][bj][m][0], acc[ai][bj][m][1]); } }
    }
};
struct EpiKV {
    static constexpr bool PERM = true;
    bf16_t* K; bf16_t* V;
    __device__ __forceinline__ void operator()(const AccT& acc, const Unit& u, int wr, int wc, int fr, int fq) const {
        const int row0 = u.pm * BM + wr * 64 + fr, cw = wc * 32 + 8 * fq, h = u.pn;
        EPI_LOOP_AM { const size_t row = (size_t)(row0 + ai * HALF + m * 16);
            *(u32x4*)(K + row * 3072 + h * 192 + cw) = pack8(acc[ai][0][m][0], acc[ai][0][m][1]);
            *(u32x4*)(V + row * 2048 + h * 128 + cw) = pack8(acc[ai][1][m][0], acc[ai][1][m][1]); }
    }
};
struct EpiScale {
    static constexpr bool PERM = true;
    bf16_t* O; int ldc; const float* scale;
    __device__ __forceinline__ void operator()(const AccT& acc, const Unit& u, int wr, int wc, int fr, int fq) const {
        const int row0 = u.pm * BM + wr * 64 + fr, col0 = u.pn * BM + wc * 32 + 8 * fq; f32x4 sv[2][2];
        EPI_LOOP_B { sv[bj][0] = *(const f32x4*)(scale + col0 + bj * HALF); sv[bj][1] = *(const f32x4*)(scale + col0 + bj * HALF + 4); }
        EPI_LOOP_AM { bf16_t* rp = O + (size_t)(row0 + ai * HALF + m * 16) * ldc + col0;
            EPI_LOOP_B { *(u32x4*)(rp + bj * HALF) = pack8(acc[ai][bj][m][0] * sv[bj][0], acc[ai][bj][m][1] * sv[bj][1]); } }
    }
};
template <bool HAS_ADD> struct EpiGate {
    static constexpr bool PERM = true;
    bf16_t* O; const bf16_t* gate; const bf16_t* add; int gcol0;
    __device__ __forceinline__ void operator()(const AccT& acc, const Unit& u, int wr, int wc, int fr, int fq) const {
        const int row0 = u.pm * BM + wr * 64 + fr, col0 = u.pn * BM + wc * 32 + 8 * fq;
        EPI_LOOP_AM { const size_t row = (size_t)(row0 + ai * HALF + m * 16);
            EPI_LOOP_B { f32x4 g0, g1; unpack8(__builtin_nontemporal_load((const u32x4*)(gate + row * 4096 + gcol0 + col0 + bj * HALF)), g0, g1);
                f32x4 v0 = g0 * acc[ai][bj][m][0], v1 = g1 * acc[ai][bj][m][1];
                if (HAS_ADD) { f32x4 a0, a1; unpack8(__builtin_nontemporal_load((const u32x4*)(add + row * 2048 + col0 + bj * HALF)), a0, a1); v0 += a0; v1 += a1; }
                *(u32x4*)(O + row * 2048 + col0 + bj * HALF) = pack8(v0, v1); } }
    }
};
struct EpiRes {
    static constexpr bool PERM = false;
    const bf16_t* base; float* out; int ldc;
    __device__ __forceinline__ void operator()(const AccT& acc, const Unit& u, int wr, int wc, int fr, int fq) const {
        const int row0 = u.pm * BM + wr * 64 + fr, col0 = u.pn * BM + wc * 32 + 4 * fq;
        EPI_LOOP_AM { const size_t off = (size_t)(row0 + ai * HALF + m * 16) * ldc + col0;
            EPI_LOOP_B {
#pragma unroll
                for (int n = 0; n < 2; ++n) { typedef unsigned u32x2_ __attribute__((ext_vector_type(2))); const u32x2_ w = __builtin_nontemporal_load((const u32x2_*)(base + off + bj * HALF + n * 16));
                    const f32x4 b = {__uint_as_float(w.x << 16), __uint_as_float(w.x & 0xffff0000u), __uint_as_float(w.y << 16), __uint_as_float(w.y & 0xffff0000u)};
                    __builtin_nontemporal_store(b + acc[ai][bj][m][n], (f32x4*)(out + off + bj * HALF + n * 16)); } } }
    }
};
struct EpiResNorm {
    static constexpr bool PERM = false;
    const float* base; float* out; bf16_t* outb; float* ss; int ldc;
    __device__ __forceinline__ void operator()(const AccT& acc, const Unit& u, int wr, int wc, int fr, int fq) const {
        const int row0 = u.pm * BM + wr * 64 + fr, col0 = u.pn * BM + wc * 32 + 4 * fq;
        EPI_LOOP_AM { const int row = row0 + ai * HALF + m * 16; const size_t off = (size_t)row * ldc + col0; float s = 0.f;
            EPI_LOOP_B {
#pragma unroll
                for (int n = 0; n < 2; ++n) { const f32x4 v = __builtin_nontemporal_load((const f32x4*)(base + off + bj * HALF + n * 16)) + acc[ai][bj][m][n];
                    typedef unsigned u32x2_ __attribute__((ext_vector_type(2))); u32x2_ w; w.x = cvt_pk_bf16(v[0], v[1]); w.y = cvt_pk_bf16(v[2], v[3]); *(u32x2_*)(outb + off + bj * HALF + n * 16) = w;
                    s += (v[0] * v[0] + v[1] * v[1]) + (v[2] * v[2] + v[3] * v[3]); } }
            s += __shfl_xor(s, 16); s += __shfl_xor(s, 32);
            if (fq == 0) atomicAdd(ss + row, s); }
    }
};
struct EpiSwiGLU {
    static constexpr bool PERM = true;
    bf16_t* O; int ldc; const float* ss;
    __device__ __forceinline__ void operator()(const AccT& acc, const Unit& u, int wr, int wc, int fr, int fq) const {
        const int row0 = u.pm * BM + wr * 64 + fr, col0 = u.pn * HALF + wc * 32 + 8 * fq;
        EPI_LOOP_AM { const int row = row0 + ai * HALF + m * 16; bf16_t* rp = O + (size_t)row * ldc + col0;
            const float inv = 1.0f / sqrtf(ss[row] * (1.f / 2048.f) + 1e-6f);
            const f32x4 g0 = acc[ai][0][m][0] * inv, g1 = acc[ai][0][m][1] * inv;
            *(u32x4*)rp = pack8(g0 * sigmoid4(g0) * (acc[ai][1][m][0] * inv), g1 * sigmoid4(g1) * (acc[ai][1][m][1] * inv)); }
    }
};

template <class Epi, class Sched, bool ALIGN_EPI = true>
__device__ __forceinline__ void gemm_phase(PG8_LAS unsigned char* lds, const Gemm g, const Sched& S, const Epi& E) {
    const int tid = threadIdx.x, wid = __builtin_amdgcn_readfirstlane(tid >> 6), lane = tid & 63, wr = wid >> 2, wc = wid & 3, fr = lane & 15, fq = lane >> 4;
    const int K = g.K, nt = K / BK;
    unsigned voffA[2], voffB[2];
#pragma unroll
    for (int i = 0; i < 2; ++i) { int R, C; stage_rc(tid * 16 + i * 8192, R, C); const int Rb = Epi::PERM ? ((R & ~31) + perm32(R & 31)) : R;
        voffA[i] = (unsigned)(R * g.lda + C) * 2u; voffB[i] = (unsigned)(Rb * g.ldb + C) * 2u; }
    const size_t kstep = (size_t)(BK * 2);
    const size_t hstepA = (size_t)HALF * g.lda * 2, hstepB = (size_t)HALF * g.ldb * 2;
    const size_t tstepA = 2 * hstepA, tstepB = g.b_pn_step ? (size_t)g.b_pn_step * 2 : 2 * hstepB, pstepA = (size_t)g.a_pn_step * 2;
    const unsigned ldsw = (unsigned)wid * 1024u;
    const int aoff = lds_byte(wr * 64 + fr, fq * 8), boff = lds_byte(wc * 32 + fr, fq * 8);
#define PG8_SA(b, h) (((b) * 2 + (h)) * HTB)
#define PG8_SB(b, h) ((4 + (b) * 2 + (h)) * HTB)
#define PG8_STAGE(bufoff, gbase, voff) do { _Pragma("unroll") for (int _i = 0; _i < 2; ++_i) \
        __builtin_amdgcn_global_load_lds((const unsigned*)((const char*)(gbase) + (voff)[_i]), (PG8_LAS unsigned*)(lds + (bufoff) + ldsw + _i * 8192), 16, 0, 0); } while (0)
#define PG8_LDA(dst, b, h) do { _Pragma("unroll") for (int m = 0; m < 4; ++m) _Pragma("unroll") for (int k = 0; k < 2; ++k) dst[m][k] = *(const PG8_LAS bf16x8*)(lds + PG8_SA(b, h) + aoff + m * 2048 + k * 1024); } while (0)
#define PG8_LDB(dst, b, h) do { _Pragma("unroll") for (int n = 0; n < 2; ++n) _Pragma("unroll") for (int k = 0; k < 2; ++k) dst[n][k] = *(const PG8_LAS bf16x8*)(lds + PG8_SB(b, h) + boff + n * 2048 + k * 1024); } while (0)
#define PG8_MMA(ai, bj, At, Bt) do { __builtin_amdgcn_s_setprio(1); _Pragma("unroll") for (int m = 0; m < 4; ++m) _Pragma("unroll") for (int n = 0; n < 2; ++n) _Pragma("unroll") for (int k = 0; k < 2; ++k) \
        acc[ai][bj][m][n] = __builtin_amdgcn_mfma_f32_16x16x32_bf16(Bt[n][k], At[m][k], acc[ai][bj][m][n], 0, 0, 0); __builtin_amdgcn_s_setprio(0); } while (0)
#define PG8_WAIT_V(n) asm volatile("s_waitcnt vmcnt(" #n ")" ::: "memory")
#define PG8_WAIT_L(n) asm volatile("s_waitcnt lgkmcnt(" #n ")" ::: "memory")
#define PG8_BAR __builtin_amdgcn_s_barrier()
#define PG8_SCHED __builtin_amdgcn_sched_barrier(0)
    Unit cur, nxt; int ui = 0;
    if (!S.next(0, cur)) return;
    f32x4 acc[2][2][4][2];
#pragma unroll
    for (int a = 0; a < 2; ++a)
#pragma unroll
        for (int b = 0; b < 2; ++b)
#pragma unroll
            for (int m = 0; m < 4; ++m)
#pragma unroll
                for (int n = 0; n < 2; ++n) acc[a][b][m][n] = (f32x4){0.f, 0.f, 0.f, 0.f};
    bf16x8 At[4][2], B0[2][2], B1[2][2];
    const char* cA = (const char*)g.A + (size_t)cur.pm * tstepA + (size_t)cur.pn * pstepA; const char* cB = (const char*)g.Bt + (size_t)cur.pn * tstepB;
    PG8_STAGE(PG8_SB(0, 0), cB, voffB); PG8_STAGE(PG8_SB(0, 1), cB + hstepB, voffB); PG8_STAGE(PG8_SA(0, 0), cA, voffA); PG8_STAGE(PG8_SA(0, 1), cA + hstepA, voffA);
    if (wr == 1) PG8_BAR;
    PG8_WAIT_V(2); PG8_BAR;
    PG8_STAGE(PG8_SB(1, 0), cB + kstep, voffB); PG8_STAGE(PG8_SA(1, 0), cA + kstep, voffA); PG8_STAGE(PG8_SB(1, 1), cB + hstepB + kstep, voffB);
    PG8_WAIT_V(6); PG8_BAR;
    for (;;) {
        const bool has_next = S.next(ui + 1, nxt);
        const char* nA = has_next ? (const char*)g.A + (size_t)nxt.pm * tstepA + (size_t)nxt.pn * pstepA : cA; const char* nB = has_next ? (const char*)g.Bt + (size_t)nxt.pn * tstepB : cB;
        for (int t = 0; t < nt; t += 2) {
            const bool last = (t == nt - 2);
            const char* a1 = cA + (size_t)(t + 1) * kstep;
            const char* a2 = last ? nA : cA + (size_t)(t + 2) * kstep; const char* b2 = last ? nB : cB + (size_t)(t + 2) * kstep;
            const char* a3 = a2 + kstep; const char* b3 = b2 + kstep;
            PG8_LDB(B0, 0, 0); PG8_LDB(B1, 0, 1); PG8_SCHED; PG8_LDA(At, 0, 0); PG8_STAGE(PG8_SA(1, 1), a1 + hstepA, voffA);
            PG8_WAIT_V(8); PG8_WAIT_L(0); PG8_BAR; PG8_MMA(0, 0, At, B0); PG8_MMA(0, 1, At, B1); PG8_BAR; PG8_SCHED;
            PG8_LDA(At, 0, 1); PG8_STAGE(PG8_SB(0, 0), b2, voffB); PG8_STAGE(PG8_SB(0, 1), b2 + hstepB, voffB); PG8_STAGE(PG8_SA(0, 0), a2, voffA);
            PG8_WAIT_V(8); PG8_WAIT_L(0); PG8_BAR; PG8_MMA(1, 0, At, B0); PG8_MMA(1, 1, At, B1); PG8_BAR; PG8_SCHED;
            PG8_LDB(B0, 1, 0); PG8_LDB(B1, 1, 1); PG8_SCHED; PG8_LDA(At, 1, 0); PG8_STAGE(PG8_SA(0, 1), a2 + hstepA, voffA);
            PG8_WAIT_V(8); PG8_WAIT_L(0); PG8_BAR; PG8_MMA(0, 0, At, B0); PG8_MMA(0, 1, At, B1); PG8_BAR; PG8_SCHED;
            PG8_LDA(At, 1, 1); PG8_STAGE(PG8_SB(1, 0), b3, voffB); PG8_STAGE(PG8_SB(1, 1), b3 + hstepB, voffB); PG8_STAGE(PG8_SA(1, 0), a3, voffA);
            PG8_WAIT_V(8); PG8_WAIT_L(0); PG8_BAR; PG8_MMA(1, 0, At, B0); PG8_MMA(1, 1, At, B1); PG8_BAR; PG8_SCHED;
        }
        if constexpr (ALIGN_EPI) { if (wr == 0) PG8_BAR; }
        E(acc, cur, wr, wc, fr, fq);
        if (!has_next) break;
#pragma unroll
        for (int a = 0; a < 2; ++a)
#pragma unroll
            for (int b = 0; b < 2; ++b)
#pragma unroll
                for (int m = 0; m < 4; ++m)
#pragma unroll
                    for (int n = 0; n < 2; ++n) acc[a][b][m][n] = (f32x4){0.f, 0.f, 0.f, 0.f};
        cur = nxt; cA = nA; cB = nB; ++ui;
        if constexpr (ALIGN_EPI) { if (wr == 1) PG8_BAR; }
    }
    PG8_WAIT_V(0);
    if constexpr (!ALIGN_EPI) { if (wr == 0) PG8_BAR; }
    PG8_BAR;
#undef PG8_SA
#undef PG8_SB
#undef PG8_STAGE
#undef PG8_LDA
#undef PG8_LDB
#undef PG8_MMA
#undef PG8_WAIT_V
#undef PG8_WAIT_L
#undef PG8_BAR
#undef PG8_SCHED
}
}

constexpr int BATCH = 2, SEQ = 4096, DM = 2048, M = BATCH * SEQ;
constexpr int NH = 16, DQK = 192, DNOPE = 128, DROPE = 64, DV = 128, QLORA = 512, KVLORA = 512;
constexpr int POOLW = 1024, DIN = 6208, DIN_PAD = 6400, DFF = 5632;
constexpr float EPS = 1e-6f;
constexpr int NWAVES = 8;

typedef unsigned short bf16;
typedef unsigned v4u __attribute__((ext_vector_type(4)));
typedef unsigned v2u __attribute__((ext_vector_type(2)));
typedef float f32x4 __attribute__((ext_vector_type(4)));
typedef short bf16x8 __attribute__((ext_vector_type(8)));
typedef short s16x4 __attribute__((ext_vector_type(4)));
typedef float f32x16 __attribute__((ext_vector_type(16)));
#define LAS __attribute__((address_space(3)))
#define LDS_WAIT() asm volatile("s_waitcnt lgkmcnt(0)" ::: "memory")

constexpr size_t MiB = 1u << 20;
constexpr size_t WS_WAO = 1 * MiB, WS_WOUT = 9 * MiB, WS_WPO = 17 * MiB, WS_WQB = 21 * MiB, WS_WKVB = 24 * MiB, WS_WPG = 28 * MiB, WS_KR = 29 * MiB;
constexpr size_t WS_G = 31 * MiB;
constexpr size_t WS_WIN = 95 * MiB, WS_XN = 120 * MiB, WS_C1 = 152 * MiB, WS_U = 184 * MiB;
constexpr size_t WS_Q = 95 * MiB, WS_K = 143 * MiB, WS_V = 191 * MiB, WS_CN = 223 * MiB, WS_POOLED = 239 * MiB, WS_PG = 255 * MiB;
constexpr size_t WS_MP = 223 * MiB, WS_O = 255 * MiB, WS_MIXED = 95 * MiB, WS_X1 = 127 * MiB, WS_H2 = 95 * MiB;
constexpr size_t WS_WGU = 191 * MiB, WS_WDN = 235 * MiB, WS_ACT = 1 * MiB;
constexpr size_t WS_END = 296 * MiB, WS_BAR = 512 * 1024, WS_KRP = 272 * MiB, WS_X1B = 257 * MiB;
constexpr int SV_BGATE = 0, SV_QAG = 4096, SV_KVAG = 4608, SV_QNG = 5120, SV_KNG = 5376, SV_PSC = 5632, SV_FNG = 6656, SV_POS = 8704, SV_END = 8704 + 8192, SV_SS = 32768;

constexpr int LDS_BYTES = 147456;

__device__ __forceinline__ unsigned cvtpk(float lo, float hi) { return pg8::cvt_pk_bf16(lo, hi); }
__device__ __forceinline__ float bflo(unsigned w) { return __uint_as_float(w << 16); }
__device__ __forceinline__ float bfhi(unsigned w) { return __uint_as_float(w & 0xffff0000u); }
__device__ __forceinline__ float wave_sum(float v) {
#pragma unroll
    for (int o = 1; o < 64; o <<= 1) v += __shfl_xor(v, o);
    return v;
}

__device__ __forceinline__ int dst_row(int mode, int n0) {
    if (mode == 1) { if (n0 < 1024) return n0; if (n0 < 1088) return 6144 + (n0 - 1024); if (n0 < 2112) return 1024 + (n0 - 1088); return 2048 + (n0 - 2112); }
    if (mode == 2) return (n0 >> 7) * 256 + (n0 & 127);
    if (mode == 3) return (n0 >> 7) * 256 + 128 + (n0 & 127);
    return n0;
}
__device__ __forceinline__ void transpose_item(const float* W, int K, int N, bf16* WT, int mode, int row_off, LAS float* scr, int item, int lane, const float* gk = nullptr) {
    const int nblk = N / 32, kb = item / nblk, nb = item % nblk, k0 = 64 * kb, n0 = 32 * nb;
    { float tv[32]; const float* wp = W + (size_t)(k0 + (lane >> 5)) * N + n0 + (lane & 31);
#pragma unroll
      for (int i = 0; i < 32; ++i) tv[i] = wp[(size_t)(2 * i) * N];
      if (gk) {
#pragma unroll
          for (int i = 0; i < 32; ++i) tv[i] *= gk[k0 + 2 * i + (lane >> 5)]; }
#pragma unroll
      for (int i = 0; i < 32; ++i) scr[(2 * i + (lane >> 5)) * 33 + (lane & 31)] = tv[i]; }
    LDS_WAIT(); asm volatile("" ::: "memory");
    const int c = lane & 7, dr = row_off + dst_row(mode, n0);
#pragma unroll
    for (int j = 0; j < 4; ++j) { const int n = (lane >> 3) + 8 * j; const LAS float* s = scr + (8 * c) * 33 + n;
        v4u o; o.x = cvtpk(s[0 * 33], s[1 * 33]); o.y = cvtpk(s[2 * 33], s[3 * 33]); o.z = cvtpk(s[4 * 33], s[5 * 33]); o.w = cvtpk(s[6 * 33], s[7 * 33]);
        *(v4u*)(WT + (size_t)(dr + n) * K + k0 + 8 * c) = o; }
    LDS_WAIT(); asm volatile("" ::: "memory");
}

struct TrDesc { const float* W; bf16* WT; const float* gk; int K, N, k0, n0, dr; };
__device__ __forceinline__ TrDesc tr_desc(const float* W, int K, int N, bf16* WT, int mode, int row_off, int item, const float* gk) {
    const int nblk = N / 32, kb = item / nblk, nb = item % nblk; TrDesc d; d.W = W; d.WT = WT; d.gk = gk; d.K = K; d.N = N; d.k0 = 64 * kb; d.n0 = 32 * nb; d.dr = row_off + dst_row(mode, d.n0); return d; }
__device__ __forceinline__ void tr_load(const TrDesc& d, float (&tv)[32], int lane) {
    const float* wp = d.W + (size_t)(d.k0 + (lane >> 5)) * d.N + d.n0 + (lane & 31);
#pragma unroll
    for (int i = 0; i < 32; ++i) tv[i] = __builtin_nontemporal_load(wp + (size_t)(2 * i) * d.N);
}
__device__ __forceinline__ void tr_finish(const TrDesc& d, float (&tv)[32], LAS float* scr, int lane) {
    if (d.gk) {
#pragma unroll
        for (int i = 0; i < 32; ++i) tv[i] *= d.gk[d.k0 + 2 * i + (lane >> 5)]; }
#pragma unroll
    for (int i = 0; i < 32; ++i) scr[(2 * i + (lane >> 5)) * 33 + (lane & 31)] = tv[i];
    LDS_WAIT(); asm volatile("" ::: "memory");
    const int c = lane & 7;
#pragma unroll
    for (int j = 0; j < 4; ++j) { const int n = (lane >> 3) + 8 * j; const LAS float* s_ = scr + (8 * c) * 33 + n;
        v4u o; o.x = cvtpk(s_[0 * 33], s_[1 * 33]); o.y = cvtpk(s_[2 * 33], s_[3 * 33]); o.z = cvtpk(s_[4 * 33], s_[5 * 33]); o.w = cvtpk(s_[6 * 33], s_[7 * 33]);
        *(v4u*)(d.WT + (size_t)(d.dr + n) * d.K + d.k0 + 8 * c) = o; }
    LDS_WAIT(); asm volatile("" ::: "memory");
}
#define TR_PIPELINE(FIRST, LIMIT, STRIDE, MAKE_DESC) do { int it_ = (FIRST); if (it_ < (LIMIT)) { TrDesc dA_ = MAKE_DESC(it_); float tvA_[32]; tr_load(dA_, tvA_, lane); \
        for (;;) { const int nx_ = it_ + (STRIDE); const bool more_ = nx_ < (LIMIT); TrDesc dB_ = dA_; float tvB_[32]; \
            if (more_) { dB_ = MAKE_DESC(nx_); tr_load(dB_, tvB_, lane); } \
            tr_finish(dA_, tvA_, scr, lane); if (!more_) break; \
            dA_ = dB_; _Pragma("unroll") for (int i_ = 0; i_ < 32; ++i_) tvA_[i_] = tvB_[i_]; it_ = nx_; } } } while (0)

__device__ __forceinline__ void rms_row_2048(const float* xrow, const float* g, bf16* orow, int lane) {
    const f32x4* xr = (const f32x4*)xrow + lane; const f32x4* gr = (const f32x4*)g + lane;
    f32x4 v[8]; float s = 0.f;
#pragma unroll
    for (int j = 0; j < 8; ++j) { v[j] = __builtin_nontemporal_load(xr + 64 * j); s += (v[j].x * v[j].x + v[j].y * v[j].y) + (v[j].z * v[j].z + v[j].w * v[j].w); }
    const float inv = 1.0f / sqrtf(wave_sum(s) * (1.f / 2048.f) + EPS);
    v2u* o8 = (v2u*)orow + lane;
#pragma unroll
    for (int j = 0; j < 8; ++j) { const f32x4 gv = gr[64 * j]; v2u o; o.x = cvtpk(v[j].x * inv * gv.x, v[j].y * inv * gv.y); o.y = cvtpk(v[j].z * inv * gv.z, v[j].w * inv * gv.w); o8[64 * j] = o; }
}

namespace att {
constexpr int QBLK = 32, KVBLK = 64, QB = 256;
constexpr int SHM_V = KVBLK * DV * 2, SHM_K = KVBLK * DQK * 2;
constexpr int OFF_V = 0, OFF_K = 3 * SHM_V, OFF_WS = OFF_K + 2 * SHM_K;
constexpr float SCALE = 0.07216878364870322f;
constexpr float THR = 8.f;
#define KSWZ(row, colB) ((row) * 384 + ((colB) ^ (((row) & 7) << 4)))
#define SBAR() __builtin_amdgcn_sched_barrier(0)
__device__ __forceinline__ int v_st(int k, int c) { const int kk = (k & ~0xC) | ((k & 4) << 1) | ((k & 8) >> 1); return ((kk >> 3) * 4 + (c >> 5)) * 512 + ((kk & 7) * 32 + (c & 31)) * 2; }
__device__ __forceinline__ int v_rd_base(int lane) { return ((lane & 3) << 3) | (((lane >> 2) & 3) << 6) | (((lane >> 4) & 1) << 5) | (((lane >> 5) & 1) << 8); }
__device__ __forceinline__ int crow(int r, int hi) { return (r & 3) + 8 * (r >> 2) + 4 * hi; }
__device__ __forceinline__ void mask_tile(f32x16& p0, f32x16& p1, int dq) {
    const float NEG = -__builtin_inff();
#pragma unroll
    for (int r = 0; r < 16; ++r) {
        const int c = (r & 3) + 8 * (r >> 2);
        if (dq - c < 0) p0[r] = NEG;
        if (dq - c - 32 < 0) p1[r] = NEG;
    }
}
__device__ __forceinline__ void partialSM(f32x16& p0, f32x16& p1, float& m_reg, float& mn, float& alpha) {
    float pmax = p0[0];
#pragma unroll
    for (int r = 1; r < 16; ++r) pmax = fmaxf(pmax, p0[r]);
#pragma unroll
    for (int r = 0; r < 16; ++r) pmax = fmaxf(pmax, p1[r]);
    { auto rr = __builtin_amdgcn_permlane32_swap(__float_as_uint(pmax), __float_as_uint(pmax), false, false);
      pmax = fmaxf(__uint_as_float(rr[0]), __uint_as_float(rr[1])); }
    constexpr float C2 = 1.4426950408889634f * SCALE;
    if (__builtin_expect(__all((pmax - m_reg) * SCALE <= THR), 1)) { mn = m_reg; alpha = 1.f; }
    else { mn = fmaxf(m_reg, pmax); alpha = __builtin_amdgcn_exp2f((m_reg - mn) * C2); m_reg = mn; }
    const float mnL = -mn * C2;
#pragma unroll
    for (int r = 0; r < 16; ++r) p0[r] = fmaf(p0[r], C2, mnL);
#pragma unroll
    for (int r = 0; r < 16; ++r) p1[r] = fmaf(p1[r], C2, mnL);
#pragma unroll
    for (int r = 0; r < 16; ++r) p0[r] = __builtin_amdgcn_exp2f(p0[r]);
}
__device__ __forceinline__ void finishSM(f32x16& p0, f32x16& p1, float alpha, float& l_reg, bf16x8& pa0, bf16x8& pa1, bf16x8& pa2, bf16x8& pa3) {
#pragma unroll
    for (int r = 0; r < 16; ++r) p1[r] = __builtin_amdgcn_exp2f(p1[r]);
    float ps = 0;
#pragma unroll
    for (int r = 0; r < 16; ++r) ps += p0[r];
#pragma unroll
    for (int r = 0; r < 16; ++r) ps += p1[r];
    { auto rr = __builtin_amdgcn_permlane32_swap(__float_as_uint(ps), __float_as_uint(ps), false, false);
      ps = __uint_as_float(rr[0]) + __uint_as_float(rr[1]); }
    l_reg = l_reg * alpha + ps;
#define PK4(P, B_, OUT) do { unsigned a0 = cvtpk(P[B_+0], P[B_+1]), a1 = cvtpk(P[B_+2], P[B_+3]);                          \
        unsigned b0 = cvtpk(P[B_+4], P[B_+5]), b1 = cvtpk(P[B_+6], P[B_+7]);                                             \
        auto r0 = __builtin_amdgcn_permlane32_swap(a0, b0, false, false); auto r1 = __builtin_amdgcn_permlane32_swap(a1, b1, false, false); \
        v4u w = {r0[0], r1[0], r0[1], r1[1]}; OUT = *reinterpret_cast<bf16x8*>(&w); } while (0)
    PK4(p0, 0, pa0); PK4(p0, 8, pa1); PK4(p1, 0, pa2); PK4(p1, 8, pa3);
#undef PK4
}
__device__ __forceinline__ void qkt(f32x16& p0, f32x16& p1, const char* Kb, int r32, int hi, const bf16x8* qr) {
    p0 = f32x16{}; p1 = f32x16{};
    const char* kb[4];
#pragma unroll
    for (int dd = 0; dd < 4; ++dd) kb[dd] = Kb + KSWZ(r32, (dd * 16 + hi * 8) * 2);
#pragma unroll
    for (int g = 0; g < 2; ++g) { bf16x8 b0[6], b1[6];
#pragma unroll
        for (int i = 0; i < 6; ++i) { const int d0 = 6 * g + i; const char* a = kb[d0 & 3] + (d0 >> 2) * 128; b0[i] = *reinterpret_cast<const bf16x8*>(a); b1[i] = *reinterpret_cast<const bf16x8*>(a + 32 * 384); }
        SBAR();
        __builtin_amdgcn_s_setprio(1);
#pragma unroll
        for (int i = 0; i < 6; ++i) { p0 = __builtin_amdgcn_mfma_f32_32x32x16_bf16(b0[i], qr[6 * g + i], p0, 0, 0, 0); p1 = __builtin_amdgcn_mfma_f32_32x32x16_bf16(b1[i], qr[6 * g + i], p1, 0, 0, 0); }
        __builtin_amdgcn_s_setprio(0);
        SBAR(); }
}
__device__ __forceinline__ void pv_tile(f32x16* o, int vb0, bf16x8 pa0, bf16x8 pa1, bf16x8 pa2, bf16x8 pa3) {
#define TRRD(dst, off) asm volatile("ds_read_b64_tr_b16 %0, %1 offset:%2" : "=&v"(dst) : "v"(vb0), "i"(off) : "memory")
#define PV_RD(S, d0) do { constexpr int b_ = (d0) * 512; TRRD(S##l0, b_); TRRD(S##h0, b_ + 2048); TRRD(S##l1, b_ + 4096); TRRD(S##h1, b_ + 6144); TRRD(S##l2, b_ + 8192); TRRD(S##h2, b_ + 10240); TRRD(S##l3, b_ + 12288); TRRD(S##h3, b_ + 14336); } while (0)
#define PV_MM(S, d0) do { \
        o[d0] = __builtin_amdgcn_mfma_f32_32x32x16_bf16(pa0, (bf16x8){S##l0[0], S##l0[1], S##l0[2], S##l0[3], S##h0[0], S##h0[1], S##h0[2], S##h0[3]}, o[d0], 0, 0, 0);   \
        o[d0] = __builtin_amdgcn_mfma_f32_32x32x16_bf16(pa1, (bf16x8){S##l1[0], S##l1[1], S##l1[2], S##l1[3], S##h1[0], S##h1[1], S##h1[2], S##h1[3]}, o[d0], 0, 0, 0);   \
        o[d0] = __builtin_amdgcn_mfma_f32_32x32x16_bf16(pa2, (bf16x8){S##l2[0], S##l2[1], S##l2[2], S##l2[3], S##h2[0], S##h2[1], S##h2[2], S##h2[3]}, o[d0], 0, 0, 0);   \
        o[d0] = __builtin_amdgcn_mfma_f32_32x32x16_bf16(pa3, (bf16x8){S##l3[0], S##l3[1], S##l3[2], S##l3[3], S##h3[0], S##h3[1], S##h3[2], S##h3[3]}, o[d0], 0, 0, 0); } while (0)
    s16x4 Al0, Al1, Al2, Al3, Ah0, Ah1, Ah2, Ah3, Bl0, Bl1, Bl2, Bl3, Bh0, Bh1, Bh2, Bh3;
    PV_RD(A, 0); PV_RD(B, 1);
    asm volatile("s_waitcnt lgkmcnt(8)" ::: "memory"); SBAR(); PV_MM(A, 0); SBAR();
    PV_RD(A, 2);
    asm volatile("s_waitcnt lgkmcnt(8)" ::: "memory"); SBAR(); PV_MM(B, 1); SBAR();
    PV_RD(B, 3);
    asm volatile("s_waitcnt lgkmcnt(8)" ::: "memory"); SBAR(); PV_MM(A, 2); SBAR();
    asm volatile("s_waitcnt lgkmcnt(0)" ::: "memory"); SBAR(); PV_MM(B, 3);
#undef PV_MM
#undef PV_RD
#undef TRRD
}
__device__ __forceinline__ void attn_unit(int b, int h, int qb, const bf16* Q, const bf16* K, const bf16* V, bf16* O, char* lds) {
    const int tid = threadIdx.x, wid = __builtin_amdgcn_readfirstlane(tid >> 6), lane = tid & 63, r32 = lane & 31, hi = lane >> 5;
    const size_t rowb = (size_t)b * SEQ;
    const int q0 = qb * QB, qlo = q0 + wid * QBLK;
    const int NT = (q0 + QB) / KVBLK;
    char* V_lds = lds + OFF_V; char* K_lds = lds + OFF_K;
#define WAVE_WS() ({ int t_ = (int)threadIdx.x; asm volatile("" : "+v"(t_)); (float*)(lds + OFF_WS) + (t_ >> 6) * 64; })
    LAS unsigned char* ldsl_ = (LAS unsigned char*)lds;
    unsigned ksrc[3], vsrc[2];
#pragma unroll
    for (int j = 0; j < 3; ++j) { const int s_ = (wid * 3 + j) * 64 + lane, row = s_ / 24, pc = s_ % 24; ksrc[j] = (unsigned)(row * 3072 * 2 + ((pc * 16) ^ ((row & 7) << 4))); }
#pragma unroll
    for (int j = 0; j < 2; ++j) { const int ob = ((wid * 2 + j) * 64 + lane) * 16, st = ob >> 9, kr_ = (ob >> 6) & 7, ch = (ob >> 4) & 3, c = (st & 3) * 32 + ch * 8, kk = (st >> 2) * 8 + kr_,
                                  k = (kk & ~0xC) | ((kk & 4) << 1) | ((kk & 8) >> 1); vsrc[j] = (unsigned)(k * 2048 * 2 + c * 2); }
    const char* Kh = (const char*)(K + rowb * 3072 + h * DQK); const char* Vh = (const char*)(V + rowb * 2048 + h * DV);
#define KDMA(k0, bf) do { _Pragma("unroll") for (int j = 0; j < 3; ++j) __builtin_amdgcn_global_load_lds((const unsigned*)(Kh + (size_t)(k0) * (3072 * 2) + ksrc[j]), \
        (LAS unsigned*)(ldsl_ + OFF_K + (bf) * SHM_K + (wid * 3 + j) * 1024), 16, 0, 0); } while (0)
#define VDMA(k0, sl) do { _Pragma("unroll") for (int j = 0; j < 2; ++j) __builtin_amdgcn_global_load_lds((const unsigned*)(Vh + (size_t)(k0) * (2048 * 2) + vsrc[j]), \
        (LAS unsigned*)(ldsl_ + OFF_V + (sl) * SHM_V + (wid * 2 + j) * 1024), 16, 0, 0); } while (0)
    KDMA(0, 0); VDMA(0, 0);
    bf16x8 qr[12];
    { const bf16* Qp = Q + (rowb + qlo + r32) * 3072 + h * DQK + hi * 8;
#pragma unroll
      for (int d0 = 0; d0 < 12; ++d0) qr[d0] = *(const bf16x8*)(Qp + d0 * 16); }
    asm volatile("s_waitcnt vmcnt(0)" ::: "memory");
    __syncthreads();
    float m_reg = -1e30f, l_reg = 0.f; f32x16 o[4] = {};
    const int vbase = (int)(uintptr_t)V_lds + v_rd_base(lane);
    const int qm = qlo + r32 - 4 * hi;
    f32x16 p0, p1;
#define SP_STAGE(VS) do { float mn, alpha; bf16x8 pa0, pa1, pa2, pa3; \
        partialSM(p0, p1, m_reg, mn, alpha); finishSM(p0, p1, alpha, l_reg, pa0, pa1, pa2, pa3); \
        if (__any(alpha < 1.f)) { float* al_l = WAVE_WS() + 32; if (hi == 0) al_l[r32] = alpha; asm volatile("s_waitcnt lgkmcnt(0)" ::: "memory"); \
            _Pragma("unroll") for (int d_ = 0; d_ < 4; ++d_) _Pragma("unroll") for (int r = 0; r < 16; ++r) o[d_][r] *= al_l[crow(r, hi)]; } \
        SBAR(); pv_tile(o, vbase + (VS) * SHM_V, pa0, pa1, pa2, pa3); } while (0)
    for (int t = 0; t < NT; ++t) {
        const int cur = t & 1, kb_ = t * KVBLK;
        if (t + 1 < NT) { KDMA((t + 1) * KVBLK, cur ^ 1); VDMA((t + 1) * KVBLK, cur ^ 1); }
        SBAR();
        qkt(p0, p1, K_lds + cur * SHM_K, r32, hi, qr); if (kb_ + KVBLK - 1 > qlo) mask_tile(p0, p1, qm - kb_);
        SBAR();
        SP_STAGE(cur);
        asm volatile("s_waitcnt vmcnt(0)" ::: "memory");
        __syncthreads();
    }
#undef SP_STAGE
    float* li_l = WAVE_WS();
    if (hi == 0) li_l[r32] = l_reg; asm volatile("s_waitcnt lgkmcnt(0)" ::: "memory");
    float rli[16];
#pragma unroll
    for (int r = 0; r < 16; ++r) rli[r] = __builtin_amdgcn_rcpf(li_l[crow(r, hi)]);
    bf16* Ow = O + (rowb + qlo) * 2048 + h * DV;
#pragma unroll
    for (int r = 0; r < 16; ++r) { const int orow = crow(r, hi);
#pragma unroll
        for (int d0 = 0; d0 < 4; ++d0) { const float v = o[d0][r] * rli[r];
            const float vn = __shfl_xor(v, 1);
            if ((r32 & 1) == 0) *(unsigned*)(Ow + (size_t)orow * 2048 + d0 * 32 + r32) = cvtpk(v, vn); } }
    __syncthreads();
#undef KDMA
#undef VDMA
#undef WAVE_WS
}
#undef SBAR
}

struct Args { const float* in[20]; float* out; unsigned char* ws; int ph_lo, ph_hi, coop, pad; };
#define XB_TMO      128
#define XB_XCNT(j)  (256  + 64 * (j))
#define XB_XSUB(j)  (1280 + 64 * (j))
#define XB_XGEN(j)  (2304 + 64 * (j))
#define XB_TOP      3328
#define XB_TOPGEN   3392
#define XCD_BAR_WORDS 3456
#define XB_SPIN_CAP (1u << 20)
__device__ __forceinline__ unsigned xb_ld(unsigned* p)              { return __hip_atomic_load(p, __ATOMIC_RELAXED, __HIP_MEMORY_SCOPE_AGENT); }
__device__ __forceinline__ unsigned xb_add(unsigned* p, unsigned v) { return __hip_atomic_fetch_add(p, v, __ATOMIC_RELAXED, __HIP_MEMORY_SCOPE_AGENT); }
__device__ __forceinline__ unsigned xb_xcc_id() { return (unsigned)__builtin_amdgcn_s_getreg((3 << 11) | 20) & 0xFu; }
#define XB_SPIN(cond, bar) do { unsigned _sp = 0; while (cond) { __builtin_amdgcn_s_sleep(1); \
    if ((++_sp & 255u) == 0u) { if (xb_ld(&(bar)[XB_TMO])) break; if (_sp > XB_SPIN_CAP) { atomicAdd(&(bar)[XB_TMO], 1u); break; } } } } while (0)
__device__ __forceinline__ void xcd_barrier_complete(unsigned* bar, unsigned x, unsigned& nloc, unsigned& nx) {
    const unsigned G = gridDim.x;
    unsigned sum, cnt, mine, sp = 0u;
    for (;;) {
        sum = 0u; cnt = 0u; mine = 0u;
#pragma unroll
        for (unsigned j = 0; j < 16; ++j) { const unsigned c = xb_ld(&bar[XB_XCNT(j)]); sum += c; cnt += (c > 0u) ? 1u : 0u; mine = (j == x) ? c : mine; }
        if (sum == G) break;
        __builtin_amdgcn_s_sleep(1);
        if ((++sp & 255u) == 0u) { if (xb_ld(&bar[XB_TMO])) break; if (sp > XB_SPIN_CAP) { atomicAdd(&bar[XB_TMO], 1u); break; } }
    }
    nloc = mine > 0u ? mine : 1u; nx = cnt > 0u ? cnt : 1u;
}
__device__ __forceinline__ void grid_bar(unsigned* bar, volatile LAS unsigned* st) {
    asm volatile("s_waitcnt vmcnt(0)" ::: "memory");
    __syncthreads();
    if (threadIdx.x == 0) {
        const unsigned x = xb_xcc_id();
        __builtin_amdgcn_s_waitcnt(0);
        unsigned nloc = st[0], nx = st[1];
        if (nloc == 0u) { xcd_barrier_complete(bar, x, nloc, nx); st[0] = nloc; st[1] = nx; }
        const unsigned old = xb_add(&bar[XB_XSUB(x)], 1u);
        const unsigned gen = old / nloc;
        if (old + 1u == (gen + 1u) * nloc) {
            __builtin_amdgcn_fence(__ATOMIC_RELEASE, "agent");
            asm volatile("s_waitcnt vmcnt(0)" ::: "memory");
            const unsigned og = xb_add(&bar[XB_TOP], 1u);
            const unsigned tg = og / nx;
            if (og + 1u == (tg + 1u) * nx) xb_add(&bar[XB_TOPGEN], 1u);
            else XB_SPIN(xb_ld(&bar[XB_TOPGEN]) == tg, bar);
            __builtin_amdgcn_fence(__ATOMIC_ACQUIRE, "agent");
            xb_add(&bar[XB_XGEN(x)], 1u);
            asm volatile("s_waitcnt vmcnt(0)" ::: "memory");
        } else {
            XB_SPIN(xb_ld(&bar[XB_XGEN(x)]) == gen, bar);
            __builtin_amdgcn_fence(__ATOMIC_ACQUIRE, "agent");
            asm volatile("s_waitcnt vmcnt(0)" ::: "memory");
        }
    }
    __syncthreads();
}
constexpr int NPH = 11;

__global__ void __launch_bounds__(NWAVES * 64, 2) mega_fwd(Args args) {
    extern __shared__ __attribute__((aligned(16))) unsigned char lds[];
    LAS unsigned char* ldsl = (LAS unsigned char*)lds;
    const int tid = threadIdx.x, lane = tid & 63, wave = __builtin_amdgcn_readfirstlane(tid >> 6);
    const int G = gridDim.x, bx = blockIdx.x;
    const int vcu = (G % 8 == 0) ? (bx % 8) * (G / 8) + bx / 8 : bx;
    const int gw = vcu * NWAVES + wave, NGW = G * NWAVES;
    unsigned char* ws = args.ws;
    const float* const* kin = (const float* const*)__builtin_amdgcn_kernarg_segment_ptr();
    const float* svec = (const float*)ws;
    const float* b_gate = svec + SV_BGATE; const float* q_a_norm_g = svec + SV_QAG; const float* kv_a_norm_g = svec + SV_KVAG; const float* q_norm_g = svec + SV_QNG;
    const float* k_norm_g = svec + SV_KNG; const float* pool_scale = svec + SV_PSC; const float* ffn_norm_g = svec + SV_FNG; const int* positions = (const int*)(svec + SV_POS);
    bf16* WIN_T = (bf16*)(ws + WS_WIN); bf16* WQB_T = (bf16*)(ws + WS_WQB); bf16* WKVB_T = (bf16*)(ws + WS_WKVB); bf16* WPG_T = (bf16*)(ws + WS_WPG);
    bf16* WPO_T = (bf16*)(ws + WS_WPO); bf16* WAO_T = (bf16*)(ws + WS_WAO); bf16* WOUT_T = (bf16*)(ws + WS_WOUT); bf16* WGU_T = (bf16*)(ws + WS_WGU); bf16* WDN_T = (bf16*)(ws + WS_WDN);
    bf16* XN = (bf16*)(ws + WS_XN); bf16* C1 = (bf16*)(ws + WS_C1); float* KRP = (float*)(ws + WS_KRP); bf16* U = (bf16*)(ws + WS_U); bf16* Gt = (bf16*)(ws + WS_G);
    bf16* CN = (bf16*)(ws + WS_CN); bf16* POOLED = (bf16*)(ws + WS_POOLED); bf16* Qb = (bf16*)(ws + WS_Q); bf16* Kb = (bf16*)(ws + WS_K); bf16* Vb = (bf16*)(ws + WS_V);
    bf16* PG = (bf16*)(ws + WS_PG); bf16* MP = (bf16*)(ws + WS_MP); bf16* Ob = (bf16*)(ws + WS_O); bf16* MIXED = (bf16*)(ws + WS_MIXED);
    float* X1 = (float*)(ws + WS_X1); bf16* H2 = (bf16*)(ws + WS_H2); bf16* ACT = (bf16*)(ws + WS_ACT);

    const int lo = args.ph_lo, hi_ph = args.ph_hi;
#ifndef PHMASK
#define PHMASK 0x7ff
#endif
#define IN(k) (((PHMASK >> (k)) & 1) && lo <= (k) && (k) < hi_ph)
#define SEAM(k) do { if (IN(k) && IN((k) + 1)) { unsigned char* w2_ = args.ws; asm volatile("" : "+s"(w2_)); grid_bar((unsigned*)(w2_ + WS_BAR), (volatile LAS unsigned*)(ldsl + 140032)); } } while (0)
    if (args.coop > 1) cg::this_grid().sync();
    if (threadIdx.x < 2) ((volatile LAS unsigned*)(ldsl + 140032))[threadIdx.x] = 0u;
    __syncthreads();
    if (args.coop && threadIdx.x == 0) { unsigned char* w2_ = args.ws; asm volatile("" : "+s"(w2_)); (void)xb_add(&((unsigned*)(w2_ + WS_BAR))[XB_XCNT(xb_xcc_id())], 1u); }
    LAS float* scr = (LAS float*)(ldsl + wave * 16384);
#ifdef TPROBE
#define TP_BEGIN(k) do { if ((TPROBE >> (k)) & 1) { if (blockIdx.x == 0 && threadIdx.x == 0) { *(volatile LAS unsigned*)(ldsl + 140000) = (unsigned)__builtin_amdgcn_s_memrealtime(); } } } while (0)
#define TP_END(k) do { if ((TPROBE >> (k)) & 1) { if (blockIdx.x == 0 && threadIdx.x == 0) { volatile LAS unsigned* tp_ = (volatile LAS unsigned*)(ldsl + 140000); tp_[1] += (unsigned)__builtin_amdgcn_s_memrealtime() - tp_[0]; } } } while (0)
    if (blockIdx.x == 0 && threadIdx.x == 0) { ((volatile LAS unsigned*)(ldsl + 140000))[1] = 0u; }
#else
#define TP_BEGIN(k) do {} while (0)
#define TP_END(k) do {} while (0)
#endif

    if (IN(0)) { TP_BEGIN(0);
        { float* sv = (float*)ws; const int gt = bx * (NWAVES * 64) + tid, GT = G * NWAVES * 64;
          for (int i = gt; i < M; i += GT) sv[SV_SS + i] = 0.f;
          for (int i = gt; i < SV_END; i += GT) { int idx, off, lim = 1 << 30;
              if (i < SV_QAG) { idx = 4; off = SV_BGATE; } else if (i < SV_KVAG) { idx = 5; off = SV_QAG; } else if (i < SV_QNG) { idx = 7; off = SV_KVAG; }
              else if (i < SV_KNG) { idx = 9; off = SV_QNG; lim = 192; } else if (i < SV_PSC) { idx = 10; off = SV_KNG; lim = 192; }
              else if (i < SV_FNG) { idx = 13; off = SV_PSC; } else if (i < SV_POS) { idx = 16; off = SV_FNG; } else { idx = 1; off = SV_POS; }
              const float* src = kin[idx]; sv[i] = (i - off < lim) ? src[i - off] : 0.f; } }
        constexpr int I_IN = (DM / 64) * (DIN / 32), I_QB = (QLORA / 64) * (NH * DQK / 32), I_KVB = (KVLORA / 64) * (NH * 256 / 32), I_PG = (256 / 64) * (256 / 32),
                      I_PO = (POOLW / 64) * (DM / 32), I_AO = (DM / 64) * (DM / 32), I_OUT = I_AO;
        constexpr int NITEMS = I_IN + I_QB + I_KVB + 4 * I_PG + I_PO + I_AO + I_OUT;
#define P0_DESC(it__) ([&]() { int r = (it__), idx, Kd, Nd, mode = 0, roff = 0; size_t dsto, srco = 0; \
            if (r < I_IN) { idx = 3; Kd = DM; Nd = DIN; mode = 1; dsto = WS_WIN; } \
            else if ((r -= I_IN) < I_QB) { idx = 6; Kd = QLORA; Nd = NH * DQK; dsto = WS_WQB; } \
            else if ((r -= I_QB) < I_KVB) { idx = 8; Kd = KVLORA; Nd = NH * 256; dsto = WS_WKVB; } \
            else if ((r -= I_KVB) < 4 * I_PG) { const int g = r / I_PG; r = r % I_PG; idx = 12; Kd = 256; Nd = 256; dsto = WS_WPG; roff = g * 256; srco = (size_t)g * 65536; } \
            else if ((r -= 4 * I_PG) < I_PO) { idx = 14; Kd = POOLW; Nd = DM; dsto = WS_WPO; } \
            else if ((r -= I_PO) < I_AO) { idx = 11; Kd = DM; Nd = DM; dsto = WS_WAO; } \
            else { r -= I_AO; idx = 15; Kd = DM; Nd = DM; dsto = WS_WOUT; } \
            return tr_desc(kin[idx] + srco, Kd, Nd, (bf16*)(ws + dsto), mode, roff, r, nullptr); }())
        TR_PIPELINE(gw, NITEMS, NGW, P0_DESC);
#undef P0_DESC
        { v4u* z = (v4u*)(WIN_T + (size_t)DIN * DM); const int nz = (DIN_PAD - DIN) * DM / 8;
          for (int i = gw * 64 + lane; i < nz; i += NGW * 64) z[i] = (v4u){0u, 0u, 0u, 0u}; }
        { const float* x = kin[0]; const float* attn_norm_g = kin[2];
          for (int m = gw; m < M; m += NGW) rms_row_2048(x + (size_t)m * DM, attn_norm_g, XN + (size_t)m * DM, lane); }
    TP_END(0); }
    SEAM(0);
    if (IN(1)) { TP_BEGIN(1);
        { pg8::Gemm g{XN, WIN_T, M, 6144, DM, DM, DM, 0, 0}; pg8::StaticOrder S; S.init(M, 6144, G, bx);
          pg8::EpiIn E{C1, U, Gt, b_gate};
          pg8::gemm_phase<pg8::EpiIn, pg8::StaticOrder>(ldsl, g, S, E); }
        { pg8::Gemm g{XN, WIN_T + (size_t)6144 * DM, M, 2048, 256, DM, DM, 256, 256}; pg8::StaticOrder S; S.init(M, 2048, G, bx);
          pg8::EpiKRP E{KRP};
          pg8::gemm_phase<pg8::EpiKRP, pg8::StaticOrder>(ldsl, g, S, E); }
    TP_END(1); }
    SEAM(1);
    if (IN(2)) { TP_BEGIN(2);
        for (int m = gw; m < M; m += NGW) {
            const v4u cq = __builtin_nontemporal_load((const v4u*)(C1 + (size_t)m * 1024 + 8 * lane)), ck = __builtin_nontemporal_load((const v4u*)(C1 + (size_t)m * 1024 + 512 + 8 * lane));
            const float fq_[8] = {bflo(cq.x), bfhi(cq.x), bflo(cq.y), bfhi(cq.y), bflo(cq.z), bfhi(cq.z), bflo(cq.w), bfhi(cq.w)};
            const float fk_[8] = {bflo(ck.x), bfhi(ck.x), bflo(ck.y), bfhi(ck.y), bflo(ck.z), bfhi(ck.z), bflo(ck.w), bfhi(ck.w)};
            float sq = 0.f, skv = 0.f;
#pragma unroll
            for (int e = 0; e < 8; ++e) { sq += fq_[e] * fq_[e]; skv += fk_[e] * fk_[e]; }
            const float iq = 1.0f / sqrtf(wave_sum(sq) * (1.f / 512.f) + EPS), ikv = 1.0f / sqrtf(wave_sum(skv) * (1.f / 512.f) + EPS);
            if (lane < 16) { f32x4 acc4 = {0.f, 0.f, 0.f, 0.f};
#pragma unroll
                for (int ks = 0; ks < 8; ++ks) acc4 += __builtin_nontemporal_load((const f32x4*)(KRP + ((size_t)ks * 8192 + m) * 64 + 4 * lane));
                *(f32x4*)((float*)(ws + WS_KR) + (size_t)m * 64 + 4 * lane) = acc4; }
            const f32x4 gq0 = ((const f32x4*)q_a_norm_g)[2 * lane], gq1 = ((const f32x4*)q_a_norm_g)[2 * lane + 1], gk0 = ((const f32x4*)kv_a_norm_g)[2 * lane], gk1 = ((const f32x4*)kv_a_norm_g)[2 * lane + 1];
            v4u oq, ok;
            oq.x = cvtpk(fq_[0] * iq * gq0.x, fq_[1] * iq * gq0.y); oq.y = cvtpk(fq_[2] * iq * gq0.z, fq_[3] * iq * gq0.w); oq.z = cvtpk(fq_[4] * iq * gq1.x, fq_[5] * iq * gq1.y); oq.w = cvtpk(fq_[6] * iq * gq1.z, fq_[7] * iq * gq1.w);
            ok.x = cvtpk(fk_[0] * ikv * gk0.x, fk_[1] * ikv * gk0.y); ok.y = cvtpk(fk_[2] * ikv * gk0.z, fk_[3] * ikv * gk0.w); ok.z = cvtpk(fk_[4] * ikv * gk1.x, fk_[5] * ikv * gk1.y); ok.w = cvtpk(fk_[6] * ikv * gk1.z, fk_[7] * ikv * gk1.w);
            *(v4u*)(CN + (size_t)m * 1024 + 8 * lane) = oq; *(v4u*)(CN + (size_t)m * 1024 + 512 + 8 * lane) = ok;
        }
        for (int base = gw * 4; base < M; base += NGW * 4) {
            const int s0 = base & (SEQ - 1);
#pragma unroll
            for (int jj = 0; jj < 2; ++jj) {
                const int col = 8 * lane + 512 * jj, grp = col >> 8, w = 2 << grp; int cnt = (s0 + 1 < w) ? s0 + 1 : w;
                float a[8], uc[8];
#pragma unroll
                for (int e = 0; e < 8; ++e) a[e] = 0.f;
#pragma unroll
                for (int d = 0; d < 16; ++d) {
                    if (d < cnt) { const v4u q = *(const v4u*)(U + (size_t)(base - d) * 1024 + col);
                        const float f[8] = {bflo(q.x), bfhi(q.x), bflo(q.y), bfhi(q.y), bflo(q.z), bfhi(q.z), bflo(q.w), bfhi(q.w)};
#pragma unroll
                        for (int e = 0; e < 8; ++e) { a[e] += f[e]; if (d == 0) uc[e] = f[e]; } }
                }
#pragma unroll
                for (int i = 0; i < 4; ++i) {
                    const int m = base + i;
                    if (i > 0) { const int s = s0 + i;
                        { const v4u q = *(const v4u*)(U + (size_t)m * 1024 + col);
                          uc[0] = bflo(q.x); uc[1] = bfhi(q.x); uc[2] = bflo(q.y); uc[3] = bfhi(q.y); uc[4] = bflo(q.z); uc[5] = bfhi(q.z); uc[6] = bflo(q.w); uc[7] = bfhi(q.w); }
#pragma unroll
                        for (int e = 0; e < 8; ++e) a[e] += uc[e];
                        if (s >= w) { const v4u q = *(const v4u*)(U + (size_t)(m - w) * 1024 + col);
                            a[0] -= bflo(q.x); a[1] -= bfhi(q.x); a[2] -= bflo(q.y); a[3] -= bfhi(q.y); a[4] -= bflo(q.z); a[5] -= bfhi(q.z); a[6] -= bflo(q.w); a[7] -= bfhi(q.w); }
                        cnt = (s + 1 < w) ? s + 1 : w; }
                    const float rc = 1.0f / (float)cnt;
                    v4u o; o.x = cvtpk(a[0] * rc - uc[0], a[1] * rc - uc[1]); o.y = cvtpk(a[2] * rc - uc[2], a[3] * rc - uc[3]);
                    o.z = cvtpk(a[4] * rc - uc[4], a[5] * rc - uc[5]); o.w = cvtpk(a[6] * rc - uc[6], a[7] * rc - uc[7]);
                    *(v4u*)(POOLED + (size_t)m * 1024 + col) = o;
                }
            }
        }
    TP_END(2); }
    SEAM(2);
    if (IN(3)) { TP_BEGIN(3);
        { pg8::Gemm g{CN, WQB_T, M, NH * DQK, QLORA, 1024, QLORA, 0, 0}; pg8::StaticOrder S; S.init(M, NH * DQK, G, bx);
          pg8::EpiBf16 E{Qb, 3072}; pg8::gemm_phase<pg8::EpiBf16, pg8::StaticOrder>(ldsl, g, S, E); }
        { pg8::Gemm g{CN + 512, WKVB_T, M, NH * 256, KVLORA, 1024, KVLORA, 0, 0}; pg8::StaticOrder S; S.init(M, NH * 256, G, bx);
          pg8::EpiKV E{Kb, Vb}; pg8::gemm_phase<pg8::EpiKV, pg8::StaticOrder>(ldsl, g, S, E); }
        { pg8::Gemm g{POOLED, WPG_T, M, POOLW, 256, 1024, 256, 256, 0}; pg8::StaticOrder S; S.init(M, POOLW, G, (bx + 128) % G);
          pg8::EpiScale E{PG, 1024, pool_scale}; pg8::gemm_phase<pg8::EpiScale, pg8::StaticOrder>(ldsl, g, S, E); }
    TP_END(3); }
    SEAM(3);
    if (IN(4)) { TP_BEGIN(4);
        for (int m = gw; m < M; m += NGW) {
            const float pos = (float)positions[m];
            const int sub = lane & 3, h = lane >> 2;
            float cs[8], sn[8];
#pragma unroll
            for (int j = 0; j < 8; ++j) { const int i = 8 * sub + j; const float invf = __builtin_amdgcn_exp2f(-(float)i * (13.287712379549449f / 32.f));
                const float ang = pos * invf; const float k = rintf(ang * 0.15915494309189535f);
                float r = fmaf(-k, 6.2831854820251465f, ang); r = fmaf(-k, -1.7484555e-7f, r);
                sn[j] = __sinf(r); cs[j] = __cosf(r); }
#pragma unroll
            for (int which = 0; which < 2; ++which) {
                bf16* base = (which == 0 ? Qb : Kb) + (size_t)m * 3072 + h * DQK;
                const float* gn = (which == 0) ? q_norm_g : k_norm_g;
                float nv[32], rl[8], rh[8]; float ss = 0.f;
#pragma unroll
                for (int jj = 0; jj < 4; ++jj) { const v4u q = *(const v4u*)(base + 32 * sub + 8 * jj);
                    nv[8 * jj + 0] = bflo(q.x); nv[8 * jj + 1] = bfhi(q.x); nv[8 * jj + 2] = bflo(q.y); nv[8 * jj + 3] = bfhi(q.y);
                    nv[8 * jj + 4] = bflo(q.z); nv[8 * jj + 5] = bfhi(q.z); nv[8 * jj + 6] = bflo(q.w); nv[8 * jj + 7] = bfhi(q.w); }
                if (which == 0) {
                    const v4u a = *(const v4u*)(base + 128 + 8 * sub), b = *(const v4u*)(base + 160 + 8 * sub);
                    rl[0] = bflo(a.x); rl[1] = bfhi(a.x); rl[2] = bflo(a.y); rl[3] = bfhi(a.y); rl[4] = bflo(a.z); rl[5] = bfhi(a.z); rl[6] = bflo(a.w); rl[7] = bfhi(a.w);
                    rh[0] = bflo(b.x); rh[1] = bfhi(b.x); rh[2] = bflo(b.y); rh[3] = bfhi(b.y); rh[4] = bflo(b.z); rh[5] = bfhi(b.z); rh[6] = bflo(b.w); rh[7] = bfhi(b.w);
                } else {
                    const float* kp = (const float*)(ws + WS_KR) + (size_t)m * 64 + 8 * sub;
                    const f32x4 a0 = *(const f32x4*)kp, a1 = *(const f32x4*)(kp + 4), b0 = *(const f32x4*)(kp + 32), b1 = *(const f32x4*)(kp + 36);
                    rl[0] = a0.x; rl[1] = a0.y; rl[2] = a0.z; rl[3] = a0.w; rl[4] = a1.x; rl[5] = a1.y; rl[6] = a1.z; rl[7] = a1.w;
                    rh[0] = b0.x; rh[1] = b0.y; rh[2] = b0.z; rh[3] = b0.w; rh[4] = b1.x; rh[5] = b1.y; rh[6] = b1.z; rh[7] = b1.w;
                }
#pragma unroll
                for (int e = 0; e < 32; ++e) ss += nv[e] * nv[e];
#pragma unroll
                for (int e = 0; e < 8; ++e) ss += rl[e] * rl[e] + rh[e] * rh[e];
                ss += __shfl_xor(ss, 1); ss += __shfl_xor(ss, 2);
                const float inv = 1.0f / sqrtf(ss * (1.f / 192.f) + EPS);
#pragma unroll
                for (int jj = 0; jj < 4; ++jj) { const f32x4 g0 = *(const f32x4*)(gn + 32 * sub + 8 * jj), g1 = *(const f32x4*)(gn + 32 * sub + 8 * jj + 4);
                    v4u o; o.x = cvtpk(nv[8 * jj + 0] * inv * g0.x, nv[8 * jj + 1] * inv * g0.y); o.y = cvtpk(nv[8 * jj + 2] * inv * g0.z, nv[8 * jj + 3] * inv * g0.w);
                    o.z = cvtpk(nv[8 * jj + 4] * inv * g1.x, nv[8 * jj + 5] * inv * g1.y); o.w = cvtpk(nv[8 * jj + 6] * inv * g1.z, nv[8 * jj + 7] * inv * g1.w);
                    *(v4u*)(base + 32 * sub + 8 * jj) = o; }
                float ol[8], oh[8];
#pragma unroll
                for (int e = 0; e < 8; ++e) { const float a = rl[e] * inv * gn[128 + 8 * sub + e], b = rh[e] * inv * gn[160 + 8 * sub + e];
                    ol[e] = a * cs[e] - b * sn[e]; oh[e] = b * cs[e] + a * sn[e]; }
                v4u o1, o2; o1.x = cvtpk(ol[0], ol[1]); o1.y = cvtpk(ol[2], ol[3]); o1.z = cvtpk(ol[4], ol[5]); o1.w = cvtpk(ol[6], ol[7]);
                o2.x = cvtpk(oh[0], oh[1]); o2.y = cvtpk(oh[2], oh[3]); o2.z = cvtpk(oh[4], oh[5]); o2.w = cvtpk(oh[6], oh[7]);
                *(v4u*)(base + 128 + 8 * sub) = o1; *(v4u*)(base + 160 + 8 * sub) = o2;
            }
        }
        { pg8::Gemm g{PG, WPO_T, M, DM, POOLW, POOLW, POOLW, 0, 0}; pg8::StaticOrder S; S.init(M, DM, G, bx);
          pg8::EpiGate<false> E{MP, Gt, nullptr, 0}; pg8::gemm_phase<pg8::EpiGate<false>, pg8::StaticOrder>(ldsl, g, S, E); }
    TP_END(4); }
    SEAM(4);
    if (IN(5)) { TP_BEGIN(5);
        const int npair = BATCH * NH * 8;
        for (int p = vcu; p < npair; p += G) {
            const int bh = p >> 3, s = p & 7;
            att::attn_unit(bh / NH, bh % NH, 15 - s, Qb, Kb, Vb, Ob, (char*)lds);
            att::attn_unit(bh / NH, bh % NH, s, Qb, Kb, Vb, Ob, (char*)lds);
        }
    TP_END(5); }
    SEAM(5);
    if (IN(6)) { TP_BEGIN(6);
        pg8::Gemm g{Ob, WAO_T, M, DM, DM, DM, DM, 0, 0}; pg8::StaticOrder S; S.init(M, DM, G, bx);
        pg8::EpiGate<true> E{MIXED, Gt, MP, 2048}; pg8::gemm_phase<pg8::EpiGate<true>, pg8::StaticOrder>(ldsl, g, S, E);
    TP_END(6); }
    SEAM(6);
    if (IN(7)) { TP_BEGIN(7);
        { constexpr int I_G = (DM / 64) * (DFF / 32);
#define GU_DESC(it__) ((it__) < I_G ? tr_desc(kin[17], DM, DFF, (bf16*)(ws + WS_WGU), 2, 0, (it__), ffn_norm_g) : tr_desc(kin[18], DM, DFF, (bf16*)(ws + WS_WGU), 3, 0, (it__) - I_G, ffn_norm_g))
          TR_PIPELINE(gw, 2 * I_G, NGW, GU_DESC);
#undef GU_DESC
          __syncthreads(); }
        pg8::Gemm g{MIXED, WOUT_T, M, DM, DM, DM, DM, 0, 0}; pg8::StaticOrder S; S.init(M, DM, G, bx);
        pg8::EpiResNorm E{kin[0], X1, (bf16*)(ws + WS_X1B), (float*)ws + SV_SS, DM}; pg8::gemm_phase<pg8::EpiResNorm, pg8::StaticOrder>(ldsl, g, S, E);
    TP_END(7); }
    SEAM(7);
    if (IN(9)) { TP_BEGIN(9);
        pg8::Gemm g{(bf16*)(ws + WS_X1B), WGU_T, M, 2 * DFF, DM, DM, DM, 0, 0}; pg8::StaticOrder S; S.init(M, 2 * DFF, G, bx);
        pg8::EpiSwiGLU E{ACT, DFF, (const float*)ws + SV_SS}; pg8::gemm_phase<pg8::EpiSwiGLU, pg8::StaticOrder>(ldsl, g, S, E);
        if (G == 256 ? (bx >= 128) : true) {
            constexpr int I_D2 = (DFF / 64) * (DM / 32);
            const int nw = (G == 256) ? 128 * NWAVES : NGW, w0 = (G == 256) ? (bx - 128) * NWAVES + wave : gw;
#define DN_DESC(it__) tr_desc(kin[19], DFF, DM, (bf16*)(ws + WS_WDN), 0, 0, (it__), nullptr)
            TR_PIPELINE(w0, I_D2, nw, DN_DESC);
#undef DN_DESC
        }
    TP_END(9); }
    SEAM(9);
    if (IN(10)) { TP_BEGIN(10);
        pg8::Gemm g{ACT, WDN_T, M, DM, DFF, DFF, DFF, 0, 0}; pg8::StaticOrder S; S.init(M, DM, G, bx);
        pg8::EpiRes E{(const bf16*)(ws + WS_X1B), args.out, DM}; pg8::gemm_phase<pg8::EpiRes, pg8::StaticOrder>(ldsl, g, S, E);
    TP_END(10); }
#ifdef TPROBE
    if (blockIdx.x == 0 && threadIdx.x == 0) { const unsigned w_ = 4u * ((volatile LAS unsigned*)(ldsl + 140000))[1]; const unsigned long long t0_ = __builtin_amdgcn_s_memrealtime(); while ((unsigned)(__builtin_amdgcn_s_memrealtime() - t0_) < w_) __builtin_amdgcn_s_sleep(8); }
#endif
#undef IN
#undef SEAM
}

extern "C" void kernel_launch(void* const* d_in, const int* in_sizes, int n_in, void* d_out, int out_size, void* d_ws, size_t ws_size, hipStream_t stream) {
    static int grid = 0;
    if (grid == 0) {
        if (n_in != 20 || out_size != M * DM || ws_size < WS_END) { fprintf(stderr, "kernel_launch: unexpected shapes (n_in %d, out %d, ws %zu)\n", n_in, out_size, ws_size); grid = -1; return; }
        int dev = 0, cus = 0, per_cu = 0;
        (void)hipGetDevice(&dev); (void)hipDeviceGetAttribute(&cus, hipDeviceAttributeMultiprocessorCount, dev);
        if (hipFuncSetAttribute((const void*)mega_fwd, hipFuncAttributeMaxDynamicSharedMemorySize, LDS_BYTES) != hipSuccess) { fprintf(stderr, "kernel_launch: hipFuncSetAttribute failed\n"); grid = -1; return; }
        if (hipOccupancyMaxActiveBlocksPerMultiprocessor(&per_cu, (const void*)mega_fwd, NWAVES * 64, LDS_BYTES) != hipSuccess || per_cu < 1) { fprintf(stderr, "kernel_launch: occupancy query says %d\n", per_cu); per_cu = 1; }
        (void)hipGetLastError();
        grid = cus > 0 ? cus : 256;
    }
    if (grid < 0) return;
    Args a{};
    for (int i = 0; i < 20; ++i) a.in[i] = (const float*)d_in[i];
    a.out = (float*)d_out; a.ws = (unsigned char*)d_ws;
    if (MK_N_LAUNCHES == 1) {
        a.ph_lo = 0; a.ph_hi = NPH; a.coop = 1;
        (void)hipMemsetAsync((char*)d_ws + WS_BAR, 0, 16384, stream);
        void* kargs[] = {&a};
        hipError_t e = hipLaunchCooperativeKernel((const void*)mega_fwd, dim3(grid), dim3(NWAVES * 64), kargs, LDS_BYTES, stream);
        if (e != hipSuccess) fprintf(stderr, "kernel_launch: cooperative launch failed: %s (grid %d)\n", hipGetErrorString(e), grid);
    } else {
        for (int p = 0; p < NPH; ++p) {
            a.ph_lo = p; a.ph_hi = p + 1;
            hipLaunchKernelGGL(mega_fwd, dim3(grid), dim3(NWAVES * 64), LDS_BYTES, stream, a);
        }
    }
}
```

```cpp
#include <hip/hip_runtime.h>
#include <hip/hip_cooperative_groups.h>
#include <cstdio>
#include <cstdint>
namespace cg = cooperative_groups;

#ifndef MK_N_LAUNCHES
#define MK_N_LAUNCHES 1
#endif

namespace pg8 {
#define PG8_LAS __attribute__((address_space(3)))
typedef unsigned short bf16_t;
typedef short bf16x8 __attribute__((ext_vector_type(8)));
typedef float f32x4 __attribute__((ext_vector_type(4)));
typedef unsigned u32x4 __attribute__((ext_vector_type(4)));
constexpr int BM = 256, BK = 64, HALF = 128, HTB = HALF * BK * 2, STAGE_BYTES = 8 * HTB, NXCD = 8, WGM = 8;

__host__ __device__ __forceinline__ int lds_byte(int r, int c) { const int st = (r >> 4) * 2 + (c >> 5), rr = r & 15, cc = c & 31, ob = rr * 64 + cc * 2; return st * 1024 + (ob ^ (((ob >> 9) & 1) << 5)); }
__host__ __device__ __forceinline__ void stage_rc(int b, int& R, int& C) { const int st = b / 1024, sb = b % 1024, swz = sb ^ (((sb >> 9) & 1) << 5); R = (st >> 1) * 16 + swz / 64; C = (st & 1) * 32 + (swz % 64) / 2; }
__host__ __device__ __forceinline__ int perm32(int rho) { const int n = rho >> 4, i = rho & 15; return 8 * (i >> 2) + 4 * n + (i & 3); }

struct Unit { int pm, pn; };
struct Gemm { const bf16_t* A; const bf16_t* Bt; int M, N, K, lda, ldb, a_pn_step, b_pn_step; };

struct StaticOrder {
    int nM, nN, nwg, G, c;
    __host__ __device__ void init(int M, int N, int G_, int c_) { nM = M / BM; nN = N / BM; nwg = nM * nN; G = G_; c = c_; }
    __host__ __device__ bool next(int i, Unit& u) const {
        const long L = (long)i * G + c; if (L >= nwg) return false;
        int wgid = (int)L; { const int q = nwg / NXCD, r = nwg % NXCD, xcd = wgid % NXCD, off = wgid / NXCD; wgid = (xcd < r ? xcd * (q + 1) : r * (q + 1) + (xcd - r) * q) + off; }
        const int nig = WGM * nN, gid = wgid / nig, fm = gid * WGM, gsz = (nM - fm) < WGM ? (nM - fm) : WGM;
        u.pm = fm + ((wgid % nig) % gsz); u.pn = (wgid % nig) / gsz; return true;
    }
};

typedef float f32x2_t_ __attribute__((ext_vector_type(2))); typedef __bf16 bf16x2_t_ __attribute__((ext_vector_type(2)));
__device__ __forceinline__ unsigned cvt_pk_bf16(float lo, float hi) { f32x2_t_ v = {lo, hi}; bf16x2_t_ b = __builtin_convertvector(v, bf16x2_t_); return __builtin_bit_cast(unsigned, b); }
__device__ __forceinline__ u32x4 pack8(f32x4 a, f32x4 b) { u32x4 w; w.x = cvt_pk_bf16(a[0], a[1]); w.y = cvt_pk_bf16(a[2], a[3]); w.z = cvt_pk_bf16(b[0], b[1]); w.w = cvt_pk_bf16(b[2], b[3]); return w; }
__device__ __forceinline__ void unpack8(u32x4 w, f32x4& a, f32x4& b) {
    a[0] = __uint_as_float(w.x << 16); a[1] = __uint_as_float(w.x & 0xffff0000u); a[2] = __uint_as_float(w.y << 16); a[3] = __uint_as_float(w.y & 0xffff0000u);
    b[0] = __uint_as_float(w.z << 16); b[1] = __uint_as_float(w.z & 0xffff0000u); b[2] = __uint_as_float(w.w << 16); b[3] = __uint_as_float(w.w & 0xffff0000u); }
__device__ __forceinline__ float sigmoidf_(float v) { return __builtin_amdgcn_rcpf(1.0f + __builtin_amdgcn_exp2f(-1.4426950408889634f * v)); }
__device__ __forceinline__ f32x4 sigmoid4(f32x4 v) { f32x4 o; o[0] = sigmoidf_(v[0]); o[1] = sigmoidf_(v[1]); o[2] = sigmoidf_(v[2]); o[3] = sigmoidf_(v[3]); return o; }

typedef f32x4 AccT[2][2][4][2];
#define EPI_LOOP_AM _Pragma("unroll") for (int ai = 0; ai < 2; ++ai) _Pragma("unroll") for (int m = 0; m < 4; ++m)
#define EPI_LOOP_B _Pragma("unroll") for (int bj = 0; bj < 2; ++bj)

struct EpiIn {
    static constexpr bool PERM = true;
    bf16_t* C1; bf16_t* U; bf16_t* G; const float* bgate;
    __device__ __forceinline__ void operator()(const AccT& acc, const Unit& u, int wr, int wc, int fr, int fq) const {
        const int row0 = u.pm * BM + wr * 64 + fr, pn = u.pn, cw = wc * 32 + 8 * fq;
        if (pn < 4) {
            EPI_LOOP_AM { bf16_t* rp = C1 + (size_t)(row0 + ai * HALF + m * 16) * 1024 + pn * 256 + cw;
                EPI_LOOP_B { *(u32x4*)(rp + bj * HALF) = pack8(acc[ai][bj][m][0], acc[ai][bj][m][1]); } }
        } else if (pn < 8) {
            EPI_LOOP_AM { bf16_t* rp = U + (size_t)(row0 + ai * HALF + m * 16) * 1024 + (pn - 4) * 256 + cw;
                EPI_LOOP_B { *(u32x4*)(rp + bj * HALF) = pack8(acc[ai][bj][m][0], acc[ai][bj][m][1]); } }
        } else {
            const int gc = (pn - 8) * 256 + cw; f32x4 bv[2][2];
            EPI_LOOP_B { bv[bj][0] = *(const f32x4*)(bgate + gc + bj * HALF); bv[bj][1] = *(const f32x4*)(bgate + gc + bj * HALF + 4); }
            EPI_LOOP_AM { bf16_t* rp = G + (size_t)(row0 + ai * HALF + m * 16) * 4096 + gc;
                EPI_LOOP_B { *(u32x4*)(rp + bj * HALF) = pack8(sigmoid4(acc[ai][bj][m][0] + bv[bj][0]), sigmoid4(acc[ai][bj][m][1] + bv[bj][1])); } }
        }
    }
};
struct EpiKRP {
    static constexpr bool PERM = true;
    float* KRP;
    __device__ __forceinline__ void operator()(const AccT& acc, const Unit& u, int wr, int wc, int fr, int fq) const {
        const int row0 = u.pm * BM + wr * 64 + fr, cw = wc * 32 + 8 * fq;
        if (wc < 2) { EPI_LOOP_AM { float* rp = KRP + ((size_t)u.pn * 8192 + (row0 + ai * HALF + m * 16)) * 64 + cw; *(f32x4*)rp = acc[ai][0][m][0]; *(f32x4*)(rp + 4) = acc[ai][0][m][1]; } }
    }
};
struct EpiBf16 {
    static constexpr bool PERM = true;
    bf16_t* O; int ldc;
    __device__ __forceinline__ void operator()(const AccT& acc, const Unit& u, int wr, int wc, int fr, int fq) const {
        const int row0 = u.pm * BM + wr * 64 + fr, col0 = u.pn * BM + wc * 32 + 8 * fq;
        EPI_LOOP_AM { bf16_t* rp = O + (size_t)(row0 + ai * HALF + m * 16) * ldc + col0;
            EPI_LOOP_B { *(u32x4*)(rp + bj * HALF) = pack8(acc[ai][bj][m][0], acc[ai][bj][m][1]); } }
    }
};
struct EpiKV {
    static constexpr bool PERM = true;
    bf16_t* K; bf16_t* V;
    __device__ __forceinline__ void operator()(const AccT& acc, const Unit& u, int wr, int wc, int fr, int fq) const {
        const int row0 = u.pm * BM + wr * 64 + fr, cw = wc * 32 + 8 * fq, h = u.pn;
        EPI_LOOP_AM { const size_t row = (size_t)(row0 + ai * HALF + m * 16);
            *(u32x4*)(K + row * 3072 + h * 192 + cw) = pack8(acc[ai][0][m][0], acc[ai][0][m][1]);
            *(u32x4*)(V + row * 2048 + h * 128 + cw) = pack8(acc[ai][1][m][0], acc[ai][1][m][1]); }
    }
};
struct EpiScale {
    static constexpr bool PERM = true;
    bf16_t* O; int ldc; const float* scale;
    __device__ __forceinline__ void operator()(const AccT& acc, const Unit& u, int wr, int wc, int fr, int fq) const {
        const int row0 = u.pm * BM + wr * 64 + fr, col0 = u.pn * BM + wc * 32 + 8 * fq; f32x4 sv[2][2];
        EPI_LOOP_B { sv[bj][0] = *(const f32x4*)(scale + col0 + bj * HALF); sv[bj][1] = *(const f32x4*)(scale + col0 + bj * HALF + 4); }
        EPI_LOOP_AM { bf16_t* rp = O + (size_t)(row0 + ai * HALF + m * 16) * ldc + col0;
            EPI_LOOP_B { *(u32x4*)(rp + bj * HALF) = pack8(acc[ai][bj][m][0] * sv[bj][0], acc[ai][bj][m][1] * sv[bj][1]); } }
    }
};
template <bool HAS_ADD> struct EpiGate {
    static constexpr bool PERM = true;
    bf16_t* O; const bf16_t* gate; const bf16_t* add; int gcol0;
    __device__ __forceinline__ void operator()(const AccT& acc, const Unit& u, int wr, int wc, int fr, int fq) const {
        const int row0 = u.pm * BM + wr * 64 + fr, col0 = u.pn * BM + wc * 32 + 8 * fq;
        EPI_LOOP_AM { const size_t row = (size_t)(row0 + ai * HALF + m * 16);
            EPI_LOOP_B { f32x4 g0, g1; unpack8(__builtin_nontemporal_load((const u32x4*)(gate + row * 4096 + gcol0 + col0 + bj * HALF)), g0, g1);
                f32x4 v0 = g0 * acc[ai][bj][m][0], v1 = g1 * acc[ai][bj][m][1];
                if (HAS_ADD) { f32x4 a0, a1; unpack8(__builtin_nontemporal_load((const u32x4*)(add + row * 2048 + col0 + bj * HALF)), a0, a1); v0 += a0; v1 += a1; }
                *(u32x4*)(O + row * 2048 + col0 + bj * HALF) = pack8(v0, v1); } }
    }
};
struct EpiRes {
    static constexpr bool PERM = true;
    const bf16_t* base; float* out; int ldc;
    __device__ __forceinline__ void operator()(const AccT& acc, const Unit& u, int wr, int wc, int fr, int fq) const {
        const int row0 = u.pm * BM + wr * 64 + fr, col0 = u.pn * BM + wc * 32 + 8 * fq;
        EPI_LOOP_AM { const size_t off = (size_t)(row0 + ai * HALF + m * 16) * ldc + col0;
            EPI_LOOP_B { f32x4 b0, b1; unpack8(__builtin_nontemporal_load((const u32x4*)(base + off + bj * HALF)), b0, b1);
                __builtin_nontemporal_store(b0 + acc[ai][bj][m][0], (f32x4*)(out + off + bj * HALF)); __builtin_nontemporal_store(b1 + acc[ai][bj][m][1], (f32x4*)(out + off + bj * HALF + 4)); } }
    }
};
struct EpiResNorm {
    static constexpr bool PERM = true;
    const float* base; float* out; bf16_t* outb; float* ss; int ldc;
    __device__ __forceinline__ void operator()(const AccT& acc, const Unit& u, int wr, int wc, int fr, int fq) const {
        const int row0 = u.pm * BM + wr * 64 + fr, col0 = u.pn * BM + wc * 32 + 8 * fq;
        EPI_LOOP_AM { const int row = row0 + ai * HALF + m * 16; const size_t off = (size_t)row * ldc + col0; float s = 0.f;
            EPI_LOOP_B { const f32x4 v0 = __builtin_nontemporal_load((const f32x4*)(base + off + bj * HALF)) + acc[ai][bj][m][0], v1 = __builtin_nontemporal_load((const f32x4*)(base + off + bj * HALF + 4)) + acc[ai][bj][m][1];
                *(u32x4*)(outb + off + bj * HALF) = pack8(v0, v1);
                s += ((v0[0] * v0[0] + v0[1] * v0[1]) + (v0[2] * v0[2] + v0[3] * v0[3])) + ((v1[0] * v1[0] + v1[1] * v1[1]) + (v1[2] * v1[2] + v1[3] * v1[3])); }
            s += __shfl_xor(s, 16); s += __shfl_xor(s, 32);
            if (fq == 0) atomicAdd(ss + row, s); }
    }
};
struct EpiSwiGLU {
    static constexpr bool PERM = true;
    bf16_t* O; int ldc; const float* ss;
    __device__ __forceinline__ void operator()(const AccT& acc, const Unit& u, int wr, int wc, int fr, int fq) const {
        const int row0 = u.pm * BM + wr * 64 + fr, col0 = u.pn * HALF + wc * 32 + 8 * fq;
        EPI_LOOP_AM { const int row = row0 + ai * HALF + m * 16; bf16_t* rp = O + (size_t)row * ldc + col0;
            const float inv = 1.0f / sqrtf(ss[row] * (1.f / 2048.f) + 1e-6f);
            const f32x4 g0 = acc[ai][0][m][0] * inv, g1 = acc[ai][0][m][1] * inv;
            *(u32x4*)rp = pack8(g0 * sigmoid4(g0) * (acc[ai][1][m][0] * inv), g1 * sigmoid4(g1) * (acc[ai][1][m][1] * inv)); }
    }
};

template <class Epi, class Sched, bool ALIGN_EPI = true>
__device__ __forceinline__ void gemm_phase(PG8_LAS unsigned char* lds, const Gemm g, const Sched& S, const Epi& E) {
    const int tid = threadIdx.x, wid = __builtin_amdgcn_readfirstlane(tid >> 6), lane = tid & 63, wr = wid >> 2, wc = wid & 3, fr = lane & 15, fq = lane >> 4;
    const int K = g.K, nt = K / BK;
    unsigned voffA[2], voffB[2];
#pragma unroll
    for (int i = 0; i < 2; ++i) { int R, C; stage_rc(tid * 16 + i * 8192, R, C); const int Rb = Epi::PERM ? ((R & ~31) + perm32(R & 31)) : R;
        voffA[i] = (unsigned)(R * g.lda + C) * 2u; voffB[i] = (unsigned)(Rb * g.ldb + C) * 2u; }
    const size_t kstep = (size_t)(BK * 2);
    const size_t hstepA = (size_t)HALF * g.lda * 2, hstepB = (size_t)HALF * g.ldb * 2;
    const size_t tstepA = 2 * hstepA, tstepB = g.b_pn_step ? (size_t)g.b_pn_step * 2 : 2 * hstepB, pstepA = (size_t)g.a_pn_step * 2;
    const unsigned ldsw = (unsigned)wid * 1024u;
    const int aoff = lds_byte(wr * 64 + fr, fq * 8), boff = lds_byte(wc * 32 + fr, fq * 8);
#define PG8_SA(b, h) (((b) * 2 + (h)) * HTB)
#define PG8_SB(b, h) ((4 + (b) * 2 + (h)) * HTB)
#define PG8_STAGE(bufoff, gbase, voff) do { _Pragma("unroll") for (int _i = 0; _i < 2; ++_i) \
        __builtin_amdgcn_global_load_lds((const unsigned*)((const char*)(gbase) + (voff)[_i]), (PG8_LAS unsigned*)(lds + (bufoff) + ldsw + _i * 8192), 16, 0, 0); } while (0)
#define PG8_LDA(dst, b, h) do { _Pragma("unroll") for (int m = 0; m < 4; ++m) _Pragma("unroll") for (int k = 0; k < 2; ++k) dst[m][k] = *(const PG8_LAS bf16x8*)(lds + PG8_SA(b, h) + aoff + m * 2048 + k * 1024); } while (0)
#define PG8_LDB(dst, b, h) do { _Pragma("unroll") for (int n = 0; n < 2; ++n) _Pragma("unroll") for (int k = 0; k < 2; ++k) dst[n][k] = *(const PG8_LAS bf16x8*)(lds + PG8_SB(b, h) + boff + n * 2048 + k * 1024); } while (0)
#define PG8_MMA(ai, bj, At, Bt) do { __builtin_amdgcn_s_setprio(1); _Pragma("unroll") for (int m = 0; m < 4; ++m) _Pragma("unroll") for (int n = 0; n < 2; ++n) _Pragma("unroll") for (int k = 0; k < 2; ++k) \
        acc[ai][bj][m][n] = __builtin_amdgcn_mfma_f32_16x16x32_bf16(Bt[n][k], At[m][k], acc[ai][bj][m][n], 0, 0, 0); __builtin_amdgcn_s_setprio(0); } while (0)
#define PG8_WAIT_V(n) asm volatile("s_waitcnt vmcnt(" #n ")" ::: "memory")
#define PG8_WAIT_L(n) asm volatile("s_waitcnt lgkmcnt(" #n ")" ::: "memory")
#define PG8_BAR __builtin_amdgcn_s_barrier()
#define PG8_SCHED __builtin_amdgcn_sched_barrier(0)
    Unit cur, nxt; int ui = 0;
    if (!S.next(0, cur)) return;
    f32x4 acc[2][2][4][2];
#pragma unroll
    for (int a = 0; a < 2; ++a)
#pragma unroll
        for (int b = 0; b < 2; ++b)
#pragma unroll
            for (int m = 0; m < 4; ++m)
#pragma unroll
                for (int n = 0; n < 2; ++n) acc[a][b][m][n] = (f32x4){0.f, 0.f, 0.f, 0.f};
    bf16x8 At[4][2], B0[2][2], B1[2][2];
    const char* cA = (const char*)g.A + (size_t)cur.pm * tstepA + (size_t)cur.pn * pstepA; const char* cB = (const char*)g.Bt + (size_t)cur.pn * tstepB;
    PG8_STAGE(PG8_SB(0, 0), cB, voffB); PG8_STAGE(PG8_SB(0, 1), cB + hstepB, voffB); PG8_STAGE(PG8_SA(0, 0), cA, voffA); PG8_STAGE(PG8_SA(0, 1), cA + hstepA, voffA);
    if (wr == 1) PG8_BAR;
    PG8_WAIT_V(2); PG8_BAR;
    PG8_STAGE(PG8_SB(1, 0), cB + kstep, voffB); PG8_STAGE(PG8_SA(1, 0), cA + kstep, voffA); PG8_STAGE(PG8_SB(1, 1), cB + hstepB + kstep, voffB);
    PG8_WAIT_V(6); PG8_BAR;
    for (;;) {
        const bool has_next = S.next(ui + 1, nxt);
        const char* nA = has_next ? (const char*)g.A + (size_t)nxt.pm * tstepA + (size_t)nxt.pn * pstepA : cA; const char* nB = has_next ? (const char*)g.Bt + (size_t)nxt.pn * tstepB : cB;
        for (int t = 0; t < nt; t += 2) {
            const bool last = (t == nt - 2);
            const char* a1 = cA + (size_t)(t + 1) * kstep;
            const char* a2 = last ? nA : cA + (size_t)(t + 2) * kstep; const char* b2 = last ? nB : cB + (size_t)(t + 2) * kstep;
            const char* a3 = a2 + kstep; const char* b3 = b2 + kstep;
            PG8_LDB(B0, 0, 0); PG8_LDB(B1, 0, 1); PG8_SCHED; PG8_LDA(At, 0, 0); PG8_STAGE(PG8_SA(1, 1), a1 + hstepA, voffA);
            PG8_WAIT_V(8); PG8_WAIT_L(0); PG8_BAR; PG8_MMA(0, 0, At, B0); PG8_MMA(0, 1, At, B1); PG8_BAR; PG8_SCHED;
            PG8_LDA(At, 0, 1); PG8_STAGE(PG8_SB(0, 0), b2, voffB); PG8_STAGE(PG8_SB(0, 1), b2 + hstepB, voffB); PG8_STAGE(PG8_SA(0, 0), a2, voffA);
            PG8_WAIT_V(8); PG8_WAIT_L(0); PG8_BAR; PG8_MMA(1, 0, At, B0); PG8_MMA(1, 1, At, B1); PG8_BAR; PG8_SCHED;
            PG8_LDB(B0, 1, 0); PG8_LDB(B1, 1, 1); PG8_SCHED; PG8_LDA(At, 1, 0); PG8_STAGE(PG8_SA(0, 1), a2 + hstepA, voffA);
            PG8_WAIT_V(8); PG8_WAIT_L(0); PG8_BAR; PG8_MMA(0, 0, At, B0); PG8_MMA(0, 1, At, B1); PG8_BAR; PG8_SCHED;
            PG8_LDA(At, 1, 1); PG8_STAGE(PG8_SB(1, 0), b3, voffB); PG8_STAGE(PG8_SB(1, 1), b3 + hstepB, voffB); PG8_STAGE(PG8_SA(1, 0), a3, voffA);
            PG8_WAIT_V(8); PG8_WAIT_L(0); PG8_BAR; PG8_MMA(1, 0, At, B0); PG8_MMA(1, 1, At, B1); PG8_BAR; PG8_SCHED;
        }
        if constexpr (ALIGN_EPI) { if (wr == 0) PG8_BAR; }
        E(acc, cur, wr, wc, fr, fq);
        if (!has_next) break;
#pragma unroll
        for (int a = 0; a < 2; ++a)
#pragma unroll
            for (int b = 0; b < 2; ++b)
#pragma unroll
                for (int m = 0; m < 4; ++m)
#pragma unroll
                    for (int n = 0; n < 2; ++n) acc[a][b][m][n] = (f32x4){0.f, 0.f, 0.f, 0.f};
        cur = nxt; cA = nA; cB = nB; ++ui;
        if constexpr (ALIGN_EPI) { if (wr == 1) PG8_BAR; }
    }
    PG8_WAIT_V(0);
    if constexpr (!ALIGN_EPI) { if (wr == 0) PG8_BAR; }
    PG8_BAR;
#undef PG8_SA
#undef PG8_SB
#undef PG8_STAGE
#undef PG8_LDA
#undef PG8_LDB
#undef PG8_MMA
#undef PG8_WAIT_V
#undef PG8_WAIT_L
#undef PG8_BAR
#undef PG8_SCHED
}
}

constexpr int BATCH = 2, SEQ = 4096, DM = 2048, M = BATCH * SEQ;
constexpr int NH = 16, DQK = 192, DNOPE = 128, DROPE = 64, DV = 128, QLORA = 512, KVLORA = 512;
constexpr int POOLW = 1024, DIN = 6208, DIN_PAD = 6400, DFF = 5632;
constexpr float EPS = 1e-6f;
constexpr int NWAVES = 8;

typedef unsigned short bf16;
typedef unsigned v4u __attribute__((ext_vector_type(4)));
typedef unsigned v2u __attribute__((ext_vector_type(2)));
typedef float f32x4 __attribute__((ext_vector_type(4)));
typedef short bf16x8 __attribute__((ext_vector_type(8)));
typedef short s16x4 __attribute__((ext_vector_type(4)));
typedef float f32x16 __attribute__((ext_vector_type(16)));
#define LAS __attribute__((address_space(3)))
#define LDS_WAIT() asm volatile("s_waitcnt lgkmcnt(0)" ::: "memory")

constexpr size_t MiB = 1u << 20;
constexpr size_t WS_WAO = 1 * MiB, WS_WOUT = 9 * MiB, WS_WPO = 17 * MiB, WS_WQB = 21 * MiB, WS_WKVB = 24 * MiB, WS_WPG = 28 * MiB, WS_KR = 29 * MiB;
constexpr size_t WS_G = 31 * MiB;
constexpr size_t WS_WIN = 95 * MiB, WS_XN = 120 * MiB, WS_C1 = 152 * MiB, WS_U = 184 * MiB;
constexpr size_t WS_Q = 95 * MiB, WS_K = 143 * MiB, WS_V = 191 * MiB, WS_CN = 223 * MiB, WS_POOLED = 239 * MiB, WS_PG = 255 * MiB;
constexpr size_t WS_MP = 223 * MiB, WS_O = 255 * MiB, WS_MIXED = 95 * MiB, WS_X1 = 127 * MiB, WS_H2 = 95 * MiB;
constexpr size_t WS_WGU = 191 * MiB, WS_WDN = 235 * MiB, WS_ACT = 1 * MiB;
constexpr size_t WS_END = 296 * MiB, WS_BAR = 512 * 1024, WS_KRP = 272 * MiB, WS_X1B = 257 * MiB;
constexpr int SV_BGATE = 0, SV_QAG = 4096, SV_KVAG = 4608, SV_QNG = 5120, SV_KNG = 5376, SV_PSC = 5632, SV_FNG = 6656, SV_POS = 8704, SV_END = 8704 + 8192, SV_SS = 32768;

constexpr int LDS_BYTES = 147456;

__device__ __forceinline__ unsigned cvtpk(float lo, float hi) { return pg8::cvt_pk_bf16(lo, hi); }
__device__ __forceinline__ float bflo(unsigned w) { return __uint_as_float(w << 16); }
__device__ __forceinline__ float bfhi(unsigned w) { return __uint_as_float(w & 0xffff0000u); }
__device__ __forceinline__ float wave_sum(float v) {
#pragma unroll
    for (int o = 1; o < 64; o <<= 1) v += __shfl_xor(v, o);
    return v;
}

__device__ __forceinline__ int dst_row(int mode, int n0) {
    if (mode == 1) { if (n0 < 1024) return n0; if (n0 < 1088) return 6144 + (n0 - 1024); if (n0 < 2112) return 1024 + (n0 - 1088); return 2048 + (n0 - 2112); }
    if (mode == 2) return (n0 >> 7) * 256 + (n0 & 127);
    if (mode == 3) return (n0 >> 7) * 256 + 128 + (n0 & 127);
    return n0;
}
__device__ __forceinline__ void transpose_item(const float* W, int K, int N, bf16* WT, int mode, int row_off, LAS float* scr, int item, int lane, const float* gk = nullptr) {
    const int nblk = N / 32, kb = item / nblk, nb = item % nblk, k0 = 64 * kb, n0 = 32 * nb;
    { float tv[32]; const float* wp = W + (size_t)(k0 + (lane >> 5)) * N + n0 + (lane & 31);
#pragma unroll
      for (int i = 0; i < 32; ++i) tv[i] = wp[(size_t)(2 * i) * N];
      if (gk) {
#pragma unroll
          for (int i = 0; i < 32; ++i) tv[i] *= gk[k0 + 2 * i + (lane >> 5)]; }
#pragma unroll
      for (int i = 0; i < 32; ++i) scr[(2 * i + (lane >> 5)) * 33 + (lane & 31)] = tv[i]; }
    LDS_WAIT(); asm volatile("" ::: "memory");
    const int c = lane & 7, dr = row_off + dst_row(mode, n0);
#pragma unroll
    for (int j = 0; j < 4; ++j) { const int n = (lane >> 3) + 8 * j; const LAS float* s = scr + (8 * c) * 33 + n;
        v4u o; o.x = cvtpk(s[0 * 33], s[1 * 33]); o.y = cvtpk(s[2 * 33], s[3 * 33]); o.z = cvtpk(s[4 * 33], s[5 * 33]); o.w = cvtpk(s[6 * 33], s[7 * 33]);
        *(v4u*)(WT + (size_t)(dr + n) * K + k0 + 8 * c) = o; }
    LDS_WAIT(); asm volatile("" ::: "memory");
}

struct TrDesc { const float* W; bf16* WT; const float* gk; int K, N, k0, n0, dr; };
__device__ __forceinline__ TrDesc tr_desc(const float* W, int K, int N, bf16* WT, int mode, int row_off, int item, const float* gk) {
    const int nblk = N / 32, kb = item / nblk, nb = item % nblk; TrDesc d; d.W = W; d.WT = WT; d.gk = gk; d.K = K; d.N = N; d.k0 = 64 * kb; d.n0 = 32 * nb; d.dr = row_off + dst_row(mode, d.n0); return d; }
__device__ __forceinline__ void tr_load(const TrDesc& d, float (&tv)[32], int lane) {
    const float* wp = d.W + (size_t)(d.k0 + (lane >> 5)) * d.N + d.n0 + (lane & 31);
#pragma unroll
    for (int i = 0; i < 32; ++i) tv[i] = __builtin_nontemporal_load(wp + (size_t)(2 * i) * d.N);
}
__device__ __forceinline__ void tr_finish(const TrDesc& d, float (&tv)[32], LAS float* scr, int lane) {
    if (d.gk) {
#pragma unroll
        for (int i = 0; i < 32; ++i) tv[i] *= d.gk[d.k0 + 2 * i + (lane >> 5)]; }
#pragma unroll
    for (int i = 0; i < 32; ++i) scr[(2 * i + (lane >> 5)) * 33 + (lane & 31)] = tv[i];
    LDS_WAIT(); asm volatile("" ::: "memory");
    const int c = lane & 7;
#pragma unroll
    for (int j = 0; j < 4; ++j) { const int n = (lane >> 3) + 8 * j; const LAS float* s_ = scr + (8 * c) * 33 + n;
        v4u o; o.x = cvtpk(s_[0 * 33], s_[1 * 33]); o.y = cvtpk(s_[2 * 33], s_[3 * 33]); o.z = cvtpk(s_[4 * 33], s_[5 * 33]); o.w = cvtpk(s_[6 * 33], s_[7 * 33]);
        *(v4u*)(d.WT + (size_t)(d.dr + n) * d.K + d.k0 + 8 * c) = o; }
    LDS_WAIT(); asm volatile("" ::: "memory");
}
#define TR_PIPELINE(FIRST, LIMIT, STRIDE, MAKE_DESC) do { int it_ = (FIRST); if (it_ < (LIMIT)) { TrDesc dA_ = MAKE_DESC(it_); float tvA_[32]; tr_load(dA_, tvA_, lane); \
        for (;;) { const int nx_ = it_ + (STRIDE); const bool more_ = nx_ < (LIMIT); TrDesc dB_ = dA_; float tvB_[32]; \
            if (more_) { dB_ = MAKE_DESC(nx_); tr_load(dB_, tvB_, lane); } \
            tr_finish(dA_, tvA_, scr, lane); if (!more_) break; \
            dA_ = dB_; _Pragma("unroll") for (int i_ = 0; i_ < 32; ++i_) tvA_[i_] = tvB_[i_]; it_ = nx_; } } } while (0)

__device__ __forceinline__ void rms_row_2048(const float* xrow, const float* g, bf16* orow, int lane) {
    const f32x4* xr = (const f32x4*)xrow + lane; const f32x4* gr = (const f32x4*)g + lane;
    f32x4 v[8]; float s = 0.f;
#pragma unroll
    for (int j = 0; j < 8; ++j) { v[j] = __builtin_nontemporal_load(xr + 64 * j); s += (v[j].x * v[j].x + v[j].y * v[j].y) + (v[j].z * v[j].z + v[j].w * v[j].w); }
    const float inv = 1.0f / sqrtf(wave_sum(s) * (1.f / 2048.f) + EPS);
    v2u* o8 = (v2u*)orow + lane;
#pragma unroll
    for (int j = 0; j < 8; ++j) { const f32x4 gv = gr[64 * j]; v2u o; o.x = cvtpk(v[j].x * inv * gv.x, v[j].y * inv * gv.y); o.y = cvtpk(v[j].z * inv * gv.z, v[j].w * inv * gv.w); o8[64 * j] = o; }
}

namespace att {
constexpr int QBLK = 32, KVBLK = 64, QB = 256;
constexpr int SHM_V = KVBLK * DV * 2, SHM_K = KVBLK * DQK * 2;
constexpr int OFF_V = 0, OFF_K = 3 * SHM_V, OFF_WS = OFF_K + 2 * SHM_K;
constexpr float SCALE = 0.07216878364870322f;
constexpr float THR = 8.f;
#define KSWZ(row, colB) ((row) * 384 + ((colB) ^ (((row) & 7) << 4)))
#define SBAR() __builtin_amdgcn_sched_barrier(0)
__device__ __forceinline__ int v_st(int k, int c) { const int kk = (k & ~0xC) | ((k & 4) << 1) | ((k & 8) >> 1); return ((kk >> 3) * 4 + (c >> 5)) * 512 + ((kk & 7) * 32 + (c & 31)) * 2; }
__device__ __forceinline__ int v_rd_base(int lane) { return ((lane & 3) << 3) | (((lane >> 2) & 3) << 6) | (((lane >> 4) & 1) << 5) | (((lane >> 5) & 1) << 8); }
__device__ __forceinline__ int crow(int r, int hi) { return (r & 3) + 8 * (r >> 2) + 4 * hi; }
__device__ __forceinline__ void mask_tile(f32x16& p0, f32x16& p1, int dq) {
    const float NEG = -__builtin_inff();
#pragma unroll
    for (int r = 0; r < 16; ++r) {
        const int c = (r & 3) + 8 * (r >> 2);
        if (dq - c < 0) p0[r] = NEG;
        if (dq - c - 32 < 0) p1[r] = NEG;
    }
}
__device__ __forceinline__ void partialSM(f32x16& p0, f32x16& p1, float& m_reg, float& mn, float& alpha) {
    float pmax = p0[0];
#pragma unroll
    for (int r = 1; r < 16; ++r) pmax = fmaxf(pmax, p0[r]);
#pragma unroll
    for (int r = 0; r < 16; ++r) pmax = fmaxf(pmax, p1[r]);
    { auto rr = __builtin_amdgcn_permlane32_swap(__float_as_uint(pmax), __float_as_uint(pmax), false, false);
      pmax = fmaxf(__uint_as_float(rr[0]), __uint_as_float(rr[1])); }
    constexpr float C2 = 1.4426950408889634f * SCALE;
    if (__builtin_expect(__all((pmax - m_reg) * SCALE <= THR), 1)) { mn = m_reg; alpha = 1.f; }
    else { mn = fmaxf(m_reg, pmax); alpha = __builtin_amdgcn_exp2f((m_reg - mn) * C2); m_reg = mn; }
    const float mnL = -mn * C2;
#pragma unroll
    for (int r = 0; r < 16; ++r) p0[r] = fmaf(p0[r], C2, mnL);
#pragma unroll
    for (int r = 0; r < 16; ++r) p1[r] = fmaf(p1[r], C2, mnL);
#pragma unroll
    for (int r = 0; r < 16; ++r) p0[r] = __builtin_amdgcn_exp2f(p0[r]);
}
__device__ __forceinline__ void finishSM(f32x16& p0, f32x16& p1, float alpha, float& l_reg, bf16x8& pa0, bf16x8& pa1, bf16x8& pa2, bf16x8& pa3) {
#pragma unroll
    for (int r = 0; r < 16; ++r) p1[r] = __builtin_amdgcn_exp2f(p1[r]);
    float ps = 0;
#pragma unroll
    for (int r = 0; r < 16; ++r) ps += p0[r];
#pragma unroll
    for (int r = 0; r < 16; ++r) ps += p1[r];
    { auto rr = __builtin_amdgcn_permlane32_swap(__float_as_uint(ps), __float_as_uint(ps), false, false);
      ps = __uint_as_float(rr[0]) + __uint_as_float(rr[1]); }
    l_reg = l_reg * alpha + ps;
#define PK4(P, B_, OUT) do { unsigned a0 = cvtpk(P[B_+0], P[B_+1]), a1 = cvtpk(P[B_+2], P[B_+3]);                          \
        unsigned b0 = cvtpk(P[B_+4], P[B_+5]), b1 = cvtpk(P[B_+6], P[B_+7]);                                             \
        auto r0 = __builtin_amdgcn_permlane32_swap(a0, b0, false, false); auto r1 = __builtin_amdgcn_permlane32_swap(a1, b1, false, false); \
        v4u w = {r0[0], r1[0], r0[1], r1[1]}; OUT = *reinterpret_cast<bf16x8*>(&w); } while (0)
    PK4(p0, 0, pa0); PK4(p0, 8, pa1); PK4(p1, 0, pa2); PK4(p1, 8, pa3);
#undef PK4
}
__device__ __forceinline__ void qkt(f32x16& p0, f32x16& p1, const char* Kb, int r32, int hi, const bf16x8* qr) {
    p0 = f32x16{}; p1 = f32x16{};
    const char* kb[4];
#pragma unroll
    for (int dd = 0; dd < 4; ++dd) kb[dd] = Kb + KSWZ(r32, (dd * 16 + hi * 8) * 2);
#pragma unroll
    for (int g = 0; g < 2; ++g) { bf16x8 b0[6], b1[6];
#pragma unroll
        for (int i = 0; i < 6; ++i) { const int d0 = 6 * g + i; const char* a = kb[d0 & 3] + (d0 >> 2) * 128; b0[i] = *reinterpret_cast<const bf16x8*>(a); b1[i] = *reinterpret_cast<const bf16x8*>(a + 32 * 384); }
        SBAR();
        __builtin_amdgcn_s_setprio(1);
#pragma unroll
        for (int i = 0; i < 6; ++i) { p0 = __builtin_amdgcn_mfma_f32_32x32x16_bf16(b0[i], qr[6 * g + i], p0, 0, 0, 0); p1 = __builtin_amdgcn_mfma_f32_32x32x16_bf16(b1[i], qr[6 * g + i], p1, 0, 0, 0); }
        __builtin_amdgcn_s_setprio(0);
        SBAR(); }
}
__device__ __forceinline__ void pv_tile(f32x16* o, int vb0, bf16x8 pa0, bf16x8 pa1, bf16x8 pa2, bf16x8 pa3) {
#define TRRD(dst, off) asm volatile("ds_read_b64_tr_b16 %0, %1 offset:%2" : "=&v"(dst) : "v"(vb0), "i"(off) : "memory")
#define PV_RD(S, d0) do { constexpr int b_ = (d0) * 512; TRRD(S##l0, b_); TRRD(S##h0, b_ + 2048); TRRD(S##l1, b_ + 4096); TRRD(S##h1, b_ + 6144); TRRD(S##l2, b_ + 8192); TRRD(S##h2, b_ + 10240); TRRD(S##l3, b_ + 12288); TRRD(S##h3, b_ + 14336); } while (0)
#define PV_MM(S, d0) do { \
        o[d0] = __builtin_amdgcn_mfma_f32_32x32x16_bf16(pa0, (bf16x8){S##l0[0], S##l0[1], S##l0[2], S##l0[3], S##h0[0], S##h0[1], S##h0[2], S##h0[3]}, o[d0], 0, 0, 0);   \
        o[d0] = __builtin_amdgcn_mfma_f32_32x32x16_bf16(pa1, (bf16x8){S##l1[0], S##l1[1], S##l1[2], S##l1[3], S##h1[0], S##h1[1], S##h1[2], S##h1[3]}, o[d0], 0, 0, 0);   \
        o[d0] = __builtin_amdgcn_mfma_f32_32x32x16_bf16(pa2, (bf16x8){S##l2[0], S##l2[1], S##l2[2], S##l2[3], S##h2[0], S##h2[1], S##h2[2], S##h2[3]}, o[d0], 0, 0, 0);   \
        o[d0] = __builtin_amdgcn_mfma_f32_32x32x16_bf16(pa3, (bf16x8){S##l3[0], S##l3[1], S##l3[2], S##l3[3], S##h3[0], S##h3[1], S##h3[2], S##h3[3]}, o[d0], 0, 0, 0); } while (0)
    s16x4 Al0, Al1, Al2, Al3, Ah0, Ah1, Ah2, Ah3, Bl0, Bl1, Bl2, Bl3, Bh0, Bh1, Bh2, Bh3;
    PV_RD(A, 0); PV_RD(B, 1);
    asm volatile("s_waitcnt lgkmcnt(8)" ::: "memory"); SBAR(); PV_MM(A, 0); SBAR();
    PV_RD(A, 2);
    asm volatile("s_waitcnt lgkmcnt(8)" ::: "memory"); SBAR(); PV_MM(B, 1); SBAR();
    PV_RD(B, 3);
    asm volatile("s_waitcnt lgkmcnt(8)" ::: "memory"); SBAR(); PV_MM(A, 2); SBAR();
    asm volatile("s_waitcnt lgkmcnt(0)" ::: "memory"); SBAR(); PV_MM(B, 3);
#undef PV_MM
#undef PV_RD
#undef TRRD
}
__device__ __forceinline__ void attn_unit(int b, int h, int qb, const bf16* Q, const bf16* K, const bf16* V, bf16* O, char* lds) {
    const int tid = threadIdx.x, wid = __builtin_amdgcn_readfirstlane(tid >> 6), lane = tid & 63, r32 = lane & 31, hi = lane >> 5;
    const size_t rowb = (size_t)b * SEQ;
    const int q0 = qb * QB, qlo = q0 + wid * QBLK;
    const int NT = (q0 + QB) / KVBLK;
    char* V_lds = lds + OFF_V; char* K_lds = lds + OFF_K;
#define WAVE_WS() ({ int t_ = (int)threadIdx.x; asm volatile("" : "+v"(t_)); (float*)(lds + OFF_WS) + (t_ >> 6) * 64; })
    LAS unsigned char* ldsl_ = (LAS unsigned char*)lds;
    unsigned ksrc[3], vsrc[2];
#pragma unroll
    for (int j = 0; j < 3; ++j) { const int s_ = (wid * 3 + j) * 64 + lane, row = s_ / 24, pc = s_ % 24; ksrc[j] = (unsigned)(row * 3072 * 2 + ((pc * 16) ^ ((row & 7) << 4))); }
#pragma unroll
    for (int j = 0; j < 2; ++j) { const int ob = ((wid * 2 + j) * 64 + lane) * 16, st = ob >> 9, kr_ = (ob >> 6) & 7, ch = (ob >> 4) & 3, c = (st & 3) * 32 + ch * 8, kk = (st >> 2) * 8 + kr_,
                                  k = (kk & ~0xC) | ((kk & 4) << 1) | ((kk & 8) >> 1); vsrc[j] = (unsigned)(k * 2048 * 2 + c * 2); }
    const char* Kh = (const char*)(K + rowb * 3072 + h * DQK); const char* Vh = (const char*)(V + rowb * 2048 + h * DV);
#define KDMA(k0, bf) do { _Pragma("unroll") for (int j = 0; j < 3; ++j) __builtin_amdgcn_global_load_lds((const unsigned*)(Kh + (size_t)(k0) * (3072 * 2) + ksrc[j]), \
        (LAS unsigned*)(ldsl_ + OFF_K + (bf) * SHM_K + (wid * 3 + j) * 1024), 16, 0, 0); } while (0)
#define VDMA(k0, sl) do { _Pragma("unroll") for (int j = 0; j < 2; ++j) __builtin_amdgcn_global_load_lds((const unsigned*)(Vh + (size_t)(k0) * (2048 * 2) + vsrc[j]), \
        (LAS unsigned*)(ldsl_ + OFF_V + (sl) * SHM_V + (wid * 2 + j) * 1024), 16, 0, 0); } while (0)
    KDMA(0, 0); VDMA(0, 0);
    bf16x8 qr[12];
    { const bf16* Qp = Q + (rowb + qlo + r32) * 3072 + h * DQK + hi * 8;
#pragma unroll
      for (int d0 = 0; d0 < 12; ++d0) qr[d0] = *(const bf16x8*)(Qp + d0 * 16); }
    asm volatile("s_waitcnt vmcnt(0)" ::: "memory");
    __syncthreads();
    float m_reg = -1e30f, l_reg = 0.f; f32x16 o[4] = {};
    const int vbase = (int)(uintptr_t)V_lds + v_rd_base(lane);
    const int qm = qlo + r32 - 4 * hi;
    f32x16 p0, p1;
#define SP_STAGE(VS) do { float mn, alpha; bf16x8 pa0, pa1, pa2, pa3; \
        partialSM(p0, p1, m_reg, mn, alpha); finishSM(p0, p1, alpha, l_reg, pa0, pa1, pa2, pa3); \
        if (__any(alpha < 1.f)) { float* al_l = WAVE_WS() + 32; if (hi == 0) al_l[r32] = alpha; asm volatile("s_waitcnt lgkmcnt(0)" ::: "memory"); \
            _Pragma("unroll") for (int d_ = 0; d_ < 4; ++d_) _Pragma("unroll") for (int r = 0; r < 16; ++r) o[d_][r] *= al_l[crow(r, hi)]; } \
        SBAR(); pv_tile(o, vbase + (VS) * SHM_V, pa0, pa1, pa2, pa3); } while (0)
    for (int t = 0; t < NT; ++t) {
        const int cur = t & 1, kb_ = t * KVBLK;
        if (t + 1 < NT) { KDMA((t + 1) * KVBLK, cur ^ 1); VDMA((t + 1) * KVBLK, cur ^ 1); }
        SBAR();
        qkt(p0, p1, K_lds + cur * SHM_K, r32, hi, qr); if (kb_ + KVBLK - 1 > qlo) mask_tile(p0, p1, qm - kb_);
        SBAR();
        SP_STAGE(cur);
        asm volatile("s_waitcnt vmcnt(0)" ::: "memory");
        __syncthreads();
    }
#undef SP_STAGE
    float* li_l = WAVE_WS();
    if (hi == 0) li_l[r32] = l_reg; asm volatile("s_waitcnt lgkmcnt(0)" ::: "memory");
    float rli[16];
#pragma unroll
    for (int r = 0; r < 16; ++r) rli[r] = __builtin_amdgcn_rcpf(li_l[crow(r, hi)]);
    bf16* Ow = O + (rowb + qlo) * 2048 + h * DV;
#pragma unroll
    for (int r = 0; r < 16; ++r) { const int orow = crow(r, hi);
#pragma unroll
        for (int d0 = 0; d0 < 4; ++d0) { const float v = o[d0][r] * rli[r];
            const float vn = __shfl_xor(v, 1);
            if ((r32 & 1) == 0) *(unsigned*)(Ow + (size_t)orow * 2048 + d0 * 32 + r32) = cvtpk(v, vn); } }
    __syncthreads();
#undef KDMA
#undef VDMA
#undef WAVE_WS
}
#undef SBAR
}

struct Args { const float* in[20]; float* out; unsigned char* ws; int ph_lo, ph_hi, coop, pad; };
#define XB_TMO      128
#define XB_XCNT(j)  (256  + 64 * (j))
#define XB_XSUB(j)  (1280 + 64 * (j))
#define XB_XGEN(j)  (2304 + 64 * (j))
#define XB_TOP      3328
#define XB_TOPGEN   3392
#define XCD_BAR_WORDS 3456
#define XB_SPIN_CAP (1u << 20)
__device__ __forceinline__ unsigned xb_ld(unsigned* p)              { return __hip_atomic_load(p, __ATOMIC_RELAXED, __HIP_MEMORY_SCOPE_AGENT); }
__device__ __forceinline__ unsigned xb_add(unsigned* p, unsigned v) { return __hip_atomic_fetch_add(p, v, __ATOMIC_RELAXED, __HIP_MEMORY_SCOPE_AGENT); }
__device__ __forceinline__ unsigned xb_xcc_id() { return (unsigned)__builtin_amdgcn_s_getreg((3 << 11) | 20) & 0xFu; }
#define XB_SPIN(cond, bar) do { unsigned _sp = 0; while (cond) { __builtin_amdgcn_s_sleep(1); \
    if ((++_sp & 255u) == 0u) { if (xb_ld(&(bar)[XB_TMO])) break; if (_sp > XB_SPIN_CAP) { atomicAdd(&(bar)[XB_TMO], 1u); break; } } } } while (0)
__device__ __forceinline__ void xcd_barrier_complete(unsigned* bar, unsigned x, unsigned& nloc, unsigned& nx) {
    const unsigned G = gridDim.x;
    unsigned sum, cnt, mine, sp = 0u;
    for (;;) {
        sum = 0u; cnt = 0u; mine = 0u;
#pragma unroll
        for (unsigned j = 0; j < 16; ++j) { const unsigned c = xb_ld(&bar[XB_XCNT(j)]); sum += c; cnt += (c > 0u) ? 1u : 0u; mine = (j == x) ? c : mine; }
        if (sum == G) break;
        __builtin_amdgcn_s_sleep(1);
        if ((++sp & 255u) == 0u) { if (xb_ld(&bar[XB_TMO])) break; if (sp > XB_SPIN_CAP) { atomicAdd(&bar[XB_TMO], 1u); break; } }
    }
    nloc = mine > 0u ? mine : 1u; nx = cnt > 0u ? cnt : 1u;
}
__device__ __forceinline__ void grid_bar(unsigned* bar, volatile LAS unsigned* st) {
    asm volatile("s_waitcnt vmcnt(0)" ::: "memory");
    __syncthreads();
    if (threadIdx.x == 0) {
        const unsigned x = xb_xcc_id();
        __builtin_amdgcn_s_waitcnt(0);
        unsigned nloc = st[0], nx = st[1];
        if (nloc == 0u) { xcd_barrier_complete(bar, x, nloc, nx); st[0] = nloc; st[1] = nx; }
        const unsigned old = xb_add(&bar[XB_XSUB(x)], 1u);
        const unsigned gen = old / nloc;
        if (old + 1u == (gen + 1u) * nloc) {
            __builtin_amdgcn_fence(__ATOMIC_RELEASE, "agent");
            asm volatile("s_waitcnt vmcnt(0)" ::: "memory");
            const unsigned og = xb_add(&bar[XB_TOP], 1u);
            const unsigned tg = og / nx;
            if (og + 1u == (tg + 1u) * nx) xb_add(&bar[XB_TOPGEN], 1u);
            else XB_SPIN(xb_ld(&bar[XB_TOPGEN]) == tg, bar);
            __builtin_amdgcn_fence(__ATOMIC_ACQUIRE, "agent");
            xb_add(&bar[XB_XGEN(x)], 1u);
            asm volatile("s_waitcnt vmcnt(0)" ::: "memory");
        } else {
            XB_SPIN(xb_ld(&bar[XB_XGEN(x)]) == gen, bar);
            __builtin_amdgcn_fence(__ATOMIC_ACQUIRE, "agent");
            asm volatile("s_waitcnt vmcnt(0)" ::: "memory");
        }
    }
    __syncthreads();
}
constexpr int NPH = 11;

__global__ void __launch_bounds__(NWAVES * 64, 2) mega_fwd(Args args) {
    extern __shared__ __attribute__((aligned(16))) unsigned char lds[];
    LAS unsigned char* ldsl = (LAS unsigned char*)lds;
    const int tid = threadIdx.x, lane = tid & 63, wave = __builtin_amdgcn_readfirstlane(tid >> 6);
    const int G = gridDim.x, bx = blockIdx.x;
    const int vcu = (G % 8 == 0) ? (bx % 8) * (G / 8) + bx / 8 : bx;
    const int gw = vcu * NWAVES + wave, NGW = G * NWAVES;
    unsigned char* ws = args.ws;
    const float* const* kin = (const float* const*)__builtin_amdgcn_kernarg_segment_ptr();
    const float* svec = (const float*)ws;
    const float* b_gate = svec + SV_BGATE; const float* q_a_norm_g = svec + SV_QAG; const float* kv_a_norm_g = svec + SV_KVAG; const float* q_norm_g = svec + SV_QNG;
    const float* k_norm_g = svec + SV_KNG; const float* pool_scale = svec + SV_PSC; const float* ffn_norm_g = svec + SV_FNG; const int* positions = (const int*)(svec + SV_POS);
    bf16* WIN_T = (bf16*)(ws + WS_WIN); bf16* WQB_T = (bf16*)(ws + WS_WQB); bf16* WKVB_T = (bf16*)(ws + WS_WKVB); bf16* WPG_T = (bf16*)(ws + WS_WPG);
    bf16* WPO_T = (bf16*)(ws + WS_WPO); bf16* WAO_T = (bf16*)(ws + WS_WAO); bf16* WOUT_T = (bf16*)(ws + WS_WOUT); bf16* WGU_T = (bf16*)(ws + WS_WGU); bf16* WDN_T = (bf16*)(ws + WS_WDN);
    bf16* XN = (bf16*)(ws + WS_XN); bf16* C1 = (bf16*)(ws + WS_C1); float* KRP = (float*)(ws + WS_KRP); bf16* U = (bf16*)(ws + WS_U); bf16* Gt = (bf16*)(ws + WS_G);
    bf16* CN = (bf16*)(ws + WS_CN); bf16* POOLED = (bf16*)(ws + WS_POOLED); bf16* Qb = (bf16*)(ws + WS_Q); bf16* Kb = (bf16*)(ws + WS_K); bf16* Vb = (bf16*)(ws + WS_V);
    bf16* PG = (bf16*)(ws + WS_PG); bf16* MP = (bf16*)(ws + WS_MP); bf16* Ob = (bf16*)(ws + WS_O); bf16* MIXED = (bf16*)(ws + WS_MIXED);
    float* X1 = (float*)(ws + WS_X1); bf16* H2 = (bf16*)(ws + WS_H2); bf16* ACT = (bf16*)(ws + WS_ACT);

    const int lo = args.ph_lo, hi_ph = args.ph_hi;
#ifndef PHMASK
#define PHMASK 0x7ff
#endif
#define IN(k) (((PHMASK >> (k)) & 1) && lo <= (k) && (k) < hi_ph)
#define SEAM(k) do { if (IN(k) && IN((k) + 1)) { unsigned char* w2_ = args.ws; asm volatile("" : "+s"(w2_)); grid_bar((unsigned*)(w2_ + WS_BAR), (volatile LAS unsigned*)(ldsl + 140032)); } } while (0)
    if (args.coop > 1) cg::this_grid().sync();
    if (threadIdx.x < 2) ((volatile LAS unsigned*)(ldsl + 140032))[threadIdx.x] = 0u;
    __syncthreads();
    if (args.coop && threadIdx.x == 0) { unsigned char* w2_ = args.ws; asm volatile("" : "+s"(w2_)); (void)xb_add(&((unsigned*)(w2_ + WS_BAR))[XB_XCNT(xb_xcc_id())], 1u); }
    LAS float* scr = (LAS float*)(ldsl + wave * 16384);
#ifdef TPROBE
#define TP_BEGIN(k) do { if ((TPROBE >> (k)) & 1) { if (blockIdx.x == 0 && threadIdx.x == 0) { *(volatile LAS unsigned*)(ldsl + 140000) = (unsigned)__builtin_amdgcn_s_memrealtime(); } } } while (0)
#define TP_END(k) do { if ((TPROBE >> (k)) & 1) { if (blockIdx.x == 0 && threadIdx.x == 0) { volatile LAS unsigned* tp_ = (volatile LAS unsigned*)(ldsl + 140000); tp_[1] += (unsigned)__builtin_amdgcn_s_memrealtime() - tp_[0]; } } } while (0)
    if (blockIdx.x == 0 && threadIdx.x == 0) { ((volatile LAS unsigned*)(ldsl + 140000))[1] = 0u; }
#else
#define TP_BEGIN(k) do {} while (0)
#define TP_END(k) do {} while (0)
#endif

    if (IN(0)) { TP_BEGIN(0);
        { float* sv = (float*)ws; const int gt = bx * (NWAVES * 64) + tid, GT = G * NWAVES * 64;
          for (int i = gt; i < M; i += GT) sv[SV_SS + i] = 0.f;
          for (int i = gt; i < SV_END; i += GT) { int idx, off, lim = 1 << 30;
              if (i < SV_QAG) { idx = 4; off = SV_BGATE; } else if (i < SV_KVAG) { idx = 5; off = SV_QAG; } else if (i < SV_QNG) { idx = 7; off = SV_KVAG; }
              else if (i < SV_KNG) { idx = 9; off = SV_QNG; lim = 192; } else if (i < SV_PSC) { idx = 10; off = SV_KNG; lim = 192; }
              else if (i < SV_FNG) { idx = 13; off = SV_PSC; } else if (i < SV_POS) { idx = 16; off = SV_FNG; } else { idx = 1; off = SV_POS; }
              const float* src = kin[idx]; sv[i] = (i - off < lim) ? src[i - off] : 0.f; } }
        constexpr int I_IN = (DM / 64) * (DIN / 32), I_QB = (QLORA / 64) * (NH * DQK / 32), I_KVB = (KVLORA / 64) * (NH * 256 / 32), I_PG = (256 / 64) * (256 / 32),
                      I_PO = (POOLW / 64) * (DM / 32), I_AO = (DM / 64) * (DM / 32), I_OUT = I_AO;
        constexpr int NITEMS = I_IN + I_QB + I_KVB + 4 * I_PG + I_PO + I_AO + I_OUT;
#define P0_DESC(it__) ([&]() { int r = (it__), idx, Kd, Nd, mode = 0, roff = 0; size_t dsto, srco = 0; \
            if (r < I_IN) { idx = 3; Kd = DM; Nd = DIN; mode = 1; dsto = WS_WIN; } \
            else if ((r -= I_IN) < I_QB) { idx = 6; Kd = QLORA; Nd = NH * DQK; dsto = WS_WQB; } \
            else if ((r -= I_QB) < I_KVB) { idx = 8; Kd = KVLORA; Nd = NH * 256; dsto = WS_WKVB; } \
            else if ((r -= I_KVB) < 4 * I_PG) { const int g = r / I_PG; r = r % I_PG; idx = 12; Kd = 256; Nd = 256; dsto = WS_WPG; roff = g * 256; srco = (size_t)g * 65536; } \
            else if ((r -= 4 * I_PG) < I_PO) { idx = 14; Kd = POOLW; Nd = DM; dsto = WS_WPO; } \
            else if ((r -= I_PO) < I_AO) { idx = 11; Kd = DM; Nd = DM; dsto = WS_WAO; } \
            else { r -= I_AO; idx = 15; Kd = DM; Nd = DM; dsto = WS_WOUT; } \
            return tr_desc(kin[idx] + srco, Kd, Nd, (bf16*)(ws + dsto), mode, roff, r, nullptr); }())
        TR_PIPELINE(gw, NITEMS, NGW, P0_DESC);
#undef P0_DESC
        { v4u* z = (v4u*)(WIN_T + (size_t)DIN * DM); const int nz = (DIN_PAD - DIN) * DM / 8;
          for (int i = gw * 64 + lane; i < nz; i += NGW * 64) z[i] = (v4u){0u, 0u, 0u, 0u}; }
        { const float* x = kin[0]; const float* attn_norm_g = kin[2];
          for (int m = gw; m < M; m += NGW) rms_row_2048(x + (size_t)m * DM, attn_norm_g, XN + (size_t)m * DM, lane); }
    TP_END(0); }
    SEAM(0);
    if (IN(1)) { TP_BEGIN(1);
        { pg8::Gemm g{XN, WIN_T, M, 6144, DM, DM, DM, 0, 0}; pg8::StaticOrder S; S.init(M, 6144, G, bx);
          pg8::EpiIn E{C1, U, Gt, b_gate};
          pg8::gemm_phase<pg8::EpiIn, pg8::StaticOrder>(ldsl, g, S, E); }
        { pg8::Gemm g{XN, WIN_T + (size_t)6144 * DM, M, 2048, 256, DM, DM, 256, 256}; pg8::StaticOrder S; S.init(M, 2048, G, bx);
          pg8::EpiKRP E{KRP};
          pg8::gemm_phase<pg8::EpiKRP, pg8::StaticOrder>(ldsl, g, S, E); }
    TP_END(1); }
    SEAM(1);
    if (IN(2)) { TP_BEGIN(2);
        for (int m = gw; m < M; m += NGW) {
            const v4u cq = __builtin_nontemporal_load((const v4u*)(C1 + (size_t)m * 1024 + 8 * lane)), ck = __builtin_nontemporal_load((const v4u*)(C1 + (size_t)m * 1024 + 512 + 8 * lane));
            const float fq_[8] = {bflo(cq.x), bfhi(cq.x), bflo(cq.y), bfhi(cq.y), bflo(cq.z), bfhi(cq.z), bflo(cq.w), bfhi(cq.w)};
            const float fk_[8] = {bflo(ck.x), bfhi(ck.x), bflo(ck.y), bfhi(ck.y), bflo(ck.z), bfhi(ck.z), bflo(ck.w), bfhi(ck.w)};
            float sq = 0.f, skv = 0.f;
#pragma unroll
            for (int e = 0; e < 8; ++e) { sq += fq_[e] * fq_[e]; skv += fk_[e] * fk_[e]; }
            const float iq = 1.0f / sqrtf(wave_sum(sq) * (1.f / 512.f) + EPS), ikv = 1.0f / sqrtf(wave_sum(skv) * (1.f / 512.f) + EPS);
            if (lane < 16) { f32x4 acc4 = {0.f, 0.f, 0.f, 0.f};
#pragma unroll
                for (int ks = 0; ks < 8; ++ks) acc4 += __builtin_nontemporal_load((const f32x4*)(KRP + ((size_t)ks * 8192 + m) * 64 + 4 * lane));
                *(f32x4*)((float*)(ws + WS_KR) + (size_t)m * 64 + 4 * lane) = acc4; }
            const f32x4 gq0 = ((const f32x4*)q_a_norm_g)[2 * lane], gq1 = ((const f32x4*)q_a_norm_g)[2 * lane + 1], gk0 = ((const f32x4*)kv_a_norm_g)[2 * lane], gk1 = ((const f32x4*)kv_a_norm_g)[2 * lane + 1];
            v4u oq, ok;
            oq.x = cvtpk(fq_[0] * iq * gq0.x, fq_[1] * iq * gq0.y); oq.y = cvtpk(fq_[2] * iq * gq0.z, fq_[3] * iq * gq0.w); oq.z = cvtpk(fq_[4] * iq * gq1.x, fq_[5] * iq * gq1.y); oq.w = cvtpk(fq_[6] * iq * gq1.z, fq_[7] * iq * gq1.w);
            ok.x = cvtpk(fk_[0] * ikv * gk0.x, fk_[1] * ikv * gk0.y); ok.y = cvtpk(fk_[2] * ikv * gk0.z, fk_[3] * ikv * gk0.w); ok.z = cvtpk(fk_[4] * ikv * gk1.x, fk_[5] * ikv * gk1.y); ok.w = cvtpk(fk_[6] * ikv * gk1.z, fk_[7] * ikv * gk1.w);
            *(v4u*)(CN + (size_t)m * 1024 + 8 * lane) = oq; *(v4u*)(CN + (size_t)m * 1024 + 512 + 8 * lane) = ok;
        }
        for (int base = gw * 4; base < M; base += NGW * 4) {
            const int s0 = base & (SEQ - 1);
#pragma unroll
            for (int jj = 0; jj < 2; ++jj) {
                const int col = 8 * lane + 512 * jj, grp = col >> 8, w = 2 << grp; int cnt = (s0 + 1 < w) ? s0 + 1 : w;
                float a[8], uc[8];
#pragma unroll
                for (int e = 0; e < 8; ++e) a[e] = 0.f;
#pragma unroll
                for (int d = 0; d < 16; ++d) {
                    if (d < cnt) { const v4u q = *(const v4u*)(U + (size_t)(base - d) * 1024 + col);
                        const float f[8] = {bflo(q.x), bfhi(q.x), bflo(q.y), bfhi(q.y), bflo(q.z), bfhi(q.z), bflo(q.w), bfhi(q.w)};
#pragma unroll
                        for (int e = 0; e < 8; ++e) { a[e] += f[e]; if (d == 0) uc[e] = f[e]; } }
                }
#pragma unroll
                for (int i = 0; i < 4; ++i) {
                    const int m = base + i;
                    if (i > 0) { const int s = s0 + i;
                        { const v4u q = *(const v4u*)(U + (size_t)m * 1024 + col);
                          uc[0] = bflo(q.x); uc[1] = bfhi(q.x); uc[2] = bflo(q.y); uc[3] = bfhi(q.y); uc[4] = bflo(q.z); uc[5] = bfhi(q.z); uc[6] = bflo(q.w); uc[7] = bfhi(q.w); }
#pragma unroll
                        for (int e = 0; e < 8; ++e) a[e] += uc[e];
                        if (s >= w) { const v4u q = *(const v4u*)(U + (size_t)(m - w) * 1024 + col);
                            a[0] -= bflo(q.x); a[1] -= bfhi(q.x); a[2] -= bflo(q.y); a[3] -= bfhi(q.y); a[4] -= bflo(q.z); a[5] -= bfhi(q.z); a[6] -= bflo(q.w); a[7] -= bfhi(q.w); }
                        cnt = (s + 1 < w) ? s + 1 : w; }
                    const float rc = 1.0f / (float)cnt;
                    v4u o; o.x = cvtpk(a[0] * rc - uc[0], a[1] * rc - uc[1]); o.y = cvtpk(a[2] * rc - uc[2], a[3] * rc - uc[3]);
                    o.z = cvtpk(a[4] * rc - uc[4], a[5] * rc - uc[5]); o.w = cvtpk(a[6] * rc - uc[6], a[7] * rc - uc[7]);
                    *(v4u*)(POOLED + (size_t)m * 1024 + col) = o;
                }
            }
        }
    TP_END(2); }
    SEAM(2);
    if (IN(3)) { TP_BEGIN(3);
        { pg8::Gemm g{CN, WQB_T, M, NH * DQK, QLORA, 1024, QLORA, 0, 0}; pg8::StaticOrder S; S.init(M, NH * DQK, G, bx);
          pg8::EpiBf16 E{Qb, 3072}; pg8::gemm_phase<pg8::EpiBf16, pg8::StaticOrder>(ldsl, g, S, E); }
        { pg8::Gemm g{CN + 512, WKVB_T, M, NH * 256, KVLORA, 1024, KVLORA, 0, 0}; pg8::StaticOrder S; S.init(M, NH * 256, G, bx);
          pg8::EpiKV E{Kb, Vb}; pg8::gemm_phase<pg8::EpiKV, pg8::StaticOrder>(ldsl, g, S, E); }
        { pg8::Gemm g{POOLED, WPG_T, M, POOLW, 256, 1024, 256, 256, 0}; pg8::StaticOrder S; S.init(M, POOLW, G, (bx + 128) % G);
          pg8::EpiScale E{PG, 1024, pool_scale}; pg8::gemm_phase<pg8::EpiScale, pg8::StaticOrder>(ldsl, g, S, E); }
    TP_END(3); }
    SEAM(3);
    if (IN(4)) { TP_BEGIN(4);
        for (int m = gw; m < M; m += NGW) {
            const float pos = (float)positions[m];
            const int sub = lane & 3, h = lane >> 2;
            float cs[8], sn[8];
#pragma unroll
            for (int j = 0; j < 8; ++j) { const int i = 8 * sub + j; const float invf = __builtin_amdgcn_exp2f(-(float)i * (13.287712379549449f / 32.f));
                const float ang = pos * invf; const float k = rintf(ang * 0.15915494309189535f);
                float r = fmaf(-k, 6.2831854820251465f, ang); r = fmaf(-k, -1.7484555e-7f, r);
                sn[j] = __sinf(r); cs[j] = __cosf(r); }
#pragma unroll
            for (int which = 0; which < 2; ++which) {
                bf16* base = (which == 0 ? Qb : Kb) + (size_t)m * 3072 + h * DQK;
                const float* gn = (which == 0) ? q_norm_g : k_norm_g;
                float nv[32], rl[8], rh[8]; float ss = 0.f;
#pragma unroll
                for (int jj = 0; jj < 4; ++jj) { const v4u q = *(const v4u*)(base + 32 * sub + 8 * jj);
                    nv[8 * jj + 0] = bflo(q.x); nv[8 * jj + 1] = bfhi(q.x); nv[8 * jj + 2] = bflo(q.y); nv[8 * jj + 3] = bfhi(q.y);
                    nv[8 * jj + 4] = bflo(q.z); nv[8 * jj + 5] = bfhi(q.z); nv[8 * jj + 6] = bflo(q.w); nv[8 * jj + 7] = bfhi(q.w); }
                if (which == 0) {
                    const v4u a = *(const v4u*)(base + 128 + 8 * sub), b = *(const v4u*)(base + 160 + 8 * sub);
                    rl[0] = bflo(a.x); rl[1] = bfhi(a.x); rl[2] = bflo(a.y); rl[3] = bfhi(a.y); rl[4] = bflo(a.z); rl[5] = bfhi(a.z); rl[6] = bflo(a.w); rl[7] = bfhi(a.w);
                    rh[0] = bflo(b.x); rh[1] = bfhi(b.x); rh[2] = bflo(b.y); rh[3] = bfhi(b.y); rh[4] = bflo(b.z); rh[5] = bfhi(b.z); rh[6] = bflo(b.w); rh[7] = bfhi(b.w);
                } else {
                    const float* kp = (const float*)(ws + WS_KR) + (size_t)m * 64 + 8 * sub;
                    const f32x4 a0 = *(const f32x4*)kp, a1 = *(const f32x4*)(kp + 4), b0 = *(const f32x4*)(kp + 32), b1 = *(const f32x4*)(kp + 36);
                    rl[0] = a0.x; rl[1] = a0.y; rl[2] = a0.z; rl[3] = a0.w; rl[4] = a1.x; rl[5] = a1.y; rl[6] = a1.z; rl[7] = a1.w;
                    rh[0] = b0.x; rh[1] = b0.y; rh[2] = b0.z; rh[3] = b0.w; rh[4] = b1.x; rh[5] = b1.y; rh[6] = b1.z; rh[7] = b1.w;
                }
#pragma unroll
                for (int e = 0; e < 32; ++e) ss += nv[e] * nv[e];
#pragma unroll
                for (int e = 0; e < 8; ++e) ss += rl[e] * rl[e] + rh[e] * rh[e];
                ss += __shfl_xor(ss, 1); ss += __shfl_xor(ss, 2);
                const float inv = 1.0f / sqrtf(ss * (1.f / 192.f) + EPS);
#pragma unroll
                for (int jj = 0; jj < 4; ++jj) { const f32x4 g0 = *(const f32x4*)(gn + 32 * sub + 8 * jj), g1 = *(const f32x4*)(gn + 32 * sub + 8 * jj + 4);
                    v4u o; o.x = cvtpk(nv[8 * jj + 0] * inv * g0.x, nv[8 * jj + 1] * inv * g0.y); o.y = cvtpk(nv[8 * jj + 2] * inv * g0.z, nv[8 * jj + 3] * inv * g0.w);
                    o.z = cvtpk(nv[8 * jj + 4] * inv * g1.x, nv[8 * jj + 5] * inv * g1.y); o.w = cvtpk(nv[8 * jj + 6] * inv * g1.z, nv[8 * jj + 7] * inv * g1.w);
                    *(v4u*)(base + 32 * sub + 8 * jj) = o; }
                float ol[8], oh[8];
#pragma unroll
                for (int e = 0; e < 8; ++e) { const float a = rl[e] * inv * gn[128 + 8 * sub + e], b = rh[e] * inv * gn[160 + 8 * sub + e];
                    ol[e] = a * cs[e] - b * sn[e]; oh[e] = b * cs[e] + a * sn[e]; }
                v4u o1, o2; o1.x = cvtpk(ol[0], ol[1]); o1.y = cvtpk(ol[2], ol[3]); o1.z = cvtpk(ol[4], ol[5]); o1.w = cvtpk(ol[6], ol[7]);
                o2.x = cvtpk(oh[0], oh[1]); o2.y = cvtpk(oh[2], oh[3]); o2.z = cvtpk(oh[4], oh[5]); o2.w = cvtpk(oh[6], oh[7]);
                *(v4u*)(base + 128 + 8 * sub) = o1; *(v4u*)(base + 160 + 8 * sub) = o2;
            }
        }
        { pg8::Gemm g{PG, WPO_T, M, DM, POOLW, POOLW, POOLW, 0, 0}; pg8::StaticOrder S; S.init(M, DM, G, bx);
          pg8::EpiGate<false> E{MP, Gt, nullptr, 0}; pg8::gemm_phase<pg8::EpiGate<false>, pg8::StaticOrder>(ldsl, g, S, E); }
    TP_END(4); }
    SEAM(4);
    if (IN(5)) { TP_BEGIN(5);
        const int npair = BATCH * NH * 8;
        for (int p = vcu; p < npair; p += G) {
            const int bh = p >> 3, s = p & 7;
            att::attn_unit(bh / NH, bh % NH, 15 - s, Qb, Kb, Vb, Ob, (char*)lds);
            att::attn_unit(bh / NH, bh % NH, s, Qb, Kb, Vb, Ob, (char*)lds);
        }
    TP_END(5); }
    SEAM(5);
    if (IN(6)) { TP_BEGIN(6);
        pg8::Gemm g{Ob, WAO_T, M, DM, DM, DM, DM, 0, 0}; pg8::StaticOrder S; S.init(M, DM, G, bx);
        pg8::EpiGate<true> E{MIXED, Gt, MP, 2048}; pg8::gemm_phase<pg8::EpiGate<true>, pg8::StaticOrder>(ldsl, g, S, E);
    TP_END(6); }
    SEAM(6);
    if (IN(7)) { TP_BEGIN(7);
        { constexpr int I_G = (DM / 64) * (DFF / 32);
#define GU_DESC(it__) ((it__) < I_G ? tr_desc(kin[17], DM, DFF, (bf16*)(ws + WS_WGU), 2, 0, (it__), ffn_norm_g) : tr_desc(kin[18], DM, DFF, (bf16*)(ws + WS_WGU), 3, 0, (it__) - I_G, ffn_norm_g))
          TR_PIPELINE(gw, 2 * I_G, NGW, GU_DESC);
#undef GU_DESC
          __syncthreads(); }
        pg8::Gemm g{MIXED, WOUT_T, M, DM, DM, DM, DM, 0, 0}; pg8::StaticOrder S; S.init(M, DM, G, bx);
        pg8::EpiResNorm E{kin[0], X1, (bf16*)(ws + WS_X1B), (float*)ws + SV_SS, DM}; pg8::gemm_phase<pg8::EpiResNorm, pg8::StaticOrder>(ldsl, g, S, E);
    TP_END(7); }
    SEAM(7);
    if (IN(9)) { TP_BEGIN(9);
        pg8::Gemm g{(bf16*)(ws + WS_X1B), WGU_T, M, 2 * DFF, DM, DM, DM, 0, 0}; pg8::StaticOrder S; S.init(M, 2 * DFF, G, bx);
        pg8::EpiSwiGLU E{ACT, DFF, (const float*)ws + SV_SS}; pg8::gemm_phase<pg8::EpiSwiGLU, pg8::StaticOrder>(ldsl, g, S, E);
        if (G == 256 ? (bx >= 128) : true) {
            constexpr int I_D2 = (DFF / 64) * (DM / 32);
            const int nw = (G == 256) ? 128 * NWAVES : NGW, w0 = (G == 256) ? (bx - 128) * NWAVES + wave : gw;
#define DN_DESC(it__) tr_desc(kin[19], DFF, DM, (bf16*)(ws + WS_WDN), 0, 0, (it__), nullptr)
            TR_PIPELINE(w0, I_D2, nw, DN_DESC);
#undef DN_DESC
        }
    TP_END(9); }
    SEAM(9);
    if (IN(10)) { TP_BEGIN(10);
        pg8::Gemm g{ACT, WDN_T, M, DM, DFF, DFF, DFF, 0, 0}; pg8::StaticOrder S; S.init(M, DM, G, bx);
        pg8::EpiRes E{(const bf16*)(ws + WS_X1B), args.out, DM}; pg8::gemm_phase<pg8::EpiRes, pg8::StaticOrder>(ldsl, g, S, E);
    TP_END(10); }
#ifdef TPROBE
    if (blockIdx.x == 0 && threadIdx.x == 0) { const unsigned w_ = 4u * ((volatile LAS unsigned*)(ldsl + 140000))[1]; const unsigned long long t0_ = __builtin_amdgcn_s_memrealtime(); while ((unsigned)(__builtin_amdgcn_s_memrealtime() - t0_) < w_) __builtin_amdgcn_s_sleep(8); }
#endif
#undef IN
#undef SEAM
}

extern "C" void kernel_launch(void* const* d_in, const int* in_sizes, int n_in, void* d_out, int out_size, void* d_ws, size_t ws_size, hipStream_t stream) {
    static int grid = 0;
    if (grid == 0) {
        if (n_in != 20 || out_size != M * DM || ws_size < WS_END) { fprintf(stderr, "kernel_launch: unexpected shapes (n_in %d, out %d, ws %zu)\n", n_in, out_size, ws_size); grid = -1; return; }
        int dev = 0, cus = 0, per_cu = 0;
        (void)hipGetDevice(&dev); (void)hipDeviceGetAttribute(&cus, hipDeviceAttributeMultiprocessorCount, dev);
        if (hipFuncSetAttribute((const void*)mega_fwd, hipFuncAttributeMaxDynamicSharedMemorySize, LDS_BYTES) != hipSuccess) { fprintf(stderr, "kernel_launch: hipFuncSetAttribute failed\n"); grid = -1; return; }
        if (hipOccupancyMaxActiveBlocksPerMultiprocessor(&per_cu, (const void*)mega_fwd, NWAVES * 64, LDS_BYTES) != hipSuccess || per_cu < 1) { fprintf(stderr, "kernel_launch: occupancy query says %d\n", per_cu); per_cu = 1; }
        (void)hipGetLastError();
        grid = cus > 0 ? cus : 256;
    }
    if (grid < 0) return;
    Args a{};
    for (int i = 0; i < 20; ++i) a.in[i] = (const float*)d_in[i];
    a.out = (float*)d_out; a.ws = (unsigned char*)d_ws;
    if (MK_N_LAUNCHES == 1) {
        a.ph_lo = 0; a.ph_hi = NPH; a.coop = 1;
        (void)hipMemsetAsync((char*)d_ws + WS_BAR, 0, 16384, stream);
        void* kargs[] = {&a};
        hipError_t e = hipLaunchCooperativeKernel((const void*)mega_fwd, dim3(grid), dim3(NWAVES * 64), kargs, LDS_BYTES, stream);
        if (e != hipSuccess) fprintf(stderr, "kernel_launch: cooperative launch failed: %s (grid %d)\n", hipGetErrorString(e), grid);
    } else {
        for (int p = 0; p < NPH; ++p) {
            a.ph_lo = p; a.ph_hi = p + 1;
            hipLaunchKernelGGL(mega_fwd, dim3(grid), dim3(NWAVES * 64), LDS_BYTES, stream, a);
        }
    }
}
```

```cpp
#include <hip/hip_runtime.h>
#include <hip/hip_cooperative_groups.h>
#include <cstdio>
#include <cstdint>
namespace cg = cooperative_groups;

#ifndef MK_N_LAUNCHES
#define MK_N_LAUNCHES 1
#endif

namespace pg8 {
#define PG8_LAS __attribute__((address_space(3)))
typedef unsigned short bf16_t;
typedef short bf16x8 __attribute__((ext_vector_type(8)));
typedef float f32x4 __attribute__((ext_vector_type(4)));
typedef unsigned u32x4 __attribute__((ext_vector_type(4)));
constexpr int BM = 256, BK = 64, HALF = 128, HTB = HALF * BK * 2, STAGE_BYTES = 8 * HTB, NXCD = 8, WGM = 8;

__host__ __device__ __forceinline__ int lds_byte(int r, int c) { const int st = (r >> 4) * 2 + (c >> 5), rr = r & 15, cc = c & 31, ob = rr * 64 + cc * 2; return st * 1024 + (ob ^ (((ob >> 9) & 1) << 5)); }
__host__ __device__ __forceinline__ void stage_rc(int b, int& R, int& C) { const int st = b / 1024, sb = b % 1024, swz = sb ^ (((sb >> 9) & 1) << 5); R = (st >> 1) * 16 + swz / 64; C = (st & 1) * 32 + (swz % 64) / 2; }
__host__ __device__ __forceinline__ int perm32(int rho) { const int n = rho >> 4, i = rho & 15; return 8 * (i >> 2) + 4 * n + (i & 3); }

struct Unit { int pm, pn; };
struct Gemm { const bf16_t* A; const bf16_t* Bt; int M, N, K, lda, ldb, a_pn_step, b_pn_step; };

struct StaticOrder {
    int nM, nN, nwg, G, c;
    __host__ __device__ void init(int M, int N, int G_, int c_) { nM = M / BM; nN = N / BM; nwg = nM * nN; G = G_; c = c_; }
    __host__ __device__ bool next(int i, Unit& u) const {
        const long L = (long)i * G + c; if (L >= nwg) return false;
        int wgid = (int)L; { const int q = nwg / NXCD, r = nwg % NXCD, xcd = wgid % NXCD, off = wgid / NXCD; wgid = (xcd < r ? xcd * (q + 1) : r * (q + 1) + (xcd - r) * q) + off; }
        const int nig = WGM * nN, gid = wgid / nig, fm = gid * WGM, gsz = (nM - fm) < WGM ? (nM - fm) : WGM;
        u.pm = fm + ((wgid % nig) % gsz); u.pn = (wgid % nig) / gsz; return true;
    }
};

typedef float f32x2_t_ __attribute__((ext_vector_type(2))); typedef __bf16 bf16x2_t_ __attribute__((ext_vector_type(2)));
__device__ __forceinline__ unsigned cvt_pk_bf16(float lo, float hi) { f32x2_t_ v = {lo, hi}; bf16x2_t_ b = __builtin_convertvector(v, bf16x2_t_); return __builtin_bit_cast(unsigned, b); }
__device__ __forceinline__ u32x4 pack8(f32x4 a, f32x4 b) { u32x4 w; w.x = cvt_pk_bf16(a[0], a[1]); w.y = cvt_pk_bf16(a[2], a[3]); w.z = cvt_pk_bf16(b[0], b[1]); w.w = cvt_pk_bf16(b[2], b[3]); return w; }
__device__ __forceinline__ void unpack8(u32x4 w, f32x4& a, f32x4& b) {
    a[0] = __uint_as_float(w.x << 16); a[1] = __uint_as_float(w.x & 0xffff0000u); a[2] = __uint_as_float(w.y << 16); a[3] = __uint_as_float(w.y & 0xffff0000u);
    b[0] = __uint_as_float(w.z << 16); b[1] = __uint_as_float(w.z & 0xffff0000u); b[2] = __uint_as_float(w.w << 16); b[3] = __uint_as_float(w.w & 0xffff0000u); }
__device__ __forceinline__ float sigmoidf_(float v) { return __builtin_amdgcn_rcpf(1.0f + __builtin_amdgcn_exp2f(-1.4426950408889634f * v)); }
__device__ __forceinline__ f32x4 sigmoid4(f32x4 v) { f32x4 o; o[0] = sigmoidf_(v[0]); o[1] = sigmoidf_(v[1]); o[2] = sigmoidf_(v[2]); o[3] = sigmoidf_(v[3]); return o; }

typedef f32x4 AccT[2][2][4][2];
#define EPI_LOOP_AM _Pragma("unroll") for (int ai = 0; ai < 2; ++ai) _Pragma("unroll") for (int m = 0; m < 4; ++m)
#define EPI_LOOP_B _Pragma("unroll") for (int bj = 0; bj < 2; ++bj)

struct EpiIn {
    static constexpr bool PERM = true;
    bf16_t* C1; bf16_t* U; bf16_t* G; const float* bgate;
    __device__ __forceinline__ void operator()(const AccT& acc, const Unit& u, int wr, int wc, int fr, int fq) const {
        const int row0 = u.pm * BM + wr * 64 + fr, pn = u.pn, cw = wc * 32 + 8 * fq;
        if (pn < 4) {
            EPI_LOOP_AM { bf16_t* rp = C1 + (size_t)(row0 + ai * HALF + m * 16) * 1024 + pn * 256 + cw;
                EPI_LOOP_B { *(u32x4*)(rp + bj * HALF) = pack8(acc[ai][bj][m][0], acc[ai][bj][m][1]); } }
        } else if (pn < 8) {
            EPI_LOOP_AM { bf16_t* rp = U + (size_t)(row0 + ai * HALF + m * 16) * 1024 + (pn - 4) * 256 + cw;
                EPI_LOOP_B { *(u32x4*)(rp + bj * HALF) = pack8(acc[ai][bj][m][0], acc[ai][bj][m][1]); } }
        } else {
            const int gc = (pn - 8) * 256 + cw; f32x4 bv[2][2];
            EPI_LOOP_B { bv[bj][0] = *(const f32x4*)(bgate + gc + bj * HALF); bv[bj][1] = *(const f32x4*)(bgate + gc + bj * HALF + 4); }
            EPI_LOOP_AM { bf16_t* rp = G + (size_t)(row0 + ai * HALF + m * 16) * 4096 + gc;
                EPI_LOOP_B { *(u32x4*)(rp + bj * HALF) = pack8(sigmoid4(acc[ai][bj][m][0] + bv[bj][0]), sigmoid4(acc[ai][bj][m][1] + bv[bj][1])); } }
        }
    }
};
struct EpiKRP {
    static constexpr bool PERM = true;
    float* KRP;
    __device__ __forceinline__ void operator()(const AccT& acc, const Unit& u, int wr, int wc, int fr, int fq) const {
        const int row0 = u.pm * BM + wr * 64 + fr, cw = wc * 32 + 8 * fq;
        if (wc < 2) { EPI_LOOP_AM { float* rp = KRP + ((size_t)u.pn * 8192 + (row0 + ai * HALF + m * 16)) * 64 + cw; *(f32x4*)rp = acc[ai][0][m][0]; *(f32x4*)(rp + 4) = acc[ai][0][m][1]; } }
    }
};
struct EpiBf16 {
    static constexpr bool PERM = true;
    bf16_t* O; int ldc;
    __device__ __forceinline__ void operator()(const AccT& acc, const Unit& u, int wr, int wc, int fr, int fq) const {
        const int row0 = u.pm * BM + wr * 64 + fr, col0 = u.pn * BM + wc * 32 + 8 * fq;
        EPI_LOOP_AM { bf16_t* rp = O + (size_t)(row0 + ai * HALF + m * 16) * ldc + col0;
            EPI_LOOP_B { *(u32x4*)(rp + bj * HALF) = pack8(acc[ai][bj][m][0], acc[ai][bj][m][1]); } }
    }
};
struct EpiKV {
    static constexpr bool PERM = true;
    bf16_t* K; bf16_t* V;
    __device__ __forceinline__ void operator()(const AccT& acc, const Unit& u, int wr, int wc, int fr, int fq) const {
        const int row0 = u.pm * BM + wr * 64 + fr, cw = wc * 32 + 8 * fq, h = u.pn;
        EPI_LOOP_AM { const size_t row = (size_t)(row0 + ai * HALF + m * 16);
            *(u32x4*)(K + row * 3072 + h * 192 + cw) = pack8(acc[ai][0][m][0], acc[ai][0][m][1]);
            *(u32x4*)(V + row * 2048 + h * 128 + cw) = pack8(acc[ai][1][m][0], acc[ai][1][m][1]); }
    }
};
struct EpiScale {
    static constexpr bool PERM = true;
    bf16_t* O; int ldc; const float* scale;
    __device__ __forceinline__ void operator()(const AccT& acc, const Unit& u, int wr, int wc, int fr, int fq) const {
        const int row0 = u.pm * BM + wr * 64 + fr, col0 = u.pn * BM + wc * 32 + 8 * fq; f32x4 sv[2][2];
        EPI_LOOP_B { sv[bj][0] = *(const f32x4*)(scale + col0 + bj * HALF); sv[bj][1] = *(const f32x4*)(scale + col0 + bj * HALF + 4); }
        EPI_LOOP_AM { bf16_t* rp = O + (size_t)(row0 + ai * HALF + m * 16) * ldc + col0;
            EPI_LOOP_B { *(u32x4*)(rp + bj * HALF) = pack8(acc[ai][bj][m][0] * sv[bj][0], acc[ai][bj][m][1] * sv[bj][1]); } }
    }
};
template <bool HAS_ADD> struct EpiGate {
    static constexpr bool PERM = true;
    bf16_t* O; const bf16_t* gate; const bf16_t* add; int gcol0;
    __device__ __forceinline__ void operator()(const AccT& acc, const Unit& u, int wr, int wc, int fr, int fq) const {
        const int row0 = u.pm * BM + wr * 64 + fr, col0 = u.pn * BM + wc * 32 + 8 * fq;
        EPI_LOOP_AM { const size_t row = (size_t)(row0 + ai * HALF + m * 16);
            EPI_LOOP_B { f32x4 g0, g1; unpack8(__builtin_nontemporal_load((const u32x4*)(gate + row * 4096 + gcol0 + col0 + bj * HALF)), g0, g1);
                f32x4 v0 = g0 * acc[ai][bj][m][0], v1 = g1 * acc[ai][bj][m][1];
                if (HAS_ADD) { f32x4 a0, a1; unpack8(__builtin_nontemporal_load((const u32x4*)(add + row * 2048 + col0 + bj * HALF)), a0, a1); v0 += a0; v1 += a1; }
                *(u32x4*)(O + row * 2048 + col0 + bj * HALF) = pack8(v0, v1); } }
    }
};
struct EpiRes {
    static constexpr bool PERM = true;
    const bf16_t* base; float* out; int ldc;
    __device__ __forceinline__ void operator()(const AccT& acc, const Unit& u, int wr, int wc, int fr, int fq) const {
        const int row0 = u.pm * BM + wr * 64 + fr, col0 = u.pn * BM + wc * 32 + 8 * fq;
        EPI_LOOP_AM { const size_t off = (size_t)(row0 + ai * HALF + m * 16) * ldc + col0;
            EPI_LOOP_B { f32x4 b0, b1; unpack8(__builtin_nontemporal_load((const u32x4*)(base + off + bj * HALF)), b0, b1);
                __builtin_nontemporal_store(b0 + acc[ai][bj][m][0], (f32x4*)(out + off + bj * HALF)); __builtin_nontemporal_store(b1 + acc[ai][bj][m][1], (f32x4*)(out + off + bj * HALF + 4)); } }
    }
};
struct EpiResNorm {
    static constexpr bool PERM = true;
    const float* base; float* out; bf16_t* outb; float* ss; int ldc;
    __device__ __forceinline__ void operator()(const AccT& acc, const Unit& u, int wr, int wc, int fr, int fq) const {
        const int row0 = u.pm * BM + wr * 64 + fr, col0 = u.pn * BM + wc * 32 + 8 * fq;
        EPI_LOOP_AM { const int row = row0 + ai * HALF + m * 16; const size_t off = (size_t)row * ldc + col0; float s = 0.f;
            EPI_LOOP_B { const f32x4 v0 = __builtin_nontemporal_load((const f32x4*)(base + off + bj * HALF)) + acc[ai][bj][m][0], v1 = __builtin_nontemporal_load((const f32x4*)(base + off + bj * HALF + 4)) + acc[ai][bj][m][1];
                *(u32x4*)(outb + off + bj * HALF) = pack8(v0, v1);
                s += ((v0[0] * v0[0] + v0[1] * v0[1]) + (v0[2] * v0[2] + v0[3] * v0[3])) + ((v1[0] * v1[0] + v1[1] * v1[1]) + (v1[2] * v1[2] + v1[3] * v1[3])); }
            s += __shfl_xor(s, 16); s += __shfl_xor(s, 32);
            if (fq == 0) atomicAdd(ss + row, s); }
    }
};
struct EpiSwiGLU {
    static constexpr bool PERM = true;
    bf16_t* O; int ldc; const float* ss;
    __device__ __forceinline__ void operator()(const AccT& acc, const Unit& u, int wr, int wc, int fr, int fq) const {
        const int row0 = u.pm * BM + wr * 64 + fr, col0 = u.pn * HALF + wc * 32 + 8 * fq;
        EPI_LOOP_AM { const int row = row0 + ai * HALF + m * 16; bf16_t* rp = O + (size_t)row * ldc + col0;
            const float inv = 1.0f / sqrtf(ss[row] * (1.f / 2048.f) + 1e-6f);
            const f32x4 g0 = acc[ai][0][m][0] * inv, g1 = acc[ai][0][m][1] * inv;
            *(u32x4*)rp = pack8(g0 * sigmoid4(g0) * (acc[ai][1][m][0] * inv), g1 * sigmoid4(g1) * (acc[ai][1][m][1] * inv)); }
    }
};

template <class Epi, class Sched, bool ALIGN_EPI = true>
__device__ __forceinline__ void gemm_phase(PG8_LAS unsigned char* lds, const Gemm g, const Sched& S, const Epi& E) {
    const int tid = threadIdx.x, wid = __builtin_amdgcn_readfirstlane(tid >> 6), lane = tid & 63, wr = wid >> 2, wc = wid & 3, fr = lane & 15, fq = lane >> 4;
    const int K = g.K, nt = K / BK;
    unsigned voffA[2], voffB[2];
#pragma unroll
    for (int i = 0; i < 2; ++i) { int R, C; stage_rc(tid * 16 + i * 8192, R, C); const int Rb = Epi::PERM ? ((R & ~31) + perm32(R & 31)) : R;
        voffA[i] = (unsigned)(R * g.lda + C) * 2u; voffB[i] = (unsigned)(Rb * g.ldb + C) * 2u; }
    const size_t kstep = (size_t)(BK * 2);
    const size_t hstepA = (size_t)HALF * g.lda * 2, hstepB = (size_t)HALF * g.ldb * 2;
    const size_t tstepA = 2 * hstepA, tstepB = g.b_pn_step ? (size_t)g.b_pn_step * 2 : 2 * hstepB, pstepA = (size_t)g.a_pn_step * 2;
    const unsigned ldsw = (unsigned)wid * 1024u;
    const int aoff = lds_byte(wr * 64 + fr, fq * 8), boff = lds_byte(wc * 32 + fr, fq * 8);
#define PG8_SA(b, h) (((b) * 2 + (h)) * HTB)
#define PG8_SB(b, h) ((4 + (b) * 2 + (h)) * HTB)
#define PG8_STAGE(bufoff, gbase, voff) do { _Pragma("unroll") for (int _i = 0; _i < 2; ++_i) \
        __builtin_amdgcn_global_load_lds((const unsigned*)((const char*)(gbase) + (voff)[_i]), (PG8_LAS unsigned*)(lds + (bufoff) + ldsw + _i * 8192), 16, 0, 0); } while (0)
#define PG8_LDA(dst, b, h) do { _Pragma("unroll") for (int m = 0; m < 4; ++m) _Pragma("unroll") for (int k = 0; k < 2; ++k) dst[m][k] = *(const PG8_LAS bf16x8*)(lds + PG8_SA(b, h) + aoff + m * 2048 + k * 1024); } while (0)
#define PG8_LDB(dst, b, h) do { _Pragma("unroll") for (int n = 0; n < 2; ++n) _Pragma("unroll") for (int k = 0; k < 2; ++k) dst[n][k] = *(const PG8_LAS bf16x8*)(lds + PG8_SB(b, h) + boff + n * 2048 + k * 1024); } while (0)
#define PG8_MMA(ai, bj, At, Bt) do { __builtin_amdgcn_s_setprio(1); _Pragma("unroll") for (int m = 0; m < 4; ++m) _Pragma("unroll") for (int n = 0; n < 2; ++n) _Pragma("unroll") for (int k = 0; k < 2; ++k) \
        acc[ai][bj][m][n] = __builtin_amdgcn_mfma_f32_16x16x32_bf16(Bt[n][k], At[m][k], acc[ai][bj][m][n], 0, 0, 0); __builtin_amdgcn_s_setprio(0); } while (0)
#define PG8_WAIT_V(n) asm volatile("s_waitcnt vmcnt(" #n ")" ::: "memory")
#define PG8_WAIT_L(n) asm volatile("s_waitcnt lgkmcnt(" #n ")" ::: "memory")
#define PG8_BAR __builtin_amdgcn_s_barrier()
#define PG8_SCHED __builtin_amdgcn_sched_barrier(0)
    Unit cur, nxt; int ui = 0;
    if (!S.next(0, cur)) return;
    f32x4 acc[2][2][4][2];
#pragma unroll
    for (int a = 0; a < 2; ++a)
#pragma unroll
        for (int b = 0; b < 2; ++b)
#pragma unroll
            for (int m = 0; m < 4; ++m)
#pragma unroll
                for (int n = 0; n < 2; ++n) acc[a][b][m][n] = (f32x4){0.f, 0.f, 0.f, 0.f};
    bf16x8 At[4][2], B0[2][2], B1[2][2];
    const char* cA = (const char*)g.A + (size_t)cur.pm * tstepA + (size_t)cur.pn * pstepA; const char* cB = (const char*)g.Bt + (size_t)cur.pn * tstepB;
    PG8_STAGE(PG8_SB(0, 0), cB, voffB); PG8_STAGE(PG8_SB(0, 1), cB + hstepB, voffB); PG8_STAGE(PG8_SA(0, 0), cA, voffA); PG8_STAGE(PG8_SA(0, 1), cA + hstepA, voffA);
    if (wr == 1) PG8_BAR;
    PG8_WAIT_V(2); PG8_BAR;
    PG8_STAGE(PG8_SB(1, 0), cB + kstep, voffB); PG8_STAGE(PG8_SA(1, 0), cA + kstep, voffA); PG8_STAGE(PG8_SB(1, 1), cB + hstepB + kstep, voffB);
    PG8_WAIT_V(6); PG8_BAR;
    for (;;) {
        const bool has_next = S.next(ui + 1, nxt);
        const char* nA = has_next ? (const char*)g.A + (size_t)nxt.pm * tstepA + (size_t)nxt.pn * pstepA : cA; const char* nB = has_next ? (const char*)g.Bt + (size_t)nxt.pn * tstepB : cB;
        for (int t = 0; t < nt; t += 2) {
            const bool last = (t == nt - 2);
            const char* a1 = cA + (size_t)(t + 1) * kstep;
            const char* a2 = last ? nA : cA + (size_t)(t + 2) * kstep; const char* b2 = last ? nB : cB + (size_t)(t + 2) * kstep;
            const char* a3 = a2 + kstep; const char* b3 = b2 + kstep;
            PG8_LDB(B0, 0, 0); PG8_LDB(B1, 0, 1); PG8_SCHED; PG8_LDA(At, 0, 0); PG8_STAGE(PG8_SA(1, 1), a1 + hstepA, voffA);
            PG8_WAIT_V(8); PG8_WAIT_L(0); PG8_BAR; PG8_MMA(0, 0, At, B0); PG8_MMA(0, 1, At, B1); PG8_BAR; PG8_SCHED;
            PG8_LDA(At, 0, 1); PG8_STAGE(PG8_SB(0, 0), b2, voffB); PG8_STAGE(PG8_SB(0, 1), b2 + hstepB, voffB); PG8_STAGE(PG8_SA(0, 0), a2, voffA);
            PG8_WAIT_V(8); PG8_WAIT_L(0); PG8_BAR; PG8_MMA(1, 0, At, B0); PG8_MMA(1, 1, At, B1); PG8_BAR; PG8_SCHED;
            PG8_LDB(B0, 1, 0); PG8_LDB(B1, 1, 1); PG8_SCHED; PG8_LDA(At, 1, 0); PG8_STAGE(PG8_SA(0, 1), a2 + hstepA, voffA);
            PG8_WAIT_V(8); PG8_WAIT_L(0); PG8_BAR; PG8_MMA(0, 0, At, B0); PG8_MMA(0, 1, At, B1); PG8_BAR; PG8_SCHED;
            PG8_LDA(At, 1, 1); PG8_STAGE(PG8_SB(1, 0), b3, voffB); PG8_STAGE(PG8_SB(1, 1), b3 + hstepB, voffB); PG8_STAGE(PG8_SA(1, 0), a3, voffA);
            PG8_WAIT_V(8); PG8_WAIT_L(0); PG8_BAR; PG8_MMA(1, 0, At, B0); PG8_MMA(1, 1, At, B1); PG8_BAR; PG8_SCHED;
        }
        if constexpr (ALIGN_EPI) { if (wr == 0) PG8_BAR; }
        E(acc, cur, wr, wc, fr, fq);
        if (!has_next) break;
#pragma unroll
        for (int a = 0; a < 2; ++a)
#pragma unroll
            for (int b = 0; b < 2; ++b)
#pragma unroll
                for (int m = 0; m < 4; ++m)
#pragma unroll
                    for (int n = 0; n < 2; ++n) acc[a][b][m][n] = (f32x4){0.f, 0.f, 0.f, 0.f};
        cur = nxt; cA = nA; cB = nB; ++ui;
        if constexpr (ALIGN_EPI) { if (wr == 1) PG8_BAR; }
    }
    PG8_WAIT_V(0);
    if constexpr (!ALIGN_EPI) { if (wr == 0) PG8_BAR; }
    PG8_BAR;
#undef PG8_SA
#undef PG8_SB
#undef PG8_STAGE
#undef PG8_LDA
#undef PG8_LDB
#undef PG8_MMA
#undef PG8_WAIT_V
#undef PG8_WAIT_L
#undef PG8_BAR
#undef PG8_SCHED
}
}

constexpr int BATCH = 2, SEQ = 4096, DM = 2048, M = BATCH * SEQ;
constexpr int NH = 16, DQK = 192, DNOPE = 128, DROPE = 64, DV = 128, QLORA = 512, KVLORA = 512;
constexpr int POOLW = 1024, DIN = 6208, DIN_PAD = 6400, DFF = 5632;
constexpr float EPS = 1e-6f;
constexpr int NWAVES = 8;

typedef unsigned short bf16;
typedef unsigned v4u __attribute__((ext_vector_type(4)));
typedef unsigned v2u __attribute__((ext_vector_type(2)));
typedef float f32x4 __attribute__((ext_vector_type(4)));
typedef short bf16x8 __attribute__((ext_vector_type(8)));
typedef short s16x4 __attribute__((ext_vector_type(4)));
typedef float f32x16 __attribute__((ext_vector_type(16)));
#define LAS __attribute__((address_space(3)))
#define LDS_WAIT() asm volatile("s_waitcnt lgkmcnt(0)" ::: "memory")

constexpr size_t MiB = 1u << 20;
constexpr size_t WS_WAO = 1 * MiB, WS_WOUT = 9 * MiB, WS_WPO = 17 * MiB, WS_WQB = 21 * MiB, WS_WKVB = 24 * MiB, WS_WPG = 28 * MiB, WS_KR = 29 * MiB;
constexpr size_t WS_G = 31 * MiB;
constexpr size_t WS_WIN = 95 * MiB, WS_XN = 120 * MiB, WS_C1 = 152 * MiB, WS_U = 184 * MiB;
constexpr size_t WS_Q = 95 * MiB, WS_K = 143 * MiB, WS_V = 191 * MiB, WS_CN = 223 * MiB, WS_POOLED = 239 * MiB, WS_PG = 255 * MiB;
constexpr size_t WS_MP = 223 * MiB, WS_O = 255 * MiB, WS_MIXED = 95 * MiB, WS_X1 = 127 * MiB, WS_H2 = 95 * MiB;
constexpr size_t WS_WGU = 191 * MiB, WS_WDN = 235 * MiB, WS_ACT = 1 * MiB;
constexpr size_t WS_END = 296 * MiB, WS_BAR = 512 * 1024, WS_KRP = 272 * MiB, WS_X1B = 257 * MiB;
constexpr int SV_BGATE = 0, SV_QAG = 4096, SV_KVAG = 4608, SV_QNG = 5120, SV_KNG = 5376, SV_PSC = 5632, SV_FNG = 6656, SV_POS = 8704, SV_END = 8704 + 8192, SV_SS = 32768;

constexpr int LDS_BYTES = 147456;

__device__ __forceinline__ unsigned cvtpk(float lo, float hi) { return pg8::cvt_pk_bf16(lo, hi); }
__device__ __forceinline__ float bflo(unsigned w) { return __uint_as_float(w << 16); }
__device__ __forceinline__ float bfhi(unsigned w) { return __uint_as_float(w & 0xffff0000u); }
__device__ __forceinline__ float wave_sum(float v) {
#pragma unroll
    for (int o = 1; o < 64; o <<= 1) v += __shfl_xor(v, o);
    return v;
}

__device__ __forceinline__ int dst_row(int mode, int n0) {
    if (mode == 1) { if (n0 < 1024) return n0; if (n0 < 1088) return 6144 + (n0 - 1024); if (n0 < 2112) return 1024 + (n0 - 1088); return 2048 + (n0 - 2112); }
    if (mode == 2) return (n0 >> 7) * 256 + (n0 & 127);
    if (mode == 3) return (n0 >> 7) * 256 + 128 + (n0 & 127);
    return n0;
}
__device__ __forceinline__ void transpose_item(const float* W, int K, int N, bf16* WT, int mode, int row_off, LAS float* scr, int item, int lane, const float* gk = nullptr) {
    const int nblk = N / 32, kb = item / nblk, nb = item % nblk, k0 = 64 * kb, n0 = 32 * nb;
    { float tv[32]; const float* wp = W + (size_t)(k0 + (lane >> 5)) * N + n0 + (lane & 31);
#pragma unroll
      for (int i = 0; i < 32; ++i) tv[i] = wp[(size_t)(2 * i) * N];
      if (gk) {
#pragma unroll
          for (int i = 0; i < 32; ++i) tv[i] *= gk[k0 + 2 * i + (lane >> 5)]; }
#pragma unroll
      for (int i = 0; i < 32; ++i) scr[(2 * i + (lane >> 5)) * 33 + (lane & 31)] = tv[i]; }
    LDS_WAIT(); asm volatile("" ::: "memory");
    const int c = lane & 7, dr = row_off + dst_row(mode, n0);
#pragma unroll
    for (int j = 0; j < 4; ++j) { const int n = (lane >> 3) + 8 * j; const LAS float* s = scr + (8 * c) * 33 + n;
        v4u o; o.x = cvtpk(s[0 * 33], s[1 * 33]); o.y = cvtpk(s[2 * 33], s[3 * 33]); o.z = cvtpk(s[4 * 33], s[5 * 33]); o.w = cvtpk(s[6 * 33], s[7 * 33]);
        *(v4u*)(WT + (size_t)(dr + n) * K + k0 + 8 * c) = o; }
    LDS_WAIT(); asm volatile("" ::: "memory");
}

struct TrDesc { const float* W; bf16* WT; const float* gk; int K, N, k0, n0, dr; };
__device__ __forceinline__ TrDesc tr_desc(const float* W, int K, int N, bf16* WT, int mode, int row_off, int item, const float* gk) {
    const int nblk = N / 32, kb = item / nblk, nb = item % nblk; TrDesc d; d.W = W; d.WT = WT; d.gk = gk; d.K = K; d.N = N; d.k0 = 64 * kb; d.n0 = 32 * nb; d.dr = row_off + dst_row(mode, d.n0); return d; }
__device__ __forceinline__ void tr_load(const TrDesc& d, float (&tv)[32], int lane) {
    const float* wp = d.W + (size_t)(d.k0 + (lane >> 5)) * d.N + d.n0 + (lane & 31);
#pragma unroll
    for (int i = 0; i < 32; ++i) tv[i] = __builtin_nontemporal_load(wp + (size_t)(2 * i) * d.N);
}
__device__ __forceinline__ void tr_finish(const TrDesc& d, float (&tv)[32], LAS float* scr, int lane) {
    if (d.gk) {
#pragma unroll
        for (int i = 0; i < 32; ++i) tv[i] *= d.gk[d.k0 + 2 * i + (lane >> 5)]; }
#pragma unroll
    for (int i = 0; i < 32; ++i) scr[(2 * i + (lane >> 5)) * 33 + (lane & 31)] = tv[i];
    LDS_WAIT(); asm volatile("" ::: "memory");
    const int c = lane & 7;
#pragma unroll
    for (int j = 0; j < 4; ++j) { const int n = (lane >> 3) + 8 * j; const LAS float* s_ = scr + (8 * c) * 33 + n;
        v4u o; o.x = cvtpk(s_[0 * 33], s_[1 * 33]); o.y = cvtpk(s_[2 * 33], s_[3 * 33]); o.z = cvtpk(s_[4 * 33], s_[5 * 33]); o.w = cvtpk(s_[6 * 33], s_[7 * 33]);
        *(v4u*)(d.WT + (size_t)(d.dr + n) * d.K + d.k0 + 8 * c) = o; }
    LDS_WAIT(); asm volatile("" ::: "memory");
}
#define TR_PIPELINE(FIRST, LIMIT, STRIDE, MAKE_DESC) do { int it_ = (FIRST); if (it_ < (LIMIT)) { TrDesc dA_ = MAKE_DESC(it_); float tvA_[32]; tr_load(dA_, tvA_, lane); \
        for (;;) { const int nx_ = it_ + (STRIDE); const bool more_ = nx_ < (LIMIT); TrDesc dB_ = dA_; float tvB_[32]; \
            if (more_) { dB_ = MAKE_DESC(nx_); tr_load(dB_, tvB_, lane); } \
            tr_finish(dA_, tvA_, scr, lane); if (!more_) break; \
            dA_ = dB_; _Pragma("unroll") for (int i_ = 0; i_ < 32; ++i_) tvA_[i_] = tvB_[i_]; it_ = nx_; } } } while (0)

__device__ __forceinline__ void rms_row_2048(const float* xrow, const float* g, bf16* orow, int lane) {
    const f32x4* xr = (const f32x4*)xrow + 2 * lane; const f32x4* gr = (const f32x4*)g + 2 * lane;
    f32x4 v[8]; float s = 0.f;
#pragma unroll
    for (int j = 0; j < 4; ++j) { v[2 * j] = __builtin_nontemporal_load(xr + 128 * j); v[2 * j + 1] = __builtin_nontemporal_load(xr + 128 * j + 1); }
#pragma unroll
    for (int j = 0; j < 8; ++j) s += (v[j].x * v[j].x + v[j].y * v[j].y) + (v[j].z * v[j].z + v[j].w * v[j].w);
    const float inv = 1.0f / sqrtf(wave_sum(s) * (1.f / 2048.f) + EPS);
    v4u* o16 = (v4u*)orow + lane;
#pragma unroll
    for (int j = 0; j < 4; ++j) { const f32x4 g0 = gr[128 * j], g1 = gr[128 * j + 1]; const f32x4 a = v[2 * j], b = v[2 * j + 1]; v4u o;
        o.x = cvtpk(a.x * inv * g0.x, a.y * inv * g0.y); o.y = cvtpk(a.z * inv * g0.z, a.w * inv * g0.w); o.z = cvtpk(b.x * inv * g1.x, b.y * inv * g1.y); o.w = cvtpk(b.z * inv * g1.z, b.w * inv * g1.w);
        o16[64 * j] = o; }
}

namespace att {
constexpr int QBLK = 32, KVBLK = 64, QB = 256;
constexpr int SHM_V = KVBLK * DV * 2, SHM_K = KVBLK * DQK * 2;
constexpr int OFF_V = 0, OFF_K = 3 * SHM_V, OFF_WS = OFF_K + 2 * SHM_K;
constexpr float SCALE = 0.07216878364870322f;
constexpr float THR = 8.f;
#define KSWZ(row, colB) ((row) * 384 + ((colB) ^ (((row) & 7) << 4)))
#define SBAR() __builtin_amdgcn_sched_barrier(0)
__device__ __forceinline__ int v_st(int k, int c) { const int kk = (k & ~0xC) | ((k & 4) << 1) | ((k & 8) >> 1); return ((kk >> 3) * 4 + (c >> 5)) * 512 + ((kk & 7) * 32 + (c & 31)) * 2; }
__device__ __forceinline__ int v_rd_base(int lane) { return ((lane & 3) << 3) | (((lane >> 2) & 3) << 6) | (((lane >> 4) & 1) << 5) | (((lane >> 5) & 1) << 8); }
__device__ __forceinline__ int crow(int r, int hi) { return (r & 3) + 8 * (r >> 2) + 4 * hi; }
__device__ __forceinline__ void mask_tile(f32x16& p0, f32x16& p1, int dq) {
    const float NEG = -__builtin_inff();
#pragma unroll
    for (int r = 0; r < 16; ++r) {
        const int c = (r & 3) + 8 * (r >> 2);
        if (dq - c < 0) p0[r] = NEG;
        if (dq - c - 32 < 0) p1[r] = NEG;
    }
}
__device__ __forceinline__ void partialSM(f32x16& p0, f32x16& p1, float& m_reg, float& mn, float& alpha) {
    float pmax = p0[0];
#pragma unroll
    for (int r = 1; r < 16; ++r) pmax = fmaxf(pmax, p0[r]);
#pragma unroll
    for (int r = 0; r < 16; ++r) pmax = fmaxf(pmax, p1[r]);
    { auto rr = __builtin_amdgcn_permlane32_swap(__float_as_uint(pmax), __float_as_uint(pmax), false, false);
      pmax = fmaxf(__uint_as_float(rr[0]), __uint_as_float(rr[1])); }
    constexpr float C2 = 1.4426950408889634f * SCALE;
    if (__builtin_expect(__all((pmax - m_reg) * SCALE <= THR), 1)) { mn = m_reg; alpha = 1.f; }
    else { mn = fmaxf(m_reg, pmax); alpha = __builtin_amdgcn_exp2f((m_reg - mn) * C2); m_reg = mn; }
    const float mnL = -mn * C2;
#pragma unroll
    for (int r = 0; r < 16; ++r) p0[r] = fmaf(p0[r], C2, mnL);
#pragma unroll
    for (int r = 0; r < 16; ++r) p1[r] = fmaf(p1[r], C2, mnL);
#pragma unroll
    for (int r = 0; r < 16; ++r) p0[r] = __builtin_amdgcn_exp2f(p0[r]);
}
__device__ __forceinline__ void finishSM(f32x16& p0, f32x16& p1, float alpha, float& l_reg, bf16x8& pa0, bf16x8& pa1, bf16x8& pa2, bf16x8& pa3) {
#pragma unroll
    for (int r = 0; r < 16; ++r) p1[r] = __builtin_amdgcn_exp2f(p1[r]);
    float ps = 0;
#pragma unroll
    for (int r = 0; r < 16; ++r) ps += p0[r];
#pragma unroll
    for (int r = 0; r < 16; ++r) ps += p1[r];
    { auto rr = __builtin_amdgcn_permlane32_swap(__float_as_uint(ps), __float_as_uint(ps), false, false);
      ps = __uint_as_float(rr[0]) + __uint_as_float(rr[1]); }
    l_reg = l_reg * alpha + ps;
#define PK4(P, B_, OUT) do { unsigned a0 = cvtpk(P[B_+0], P[B_+1]), a1 = cvtpk(P[B_+2], P[B_+3]);                          \
        unsigned b0 = cvtpk(P[B_+4], P[B_+5]), b1 = cvtpk(P[B_+6], P[B_+7]);                                             \
        auto r0 = __builtin_amdgcn_permlane32_swap(a0, b0, false, false); auto r1 = __builtin_amdgcn_permlane32_swap(a1, b1, false, false); \
        v4u w = {r0[0], r1[0], r0[1], r1[1]}; OUT = *reinterpret_cast<bf16x8*>(&w); } while (0)
    PK4(p0, 0, pa0); PK4(p0, 8, pa1); PK4(p1, 0, pa2); PK4(p1, 8, pa3);
#undef PK4
}
__device__ __forceinline__ void qkt(f32x16& p0, f32x16& p1, const char* Kb, int r32, int hi, const bf16x8* qr) {
    p0 = f32x16{}; p1 = f32x16{};
    const char* kb[4];
#pragma unroll
    for (int dd = 0; dd < 4; ++dd) kb[dd] = Kb + KSWZ(r32, (dd * 16 + hi * 8) * 2);
#pragma unroll
    for (int g = 0; g < 2; ++g) { bf16x8 b0[6], b1[6];
#pragma unroll
        for (int i = 0; i < 6; ++i) { const int d0 = 6 * g + i; const char* a = kb[d0 & 3] + (d0 >> 2) * 128; b0[i] = *reinterpret_cast<const bf16x8*>(a); b1[i] = *reinterpret_cast<const bf16x8*>(a + 32 * 384); }
        SBAR();
        __builtin_amdgcn_s_setprio(1);
#pragma unroll
        for (int i = 0; i < 6; ++i) { p0 = __builtin_amdgcn_mfma_f32_32x32x16_bf16(b0[i], qr[6 * g + i], p0, 0, 0, 0); p1 = __builtin_amdgcn_mfma_f32_32x32x16_bf16(b1[i], qr[6 * g + i], p1, 0, 0, 0); }
        __builtin_amdgcn_s_setprio(0);
        SBAR(); }
}
__device__ __forceinline__ void pv_tile(f32x16* o, int vb0, bf16x8 pa0, bf16x8 pa1, bf16x8 pa2, bf16x8 pa3) {
#define TRRD(dst, off) asm volatile("ds_read_b64_tr_b16 %0, %1 offset:%2" : "=&v"(dst) : "v"(vb0), "i"(off) : "memory")
#define PV_RD(S, d0) do { constexpr int b_ = (d0) * 512; TRRD(S##l0, b_); TRRD(S##h0, b_ + 2048); TRRD(S##l1, b_ + 4096); TRRD(S##h1, b_ + 6144); TRRD(S##l2, b_ + 8192); TRRD(S##h2, b_ + 10240); TRRD(S##l3, b_ + 12288); TRRD(S##h3, b_ + 14336); } while (0)
#define PV_MM(S, d0) do { \
        o[d0] = __builtin_amdgcn_mfma_f32_32x32x16_bf16(pa0, (bf16x8){S##l0[0], S##l0[1], S##l0[2], S##l0[3], S##h0[0], S##h0[1], S##h0[2], S##h0[3]}, o[d0], 0, 0, 0);   \
        o[d0] = __builtin_amdgcn_mfma_f32_32x32x16_bf16(pa1, (bf16x8){S##l1[0], S##l1[1], S##l1[2], S##l1[3], S##h1[0], S##h1[1], S##h1[2], S##h1[3]}, o[d0], 0, 0, 0);   \
        o[d0] = __builtin_amdgcn_mfma_f32_32x32x16_bf16(pa2, (bf16x8){S##l2[0], S##l2[1], S##l2[2], S##l2[3], S##h2[0], S##h2[1], S##h2[2], S##h2[3]}, o[d0], 0, 0, 0);   \
        o[d0] = __builtin_amdgcn_mfma_f32_32x32x16_bf16(pa3, (bf16x8){S##l3[0], S##l3[1], S##l3[2], S##l3[3], S##h3[0], S##h3[1], S##h3[2], S##h3[3]}, o[d0], 0, 0, 0); } while (0)
    s16x4 Al0, Al1, Al2, Al3, Ah0, Ah1, Ah2, Ah3, Bl0, Bl1, Bl2, Bl3, Bh0, Bh1, Bh2, Bh3;
    PV_RD(A, 0); PV_RD(B, 1);
    asm volatile("s_waitcnt lgkmcnt(8)" ::: "memory"); SBAR(); PV_MM(A, 0); SBAR();
    PV_RD(A, 2);
    asm volatile("s_waitcnt lgkmcnt(8)" ::: "memory"); SBAR(); PV_MM(B, 1); SBAR();
    PV_RD(B, 3);
    asm volatile("s_waitcnt lgkmcnt(8)" ::: "memory"); SBAR(); PV_MM(A, 2); SBAR();
    asm volatile("s_waitcnt lgkmcnt(0)" ::: "memory"); SBAR(); PV_MM(B, 3);
#undef PV_MM
#undef PV_RD
#undef TRRD
}
__device__ __forceinline__ void attn_unit(int b, int h, int qb, const bf16* Q, const bf16* K, const bf16* V, bf16* O, char* lds) {
    const int tid = threadIdx.x, wid = __builtin_amdgcn_readfirstlane(tid >> 6), lane = tid & 63, r32 = lane & 31, hi = lane >> 5;
    const size_t rowb = (size_t)b * SEQ;
    const int q0 = qb * QB, qlo = q0 + wid * QBLK;
    const int NT = (q0 + QB) / KVBLK;
    char* V_lds = lds + OFF_V; char* K_lds = lds + OFF_K;
#define WAVE_WS() ({ int t_ = (int)threadIdx.x; asm volatile("" : "+v"(t_)); (float*)(lds + OFF_WS) + (t_ >> 6) * 64; })
    LAS unsigned char* ldsl_ = (LAS unsigned char*)lds;
    unsigned ksrc[3], vsrc[2];
#pragma unroll
    for (int j = 0; j < 3; ++j) { const int s_ = (wid * 3 + j) * 64 + lane, row = s_ / 24, pc = s_ % 24; ksrc[j] = (unsigned)(row * 3072 * 2 + ((pc * 16) ^ ((row & 7) << 4))); }
#pragma unroll
    for (int j = 0; j < 2; ++j) { const int ob = ((wid * 2 + j) * 64 + lane) * 16, st = ob >> 9, kr_ = (ob >> 6) & 7, ch = (ob >> 4) & 3, c = (st & 3) * 32 + ch * 8, kk = (st >> 2) * 8 + kr_,
                                  k = (kk & ~0xC) | ((kk & 4) << 1) | ((kk & 8) >> 1); vsrc[j] = (unsigned)(k * 2048 * 2 + c * 2); }
    const char* Kh = (const char*)(K + rowb * 3072 + h * DQK); const char* Vh = (const char*)(V + rowb * 2048 + h * DV);
#define KDMA(k0, bf) do { _Pragma("unroll") for (int j = 0; j < 3; ++j) __builtin_amdgcn_global_load_lds((const unsigned*)(Kh + (size_t)(k0) * (3072 * 2) + ksrc[j]), \
        (LAS unsigned*)(ldsl_ + OFF_K + (bf) * SHM_K + (wid * 3 + j) * 1024), 16, 0, 0); } while (0)
#define VDMA(k0, sl) do { _Pragma("unroll") for (int j = 0; j < 2; ++j) __builtin_amdgcn_global_load_lds((const unsigned*)(Vh + (size_t)(k0) * (2048 * 2) + vsrc[j]), \
        (LAS unsigned*)(ldsl_ + OFF_V + (sl) * SHM_V + (wid * 2 + j) * 1024), 16, 0, 0); } while (0)
    KDMA(0, 0); VDMA(0, 0);
    bf16x8 qr[12];
    { const bf16* Qp = Q + (rowb + qlo + r32) * 3072 + h * DQK + hi * 8;
#pragma unroll
      for (int d0 = 0; d0 < 12; ++d0) qr[d0] = *(const bf16x8*)(Qp + d0 * 16); }
    asm volatile("s_waitcnt vmcnt(0)" ::: "memory");
    __syncthreads();
    float m_reg = -1e30f, l_reg = 0.f; f32x16 o[4] = {};
    const int vbase = (int)(uintptr_t)V_lds + v_rd_base(lane);
    const int qm = qlo + r32 - 4 * hi;
    f32x16 p0, p1;
#define SP_STAGE(VS) do { float mn, alpha; bf16x8 pa0, pa1, pa2, pa3; \
        partialSM(p0, p1, m_reg, mn, alpha); finishSM(p0, p1, alpha, l_reg, pa0, pa1, pa2, pa3); \
        if (__any(alpha < 1.f)) { float* al_l = WAVE_WS() + 32; if (hi == 0) al_l[r32] = alpha; asm volatile("s_waitcnt lgkmcnt(0)" ::: "memory"); \
            _Pragma("unroll") for (int d_ = 0; d_ < 4; ++d_) _Pragma("unroll") for (int r = 0; r < 16; ++r) o[d_][r] *= al_l[crow(r, hi)]; } \
        SBAR(); pv_tile(o, vbase + (VS) * SHM_V, pa0, pa1, pa2, pa3); } while (0)
    for (int t = 0; t < NT; ++t) {
        const int cur = t & 1, kb_ = t * KVBLK;
        if (t + 1 < NT) { KDMA((t + 1) * KVBLK, cur ^ 1); VDMA((t + 1) * KVBLK, cur ^ 1); }
        SBAR();
        qkt(p0, p1, K_lds + cur * SHM_K, r32, hi, qr); if (kb_ + KVBLK - 1 > qlo) mask_tile(p0, p1, qm - kb_);
        SBAR();
        SP_STAGE(cur);
        asm volatile("s_waitcnt vmcnt(0)" ::: "memory");
        __syncthreads();
    }
#undef SP_STAGE
    float* li_l = WAVE_WS();
    if (hi == 0) li_l[r32] = l_reg; asm volatile("s_waitcnt lgkmcnt(0)" ::: "memory");
    float rli[16];
#pragma unroll
    for (int r = 0; r < 16; ++r) rli[r] = __builtin_amdgcn_rcpf(li_l[crow(r, hi)]);
    bf16* Ow = O + (rowb + qlo) * 2048 + h * DV;
#pragma unroll
    for (int r = 0; r < 16; ++r) { const int orow = crow(r, hi);
#pragma unroll
        for (int d0 = 0; d0 < 4; ++d0) { const float v = o[d0][r] * rli[r];
            const float vn = __shfl_xor(v, 1);
            if ((r32 & 1) == 0) *(unsigned*)(Ow + (size_t)orow * 2048 + d0 * 32 + r32) = cvtpk(v, vn); } }
    __syncthreads();
#undef KDMA
#undef VDMA
#undef WAVE_WS
}
#undef SBAR
}

struct Args { const float* in[20]; float* out; unsigned char* ws; int ph_lo, ph_hi, coop, pad; };
#define XB_TMO      128
#define XB_XCNT(j)  (256  + 64 * (j))
#define XB_XSUB(j)  (1280 + 64 * (j))
#define XB_XGEN(j)  (2304 + 64 * (j))
#define XB_TOP      3328
#define XB_TOPGEN   3392
#define XCD_BAR_WORDS 3456
#define XB_SPIN_CAP (1u << 20)
__device__ __forceinline__ unsigned xb_ld(unsigned* p)              { return __hip_atomic_load(p, __ATOMIC_RELAXED, __HIP_MEMORY_SCOPE_AGENT); }
__device__ __forceinline__ unsigned xb_add(unsigned* p, unsigned v) { return __hip_atomic_fetch_add(p, v, __ATOMIC_RELAXED, __HIP_MEMORY_SCOPE_AGENT); }
__device__ __forceinline__ unsigned xb_xcc_id() { return (unsigned)__builtin_amdgcn_s_getreg((3 << 11) | 20) & 0xFu; }
#define XB_SPIN(cond, bar) do { unsigned _sp = 0; while (cond) { __builtin_amdgcn_s_sleep(1); \
    if ((++_sp & 255u) == 0u) { if (xb_ld(&(bar)[XB_TMO])) break; if (_sp > XB_SPIN_CAP) { atomicAdd(&(bar)[XB_TMO], 1u); break; } } } } while (0)
__device__ __forceinline__ void xcd_barrier_complete(unsigned* bar, unsigned x, unsigned& nloc, unsigned& nx) {
    const unsigned G = gridDim.x;
    unsigned sum, cnt, mine, sp = 0u;
    for (;;) {
        sum = 0u; cnt = 0u; mine = 0u;
#pragma unroll
        for (unsigned j = 0; j < 16; ++j) { const unsigned c = xb_ld(&bar[XB_XCNT(j)]); sum += c; cnt += (c > 0u) ? 1u : 0u; mine = (j == x) ? c : mine; }
        if (sum == G) break;
        __builtin_amdgcn_s_sleep(1);
        if ((++sp & 255u) == 0u) { if (xb_ld(&bar[XB_TMO])) break; if (sp > XB_SPIN_CAP) { atomicAdd(&bar[XB_TMO], 1u); break; } }
    }
    nloc = mine > 0u ? mine : 1u; nx = cnt > 0u ? cnt : 1u;
}
__device__ __forceinline__ void grid_bar(unsigned* bar, volatile LAS unsigned* st) {
    asm volatile("s_waitcnt vmcnt(0)" ::: "memory");
    __syncthreads();
    if (threadIdx.x == 0) {
        const unsigned x = xb_xcc_id();
        __builtin_amdgcn_s_waitcnt(0);
        unsigned nloc = st[0], nx = st[1];
        if (nloc == 0u) { xcd_barrier_complete(bar, x, nloc, nx); st[0] = nloc; st[1] = nx; }
        const unsigned old = xb_add(&bar[XB_XSUB(x)], 1u);
        const unsigned gen = old / nloc;
        if (old + 1u == (gen + 1u) * nloc) {
            __builtin_amdgcn_fence(__ATOMIC_RELEASE, "agent");
            asm volatile("s_waitcnt vmcnt(0)" ::: "memory");
            const unsigned og = xb_add(&bar[XB_TOP], 1u);
            const unsigned tg = og / nx;
            if (og + 1u == (tg + 1u) * nx) xb_add(&bar[XB_TOPGEN], 1u);
            else XB_SPIN(xb_ld(&bar[XB_TOPGEN]) == tg, bar);
            __builtin_amdgcn_fence(__ATOMIC_ACQUIRE, "agent");
            xb_add(&bar[XB_XGEN(x)], 1u);
            asm volatile("s_waitcnt vmcnt(0)" ::: "memory");
        } else {
            XB_SPIN(xb_ld(&bar[XB_XGEN(x)]) == gen, bar);
            __builtin_amdgcn_fence(__ATOMIC_ACQUIRE, "agent");
            asm volatile("s_waitcnt vmcnt(0)" ::: "memory");
        }
    }
    __syncthreads();
}
constexpr int NPH = 11;

__global__ void __launch_bounds__(NWAVES * 64, 2) mega_fwd(Args args) {
    extern __shared__ __attribute__((aligned(16))) unsigned char lds[];
    LAS unsigned char* ldsl = (LAS unsigned char*)lds;
    const int tid = threadIdx.x, lane = tid & 63, wave = __builtin_amdgcn_readfirstlane(tid >> 6);
    const int G = gridDim.x, bx = blockIdx.x;
    const int vcu = (G % 8 == 0) ? (bx % 8) * (G / 8) + bx / 8 : bx;
    const int gw = vcu * NWAVES + wave, NGW = G * NWAVES;
    unsigned char* ws = args.ws;
    const float* const* kin = (const float* const*)__builtin_amdgcn_kernarg_segment_ptr();
    const float* svec = (const float*)ws;
    const float* b_gate = svec + SV_BGATE; const float* q_a_norm_g = svec + SV_QAG; const float* kv_a_norm_g = svec + SV_KVAG; const float* q_norm_g = svec + SV_QNG;
    const float* k_norm_g = svec + SV_KNG; const float* pool_scale = svec + SV_PSC; const float* ffn_norm_g = svec + SV_FNG; const int* positions = (const int*)(svec + SV_POS);
    bf16* WIN_T = (bf16*)(ws + WS_WIN); bf16* WQB_T = (bf16*)(ws + WS_WQB); bf16* WKVB_T = (bf16*)(ws + WS_WKVB); bf16* WPG_T = (bf16*)(ws + WS_WPG);
    bf16* WPO_T = (bf16*)(ws + WS_WPO); bf16* WAO_T = (bf16*)(ws + WS_WAO); bf16* WOUT_T = (bf16*)(ws + WS_WOUT); bf16* WGU_T = (bf16*)(ws + WS_WGU); bf16* WDN_T = (bf16*)(ws + WS_WDN);
    bf16* XN = (bf16*)(ws + WS_XN); bf16* C1 = (bf16*)(ws + WS_C1); float* KRP = (float*)(ws + WS_KRP); bf16* U = (bf16*)(ws + WS_U); bf16* Gt = (bf16*)(ws + WS_G);
    bf16* CN = (bf16*)(ws + WS_CN); bf16* POOLED = (bf16*)(ws + WS_POOLED); bf16* Qb = (bf16*)(ws + WS_Q); bf16* Kb = (bf16*)(ws + WS_K); bf16* Vb = (bf16*)(ws + WS_V);
    bf16* PG = (bf16*)(ws + WS_PG); bf16* MP = (bf16*)(ws + WS_MP); bf16* Ob = (bf16*)(ws + WS_O); bf16* MIXED = (bf16*)(ws + WS_MIXED);
    float* X1 = (float*)(ws + WS_X1); bf16* H2 = (bf16*)(ws + WS_H2); bf16* ACT = (bf16*)(ws + WS_ACT);

    const int lo = args.ph_lo, hi_ph = args.ph_hi;
#ifndef PHMASK
#define PHMASK 0x7ff
#endif
#define IN(k) (((PHMASK >> (k)) & 1) && lo <= (k) && (k) < hi_ph)
#define SEAM(k) do { if (IN(k) && IN((k) + 1)) { unsigned char* w2_ = args.ws; asm volatile("" : "+s"(w2_)); grid_bar((unsigned*)(w2_ + WS_BAR), (volatile LAS unsigned*)(ldsl + 140032)); } } while (0)
    if (args.coop > 1) cg::this_grid().sync();
    if (threadIdx.x < 2) ((volatile LAS unsigned*)(ldsl + 140032))[threadIdx.x] = 0u;
    __syncthreads();
    if (args.coop && threadIdx.x == 0) { unsigned char* w2_ = args.ws; asm volatile("" : "+s"(w2_)); (void)xb_add(&((unsigned*)(w2_ + WS_BAR))[XB_XCNT(xb_xcc_id())], 1u); }
    LAS float* scr = (LAS float*)(ldsl + wave * 16384);
#ifdef TPROBE
#define TP_BEGIN(k) do { if ((TPROBE >> (k)) & 1) { if (blockIdx.x == 0 && threadIdx.x == 0) { *(volatile LAS unsigned*)(ldsl + 140000) = (unsigned)__builtin_amdgcn_s_memrealtime(); } } } while (0)
#define TP_END(k) do { if ((TPROBE >> (k)) & 1) { if (blockIdx.x == 0 && threadIdx.x == 0) { volatile LAS unsigned* tp_ = (volatile LAS unsigned*)(ldsl + 140000); tp_[1] += (unsigned)__builtin_amdgcn_s_memrealtime() - tp_[0]; } } } while (0)
    if (blockIdx.x == 0 && threadIdx.x == 0) { ((volatile LAS unsigned*)(ldsl + 140000))[1] = 0u; }
#else
#define TP_BEGIN(k) do {} while (0)
#define TP_END(k) do {} while (0)
#endif

    if (IN(0)) { TP_BEGIN(0);
        { float* sv = (float*)ws; const int gt = bx * (NWAVES * 64) + tid, GT = G * NWAVES * 64;
          for (int i = gt; i < M; i += GT) sv[SV_SS + i] = 0.f;
          for (int i = gt; i < SV_END; i += GT) { int idx, off, lim = 1 << 30;
              if (i < SV_QAG) { idx = 4; off = SV_BGATE; } else if (i < SV_KVAG) { idx = 5; off = SV_QAG; } else if (i < SV_QNG) { idx = 7; off = SV_KVAG; }
              else if (i < SV_KNG) { idx = 9; off = SV_QNG; lim = 192; } else if (i < SV_PSC) { idx = 10; off = SV_KNG; lim = 192; }
              else if (i < SV_FNG) { idx = 13; off = SV_PSC; } else if (i < SV_POS) { idx = 16; off = SV_FNG; } else { idx = 1; off = SV_POS; }
              const float* src = kin[idx]; sv[i] = (i - off < lim) ? src[i - off] : 0.f; } }
        constexpr int I_IN = (DM / 64) * (DIN / 32), I_QB = (QLORA / 64) * (NH * DQK / 32), I_KVB = (KVLORA / 64) * (NH * 256 / 32), I_PG = (256 / 64) * (256 / 32),
                      I_PO = (POOLW / 64) * (DM / 32), I_AO = (DM / 64) * (DM / 32), I_OUT = I_AO;
        constexpr int NITEMS = I_IN + I_QB + I_KVB + 4 * I_PG + I_PO + I_AO + I_OUT;
#define P0_DESC(it__) ([&]() { int r = (it__), idx, Kd, Nd, mode = 0, roff = 0; size_t dsto, srco = 0; \
            if (r < I_IN) { idx = 3; Kd = DM; Nd = DIN; mode = 1; dsto = WS_WIN; } \
            else if ((r -= I_IN) < I_QB) { idx = 6; Kd = QLORA; Nd = NH * DQK; dsto = WS_WQB; } \
            else if ((r -= I_QB) < I_KVB) { idx = 8; Kd = KVLORA; Nd = NH * 256; dsto = WS_WKVB; } \
            else if ((r -= I_KVB) < 4 * I_PG) { const int g = r / I_PG; r = r % I_PG; idx = 12; Kd = 256; Nd = 256; dsto = WS_WPG; roff = g * 256; srco = (size_t)g * 65536; } \
            else if ((r -= 4 * I_PG) < I_PO) { idx = 14; Kd = POOLW; Nd = DM; dsto = WS_WPO; } \
            else if ((r -= I_PO) < I_AO) { idx = 11; Kd = DM; Nd = DM; dsto = WS_WAO; } \
            else { r -= I_AO; idx = 15; Kd = DM; Nd = DM; dsto = WS_WOUT; } \
            return tr_desc(kin[idx] + srco, Kd, Nd, (bf16*)(ws + dsto), mode, roff, r, nullptr); }())
        TR_PIPELINE(gw, NITEMS, NGW, P0_DESC);
#undef P0_DESC
        { v4u* z = (v4u*)(WIN_T + (size_t)DIN * DM); const int nz = (DIN_PAD - DIN) * DM / 8;
          for (int i = gw * 64 + lane; i < nz; i += NGW * 64) z[i] = (v4u){0u, 0u, 0u, 0u}; }
        { const float* x = kin[0]; const float* attn_norm_g = kin[2];
          for (int m = gw; m < M; m += NGW) rms_row_2048(x + (size_t)m * DM, attn_norm_g, XN + (size_t)m * DM, lane); }
    TP_END(0); }
    SEAM(0);
    if (IN(1)) { TP_BEGIN(1);
        { pg8::Gemm g{XN, WIN_T, M, 6144, DM, DM, DM, 0, 0}; pg8::StaticOrder S; S.init(M, 6144, G, bx);
          pg8::EpiIn E{C1, U, Gt, b_gate};
          pg8::gemm_phase<pg8::EpiIn, pg8::StaticOrder>(ldsl, g, S, E); }
        { pg8::Gemm g{XN, WIN_T + (size_t)6144 * DM, M, 2048, 256, DM, DM, 256, 256}; pg8::StaticOrder S; S.init(M, 2048, G, bx);
          pg8::EpiKRP E{KRP};
          pg8::gemm_phase<pg8::EpiKRP, pg8::StaticOrder>(ldsl, g, S, E); }
    TP_END(1); }
    SEAM(1);
    if (IN(2)) { TP_BEGIN(2);
        for (int m = gw; m < M; m += NGW) {
            const v4u cq = __builtin_nontemporal_load((const v4u*)(C1 + (size_t)m * 1024 + 8 * lane)), ck = __builtin_nontemporal_load((const v4u*)(C1 + (size_t)m * 1024 + 512 + 8 * lane));
            const float fq_[8] = {bflo(cq.x), bfhi(cq.x), bflo(cq.y), bfhi(cq.y), bflo(cq.z), bfhi(cq.z), bflo(cq.w), bfhi(cq.w)};
            const float fk_[8] = {bflo(ck.x), bfhi(ck.x), bflo(ck.y), bfhi(ck.y), bflo(ck.z), bfhi(ck.z), bflo(ck.w), bfhi(ck.w)};
            float sq = 0.f, skv = 0.f;
#pragma unroll
            for (int e = 0; e < 8; ++e) { sq += fq_[e] * fq_[e]; skv += fk_[e] * fk_[e]; }
            const float iq = 1.0f / sqrtf(wave_sum(sq) * (1.f / 512.f) + EPS), ikv = 1.0f / sqrtf(wave_sum(skv) * (1.f / 512.f) + EPS);
            if (lane < 16) { f32x4 acc4 = {0.f, 0.f, 0.f, 0.f};
#pragma unroll
                for (int ks = 0; ks < 8; ++ks) acc4 += __builtin_nontemporal_load((const f32x4*)(KRP + ((size_t)ks * 8192 + m) * 64 + 4 * lane));
                *(f32x4*)((float*)(ws + WS_KR) + (size_t)m * 64 + 4 * lane) = acc4; }
            const f32x4 gq0 = ((const f32x4*)q_a_norm_g)[2 * lane], gq1 = ((const f32x4*)q_a_norm_g)[2 * lane + 1], gk0 = ((const f32x4*)kv_a_norm_g)[2 * lane], gk1 = ((const f32x4*)kv_a_norm_g)[2 * lane + 1];
            v4u oq, ok;
            oq.x = cvtpk(fq_[0] * iq * gq0.x, fq_[1] * iq * gq0.y); oq.y = cvtpk(fq_[2] * iq * gq0.z, fq_[3] * iq * gq0.w); oq.z = cvtpk(fq_[4] * iq * gq1.x, fq_[5] * iq * gq1.y); oq.w = cvtpk(fq_[6] * iq * gq1.z, fq_[7] * iq * gq1.w);
            ok.x = cvtpk(fk_[0] * ikv * gk0.x, fk_[1] * ikv * gk0.y); ok.y = cvtpk(fk_[2] * ikv * gk0.z, fk_[3] * ikv * gk0.w); ok.z = cvtpk(fk_[4] * ikv * gk1.x, fk_[5] * ikv * gk1.y); ok.w = cvtpk(fk_[6] * ikv * gk1.z, fk_[7] * ikv * gk1.w);
            *(v4u*)(CN + (size_t)m * 1024 + 8 * lane) = oq; *(v4u*)(CN + (size_t)m * 1024 + 512 + 8 * lane) = ok;
        }
        for (int base = gw * 4; base < M; base += NGW * 4) {
            const int s0 = base & (SEQ - 1);
#pragma unroll
            for (int jj = 0; jj < 2; ++jj) {
                const int col = 8 * lane + 512 * jj, grp = col >> 8, w = 2 << grp; int cnt = (s0 + 1 < w) ? s0 + 1 : w;
                float a[8], uc[8];
#pragma unroll
                for (int e = 0; e < 8; ++e) a[e] = 0.f;
#pragma unroll
                for (int d = 0; d < 16; ++d) {
                    if (d < cnt) { const v4u q = *(const v4u*)(U + (size_t)(base - d) * 1024 + col);
                        const float f[8] = {bflo(q.x), bfhi(q.x), bflo(q.y), bfhi(q.y), bflo(q.z), bfhi(q.z), bflo(q.w), bfhi(q.w)};
#pragma unroll
                        for (int e = 0; e < 8; ++e) { a[e] += f[e]; if (d == 0) uc[e] = f[e]; } }
                }
#pragma unroll
                for (int i = 0; i < 4; ++i) {
                    const int m = base + i;
                    if (i > 0) { const int s = s0 + i;
                        { const v4u q = *(const v4u*)(U + (size_t)m * 1024 + col);
                          uc[0] = bflo(q.x); uc[1] = bfhi(q.x); uc[2] = bflo(q.y); uc[3] = bfhi(q.y); uc[4] = bflo(q.z); uc[5] = bfhi(q.z); uc[6] = bflo(q.w); uc[7] = bfhi(q.w); }
#pragma unroll
                        for (int e = 0; e < 8; ++e) a[e] += uc[e];
                        if (s >= w) { const v4u q = *(const v4u*)(U + (size_t)(m - w) * 1024 + col);
                            a[0] -= bflo(q.x); a[1] -= bfhi(q.x); a[2] -= bflo(q.y); a[3] -= bfhi(q.y); a[4] -= bflo(q.z); a[5] -= bfhi(q.z); a[6] -= bflo(q.w); a[7] -= bfhi(q.w); }
                        cnt = (s + 1 < w) ? s + 1 : w; }
                    const float rc = 1.0f / (float)cnt;
                    v4u o; o.x = cvtpk(a[0] * rc - uc[0], a[1] * rc - uc[1]); o.y = cvtpk(a[2] * rc - uc[2], a[3] * rc - uc[3]);
                    o.z = cvtpk(a[4] * rc - uc[4], a[5] * rc - uc[5]); o.w = cvtpk(a[6] * rc - uc[6], a[7] * rc - uc[7]);
                    *(v4u*)(POOLED + (size_t)m * 1024 + col) = o;
                }
            }
        }
    TP_END(2); }
    SEAM(2);
    if (IN(3)) { TP_BEGIN(3);
        { pg8::Gemm g{CN, WQB_T, M, NH * DQK, QLORA, 1024, QLORA, 0, 0}; pg8::StaticOrder S; S.init(M, NH * DQK, G, bx);
          pg8::EpiBf16 E{Qb, 3072}; pg8::gemm_phase<pg8::EpiBf16, pg8::StaticOrder>(ldsl, g, S, E); }
        { pg8::Gemm g{CN + 512, WKVB_T, M, NH * 256, KVLORA, 1024, KVLORA, 0, 0}; pg8::StaticOrder S; S.init(M, NH * 256, G, bx);
          pg8::EpiKV E{Kb, Vb}; pg8::gemm_phase<pg8::EpiKV, pg8::StaticOrder>(ldsl, g, S, E); }
        { pg8::Gemm g{POOLED, WPG_T, M, POOLW, 256, 1024, 256, 256, 0}; pg8::StaticOrder S; S.init(M, POOLW, G, (bx + 128) % G);
          pg8::EpiScale E{PG, 1024, pool_scale}; pg8::gemm_phase<pg8::EpiScale, pg8::StaticOrder>(ldsl, g, S, E); }
    TP_END(3); }
    SEAM(3);
    if (IN(4)) { TP_BEGIN(4);
        for (int m = gw; m < M; m += NGW) {
            const float pos = (float)positions[m];
            const int sub = lane & 3, h = lane >> 2;
            float cs[8], sn[8];
#pragma unroll
            for (int j = 0; j < 8; ++j) { const int i = 8 * sub + j; const float invf = __builtin_amdgcn_exp2f(-(float)i * (13.287712379549449f / 32.f));
                const float ang = pos * invf; const float k = rintf(ang * 0.15915494309189535f);
                float r = fmaf(-k, 6.2831854820251465f, ang); r = fmaf(-k, -1.7484555e-7f, r);
                sn[j] = __sinf(r); cs[j] = __cosf(r); }
#pragma unroll
            for (int which = 0; which < 2; ++which) {
                bf16* base = (which == 0 ? Qb : Kb) + (size_t)m * 3072 + h * DQK;
                const float* gn = (which == 0) ? q_norm_g : k_norm_g;
                float nv[32], rl[8], rh[8]; float ss = 0.f;
#pragma unroll
                for (int jj = 0; jj < 4; ++jj) { const v4u q = *(const v4u*)(base + 32 * sub + 8 * jj);
                    nv[8 * jj + 0] = bflo(q.x); nv[8 * jj + 1] = bfhi(q.x); nv[8 * jj + 2] = bflo(q.y); nv[8 * jj + 3] = bfhi(q.y);
                    nv[8 * jj + 4] = bflo(q.z); nv[8 * jj + 5] = bfhi(q.z); nv[8 * jj + 6] = bflo(q.w); nv[8 * jj + 7] = bfhi(q.w); }
                if (which == 0) {
                    const v4u a = *(const v4u*)(base + 128 + 8 * sub), b = *(const v4u*)(base + 160 + 8 * sub);
                    rl[0] = bflo(a.x); rl[1] = bfhi(a.x); rl[2] = bflo(a.y); rl[3] = bfhi(a.y); rl[4] = bflo(a.z); rl[5] = bfhi(a.z); rl[6] = bflo(a.w); rl[7] = bfhi(a.w);
                    rh[0] = bflo(b.x); rh[1] = bfhi(b.x); rh[2] = bflo(b.y); rh[3] = bfhi(b.y); rh[4] = bflo(b.z); rh[5] = bfhi(b.z); rh[6] = bflo(b.w); rh[7] = bfhi(b.w);
                } else {
                    const float* kp = (const float*)(ws + WS_KR) + (size_t)m * 64 + 8 * sub;
                    const f32x4 a0 = *(const f32x4*)kp, a1 = *(const f32x4*)(kp + 4), b0 = *(const f32x4*)(kp + 32), b1 = *(const f32x4*)(kp + 36);
                    rl[0] = a0.x; rl[1] = a0.y; rl[2] = a0.z; rl[3] = a0.w; rl[4] = a1.x; rl[5] = a1.y; rl[6] = a1.z; rl[7] = a1.w;
                    rh[0] = b0.x; rh[1] = b0.y; rh[2] = b0.z; rh[3] = b0.w; rh[4] = b1.x; rh[5] = b1.y; rh[6] = b1.z; rh[7] = b1.w;
                }
#pragma unroll
                for (int e = 0; e < 32; ++e) ss += nv[e] * nv[e];
#pragma unroll
                for (int e = 0; e < 8; ++e) ss += rl[e] * rl[e] + rh[e] * rh[e];
                ss += __shfl_xor(ss, 1); ss += __shfl_xor(ss, 2);
                const float inv = 1.0f / sqrtf(ss * (1.f / 192.f) + EPS);
#pragma unroll
                for (int jj = 0; jj < 4; ++jj) { const f32x4 g0 = *(const f32x4*)(gn + 32 * sub + 8 * jj), g1 = *(const f32x4*)(gn + 32 * sub + 8 * jj + 4);
                    v4u o; o.x = cvtpk(nv[8 * jj + 0] * inv * g0.x, nv[8 * jj + 1] * inv * g0.y); o.y = cvtpk(nv[8 * jj + 2] * inv * g0.z, nv[8 * jj + 3] * inv * g0.w);
                    o.z = cvtpk(nv[8 * jj + 4] * inv * g1.x, nv[8 * jj + 5] * inv * g1.y); o.w = cvtpk(nv[8 * jj + 6] * inv * g1.z, nv[8 * jj + 7] * inv * g1.w);
                    *(v4u*)(base + 32 * sub + 8 * jj) = o; }
                float ol[8], oh[8];
#pragma unroll
                for (int e = 0; e < 8; ++e) { const float a = rl[e] * inv * gn[128 + 8 * sub + e], b = rh[e] * inv * gn[160 + 8 * sub + e];
                    ol[e] = a * cs[e] - b * sn[e]; oh[e] = b * cs[e] + a * sn[e]; }
                v4u o1, o2; o1.x = cvtpk(ol[0], ol[1]); o1.y = cvtpk(ol[2], ol[3]); o1.z = cvtpk(ol[4], ol[5]); o1.w = cvtpk(ol[6], ol[7]);
                o2.x = cvtpk(oh[0], oh[1]); o2.y = cvtpk(oh[2], oh[3]); o2.z = cvtpk(oh[4], oh[5]); o2.w = cvtpk(oh[6], oh[7]);
                *(v4u*)(base + 128 + 8 * sub) = o1; *(v4u*)(base + 160 + 8 * sub) = o2;
            }
        }
        { pg8::Gemm g{PG, WPO_T, M, DM, POOLW, POOLW, POOLW, 0, 0}; pg8::StaticOrder S; S.init(M, DM, G, bx);
          pg8::EpiGate<false> E{MP, Gt, nullptr, 0}; pg8::gemm_phase<pg8::EpiGate<false>, pg8::StaticOrder>(ldsl, g, S, E); }
    TP_END(4); }
    SEAM(4);
    if (IN(5)) { TP_BEGIN(5);
        const int npair = BATCH * NH * 8;
        for (int p = vcu; p < npair; p += G) {
            const int bh = p >> 3, s = p & 7;
            att::attn_unit(bh / NH, bh % NH, 15 - s, Qb, Kb, Vb, Ob, (char*)lds);
            att::attn_unit(bh / NH, bh % NH, s, Qb, Kb, Vb, Ob, (char*)lds);
        }
    TP_END(5); }
    SEAM(5);
    if (IN(6)) { TP_BEGIN(6);
        pg8::Gemm g{Ob, WAO_T, M, DM, DM, DM, DM, 0, 0}; pg8::StaticOrder S; S.init(M, DM, G, bx);
        pg8::EpiGate<true> E{MIXED, Gt, MP, 2048}; pg8::gemm_phase<pg8::EpiGate<true>, pg8::StaticOrder>(ldsl, g, S, E);
    TP_END(6); }
    SEAM(6);
    if (IN(7)) { TP_BEGIN(7);
        { constexpr int I_G = (DM / 64) * (DFF / 32);
#define GU_DESC(it__) ((it__) < I_G ? tr_desc(kin[17], DM, DFF, (bf16*)(ws + WS_WGU), 2, 0, (it__), ffn_norm_g) : tr_desc(kin[18], DM, DFF, (bf16*)(ws + WS_WGU), 3, 0, (it__) - I_G, ffn_norm_g))
          TR_PIPELINE(gw, 2 * I_G, NGW, GU_DESC);
#undef GU_DESC
          __syncthreads(); }
        pg8::Gemm g{MIXED, WOUT_T, M, DM, DM, DM, DM, 0, 0}; pg8::StaticOrder S; S.init(M, DM, G, bx);
        pg8::EpiResNorm E{kin[0], X1, (bf16*)(ws + WS_X1B), (float*)ws + SV_SS, DM}; pg8::gemm_phase<pg8::EpiResNorm, pg8::StaticOrder>(ldsl, g, S, E);
    TP_END(7); }
    SEAM(7);
    if (IN(9)) { TP_BEGIN(9);
        pg8::Gemm g{(bf16*)(ws + WS_X1B), WGU_T, M, 2 * DFF, DM, DM, DM, 0, 0}; pg8::StaticOrder S; S.init(M, 2 * DFF, G, bx);
        pg8::EpiSwiGLU E{ACT, DFF, (const float*)ws + SV_SS}; pg8::gemm_phase<pg8::EpiSwiGLU, pg8::StaticOrder>(ldsl, g, S, E);
        if (G == 256 ? (bx >= 128) : true) {
            constexpr int I_D2 = (DFF / 64) * (DM / 32);
            const int nw = (G == 256) ? 128 * NWAVES : NGW, w0 = (G == 256) ? (bx - 128) * NWAVES + wave : gw;
#define DN_DESC(it__) tr_desc(kin[19], DFF, DM, (bf16*)(ws + WS_WDN), 0, 0, (it__), nullptr)
            TR_PIPELINE(w0, I_D2, nw, DN_DESC);
#undef DN_DESC
        }
    TP_END(9); }
    SEAM(9);
    if (IN(10)) { TP_BEGIN(10);
        pg8::Gemm g{ACT, WDN_T, M, DM, DFF, DFF, DFF, 0, 0}; pg8::StaticOrder S; S.init(M, DM, G, bx);
        pg8::EpiRes E{(const bf16*)(ws + WS_X1B), args.out, DM}; pg8::gemm_phase<pg8::EpiRes, pg8::StaticOrder>(ldsl, g, S, E);
    TP_END(10); }
#ifdef TPROBE
    if (blockIdx.x == 0 && threadIdx.x == 0) { const unsigned w_ = 4u * ((volatile LAS unsigned*)(ldsl + 140000))[1]; const unsigned long long t0_ = __builtin_amdgcn_s_memrealtime(); while ((unsigned)(__builtin_amdgcn_s_memrealtime() - t0_) < w_) __builtin_amdgcn_s_sleep(8); }
#endif
#undef IN
#undef SEAM
}

extern "C" void kernel_launch(void* const* d_in, const int* in_sizes, int n_in, void* d_out, int out_size, void* d_ws, size_t ws_size, hipStream_t stream) {
    static int grid = 0;
    if (grid == 0) {
        if (n_in != 20 || out_size != M * DM || ws_size < WS_END) { fprintf(stderr, "kernel_launch: unexpected shapes (n_in %d, out %d, ws %zu)\n", n_in, out_size, ws_size); grid = -1; return; }
        int dev = 0, cus = 0, per_cu = 0;
        (void)hipGetDevice(&dev); (void)hipDeviceGetAttribute(&cus, hipDeviceAttributeMultiprocessorCount, dev);
        if (hipFuncSetAttribute((const void*)mega_fwd, hipFuncAttributeMaxDynamicSharedMemorySize, LDS_BYTES) != hipSuccess) { fprintf(stderr, "kernel_launch: hipFuncSetAttribute failed\n"); grid = -1; return; }
        if (hipOccupancyMaxActiveBlocksPerMultiprocessor(&per_cu, (const void*)mega_fwd, NWAVES * 64, LDS_BYTES) != hipSuccess || per_cu < 1) { fprintf(stderr, "kernel_launch: occupancy query says %d\n", per_cu); per_cu = 1; }
        (void)hipGetLastError();
        grid = cus > 0 ? cus : 256;
    }
    if (grid < 0) return;
    Args a{};
    for (int i = 0; i < 20; ++i) a.in[i] = (const float*)d_in[i];
    a.out = (float*)d_out; a.ws = (unsigned char*)d_ws;
    if (MK_N_LAUNCHES == 1) {
        a.ph_lo = 0; a.ph_hi = NPH; a.coop = 1;
        (void)hipMemsetAsync((char*)d_ws + WS_BAR, 0, 16384, stream);
        void* kargs[] = {&a};
        hipError_t e = hipLaunchCooperativeKernel((const void*)mega_fwd, dim3(grid), dim3(NWAVES * 64), kargs, LDS_BYTES, stream);
        if (e != hipSuccess) fprintf(stderr, "kernel_launch: cooperative launch failed: %s (grid %d)\n", hipGetErrorString(e), grid);
    } else {
        for (int p = 0; p < NPH; ++p) {
            a.ph_lo = p; a.ph_hi = p + 1;
            hipLaunchKernelGGL(mega_fwd, dim3(grid), dim3(NWAVES * 64), LDS_BYTES, stream, a);
        }
    }
}
```

```cpp
#include <hip/hip_runtime.h>
#include <hip/hip_cooperative_groups.h>
#include <cstdio>
#include <cstdint>
namespace cg = cooperative_groups;

#ifndef MK_N_LAUNCHES
#define MK_N_LAUNCHES 1
#endif

namespace pg8 {
#define PG8_LAS __attribute__((address_space(3)))
typedef unsigned short bf16_t;
typedef short bf16x8 __attribute__((ext_vector_type(8)));
typedef float f32x4 __attribute__((ext_vector_type(4)));
typedef unsigned u32x4 __attribute__((ext_vector_type(4)));
constexpr int BM = 256, BK = 64, HALF = 128, HTB = HALF * BK * 2, STAGE_BYTES = 8 * HTB, NXCD = 8, WGM = 8;

__host__ __device__ __forceinline__ int lds_byte(int r, int c) { const int st = (r >> 4) * 2 + (c >> 5), rr = r & 15, cc = c & 31, ob = rr * 64 + cc * 2; return st * 1024 + (ob ^ (((ob >> 9) & 1) << 5)); }
__host__ __device__ __forceinline__ void stage_rc(int b, int& R, int& C) { const int st = b / 1024, sb = b % 1024, swz = sb ^ (((sb >> 9) & 1) << 5); R = (st >> 1) * 16 + swz / 64; C = (st & 1) * 32 + (swz % 64) / 2; }
__host__ __device__ __forceinline__ int perm32(int rho) { const int n = rho >> 4, i = rho & 15; return 8 * (i >> 2) + 4 * n + (i & 3); }

struct Unit { int pm, pn; };
struct Gemm { const bf16_t* A; const bf16_t* Bt; int M, N, K, lda, ldb, a_pn_step, b_pn_step; };

struct StaticOrder {
    int nM, nN, nwg, G, c;
    __host__ __device__ void init(int M, int N, int G_, int c_) { nM = M / BM; nN = N / BM; nwg = nM * nN; G = G_; c = c_; }
    __host__ __device__ bool next(int i, Unit& u) const {
        const long L = (long)i * G + c; if (L >= nwg) return false;
        int wgid = (int)L; { const int q = nwg / NXCD, r = nwg % NXCD, xcd = wgid % NXCD, off = wgid / NXCD; wgid = (xcd < r ? xcd * (q + 1) : r * (q + 1) + (xcd - r) * q) + off; }
        const int nig = WGM * nN, gid = wgid / nig, fm = gid * WGM, gsz = (nM - fm) < WGM ? (nM - fm) : WGM;
        u.pm = fm + ((wgid % nig) % gsz); u.pn = (wgid % nig) / gsz; return true;
    }
};

typedef float f32x2_t_ __attribute__((ext_vector_type(2))); typedef __bf16 bf16x2_t_ __attribute__((ext_vector_type(2)));
__device__ __forceinline__ unsigned cvt_pk_bf16(float lo, float hi) { f32x2_t_ v = {lo, hi}; bf16x2_t_ b = __builtin_convertvector(v, bf16x2_t_); return __builtin_bit_cast(unsigned, b); }
__device__ __forceinline__ u32x4 pack8(f32x4 a, f32x4 b) { u32x4 w; w.x = cvt_pk_bf16(a[0], a[1]); w.y = cvt_pk_bf16(a[2], a[3]); w.z = cvt_pk_bf16(b[0], b[1]); w.w = cvt_pk_bf16(b[2], b[3]); return w; }
__device__ __forceinline__ void unpack8(u32x4 w, f32x4& a, f32x4& b) {
    a[0] = __uint_as_float(w.x << 16); a[1] = __uint_as_float(w.x & 0xffff0000u); a[2] = __uint_as_float(w.y << 16); a[3] = __uint_as_float(w.y & 0xffff0000u);
    b[0] = __uint_as_float(w.z << 16); b[1] = __uint_as_float(w.z & 0xffff0000u); b[2] = __uint_as_float(w.w << 16); b[3] = __uint_as_float(w.w & 0xffff0000u); }
__device__ __forceinline__ float sigmoidf_(float v) { return __builtin_amdgcn_rcpf(1.0f + __builtin_amdgcn_exp2f(-1.4426950408889634f * v)); }
__device__ __forceinline__ f32x4 sigmoid4(f32x4 v) { f32x4 o; o[0] = sigmoidf_(v[0]); o[1] = sigmoidf_(v[1]); o[2] = sigmoidf_(v[2]); o[3] = sigmoidf_(v[3]); return o; }

typedef f32x4 AccT[2][2][4][2];
#define EPI_LOOP_AM _Pragma("unroll") for (int ai = 0; ai < 2; ++ai) _Pragma("unroll") for (int m = 0; m < 4; ++m)
#define EPI_LOOP_B _Pragma("unroll") for (int bj = 0; bj < 2; ++bj)

struct EpiIn {
    static constexpr bool PERM = true;
    bf16_t* C1; bf16_t* U; bf16_t* G; const float* bgate;
    __device__ __forceinline__ void operator()(const AccT& acc, const Unit& u, int wr, int wc, int fr, int fq) const {
        const int row0 = u.pm * BM + wr * 64 + fr, pn = u.pn, cw = wc * 32 + 8 * fq;
        if (pn < 4) {
            EPI_LOOP_AM { bf16_t* rp = C1 + (size_t)(row0 + ai * HALF + m * 16) * 1024 + pn * 256 + cw;
                EPI_LOOP_B { *(u32x4*)(rp + bj * HALF) = pack8(acc[ai][bj][m][0], acc[ai][bj][m][1]); } }
        } else if (pn < 8) {
            EPI_LOOP_AM { bf16_t* rp = U + (size_t)(row0 + ai * HALF + m * 16) * 1024 + (pn - 4) * 256 + cw;
                EPI_LOOP_B { *(u32x4*)(rp + bj * HALF) = pack8(acc[ai][bj][m][0], acc[ai][bj][m][1]); } }
        } else {
            const int gc = (pn - 8) * 256 + cw; f32x4 bv[2][2];
            EPI_LOOP_B { bv[bj][0] = *(const f32x4*)(bgate + gc + bj * HALF); bv[bj][1] = *(const f32x4*)(bgate + gc + bj * HALF + 4); }
            EPI_LOOP_AM { bf16_t* rp = G + (size_t)(row0 + ai * HALF + m * 16) * 4096 + gc;
                EPI_LOOP_B { *(u32x4*)(rp + bj * HALF) = pack8(sigmoid4(acc[ai][bj][m][0] + bv[bj][0]), sigmoid4(acc[ai][bj][m][1] + bv[bj][1])); } }
        }
    }
};
struct EpiKRP {
    static constexpr bool PERM = true;
    float* KRP;
    __device__ __forceinline__ void operator()(const AccT& acc, const Unit& u, int wr, int wc, int fr, int fq) const {
        const int row0 = u.pm * BM + wr * 64 + fr, cw = wc * 32 + 8 * fq;
        if (wc < 2) { EPI_LOOP_AM { float* rp = KRP + ((size_t)u.pn * 8192 + (row0 + ai * HALF + m * 16)) * 64 + cw; *(f32x4*)rp = acc[ai][0][m][0]; *(f32x4*)(rp + 4) = acc[ai][0][m][1]; } }
    }
};
struct EpiBf16 {
    static constexpr bool PERM = true;
    bf16_t* O; int ldc;
    __device__ __forceinline__ void operator()(const AccT& acc, const Unit& u, int wr, int wc, int fr, int fq) const {
        const int row0 = u.pm * BM + wr * 64 + fr, col0 = u.pn * BM + wc * 32 + 8 * fq;
        EPI_LOOP_AM { bf16_t* rp = O + (size_t)(row0 + ai * HALF + m * 16) * ldc + col0;
            EPI_LOOP_B { *(u32x4*)(rp + bj * HALF) = pack8(acc[ai][bj][m][0], acc[ai][bj][m][1]); } }
    }
};
struct EpiKV {
    static constexpr bool PERM = true;
    bf16_t* K; bf16_t* V;
    __device__ __forceinline__ void operator()(const AccT& acc, const Unit& u, int wr, int wc, int fr, int fq) const {
        const int row0 = u.pm * BM + wr * 64 + fr, cw = wc * 32 + 8 * fq, h = u.pn;
        EPI_LOOP_AM { const size_t row = (size_t)(row0 + ai * HALF + m * 16);
            *(u32x4*)(K + row * 3072 + h * 192 + cw) = pack8(acc[ai][0][m][0], acc[ai][0][m][1]);
            *(u32x4*)(V + row * 2048 + h * 128 + cw) = pack8(acc[ai][1][m][0], acc[ai][1][m][1]); }
    }
};
struct EpiScale {
    static constexpr bool PERM = true;
    bf16_t* O; int ldc; const float* scale;
    __device__ __forceinline__ void operator()(const AccT& acc, const Unit& u, int wr, int wc, int fr, int fq) const {
        const int row0 = u.pm * BM + wr * 64 + fr, col0 = u.pn * BM + wc * 32 + 8 * fq; f32x4 sv[2][2];
        EPI_LOOP_B { sv[bj][0] = *(const f32x4*)(scale + col0 + bj * HALF); sv[bj][1] = *(const f32x4*)(scale + col0 + bj * HALF + 4); }
        EPI_LOOP_AM { bf16_t* rp = O + (size_t)(row0 + ai * HALF + m * 16) * ldc + col0;
            EPI_LOOP_B { *(u32x4*)(rp + bj * HALF) = pack8(acc[ai][bj][m][0] * sv[bj][0], acc[ai][bj][m][1] * sv[bj][1]); } }
    }
};
template <bool HAS_ADD> struct EpiGate {
    static constexpr bool PERM = true;
    bf16_t* O; const bf16_t* gate; const bf16_t* add; int gcol0;
    __device__ __forceinline__ void operator()(const AccT& acc, const Unit& u, int wr, int wc, int fr, int fq) const {
        const int row0 = u.pm * BM + wr * 64 + fr, col0 = u.pn * BM + wc * 32 + 8 * fq;
        EPI_LOOP_AM { const size_t row = (size_t)(row0 + ai * HALF + m * 16);
            EPI_LOOP_B { f32x4 g0, g1; unpack8(__builtin_nontemporal_load((const u32x4*)(gate + row * 4096 + gcol0 + col0 + bj * HALF)), g0, g1);
                f32x4 v0 = g0 * acc[ai][bj][m][0], v1 = g1 * acc[ai][bj][m][1];
                if (HAS_ADD) { f32x4 a0, a1; unpack8(__builtin_nontemporal_load((const u32x4*)(add + row * 2048 + col0 + bj * HALF)), a0, a1); v0 += a0; v1 += a1; }
                *(u32x4*)(O + row * 2048 + col0 + bj * HALF) = pack8(v0, v1); } }
    }
};
struct EpiRes {
    static constexpr bool PERM = true;
    const bf16_t* base; float* out; int ldc;
    __device__ __forceinline__ void operator()(const AccT& acc, const Unit& u, int wr, int wc, int fr, int fq) const {
        const int row0 = u.pm * BM + wr * 64 + fr, col0 = u.pn * BM + wc * 32 + 8 * fq;
        EPI_LOOP_AM { const size_t off = (size_t)(row0 + ai * HALF + m * 16) * ldc + col0;
            EPI_LOOP_B { f32x4 b0, b1; unpack8(__builtin_nontemporal_load((const u32x4*)(base + off + bj * HALF)), b0, b1);
                __builtin_nontemporal_store(b0 + acc[ai][bj][m][0], (f32x4*)(out + off + bj * HALF)); __builtin_nontemporal_store(b1 + acc[ai][bj][m][1], (f32x4*)(out + off + bj * HALF + 4)); } }
    }
};
struct EpiResNorm {
    static constexpr bool PERM = true;
    const float* base; float* out; bf16_t* outb; float* ss; int ldc;
    __device__ __forceinline__ void operator()(const AccT& acc, const Unit& u, int wr, int wc, int fr, int fq) const {
        const int row0 = u.pm * BM + wr * 64 + fr, col0 = u.pn * BM + wc * 32 + 8 * fq;
        EPI_LOOP_AM { const int row = row0 + ai * HALF + m * 16; const size_t off = (size_t)row * ldc + col0; float s = 0.f;
            EPI_LOOP_B { const f32x4 v0 = __builtin_nontemporal_load((const f32x4*)(base + off + bj * HALF)) + acc[ai][bj][m][0], v1 = __builtin_nontemporal_load((const f32x4*)(base + off + bj * HALF + 4)) + acc[ai][bj][m][1];
                *(u32x4*)(outb + off + bj * HALF) = pack8(v0, v1);
                s += ((v0[0] * v0[0] + v0[1] * v0[1]) + (v0[2] * v0[2] + v0[3] * v0[3])) + ((v1[0] * v1[0] + v1[1] * v1[1]) + (v1[2] * v1[2] + v1[3] * v1[3])); }
            s += __shfl_xor(s, 16); s += __shfl_xor(s, 32);
            if (fq == 0) atomicAdd(ss + row, s); }
    }
};
struct EpiSwiGLU {
    static constexpr bool PERM = true;
    bf16_t* O; int ldc; const float* ss;
    __device__ __forceinline__ void operator()(const AccT& acc, const Unit& u, int wr, int wc, int fr, int fq) const {
        const int row0 = u.pm * BM + wr * 64 + fr, col0 = u.pn * HALF + wc * 32 + 8 * fq;
        EPI_LOOP_AM { const int row = row0 + ai * HALF + m * 16; bf16_t* rp = O + (size_t)row * ldc + col0;
            const float inv = __builtin_amdgcn_rsqf(ss[row] * (1.f / 2048.f) + 1e-6f);
            const f32x4 g0 = acc[ai][0][m][0] * inv, g1 = acc[ai][0][m][1] * inv;
            *(u32x4*)rp = pack8(g0 * sigmoid4(g0) * (acc[ai][1][m][0] * inv), g1 * sigmoid4(g1) * (acc[ai][1][m][1] * inv)); }
    }
};

template <class Epi, class Sched, bool ALIGN_EPI = true>
__device__ __forceinline__ void gemm_phase(PG8_LAS unsigned char* lds, const Gemm g, const Sched& S, const Epi& E) {
    const int tid = threadIdx.x, wid = __builtin_amdgcn_readfirstlane(tid >> 6), lane = tid & 63, wr = wid >> 2, wc = wid & 3, fr = lane & 15, fq = lane >> 4;
    const int K = g.K, nt = K / BK;
    unsigned voffA[2], voffB[2];
#pragma unroll
    for (int i = 0; i < 2; ++i) { int R, C; stage_rc(tid * 16 + i * 8192, R, C); const int Rb = Epi::PERM ? ((R & ~31) + perm32(R & 31)) : R;
        voffA[i] = (unsigned)(R * g.lda + C) * 2u; voffB[i] = (unsigned)(Rb * g.ldb + C) * 2u; }
    const size_t kstep = (size_t)(BK * 2);
    const size_t hstepA = (size_t)HALF * g.lda * 2, hstepB = (size_t)HALF * g.ldb * 2;
    const size_t tstepA = 2 * hstepA, tstepB = g.b_pn_step ? (size_t)g.b_pn_step * 2 : 2 * hstepB, pstepA = (size_t)g.a_pn_step * 2;
    const unsigned ldsw = (unsigned)wid * 1024u;
    const int aoff = lds_byte(wr * 64 + fr, fq * 8), boff = lds_byte(wc * 32 + fr, fq * 8);
#define PG8_SA(b, h) (((b) * 2 + (h)) * HTB)
#define PG8_SB(b, h) ((4 + (b) * 2 + (h)) * HTB)
#define PG8_STAGE(bufoff, gbase, voff) do { _Pragma("unroll") for (int _i = 0; _i < 2; ++_i) \
        __builtin_amdgcn_global_load_lds((const unsigned*)((const char*)(gbase) + (voff)[_i]), (PG8_LAS unsigned*)(lds + (bufoff) + ldsw + _i * 8192), 16, 0, 0); } while (0)
#define PG8_LDA(dst, b, h) do { _Pragma("unroll") for (int m = 0; m < 4; ++m) _Pragma("unroll") for (int k = 0; k < 2; ++k) dst[m][k] = *(const PG8_LAS bf16x8*)(lds + PG8_SA(b, h) + aoff + m * 2048 + k * 1024); } while (0)
#define PG8_LDB(dst, b, h) do { _Pragma("unroll") for (int n = 0; n < 2; ++n) _Pragma("unroll") for (int k = 0; k < 2; ++k) dst[n][k] = *(const PG8_LAS bf16x8*)(lds + PG8_SB(b, h) + boff + n * 2048 + k * 1024); } while (0)
#define PG8_MMA(ai, bj, At, Bt) do { __builtin_amdgcn_s_setprio(1); _Pragma("unroll") for (int m = 0; m < 4; ++m) _Pragma("unroll") for (int n = 0; n < 2; ++n) _Pragma("unroll") for (int k = 0; k < 2; ++k) \
        acc[ai][bj][m][n] = __builtin_amdgcn_mfma_f32_16x16x32_bf16(Bt[n][k], At[m][k], acc[ai][bj][m][n], 0, 0, 0); __builtin_amdgcn_s_setprio(0); } while (0)
#define PG8_WAIT_V(n) asm volatile("s_waitcnt vmcnt(" #n ")" ::: "memory")
#define PG8_WAIT_L(n) asm volatile("s_waitcnt lgkmcnt(" #n ")" ::: "memory")
#define PG8_BAR __builtin_amdgcn_s_barrier()
#define PG8_SCHED __builtin_amdgcn_sched_barrier(0)
    Unit cur, nxt; int ui = 0;
    if (!S.next(0, cur)) return;
    f32x4 acc[2][2][4][2];
#pragma unroll
    for (int a = 0; a < 2; ++a)
#pragma unroll
        for (int b = 0; b < 2; ++b)
#pragma unroll
            for (int m = 0; m < 4; ++m)
#pragma unroll
                for (int n = 0; n < 2; ++n) acc[a][b][m][n] = (f32x4){0.f, 0.f, 0.f, 0.f};
    bf16x8 At[4][2], B0[2][2], B1[2][2];
    const char* cA = (const char*)g.A + (size_t)cur.pm * tstepA + (size_t)cur.pn * pstepA; const char* cB = (const char*)g.Bt + (size_t)cur.pn * tstepB;
    PG8_STAGE(PG8_SB(0, 0), cB, voffB); PG8_STAGE(PG8_SB(0, 1), cB + hstepB, voffB); PG8_STAGE(PG8_SA(0, 0), cA, voffA); PG8_STAGE(PG8_SA(0, 1), cA + hstepA, voffA);
    if (wr == 1) PG8_BAR;
    PG8_WAIT_V(2); PG8_BAR;
    PG8_STAGE(PG8_SB(1, 0), cB + kstep, voffB); PG8_STAGE(PG8_SA(1, 0), cA + kstep, voffA); PG8_STAGE(PG8_SB(1, 1), cB + hstepB + kstep, voffB);
    PG8_WAIT_V(6); PG8_BAR;
    for (;;) {
        const bool has_next = S.next(ui + 1, nxt);
        const char* nA = has_next ? (const char*)g.A + (size_t)nxt.pm * tstepA + (size_t)nxt.pn * pstepA : cA; const char* nB = has_next ? (const char*)g.Bt + (size_t)nxt.pn * tstepB : cB;
        for (int t = 0; t < nt; t += 2) {
            const bool last = (t == nt - 2);
            const char* a1 = cA + (size_t)(t + 1) * kstep;
            const char* a2 = last ? nA : cA + (size_t)(t + 2) * kstep; const char* b2 = last ? nB : cB + (size_t)(t + 2) * kstep;
            const char* a3 = a2 + kstep; const char* b3 = b2 + kstep;
            PG8_LDB(B0, 0, 0); PG8_LDB(B1, 0, 1); PG8_SCHED; PG8_LDA(At, 0, 0); PG8_STAGE(PG8_SA(1, 1), a1 + hstepA, voffA);
            PG8_WAIT_V(8); PG8_WAIT_L(0); PG8_BAR; PG8_MMA(0, 0, At, B0); PG8_MMA(0, 1, At, B1); PG8_BAR; PG8_SCHED;
            PG8_LDA(At, 0, 1); PG8_STAGE(PG8_SB(0, 0), b2, voffB); PG8_STAGE(PG8_SB(0, 1), b2 + hstepB, voffB); PG8_STAGE(PG8_SA(0, 0), a2, voffA);
            PG8_WAIT_V(8); PG8_WAIT_L(0); PG8_BAR; PG8_MMA(1, 0, At, B0); PG8_MMA(1, 1, At, B1); PG8_BAR; PG8_SCHED;
            PG8_LDB(B0, 1, 0); PG8_LDB(B1, 1, 1); PG8_SCHED; PG8_LDA(At, 1, 0); PG8_STAGE(PG8_SA(0, 1), a2 + hstepA, voffA);
            PG8_WAIT_V(8); PG8_WAIT_L(0); PG8_BAR; PG8_MMA(0, 0, At, B0); PG8_MMA(0, 1, At, B1); PG8_BAR; PG8_SCHED;
            PG8_LDA(At, 1, 1); PG8_STAGE(PG8_SB(1, 0), b3, voffB); PG8_STAGE(PG8_SB(1, 1), b3 + hstepB, voffB); PG8_STAGE(PG8_SA(1, 0), a3, voffA);
            PG8_WAIT_V(8); PG8_WAIT_L(0); PG8_BAR; PG8_MMA(1, 0, At, B0); PG8_MMA(1, 1, At, B1); PG8_BAR; PG8_SCHED;
        }
        if constexpr (ALIGN_EPI) { if (wr == 0) PG8_BAR; }
        E(acc, cur, wr, wc, fr, fq);
        if (!has_next) break;
#pragma unroll
        for (int a = 0; a < 2; ++a)
#pragma unroll
            for (int b = 0; b < 2; ++b)
#pragma unroll
                for (int m = 0; m < 4; ++m)
#pragma unroll
                    for (int n = 0; n < 2; ++n) acc[a][b][m][n] = (f32x4){0.f, 0.f, 0.f, 0.f};
        cur = nxt; cA = nA; cB = nB; ++ui;
        if constexpr (ALIGN_EPI) { if (wr == 1) PG8_BAR; }
    }
    PG8_WAIT_V(0);
    if constexpr (!ALIGN_EPI) { if (wr == 0) PG8_BAR; }
    PG8_BAR;
#undef PG8_SA
#undef PG8_SB
#undef PG8_STAGE
#undef PG8_LDA
#undef PG8_LDB
#undef PG8_MMA
#undef PG8_WAIT_V
#undef PG8_WAIT_L
#undef PG8_BAR
#undef PG8_SCHED
}
}

constexpr int BATCH = 2, SEQ = 4096, DM = 2048, M = BATCH * SEQ;
constexpr int NH = 16, DQK = 192, DNOPE = 128, DROPE = 64, DV = 128, QLORA = 512, KVLORA = 512;
constexpr int POOLW = 1024, DIN = 6208, DIN_PAD = 6400, DFF = 5632;
constexpr float EPS = 1e-6f;
constexpr int NWAVES = 8;

typedef unsigned short bf16;
typedef unsigned v4u __attribute__((ext_vector_type(4)));
typedef unsigned v2u __attribute__((ext_vector_type(2)));
typedef float f32x4 __attribute__((ext_vector_type(4)));
typedef short bf16x8 __attribute__((ext_vector_type(8)));
typedef short s16x4 __attribute__((ext_vector_type(4)));
typedef float f32x16 __attribute__((ext_vector_type(16)));
#define LAS __attribute__((address_space(3)))
#define LDS_WAIT() asm volatile("s_waitcnt lgkmcnt(0)" ::: "memory")

constexpr size_t MiB = 1u << 20;
constexpr size_t WS_WAO = 1 * MiB, WS_WOUT = 9 * MiB, WS_WPO = 17 * MiB, WS_WQB = 21 * MiB, WS_WKVB = 24 * MiB, WS_WPG = 28 * MiB, WS_KR = 29 * MiB;
constexpr size_t WS_G = 31 * MiB;
constexpr size_t WS_WIN = 95 * MiB, WS_XN = 120 * MiB, WS_C1 = 152 * MiB, WS_U = 184 * MiB;
constexpr size_t WS_Q = 95 * MiB, WS_K = 143 * MiB, WS_V = 191 * MiB, WS_CN = 223 * MiB, WS_POOLED = 239 * MiB, WS_PG = 255 * MiB;
constexpr size_t WS_MP = 223 * MiB, WS_O = 255 * MiB, WS_MIXED = 95 * MiB, WS_X1 = 127 * MiB, WS_H2 = 95 * MiB;
constexpr size_t WS_WGU = 191 * MiB, WS_WDN = 235 * MiB, WS_ACT = 1 * MiB;
constexpr size_t WS_END = 296 * MiB, WS_BAR = 512 * 1024, WS_KRP = 272 * MiB, WS_X1B = 257 * MiB;
constexpr int SV_BGATE = 0, SV_QAG = 4096, SV_KVAG = 4608, SV_QNG = 5120, SV_KNG = 5376, SV_PSC = 5632, SV_FNG = 6656, SV_POS = 8704, SV_END = 8704 + 8192, SV_SS = 32768;

constexpr int LDS_BYTES = 147456;

__device__ __forceinline__ unsigned cvtpk(float lo, float hi) { return pg8::cvt_pk_bf16(lo, hi); }
__device__ __forceinline__ float bflo(unsigned w) { return __uint_as_float(w << 16); }
__device__ __forceinline__ float bfhi(unsigned w) { return __uint_as_float(w & 0xffff0000u); }
__device__ __forceinline__ float wave_sum(float v) {
#pragma unroll
    for (int o = 1; o < 64; o <<= 1) v += __shfl_xor(v, o);
    return v;
}

__device__ __forceinline__ int dst_row(int mode, int n0) {
    if (mode == 1) { if (n0 < 1024) return n0; if (n0 < 1088) return 6144 + (n0 - 1024); if (n0 < 2112) return 1024 + (n0 - 1088); return 2048 + (n0 - 2112); }
    if (mode == 2) return (n0 >> 7) * 256 + (n0 & 127);
    if (mode == 3) return (n0 >> 7) * 256 + 128 + (n0 & 127);
    return n0;
}
__device__ __forceinline__ void transpose_item(const float* W, int K, int N, bf16* WT, int mode, int row_off, LAS float* scr, int item, int lane, const float* gk = nullptr) {
    const int nblk = N / 32, kb = item / nblk, nb = item % nblk, k0 = 64 * kb, n0 = 32 * nb;
    { float tv[32]; const float* wp = W + (size_t)(k0 + (lane >> 5)) * N + n0 + (lane & 31);
#pragma unroll
      for (int i = 0; i < 32; ++i) tv[i] = wp[(size_t)(2 * i) * N];
      if (gk) {
#pragma unroll
          for (int i = 0; i < 32; ++i) tv[i] *= gk[k0 + 2 * i + (lane >> 5)]; }
#pragma unroll
      for (int i = 0; i < 32; ++i) scr[(2 * i + (lane >> 5)) * 33 + (lane & 31)] = tv[i]; }
    LDS_WAIT(); asm volatile("" ::: "memory");
    const int c = lane & 7, dr = row_off + dst_row(mode, n0);
#pragma unroll
    for (int j = 0; j < 4; ++j) { const int n = (lane >> 3) + 8 * j; const LAS float* s = scr + (8 * c) * 33 + n;
        v4u o; o.x = cvtpk(s[0 * 33], s[1 * 33]); o.y = cvtpk(s[2 * 33], s[3 * 33]); o.z = cvtpk(s[4 * 33], s[5 * 33]); o.w = cvtpk(s[6 * 33], s[7 * 33]);
        *(v4u*)(WT + (size_t)(dr + n) * K + k0 + 8 * c) = o; }
    LDS_WAIT(); asm volatile("" ::: "memory");
}

struct TrDesc { const float* W; bf16* WT; const float* gk; int K, N, k0, n0, dr; };
__device__ __forceinline__ TrDesc tr_desc(const float* W, int K, int N, bf16* WT, int mode, int row_off, int item, const float* gk) {
    const int nblk = N / 32, kb = item / nblk, nb = item % nblk; TrDesc d; d.W = W; d.WT = WT; d.gk = gk; d.K = K; d.N = N; d.k0 = 64 * kb; d.n0 = 32 * nb; d.dr = row_off + dst_row(mode, d.n0); return d; }
__device__ __forceinline__ void tr_load(const TrDesc& d, float (&tv)[32], int lane) {
    const float* wp = d.W + (size_t)(d.k0 + (lane >> 5)) * d.N + d.n0 + (lane & 31);
#pragma unroll
    for (int i = 0; i < 32; ++i) tv[i] = __builtin_nontemporal_load(wp + (size_t)(2 * i) * d.N);
}
__device__ __forceinline__ void tr_finish(const TrDesc& d, float (&tv)[32], LAS float* scr, int lane) {
    if (d.gk) {
#pragma unroll
        for (int i = 0; i < 32; ++i) tv[i] *= d.gk[d.k0 + 2 * i + (lane >> 5)]; }
#pragma unroll
    for (int i = 0; i < 32; ++i) scr[(2 * i + (lane >> 5)) * 33 + (lane & 31)] = tv[i];
    LDS_WAIT(); asm volatile("" ::: "memory");
    const int c = lane & 7;
#pragma unroll
    for (int j = 0; j < 4; ++j) { const int n = (lane >> 3) + 8 * j; const LAS float* s_ = scr + (8 * c) * 33 + n;
        v4u o; o.x = cvtpk(s_[0 * 33], s_[1 * 33]); o.y = cvtpk(s_[2 * 33], s_[3 * 33]); o.z = cvtpk(s_[4 * 33], s_[5 * 33]); o.w = cvtpk(s_[6 * 33], s_[7 * 33]);
        *(v4u*)(d.WT + (size_t)(d.dr + n) * d.K + d.k0 + 8 * c) = o; }
    LDS_WAIT(); asm volatile("" ::: "memory");
}
#define TR_PIPELINE(FIRST, LIMIT, STRIDE, MAKE_DESC) do { int it_ = (FIRST); if (it_ < (LIMIT)) { TrDesc dA_ = MAKE_DESC(it_); float tvA_[32]; tr_load(dA_, tvA_, lane); \
        for (;;) { const int nx_ = it_ + (STRIDE); const bool more_ = nx_ < (LIMIT); TrDesc dB_ = dA_; float tvB_[32]; \
            if (more_) { dB_ = MAKE_DESC(nx_); tr_load(dB_, tvB_, lane); } \
            tr_finish(dA_, tvA_, scr, lane); if (!more_) break; \
            dA_ = dB_; _Pragma("unroll") for (int i_ = 0; i_ < 32; ++i_) tvA_[i_] = tvB_[i_]; it_ = nx_; } } } while (0)

__device__ __forceinline__ void rms_row_2048(const float* xrow, const float* g, bf16* orow, int lane) {
    const f32x4* xr = (const f32x4*)xrow + 2 * lane; const f32x4* gr = (const f32x4*)g + 2 * lane;
    f32x4 v[8]; float s = 0.f;
#pragma unroll
    for (int j = 0; j < 4; ++j) { v[2 * j] = __builtin_nontemporal_load(xr + 128 * j); v[2 * j + 1] = __builtin_nontemporal_load(xr + 128 * j + 1); }
#pragma unroll
    for (int j = 0; j < 8; ++j) s += (v[j].x * v[j].x + v[j].y * v[j].y) + (v[j].z * v[j].z + v[j].w * v[j].w);
    const float inv = __builtin_amdgcn_rsqf(wave_sum(s) * (1.f / 2048.f) + EPS);
    v4u* o16 = (v4u*)orow + lane;
#pragma unroll
    for (int j = 0; j < 4; ++j) { const f32x4 g0 = gr[128 * j], g1 = gr[128 * j + 1]; const f32x4 a = v[2 * j], b = v[2 * j + 1]; v4u o;
        o.x = cvtpk(a.x * inv * g0.x, a.y * inv * g0.y); o.y = cvtpk(a.z * inv * g0.z, a.w * inv * g0.w); o.z = cvtpk(b.x * inv * g1.x, b.y * inv * g1.y); o.w = cvtpk(b.z * inv * g1.z, b.w * inv * g1.w);
        o16[64 * j] = o; }
}

namespace att {
constexpr int QBLK = 32, KVBLK = 64, QB = 256;
constexpr int SHM_V = KVBLK * DV * 2, SHM_K = KVBLK * DQK * 2;
constexpr int OFF_V = 0, OFF_K = 3 * SHM_V, OFF_WS = OFF_K + 2 * SHM_K;
constexpr float SCALE = 0.07216878364870322f;
constexpr float THR = 8.f;
#define KSWZ(row, colB) ((row) * 384 + ((colB) ^ (((row) & 7) << 4)))
#define SBAR() __builtin_amdgcn_sched_barrier(0)
__device__ __forceinline__ int v_st(int k, int c) { const int kk = (k & ~0xC) | ((k & 4) << 1) | ((k & 8) >> 1); return ((kk >> 3) * 4 + (c >> 5)) * 512 + ((kk & 7) * 32 + (c & 31)) * 2; }
__device__ __forceinline__ int v_rd_base(int lane) { return ((lane & 3) << 3) | (((lane >> 2) & 3) << 6) | (((lane >> 4) & 1) << 5) | (((lane >> 5) & 1) << 8); }
__device__ __forceinline__ int crow(int r, int hi) { return (r & 3) + 8 * (r >> 2) + 4 * hi; }
__device__ __forceinline__ void mask_tile(f32x16& p0, f32x16& p1, int dq) {
    const float NEG = -__builtin_inff();
#pragma unroll
    for (int r = 0; r < 16; ++r) {
        const int c = (r & 3) + 8 * (r >> 2);
        if (dq - c < 0) p0[r] = NEG;
        if (dq - c - 32 < 0) p1[r] = NEG;
    }
}
__device__ __forceinline__ void partialSM(f32x16& p0, f32x16& p1, float& m_reg, float& mn, float& alpha) {
    float pmax = p0[0];
#pragma unroll
    for (int r = 1; r < 16; ++r) pmax = fmaxf(pmax, p0[r]);
#pragma unroll
    for (int r = 0; r < 16; ++r) pmax = fmaxf(pmax, p1[r]);
    { auto rr = __builtin_amdgcn_permlane32_swap(__float_as_uint(pmax), __float_as_uint(pmax), false, false);
      pmax = fmaxf(__uint_as_float(rr[0]), __uint_as_float(rr[1])); }
    constexpr float C2 = 1.4426950408889634f * SCALE;
    if (__builtin_expect(__all((pmax - m_reg) * SCALE <= THR), 1)) { mn = m_reg; alpha = 1.f; }
    else { mn = fmaxf(m_reg, pmax); alpha = __builtin_amdgcn_exp2f((m_reg - mn) * C2); m_reg = mn; }
    const float mnL = -mn * C2;
#pragma unroll
    for (int r = 0; r < 16; ++r) p0[r] = fmaf(p0[r], C2, mnL);
#pragma unroll
    for (int r = 0; r < 16; ++r) p1[r] = fmaf(p1[r], C2, mnL);
#pragma unroll
    for (int r = 0; r < 16; ++r) p0[r] = __builtin_amdgcn_exp2f(p0[r]);
}
__device__ __forceinline__ void finishSM(f32x16& p0, f32x16& p1, float alpha, float& l_reg, bf16x8& pa0, bf16x8& pa1, bf16x8& pa2, bf16x8& pa3) {
#pragma unroll
    for (int r = 0; r < 16; ++r) p1[r] = __builtin_amdgcn_exp2f(p1[r]);
    float ps = 0;
#pragma unroll
    for (int r = 0; r < 16; ++r) ps += p0[r];
#pragma unroll
    for (int r = 0; r < 16; ++r) ps += p1[r];
    { auto rr = __builtin_amdgcn_permlane32_swap(__float_as_uint(ps), __float_as_uint(ps), false, false);
      ps = __uint_as_float(rr[0]) + __uint_as_float(rr[1]); }
    l_reg = l_reg * alpha + ps;
#define PK4(P, B_, OUT) do { unsigned a0 = cvtpk(P[B_+0], P[B_+1]), a1 = cvtpk(P[B_+2], P[B_+3]);                          \
        unsigned b0 = cvtpk(P[B_+4], P[B_+5]), b1 = cvtpk(P[B_+6], P[B_+7]);                                             \
        auto r0 = __builtin_amdgcn_permlane32_swap(a0, b0, false, false); auto r1 = __builtin_amdgcn_permlane32_swap(a1, b1, false, false); \
        v4u w = {r0[0], r1[0], r0[1], r1[1]}; OUT = *reinterpret_cast<bf16x8*>(&w); } while (0)
    PK4(p0, 0, pa0); PK4(p0, 8, pa1); PK4(p1, 0, pa2); PK4(p1, 8, pa3);
#undef PK4
}
__device__ __forceinline__ void qkt(f32x16& p0, f32x16& p1, const char* Kb, int r32, int hi, const bf16x8* qr) {
    p0 = f32x16{}; p1 = f32x16{};
    const char* kb[4];
#pragma unroll
    for (int dd = 0; dd < 4; ++dd) kb[dd] = Kb + KSWZ(r32, (dd * 16 + hi * 8) * 2);
#pragma unroll
    for (int g = 0; g < 2; ++g) { bf16x8 b0[6], b1[6];
#pragma unroll
        for (int i = 0; i < 6; ++i) { const int d0 = 6 * g + i; const char* a = kb[d0 & 3] + (d0 >> 2) * 128; b0[i] = *reinterpret_cast<const bf16x8*>(a); b1[i] = *reinterpret_cast<const bf16x8*>(a + 32 * 384); }
        SBAR();
        __builtin_amdgcn_s_setprio(1);
#pragma unroll
        for (int i = 0; i < 6; ++i) { p0 = __builtin_amdgcn_mfma_f32_32x32x16_bf16(b0[i], qr[6 * g + i], p0, 0, 0, 0); p1 = __builtin_amdgcn_mfma_f32_32x32x16_bf16(b1[i], qr[6 * g + i], p1, 0, 0, 0); }
        __builtin_amdgcn_s_setprio(0);
        SBAR(); }
}
__device__ __forceinline__ void pv_tile(f32x16* o, int vb0, bf16x8 pa0, bf16x8 pa1, bf16x8 pa2, bf16x8 pa3) {
#define TRRD(dst, off) asm volatile("ds_read_b64_tr_b16 %0, %1 offset:%2" : "=&v"(dst) : "v"(vb0), "i"(off) : "memory")
#define PV_RD(S, d0) do { constexpr int b_ = (d0) * 512; TRRD(S##l0, b_); TRRD(S##h0, b_ + 2048); TRRD(S##l1, b_ + 4096); TRRD(S##h1, b_ + 6144); TRRD(S##l2, b_ + 8192); TRRD(S##h2, b_ + 10240); TRRD(S##l3, b_ + 12288); TRRD(S##h3, b_ + 14336); } while (0)
#define PV_MM(S, d0) do { \
        o[d0] = __builtin_amdgcn_mfma_f32_32x32x16_bf16(pa0, (bf16x8){S##l0[0], S##l0[1], S##l0[2], S##l0[3], S##h0[0], S##h0[1], S##h0[2], S##h0[3]}, o[d0], 0, 0, 0);   \
        o[d0] = __builtin_amdgcn_mfma_f32_32x32x16_bf16(pa1, (bf16x8){S##l1[0], S##l1[1], S##l1[2], S##l1[3], S##h1[0], S##h1[1], S##h1[2], S##h1[3]}, o[d0], 0, 0, 0);   \
        o[d0] = __builtin_amdgcn_mfma_f32_32x32x16_bf16(pa2, (bf16x8){S##l2[0], S##l2[1], S##l2[2], S##l2[3], S##h2[0], S##h2[1], S##h2[2], S##h2[3]}, o[d0], 0, 0, 0);   \
        o[d0] = __builtin_amdgcn_mfma_f32_32x32x16_bf16(pa3, (bf16x8){S##l3[0], S##l3[1], S##l3[2], S##l3[3], S##h3[0], S##h3[1], S##h3[2], S##h3[3]}, o[d0], 0, 0, 0); } while (0)
    s16x4 Al0, Al1, Al2, Al3, Ah0, Ah1, Ah2, Ah3, Bl0, Bl1, Bl2, Bl3, Bh0, Bh1, Bh2, Bh3;
    PV_RD(A, 0); PV_RD(B, 1);
    asm volatile("s_waitcnt lgkmcnt(8)" ::: "memory"); SBAR(); PV_MM(A, 0); SBAR();
    PV_RD(A, 2);
    asm volatile("s_waitcnt lgkmcnt(8)" ::: "memory"); SBAR(); PV_MM(B, 1); SBAR();
    PV_RD(B, 3);
    asm volatile("s_waitcnt lgkmcnt(8)" ::: "memory"); SBAR(); PV_MM(A, 2); SBAR();
    asm volatile("s_waitcnt lgkmcnt(0)" ::: "memory"); SBAR(); PV_MM(B, 3);
#undef PV_MM
#undef PV_RD
#undef TRRD
}
__device__ __forceinline__ void attn_unit(int b, int h, int qb, const bf16* Q, const bf16* K, const bf16* V, bf16* O, char* lds) {
    const int tid = threadIdx.x, wid = __builtin_amdgcn_readfirstlane(tid >> 6), lane = tid & 63, r32 = lane & 31, hi = lane >> 5;
    const size_t rowb = (size_t)b * SEQ;
    const int q0 = qb * QB, qlo = q0 + wid * QBLK;
    const int NT = (q0 + QB) / KVBLK;
    char* V_lds = lds + OFF_V; char* K_lds = lds + OFF_K;
#define WAVE_WS() ({ int t_ = (int)threadIdx.x; asm volatile("" : "+v"(t_)); (float*)(lds + OFF_WS) + (t_ >> 6) * 64; })
    LAS unsigned char* ldsl_ = (LAS unsigned char*)lds;
    unsigned ksrc[3], vsrc[2];
#pragma unroll
    for (int j = 0; j < 3; ++j) { const int s_ = (wid * 3 + j) * 64 + lane, row = s_ / 24, pc = s_ % 24; ksrc[j] = (unsigned)(row * 3072 * 2 + ((pc * 16) ^ ((row & 7) << 4))); }
#pragma unroll
    for (int j = 0; j < 2; ++j) { const int ob = ((wid * 2 + j) * 64 + lane) * 16, st = ob >> 9, kr_ = (ob >> 6) & 7, ch = (ob >> 4) & 3, c = (st & 3) * 32 + ch * 8, kk = (st >> 2) * 8 + kr_,
                                  k = (kk & ~0xC) | ((kk & 4) << 1) | ((kk & 8) >> 1); vsrc[j] = (unsigned)(k * 2048 * 2 + c * 2); }
    const char* Kh = (const char*)(K + rowb * 3072 + h * DQK); const char* Vh = (const char*)(V + rowb * 2048 + h * DV);
#define KDMA(k0, bf) do { _Pragma("unroll") for (int j = 0; j < 3; ++j) __builtin_amdgcn_global_load_lds((const unsigned*)(Kh + (size_t)(k0) * (3072 * 2) + ksrc[j]), \
        (LAS unsigned*)(ldsl_ + OFF_K + (bf) * SHM_K + (wid * 3 + j) * 1024), 16, 0, 0); } while (0)
#define VDMA(k0, sl) do { _Pragma("unroll") for (int j = 0; j < 2; ++j) __builtin_amdgcn_global_load_lds((const unsigned*)(Vh + (size_t)(k0) * (2048 * 2) + vsrc[j]), \
        (LAS unsigned*)(ldsl_ + OFF_V + (sl) * SHM_V + (wid * 2 + j) * 1024), 16, 0, 0); } while (0)
    KDMA(0, 0); VDMA(0, 0);
    bf16x8 qr[12];
    { const bf16* Qp = Q + (rowb + qlo + r32) * 3072 + h * DQK + hi * 8;
#pragma unroll
      for (int d0 = 0; d0 < 12; ++d0) qr[d0] = *(const bf16x8*)(Qp + d0 * 16); }
    asm volatile("s_waitcnt vmcnt(0)" ::: "memory");
    __syncthreads();
    float m_reg = -1e30f, l_reg = 0.f; f32x16 o[4] = {};
    const int vbase = (int)(uintptr_t)V_lds + v_rd_base(lane);
    const int qm = qlo + r32 - 4 * hi;
    f32x16 p0, p1;
#define SP_STAGE(VS) do { float mn, alpha; bf16x8 pa0, pa1, pa2, pa3; \
        partialSM(p0, p1, m_reg, mn, alpha); finishSM(p0, p1, alpha, l_reg, pa0, pa1, pa2, pa3); \
        if (__any(alpha < 1.f)) { float* al_l = WAVE_WS() + 32; if (hi == 0) al_l[r32] = alpha; asm volatile("s_waitcnt lgkmcnt(0)" ::: "memory"); \
            _Pragma("unroll") for (int d_ = 0; d_ < 4; ++d_) _Pragma("unroll") for (int r = 0; r < 16; ++r) o[d_][r] *= al_l[crow(r, hi)]; } \
        SBAR(); pv_tile(o, vbase + (VS) * SHM_V, pa0, pa1, pa2, pa3); } while (0)
    for (int t = 0; t < NT; ++t) {
        const int cur = t & 1, kb_ = t * KVBLK;
        if (t + 1 < NT) { KDMA((t + 1) * KVBLK, cur ^ 1); VDMA((t + 1) * KVBLK, cur ^ 1); }
        SBAR();
        qkt(p0, p1, K_lds + cur * SHM_K, r32, hi, qr); if (kb_ + KVBLK - 1 > qlo) mask_tile(p0, p1, qm - kb_);
        SBAR();
        SP_STAGE(cur);
        asm volatile("s_waitcnt vmcnt(0)" ::: "memory");
        __syncthreads();
    }
#undef SP_STAGE
    float* li_l = WAVE_WS();
    if (hi == 0) li_l[r32] = l_reg; asm volatile("s_waitcnt lgkmcnt(0)" ::: "memory");
    float rli[16];
#pragma unroll
    for (int r = 0; r < 16; ++r) rli[r] = __builtin_amdgcn_rcpf(li_l[crow(r, hi)]);
    bf16* Ow = O + (rowb + qlo) * 2048 + h * DV;
#pragma unroll
    for (int r = 0; r < 16; ++r) { const int orow = crow(r, hi);
#pragma unroll
        for (int d0 = 0; d0 < 4; ++d0) { const float v = o[d0][r] * rli[r];
            const float vn = __shfl_xor(v, 1);
            if ((r32 & 1) == 0) *(unsigned*)(Ow + (size_t)orow * 2048 + d0 * 32 + r32) = cvtpk(v, vn); } }
    __syncthreads();
#undef KDMA
#undef VDMA
#undef WAVE_WS
}
#undef SBAR
}

struct Args { const float* in[20]; float* out; unsigned char* ws; int ph_lo, ph_hi, coop, pad; };
#define XB_TMO      128
#define XB_XCNT(j)  (256  + 64 * (j))
#define XB_XSUB(j)  (1280 + 64 * (j))
#define XB_XGEN(j)  (2304 + 64 * (j))
#define XB_TOP      3328
#define XB_TOPGEN   3392
#define XCD_BAR_WORDS 3456
#define XB_SPIN_CAP (1u << 20)
__device__ __forceinline__ unsigned xb_ld(unsigned* p)              { return __hip_atomic_load(p, __ATOMIC_RELAXED, __HIP_MEMORY_SCOPE_AGENT); }
__device__ __forceinline__ unsigned xb_add(unsigned* p, unsigned v) { return __hip_atomic_fetch_add(p, v, __ATOMIC_RELAXED, __HIP_MEMORY_SCOPE_AGENT); }
__device__ __forceinline__ unsigned xb_xcc_id() { return (unsigned)__builtin_amdgcn_s_getreg((3 << 11) | 20) & 0xFu; }
#define XB_SPIN(cond, bar) do { unsigned _sp = 0; while (cond) { __builtin_amdgcn_s_sleep(1); \
    if ((++_sp & 255u) == 0u) { if (xb_ld(&(bar)[XB_TMO])) break; if (_sp > XB_SPIN_CAP) { atomicAdd(&(bar)[XB_TMO], 1u); break; } } } } while (0)
__device__ __forceinline__ void xcd_barrier_complete(unsigned* bar, unsigned x, unsigned& nloc, unsigned& nx) {
    const unsigned G = gridDim.x;
    unsigned sum, cnt, mine, sp = 0u;
    for (;;) {
        sum = 0u; cnt = 0u; mine = 0u;
#pragma unroll
        for (unsigned j = 0; j < 16; ++j) { const unsigned c = xb_ld(&bar[XB_XCNT(j)]); sum += c; cnt += (c > 0u) ? 1u : 0u; mine = (j == x) ? c : mine; }
        if (sum == G) break;
        __builtin_amdgcn_s_sleep(1);
        if ((++sp & 255u) == 0u) { if (xb_ld(&bar[XB_TMO])) break; if (sp > XB_SPIN_CAP) { atomicAdd(&bar[XB_TMO], 1u); break; } }
    }
    nloc = mine > 0u ? mine : 1u; nx = cnt > 0u ? cnt : 1u;
}
__device__ __forceinline__ void grid_bar(unsigned* bar, volatile LAS unsigned* st) {
    asm volatile("s_waitcnt vmcnt(0)" ::: "memory");
    __syncthreads();
    if (threadIdx.x == 0) {
        const unsigned x = xb_xcc_id();
        __builtin_amdgcn_s_waitcnt(0);
        unsigned nloc = st[0], nx = st[1];
        if (nloc == 0u) { xcd_barrier_complete(bar, x, nloc, nx); st[0] = nloc; st[1] = nx; }
        const unsigned old = xb_add(&bar[XB_XSUB(x)], 1u);
        const unsigned gen = old / nloc;
        if (old + 1u == (gen + 1u) * nloc) {
            __builtin_amdgcn_fence(__ATOMIC_RELEASE, "agent");
            asm volatile("s_waitcnt vmcnt(0)" ::: "memory");
            const unsigned og = xb_add(&bar[XB_TOP], 1u);
            const unsigned tg = og / nx;
            if (og + 1u == (tg + 1u) * nx) xb_add(&bar[XB_TOPGEN], 1u);
            else XB_SPIN(xb_ld(&bar[XB_TOPGEN]) == tg, bar);
            __builtin_amdgcn_fence(__ATOMIC_ACQUIRE, "agent");
            xb_add(&bar[XB_XGEN(x)], 1u);
            asm volatile("s_waitcnt vmcnt(0)" ::: "memory");
        } else {
            XB_SPIN(xb_ld(&bar[XB_XGEN(x)]) == gen, bar);
            __builtin_amdgcn_fence(__ATOMIC_ACQUIRE, "agent");
            asm volatile("s_waitcnt vmcnt(0)" ::: "memory");
        }
    }
    __syncthreads();
}
constexpr int NPH = 11;

__global__ void __launch_bounds__(NWAVES * 64, 2) mega_fwd(Args args) {
    extern __shared__ __attribute__((aligned(16))) unsigned char lds[];
    LAS unsigned char* ldsl = (LAS unsigned char*)lds;
    const int tid = threadIdx.x, lane = tid & 63, wave = __builtin_amdgcn_readfirstlane(tid >> 6);
    const int G = gridDim.x, bx = blockIdx.x;
    const int vcu = (G % 8 == 0) ? (bx % 8) * (G / 8) + bx / 8 : bx;
    const int gw = vcu * NWAVES + wave, NGW = G * NWAVES;
    unsigned char* ws = args.ws;
    const float* const* kin = (const float* const*)__builtin_amdgcn_kernarg_segment_ptr();
    const float* svec = (const float*)ws;
    const float* b_gate = svec + SV_BGATE; const float* q_a_norm_g = svec + SV_QAG; const float* kv_a_norm_g = svec + SV_KVAG; const float* q_norm_g = svec + SV_QNG;
    const float* k_norm_g = svec + SV_KNG; const float* pool_scale = svec + SV_PSC; const float* ffn_norm_g = svec + SV_FNG; const int* positions = (const int*)(svec + SV_POS);
    bf16* WIN_T = (bf16*)(ws + WS_WIN); bf16* WQB_T = (bf16*)(ws + WS_WQB); bf16* WKVB_T = (bf16*)(ws + WS_WKVB); bf16* WPG_T = (bf16*)(ws + WS_WPG);
    bf16* WPO_T = (bf16*)(ws + WS_WPO); bf16* WAO_T = (bf16*)(ws + WS_WAO); bf16* WOUT_T = (bf16*)(ws + WS_WOUT); bf16* WGU_T = (bf16*)(ws + WS_WGU); bf16* WDN_T = (bf16*)(ws + WS_WDN);
    bf16* XN = (bf16*)(ws + WS_XN); bf16* C1 = (bf16*)(ws + WS_C1); float* KRP = (float*)(ws + WS_KRP); bf16* U = (bf16*)(ws + WS_U); bf16* Gt = (bf16*)(ws + WS_G);
    bf16* CN = (bf16*)(ws + WS_CN); bf16* POOLED = (bf16*)(ws + WS_POOLED); bf16* Qb = (bf16*)(ws + WS_Q); bf16* Kb = (bf16*)(ws + WS_K); bf16* Vb = (bf16*)(ws + WS_V);
    bf16* PG = (bf16*)(ws + WS_PG); bf16* MP = (bf16*)(ws + WS_MP); bf16* Ob = (bf16*)(ws + WS_O); bf16* MIXED = (bf16*)(ws + WS_MIXED);
    float* X1 = (float*)(ws + WS_X1); bf16* H2 = (bf16*)(ws + WS_H2); bf16* ACT = (bf16*)(ws + WS_ACT);

    const int lo = args.ph_lo, hi_ph = args.ph_hi;
#ifndef PHMASK
#define PHMASK 0x7ff
#endif
#define IN(k) (((PHMASK >> (k)) & 1) && lo <= (k) && (k) < hi_ph)
#define SEAM(k) do { if (IN(k) && IN((k) + 1)) { unsigned char* w2_ = args.ws; asm volatile("" : "+s"(w2_)); grid_bar((unsigned*)(w2_ + WS_BAR), (volatile LAS unsigned*)(ldsl + 140032)); } } while (0)
    if (args.coop > 1) cg::this_grid().sync();
    if (threadIdx.x < 2) ((volatile LAS unsigned*)(ldsl + 140032))[threadIdx.x] = 0u;
    __syncthreads();
    if (args.coop && threadIdx.x == 0) { unsigned char* w2_ = args.ws; asm volatile("" : "+s"(w2_)); (void)xb_add(&((unsigned*)(w2_ + WS_BAR))[XB_XCNT(xb_xcc_id())], 1u); }
    LAS float* scr = (LAS float*)(ldsl + wave * 16384);
#ifdef TPROBE
#define TP_BEGIN(k) do { if ((TPROBE >> (k)) & 1) { if (blockIdx.x == 0 && threadIdx.x == 0) { *(volatile LAS unsigned*)(ldsl + 140000) = (unsigned)__builtin_amdgcn_s_memrealtime(); } } } while (0)
#define TP_END(k) do { if ((TPROBE >> (k)) & 1) { if (blockIdx.x == 0 && threadIdx.x == 0) { volatile LAS unsigned* tp_ = (volatile LAS unsigned*)(ldsl + 140000); tp_[1] += (unsigned)__builtin_amdgcn_s_memrealtime() - tp_[0]; } } } while (0)
    if (blockIdx.x == 0 && threadIdx.x == 0) { ((volatile LAS unsigned*)(ldsl + 140000))[1] = 0u; }
#else
#define TP_BEGIN(k) do {} while (0)
#define TP_END(k) do {} while (0)
#endif

    if (IN(0)) { TP_BEGIN(0);
        { float* sv = (float*)ws; const int gt = bx * (NWAVES * 64) + tid, GT = G * NWAVES * 64;
          for (int i = gt; i < M; i += GT) sv[SV_SS + i] = 0.f;
          for (int i = gt; i < SV_END; i += GT) { int idx, off, lim = 1 << 30;
              if (i < SV_QAG) { idx = 4; off = SV_BGATE; } else if (i < SV_KVAG) { idx = 5; off = SV_QAG; } else if (i < SV_QNG) { idx = 7; off = SV_KVAG; }
              else if (i < SV_KNG) { idx = 9; off = SV_QNG; lim = 192; } else if (i < SV_PSC) { idx = 10; off = SV_KNG; lim = 192; }
              else if (i < SV_FNG) { idx = 13; off = SV_PSC; } else if (i < SV_POS) { idx = 16; off = SV_FNG; } else { idx = 1; off = SV_POS; }
              const float* src = kin[idx]; sv[i] = (i - off < lim) ? src[i - off] : 0.f; } }
        constexpr int I_IN = (DM / 64) * (DIN / 32), I_QB = (QLORA / 64) * (NH * DQK / 32), I_KVB = (KVLORA / 64) * (NH * 256 / 32), I_PG = (256 / 64) * (256 / 32),
                      I_PO = (POOLW / 64) * (DM / 32), I_AO = (DM / 64) * (DM / 32), I_OUT = I_AO;
        constexpr int NITEMS = I_IN + I_QB + I_KVB + 4 * I_PG + I_PO + I_AO + I_OUT;
#define P0_DESC(it__) ([&]() { int r = (it__), idx, Kd, Nd, mode = 0, roff = 0; size_t dsto, srco = 0; \
            if (r < I_IN) { idx = 3; Kd = DM; Nd = DIN; mode = 1; dsto = WS_WIN; } \
            else if ((r -= I_IN) < I_QB) { idx = 6; Kd = QLORA; Nd = NH * DQK; dsto = WS_WQB; } \
            else if ((r -= I_QB) < I_KVB) { idx = 8; Kd = KVLORA; Nd = NH * 256; dsto = WS_WKVB; } \
            else if ((r -= I_KVB) < 4 * I_PG) { const int g = r / I_PG; r = r % I_PG; idx = 12; Kd = 256; Nd = 256; dsto = WS_WPG; roff = g * 256; srco = (size_t)g * 65536; } \
            else if ((r -= 4 * I_PG) < I_PO) { idx = 14; Kd = POOLW; Nd = DM; dsto = WS_WPO; } \
            else if ((r -= I_PO) < I_AO) { idx = 11; Kd = DM; Nd = DM; dsto = WS_WAO; } \
            else { r -= I_AO; idx = 15; Kd = DM; Nd = DM; dsto = WS_WOUT; } \
            return tr_desc(kin[idx] + srco, Kd, Nd, (bf16*)(ws + dsto), mode, roff, r, nullptr); }())
        TR_PIPELINE(gw, NITEMS, NGW, P0_DESC);
#undef P0_DESC
        { v4u* z = (v4u*)(WIN_T + (size_t)DIN * DM); const int nz = (DIN_PAD - DIN) * DM / 8;
          for (int i = gw * 64 + lane; i < nz; i += NGW * 64) z[i] = (v4u){0u, 0u, 0u, 0u}; }
        { const float* x = kin[0]; const float* attn_norm_g = kin[2];
          for (int m = gw; m < M; m += NGW) rms_row_2048(x + (size_t)m * DM, attn_norm_g, XN + (size_t)m * DM, lane); }
    TP_END(0); }
    SEAM(0);
    if (IN(1)) { TP_BEGIN(1);
        { pg8::Gemm g{XN, WIN_T, M, 6144, DM, DM, DM, 0, 0}; pg8::StaticOrder S; S.init(M, 6144, G, bx);
          pg8::EpiIn E{C1, U, Gt, b_gate};
          pg8::gemm_phase<pg8::EpiIn, pg8::StaticOrder>(ldsl, g, S, E); }
        { pg8::Gemm g{XN, WIN_T + (size_t)6144 * DM, M, 2048, 256, DM, DM, 256, 256}; pg8::StaticOrder S; S.init(M, 2048, G, bx);
          pg8::EpiKRP E{KRP};
          pg8::gemm_phase<pg8::EpiKRP, pg8::StaticOrder>(ldsl, g, S, E); }
    TP_END(1); }
    SEAM(1);
    if (IN(2)) { TP_BEGIN(2);
        for (int m = gw; m < M; m += NGW) {
            const v4u cq = __builtin_nontemporal_load((const v4u*)(C1 + (size_t)m * 1024 + 8 * lane)), ck = __builtin_nontemporal_load((const v4u*)(C1 + (size_t)m * 1024 + 512 + 8 * lane));
            const float fq_[8] = {bflo(cq.x), bfhi(cq.x), bflo(cq.y), bfhi(cq.y), bflo(cq.z), bfhi(cq.z), bflo(cq.w), bfhi(cq.w)};
            const float fk_[8] = {bflo(ck.x), bfhi(ck.x), bflo(ck.y), bfhi(ck.y), bflo(ck.z), bfhi(ck.z), bflo(ck.w), bfhi(ck.w)};
            float sq = 0.f, skv = 0.f;
#pragma unroll
            for (int e = 0; e < 8; ++e) { sq += fq_[e] * fq_[e]; skv += fk_[e] * fk_[e]; }
            const float iq = __builtin_amdgcn_rsqf(wave_sum(sq) * (1.f / 512.f) + EPS), ikv = __builtin_amdgcn_rsqf(wave_sum(skv) * (1.f / 512.f) + EPS);
            if (lane < 16) { f32x4 acc4 = {0.f, 0.f, 0.f, 0.f};
#pragma unroll
                for (int ks = 0; ks < 8; ++ks) acc4 += __builtin_nontemporal_load((const f32x4*)(KRP + ((size_t)ks * 8192 + m) * 64 + 4 * lane));
                *(f32x4*)((float*)(ws + WS_KR) + (size_t)m * 64 + 4 * lane) = acc4; }
            const f32x4 gq0 = ((const f32x4*)q_a_norm_g)[2 * lane], gq1 = ((const f32x4*)q_a_norm_g)[2 * lane + 1], gk0 = ((const f32x4*)kv_a_norm_g)[2 * lane], gk1 = ((const f32x4*)kv_a_norm_g)[2 * lane + 1];
            v4u oq, ok;
            oq.x = cvtpk(fq_[0] * iq * gq0.x, fq_[1] * iq * gq0.y); oq.y = cvtpk(fq_[2] * iq * gq0.z, fq_[3] * iq * gq0.w); oq.z = cvtpk(fq_[4] * iq * gq1.x, fq_[5] * iq * gq1.y); oq.w = cvtpk(fq_[6] * iq * gq1.z, fq_[7] * iq * gq1.w);
            ok.x = cvtpk(fk_[0] * ikv * gk0.x, fk_[1] * ikv * gk0.y); ok.y = cvtpk(fk_[2] * ikv * gk0.z, fk_[3] * ikv * gk0.w); ok.z = cvtpk(fk_[4] * ikv * gk1.x, fk_[5] * ikv * gk1.y); ok.w = cvtpk(fk_[6] * ikv * gk1.z, fk_[7] * ikv * gk1.w);
            *(v4u*)(CN + (size_t)m * 1024 + 8 * lane) = oq; *(v4u*)(CN + (size_t)m * 1024 + 512 + 8 * lane) = ok;
        }
        for (int base = gw * 4; base < M; base += NGW * 4) {
            const int s0 = base & (SEQ - 1);
#pragma unroll
            for (int jj = 0; jj < 2; ++jj) {
                const int col = 8 * lane + 512 * jj, grp = col >> 8, w = 2 << grp; int cnt = (s0 + 1 < w) ? s0 + 1 : w;
                float a[8], uc[8];
#pragma unroll
                for (int e = 0; e < 8; ++e) a[e] = 0.f;
#pragma unroll
                for (int d = 0; d < 16; ++d) {
                    if (d < cnt) { const v4u q = *(const v4u*)(U + (size_t)(base - d) * 1024 + col);
                        const float f[8] = {bflo(q.x), bfhi(q.x), bflo(q.y), bfhi(q.y), bflo(q.z), bfhi(q.z), bflo(q.w), bfhi(q.w)};
#pragma unroll
                        for (int e = 0; e < 8; ++e) { a[e] += f[e]; if (d == 0) uc[e] = f[e]; } }
                }
#pragma unroll
                for (int i = 0; i < 4; ++i) {
                    const int m = base + i;
                    if (i > 0) { const int s = s0 + i;
                        { const v4u q = *(const v4u*)(U + (size_t)m * 1024 + col);
                          uc[0] = bflo(q.x); uc[1] = bfhi(q.x); uc[2] = bflo(q.y); uc[3] = bfhi(q.y); uc[4] = bflo(q.z); uc[5] = bfhi(q.z); uc[6] = bflo(q.w); uc[7] = bfhi(q.w); }
#pragma unroll
                        for (int e = 0; e < 8; ++e) a[e] += uc[e];
                        if (s >= w) { const v4u q = *(const v4u*)(U + (size_t)(m - w) * 1024 + col);
                            a[0] -= bflo(q.x); a[1] -= bfhi(q.x); a[2] -= bflo(q.y); a[3] -= bfhi(q.y); a[4] -= bflo(q.z); a[5] -= bfhi(q.z); a[6] -= bflo(q.w); a[7] -= bfhi(q.w); }
                        cnt = (s + 1 < w) ? s + 1 : w; }
                    const float rc = __builtin_amdgcn_rcpf((float)cnt);
                    v4u o; o.x = cvtpk(a[0] * rc - uc[0], a[1] * rc - uc[1]); o.y = cvtpk(a[2] * rc - uc[2], a[3] * rc - uc[3]);
                    o.z = cvtpk(a[4] * rc - uc[4], a[5] * rc - uc[5]); o.w = cvtpk(a[6] * rc - uc[6], a[7] * rc - uc[7]);
                    *(v4u*)(POOLED + (size_t)m * 1024 + col) = o;
                }
            }
        }
    TP_END(2); }
    SEAM(2);
    if (IN(3)) { TP_BEGIN(3);
        { pg8::Gemm g{CN, WQB_T, M, NH * DQK, QLORA, 1024, QLORA, 0, 0}; pg8::StaticOrder S; S.init(M, NH * DQK, G, bx);
          pg8::EpiBf16 E{Qb, 3072}; pg8::gemm_phase<pg8::EpiBf16, pg8::StaticOrder>(ldsl, g, S, E); }
        { pg8::Gemm g{CN + 512, WKVB_T, M, NH * 256, KVLORA, 1024, KVLORA, 0, 0}; pg8::StaticOrder S; S.init(M, NH * 256, G, bx);
          pg8::EpiKV E{Kb, Vb}; pg8::gemm_phase<pg8::EpiKV, pg8::StaticOrder>(ldsl, g, S, E); }
        { pg8::Gemm g{POOLED, WPG_T, M, POOLW, 256, 1024, 256, 256, 0}; pg8::StaticOrder S; S.init(M, POOLW, G, (bx + 128) % G);
          pg8::EpiScale E{PG, 1024, pool_scale}; pg8::gemm_phase<pg8::EpiScale, pg8::StaticOrder>(ldsl, g, S, E); }
    TP_END(3); }
    SEAM(3);
    if (IN(4)) { TP_BEGIN(4);
        for (int m = gw; m < M; m += NGW) {
            const float pos = (float)positions[m];
            const int sub = lane & 3, h = lane >> 2;
            float cs[8], sn[8];
#pragma unroll
            for (int j = 0; j < 8; ++j) { const int i = 8 * sub + j; const float invf = __builtin_amdgcn_exp2f(-(float)i * (13.287712379549449f / 32.f));
                const float ang = pos * invf; const float k = rintf(ang * 0.15915494309189535f);
                float r = fmaf(-k, 6.2831854820251465f, ang); r = fmaf(-k, -1.7484555e-7f, r);
                sn[j] = __sinf(r); cs[j] = __cosf(r); }
#pragma unroll
            for (int which = 0; which < 2; ++which) {
                bf16* base = (which == 0 ? Qb : Kb) + (size_t)m * 3072 + h * DQK;
                const float* gn = (which == 0) ? q_norm_g : k_norm_g;
                float nv[32], rl[8], rh[8]; float ss = 0.f;
#pragma unroll
                for (int jj = 0; jj < 4; ++jj) { const v4u q = *(const v4u*)(base + 32 * sub + 8 * jj);
                    nv[8 * jj + 0] = bflo(q.x); nv[8 * jj + 1] = bfhi(q.x); nv[8 * jj + 2] = bflo(q.y); nv[8 * jj + 3] = bfhi(q.y);
                    nv[8 * jj + 4] = bflo(q.z); nv[8 * jj + 5] = bfhi(q.z); nv[8 * jj + 6] = bflo(q.w); nv[8 * jj + 7] = bfhi(q.w); }
                if (which == 0) {
                    const v4u a = *(const v4u*)(base + 128 + 8 * sub), b = *(const v4u*)(base + 160 + 8 * sub);
                    rl[0] = bflo(a.x); rl[1] = bfhi(a.x); rl[2] = bflo(a.y); rl[3] = bfhi(a.y); rl[4] = bflo(a.z); rl[5] = bfhi(a.z); rl[6] = bflo(a.w); rl[7] = bfhi(a.w);
                    rh[0] = bflo(b.x); rh[1] = bfhi(b.x); rh[2] = bflo(b.y); rh[3] = bfhi(b.y); rh[4] = bflo(b.z); rh[5] = bfhi(b.z); rh[6] = bflo(b.w); rh[7] = bfhi(b.w);
                } else {
                    const float* kp = (const float*)(ws + WS_KR) + (size_t)m * 64 + 8 * sub;
                    const f32x4 a0 = *(const f32x4*)kp, a1 = *(const f32x4*)(kp + 4), b0 = *(const f32x4*)(kp + 32), b1 = *(const f32x4*)(kp + 36);
                    rl[0] = a0.x; rl[1] = a0.y; rl[2] = a0.z; rl[3] = a0.w; rl[4] = a1.x; rl[5] = a1.y; rl[6] = a1.z; rl[7] = a1.w;
                    rh[0] = b0.x; rh[1] = b0.y; rh[2] = b0.z; rh[3] = b0.w; rh[4] = b1.x; rh[5] = b1.y; rh[6] = b1.z; rh[7] = b1.w;
                }
#pragma unroll
                for (int e = 0; e < 32; ++e) ss += nv[e] * nv[e];
#pragma unroll
                for (int e = 0; e < 8; ++e) ss += rl[e] * rl[e] + rh[e] * rh[e];
                ss += __shfl_xor(ss, 1); ss += __shfl_xor(ss, 2);
                const float inv = __builtin_amdgcn_rsqf(ss * (1.f / 192.f) + EPS);
#pragma unroll
                for (int jj = 0; jj < 4; ++jj) { const f32x4 g0 = *(const f32x4*)(gn + 32 * sub + 8 * jj), g1 = *(const f32x4*)(gn + 32 * sub + 8 * jj + 4);
                    v4u o; o.x = cvtpk(nv[8 * jj + 0] * inv * g0.x, nv[8 * jj + 1] * inv * g0.y); o.y = cvtpk(nv[8 * jj + 2] * inv * g0.z, nv[8 * jj + 3] * inv * g0.w);
                    o.z = cvtpk(nv[8 * jj + 4] * inv * g1.x, nv[8 * jj + 5] * inv * g1.y); o.w = cvtpk(nv[8 * jj + 6] * inv * g1.z, nv[8 * jj + 7] * inv * g1.w);
                    *(v4u*)(base + 32 * sub + 8 * jj) = o; }
                float ol[8], oh[8];
#pragma unroll
                for (int e = 0; e < 8; ++e) { const float a = rl[e] * inv * gn[128 + 8 * sub + e], b = rh[e] * inv * gn[160 + 8 * sub + e];
                    ol[e] = a * cs[e] - b * sn[e]; oh[e] = b * cs[e] + a * sn[e]; }
                v4u o1, o2; o1.x = cvtpk(ol[0], ol[1]); o1.y = cvtpk(ol[2], ol[3]); o1.z = cvtpk(ol[4], ol[5]); o1.w = cvtpk(ol[6], ol[7]);
                o2.x = cvtpk(oh[0], oh[1]); o2.y = cvtpk(oh[2], oh[3]); o2.z = cvtpk(oh[4], oh[5]); o2.w = cvtpk(oh[6], oh[7]);
                *(v4u*)(base + 128 + 8 * sub) = o1; *(v4u*)(base + 160 + 8 * sub) = o2;
            }
        }
        { pg8::Gemm g{PG, WPO_T, M, DM, POOLW, POOLW, POOLW, 0, 0}; pg8::StaticOrder S; S.init(M, DM, G, bx);
          pg8::EpiGate<false> E{MP, Gt, nullptr, 0}; pg8::gemm_phase<pg8::EpiGate<false>, pg8::StaticOrder>(ldsl, g, S, E); }
    TP_END(4); }
    SEAM(4);
    if (IN(5)) { TP_BEGIN(5);
        const int npair = BATCH * NH * 8;
        for (int p = vcu; p < npair; p += G) {
            const int bh = p >> 3, s = p & 7;
            att::attn_unit(bh / NH, bh % NH, 15 - s, Qb, Kb, Vb, Ob, (char*)lds);
            att::attn_unit(bh / NH, bh % NH, s, Qb, Kb, Vb, Ob, (char*)lds);
        }
    TP_END(5); }
    SEAM(5);
    if (IN(6)) { TP_BEGIN(6);
        pg8::Gemm g{Ob, WAO_T, M, DM, DM, DM, DM, 0, 0}; pg8::StaticOrder S; S.init(M, DM, G, bx);
        pg8::EpiGate<true> E{MIXED, Gt, MP, 2048}; pg8::gemm_phase<pg8::EpiGate<true>, pg8::StaticOrder>(ldsl, g, S, E);
    TP_END(6); }
    SEAM(6);
    if (IN(7)) { TP_BEGIN(7);
        { constexpr int I_G = (DM / 64) * (DFF / 32);
#define GU_DESC(it__) ((it__) < I_G ? tr_desc(kin[17], DM, DFF, (bf16*)(ws + WS_WGU), 2, 0, (it__), ffn_norm_g) : tr_desc(kin[18], DM, DFF, (bf16*)(ws + WS_WGU), 3, 0, (it__) - I_G, ffn_norm_g))
          TR_PIPELINE(gw, 2 * I_G, NGW, GU_DESC);
#undef GU_DESC
          __syncthreads(); }
        pg8::Gemm g{MIXED, WOUT_T, M, DM, DM, DM, DM, 0, 0}; pg8::StaticOrder S; S.init(M, DM, G, bx);
        pg8::EpiResNorm E{kin[0], X1, (bf16*)(ws + WS_X1B), (float*)ws + SV_SS, DM}; pg8::gemm_phase<pg8::EpiResNorm, pg8::StaticOrder>(ldsl, g, S, E);
    TP_END(7); }
    SEAM(7);
    if (IN(9)) { TP_BEGIN(9);
        pg8::Gemm g{(bf16*)(ws + WS_X1B), WGU_T, M, 2 * DFF, DM, DM, DM, 0, 0}; pg8::StaticOrder S; S.init(M, 2 * DFF, G, bx);
        pg8::EpiSwiGLU E{ACT, DFF, (const float*)ws + SV_SS}; pg8::gemm_phase<pg8::EpiSwiGLU, pg8::StaticOrder>(ldsl, g, S, E);
        if (G == 256 ? (bx >= 128) : true) {
            constexpr int I_D2 = (DFF / 64) * (DM / 32);
            const int nw = (G == 256) ? 128 * NWAVES : NGW, w0 = (G == 256) ? (bx - 128) * NWAVES + wave : gw;
#define DN_DESC(it__) tr_desc(kin[19], DFF, DM, (bf16*)(ws + WS_WDN), 0, 0, (it__), nullptr)
            TR_PIPELINE(w0, I_D2, nw, DN_DESC);
#undef DN_DESC
        }
    TP_END(9); }
    SEAM(9);
    if (IN(10)) { TP_BEGIN(10);
        pg8::Gemm g{ACT, WDN_T, M, DM, DFF, DFF, DFF, 0, 0}; pg8::StaticOrder S; S.init(M, DM, G, bx);
        pg8::EpiRes E{(const bf16*)(ws + WS_X1B), args.out, DM}; pg8::gemm_phase<pg8::EpiRes, pg8::StaticOrder>(ldsl, g, S, E);
    TP_END(10); }
#ifdef TPROBE
    if (blockIdx.x == 0 && threadIdx.x == 0) { const unsigned w_ = 4u * ((volatile LAS unsigned*)(ldsl + 140000))[1]; const unsigned long long t0_ = __builtin_amdgcn_s_memrealtime(); while ((unsigned)(__builtin_amdgcn_s_memrealtime() - t0_) < w_) __builtin_amdgcn_s_sleep(8); }
#endif
#undef IN
#undef SEAM
}

extern "C" void kernel_launch(void* const* d_in, const int* in_sizes, int n_in, void* d_out, int out_size, void* d_ws, size_t ws_size, hipStream_t stream) {
    static int grid = 0;
    if (grid == 0) {
        if (n_in != 20 || out_size != M * DM || ws_size < WS_END) { fprintf(stderr, "kernel_launch: unexpected shapes (n_in %d, out %d, ws %zu)\n", n_in, out_size, ws_size); grid = -1; return; }
        int dev = 0, cus = 0, per_cu = 0;
        (void)hipGetDevice(&dev); (void)hipDeviceGetAttribute(&cus, hipDeviceAttributeMultiprocessorCount, dev);
        if (hipFuncSetAttribute((const void*)mega_fwd, hipFuncAttributeMaxDynamicSharedMemorySize, LDS_BYTES) != hipSuccess) { fprintf(stderr, "kernel_launch: hipFuncSetAttribute failed\n"); grid = -1; return; }
        if (hipOccupancyMaxActiveBlocksPerMultiprocessor(&per_cu, (const void*)mega_fwd, NWAVES * 64, LDS_BYTES) != hipSuccess || per_cu < 1) { fprintf(stderr, "kernel_launch: occupancy query says %d\n", per_cu); per_cu = 1; }
        (void)hipGetLastError();
        grid = cus > 0 ? cus : 256;
    }
    if (grid < 0) return;
    Args a{};
    for (int i = 0; i < 20; ++i) a.in[i] = (const float*)d_in[i];
    a.out = (float*)d_out; a.ws = (unsigned char*)d_ws;
    if (MK_N_LAUNCHES == 1) {
        a.ph_lo = 0; a.ph_hi = NPH; a.coop = 1;
        (void)hipMemsetAsync((char*)d_ws + WS_BAR, 0, 16384, stream);
        void* kargs[] = {&a};
        hipError_t e = hipLaunchCooperativeKernel((const void*)mega_fwd, dim3(grid), dim3(NWAVES * 64), kargs, LDS_BYTES, stream);
        if (e != hipSuccess) fprintf(stderr, "kernel_launch: cooperative launch failed: %s (grid %d)\n", hipGetErrorString(e), grid);
    } else {
        for (int p = 0; p < NPH; ++p) {
            a.ph_lo = p; a.ph_hi = p + 1;
            hipLaunchKernelGGL(mega_fwd, dim3(grid), dim3(NWAVES * 64), LDS_BYTES, stream, a);
        }
    }
}
```
